# Optimizing an MI355X kernel written in HIP

```python
import jax, jax.numpy as jnp
from jax import lax
import numpy as np

D_MODEL = 1024
BATCH = 2
SEQ = 8192
DEPTH = 1

D_MIX = D_MODEL
HG_WIDTH = D_MIX // 2
HG_DK = 128
HG_DV = 128
HG_HEADS = HG_WIDTH // HG_DV
HG_CHUNK = 64
NSA_WIDTH = D_MIX - HG_WIDTH
NSA_DH = 64
NSA_HEADS = NSA_WIDTH // NSA_DH
NSA_KV_HEADS = 2
NSA_GROUP = NSA_HEADS // NSA_KV_HEADS
CMP_LEN = 32
CMP_STRIDE = 16
SLC_LEN = 64
SLC_TOPK = 16
WIN = 512
Q_BLOCK = 128
PLE_DIM = 256
PEER_HEADS = 8
PEER_NKEYS = 128
PEER_N = PEER_NKEYS * PEER_NKEYS
PEER_DKEY = 256
PEER_TOPK = 16
PEER_TOKEN_BLOCK = 128
EPS = 1e-6

KV_WIDTH = NSA_KV_HEADS * NSA_DH
SPLIT_SIZES = (HG_WIDTH, HG_WIDTH, HG_WIDTH, HG_WIDTH, NSA_WIDTH,
               KV_WIDTH, KV_WIDTH, KV_WIDTH, KV_WIDTH, KV_WIDTH, KV_WIDTH, 3 * NSA_HEADS)
SPLIT_POINTS = tuple(int(v) for v in np.cumsum(SPLIT_SIZES)[:-1])
D_IN = int(sum(SPLIT_SIZES))

kernel_name = 'hybrid_hgrn2_nsa_peer_block'


def rmsnorm(x, g):
    x32 = x.astype(jnp.float32)
    y = x32 * lax.rsqrt(jnp.mean(x32 * x32, axis=-1, keepdims=True) + EPS)
    return (y * g.astype(jnp.float32)).astype(x.dtype)


def alibi_slopes(n_heads):
    return jnp.asarray(2.0 ** (-8.0 * np.arange(1, n_heads + 1) / n_heads), dtype=jnp.float32)


def masked_softmax(s, mask):
    s = jnp.where(mask, s, -jnp.inf)
    m = jnp.max(s, axis=-1, keepdims=True)
    m = jnp.where(jnp.isfinite(m), m, 0.0)
    e = jnp.where(mask, jnp.exp(s - m), 0.0)
    return e / jnp.maximum(jnp.sum(e, axis=-1, keepdims=True), 1e-30)


def hgrn2_mixer(q, f_logit, i_val, g, lb, out_gain):
    B, T, _ = q.shape
    f32 = jnp.float32
    C = HG_CHUNK
    n_chunk = T // C
    forget = lb + (1.0 - lb) * jax.nn.sigmoid(f_logit.astype(f32))
    log_f = jnp.log(forget)
    key = 1.0 - forget
    query = jax.nn.silu(q.astype(f32)) * HG_DK ** -0.5

    def chunks(a, d):
        return a.reshape(B, n_chunk, C, HG_HEADS, d).transpose(0, 3, 1, 2, 4)

    qc = chunks(query, HG_DK)
    kc = chunks(key, HG_DK)
    vc = chunks(i_val.astype(f32), HG_DV)
    G = jnp.cumsum(chunks(log_f, HG_DK), axis=3)
    G_ref = G[:, :, :, C // 2 - 1:C // 2]
    G_last = G[:, :, :, C - 1:C]
    causal = jnp.tril(jnp.ones((C, C), dtype=bool))
    a = jnp.einsum('bhntk,bhnsk->bhnts', qc * jnp.exp(G - G_ref), kc * jnp.exp(G_ref - G))
    o_intra = jnp.einsum('bhnts,bhnsv->bhntv', jnp.where(causal, a, 0.0), vc)
    q_in = jnp.moveaxis(qc * jnp.exp(G), 2, 0)
    k_in = jnp.moveaxis(kc * jnp.exp(G_last - G), 2, 0)
    v_in = jnp.moveaxis(vc, 2, 0)
    d_in = jnp.moveaxis(jnp.exp(G_last[:, :, :, 0]), 2, 0)

    def step(S, xs):
        q_t, k_t, v_t, d_t = xs
        o_t = jnp.einsum('bhtk,bhkv->bhtv', q_t, S)
        S = d_t[..., None] * S + jnp.einsum('bhtk,bhtv->bhkv', k_t, v_t)
        return S, o_t

    S0 = jnp.zeros((B, HG_HEADS, HG_DK, HG_DV), f32)
    _, o_inter = lax.scan(step, S0, (q_in, k_in, v_in, d_in))
    o = o_intra + jnp.moveaxis(o_inter, 0, 2)
    o = o.transpose(0, 2, 3, 1, 4).reshape(B, T, HG_HEADS, HG_DV)
    gate = jax.nn.silu(g.astype(f32)).reshape(B, T, HG_HEADS, HG_DV)
    return (rmsnorm(o, out_gain.reshape(HG_HEADS, HG_DV)) * gate).reshape(B, T, HG_WIDTH)


def cmp_to_slc(imp, n_slc):
    ratio = SLC_LEN // CMP_STRIDE
    span = CMP_LEN // CMP_STRIDE
    weights = np.convolve(np.ones(ratio), np.ones(span))
    n_cmp = imp.shape[-1]
    pad = n_slc * ratio + ratio + span - n_cmp
    padded = jnp.pad(imp, [(0, 0)] * (imp.ndim - 1) + [(0, pad)])
    out = float(weights[0]) * padded[..., 0:n_slc * ratio:ratio]
    for o in range(1, len(weights)):
        out = out + float(weights[o]) * padded[..., o:o + n_slc * ratio:ratio]
    return out


def nsa_mixer(q, k_cmp, v_cmp, k_slc, v_slc, k_win, v_win, gate_logit,
              q_gain, k_gain, cmp_pe, cmp_w1, cmp_w2, out_gain):
    B, T, _ = q.shape
    f32 = jnp.float32
    G, R = NSA_KV_HEADS, NSA_GROUP

    def heads(a, n):
        return a.astype(f32).reshape(B, T, n, NSA_DH).transpose(0, 2, 1, 3)

    qh = rmsnorm(heads(q, NSA_HEADS), q_gain) * NSA_DH ** -0.5
    qg = qh.reshape(B, G, R, T, NSA_DH)
    n_cmp = (T - CMP_LEN) // CMP_STRIDE + 1

    def compress(a, pe, w1, w2):
        c = a.reshape(B, G, T // CMP_STRIDE, CMP_STRIDE, NSA_DH)
        blk = jnp.concatenate([c[:, :, j:j + n_cmp] for j in range(CMP_LEN // CMP_STRIDE)], axis=3)
        blk = (blk + pe).reshape(B, G, n_cmp, CMP_LEN * NSA_DH)
        return jax.nn.gelu(blk @ w1) @ w2

    kc = rmsnorm(compress(heads(k_cmp, G), cmp_pe[0], cmp_w1[0], cmp_w2[0]), k_gain[0])
    vc = compress(heads(v_cmp, G), cmp_pe[1], cmp_w1[1], cmp_w2[1])
    cmp_end = jnp.arange(n_cmp) * CMP_STRIDE + CMP_LEN - 1
    n_slc = T // SLC_LEN
    top_n = min(SLC_TOPK, n_slc)
    k_sb = rmsnorm(heads(k_slc, G), k_gain[1]).reshape(B, G, n_slc, SLC_LEN, NSA_DH)
    v_sb = heads(v_slc, G).reshape(B, G, n_slc, SLC_LEN, NSA_DH)
    pad_w = ((0, 0), (0, 0), (WIN, 0), (0, 0))
    k_wp = jnp.pad(rmsnorm(heads(k_win, G), k_gain[2]), pad_w)
    v_wp = jnp.pad(heads(v_win, G), pad_w)
    gates = jax.nn.sigmoid(gate_logit.astype(f32)).reshape(B, T, NSA_HEADS, 3).transpose(0, 2, 1, 3)
    gates = gates.reshape(B, G, R, T, 3)
    slopes = alibi_slopes(NSA_HEADS).reshape(1, G, R, 1, 1)
    gather_blocks = jax.vmap(jax.vmap(lambda blocks, ix: blocks[ix]))

    def query_block(b):
        t0 = b * Q_BLOCK
        qb = lax.dynamic_slice_in_dim(qg, t0, Q_BLOCK, axis=3)
        gb = lax.dynamic_slice_in_dim(gates, t0, Q_BLOCK, axis=3)
        t = t0 + jnp.arange(Q_BLOCK)
        dist_c = t[:, None] - cmp_end[None, :]
        s_c = jnp.einsum('bgrtd,bgnd->bgrtn', qb, kc) - slopes * dist_c
        p_c = masked_softmax(s_c, dist_c >= 0)
        o_c = jnp.einsum('bgrtn,bgnd->bgrtd', p_c, vc)
        imp = cmp_to_slc(jnp.sum(p_c, axis=2), n_slc)
        blk_id = jnp.arange(n_slc)[None, :]
        cur = (t // SLC_LEN)[:, None]
        forced = (blk_id == 0) | (blk_id == cur) | (blk_id == cur - 1)
        imp = jnp.where(forced, jnp.inf, jnp.where(blk_id <= cur, imp, -jnp.inf))
        _, sel = lax.top_k(imp, top_n)
        ks = gather_blocks(k_sb, sel).reshape(B, G, Q_BLOCK, top_n * SLC_LEN, NSA_DH)
        vs = gather_blocks(v_sb, sel).reshape(B, G, Q_BLOCK, top_n * SLC_LEN, NSA_DH)
        pos = (sel[..., None] * SLC_LEN + jnp.arange(SLC_LEN)).reshape(B, G, Q_BLOCK, top_n * SLC_LEN)
        dist_s = (t[:, None] - pos)[:, :, None]
        s_s = jnp.einsum('bgrtd,bgtmd->bgrtm', qb, ks) - slopes * dist_s
        p_s = masked_softmax(s_s, dist_s >= 0)
        o_s = jnp.einsum('bgrtm,bgtmd->bgrtd', p_s, vs)
        kw = lax.dynamic_slice_in_dim(k_wp, t0, WIN + Q_BLOCK, axis=2)
        vw = lax.dynamic_slice_in_dim(v_wp, t0, WIN + Q_BLOCK, axis=2)
        pos_w = t0 - WIN + jnp.arange(WIN + Q_BLOCK)
        dist_w = t[:, None] - pos_w[None, :]
        valid_w = (dist_w >= 0) & (dist_w < WIN) & (pos_w[None, :] >= 0)
        s_w = jnp.einsum('bgrtd,bgsd->bgrts', qb, kw) - slopes * dist_w
        p_w = masked_softmax(s_w, valid_w)
        o_w = jnp.einsum('bgrts,bgsd->bgrtd', p_w, vw)
        return gb[..., 0:1] * o_c + gb[..., 1:2] * o_s + gb[..., 2:3] * o_w

    o = lax.map(query_block, jnp.arange(T // Q_BLOCK))
    o = o.transpose(1, 0, 4, 2, 3, 5).reshape(B, T, NSA_HEADS, NSA_DH)
    return rmsnorm(o, out_gain.reshape(NSA_HEADS, NSA_DH)).reshape(B, T, NSA_WIDTH)


def peer_ffn(h, wq, sub_keys, u, v):
    B, T, D = h.shape
    f32 = jnp.float32
    tokens = h.reshape(-1, PEER_TOKEN_BLOCK, D)

    def token_block(xt):
        q = (xt @ wq).astype(f32).reshape(PEER_TOKEN_BLOCK, PEER_HEADS, 2, PEER_DKEY // 2)
        s = jnp.einsum('thcd,hckd->thck', q, sub_keys.astype(f32))
        top_s, top_i = lax.top_k(s, PEER_TOPK)
        cand = top_s[:, :, 0, :, None] + top_s[:, :, 1, None, :]
        best_s, best_c = lax.top_k(cand.reshape(PEER_TOKEN_BLOCK, PEER_HEADS, PEER_TOPK * PEER_TOPK), PEER_TOPK)
        i1 = jnp.take_along_axis(top_i[:, :, 0], best_c // PEER_TOPK, axis=-1)
        i2 = jnp.take_along_axis(top_i[:, :, 1], best_c % PEER_TOPK, axis=-1)
        expert = i1 * PEER_NKEYS + i2
        w = jax.nn.softmax(best_s, axis=-1)
        act = jax.nn.gelu(jnp.einsum('thkd,td->thk', u[expert].astype(f32), xt.astype(f32)))
        return jnp.einsum('thk,thkd->td', w * act, v[expert].astype(f32))

    return lax.map(token_block, tokens).reshape(B, T, D).astype(h.dtype)


def setup_inputs(seed: int = 0) -> dict:
    key = jax.random.key(seed)
    ks = jax.random.split(key, 21)
    n = jax.random.normal
    f32 = jnp.float32

    def gain(k, shape):
        return 1.0 + 0.02 * n(k, shape, f32)

    return {
        'x': n(ks[0], (BATCH, SEQ, D_MODEL), f32),
        'p': n(ks[1], (DEPTH, BATCH, SEQ, PLE_DIM), f32),
        'mix_norm': gain(ks[2], (DEPTH, D_MODEL)),
        'w_in': n(ks[3], (DEPTH, D_MODEL, D_IN), f32) * D_MODEL ** -0.5,
        'hg_lb_logits': 0.1 * n(ks[4], (DEPTH + 1, HG_WIDTH), f32),
        'hg_out_norm': gain(ks[5], (DEPTH, HG_WIDTH)),
        'nsa_q_norm': gain(ks[6], (DEPTH, NSA_DH)),
        'nsa_k_norm': gain(ks[7], (DEPTH, 3, NSA_DH)),
        'cmp_pe': 0.02 * n(ks[8], (DEPTH, 2, CMP_LEN, NSA_DH), f32),
        'cmp_w1': n(ks[9], (DEPTH, 2, CMP_LEN * NSA_DH, NSA_DH), f32) * (CMP_LEN * NSA_DH) ** -0.5,
        'cmp_w2': n(ks[10], (DEPTH, 2, NSA_DH, NSA_DH), f32) * NSA_DH ** -0.5,
        'nsa_out_norm': gain(ks[11], (DEPTH, NSA_WIDTH)),
        'w_out': n(ks[12], (DEPTH, D_MIX, D_MODEL), f32) * D_MIX ** -0.5,
        'ffn_norm': gain(ks[13], (DEPTH, D_MODEL)),
        'peer_wq': n(ks[14], (DEPTH, D_MODEL, PEER_HEADS * PEER_DKEY), f32) * D_MODEL ** -0.5,
        'peer_keys': n(ks[15], (DEPTH, PEER_HEADS, 2, PEER_NKEYS, PEER_DKEY // 2), f32) * (PEER_DKEY // 2) ** -0.5,
        'peer_u': n(ks[16], (DEPTH, PEER_N, D_MODEL), f32) * D_MODEL ** -0.5,
        'peer_v': n(ks[17], (DEPTH, PEER_N, D_MODEL), f32) * PEER_HEADS ** -0.5,
        'ple_proj': n(ks[18], (DEPTH, PLE_DIM, D_MODEL), f32) * PLE_DIM ** -0.5,
        'ple_gate_norm': gain(ks[19], (DEPTH, D_MODEL)),
        'ple_gate_w': n(ks[20], (DEPTH, D_MODEL, D_MODEL), f32) * D_MODEL ** -0.5,
    }


def reference(x, p, mix_norm, w_in, hg_lb_logits, hg_out_norm, nsa_q_norm, nsa_k_norm,
              cmp_pe, cmp_w1, cmp_w2, nsa_out_norm, w_out, ffn_norm, peer_wq, peer_keys,
              peer_u, peer_v, ple_proj, ple_gate_norm, ple_gate_w):
    lb_table = jnp.cumsum(jax.nn.softmax(hg_lb_logits.astype(jnp.float32), axis=0), axis=0)
    h = x
    for i in range(DEPTH):
        a = rmsnorm(h, mix_norm[i])
        proj = a @ w_in[i]
        (hg_q, hg_f, hg_i, hg_g, n_q, n_kc, n_vc, n_ks, n_vs, n_kw, n_vw, n_gate) = jnp.split(proj, SPLIT_POINTS, axis=-1)
        o_hg = hgrn2_mixer(hg_q, hg_f, hg_i, hg_g, lb_table[i], hg_out_norm[i])
        o_nsa = nsa_mixer(n_q, n_kc, n_vc, n_ks, n_vs, n_kw, n_vw, n_gate,
                          nsa_q_norm[i], nsa_k_norm[i], cmp_pe[i], cmp_w1[i], cmp_w2[i], nsa_out_norm[i])
        mixed = jnp.concatenate([o_hg, o_nsa], axis=-1).astype(h.dtype)
        h = h + mixed @ w_out[i]
        h = h + peer_ffn(rmsnorm(h, ffn_norm[i]), peer_wq[i], peer_keys[i], peer_u[i], peer_v[i])
        gate = jax.nn.sigmoid(rmsnorm(h, ple_gate_norm[i]) @ ple_gate_w[i])
        h = h + (p[i] @ ple_proj[i]) * gate
    return h
```

```cpp
#include <hip/hip_runtime.h>
#include <cstdint>
#include <cstdio>

constexpr int D = 1024, NB = 2, T = 8192, NTOK = NB * T;
constexpr int DIN = 3352, PS = 3392;
constexpr int C_HQ = 0, C_HF = 512, C_HI = 1024, C_HG = 1536, C_NQ = 2048, C_KC = 2560, C_VC = 2688,
              C_KS = 2816, C_VS = 2944, C_KW = 3072, C_VW = 3200, C_GT = 3328;
constexpr int NCMP = 511;
constexpr float EPS = 1e-6f;
typedef unsigned short bf16;

constexpr size_t MiB = 1u << 20;
constexpr size_t WS_ACT = 82 * MiB;
constexpr size_t WS_PROJ = 114 * MiB;
constexpr size_t WS_SPARE = 220 * MiB;
constexpr size_t WS_IDS = WS_SPARE;
constexpr size_t WS_WTS = WS_SPARE + 8 * MiB;
constexpr size_t WS_KCF = WS_SPARE + 16 * MiB;
constexpr size_t WS_VCF = WS_SPARE + 17 * MiB;
constexpr size_t WS_GL = 18 * MiB;

__device__ __forceinline__ float bf2f(bf16 v) { return __uint_as_float(((unsigned)v) << 16); }
__device__ __forceinline__ bf16 f2bf(float f) { unsigned u = __float_as_uint(f); return (bf16)((u + 0x7fffu + ((u >> 16) & 1u)) >> 16); }
__device__ __forceinline__ float wave_sum(float v) {
#pragma unroll
    for (int o = 1; o < 64; o <<= 1) v += __shfl_xor(v, o);
    return v;
}
__device__ __forceinline__ float wave_max(float v) {
#pragma unroll
    for (int o = 1; o < 64; o <<= 1) v = fmaxf(v, __shfl_xor(v, o));
    return v;
}
__device__ __forceinline__ float sigmoidf_(float x) { return 1.0f / (1.0f + __expf(-x)); }
__device__ __forceinline__ float siluf_(float x) { return x * sigmoidf_(x); }
__device__ __forceinline__ float gelu_tanh(float x) { return 0.5f * x * (1.0f + tanhf(0.7978845608028654f * (x + 0.044715f * x * x * x))); }
__device__ __forceinline__ float toF(float v) { return v; }
__device__ __forceinline__ float toF(bf16 v) { return bf2f(v); }

__global__ void __launch_bounds__(256) k_rms_rows(const float* __restrict__ x, const float* __restrict__ g, bf16* __restrict__ out, int rows) {
    const int wave = (blockIdx.x * 256 + threadIdx.x) >> 6, lane = threadIdx.x & 63;
    if (wave >= rows) return;
    const float* xr = x + (size_t)wave * D;
    float v[16]; float s = 0.f;
#pragma unroll
    for (int j = 0; j < 16; ++j) { v[j] = xr[lane + 64 * j]; s += v[j] * v[j]; }
    s = wave_sum(s);
    const float r = rsqrtf(s * (1.0f / D) + EPS);
#pragma unroll
    for (int j = 0; j < 16; ++j) out[(size_t)wave * D + lane + 64 * j] = f2bf(v[j] * r * g[lane + 64 * j]);
}

struct EpiBf16 { bf16* C; int ldc; int pad; __device__ void operator()(int r, int c, float v) const { C[(size_t)r * ldc + c] = f2bf(v); } };
struct EpiF32 { float* C; int ldc; int pad; __device__ void operator()(int r, int c, float v) const { C[(size_t)r * ldc + c] = v; } };
struct EpiResid { const float* X; float* O; int ld; int pad; __device__ void operator()(int r, int c, float v) const { O[(size_t)r * ld + c] = X[(size_t)r * ld + c] + v; } };
struct EpiFinal { const float* G; float* O; int ld; int pad; __device__ void operator()(int r, int c, float v) const { const size_t i = (size_t)r * ld + c; O[i] = O[i] + v * sigmoidf_(G[i]); } };

template <typename AT, class Epi>
__global__ void __launch_bounds__(256) k_gemm_naive(const AT* __restrict__ A, int lda, const float* __restrict__ W, int ldw, int N, int K, Epi epi) {
    __shared__ float As[16][65];
    __shared__ float Bs[16][64];
    const int tid = threadIdx.x, tx = tid & 15, ty = tid >> 4;
    const int m0 = blockIdx.y * 64, n0 = blockIdx.x * 64;
    float acc[4][4];
#pragma unroll
    for (int i = 0; i < 4; ++i)
#pragma unroll
        for (int j = 0; j < 4; ++j) acc[i][j] = 0.f;
    for (int k0 = 0; k0 < K; k0 += 16) {
#pragma unroll
        for (int i = 0; i < 4; ++i) { const int idx = tid + i * 256, r = idx >> 4, kk = idx & 15; As[kk][r] = toF(A[(size_t)(m0 + r) * lda + k0 + kk]); }
#pragma unroll
        for (int i = 0; i < 4; ++i) { const int idx = tid + i * 256, kk = idx >> 6, c = idx & 63; Bs[kk][c] = (n0 + c < N) ? W[(size_t)(k0 + kk) * ldw + n0 + c] : 0.f; }
        __syncthreads();
#pragma unroll
        for (int kk = 0; kk < 16; ++kk) {
            float a[4], b[4];
#pragma unroll
            for (int i = 0; i < 4; ++i) a[i] = As[kk][ty * 4 + i];
#pragma unroll
            for (int j = 0; j < 4; ++j) b[j] = Bs[kk][tx * 4 + j];
#pragma unroll
            for (int i = 0; i < 4; ++i)
#pragma unroll
                for (int j = 0; j < 4; ++j) acc[i][j] += a[i] * b[j];
        }
        __syncthreads();
    }
#pragma unroll
    for (int i = 0; i < 4; ++i)
#pragma unroll
        for (int j = 0; j < 4; ++j) { const int r = m0 + ty * 4 + i, c = n0 + tx * 4 + j; if (c < N) epi(r, c, acc[i][j]); }
}

__global__ void __launch_bounds__(1024) k_hgrn_naive(const bf16* __restrict__ proj, const float* __restrict__ lb_logits, const float* __restrict__ out_gain, bf16* __restrict__ mixed) {
    const int b = blockIdx.x >> 2, h = blockIdx.x & 3, tid = threadIdx.x, v = tid & 127, kg = tid >> 7;
    __shared__ float qsh[128], ksh[128], fsh[128], vsh[128], part[8][128], red[2], lbs[128];
    if (tid < 128) { const float l0 = lb_logits[h * 128 + tid], l1 = lb_logits[512 + h * 128 + tid]; const float m = fmaxf(l0, l1); const float e0 = expf(l0 - m), e1 = expf(l1 - m); lbs[tid] = e0 / (e0 + e1); }
    float S[16];
#pragma unroll
    for (int i = 0; i < 16; ++i) S[i] = 0.f;
    __syncthreads();
    for (int t = 0; t < T; ++t) {
        const size_t row = (size_t)(b * T + t) * PS;
        if (tid < 128) {
            const float fl = bf2f(proj[row + C_HF + h * 128 + tid]); const float lb = lbs[tid];
            const float fg = lb + (1.0f - lb) * sigmoidf_(fl); fsh[tid] = fg; ksh[tid] = 1.0f - fg;
            qsh[tid] = siluf_(bf2f(proj[row + C_HQ + h * 128 + tid])) * 0.08838834764831845f;
        } else if (tid < 256) vsh[tid - 128] = bf2f(proj[row + C_HI + h * 128 + tid - 128]);
        __syncthreads();
        const float vv = vsh[v]; float p = 0.f;
#pragma unroll
        for (int i = 0; i < 16; ++i) { const int k = kg * 16 + i; S[i] = fsh[k] * S[i] + ksh[k] * vv; p += qsh[k] * S[i]; }
        part[kg][v] = p;
        __syncthreads();
        float o = 0.f;
        if (tid < 128) {
#pragma unroll
            for (int j = 0; j < 8; ++j) o += part[j][tid];
            const float ss = wave_sum(o * o); if ((tid & 63) == 0) red[tid >> 6] = ss;
        }
        __syncthreads();
        if (tid < 128) {
            const float tot = red[0] + red[1];
            const float y = o * rsqrtf(tot * (1.0f / 128.0f) + EPS) * out_gain[h * 128 + tid];
            const float gl = bf2f(proj[row + C_HG + h * 128 + tid]);
            mixed[(size_t)(b * T + t) * D + h * 128 + tid] = f2bf(y * siluf_(gl));
        }
    }
}

__global__ void __launch_bounds__(64) k_cmp_naive(const bf16* __restrict__ proj, const float* __restrict__ pe, const float* __restrict__ w1, const float* __restrict__ w2,
                                                  const float* __restrict__ k_gain, float* __restrict__ kc, float* __restrict__ vc) {
    int it = blockIdx.x; const int n = it % NCMP; it /= NCMP; const int g = it & 1; it >>= 1; const int b = it & 1; const int which = it >> 1;
    const int c = threadIdx.x;
    __shared__ float blk[2048]; __shared__ float hid[64];
    const int col0 = (which == 0 ? C_KC : C_VC) + g * 64;
    for (int i = c; i < 2048; i += 64) { const int j = i >> 6, d = i & 63; blk[i] = bf2f(proj[(size_t)(b * T + 16 * n + j) * PS + col0 + d]) + pe[which * 2048 + i]; }
    __syncthreads();
    float acc = 0.f;
    for (int i = 0; i < 2048; ++i) acc += blk[i] * w1[(size_t)which * 2048 * 64 + (size_t)i * 64 + c];
    hid[c] = gelu_tanh(acc);
    __syncthreads();
    float o = 0.f;
    for (int i = 0; i < 64; ++i) o += hid[i] * w2[which * 4096 + i * 64 + c];
    if (which == 0) { const float ss = wave_sum(o * o); o = o * rsqrtf(ss * (1.0f / 64.0f) + EPS) * k_gain[c]; }
    (which == 0 ? kc : vc)[((size_t)(b * 2 + g) * NCMP + n) * 64 + c] = o;
}

__global__ void __launch_bounds__(256) k_nsa_naive(const bf16* __restrict__ proj, const float* __restrict__ kc, const float* __restrict__ vc, const float* __restrict__ q_gain,
                                                   const float* __restrict__ k_gain, const float* __restrict__ out_gain, bf16* __restrict__ mixed) {
    const int g = blockIdx.x & 1, tok = blockIdx.x >> 1, b = tok / T, t = tok % T;
    const int tid = threadIdx.x, r = tid >> 6, lane = tid & 63, h = g * 4 + r;
    __shared__ float qs[4][64]; __shared__ float sc[4][1024]; __shared__ float P[520]; __shared__ float imp[128]; __shared__ int sel[128]; __shared__ int blist[16]; __shared__ int nbs;
    const float slope = exp2f(-(float)(h + 1));
    const float NEG = -__builtin_huge_valf();
    {
        float qv = bf2f(proj[(size_t)tok * PS + C_NQ + h * 64 + lane]);
        const float ss = wave_sum(qv * qv);
        qs[r][lane] = qv * rsqrtf(ss * (1.0f / 64.0f) + EPS) * q_gain[lane] * 0.125f;
    }
    __syncthreads();
    const int nvalid = (t >= 31) ? ((t - 31) / 16 + 1) : 0;
    const float* kcb = kc + (size_t)(b * 2 + g) * NCMP * 64; const float* vcb = vc + (size_t)(b * 2 + g) * NCMP * 64;
    float mx = NEG;
    for (int n = lane; n < 512; n += 64) {
        float s = NEG;
        if (n < nvalid) { float d = 0.f; for (int i = 0; i < 64; ++i) d += qs[r][i] * kcb[n * 64 + i]; s = d - slope * (float)(t - (16 * n + 31)); }
        sc[r][n] = s; mx = fmaxf(mx, s);
    }
    mx = wave_max(mx); if (mx == NEG) mx = 0.f;
    float sum = 0.f;
    for (int n = lane; n < 512; n += 64) { const float e = (n < nvalid) ? expf(sc[r][n] - mx) : 0.f; sc[r][n] = e; sum += e; }
    sum = wave_sum(sum); float inv = 1.0f / fmaxf(sum, 1e-30f);
    for (int n = lane; n < 512; n += 64) sc[r][n] *= inv;
    __syncthreads();
    float oc = 0.f;
    for (int n = 0; n < nvalid; ++n) oc += sc[r][n] * vcb[n * 64 + lane];
    for (int i = tid; i < 520; i += 256) P[i] = (i < 512) ? (sc[0][i] + sc[1][i] + sc[2][i] + sc[3][i]) : 0.f;
    __syncthreads();
    if (tid < 128) imp[tid] = P[4 * tid] + 2.f * P[4 * tid + 1] + 2.f * P[4 * tid + 2] + 2.f * P[4 * tid + 3] + P[4 * tid + 4];
    __syncthreads();
    const int cur = t >> 6;
    if (tid < 128) {
        const int j = tid; const bool forced = (j == 0) || (j == cur) || (j == cur - 1); const bool cand = !forced && j <= cur;
        const int nforced = (cur == 0) ? 1 : (cur == 1) ? 2 : 3; const int need = 16 - nforced;
        int rank = 0; const float mine = imp[j];
        for (int q = 1; q <= cur - 2; ++q) { if (q == j) continue; const float o = imp[q]; if (o > mine || (o == mine && q < j)) ++rank; }
        sel[j] = (forced || (cand && rank < need)) ? 1 : 0;
    }
    __syncthreads();
    if (tid == 0) { int nb = 0; for (int j = 0; j < 128; ++j) if (sel[j] && nb < 16) blist[nb++] = j; nbs = nb; }
    __syncthreads();
    const int nb = nbs;
    float os = 0.f;
    {
        float m2 = NEG;
        for (int s = 0; s < nb; ++s) {
            const int pos = blist[s] * 64 + lane; float val = NEG;
            if (pos <= t) {
                const bf16* kr = proj + (size_t)(b * T + pos) * PS + C_KS + g * 64; float d = 0.f, sq = 0.f;
                for (int i = 0; i < 64; ++i) { const float kv = bf2f(kr[i]); d += qs[r][i] * kv * k_gain[64 + i]; sq += kv * kv; }
                val = d * rsqrtf(sq * (1.0f / 64.0f) + EPS) - slope * (float)(t - pos);
            }
            sc[r][s * 64 + lane] = val; m2 = fmaxf(m2, val);
        }
        m2 = wave_max(m2); if (m2 == NEG) m2 = 0.f;
        float su = 0.f;
        for (int s = 0; s < nb; ++s) { const float v0 = sc[r][s * 64 + lane]; const float e = (v0 == NEG) ? 0.f : expf(v0 - m2); sc[r][s * 64 + lane] = e; su += e; }
        su = wave_sum(su); const float iv = 1.0f / fmaxf(su, 1e-30f);
        __syncthreads();
        for (int s = 0; s < nb; ++s) for (int i = 0; i < 64; ++i) {
            const float p = sc[r][s * 64 + i]; if (p != 0.f) os += p * bf2f(proj[(size_t)(b * T + blist[s] * 64 + i) * PS + C_VS + g * 64 + lane]); }
        os *= iv;
    }
    __syncthreads();
    float ow = 0.f;
    {
        float m2 = NEG;
        for (int i = lane; i < 512; i += 64) {
            const int pos = t - i; float val = NEG;
            if (pos >= 0) {
                const bf16* kr = proj + (size_t)(b * T + pos) * PS + C_KW + g * 64; float d = 0.f, sq = 0.f;
                for (int c = 0; c < 64; ++c) { const float kv = bf2f(kr[c]); d += qs[r][c] * kv * k_gain[128 + c]; sq += kv * kv; }
                val = d * rsqrtf(sq * (1.0f / 64.0f) + EPS) - slope * (float)i;
            }
            sc[r][i] = val; m2 = fmaxf(m2, val);
        }
        m2 = wave_max(m2);
        float su = 0.f;
        for (int i = lane; i < 512; i += 64) { const float v0 = sc[r][i]; const float e = (v0 == NEG) ? 0.f : expf(v0 - m2); sc[r][i] = e; su += e; }
        su = wave_sum(su); const float iv = 1.0f / fmaxf(su, 1e-30f);
        __syncthreads();
        for (int i = 0; i < 512; ++i) { const float p = sc[r][i]; if (p != 0.f) ow += p * bf2f(proj[(size_t)(b * T + t - i) * PS + C_VW + g * 64 + lane]); }
        ow *= iv;
    }
    const bf16* gl = proj + (size_t)tok * PS + C_GT + h * 3;
    const float o = sigmoidf_(bf2f(gl[0])) * oc + sigmoidf_(bf2f(gl[1])) * os + sigmoidf_(bf2f(gl[2])) * ow;
    const float ss = wave_sum(o * o);
    mixed[(size_t)tok * D + 512 + h * 64 + lane] = f2bf(o * rsqrtf(ss * (1.0f / 64.0f) + EPS) * out_gain[h * 64 + lane]);
}

__global__ void __launch_bounds__(128) k_peer_topk_naive(const bf16* __restrict__ pq, const float* __restrict__ keys, int* __restrict__ ids, float* __restrict__ wts) {
    const int tok = blockIdx.x >> 3, h = blockIdx.x & 7, k = threadIdx.x;
    __shared__ float q[256]; __shared__ float s[2][128]; __shared__ float ts[2][16]; __shared__ int ti[2][16]; __shared__ float cand[256]; __shared__ float bs[16]; __shared__ int bc[16];
    q[k] = bf2f(pq[(size_t)tok * 2048 + h * 256 + k]); q[k + 128] = bf2f(pq[(size_t)tok * 2048 + h * 256 + 128 + k]);
    __syncthreads();
#pragma unroll
    for (int c = 0; c < 2; ++c) { const float* kr = keys + ((size_t)(h * 2 + c) * 128 + k) * 128; float d = 0.f; for (int i = 0; i < 128; ++i) d += q[c * 128 + i] * kr[i]; s[c][k] = d; }
    __syncthreads();
#pragma unroll
    for (int c = 0; c < 2; ++c) { const float mine = s[c][k]; int rank = 0; for (int j = 0; j < 128; ++j) { const float o = s[c][j]; if (o > mine || (o == mine && j < k)) ++rank; } if (rank < 16) { ts[c][rank] = mine; ti[c][rank] = k; } }
    __syncthreads();
    cand[k] = ts[0][k >> 4] + ts[1][k & 15]; cand[k + 128] = ts[0][(k + 128) >> 4] + ts[1][(k + 128) & 15];
    __syncthreads();
#pragma unroll
    for (int e = 0; e < 2; ++e) { const int me = k + e * 128; const float mine = cand[me]; int rank = 0; for (int j = 0; j < 256; ++j) { const float o = cand[j]; if (o > mine || (o == mine && j < me)) ++rank; } if (rank < 16) { bs[rank] = mine; bc[rank] = me; } }
    __syncthreads();
    if (k < 16) {
        float mx = bs[0]; float sum = 0.f; for (int j = 0; j < 16; ++j) sum += expf(bs[j] - mx);
        const int c = bc[k]; ids[(size_t)tok * 128 + h * 16 + k] = ti[0][c >> 4] * 128 + ti[1][c & 15];
        wts[(size_t)tok * 128 + h * 16 + k] = expf(bs[k] - mx) / sum;
    }
}

__global__ void __launch_bounds__(256) k_peer_gather_naive(const bf16* __restrict__ hn, const int* __restrict__ ids, const float* __restrict__ wts, const float* __restrict__ U, const float* __restrict__ V,
                                                           const float* __restrict__ gnorm, float* __restrict__ hio, bf16* __restrict__ hg) {
    const int tok = blockIdx.x, tid = threadIdx.x, w = tid >> 6, lane = tid & 63;
    __shared__ float xs[1024]; __shared__ float coef[128]; __shared__ int eid[128]; __shared__ float red[4];
    for (int i = tid; i < 1024; i += 256) xs[i] = bf2f(hn[(size_t)tok * D + i]);
    if (tid < 128) eid[tid] = ids[(size_t)tok * 128 + tid];
    __syncthreads();
    for (int e = w * 32; e < w * 32 + 32; ++e) {
        const float* ur = U + (size_t)eid[e] * D; float d = 0.f;
        for (int i = lane; i < 1024; i += 64) d += ur[i] * xs[i];
        d = wave_sum(d);
        if (lane == 0) coef[e] = wts[(size_t)tok * 128 + e] * gelu_tanh(d);
    }
    __syncthreads();
    float o[4] = {0.f, 0.f, 0.f, 0.f};
    for (int e = 0; e < 128; ++e) { const float* vr = V + (size_t)eid[e] * D; const float c = coef[e];
#pragma unroll
        for (int j = 0; j < 4; ++j) o[j] += c * vr[tid + 256 * j]; }
    float ss = 0.f;
#pragma unroll
    for (int j = 0; j < 4; ++j) { o[j] += hio[(size_t)tok * D + tid + 256 * j]; hio[(size_t)tok * D + tid + 256 * j] = o[j]; ss += o[j] * o[j]; }
    ss = wave_sum(ss); if (lane == 0) red[w] = ss;
    __syncthreads();
    const float r = rsqrtf((red[0] + red[1] + red[2] + red[3]) * (1.0f / D) + EPS);
#pragma unroll
    for (int j = 0; j < 4; ++j) hg[(size_t)tok * D + tid + 256 * j] = f2bf(o[j] * r * gnorm[tid + 256 * j]);
}

extern "C" void kernel_launch(void* const* d_in, const int* in_sizes, int n_in, void* d_out, int out_size, void* d_ws, size_t ws_size, hipStream_t stream) {
    const float* x = (const float*)d_in[0]; const float* p = (const float*)d_in[1]; const float* mix_norm = (const float*)d_in[2]; const float* w_in = (const float*)d_in[3];
    const float* lb_logits = (const float*)d_in[4]; const float* hg_out_norm = (const float*)d_in[5]; const float* q_norm = (const float*)d_in[6]; const float* k_norm = (const float*)d_in[7];
    const float* cmp_pe = (const float*)d_in[8]; const float* cmp_w1 = (const float*)d_in[9]; const float* cmp_w2 = (const float*)d_in[10]; const float* nsa_out_norm = (const float*)d_in[11];
    const float* w_out = (const float*)d_in[12]; const float* ffn_norm = (const float*)d_in[13]; const float* peer_wq = (const float*)d_in[14]; const float* peer_keys = (const float*)d_in[15];
    const float* peer_u = (const float*)d_in[16]; const float* peer_v = (const float*)d_in[17]; const float* ple_proj = (const float*)d_in[18]; const float* ple_gate_norm = (const float*)d_in[19];
    const float* ple_gate_w = (const float*)d_in[20];
    float* out = (float*)d_out; unsigned char* ws = (unsigned char*)d_ws;
    bf16* act = (bf16*)(ws + WS_ACT); bf16* proj = (bf16*)(ws + WS_PROJ);
    bf16* pq = (bf16*)(ws + WS_PROJ); bf16* hg = (bf16*)(ws + WS_PROJ + 64 * MiB);
    int* ids = (int*)(ws + WS_IDS); float* wts = (float*)(ws + WS_WTS); float* kcf = (float*)(ws + WS_KCF); float* vcf = (float*)(ws + WS_VCF); float* gl = (float*)(ws + WS_GL);

    k_rms_rows<<<NTOK / 4, 256, 0, stream>>>(x, mix_norm, act, NTOK);
    k_gemm_naive<bf16, EpiBf16><<<dim3((DIN + 63) / 64, NTOK / 64), 256, 0, stream>>>(act, D, w_in, DIN, DIN, D, EpiBf16{proj, PS, 0});
    k_hgrn_naive<<<8, 1024, 0, stream>>>(proj, lb_logits, hg_out_norm, act);
    k_cmp_naive<<<2 * 2 * 2 * NCMP, 64, 0, stream>>>(proj, cmp_pe, cmp_w1, cmp_w2, k_norm, kcf, vcf);
    k_nsa_naive<<<NTOK * 2, 256, 0, stream>>>(proj, kcf, vcf, q_norm, k_norm, nsa_out_norm, act);
    k_gemm_naive<bf16, EpiResid><<<dim3(D / 64, NTOK / 64), 256, 0, stream>>>(act, D, w_out, D, D, D, EpiResid{x, out, D, 0});
    k_rms_rows<<<NTOK / 4, 256, 0, stream>>>(out, ffn_norm, act, NTOK);
    k_gemm_naive<bf16, EpiBf16><<<dim3(2048 / 64, NTOK / 64), 256, 0, stream>>>(act, D, peer_wq, 2048, 2048, D, EpiBf16{pq, 2048, 0});
    k_peer_topk_naive<<<NTOK * 8, 128, 0, stream>>>(pq, peer_keys, ids, wts);
    k_peer_gather_naive<<<NTOK, 256, 0, stream>>>(act, ids, wts, peer_u, peer_v, ple_gate_norm, out, hg);
    k_gemm_naive<bf16, EpiF32><<<dim3(D / 64, NTOK / 64), 256, 0, stream>>>(hg, D, ple_gate_w, D, D, D, EpiF32{gl, D, 0});
    k_gemm_naive<float, EpiFinal><<<dim3(D / 64, NTOK / 64), 256, 0, stream>>>(p, 256, ple_proj, D, D, 256, EpiFinal{gl, out, D, 0});
}
```

```cpp
#include <hip/hip_runtime.h>
#include <hip/hip_cooperative_groups.h>
#include <cstdint>
#include <cstdio>
namespace cg = cooperative_groups;

constexpr int D = 1024, NB = 2, T = 8192, NTOK = NB * T;
constexpr int DIN = 3352, PS = 3392;
constexpr int C_HQ = 0, C_HF = 512, C_HI = 1024, C_HG = 1536, C_NQ = 2048, C_KC = 2560, C_VC = 2688,
              C_KS = 2816, C_VS = 2944, C_KW = 3072, C_VW = 3200, C_GT = 3328;
constexpr int NCMP = 511;
constexpr float EPS = 1e-6f;
typedef unsigned short bf16;

constexpr size_t MiB = 1u << 20;
constexpr size_t WS_WINT = 1 * MiB;
constexpr size_t WS_WOUTT = 8 * MiB;
constexpr size_t WS_WQT = 10 * MiB;
constexpr size_t WS_WGT = 14 * MiB;
constexpr size_t WS_WPT = 16 * MiB;
constexpr size_t WS_KEYB = 16 * MiB + 512 * 1024;
constexpr size_t WS_W1T = 17 * MiB;
constexpr size_t WS_UB = 18 * MiB;
constexpr size_t WS_VB = 50 * MiB;
constexpr size_t WS_ACT = 82 * MiB;
constexpr size_t WS_PROJ = 114 * MiB;
constexpr size_t WS_SPARE = 220 * MiB;
constexpr size_t WS_IDS = WS_SPARE;
constexpr size_t WS_WTS = WS_SPARE + 8 * MiB;
constexpr size_t WS_KCF = WS_SPARE + 16 * MiB;
constexpr size_t WS_VCF = WS_SPARE + 17 * MiB;
constexpr size_t WS_PB = WS_SPARE + 18 * MiB;
constexpr size_t WS_VTS = WS_SPARE + 26 * MiB;
constexpr size_t WS_VTW = WS_SPARE + 30 * MiB;
constexpr size_t WS_KC = WS_SPARE + 34 * MiB;
constexpr size_t WS_VCT = WS_SPARE + 34 * MiB + 256 * 1024;
constexpr size_t WS_DEC = WS_SPARE + 34 * MiB + 512 * 1024;
constexpr size_t OUT_KIT = 32 * MiB;
constexpr size_t OUT_VT = 48 * MiB;
constexpr size_t WS_GL = 18 * MiB;

__device__ __forceinline__ float bf2f(bf16 v) { return __uint_as_float(((unsigned)v) << 16); }
__device__ __forceinline__ bf16 f2bf(float f) { unsigned u = __float_as_uint(f); return (bf16)((u + 0x7fffu + ((u >> 16) & 1u)) >> 16); }
__device__ __forceinline__ float wave_sum(float v) {
#pragma unroll
    for (int o = 1; o < 64; o <<= 1) v += __shfl_xor(v, o);
    return v;
}
__device__ __forceinline__ float wave_max(float v) {
#pragma unroll
    for (int o = 1; o < 64; o <<= 1) v = fmaxf(v, __shfl_xor(v, o));
    return v;
}
__device__ __forceinline__ float sigmoidf_(float x) { return 1.0f / (1.0f + __expf(-x)); }
__device__ __forceinline__ float siluf_(float x) { return x * sigmoidf_(x); }
__device__ __forceinline__ float gelu_tanh(float x) { return 0.5f * x * (1.0f + tanhf(0.7978845608028654f * (x + 0.044715f * x * x * x))); }
__device__ __forceinline__ float toF(float v) { return v; }
__device__ __forceinline__ float toF(bf16 v) { return bf2f(v); }

__global__ void __launch_bounds__(256) k_rms_rows(const float* __restrict__ x, const float* __restrict__ g, bf16* __restrict__ out, int rows) {
    const int wave = (blockIdx.x * 256 + threadIdx.x) >> 6, lane = threadIdx.x & 63;
    if (wave >= rows) return;
    const float* xr = x + (size_t)wave * D;
    float v[16]; float s = 0.f;
#pragma unroll
    for (int j = 0; j < 16; ++j) { v[j] = xr[lane + 64 * j]; s += v[j] * v[j]; }
    s = wave_sum(s);
    const float r = rsqrtf(s * (1.0f / D) + EPS);
#pragma unroll
    for (int j = 0; j < 16; ++j) out[(size_t)wave * D + lane + 64 * j] = f2bf(v[j] * r * g[lane + 64 * j]);
}

struct EpiBf16 { bf16* C; int ldc; int pad; __device__ void operator()(int r, int c, float v) const { C[(size_t)r * ldc + c] = f2bf(v); } };
struct EpiF32 { float* C; int ldc; int pad; __device__ void operator()(int r, int c, float v) const { C[(size_t)r * ldc + c] = v; } };
struct EpiResid { const float* X; float* O; int ld; int pad; __device__ void operator()(int r, int c, float v) const { O[(size_t)r * ld + c] = X[(size_t)r * ld + c] + v; } };
struct EpiFinal { const float* G; float* O; int ld; int pad; __device__ void operator()(int r, int c, float v) const { const size_t i = (size_t)r * ld + c; O[i] = O[i] + v * sigmoidf_(G[i]); } };

template <typename AT, class Epi>
__global__ void __launch_bounds__(256) k_gemm_naive(const AT* __restrict__ A, int lda, const float* __restrict__ W, int ldw, int N, int K, Epi epi) {
    __shared__ float As[16][65];
    __shared__ float Bs[16][64];
    const int tid = threadIdx.x, tx = tid & 15, ty = tid >> 4;
    const int m0 = blockIdx.y * 64, n0 = blockIdx.x * 64;
    float acc[4][4];
#pragma unroll
    for (int i = 0; i < 4; ++i)
#pragma unroll
        for (int j = 0; j < 4; ++j) acc[i][j] = 0.f;
    for (int k0 = 0; k0 < K; k0 += 16) {
#pragma unroll
        for (int i = 0; i < 4; ++i) { const int idx = tid + i * 256, r = idx >> 4, kk = idx & 15; As[kk][r] = toF(A[(size_t)(m0 + r) * lda + k0 + kk]); }
#pragma unroll
        for (int i = 0; i < 4; ++i) { const int idx = tid + i * 256, kk = idx >> 6, c = idx & 63; Bs[kk][c] = (n0 + c < N) ? W[(size_t)(k0 + kk) * ldw + n0 + c] : 0.f; }
        __syncthreads();
#pragma unroll
        for (int kk = 0; kk < 16; ++kk) {
            float a[4], b[4];
#pragma unroll
            for (int i = 0; i < 4; ++i) a[i] = As[kk][ty * 4 + i];
#pragma unroll
            for (int j = 0; j < 4; ++j) b[j] = Bs[kk][tx * 4 + j];
#pragma unroll
            for (int i = 0; i < 4; ++i)
#pragma unroll
                for (int j = 0; j < 4; ++j) acc[i][j] += a[i] * b[j];
        }
        __syncthreads();
    }
#pragma unroll
    for (int i = 0; i < 4; ++i)
#pragma unroll
        for (int j = 0; j < 4; ++j) { const int r = m0 + ty * 4 + i, c = n0 + tx * 4 + j; if (c < N) epi(r, c, acc[i][j]); }
}

__global__ void __launch_bounds__(1024) k_hgrn_naive(const bf16* __restrict__ proj, const float* __restrict__ lb_logits, const float* __restrict__ out_gain, bf16* __restrict__ mixed) {
    const int b = blockIdx.x >> 2, h = blockIdx.x & 3, tid = threadIdx.x, v = tid & 127, kg = tid >> 7;
    __shared__ float qsh[128], ksh[128], fsh[128], vsh[128], part[8][128], red[2], lbs[128];
    if (tid < 128) { const float l0 = lb_logits[h * 128 + tid], l1 = lb_logits[512 + h * 128 + tid]; const float m = fmaxf(l0, l1); const float e0 = expf(l0 - m), e1 = expf(l1 - m); lbs[tid] = e0 / (e0 + e1); }
    float S[16];
#pragma unroll
    for (int i = 0; i < 16; ++i) S[i] = 0.f;
    __syncthreads();
    for (int t = 0; t < T; ++t) {
        const size_t row = (size_t)(b * T + t) * PS;
        if (tid < 128) {
            const float fl = bf2f(proj[row + C_HF + h * 128 + tid]); const float lb = lbs[tid];
            const float fg = lb + (1.0f - lb) * sigmoidf_(fl); fsh[tid] = fg; ksh[tid] = 1.0f - fg;
            qsh[tid] = siluf_(bf2f(proj[row + C_HQ + h * 128 + tid])) * 0.08838834764831845f;
        } else if (tid < 256) vsh[tid - 128] = bf2f(proj[row + C_HI + h * 128 + tid - 128]);
        __syncthreads();
        const float vv = vsh[v]; float p = 0.f;
#pragma unroll
        for (int i = 0; i < 16; ++i) { const int k = kg * 16 + i; S[i] = fsh[k] * S[i] + ksh[k] * vv; p += qsh[k] * S[i]; }
        part[kg][v] = p;
        __syncthreads();
        float o = 0.f;
        if (tid < 128) {
#pragma unroll
            for (int j = 0; j < 8; ++j) o += part[j][tid];
            const float ss = wave_sum(o * o); if ((tid & 63) == 0) red[tid >> 6] = ss;
        }
        __syncthreads();
        if (tid < 128) {
            const float tot = red[0] + red[1];
            const float y = o * rsqrtf(tot * (1.0f / 128.0f) + EPS) * out_gain[h * 128 + tid];
            const float gl = bf2f(proj[row + C_HG + h * 128 + tid]);
            mixed[(size_t)(b * T + t) * D + h * 128 + tid] = f2bf(y * siluf_(gl));
        }
    }
}

__global__ void __launch_bounds__(64) k_cmp_naive(const bf16* __restrict__ proj, const float* __restrict__ pe, const float* __restrict__ w1, const float* __restrict__ w2,
                                                  const float* __restrict__ k_gain, float* __restrict__ kc, float* __restrict__ vc) {
    int it = blockIdx.x; const int n = it % NCMP; it /= NCMP; const int g = it & 1; it >>= 1; const int b = it & 1; const int which = it >> 1;
    const int c = threadIdx.x;
    __shared__ float blk[2048]; __shared__ float hid[64];
    const int col0 = (which == 0 ? C_KC : C_VC) + g * 64;
    for (int i = c; i < 2048; i += 64) { const int j = i >> 6, d = i & 63; blk[i] = bf2f(proj[(size_t)(b * T + 16 * n + j) * PS + col0 + d]) + pe[which * 2048 + i]; }
    __syncthreads();
    float acc = 0.f;
    for (int i = 0; i < 2048; ++i) acc += blk[i] * w1[(size_t)which * 2048 * 64 + (size_t)i * 64 + c];
    hid[c] = gelu_tanh(acc);
    __syncthreads();
    float o = 0.f;
    for (int i = 0; i < 64; ++i) o += hid[i] * w2[which * 4096 + i * 64 + c];
    if (which == 0) { const float ss = wave_sum(o * o); o = o * rsqrtf(ss * (1.0f / 64.0f) + EPS) * k_gain[c]; }
    (which == 0 ? kc : vc)[((size_t)(b * 2 + g) * NCMP + n) * 64 + c] = o;
}

__global__ void __launch_bounds__(256) k_nsa_naive(const bf16* __restrict__ proj, const float* __restrict__ kc, const float* __restrict__ vc, const float* __restrict__ q_gain,
                                                   const float* __restrict__ k_gain, const float* __restrict__ out_gain, bf16* __restrict__ mixed) {
    const int g = blockIdx.x & 1, tok = blockIdx.x >> 1, b = tok / T, t = tok % T;
    const int tid = threadIdx.x, r = tid >> 6, lane = tid & 63, h = g * 4 + r;
    __shared__ float qs[4][64]; __shared__ float sc[4][1024]; __shared__ float P[520]; __shared__ float imp[128]; __shared__ int sel[128]; __shared__ int blist[16]; __shared__ int nbs;
    const float slope = exp2f(-(float)(h + 1));
    const float NEG = -__builtin_huge_valf();
    {
        float qv = bf2f(proj[(size_t)tok * PS + C_NQ + h * 64 + lane]);
        const float ss = wave_sum(qv * qv);
        qs[r][lane] = qv * rsqrtf(ss * (1.0f / 64.0f) + EPS) * q_gain[lane] * 0.125f;
    }
    __syncthreads();
    const int nvalid = (t >= 31) ? ((t - 31) / 16 + 1) : 0;
    const float* kcb = kc + (size_t)(b * 2 + g) * NCMP * 64; const float* vcb = vc + (size_t)(b * 2 + g) * NCMP * 64;
    float mx = NEG;
    for (int n = lane; n < 512; n += 64) {
        float s = NEG;
        if (n < nvalid) { float d = 0.f; for (int i = 0; i < 64; ++i) d += qs[r][i] * kcb[n * 64 + i]; s = d - slope * (float)(t - (16 * n + 31)); }
        sc[r][n] = s; mx = fmaxf(mx, s);
    }
    mx = wave_max(mx); if (mx == NEG) mx = 0.f;
    float sum = 0.f;
    for (int n = lane; n < 512; n += 64) { const float e = (n < nvalid) ? expf(sc[r][n] - mx) : 0.f; sc[r][n] = e; sum += e; }
    sum = wave_sum(sum); float inv = 1.0f / fmaxf(sum, 1e-30f);
    for (int n = lane; n < 512; n += 64) sc[r][n] *= inv;
    __syncthreads();
    float oc = 0.f;
    for (int n = 0; n < nvalid; ++n) oc += sc[r][n] * vcb[n * 64 + lane];
    for (int i = tid; i < 520; i += 256) P[i] = (i < 512) ? (sc[0][i] + sc[1][i] + sc[2][i] + sc[3][i]) : 0.f;
    __syncthreads();
    if (tid < 128) imp[tid] = P[4 * tid] + 2.f * P[4 * tid + 1] + 2.f * P[4 * tid + 2] + 2.f * P[4 * tid + 3] + P[4 * tid + 4];
    __syncthreads();
    const int cur = t >> 6;
    if (tid < 128) {
        const int j = tid; const bool forced = (j == 0) || (j == cur) || (j == cur - 1); const bool cand = !forced && j <= cur;
        const int nforced = (cur == 0) ? 1 : (cur == 1) ? 2 : 3; const int need = 16 - nforced;
        int rank = 0; const float mine = imp[j];
        for (int q = 1; q <= cur - 2; ++q) { if (q == j) continue; const float o = imp[q]; if (o > mine || (o == mine && q < j)) ++rank; }
        sel[j] = (forced || (cand && rank < need)) ? 1 : 0;
    }
    __syncthreads();
    if (tid == 0) { int nb = 0; for (int j = 0; j < 128; ++j) if (sel[j] && nb < 16) blist[nb++] = j; nbs = nb; }
    __syncthreads();
    const int nb = nbs;
    float os = 0.f;
    {
        float m2 = NEG;
        for (int s = 0; s < nb; ++s) {
            const int pos = blist[s] * 64 + lane; float val = NEG;
            if (pos <= t) {
                const bf16* kr = proj + (size_t)(b * T + pos) * PS + C_KS + g * 64; float d = 0.f, sq = 0.f;
                for (int i = 0; i < 64; ++i) { const float kv = bf2f(kr[i]); d += qs[r][i] * kv * k_gain[64 + i]; sq += kv * kv; }
                val = d * rsqrtf(sq * (1.0f / 64.0f) + EPS) - slope * (float)(t - pos);
            }
            sc[r][s * 64 + lane] = val; m2 = fmaxf(m2, val);
        }
        m2 = wave_max(m2); if (m2 == NEG) m2 = 0.f;
        float su = 0.f;
        for (int s = 0; s < nb; ++s) { const float v0 = sc[r][s * 64 + lane]; const float e = (v0 == NEG) ? 0.f : expf(v0 - m2); sc[r][s * 64 + lane] = e; su += e; }
        su = wave_sum(su); const float iv = 1.0f / fmaxf(su, 1e-30f);
        __syncthreads();
        for (int s = 0; s < nb; ++s) for (int i = 0; i < 64; ++i) {
            const float p = sc[r][s * 64 + i]; if (p != 0.f) os += p * bf2f(proj[(size_t)(b * T + blist[s] * 64 + i) * PS + C_VS + g * 64 + lane]); }
        os *= iv;
    }
    __syncthreads();
    float ow = 0.f;
    {
        float m2 = NEG;
        for (int i = lane; i < 512; i += 64) {
            const int pos = t - i; float val = NEG;
            if (pos >= 0) {
                const bf16* kr = proj + (size_t)(b * T + pos) * PS + C_KW + g * 64; float d = 0.f, sq = 0.f;
                for (int c = 0; c < 64; ++c) { const float kv = bf2f(kr[c]); d += qs[r][c] * kv * k_gain[128 + c]; sq += kv * kv; }
                val = d * rsqrtf(sq * (1.0f / 64.0f) + EPS) - slope * (float)i;
            }
            sc[r][i] = val; m2 = fmaxf(m2, val);
        }
        m2 = wave_max(m2);
        float su = 0.f;
        for (int i = lane; i < 512; i += 64) { const float v0 = sc[r][i]; const float e = (v0 == NEG) ? 0.f : expf(v0 - m2); sc[r][i] = e; su += e; }
        su = wave_sum(su); const float iv = 1.0f / fmaxf(su, 1e-30f);
        __syncthreads();
        for (int i = 0; i < 512; ++i) { const float p = sc[r][i]; if (p != 0.f) ow += p * bf2f(proj[(size_t)(b * T + t - i) * PS + C_VW + g * 64 + lane]); }
        ow *= iv;
    }
    const bf16* gl = proj + (size_t)tok * PS + C_GT + h * 3;
    const float o = sigmoidf_(bf2f(gl[0])) * oc + sigmoidf_(bf2f(gl[1])) * os + sigmoidf_(bf2f(gl[2])) * ow;
    const float ss = wave_sum(o * o);
    mixed[(size_t)tok * D + 512 + h * 64 + lane] = f2bf(o * rsqrtf(ss * (1.0f / 64.0f) + EPS) * out_gain[h * 64 + lane]);
}

__global__ void __launch_bounds__(128) k_peer_topk_naive(const bf16* __restrict__ pq, const float* __restrict__ keys, int* __restrict__ ids, float* __restrict__ wts) {
    const int tok = blockIdx.x >> 3, h = blockIdx.x & 7, k = threadIdx.x;
    __shared__ float q[256]; __shared__ float s[2][128]; __shared__ float ts[2][16]; __shared__ int ti[2][16]; __shared__ float cand[256]; __shared__ float bs[16]; __shared__ int bc[16];
    q[k] = bf2f(pq[(size_t)tok * 2048 + h * 256 + k]); q[k + 128] = bf2f(pq[(size_t)tok * 2048 + h * 256 + 128 + k]);
    __syncthreads();
#pragma unroll
    for (int c = 0; c < 2; ++c) { const float* kr = keys + ((size_t)(h * 2 + c) * 128 + k) * 128; float d = 0.f; for (int i = 0; i < 128; ++i) d += q[c * 128 + i] * kr[i]; s[c][k] = d; }
    __syncthreads();
#pragma unroll
    for (int c = 0; c < 2; ++c) { const float mine = s[c][k]; int rank = 0; for (int j = 0; j < 128; ++j) { const float o = s[c][j]; if (o > mine || (o == mine && j < k)) ++rank; } if (rank < 16) { ts[c][rank] = mine; ti[c][rank] = k; } }
    __syncthreads();
    cand[k] = ts[0][k >> 4] + ts[1][k & 15]; cand[k + 128] = ts[0][(k + 128) >> 4] + ts[1][(k + 128) & 15];
    __syncthreads();
#pragma unroll
    for (int e = 0; e < 2; ++e) { const int me = k + e * 128; const float mine = cand[me]; int rank = 0; for (int j = 0; j < 256; ++j) { const float o = cand[j]; if (o > mine || (o == mine && j < me)) ++rank; } if (rank < 16) { bs[rank] = mine; bc[rank] = me; } }
    __syncthreads();
    if (k < 16) {
        float mx = bs[0]; float sum = 0.f; for (int j = 0; j < 16; ++j) sum += expf(bs[j] - mx);
        const int c = bc[k]; ids[(size_t)tok * 128 + h * 16 + k] = ti[0][c >> 4] * 128 + ti[1][c & 15];
        wts[(size_t)tok * 128 + h * 16 + k] = expf(bs[k] - mx) / sum;
    }
}

__global__ void __launch_bounds__(256) k_peer_gather_naive(const bf16* __restrict__ hn, const int* __restrict__ ids, const float* __restrict__ wts, const float* __restrict__ U, const float* __restrict__ V,
                                                           const float* __restrict__ gnorm, float* __restrict__ hio, bf16* __restrict__ hg) {
    const int tok = blockIdx.x, tid = threadIdx.x, w = tid >> 6, lane = tid & 63;
    __shared__ float xs[1024]; __shared__ float coef[128]; __shared__ int eid[128]; __shared__ float red[4];
    for (int i = tid; i < 1024; i += 256) xs[i] = bf2f(hn[(size_t)tok * D + i]);
    if (tid < 128) eid[tid] = ids[(size_t)tok * 128 + tid];
    __syncthreads();
    for (int e = w * 32; e < w * 32 + 32; ++e) {
        const float* ur = U + (size_t)eid[e] * D; float d = 0.f;
        for (int i = lane; i < 1024; i += 64) d += ur[i] * xs[i];
        d = wave_sum(d);
        if (lane == 0) coef[e] = wts[(size_t)tok * 128 + e] * gelu_tanh(d);
    }
    __syncthreads();
    float o[4] = {0.f, 0.f, 0.f, 0.f};
    for (int e = 0; e < 128; ++e) { const float* vr = V + (size_t)eid[e] * D; const float c = coef[e];
#pragma unroll
        for (int j = 0; j < 4; ++j) o[j] += c * vr[tid + 256 * j]; }
    float ss = 0.f;
#pragma unroll
    for (int j = 0; j < 4; ++j) { o[j] += hio[(size_t)tok * D + tid + 256 * j]; hio[(size_t)tok * D + tid + 256 * j] = o[j]; ss += o[j] * o[j]; }
    ss = wave_sum(ss); if (lane == 0) red[w] = ss;
    __syncthreads();
    const float r = rsqrtf((red[0] + red[1] + red[2] + red[3]) * (1.0f / D) + EPS);
#pragma unroll
    for (int j = 0; j < 4; ++j) hg[(size_t)tok * D + tid + 256 * j] = f2bf(o[j] * r * gnorm[tid + 256 * j]);
}


typedef short bf16x8 __attribute__((ext_vector_type(8)));
typedef float f32x4 __attribute__((ext_vector_type(4)));
typedef float f32x16 __attribute__((ext_vector_type(16)));
typedef unsigned u32x4 __attribute__((ext_vector_type(4)));
typedef unsigned u32x2 __attribute__((ext_vector_type(2)));
constexpr int NTHR = 512;
constexpr int LDS_BYTES = 131072;
struct Params { const float* in[21]; float* out; unsigned char* ws; };

__device__ __forceinline__ unsigned pk2(float lo, float hi) { return (unsigned)f2bf(lo) | ((unsigned)f2bf(hi) << 16); }

__device__ __forceinline__ void transpose_tile(const float* __restrict__ W, int K, int N, bf16* __restrict__ Wt, int kt, int nt, float* tile) {
    const int tid = threadIdx.x, k0 = kt * 64, n0 = nt * 64;
#pragma unroll
    for (int i = 0; i < 8; ++i) { const int idx = tid + i * NTHR, kk = idx >> 6, nn = idx & 63; tile[kk * 65 + nn] = (n0 + nn < N) ? W[(size_t)(k0 + kk) * N + n0 + nn] : 0.f; }
    __syncthreads();
    { const int nn = tid >> 3, ch = tid & 7; const float* s = tile + (ch * 8) * 65 + nn;
      u32x4 o; o.x = pk2(s[0], s[65]); o.y = pk2(s[130], s[195]); o.z = pk2(s[260], s[325]); o.w = pk2(s[390], s[455]);
      *(u32x4*)(Wt + (size_t)(n0 + nn) * K + k0 + ch * 8) = o; }
    __syncthreads();
}
__device__ __forceinline__ void cvt_range(const float* __restrict__ src, bf16* __restrict__ dst, size_t n8, size_t gtid, size_t gthreads) {
    for (size_t i = gtid; i < n8; i += gthreads) {
        const f32x4 a = ((const f32x4*)src)[2 * i], b = ((const f32x4*)src)[2 * i + 1];
        u32x4 o; o.x = pk2(a.x, a.y); o.y = pk2(a.z, a.w); o.z = pk2(b.x, b.y); o.w = pk2(b.z, b.w);
        ((u32x4*)dst)[i] = o;
    }
}
__device__ __forceinline__ void rms_row_bf16(const float* __restrict__ xr, const float* __restrict__ g, bf16* __restrict__ orow, int lane) {
    f32x4 v[4]; float s = 0.f;
#pragma unroll
    for (int j = 0; j < 4; ++j) { v[j] = ((const f32x4*)xr)[lane + 64 * j]; s += v[j].x * v[j].x + v[j].y * v[j].y + v[j].z * v[j].z + v[j].w * v[j].w; }
    s = wave_sum(s);
    const float r = rsqrtf(s * (1.0f / D) + EPS);
#pragma unroll
    for (int j = 0; j < 4; ++j) { const f32x4 gg = ((const f32x4*)g)[lane + 64 * j]; u32x2 o; o.x = pk2(v[j].x * r * gg.x, v[j].y * r * gg.y); o.y = pk2(v[j].z * r * gg.z, v[j].w * r * gg.w); ((u32x2*)orow)[lane + 64 * j] = o; }
}

__device__ __forceinline__ void phase0(const Params& p, unsigned char* lds) {
    float* tile = (float*)lds;
    const int nblk = gridDim.x, blk = blockIdx.x;
    unsigned char* ws = p.ws;
    constexpr int I_WIN = 16 * 54, I_WOUT = 16 * 16, I_WQ = 16 * 32, I_WG = 16 * 16, I_WP = 4 * 16, I_W1 = 2 * 32;
    constexpr int NIT = I_WIN + I_WOUT + I_WQ + I_WG + I_WP + I_W1;
    for (int it = blk; it < NIT; it += nblk) {
        int r = it;
        if (r < I_WIN) { transpose_tile(p.in[3], 1024, DIN, (bf16*)(ws + WS_WINT), r / 54, r % 54, tile); continue; } r -= I_WIN;
        if (r < I_WOUT) { transpose_tile(p.in[12], 1024, 1024, (bf16*)(ws + WS_WOUTT), r / 16, r % 16, tile); continue; } r -= I_WOUT;
        if (r < I_WQ) { transpose_tile(p.in[14], 1024, 2048, (bf16*)(ws + WS_WQT), r / 32, r % 32, tile); continue; } r -= I_WQ;
        if (r < I_WG) { transpose_tile(p.in[20], 1024, 1024, (bf16*)(ws + WS_WGT), r / 16, r % 16, tile); continue; } r -= I_WG;
        if (r < I_WP) { transpose_tile(p.in[18], 256, 1024, (bf16*)(ws + WS_WPT), r / 16, r % 16, tile); continue; } r -= I_WP;
        { const int which = r / 32, kt = r % 32; transpose_tile(p.in[9] + (size_t)which * 2048 * 64, 2048, 64, (bf16*)(ws + WS_W1T) + (size_t)which * 64 * 2048, kt, 0, tile); }
    }
    const size_t gtid = (size_t)blk * NTHR + threadIdx.x, gthreads = (size_t)nblk * NTHR;
    cvt_range(p.in[16], (bf16*)(ws + WS_UB), (size_t)16384 * 1024 / 8, gtid, gthreads);
    cvt_range(p.in[17], (bf16*)(ws + WS_VB), (size_t)16384 * 1024 / 8, gtid, gthreads);
    cvt_range(p.in[15], (bf16*)(ws + WS_KEYB), (size_t)8 * 2 * 128 * 128 / 8, gtid, gthreads);
    cvt_range(p.in[1], (bf16*)(ws + WS_PB), (size_t)NTOK * 256 / 8, gtid, gthreads);
    const int gw = (int)(gtid >> 6), ngw = (int)(gthreads >> 6), lane = threadIdx.x & 63;
    for (int m = gw; m < NTOK; m += ngw) rms_row_bf16(p.in[0] + (size_t)m * D, p.in[2], (bf16*)(ws + WS_ACT) + (size_t)m * D, lane);
}

__device__ __forceinline__ int swz(int ob) { return ob ^ (((ob >> 9) & 1) << 5); }
constexpr int G_STAGE = 49152;
__device__ __forceinline__ void gemm_mainloop(f32x4 (&acc)[4][4], const bf16* __restrict__ A, int lda, const bf16* __restrict__ Bt, int ldb, int K, int m0, int n0, unsigned char* lds) {
    const int tid = threadIdx.x, lane = tid & 63, wid = tid >> 6, wm = wid >> 1, wn = wid & 1, fr = lane & 15, fq = lane >> 4;
    const int lrow = tid >> 3, lc = tid & 7;
    const bf16* ag = A + (size_t)(m0 + lrow) * lda + lc * 8;
    const bf16* bg = Bt + (size_t)(n0 + lrow) * ldb + lc * 8;
    const int woff = ((lrow >> 4) * 2 + (lc >> 2)) * 1024 + swz((lrow & 15) * 64 + (lc & 3) * 16);
    const int roff = swz(fr * 64 + fq * 16);
    const int nk = K >> 6;
    u32x4 ra[4], rb[2];
#pragma unroll
    for (int i = 0; i < 4; ++i) ra[i] = *(const u32x4*)(ag + (size_t)i * 64 * lda);
#pragma unroll
    for (int i = 0; i < 2; ++i) rb[i] = *(const u32x4*)(bg + (size_t)i * 64 * ldb);
#pragma unroll
    for (int i = 0; i < 4; ++i) *(u32x4*)(lds + woff + i * 8192) = ra[i];
#pragma unroll
    for (int i = 0; i < 2; ++i) *(u32x4*)(lds + 32768 + woff + i * 8192) = rb[i];
    __syncthreads();
    for (int kt = 0; kt < nk; ++kt) {
        unsigned char* cur = lds + (kt & 1) * G_STAGE; unsigned char* nxt = lds + ((kt + 1) & 1) * G_STAGE;
        const bool more = kt + 1 < nk;
        if (more) {
#pragma unroll
            for (int i = 0; i < 4; ++i) ra[i] = *(const u32x4*)(ag + (size_t)i * 64 * lda + (kt + 1) * 64);
#pragma unroll
            for (int i = 0; i < 2; ++i) rb[i] = *(const u32x4*)(bg + (size_t)i * 64 * ldb + (kt + 1) * 64);
        }
#pragma unroll
        for (int s = 0; s < 2; ++s) {
            bf16x8 af[4], bfr[4];
#pragma unroll
            for (int i = 0; i < 4; ++i) af[i] = *(const bf16x8*)(cur + ((wm * 4 + i) * 2 + s) * 1024 + roff);
#pragma unroll
            for (int i = 0; i < 4; ++i) bfr[i] = *(const bf16x8*)(cur + 32768 + ((wn * 4 + i) * 2 + s) * 1024 + roff);
#pragma unroll
            for (int mi = 0; mi < 4; ++mi)
#pragma unroll
                for (int ni = 0; ni < 4; ++ni) acc[mi][ni] = __builtin_amdgcn_mfma_f32_16x16x32_bf16(bfr[ni], af[mi], acc[mi][ni], 0, 0, 0);
        }
        if (more) {
#pragma unroll
            for (int i = 0; i < 4; ++i) *(u32x4*)(nxt + woff + i * 8192) = ra[i];
#pragma unroll
            for (int i = 0; i < 2; ++i) *(u32x4*)(nxt + 32768 + woff + i * 8192) = rb[i];
        }
        __syncthreads();
    }
}
__device__ __forceinline__ void acc_zero(f32x4 (&acc)[4][4]) {
#pragma unroll
    for (int i = 0; i < 4; ++i)
#pragma unroll
        for (int j = 0; j < 4; ++j) acc[i][j] = (f32x4){0.f, 0.f, 0.f, 0.f};
}
__device__ __forceinline__ void phase1(const Params& p, unsigned char* lds) {
    const bf16* A = (const bf16*)(p.ws + WS_ACT); const bf16* Bt = (const bf16*)(p.ws + WS_WINT); bf16* C = (bf16*)(p.ws + WS_PROJ);
    const int lane = threadIdx.x & 63, wid = threadIdx.x >> 6, wm = wid >> 1, wn = wid & 1, fr = lane & 15, fq = lane >> 4;
    constexpr int NT = 27, NTILES = 64 * NT;
    for (int t = blockIdx.x; t < NTILES; t += gridDim.x) {
        const int m0 = (t / NT) * 256, n0 = (t % NT) * 128;
        f32x4 acc[4][4]; acc_zero(acc);
        gemm_mainloop(acc, A, D, Bt, D, D, m0, n0, lds);
#pragma unroll
        for (int mi = 0; mi < 4; ++mi)
#pragma unroll
            for (int ni = 0; ni < 4; ++ni) {
                const int row = m0 + wm * 64 + mi * 16 + fr, col = n0 + wn * 64 + ni * 16 + fq * 4;
                if (col < DIN) { u32x2 o; o.x = pk2(acc[mi][ni][0], acc[mi][ni][1]); o.y = pk2(acc[mi][ni][2], acc[mi][ni][3]); *(u32x2*)(C + (size_t)row * PS + col) = o; }
            }
    }
}


__device__ __forceinline__ void phase5(const Params& p, unsigned char* lds) {
    const bf16* A = (const bf16*)(p.ws + WS_ACT); const bf16* Bt = (const bf16*)(p.ws + WS_WOUTT); const float* X = p.in[0]; float* O = p.out;
    const int lane = threadIdx.x & 63, wid = threadIdx.x >> 6, wm = wid >> 1, wn = wid & 1, fr = lane & 15, fq = lane >> 4;
    constexpr int NT = 8, NTILES = 64 * NT;
    for (int t = blockIdx.x; t < NTILES; t += gridDim.x) {
        const int m0 = (t / NT) * 256, n0 = (t % NT) * 128;
        f32x4 acc[4][4]; acc_zero(acc);
        gemm_mainloop(acc, A, D, Bt, D, D, m0, n0, lds);
#pragma unroll
        for (int mi = 0; mi < 4; ++mi)
#pragma unroll
            for (int ni = 0; ni < 4; ++ni) {
                const size_t idx = (size_t)(m0 + wm * 64 + mi * 16 + fr) * D + n0 + wn * 64 + ni * 16 + fq * 4;
                *(f32x4*)(O + idx) = *(const f32x4*)(X + idx) + acc[mi][ni];
            }
    }
}
__device__ __forceinline__ void phase6(const Params& p, unsigned char* lds) {
    const int gw = (blockIdx.x * NTHR + threadIdx.x) >> 6, ngw = (gridDim.x * NTHR) >> 6, lane = threadIdx.x & 63;
    for (int m = gw; m < NTOK; m += ngw) rms_row_bf16(p.out + (size_t)m * D, p.in[13], (bf16*)(p.ws + WS_ACT) + (size_t)m * D, lane);
}
__device__ __forceinline__ void phase7(const Params& p, unsigned char* lds) {
    const bf16* A = (const bf16*)(p.ws + WS_ACT); const bf16* Bt = (const bf16*)(p.ws + WS_WQT); bf16* C = (bf16*)(p.ws + WS_PROJ);
    const int lane = threadIdx.x & 63, wid = threadIdx.x >> 6, wm = wid >> 1, wn = wid & 1, fr = lane & 15, fq = lane >> 4;
    constexpr int NT = 16, NTILES = 64 * NT;
    for (int t = blockIdx.x; t < NTILES; t += gridDim.x) {
        const int m0 = (t / NT) * 256, n0 = (t % NT) * 128;
        f32x4 acc[4][4]; acc_zero(acc);
        gemm_mainloop(acc, A, D, Bt, D, D, m0, n0, lds);
#pragma unroll
        for (int mi = 0; mi < 4; ++mi)
#pragma unroll
            for (int ni = 0; ni < 4; ++ni) {
                const int row = m0 + wm * 64 + mi * 16 + fr, col = n0 + wn * 64 + ni * 16 + fq * 4;
                u32x2 o; o.x = pk2(acc[mi][ni][0], acc[mi][ni][1]); o.y = pk2(acc[mi][ni][2], acc[mi][ni][3]); *(u32x2*)(C + (size_t)row * 2048 + col) = o;
            }
    }
}
__device__ __forceinline__ void phase10(const Params& p, unsigned char* lds) {
    const bf16* A1 = (const bf16*)(p.ws + WS_PROJ + 64 * MiB); const bf16* B1 = (const bf16*)(p.ws + WS_WGT);
    const bf16* A2 = (const bf16*)(p.ws + WS_PB); const bf16* B2 = (const bf16*)(p.ws + WS_WPT); float* O = p.out;
    const int lane = threadIdx.x & 63, wid = threadIdx.x >> 6, wm = wid >> 1, wn = wid & 1, fr = lane & 15, fq = lane >> 4;
    constexpr int NT = 8, NTILES = 64 * NT;
    for (int t = blockIdx.x; t < NTILES; t += gridDim.x) {
        const int m0 = (t / NT) * 256, n0 = (t % NT) * 128;
        u32x2 gpk[4][4];
        {
            f32x4 accg[4][4]; acc_zero(accg);
            gemm_mainloop(accg, A1, D, B1, D, D, m0, n0, lds);
#pragma unroll
            for (int mi = 0; mi < 4; ++mi)
#pragma unroll
                for (int ni = 0; ni < 4; ++ni) { gpk[mi][ni].x = pk2(sigmoidf_(accg[mi][ni][0]), sigmoidf_(accg[mi][ni][1])); gpk[mi][ni].y = pk2(sigmoidf_(accg[mi][ni][2]), sigmoidf_(accg[mi][ni][3])); }
        }
        f32x4 accp[4][4]; acc_zero(accp);
        gemm_mainloop(accp, A2, 256, B2, 256, 256, m0, n0, lds);
#pragma unroll
        for (int mi = 0; mi < 4; ++mi)
#pragma unroll
            for (int ni = 0; ni < 4; ++ni) {
                const size_t idx = (size_t)(m0 + wm * 64 + mi * 16 + fr) * D + n0 + wn * 64 + ni * 16 + fq * 4;
                f32x4 g; g.x = __uint_as_float(gpk[mi][ni].x << 16); g.y = __uint_as_float(gpk[mi][ni].x & 0xffff0000u); g.z = __uint_as_float(gpk[mi][ni].y << 16); g.w = __uint_as_float(gpk[mi][ni].y & 0xffff0000u);
                *(f32x4*)(O + idx) = *(const f32x4*)(O + idx) + accp[mi][ni] * g;
            }
    }
}

typedef __bf16 bf16x2v __attribute__((ext_vector_type(2)));
template <int CTRL> __device__ __forceinline__ float dpp_f(float v) { return __int_as_float(__builtin_amdgcn_update_dpp(0, __float_as_int(v), CTRL, 0xF, 0xF, false)); }
__device__ __forceinline__ float grp16_max(float v) { v = fmaxf(v, dpp_f<0xB1>(v)); v = fmaxf(v, dpp_f<0x4E>(v)); v = fmaxf(v, dpp_f<0x141>(v)); v = fmaxf(v, dpp_f<0x140>(v)); return v; }
__device__ __forceinline__ float grp16_sum(float v) { v += dpp_f<0xB1>(v); v += dpp_f<0x4E>(v); v += dpp_f<0x141>(v); v += dpp_f<0x140>(v); return v; }
#define CE_DESC(a, b) { const float _hi = fmaxf(a, b), _lo = fminf(a, b); a = _hi; b = _lo; }
__device__ __forceinline__ float grp16_top16(float (&v)[8], int lig) {
    CE_DESC(v[0], v[1]) CE_DESC(v[2], v[3]) CE_DESC(v[4], v[5]) CE_DESC(v[6], v[7])
    CE_DESC(v[0], v[2]) CE_DESC(v[1], v[3]) CE_DESC(v[4], v[6]) CE_DESC(v[5], v[7])
    CE_DESC(v[1], v[2]) CE_DESC(v[5], v[6])
    CE_DESC(v[0], v[4]) CE_DESC(v[1], v[5]) CE_DESC(v[2], v[6]) CE_DESC(v[3], v[7])
    CE_DESC(v[2], v[4]) CE_DESC(v[3], v[5])
    CE_DESC(v[1], v[2]) CE_DESC(v[3], v[4]) CE_DESC(v[5], v[6])
    float top = 0.f;
#pragma unroll
    for (int r = 0; r < 16; ++r) {
        const float m = grp16_max(v[0]);
        if (lig == r) top = m;
        const bool own = (v[0] == m);
#pragma unroll
        for (int j = 0; j < 7; ++j) v[j] = own ? v[j + 1] : v[j];
        v[7] = own ? -3.0e38f : v[7];
    }
    return top;
}
__device__ __forceinline__ void phase8(const Params& p, unsigned char* lds) {
    const bf16* PQ = (const bf16*)(p.ws + WS_PROJ); const bf16* KB = (const bf16*)(p.ws + WS_KEYB);
    int* ids = (int*)(p.ws + WS_IDS); float* wts = (float*)(p.ws + WS_WTS);
    float* S = (float*)lds;
    const int tid = threadIdx.x, lane = tid & 63, wid = tid >> 6, lig = tid & 15, gbase = lane & 48;
    for (int item = blockIdx.x; item < 2048; item += gridDim.x) {
        const int tok0 = (item >> 3) * 64, h = item & 7;
        {
            const int c = wid >> 2, key0 = (wid & 3) * 32, r = lane & 31, hh = lane >> 5;
            f32x16 acc0, acc1;
#pragma unroll
            for (int i = 0; i < 16; ++i) { acc0[i] = 0.f; acc1[i] = 0.f; }
            const bf16* bq = KB + ((size_t)(h * 2 + c) * 128 + key0 + r) * 128 + hh * 8;
            const bf16* aq0 = PQ + (size_t)(tok0 + r) * 2048 + h * 256 + c * 128 + hh * 8;
            const bf16* aq1 = aq0 + (size_t)32 * 2048;
#pragma unroll
            for (int s = 0; s < 8; ++s) {
                const bf16x8 b = *(const bf16x8*)(bq + s * 16), a0 = *(const bf16x8*)(aq0 + s * 16), a1 = *(const bf16x8*)(aq1 + s * 16);
                acc0 = __builtin_amdgcn_mfma_f32_32x32x16_bf16(a0, b, acc0, 0, 0, 0);
                acc1 = __builtin_amdgcn_mfma_f32_32x32x16_bf16(a1, b, acc1, 0, 0, 0);
            }
#pragma unroll
            for (int i = 0; i < 16; ++i) { const int tl = (i & 3) + 8 * (i >> 2) + 4 * hh; S[(c * 64 + tl) * 132 + key0 + r] = acc0[i]; S[(c * 64 + 32 + tl) * 132 + key0 + r] = acc1[i]; }
        }
        __syncthreads();
#pragma unroll 1
        for (int rd = 0; rd < 2; ++rd) {
            const int tl = (tid >> 4) + 32 * rd;
            float ts[2];
#pragma unroll
            for (int c = 0; c < 2; ++c) {
                float v[8];
                const f32x4 lo = *(const f32x4*)(S + (c * 64 + tl) * 132 + lig * 8), hi = *(const f32x4*)(S + (c * 64 + tl) * 132 + lig * 8 + 4);
                v[0] = lo.x; v[1] = lo.y; v[2] = lo.z; v[3] = lo.w; v[4] = hi.x; v[5] = hi.y; v[6] = hi.z; v[7] = hi.w;
#pragma unroll
                for (int j = 0; j < 8; ++j) v[j] = __uint_as_float((__float_as_uint(v[j]) & ~127u) | (unsigned)(lig * 8 + j));
                ts[c] = grp16_top16(v, lig);
            }
            const float t0 = ts[0], t1 = ts[1];
            int bp = 0; float my_s = 0.f; int my_eid = 0;
#pragma unroll 1
            for (int r = 0; r < 16; ++r) {
                const float other = __shfl(t1, gbase + (bp < 15 ? bp : 15));
                const float sum = t0 + other;
                const float head = (bp >= 16) ? -3.0e38f : __uint_as_float((__float_as_uint(sum) & ~15u) | (unsigned)lig);
                const int cur_eid = (int)(((__float_as_uint(t0) & 127u) << 7) | (__float_as_uint(other) & 127u));
                const float m = grp16_max(head);
                const int owner = (int)(__float_as_uint(m) & 15u);
                const int ew = __shfl(cur_eid, gbase + owner);
                if (lig == r) { my_s = m; my_eid = ew; }
                if (lig == owner) ++bp;
            }
            const float mx = grp16_max(my_s);
            const float e = __expf(my_s - mx);
            const float sm = grp16_sum(e);
            const size_t o = (size_t)(tok0 + tl) * 128 + h * 16 + lig;
            ids[o] = my_eid; wts[o] = e / sm;
        }
        __syncthreads();
    }
}

__device__ __forceinline__ void hgrn_pre_item(const Params& p, unsigned char* lds, int ci) {
    const int tid = threadIdx.x, lane = tid & 63, wid = tid >> 6, k = tid & 127, tq = tid >> 7;
    const int n = ci & 127, h = (ci >> 7) & 3, b = ci >> 9, tok0 = b * T + n * 64;
    bf16* proj = (bf16*)(p.ws + WS_PROJ);
    float* OB = p.out; bf16* KIT = (bf16*)((unsigned char*)p.out + OUT_KIT) + (size_t)ci * 8192; bf16* VTg = (bf16*)((unsigned char*)p.out + OUT_VT) + (size_t)ci * 8192;
    float* DEC = (float*)(p.ws + WS_DEC) + (size_t)ci * 128;
    bf16* QT = (bf16*)lds; bf16* KT = (bf16*)(lds + 17408); bf16* VTl = (bf16*)(lds + 34816); bf16* AM = (bf16*)(lds + 53248);
    float* part = (float*)(lds + 62464); float* gref = (float*)(lds + 64512);
    float lb; { const float l0 = p.in[4][h * 128 + k], l1 = p.in[4][512 + h * 128 + k]; const float m = fmaxf(l0, l1); const float e0 = __expf(l0 - m), e1 = __expf(l1 - m); lb = e0 / (e0 + e1); }
    float G[16], key[16], qv[16], vv[16];
    {
        float c = 0.f;
#pragma unroll
        for (int i = 0; i < 16; ++i) {
            const size_t row = (size_t)(tok0 + tq * 16 + i) * PS;
            const float fg = lb + (1.0f - lb) * sigmoidf_(bf2f(proj[row + C_HF + h * 128 + k]));
            key[i] = 1.0f - fg; c += __logf(fg); G[i] = c;
            qv[i] = siluf_(bf2f(proj[row + C_HQ + h * 128 + k])) * 0.08838834764831845f;
            vv[i] = bf2f(proj[row + C_HI + h * 128 + k]);
        }
        part[tq * 128 + k] = c;
    }
    __syncthreads();
    {
        float off = 0.f;
#pragma unroll
        for (int j = 0; j < 3; ++j) off += (j < tq) ? part[j * 128 + k] : 0.f;
#pragma unroll
        for (int i = 0; i < 16; ++i) G[i] += off;
        if (tq == 1) gref[k] = G[15];
        if (tq == 3) gref[128 + k] = G[15];
    }
    __syncthreads();
    {
        const float gr = gref[k], gl = gref[128 + k];
        const int kpos = (k & ~31) | (((k >> 2) & 3) << 3) | (((k >> 4) & 1) << 2) | (k & 3);
        unsigned kp[8], vp[8];
#pragma unroll
        for (int i = 0; i < 16; i += 2) {
            kp[i >> 1] = pk2(key[i] * __expf(gl - G[i]), key[i + 1] * __expf(gl - G[i + 1]));
            vp[i >> 1] = pk2(vv[i], vv[i + 1]);
        }
#pragma unroll
        for (int i = 0; i < 16; ++i) {
            const int t = tq * 16 + i;
            QT[t * 136 + k] = f2bf(qv[i] * __expf(G[i] - gr));
            KT[t * 136 + k] = f2bf(key[i] * __expf(gr - G[i]));
            proj[(size_t)(tok0 + t) * PS + C_HQ + h * 128 + kpos] = f2bf(qv[i] * __expf(G[i]));
        }
        u32x4 a0, a1, b0, b1; a0.x = kp[0]; a0.y = kp[1]; a0.z = kp[2]; a0.w = kp[3]; a1.x = kp[4]; a1.y = kp[5]; a1.z = kp[6]; a1.w = kp[7];
        b0.x = vp[0]; b0.y = vp[1]; b0.z = vp[2]; b0.w = vp[3]; b1.x = vp[4]; b1.y = vp[5]; b1.z = vp[6]; b1.w = vp[7];
        *(u32x4*)(KIT + k * 64 + tq * 16) = a0; *(u32x4*)(KIT + k * 64 + tq * 16 + 8) = a1;
        *(u32x4*)(VTg + k * 64 + tq * 16) = b0; *(u32x4*)(VTg + k * 64 + tq * 16 + 8) = b1;
        *(u32x4*)(VTl + k * 72 + tq * 16) = b0; *(u32x4*)(VTl + k * 72 + tq * 16 + 8) = b1;
        if (tq == 3) DEC[k] = __expf(gl);
    }
    __syncthreads();
    const int fr = lane & 15, fq = lane >> 4;
    {
        const int tt = wid >> 1;
#pragma unroll
        for (int e = 0; e < 2; ++e) {
            const int st = 2 * (wid & 1) + e;
            f32x4 acc = (f32x4){0.f, 0.f, 0.f, 0.f};
            if (st <= tt) {
#pragma unroll
                for (int s = 0; s < 4; ++s) {
                    const bf16x8 a = *(const bf16x8*)(QT + (tt * 16 + fr) * 136 + s * 32 + fq * 8), bb = *(const bf16x8*)(KT + (st * 16 + fr) * 136 + s * 32 + fq * 8);
                    acc = __builtin_amdgcn_mfma_f32_16x16x32_bf16(a, bb, acc, 0, 0, 0);
                }
            }
#pragma unroll
            for (int r = 0; r < 4; ++r) { const int t = tt * 16 + fq * 4 + r, sp = st * 16 + fr; AM[t * 72 + sp] = f2bf(sp <= t ? acc[r] : 0.f); }
        }
    }
    __syncthreads();
    {
        const int tt = wid >> 1;
        const bf16x8 a0 = *(const bf16x8*)(AM + (tt * 16 + fr) * 72 + fq * 8), a1 = *(const bf16x8*)(AM + (tt * 16 + fr) * 72 + 32 + fq * 8);
#pragma unroll
        for (int e = 0; e < 4; ++e) {
            const int vt = (wid & 1) * 4 + e;
            const bf16x8 b0 = *(const bf16x8*)(VTl + (vt * 16 + fr) * 72 + fq * 8), b1 = *(const bf16x8*)(VTl + (vt * 16 + fr) * 72 + 32 + fq * 8);
            f32x4 acc = (f32x4){0.f, 0.f, 0.f, 0.f};
            acc = __builtin_amdgcn_mfma_f32_16x16x32_bf16(a0, b0, acc, 0, 0, 0);
            acc = __builtin_amdgcn_mfma_f32_16x16x32_bf16(a1, b1, acc, 0, 0, 0);
#pragma unroll
            for (int r = 0; r < 4; ++r) OB[(size_t)(tok0 + tt * 16 + fq * 4 + r) * 512 + h * 128 + vt * 16 + fr] = acc[r];
        }
    }
    __syncthreads();
}
__device__ __forceinline__ void hgrn_scan_item(const Params& p, int wi) {
    const int lane = threadIdx.x & 63, fr = lane & 15, fq = lane >> 4;
    const int vs = wi & 7, bh = wi >> 3, h = bh & 3, b = bh >> 2;
    const bf16* proj = (const bf16*)(p.ws + WS_PROJ);
    float* OB = p.out; const bf16* KIT = (const bf16*)((unsigned char*)p.out + OUT_KIT); const bf16* VTg = (const bf16*)((unsigned char*)p.out + OUT_VT);
    const float* DEC = (const float*)(p.ws + WS_DEC);
    f32x4 S[8];
#pragma unroll
    for (int i = 0; i < 8; ++i) S[i] = (f32x4){0.f, 0.f, 0.f, 0.f};
#pragma unroll 1
    for (int n = 0; n < 128; ++n) {
        const int ci = bh * 128 + n, tok0 = b * T + n * 64;
        bf16x8 qf[4][4];
#pragma unroll
        for (int tt = 0; tt < 4; ++tt)
#pragma unroll
            for (int s = 0; s < 4; ++s) qf[tt][s] = *(const bf16x8*)(proj + (size_t)(tok0 + tt * 16 + fr) * PS + C_HQ + h * 128 + s * 32 + fq * 8);
        float oin[4][4];
#pragma unroll
        for (int tt = 0; tt < 4; ++tt)
#pragma unroll
            for (int r = 0; r < 4; ++r) oin[tt][r] = OB[(size_t)(tok0 + tt * 16 + fq * 4 + r) * 512 + h * 128 + vs * 16 + fr];
        bf16x8 Sb[4];
#pragma unroll
        for (int s = 0; s < 4; ++s) {
            u32x4 w; w.x = pk2(S[2 * s][0], S[2 * s][1]); w.y = pk2(S[2 * s][2], S[2 * s][3]); w.z = pk2(S[2 * s + 1][0], S[2 * s + 1][1]); w.w = pk2(S[2 * s + 1][2], S[2 * s + 1][3]);
            Sb[s] = __builtin_bit_cast(bf16x8, w);
        }
#pragma unroll
        for (int tt = 0; tt < 4; ++tt) {
            f32x4 acc = (f32x4){0.f, 0.f, 0.f, 0.f};
#pragma unroll
            for (int s = 0; s < 4; ++s) acc = __builtin_amdgcn_mfma_f32_16x16x32_bf16(qf[tt][s], Sb[s], acc, 0, 0, 0);
#pragma unroll
            for (int r = 0; r < 4; ++r) OB[(size_t)(tok0 + tt * 16 + fq * 4 + r) * 512 + h * 128 + vs * 16 + fr] = oin[tt][r] + acc[r];
        }
        const bf16x8 v0 = *(const bf16x8*)(VTg + (size_t)ci * 8192 + (vs * 16 + fr) * 64 + fq * 8), v1 = *(const bf16x8*)(VTg + (size_t)ci * 8192 + (vs * 16 + fr) * 64 + 32 + fq * 8);
#pragma unroll
        for (int kb = 0; kb < 8; ++kb) {
            const bf16x8 k0 = *(const bf16x8*)(KIT + (size_t)ci * 8192 + (kb * 16 + fr) * 64 + fq * 8), k1 = *(const bf16x8*)(KIT + (size_t)ci * 8192 + (kb * 16 + fr) * 64 + 32 + fq * 8);
            const f32x4 dv = *(const f32x4*)(DEC + (size_t)ci * 128 + kb * 16 + fq * 4);
            f32x4 sacc = S[kb] * dv;
            sacc = __builtin_amdgcn_mfma_f32_16x16x32_bf16(k0, v0, sacc, 0, 0, 0);
            sacc = __builtin_amdgcn_mfma_f32_16x16x32_bf16(k1, v1, sacc, 0, 0, 0);
            S[kb] = sacc;
        }
    }
}
__device__ __forceinline__ void phase4(const Params& p, unsigned char* lds) {
    const bf16* proj = (const bf16*)(p.ws + WS_PROJ); const float* OB = p.out; bf16* mixed = (bf16*)(p.ws + WS_ACT); const float* gain = p.in[5];
    const int lane = threadIdx.x & 63, gw = (blockIdx.x * NTHR + threadIdx.x) >> 6, ngw = (gridDim.x * NTHR) >> 6;
    for (int tok = gw; tok < NTOK; tok += ngw) {
        const f32x4 o0 = *(const f32x4*)(OB + (size_t)tok * 512 + lane * 8), o1 = *(const f32x4*)(OB + (size_t)tok * 512 + lane * 8 + 4);
        const u32x4 gp = *(const u32x4*)(proj + (size_t)tok * PS + C_HG + lane * 8);
        const f32x4 g0 = *(const f32x4*)(gain + lane * 8), g1 = *(const f32x4*)(gain + lane * 8 + 4);
        float ss = o0.x * o0.x + o0.y * o0.y + o0.z * o0.z + o0.w * o0.w + o1.x * o1.x + o1.y * o1.y + o1.z * o1.z + o1.w * o1.w;
        ss = grp16_sum(ss);
        const float r = rsqrtf(ss * (1.0f / 128.0f) + EPS);
        const unsigned gx = gp.x, gy = gp.y, gz = gp.z, gw_ = gp.w;
        u32x4 w;
        w.x = pk2(o0.x * r * g0.x * siluf_(__uint_as_float(gx << 16)), o0.y * r * g0.y * siluf_(__uint_as_float(gx & 0xffff0000u)));
        w.y = pk2(o0.z * r * g0.z * siluf_(__uint_as_float(gy << 16)), o0.w * r * g0.w * siluf_(__uint_as_float(gy & 0xffff0000u)));
        w.z = pk2(o1.x * r * g1.x * siluf_(__uint_as_float(gz << 16)), o1.y * r * g1.y * siluf_(__uint_as_float(gz & 0xffff0000u)));
        w.w = pk2(o1.z * r * g1.z * siluf_(__uint_as_float(gw_ << 16)), o1.w * r * g1.w * siluf_(__uint_as_float(gw_ & 0xffff0000u)));
        *(u32x4*)(mixed + (size_t)tok * D + lane * 8) = w;
    }
}

#define WAVE_LDS_SYNC() asm volatile("s_waitcnt lgkmcnt(0)" ::: "memory")
__device__ __forceinline__ void nsa_prep_item(const Params& p, unsigned char* lds, int tile) {
    const int tid = threadIdx.x, lig = tid & 15;
    const int tok0 = tile * 64;
    bf16* proj = (bf16*)(p.ws + WS_PROJ);
    for (int rho = tid >> 4; rho < 768; rho += 32) {
        const int tl = rho / 12, which = rho - tl * 12;
        int col; const float* gain; float sc = 1.0f;
        if (which < 8) { col = C_NQ + which * 64; gain = p.in[6]; sc = 0.125f; }
        else if (which < 10) { col = C_KS + (which - 8) * 64; gain = p.in[7] + 64; }
        else { col = C_KW + (which - 10) * 64; gain = p.in[7] + 128; }
        bf16* rp = proj + (size_t)(tok0 + tl) * PS + col + lig * 4;
        const u32x2 raw = *(const u32x2*)rp;
        const unsigned r0 = raw.x, r1 = raw.y;
        const float a = __uint_as_float(r0 << 16), b = __uint_as_float(r0 & 0xffff0000u), c = __uint_as_float(r1 << 16), d = __uint_as_float(r1 & 0xffff0000u);
        const float ss = grp16_sum(a * a + b * b + c * c + d * d);
        const float r = rsqrtf(ss * (1.0f / 64.0f) + EPS) * sc;
        const f32x4 gg = *(const f32x4*)(gain + lig * 4);
        u32x2 o; o.x = pk2(a * r * gg.x, b * r * gg.y); o.y = pk2(c * r * gg.z, d * r * gg.w);
        *(u32x2*)rp = o;
    }
    {
        const int c = tid & 127, tq = tid >> 7, g = c >> 6, d = c & 63, b = tok0 / T, t0 = tok0 % T;
#pragma unroll
        for (int which = 0; which < 2; ++which) {
            const int col = (which == 0 ? C_VS : C_VW) + c;
            unsigned w[8];
#pragma unroll
            for (int i = 0; i < 16; i += 2) w[i >> 1] = (unsigned)proj[(size_t)(tok0 + tq * 16 + i) * PS + col] | ((unsigned)proj[(size_t)(tok0 + tq * 16 + i + 1) * PS + col] << 16);
            bf16* dst = (bf16*)(p.ws + (which == 0 ? WS_VTS : WS_VTW)) + ((size_t)(b * 2 + g) * 64 + d) * T + t0 + tq * 16;
            u32x4 a0, a1; a0.x = w[0]; a0.y = w[1]; a0.z = w[2]; a0.w = w[3]; a1.x = w[4]; a1.y = w[5]; a1.z = w[6]; a1.w = w[7];
            *(u32x4*)dst = a0; *(u32x4*)(dst + 8) = a1;
        }
    }
}
__device__ __forceinline__ void nsa_cmp_item(const Params& p, unsigned char* lds, int item) {
    const int tid = threadIdx.x, lane = tid & 63, wid = tid >> 6, fr = lane & 15, fq = lane >> 4;
    const int nt32 = item & 15, g = (item >> 4) & 1, b = (item >> 5) & 1, which = item >> 6, n0 = nt32 * 32;
    const bf16* proj = (const bf16*)(p.ws + WS_PROJ);
    const float* pe = p.in[8] + which * 2048;
    const bf16* W1T = (const bf16*)(p.ws + WS_W1T) + (size_t)which * 64 * 2048;
    const float* w2 = p.in[10] + which * 4096;
    bf16* A = (bf16*)lds; float* H = (float*)(lds + 33280);
    const int col0 = (which == 0 ? C_KC : C_VC) + g * 64;
    const int nt = wid & 1, ct = wid >> 1;
    f32x4 acc = (f32x4){0.f, 0.f, 0.f, 0.f};
#pragma unroll 1
    for (int kc = 0; kc < 4; ++kc) {
#pragma unroll
        for (int i = 0; i < 4; ++i) {
            const int idx = tid + i * NTHR, dch = idx & 7, jj = (idx >> 3) & 7, n = idx >> 6, j = kc * 8 + jj;
            u32x4 o = (u32x4){0u, 0u, 0u, 0u};
            if (n0 + n < NCMP) {
                const u32x4 raw = *(const u32x4*)(proj + (size_t)(b * T + 16 * (n0 + n) + j) * PS + col0 + dch * 8);
                const f32x4 p0 = *(const f32x4*)(pe + j * 64 + dch * 8), p1 = *(const f32x4*)(pe + j * 64 + dch * 8 + 4);
                const unsigned r0 = raw.x, r1 = raw.y, r2 = raw.z, r3 = raw.w;
                o.x = pk2(__uint_as_float(r0 << 16) + p0.x, __uint_as_float(r0 & 0xffff0000u) + p0.y);
                o.y = pk2(__uint_as_float(r1 << 16) + p0.z, __uint_as_float(r1 & 0xffff0000u) + p0.w);
                o.z = pk2(__uint_as_float(r2 << 16) + p1.x, __uint_as_float(r2 & 0xffff0000u) + p1.y);
                o.w = pk2(__uint_as_float(r3 << 16) + p1.z, __uint_as_float(r3 & 0xffff0000u) + p1.w);
            }
            *(u32x4*)(A + n * 520 + jj * 64 + dch * 8) = o;
        }
        __syncthreads();
#pragma unroll 4
        for (int s = 0; s < 16; ++s) {
            const bf16x8 a = *(const bf16x8*)(A + (nt * 16 + fr) * 520 + s * 32 + fq * 8);
            const bf16x8 bb = *(const bf16x8*)(W1T + (size_t)(ct * 16 + fr) * 2048 + kc * 512 + s * 32 + fq * 8);
            acc = __builtin_amdgcn_mfma_f32_16x16x32_bf16(a, bb, acc, 0, 0, 0);
        }
        __syncthreads();
    }
#pragma unroll
    for (int r = 0; r < 4; ++r) H[(nt * 16 + fq * 4 + r) * 64 + ct * 16 + fr] = gelu_tanh(acc[r]);
    __syncthreads();
    {
        const int n = tid >> 4, c = (tid & 15) * 4;
        f32x4 o = (f32x4){0.f, 0.f, 0.f, 0.f};
#pragma unroll 8
        for (int i = 0; i < 64; ++i) { const float hv = H[n * 64 + i]; const f32x4 w = *(const f32x4*)(w2 + i * 64 + c); o += hv * w; }
        if (which == 0) {
            const float ss = grp16_sum(o.x * o.x + o.y * o.y + o.z * o.z + o.w * o.w);
            const float r = rsqrtf(ss * (1.0f / 64.0f) + EPS);
            const f32x4 gg = *(const f32x4*)(p.in[7] + c);
            o = o * r * gg;
        }
        if (n0 + n >= NCMP) o = (f32x4){0.f, 0.f, 0.f, 0.f};
        if (which == 0) { u32x2 w; w.x = pk2(o.x, o.y); w.y = pk2(o.z, o.w); *(u32x2*)((bf16*)(p.ws + WS_KC) + ((size_t)(b * 2 + g) * 512 + n0 + n) * 64 + c) = w; }
        else { bf16* vt = (bf16*)(p.ws + WS_VCT) + (size_t)(b * 2 + g) * 64 * 512 + n0 + n; vt[(c + 0) * 512] = f2bf(o.x); vt[(c + 1) * 512] = f2bf(o.y); vt[(c + 2) * 512] = f2bf(o.z); vt[(c + 3) * 512] = f2bf(o.w); }
    }
    __syncthreads();
}

__device__ __forceinline__ int rho16(int reg, int hh) { return (reg & 3) + 8 * (reg >> 2) + 4 * hh; }
__device__ __forceinline__ bf16x8 pack8(const float* pv) {
    u32x4 w; w.x = pk2(pv[0], pv[1]); w.y = pk2(pv[2], pv[3]); w.z = pk2(pv[4], pv[5]); w.w = pk2(pv[6], pv[7]);
    return __builtin_bit_cast(bf16x8, w);
}
__device__ __forceinline__ f32x16 score_tile(const bf16* kp, const bf16x8 (&qf)[4]) {
    f32x16 st;
#pragma unroll
    for (int i = 0; i < 16; ++i) st[i] = 0.f;
#pragma unroll
    for (int s = 0; s < 4; ++s) { const bf16x8 kf = *(const bf16x8*)(kp + s * 16); st = __builtin_amdgcn_mfma_f32_32x32x16_bf16(kf, qf[s], st, 0, 0, 0); }
    return st;
}
__device__ __forceinline__ void pv_tile(f32x16& o0, f32x16& o1, const bf16* vp, size_t vstride32, const float* pv) {
    const bf16x8 p0 = pack8(pv), p1 = pack8(pv + 8);
#pragma unroll
    for (int dt = 0; dt < 2; ++dt) {
        const bf16* v = vp + (size_t)dt * vstride32;
        const u32x2 a0 = *(const u32x2*)(v), a1 = *(const u32x2*)(v + 8), b0 = *(const u32x2*)(v + 16), b1 = *(const u32x2*)(v + 24);
        u32x4 w0, w1; w0.x = a0.x; w0.y = a0.y; w0.z = a1.x; w0.w = a1.y; w1.x = b0.x; w1.y = b0.y; w1.z = b1.x; w1.w = b1.y;
        if (dt == 0) { o0 = __builtin_amdgcn_mfma_f32_32x32x16_bf16(__builtin_bit_cast(bf16x8, w0), p0, o0, 0, 0, 0); o0 = __builtin_amdgcn_mfma_f32_32x32x16_bf16(__builtin_bit_cast(bf16x8, w1), p1, o0, 0, 0, 0); }
        else { o1 = __builtin_amdgcn_mfma_f32_32x32x16_bf16(__builtin_bit_cast(bf16x8, w0), p0, o1, 0, 0, 0); o1 = __builtin_amdgcn_mfma_f32_32x32x16_bf16(__builtin_bit_cast(bf16x8, w1), p1, o1, 0, 0, 0); }
    }
}
__device__ __forceinline__ void softmax_step(float* sv, float& m, float& l, f32x16& o0, f32x16& o1) {
    float ml = sv[0];
#pragma unroll
    for (int i = 1; i < 16; ++i) ml = fmaxf(ml, sv[i]);
    ml = fmaxf(ml, __shfl_xor(ml, 32));
    const float mn = fmaxf(m, ml), alpha = __expf(m - mn);
    m = mn;
    float ps = 0.f;
#pragma unroll
    for (int i = 0; i < 16; ++i) { const float e = (sv[i] > -1e29f) ? __expf(sv[i] - mn) : 0.f; sv[i] = e; ps += e; }
    l = l * alpha + ps;
#pragma unroll
    for (int i = 0; i < 16; ++i) { o0[i] *= alpha; o1[i] *= alpha; }
}
__device__ __forceinline__ void nsa_attn_item(const Params& p, unsigned char* wlds, int item) {
    const int lane = threadIdx.x & 63, c = lane & 31, hh = lane >> 5, jt = c >> 2, r4 = c & 3;
    const int oct = item & 1023, g = (item >> 10) & 1, b = item >> 11;
    const int t0 = oct * 8, tc = t0 + jt, h = g * 4 + r4;
    const float slope = exp2f(-(float)(h + 1));
    const bf16* proj = (const bf16*)(p.ws + WS_PROJ);
    float* impA = (float*)wlds; float* impB = impA + 1024; unsigned* msk = (unsigned*)(impB + 1024);
#pragma unroll
    for (int i = 0; i < 16; ++i) { impA[lane + 64 * i] = 0.f; impB[lane + 64 * i] = 0.f; }
    if (lane < 32) msk[lane] = 0u;
    bf16x8 qf[4];
    { const bf16* qp = proj + (size_t)(b * T + tc) * PS + C_NQ + h * 64 + hh * 8;
#pragma unroll
      for (int s = 0; s < 4; ++s) qf[s] = *(const bf16x8*)(qp + s * 16); }
    f32x16 oc0, oc1;
#pragma unroll
    for (int i = 0; i < 16; ++i) { oc0[i] = 0.f; oc1[i] = 0.f; }
    float gate[3];
    { const bf16* gp = proj + (size_t)(b * T + tc) * PS + C_GT + h * 3;
#pragma unroll
      for (int i = 0; i < 3; ++i) gate[i] = sigmoidf_(bf2f(gp[i])); }
    WAVE_LDS_SYNC();
    {
        const bf16* KC = (const bf16*)(p.ws + WS_KC) + (size_t)(b * 2 + g) * 512 * 64;
        const bf16* VCT = (const bf16*)(p.ws + WS_VCT) + (size_t)(b * 2 + g) * 64 * 512;
        const int nmax = (t0 + 7 >= 31) ? ((t0 + 7 - 31) >> 4) : -1;
        float m = -1e30f, l = 0.f;
        f32x16 o0, o1;
#pragma unroll
        for (int i = 0; i < 16; ++i) { o0[i] = 0.f; o1[i] = 0.f; }
#pragma unroll 1
        for (int n0 = 0; n0 <= nmax; n0 += 32) {
            const f32x16 st = score_tile(KC + (size_t)(n0 + c) * 64 + hh * 8, qf);
            float sv[16];
#pragma unroll
            for (int i = 0; i < 16; ++i) { const int dist = tc - (16 * (n0 + rho16(i, hh)) + 31); sv[i] = (dist >= 0) ? st[i] - slope * (float)dist : -1e30f; }
            float ml = sv[0];
#pragma unroll
            for (int i = 1; i < 16; ++i) ml = fmaxf(ml, sv[i]);
            ml = fmaxf(ml, __shfl_xor(ml, 32));
            const float mn = fmaxf(m, ml); float ps = 0.f;
#pragma unroll
            for (int i = 0; i < 16; ++i) ps += (sv[i] > -1e29f) ? __expf(sv[i] - mn) : 0.f;
            l = l * __expf(m - mn) + ps; m = mn;
        }
        l += __shfl_xor(l, 32);
        const float inv = 1.0f / fmaxf(l, 1e-30f);
#pragma unroll 1
        for (int n0 = 0; n0 <= nmax; n0 += 32) {
            const f32x16 st = score_tile(KC + (size_t)(n0 + c) * 64 + hh * 8, qf);
            float pv[16];
#pragma unroll
            for (int i = 0; i < 16; ++i) { const int dist = tc - (16 * (n0 + rho16(i, hh)) + 31); pv[i] = (dist >= 0) ? __expf(st[i] - slope * (float)dist - m) * inv : 0.f; }
            pv_tile(o0, o1, VCT + (size_t)c * 512 + n0 + 4 * hh, (size_t)32 * 512, pv);
#pragma unroll
            for (int i = 0; i < 16; ++i) { float v = pv[i]; v += dpp_f<0xB1>(v); v += dpp_f<0x4E>(v); pv[i] = v; }
            if (r4 == 0) {
#pragma unroll
                for (int rg = 0; rg < 4; ++rg) {
                    const int jb = (n0 >> 2) + 2 * rg + hh;
                    impA[jt * 128 + jb] = pv[4 * rg] + 2.f * pv[4 * rg + 1] + 2.f * pv[4 * rg + 2] + 2.f * pv[4 * rg + 3];
                    if (jb >= 1) impB[jt * 128 + jb - 1] = pv[4 * rg];
                }
            }
        }
#pragma unroll
        for (int i = 0; i < 16; ++i) { oc0[i] = gate[0] * o0[i]; oc1[i] = gate[0] * o1[i]; }
    }
    WAVE_LDS_SYNC();
    {
        const int lig = lane & 15, grp = lane >> 4;
#pragma unroll 1
        for (int half = 0; half < 2; ++half) {
            const int j2 = half * 4 + grp, cur = (t0 + j2) >> 6;
            float v[8];
#pragma unroll
            for (int e = 0; e < 8; ++e) {
                const int j = lig * 8 + e; const float val = impA[j2 * 128 + j] + impB[j2 * 128 + j];
                v[e] = (j >= 1 && j <= cur - 2) ? __uint_as_float((__float_as_uint(val) & ~127u) | (unsigned)(127 - j)) : -1.0f;
            }
            const float top = grp16_top16(v, lig);
            const int need = 16 - ((cur == 0) ? 1 : (cur == 1) ? 2 : 3);
            if (lig < need && top >= 0.f) { const int idx = 127 - (int)(__float_as_uint(top) & 127u); atomicOr(&msk[j2 * 4 + (idx >> 5)], 1u << (idx & 31)); }
            if (lig == 0) { atomicOr(&msk[j2 * 4], 1u); atomicOr(&msk[j2 * 4 + (cur >> 5)], 1u << (cur & 31)); if (cur >= 1) atomicOr(&msk[j2 * 4 + ((cur - 1) >> 5)], 1u << ((cur - 1) & 31)); }
        }
    }
    WAVE_LDS_SYNC();
    {
        unsigned mym[4], um[4];
#pragma unroll
        for (int w = 0; w < 4; ++w) { mym[w] = msk[jt * 4 + w]; unsigned u = 0u;
#pragma unroll
            for (int j = 0; j < 8; ++j) u |= msk[j * 4 + w];
            um[w] = (unsigned)__builtin_amdgcn_readfirstlane((int)u); }
        const bf16* VTS = (const bf16*)(p.ws + WS_VTS) + (size_t)(b * 2 + g) * 64 * T;
        float m = -1e30f, l = 0.f;
        f32x16 o0, o1;
#pragma unroll
        for (int i = 0; i < 16; ++i) { o0[i] = 0.f; o1[i] = 0.f; }
#pragma unroll
        for (int w = 0; w < 4; ++w) {
            unsigned u = um[w];
#pragma unroll 1
            while (u) {
                const int bit = __builtin_ctz(u); u &= u - 1u;
                const int jb = w * 32 + bit;
                const bool colsel = (mym[w] >> bit) & 1u;
#pragma unroll 1
                for (int hf = 0; hf < 2; ++hf) {
                    const int key0 = jb * 64 + hf * 32;
                    const f32x16 st = score_tile(proj + (size_t)(b * T + key0 + c) * PS + C_KS + g * 64 + hh * 8, qf);
                    float sv[16];
#pragma unroll
                    for (int i = 0; i < 16; ++i) { const int dist = tc - (key0 + rho16(i, hh)); sv[i] = (colsel && dist >= 0) ? st[i] - slope * (float)dist : -1e30f; }
                    softmax_step(sv, m, l, o0, o1);
                    pv_tile(o0, o1, VTS + (size_t)c * T + key0 + 4 * hh, (size_t)32 * T, sv);
                }
            }
        }
        l += __shfl_xor(l, 32);
        const float sc = gate[1] / fmaxf(l, 1e-30f);
#pragma unroll
        for (int i = 0; i < 16; ++i) { oc0[i] += sc * o0[i]; oc1[i] += sc * o1[i]; }
    }
    {
        const bf16* VTW = (const bf16*)(p.ws + WS_VTW) + (size_t)(b * 2 + g) * 64 * T;
        float m = -1e30f, l = 0.f;
        f32x16 o0, o1;
#pragma unroll
        for (int i = 0; i < 16; ++i) { o0[i] = 0.f; o1[i] = 0.f; }
        const int kstart = (t0 - 511 > 0 ? t0 - 511 : 0) & ~31;
#pragma unroll 1
        for (int key0 = kstart; key0 <= t0 + 7; key0 += 32) {
            const f32x16 st = score_tile(proj + (size_t)(b * T + key0 + c) * PS + C_KW + g * 64 + hh * 8, qf);
            float sv[16];
#pragma unroll
            for (int i = 0; i < 16; ++i) { const int dist = tc - (key0 + rho16(i, hh)); sv[i] = (dist >= 0 && dist < 512) ? st[i] - slope * (float)dist : -1e30f; }
            softmax_step(sv, m, l, o0, o1);
            pv_tile(o0, o1, VTW + (size_t)c * T + key0 + 4 * hh, (size_t)32 * T, sv);
        }
        l += __shfl_xor(l, 32);
        const float sc = gate[2] / fmaxf(l, 1e-30f);
#pragma unroll
        for (int i = 0; i < 16; ++i) { oc0[i] += sc * o0[i]; oc1[i] += sc * o1[i]; }
    }
    {
        float ss = 0.f;
#pragma unroll
        for (int i = 0; i < 16; ++i) ss += oc0[i] * oc0[i] + oc1[i] * oc1[i];
        ss += __shfl_xor(ss, 32);
        const float r = rsqrtf(ss * (1.0f / 64.0f) + EPS);
        const float* og = p.in[11] + h * 64;
        bf16* op = (bf16*)(p.ws + WS_ACT) + (size_t)(b * T + tc) * D + 512 + h * 64;
#pragma unroll
        for (int dt = 0; dt < 2; ++dt)
#pragma unroll
            for (int rg = 0; rg < 4; ++rg) {
                const int d0 = dt * 32 + 8 * rg + 4 * hh;
                const f32x4 gg = *(const f32x4*)(og + d0);
                u32x2 w;
                if (dt == 0) { w.x = pk2(oc0[4 * rg] * r * gg.x, oc0[4 * rg + 1] * r * gg.y); w.y = pk2(oc0[4 * rg + 2] * r * gg.z, oc0[4 * rg + 3] * r * gg.w); }
                else { w.x = pk2(oc1[4 * rg] * r * gg.x, oc1[4 * rg + 1] * r * gg.y); w.y = pk2(oc1[4 * rg + 2] * r * gg.z, oc1[4 * rg + 3] * r * gg.w); }
                *(u32x2*)(op + d0) = w;
            }
    }
    WAVE_LDS_SYNC();
}
__device__ __forceinline__ void phase2(const Params& p, unsigned char* lds) {
    for (int it = blockIdx.x; it < 128 + 256 + 1024; it += gridDim.x) {
        if (it < 128) nsa_cmp_item(p, lds, it);
        else if (it < 384) nsa_prep_item(p, lds, it - 128);
        else hgrn_pre_item(p, lds, it - 384);
    }
}
__device__ __forceinline__ void phase3(const Params& p, unsigned char* lds) {
    const int gw = (blockIdx.x * NTHR + threadIdx.x) >> 6;
    const int wid = threadIdx.x >> 6;
    if (wid == 0 && blockIdx.x < 64) hgrn_scan_item(p, blockIdx.x);
    const int ngw = (gridDim.x * NTHR) >> 6;
    for (int it = gw; it < 4096; it += ngw) nsa_attn_item(p, lds + wid * 8320, 4095 - it);
}

__device__ __forceinline__ float dot2u(unsigned a, unsigned b, float acc) { return __builtin_amdgcn_fdot2_f32_bf16(__builtin_bit_cast(bf16x2v, a), __builtin_bit_cast(bf16x2v, b), acc, false); }
__device__ __forceinline__ float dot8(u32x4 a, u32x4 b, float acc) {
    const unsigned a0 = a.x, a1 = a.y, a2 = a.z, a3 = a.w, b0 = b.x, b1 = b.y, b2 = b.z, b3 = b.w;
    acc = dot2u(a0, b0, acc); acc = dot2u(a1, b1, acc); acc = dot2u(a2, b2, acc); acc = dot2u(a3, b3, acc);
    return acc;
}
__device__ __forceinline__ void axpy8(float (&o)[8], float c, u32x4 v) {
    o[0] += c * __uint_as_float(v.x << 16); o[1] += c * __uint_as_float(v.x & 0xffff0000u);
    o[2] += c * __uint_as_float(v.y << 16); o[3] += c * __uint_as_float(v.y & 0xffff0000u);
    o[4] += c * __uint_as_float(v.z << 16); o[5] += c * __uint_as_float(v.z & 0xffff0000u);
    o[6] += c * __uint_as_float(v.w << 16); o[7] += c * __uint_as_float(v.w & 0xffff0000u);
}
__device__ __forceinline__ void phase9(const Params& p, unsigned char* lds) {
    const bf16* HN = (const bf16*)(p.ws + WS_ACT); const bf16* UB = (const bf16*)(p.ws + WS_UB); const bf16* VB = (const bf16*)(p.ws + WS_VB);
    const int* ids = (const int*)(p.ws + WS_IDS); const float* wts = (const float*)(p.ws + WS_WTS);
    float* O = p.out; bf16* HG = (bf16*)(p.ws + WS_PROJ + 64 * MiB); const float* gn = p.in[19];
    const int lane = threadIdx.x & 63, gw = (blockIdx.x * NTHR + threadIdx.x) >> 6, ngw = (gridDim.x * NTHR) >> 6;
    for (int tok = gw; tok < NTOK; tok += ngw) {
        const u32x4 x0 = *(const u32x4*)(HN + (size_t)tok * D + lane * 8), x1 = *(const u32x4*)(HN + (size_t)tok * D + 512 + lane * 8);
        float oa[8], ob[8];
#pragma unroll
        for (int j = 0; j < 8; ++j) { oa[j] = 0.f; ob[j] = 0.f; }
#pragma unroll 1
        for (int half = 0; half < 2; ++half) {
            const int myid = ids[(size_t)tok * 128 + half * 64 + lane]; const float myw = wts[(size_t)tok * 128 + half * 64 + lane];
#pragma unroll 1
            for (int eb = 0; eb < 64; eb += 8) {
                int id[8]; float d[8];
#pragma unroll
                for (int j = 0; j < 8; ++j) id[j] = __shfl(myid, eb + j);
                u32x4 ua[8], ub[8];
#pragma unroll
                for (int j = 0; j < 8; ++j) { const bf16* ur = UB + (size_t)id[j] * D; ua[j] = *(const u32x4*)(ur + lane * 8); ub[j] = *(const u32x4*)(ur + 512 + lane * 8); }
#pragma unroll
                for (int j = 0; j < 8; ++j) { d[j] = dot8(ub[j], x1, dot8(ua[j], x0, 0.f)); }
#pragma unroll
                for (int j = 0; j < 8; ++j) { const bf16* vr = VB + (size_t)id[j] * D; ua[j] = *(const u32x4*)(vr + lane * 8); ub[j] = *(const u32x4*)(vr + 512 + lane * 8); }
#pragma unroll
                for (int j = 0; j < 8; ++j) d[j] = wave_sum(d[j]);
#pragma unroll
                for (int j = 0; j < 8; ++j) { const float c = __shfl(myw, eb + j) * gelu_tanh(d[j]); axpy8(oa, c, ua[j]); axpy8(ob, c, ub[j]); }
            }
        }
        float* orow = O + (size_t)tok * D;
        f32x4 h0 = *(const f32x4*)(orow + lane * 8), h1 = *(const f32x4*)(orow + lane * 8 + 4), h2 = *(const f32x4*)(orow + 512 + lane * 8), h3 = *(const f32x4*)(orow + 512 + lane * 8 + 4);
        h0.x += oa[0]; h0.y += oa[1]; h0.z += oa[2]; h0.w += oa[3]; h1.x += oa[4]; h1.y += oa[5]; h1.z += oa[6]; h1.w += oa[7];
        h2.x += ob[0]; h2.y += ob[1]; h2.z += ob[2]; h2.w += ob[3]; h3.x += ob[4]; h3.y += ob[5]; h3.z += ob[6]; h3.w += ob[7];
        *(f32x4*)(orow + lane * 8) = h0; *(f32x4*)(orow + lane * 8 + 4) = h1; *(f32x4*)(orow + 512 + lane * 8) = h2; *(f32x4*)(orow + 512 + lane * 8 + 4) = h3;
        float ss = h0.x * h0.x + h0.y * h0.y + h0.z * h0.z + h0.w * h0.w + h1.x * h1.x + h1.y * h1.y + h1.z * h1.z + h1.w * h1.w
                 + h2.x * h2.x + h2.y * h2.y + h2.z * h2.z + h2.w * h2.w + h3.x * h3.x + h3.y * h3.y + h3.z * h3.z + h3.w * h3.w;
        ss = wave_sum(ss);
        const float r = rsqrtf(ss * (1.0f / D) + EPS);
        const f32x4 g0 = *(const f32x4*)(gn + lane * 8), g1 = *(const f32x4*)(gn + lane * 8 + 4), g2 = *(const f32x4*)(gn + 512 + lane * 8), g3 = *(const f32x4*)(gn + 512 + lane * 8 + 4);
        u32x4 q0, q1;
        q0.x = pk2(h0.x * r * g0.x, h0.y * r * g0.y); q0.y = pk2(h0.z * r * g0.z, h0.w * r * g0.w); q0.z = pk2(h1.x * r * g1.x, h1.y * r * g1.y); q0.w = pk2(h1.z * r * g1.z, h1.w * r * g1.w);
        q1.x = pk2(h2.x * r * g2.x, h2.y * r * g2.y); q1.y = pk2(h2.z * r * g2.z, h2.w * r * g2.w); q1.z = pk2(h3.x * r * g3.x, h3.y * r * g3.y); q1.w = pk2(h3.z * r * g3.z, h3.w * r * g3.w);
        *(u32x4*)(HG + (size_t)tok * D + lane * 8) = q0; *(u32x4*)(HG + (size_t)tok * D + 512 + lane * 8) = q1;
    }
}

__global__ void __launch_bounds__(NTHR, 2) mega(Params p, int ph_lo, int ph_hi) {
    extern __shared__ __attribute__((aligned(16))) unsigned char lds[];
    cg::grid_group grid = cg::this_grid();
#define RUN_PHASE(k, call) if (ph_lo <= (k) && (k) < ph_hi) { if ((k) > ph_lo) grid.sync(); call; }
    RUN_PHASE(0, phase0(p, lds))
    RUN_PHASE(1, phase1(p, lds))
    RUN_PHASE(2, phase2(p, lds))
    RUN_PHASE(3, phase3(p, lds))
    RUN_PHASE(4, phase4(p, lds))
    RUN_PHASE(5, phase5(p, lds))
    RUN_PHASE(6, phase6(p, lds))
    RUN_PHASE(7, phase7(p, lds))
    RUN_PHASE(8, phase8(p, lds))
    RUN_PHASE(9, phase9(p, lds))
    RUN_PHASE(10, phase10(p, lds))
}

static void launch_mega(const Params& p, int lo, int hi, hipStream_t stream) {
    static int grid = 0;
    if (grid == 0) {
        int dev = 0, cus = 0, per_cu = 0;
        hipGetDevice(&dev); hipDeviceGetAttribute(&cus, hipDeviceAttributeMultiprocessorCount, dev);
        hipFuncSetAttribute((const void*)mega, hipFuncAttributeMaxDynamicSharedMemorySize, LDS_BYTES);
        hipOccupancyMaxActiveBlocksPerMultiprocessor(&per_cu, (const void*)mega, NTHR, LDS_BYTES);
        if (per_cu < 1) { fprintf(stderr, "mega: occupancy query says %d blocks/CU\n", per_cu); per_cu = 1; }
        grid = cus;
    }
    Params pp = p; int l = lo, h = hi;
    void* args[] = {&pp, &l, &h};
    hipError_t e = hipLaunchCooperativeKernel((const void*)mega, dim3(grid), dim3(NTHR), args, LDS_BYTES, stream);
    if (e != hipSuccess) fprintf(stderr, "cooperative launch failed: %s (grid %d)\n", hipGetErrorString(e), grid);
}

extern "C" void kernel_launch(void* const* d_in, const int* in_sizes, int n_in, void* d_out, int out_size, void* d_ws, size_t ws_size, hipStream_t stream) {
    const float* x = (const float*)d_in[0]; const float* p = (const float*)d_in[1]; const float* mix_norm = (const float*)d_in[2]; const float* w_in = (const float*)d_in[3];
    const float* lb_logits = (const float*)d_in[4]; const float* hg_out_norm = (const float*)d_in[5]; const float* q_norm = (const float*)d_in[6]; const float* k_norm = (const float*)d_in[7];
    const float* cmp_pe = (const float*)d_in[8]; const float* cmp_w1 = (const float*)d_in[9]; const float* cmp_w2 = (const float*)d_in[10]; const float* nsa_out_norm = (const float*)d_in[11];
    const float* w_out = (const float*)d_in[12]; const float* ffn_norm = (const float*)d_in[13]; const float* peer_wq = (const float*)d_in[14]; const float* peer_keys = (const float*)d_in[15];
    const float* peer_u = (const float*)d_in[16]; const float* peer_v = (const float*)d_in[17]; const float* ple_proj = (const float*)d_in[18]; const float* ple_gate_norm = (const float*)d_in[19];
    const float* ple_gate_w = (const float*)d_in[20];
    float* out = (float*)d_out; unsigned char* ws = (unsigned char*)d_ws;
    bf16* act = (bf16*)(ws + WS_ACT); bf16* proj = (bf16*)(ws + WS_PROJ);
    bf16* pq = (bf16*)(ws + WS_PROJ); bf16* hg = (bf16*)(ws + WS_PROJ + 64 * MiB);
    int* ids = (int*)(ws + WS_IDS); float* wts = (float*)(ws + WS_WTS); float* kcf = (float*)(ws + WS_KCF); float* vcf = (float*)(ws + WS_VCF); float* gl = (float*)(ws + WS_GL);

    Params prm{}; for (int i = 0; i < 21; ++i) prm.in[i] = (const float*)d_in[i]; prm.out = out; prm.ws = ws;
    launch_mega(prm, 0, 11, stream);
}
```

```cpp
#include <hip/hip_runtime.h>
#include <hip/hip_cooperative_groups.h>
#include <cstdint>
#include <cstdio>
namespace cg = cooperative_groups;

constexpr int D = 1024, NB = 2, T = 8192, NTOK = NB * T;
constexpr int DIN = 3352, PS = 3392;
constexpr int C_HQ = 0, C_HF = 512, C_HI = 1024, C_HG = 1536, C_NQ = 2048, C_KC = 2560, C_VC = 2688,
              C_KS = 2816, C_VS = 2944, C_KW = 3072, C_VW = 3200, C_GT = 3328;
constexpr int NCMP = 511;
constexpr float EPS = 1e-6f;
typedef unsigned short bf16;

constexpr size_t MiB = 1u << 20;
constexpr size_t WS_WINT = 1 * MiB;
constexpr size_t WS_WOUTT = 8 * MiB;
constexpr size_t WS_WQT = 10 * MiB;
constexpr size_t WS_WGT = 14 * MiB;
constexpr size_t WS_WPT = 16 * MiB;
constexpr size_t WS_KEYB = 16 * MiB + 512 * 1024;
constexpr size_t WS_W1T = 17 * MiB;
constexpr size_t WS_UB = 18 * MiB;
constexpr size_t WS_VB = 50 * MiB;
constexpr size_t WS_ACT = 82 * MiB;
constexpr size_t WS_PROJ = 114 * MiB;
constexpr size_t WS_SPARE = 220 * MiB;
constexpr size_t WS_IDS = WS_SPARE;
constexpr size_t WS_WTS = WS_SPARE + 8 * MiB;
constexpr size_t WS_KCF = WS_SPARE + 16 * MiB;
constexpr size_t WS_VCF = WS_SPARE + 17 * MiB;
constexpr size_t WS_PB = WS_SPARE + 18 * MiB;
constexpr size_t WS_VTS = WS_SPARE + 26 * MiB;
constexpr size_t WS_VTW = WS_SPARE + 30 * MiB;
constexpr size_t WS_KC = WS_SPARE + 34 * MiB;
constexpr size_t WS_VCT = WS_SPARE + 34 * MiB + 256 * 1024;
constexpr size_t WS_DEC = WS_SPARE + 34 * MiB + 512 * 1024;
constexpr size_t OUT_KIT = 32 * MiB;
constexpr size_t OUT_VT = 48 * MiB;
constexpr size_t WS_GL = 18 * MiB;

__device__ __forceinline__ float bf2f(bf16 v) { return __uint_as_float(((unsigned)v) << 16); }
__device__ __forceinline__ bf16 f2bf(float f) { unsigned u = __float_as_uint(f); return (bf16)((u + 0x7fffu + ((u >> 16) & 1u)) >> 16); }
__device__ __forceinline__ float wave_sum(float v) {
#pragma unroll
    for (int o = 1; o < 64; o <<= 1) v += __shfl_xor(v, o);
    return v;
}
__device__ __forceinline__ float wave_max(float v) {
#pragma unroll
    for (int o = 1; o < 64; o <<= 1) v = fmaxf(v, __shfl_xor(v, o));
    return v;
}
__device__ __forceinline__ float sigmoidf_(float x) { return 1.0f / (1.0f + __expf(-x)); }
__device__ __forceinline__ float siluf_(float x) { return x * sigmoidf_(x); }
__device__ __forceinline__ float gelu_tanh(float x) { return 0.5f * x * (1.0f + tanhf(0.7978845608028654f * (x + 0.044715f * x * x * x))); }
__device__ __forceinline__ float toF(float v) { return v; }
__device__ __forceinline__ float toF(bf16 v) { return bf2f(v); }

__global__ void __launch_bounds__(256) k_rms_rows(const float* __restrict__ x, const float* __restrict__ g, bf16* __restrict__ out, int rows) {
    const int wave = (blockIdx.x * 256 + threadIdx.x) >> 6, lane = threadIdx.x & 63;
    if (wave >= rows) return;
    const float* xr = x + (size_t)wave * D;
    float v[16]; float s = 0.f;
#pragma unroll
    for (int j = 0; j < 16; ++j) { v[j] = xr[lane + 64 * j]; s += v[j] * v[j]; }
    s = wave_sum(s);
    const float r = rsqrtf(s * (1.0f / D) + EPS);
#pragma unroll
    for (int j = 0; j < 16; ++j) out[(size_t)wave * D + lane + 64 * j] = f2bf(v[j] * r * g[lane + 64 * j]);
}

struct EpiBf16 { bf16* C; int ldc; int pad; __device__ void operator()(int r, int c, float v) const { C[(size_t)r * ldc + c] = f2bf(v); } };
struct EpiF32 { float* C; int ldc; int pad; __device__ void operator()(int r, int c, float v) const { C[(size_t)r * ldc + c] = v; } };
struct EpiResid { const float* X; float* O; int ld; int pad; __device__ void operator()(int r, int c, float v) const { O[(size_t)r * ld + c] = X[(size_t)r * ld + c] + v; } };
struct EpiFinal { const float* G; float* O; int ld; int pad; __device__ void operator()(int r, int c, float v) const { const size_t i = (size_t)r * ld + c; O[i] = O[i] + v * sigmoidf_(G[i]); } };

template <typename AT, class Epi>
__global__ void __launch_bounds__(256) k_gemm_naive(const AT* __restrict__ A, int lda, const float* __restrict__ W, int ldw, int N, int K, Epi epi) {
    __shared__ float As[16][65];
    __shared__ float Bs[16][64];
    const int tid = threadIdx.x, tx = tid & 15, ty = tid >> 4;
    const int m0 = blockIdx.y * 64, n0 = blockIdx.x * 64;
    float acc[4][4];
#pragma unroll
    for (int i = 0; i < 4; ++i)
#pragma unroll
        for (int j = 0; j < 4; ++j) acc[i][j] = 0.f;
    for (int k0 = 0; k0 < K; k0 += 16) {
#pragma unroll
        for (int i = 0; i < 4; ++i) { const int idx = tid + i * 256, r = idx >> 4, kk = idx & 15; As[kk][r] = toF(A[(size_t)(m0 + r) * lda + k0 + kk]); }
#pragma unroll
        for (int i = 0; i < 4; ++i) { const int idx = tid + i * 256, kk = idx >> 6, c = idx & 63; Bs[kk][c] = (n0 + c < N) ? W[(size_t)(k0 + kk) * ldw + n0 + c] : 0.f; }
        __syncthreads();
#pragma unroll
        for (int kk = 0; kk < 16; ++kk) {
            float a[4], b[4];
#pragma unroll
            for (int i = 0; i < 4; ++i) a[i] = As[kk][ty * 4 + i];
#pragma unroll
            for (int j = 0; j < 4; ++j) b[j] = Bs[kk][tx * 4 + j];
#pragma unroll
            for (int i = 0; i < 4; ++i)
#pragma unroll
                for (int j = 0; j < 4; ++j) acc[i][j] += a[i] * b[j];
        }
        __syncthreads();
    }
#pragma unroll
    for (int i = 0; i < 4; ++i)
#pragma unroll
        for (int j = 0; j < 4; ++j) { const int r = m0 + ty * 4 + i, c = n0 + tx * 4 + j; if (c < N) epi(r, c, acc[i][j]); }
}

__global__ void __launch_bounds__(1024) k_hgrn_naive(const bf16* __restrict__ proj, const float* __restrict__ lb_logits, const float* __restrict__ out_gain, bf16* __restrict__ mixed) {
    const int b = blockIdx.x >> 2, h = blockIdx.x & 3, tid = threadIdx.x, v = tid & 127, kg = tid >> 7;
    __shared__ float qsh[128], ksh[128], fsh[128], vsh[128], part[8][128], red[2], lbs[128];
    if (tid < 128) { const float l0 = lb_logits[h * 128 + tid], l1 = lb_logits[512 + h * 128 + tid]; const float m = fmaxf(l0, l1); const float e0 = expf(l0 - m), e1 = expf(l1 - m); lbs[tid] = e0 / (e0 + e1); }
    float S[16];
#pragma unroll
    for (int i = 0; i < 16; ++i) S[i] = 0.f;
    __syncthreads();
    for (int t = 0; t < T; ++t) {
        const size_t row = (size_t)(b * T + t) * PS;
        if (tid < 128) {
            const float fl = bf2f(proj[row + C_HF + h * 128 + tid]); const float lb = lbs[tid];
            const float fg = lb + (1.0f - lb) * sigmoidf_(fl); fsh[tid] = fg; ksh[tid] = 1.0f - fg;
            qsh[tid] = siluf_(bf2f(proj[row + C_HQ + h * 128 + tid])) * 0.08838834764831845f;
        } else if (tid < 256) vsh[tid - 128] = bf2f(proj[row + C_HI + h * 128 + tid - 128]);
        __syncthreads();
        const float vv = vsh[v]; float p = 0.f;
#pragma unroll
        for (int i = 0; i < 16; ++i) { const int k = kg * 16 + i; S[i] = fsh[k] * S[i] + ksh[k] * vv; p += qsh[k] * S[i]; }
        part[kg][v] = p;
        __syncthreads();
        float o = 0.f;
        if (tid < 128) {
#pragma unroll
            for (int j = 0; j < 8; ++j) o += part[j][tid];
            const float ss = wave_sum(o * o); if ((tid & 63) == 0) red[tid >> 6] = ss;
        }
        __syncthreads();
        if (tid < 128) {
            const float tot = red[0] + red[1];
            const float y = o * rsqrtf(tot * (1.0f / 128.0f) + EPS) * out_gain[h * 128 + tid];
            const float gl = bf2f(proj[row + C_HG + h * 128 + tid]);
            mixed[(size_t)(b * T + t) * D + h * 128 + tid] = f2bf(y * siluf_(gl));
        }
    }
}

__global__ void __launch_bounds__(64) k_cmp_naive(const bf16* __restrict__ proj, const float* __restrict__ pe, const float* __restrict__ w1, const float* __restrict__ w2,
                                                  const float* __restrict__ k_gain, float* __restrict__ kc, float* __restrict__ vc) {
    int it = blockIdx.x; const int n = it % NCMP; it /= NCMP; const int g = it & 1; it >>= 1; const int b = it & 1; const int which = it >> 1;
    const int c = threadIdx.x;
    __shared__ float blk[2048]; __shared__ float hid[64];
    const int col0 = (which == 0 ? C_KC : C_VC) + g * 64;
    for (int i = c; i < 2048; i += 64) { const int j = i >> 6, d = i & 63; blk[i] = bf2f(proj[(size_t)(b * T + 16 * n + j) * PS + col0 + d]) + pe[which * 2048 + i]; }
    __syncthreads();
    float acc = 0.f;
    for (int i = 0; i < 2048; ++i) acc += blk[i] * w1[(size_t)which * 2048 * 64 + (size_t)i * 64 + c];
    hid[c] = gelu_tanh(acc);
    __syncthreads();
    float o = 0.f;
    for (int i = 0; i < 64; ++i) o += hid[i] * w2[which * 4096 + i * 64 + c];
    if (which == 0) { const float ss = wave_sum(o * o); o = o * rsqrtf(ss * (1.0f / 64.0f) + EPS) * k_gain[c]; }
    (which == 0 ? kc : vc)[((size_t)(b * 2 + g) * NCMP + n) * 64 + c] = o;
}

__global__ void __launch_bounds__(256) k_nsa_naive(const bf16* __restrict__ proj, const float* __restrict__ kc, const float* __restrict__ vc, const float* __restrict__ q_gain,
                                                   const float* __restrict__ k_gain, const float* __restrict__ out_gain, bf16* __restrict__ mixed) {
    const int g = blockIdx.x & 1, tok = blockIdx.x >> 1, b = tok / T, t = tok % T;
    const int tid = threadIdx.x, r = tid >> 6, lane = tid & 63, h = g * 4 + r;
    __shared__ float qs[4][64]; __shared__ float sc[4][1024]; __shared__ float P[520]; __shared__ float imp[128]; __shared__ int sel[128]; __shared__ int blist[16]; __shared__ int nbs;
    const float slope = exp2f(-(float)(h + 1));
    const float NEG = -__builtin_huge_valf();
    {
        float qv = bf2f(proj[(size_t)tok * PS + C_NQ + h * 64 + lane]);
        const float ss = wave_sum(qv * qv);
        qs[r][lane] = qv * rsqrtf(ss * (1.0f / 64.0f) + EPS) * q_gain[lane] * 0.125f;
    }
    __syncthreads();
    const int nvalid = (t >= 31) ? ((t - 31) / 16 + 1) : 0;
    const float* kcb = kc + (size_t)(b * 2 + g) * NCMP * 64; const float* vcb = vc + (size_t)(b * 2 + g) * NCMP * 64;
    float mx = NEG;
    for (int n = lane; n < 512; n += 64) {
        float s = NEG;
        if (n < nvalid) { float d = 0.f; for (int i = 0; i < 64; ++i) d += qs[r][i] * kcb[n * 64 + i]; s = d - slope * (float)(t - (16 * n + 31)); }
        sc[r][n] = s; mx = fmaxf(mx, s);
    }
    mx = wave_max(mx); if (mx == NEG) mx = 0.f;
    float sum = 0.f;
    for (int n = lane; n < 512; n += 64) { const float e = (n < nvalid) ? expf(sc[r][n] - mx) : 0.f; sc[r][n] = e; sum += e; }
    sum = wave_sum(sum); float inv = 1.0f / fmaxf(sum, 1e-30f);
    for (int n = lane; n < 512; n += 64) sc[r][n] *= inv;
    __syncthreads();
    float oc = 0.f;
    for (int n = 0; n < nvalid; ++n) oc += sc[r][n] * vcb[n * 64 + lane];
    for (int i = tid; i < 520; i += 256) P[i] = (i < 512) ? (sc[0][i] + sc[1][i] + sc[2][i] + sc[3][i]) : 0.f;
    __syncthreads();
    if (tid < 128) imp[tid] = P[4 * tid] + 2.f * P[4 * tid + 1] + 2.f * P[4 * tid + 2] + 2.f * P[4 * tid + 3] + P[4 * tid + 4];
    __syncthreads();
    const int cur = t >> 6;
    if (tid < 128) {
        const int j = tid; const bool forced = (j == 0) || (j == cur) || (j == cur - 1); const bool cand = !forced && j <= cur;
        const int nforced = (cur == 0) ? 1 : (cur == 1) ? 2 : 3; const int need = 16 - nforced;
        int rank = 0; const float mine = imp[j];
        for (int q = 1; q <= cur - 2; ++q) { if (q == j) continue; const float o = imp[q]; if (o > mine || (o == mine && q < j)) ++rank; }
        sel[j] = (forced || (cand && rank < need)) ? 1 : 0;
    }
    __syncthreads();
    if (tid == 0) { int nb = 0; for (int j = 0; j < 128; ++j) if (sel[j] && nb < 16) blist[nb++] = j; nbs = nb; }
    __syncthreads();
    const int nb = nbs;
    float os = 0.f;
    {
        float m2 = NEG;
        for (int s = 0; s < nb; ++s) {
            const int pos = blist[s] * 64 + lane; float val = NEG;
            if (pos <= t) {
                const bf16* kr = proj + (size_t)(b * T + pos) * PS + C_KS + g * 64; float d = 0.f, sq = 0.f;
                for (int i = 0; i < 64; ++i) { const float kv = bf2f(kr[i]); d += qs[r][i] * kv * k_gain[64 + i]; sq += kv * kv; }
                val = d * rsqrtf(sq * (1.0f / 64.0f) + EPS) - slope * (float)(t - pos);
            }
            sc[r][s * 64 + lane] = val; m2 = fmaxf(m2, val);
        }
        m2 = wave_max(m2); if (m2 == NEG) m2 = 0.f;
        float su = 0.f;
        for (int s = 0; s < nb; ++s) { const float v0 = sc[r][s * 64 + lane]; const float e = (v0 == NEG) ? 0.f : expf(v0 - m2); sc[r][s * 64 + lane] = e; su += e; }
        su = wave_sum(su); const float iv = 1.0f / fmaxf(su, 1e-30f);
        __syncthreads();
        for (int s = 0; s < nb; ++s) for (int i = 0; i < 64; ++i) {
            const float p = sc[r][s * 64 + i]; if (p != 0.f) os += p * bf2f(proj[(size_t)(b * T + blist[s] * 64 + i) * PS + C_VS + g * 64 + lane]); }
        os *= iv;
    }
    __syncthreads();
    float ow = 0.f;
    {
        float m2 = NEG;
        for (int i = lane; i < 512; i += 64) {
            const int pos = t - i; float val = NEG;
            if (pos >= 0) {
                const bf16* kr = proj + (size_t)(b * T + pos) * PS + C_KW + g * 64; float d = 0.f, sq = 0.f;
                for (int c = 0; c < 64; ++c) { const float kv = bf2f(kr[c]); d += qs[r][c] * kv * k_gain[128 + c]; sq += kv * kv; }
                val = d * rsqrtf(sq * (1.0f / 64.0f) + EPS) - slope * (float)i;
            }
            sc[r][i] = val; m2 = fmaxf(m2, val);
        }
        m2 = wave_max(m2);
        float su = 0.f;
        for (int i = lane; i < 512; i += 64) { const float v0 = sc[r][i]; const float e = (v0 == NEG) ? 0.f : expf(v0 - m2); sc[r][i] = e; su += e; }
        su = wave_sum(su); const float iv = 1.0f / fmaxf(su, 1e-30f);
        __syncthreads();
        for (int i = 0; i < 512; ++i) { const float p = sc[r][i]; if (p != 0.f) ow += p * bf2f(proj[(size_t)(b * T + t - i) * PS + C_VW + g * 64 + lane]); }
        ow *= iv;
    }
    const bf16* gl = proj + (size_t)tok * PS + C_GT + h * 3;
    const float o = sigmoidf_(bf2f(gl[0])) * oc + sigmoidf_(bf2f(gl[1])) * os + sigmoidf_(bf2f(gl[2])) * ow;
    const float ss = wave_sum(o * o);
    mixed[(size_t)tok * D + 512 + h * 64 + lane] = f2bf(o * rsqrtf(ss * (1.0f / 64.0f) + EPS) * out_gain[h * 64 + lane]);
}

__global__ void __launch_bounds__(128) k_peer_topk_naive(const bf16* __restrict__ pq, const float* __restrict__ keys, int* __restrict__ ids, float* __restrict__ wts) {
    const int tok = blockIdx.x >> 3, h = blockIdx.x & 7, k = threadIdx.x;
    __shared__ float q[256]; __shared__ float s[2][128]; __shared__ float ts[2][16]; __shared__ int ti[2][16]; __shared__ float cand[256]; __shared__ float bs[16]; __shared__ int bc[16];
    q[k] = bf2f(pq[(size_t)tok * 2048 + h * 256 + k]); q[k + 128] = bf2f(pq[(size_t)tok * 2048 + h * 256 + 128 + k]);
    __syncthreads();
#pragma unroll
    for (int c = 0; c < 2; ++c) { const float* kr = keys + ((size_t)(h * 2 + c) * 128 + k) * 128; float d = 0.f; for (int i = 0; i < 128; ++i) d += q[c * 128 + i] * kr[i]; s[c][k] = d; }
    __syncthreads();
#pragma unroll
    for (int c = 0; c < 2; ++c) { const float mine = s[c][k]; int rank = 0; for (int j = 0; j < 128; ++j) { const float o = s[c][j]; if (o > mine || (o == mine && j < k)) ++rank; } if (rank < 16) { ts[c][rank] = mine; ti[c][rank] = k; } }
    __syncthreads();
    cand[k] = ts[0][k >> 4] + ts[1][k & 15]; cand[k + 128] = ts[0][(k + 128) >> 4] + ts[1][(k + 128) & 15];
    __syncthreads();
#pragma unroll
    for (int e = 0; e < 2; ++e) { const int me = k + e * 128; const float mine = cand[me]; int rank = 0; for (int j = 0; j < 256; ++j) { const float o = cand[j]; if (o > mine || (o == mine && j < me)) ++rank; } if (rank < 16) { bs[rank] = mine; bc[rank] = me; } }
    __syncthreads();
    if (k < 16) {
        float mx = bs[0]; float sum = 0.f; for (int j = 0; j < 16; ++j) sum += expf(bs[j] - mx);
        const int c = bc[k]; ids[(size_t)tok * 128 + h * 16 + k] = ti[0][c >> 4] * 128 + ti[1][c & 15];
        wts[(size_t)tok * 128 + h * 16 + k] = expf(bs[k] - mx) / sum;
    }
}

__global__ void __launch_bounds__(256) k_peer_gather_naive(const bf16* __restrict__ hn, const int* __restrict__ ids, const float* __restrict__ wts, const float* __restrict__ U, const float* __restrict__ V,
                                                           const float* __restrict__ gnorm, float* __restrict__ hio, bf16* __restrict__ hg) {
    const int tok = blockIdx.x, tid = threadIdx.x, w = tid >> 6, lane = tid & 63;
    __shared__ float xs[1024]; __shared__ float coef[128]; __shared__ int eid[128]; __shared__ float red[4];
    for (int i = tid; i < 1024; i += 256) xs[i] = bf2f(hn[(size_t)tok * D + i]);
    if (tid < 128) eid[tid] = ids[(size_t)tok * 128 + tid];
    __syncthreads();
    for (int e = w * 32; e < w * 32 + 32; ++e) {
        const float* ur = U + (size_t)eid[e] * D; float d = 0.f;
        for (int i = lane; i < 1024; i += 64) d += ur[i] * xs[i];
        d = wave_sum(d);
        if (lane == 0) coef[e] = wts[(size_t)tok * 128 + e] * gelu_tanh(d);
    }
    __syncthreads();
    float o[4] = {0.f, 0.f, 0.f, 0.f};
    for (int e = 0; e < 128; ++e) { const float* vr = V + (size_t)eid[e] * D; const float c = coef[e];
#pragma unroll
        for (int j = 0; j < 4; ++j) o[j] += c * vr[tid + 256 * j]; }
    float ss = 0.f;
#pragma unroll
    for (int j = 0; j < 4; ++j) { o[j] += hio[(size_t)tok * D + tid + 256 * j]; hio[(size_t)tok * D + tid + 256 * j] = o[j]; ss += o[j] * o[j]; }
    ss = wave_sum(ss); if (lane == 0) red[w] = ss;
    __syncthreads();
    const float r = rsqrtf((red[0] + red[1] + red[2] + red[3]) * (1.0f / D) + EPS);
#pragma unroll
    for (int j = 0; j < 4; ++j) hg[(size_t)tok * D + tid + 256 * j] = f2bf(o[j] * r * gnorm[tid + 256 * j]);
}


typedef short bf16x8 __attribute__((ext_vector_type(8)));
typedef float f32x4 __attribute__((ext_vector_type(4)));
typedef float f32x16 __attribute__((ext_vector_type(16)));
typedef unsigned u32x4 __attribute__((ext_vector_type(4)));
typedef unsigned u32x2 __attribute__((ext_vector_type(2)));
constexpr int NTHR = 512;
constexpr int LDS_BYTES = 131072 + 16;
struct Params { const float* in[21]; float* out; unsigned char* ws; };

__device__ __forceinline__ unsigned pk2(float lo, float hi) { return (unsigned)f2bf(lo) | ((unsigned)f2bf(hi) << 16); }

__device__ __forceinline__ void transpose_tile(const float* __restrict__ W, int K, int N, bf16* __restrict__ Wt, int kt, int nt, float* tile) {
    const int tid = threadIdx.x, k0 = kt * 64, n0 = nt * 64;
#pragma unroll
    for (int i = 0; i < 8; ++i) { const int idx = tid + i * NTHR, kk = idx >> 6, nn = idx & 63; tile[kk * 65 + nn] = (n0 + nn < N) ? W[(size_t)(k0 + kk) * N + n0 + nn] : 0.f; }
    __syncthreads();
    { const int nn = tid >> 3, ch = tid & 7; const float* s = tile + (ch * 8) * 65 + nn;
      u32x4 o; o.x = pk2(s[0], s[65]); o.y = pk2(s[130], s[195]); o.z = pk2(s[260], s[325]); o.w = pk2(s[390], s[455]);
      *(u32x4*)(Wt + (size_t)(n0 + nn) * K + k0 + ch * 8) = o; }
    __syncthreads();
}
__device__ __forceinline__ void cvt_range(const float* __restrict__ src, bf16* __restrict__ dst, size_t n8, size_t gtid, size_t gthreads) {
    for (size_t i = gtid; i < n8; i += gthreads) {
        const f32x4 a = ((const f32x4*)src)[2 * i], b = ((const f32x4*)src)[2 * i + 1];
        u32x4 o; o.x = pk2(a.x, a.y); o.y = pk2(a.z, a.w); o.z = pk2(b.x, b.y); o.w = pk2(b.z, b.w);
        ((u32x4*)dst)[i] = o;
    }
}
__device__ __forceinline__ void rms_row_bf16(const float* __restrict__ xr, const float* __restrict__ g, bf16* __restrict__ orow, int lane) {
    f32x4 v[4]; float s = 0.f;
#pragma unroll
    for (int j = 0; j < 4; ++j) { v[j] = ((const f32x4*)xr)[lane + 64 * j]; s += v[j].x * v[j].x + v[j].y * v[j].y + v[j].z * v[j].z + v[j].w * v[j].w; }
    s = wave_sum(s);
    const float r = rsqrtf(s * (1.0f / D) + EPS);
#pragma unroll
    for (int j = 0; j < 4; ++j) { const f32x4 gg = ((const f32x4*)g)[lane + 64 * j]; u32x2 o; o.x = pk2(v[j].x * r * gg.x, v[j].y * r * gg.y); o.y = pk2(v[j].z * r * gg.z, v[j].w * r * gg.w); ((u32x2*)orow)[lane + 64 * j] = o; }
}

__device__ __forceinline__ void phase0(const Params& p, unsigned char* lds) {
    float* tile = (float*)lds;
    const int nblk = gridDim.x, blk = blockIdx.x;
    unsigned char* ws = p.ws;
    constexpr int I_WIN = 16 * 54, I_WOUT = 16 * 16, I_WQ = 16 * 32, I_WG = 16 * 16, I_WP = 4 * 16, I_W1 = 2 * 32;
    constexpr int NIT = I_WIN + I_WOUT + I_WQ + I_WG + I_WP + I_W1;
    for (int it = blk; it < NIT; it += nblk) {
        int r = it;
        if (r < I_WIN) { transpose_tile(p.in[3], 1024, DIN, (bf16*)(ws + WS_WINT), r / 54, r % 54, tile); continue; } r -= I_WIN;
        if (r < I_WOUT) { transpose_tile(p.in[12], 1024, 1024, (bf16*)(ws + WS_WOUTT), r / 16, r % 16, tile); continue; } r -= I_WOUT;
        if (r < I_WQ) { transpose_tile(p.in[14], 1024, 2048, (bf16*)(ws + WS_WQT), r / 32, r % 32, tile); continue; } r -= I_WQ;
        if (r < I_WG) { transpose_tile(p.in[20], 1024, 1024, (bf16*)(ws + WS_WGT), r / 16, r % 16, tile); continue; } r -= I_WG;
        if (r < I_WP) { transpose_tile(p.in[18], 256, 1024, (bf16*)(ws + WS_WPT), r / 16, r % 16, tile); continue; } r -= I_WP;
        { const int which = r / 32, kt = r % 32; transpose_tile(p.in[9] + (size_t)which * 2048 * 64, 2048, 64, (bf16*)(ws + WS_W1T) + (size_t)which * 64 * 2048, kt, 0, tile); }
    }
    const size_t gtid = (size_t)blk * NTHR + threadIdx.x, gthreads = (size_t)nblk * NTHR;
    cvt_range(p.in[16], (bf16*)(ws + WS_UB), (size_t)16384 * 1024 / 8, gtid, gthreads);
    cvt_range(p.in[17], (bf16*)(ws + WS_VB), (size_t)16384 * 1024 / 8, gtid, gthreads);
    cvt_range(p.in[15], (bf16*)(ws + WS_KEYB), (size_t)8 * 2 * 128 * 128 / 8, gtid, gthreads);
    cvt_range(p.in[1], (bf16*)(ws + WS_PB), (size_t)NTOK * 256 / 8, gtid, gthreads);
    const int gw = (int)(gtid >> 6), ngw = (int)(gthreads >> 6), lane = threadIdx.x & 63;
    for (int m = gw; m < NTOK; m += ngw) rms_row_bf16(p.in[0] + (size_t)m * D, p.in[2], (bf16*)(ws + WS_ACT) + (size_t)m * D, lane);
}

__device__ __forceinline__ int swz(int ob) { return ob ^ (((ob >> 9) & 1) << 5); }
constexpr int G_STAGE = 49152;
__device__ __forceinline__ void gemm_mainloop(f32x4 (&acc)[4][4], const bf16* __restrict__ A, int lda, const bf16* __restrict__ Bt, int ldb, int K, int m0, int n0, unsigned char* lds) {
    const int tid = threadIdx.x, lane = tid & 63, wid = tid >> 6, wm = wid >> 1, wn = wid & 1, fr = lane & 15, fq = lane >> 4;
    const int lrow = tid >> 3, lc = tid & 7;
    const bf16* ag = A + (size_t)(m0 + lrow) * lda + lc * 8;
    const bf16* bg = Bt + (size_t)(n0 + lrow) * ldb + lc * 8;
    const int woff = ((lrow >> 4) * 2 + (lc >> 2)) * 1024 + swz((lrow & 15) * 64 + (lc & 3) * 16);
    const int roff = swz(fr * 64 + fq * 16);
    const int nk = K >> 6;
    u32x4 ra[4], rb[2];
#pragma unroll
    for (int i = 0; i < 4; ++i) ra[i] = *(const u32x4*)(ag + (size_t)i * 64 * lda);
#pragma unroll
    for (int i = 0; i < 2; ++i) rb[i] = *(const u32x4*)(bg + (size_t)i * 64 * ldb);
#pragma unroll
    for (int i = 0; i < 4; ++i) *(u32x4*)(lds + woff + i * 8192) = ra[i];
#pragma unroll
    for (int i = 0; i < 2; ++i) *(u32x4*)(lds + 32768 + woff + i * 8192) = rb[i];
    __syncthreads();
    for (int kt = 0; kt < nk; ++kt) {
        unsigned char* cur = lds + (kt & 1) * G_STAGE; unsigned char* nxt = lds + ((kt + 1) & 1) * G_STAGE;
        const bool more = kt + 1 < nk;
        if (more) {
#pragma unroll
            for (int i = 0; i < 4; ++i) ra[i] = *(const u32x4*)(ag + (size_t)i * 64 * lda + (kt + 1) * 64);
#pragma unroll
            for (int i = 0; i < 2; ++i) rb[i] = *(const u32x4*)(bg + (size_t)i * 64 * ldb + (kt + 1) * 64);
        }
#pragma unroll
        for (int s = 0; s < 2; ++s) {
            bf16x8 af[4], bfr[4];
#pragma unroll
            for (int i = 0; i < 4; ++i) af[i] = *(const bf16x8*)(cur + ((wm * 4 + i) * 2 + s) * 1024 + roff);
#pragma unroll
            for (int i = 0; i < 4; ++i) bfr[i] = *(const bf16x8*)(cur + 32768 + ((wn * 4 + i) * 2 + s) * 1024 + roff);
#pragma unroll
            for (int mi = 0; mi < 4; ++mi)
#pragma unroll
                for (int ni = 0; ni < 4; ++ni) acc[mi][ni] = __builtin_amdgcn_mfma_f32_16x16x32_bf16(bfr[ni], af[mi], acc[mi][ni], 0, 0, 0);
        }
        if (more) {
#pragma unroll
            for (int i = 0; i < 4; ++i) *(u32x4*)(nxt + woff + i * 8192) = ra[i];
#pragma unroll
            for (int i = 0; i < 2; ++i) *(u32x4*)(nxt + 32768 + woff + i * 8192) = rb[i];
        }
        __syncthreads();
    }
}
__device__ __forceinline__ void acc_zero(f32x4 (&acc)[4][4]) {
#pragma unroll
    for (int i = 0; i < 4; ++i)
#pragma unroll
        for (int j = 0; j < 4; ++j) acc[i][j] = (f32x4){0.f, 0.f, 0.f, 0.f};
}
__device__ __forceinline__ void phase1(const Params& p, unsigned char* lds) {
    const bf16* A = (const bf16*)(p.ws + WS_ACT); const bf16* Bt = (const bf16*)(p.ws + WS_WINT); bf16* C = (bf16*)(p.ws + WS_PROJ);
    const int lane = threadIdx.x & 63, wid = threadIdx.x >> 6, wm = wid >> 1, wn = wid & 1, fr = lane & 15, fq = lane >> 4;
    constexpr int NT = 27, NTILES = 64 * NT;
    for (int t = blockIdx.x; t < NTILES; t += gridDim.x) {
        const int m0 = (t / NT) * 256, n0 = (t % NT) * 128;
        f32x4 acc[4][4]; acc_zero(acc);
        gemm_mainloop(acc, A, D, Bt, D, D, m0, n0, lds);
#pragma unroll
        for (int mi = 0; mi < 4; ++mi)
#pragma unroll
            for (int ni = 0; ni < 4; ++ni) {
                const int row = m0 + wm * 64 + mi * 16 + fr, col = n0 + wn * 64 + ni * 16 + fq * 4;
                if (col < DIN) { u32x2 o; o.x = pk2(acc[mi][ni][0], acc[mi][ni][1]); o.y = pk2(acc[mi][ni][2], acc[mi][ni][3]); *(u32x2*)(C + (size_t)row * PS + col) = o; }
            }
    }
}


__device__ __forceinline__ void phase5(const Params& p, unsigned char* lds) {
    const bf16* A = (const bf16*)(p.ws + WS_ACT); const bf16* Bt = (const bf16*)(p.ws + WS_WOUTT); const float* X = p.in[0]; float* O = p.out;
    const int lane = threadIdx.x & 63, wid = threadIdx.x >> 6, wm = wid >> 1, wn = wid & 1, fr = lane & 15, fq = lane >> 4;
    constexpr int NT = 8, NTILES = 64 * NT;
    for (int t = blockIdx.x; t < NTILES; t += gridDim.x) {
        const int m0 = (t / NT) * 256, n0 = (t % NT) * 128;
        f32x4 acc[4][4]; acc_zero(acc);
        gemm_mainloop(acc, A, D, Bt, D, D, m0, n0, lds);
#pragma unroll
        for (int mi = 0; mi < 4; ++mi)
#pragma unroll
            for (int ni = 0; ni < 4; ++ni) {
                const size_t idx = (size_t)(m0 + wm * 64 + mi * 16 + fr) * D + n0 + wn * 64 + ni * 16 + fq * 4;
                *(f32x4*)(O + idx) = *(const f32x4*)(X + idx) + acc[mi][ni];
            }
    }
}
__device__ __forceinline__ void phase6(const Params& p, unsigned char* lds) {
    const int gw = (blockIdx.x * NTHR + threadIdx.x) >> 6, ngw = (gridDim.x * NTHR) >> 6, lane = threadIdx.x & 63;
    for (int m = gw; m < NTOK; m += ngw) rms_row_bf16(p.out + (size_t)m * D, p.in[13], (bf16*)(p.ws + WS_ACT) + (size_t)m * D, lane);
}
__device__ __forceinline__ void phase7(const Params& p, unsigned char* lds) {
    const bf16* A = (const bf16*)(p.ws + WS_ACT); const bf16* Bt = (const bf16*)(p.ws + WS_WQT); bf16* C = (bf16*)(p.ws + WS_PROJ);
    const int lane = threadIdx.x & 63, wid = threadIdx.x >> 6, wm = wid >> 1, wn = wid & 1, fr = lane & 15, fq = lane >> 4;
    constexpr int NT = 16, NTILES = 64 * NT;
    for (int t = blockIdx.x; t < NTILES; t += gridDim.x) {
        const int m0 = (t / NT) * 256, n0 = (t % NT) * 128;
        f32x4 acc[4][4]; acc_zero(acc);
        gemm_mainloop(acc, A, D, Bt, D, D, m0, n0, lds);
#pragma unroll
        for (int mi = 0; mi < 4; ++mi)
#pragma unroll
            for (int ni = 0; ni < 4; ++ni) {
                const int row = m0 + wm * 64 + mi * 16 + fr, col = n0 + wn * 64 + ni * 16 + fq * 4;
                u32x2 o; o.x = pk2(acc[mi][ni][0], acc[mi][ni][1]); o.y = pk2(acc[mi][ni][2], acc[mi][ni][3]); *(u32x2*)(C + (size_t)row * 2048 + col) = o;
            }
    }
}
__device__ __forceinline__ void phase10(const Params& p, unsigned char* lds) {
    const bf16* A1 = (const bf16*)(p.ws + WS_PROJ + 64 * MiB); const bf16* B1 = (const bf16*)(p.ws + WS_WGT);
    const bf16* A2 = (const bf16*)(p.ws + WS_PB); const bf16* B2 = (const bf16*)(p.ws + WS_WPT); float* O = p.out;
    const int lane = threadIdx.x & 63, wid = threadIdx.x >> 6, wm = wid >> 1, wn = wid & 1, fr = lane & 15, fq = lane >> 4;
    constexpr int NT = 8, NTILES = 64 * NT;
    for (int t = blockIdx.x; t < NTILES; t += gridDim.x) {
        const int m0 = (t / NT) * 256, n0 = (t % NT) * 128;
        u32x2 gpk[4][4];
        {
            f32x4 accg[4][4]; acc_zero(accg);
            gemm_mainloop(accg, A1, D, B1, D, D, m0, n0, lds);
#pragma unroll
            for (int mi = 0; mi < 4; ++mi)
#pragma unroll
                for (int ni = 0; ni < 4; ++ni) { gpk[mi][ni].x = pk2(sigmoidf_(accg[mi][ni][0]), sigmoidf_(accg[mi][ni][1])); gpk[mi][ni].y = pk2(sigmoidf_(accg[mi][ni][2]), sigmoidf_(accg[mi][ni][3])); }
        }
        f32x4 accp[4][4]; acc_zero(accp);
        gemm_mainloop(accp, A2, 256, B2, 256, 256, m0, n0, lds);
#pragma unroll
        for (int mi = 0; mi < 4; ++mi)
#pragma unroll
            for (int ni = 0; ni < 4; ++ni) {
                const size_t idx = (size_t)(m0 + wm * 64 + mi * 16 + fr) * D + n0 + wn * 64 + ni * 16 + fq * 4;
                f32x4 g; g.x = __uint_as_float(gpk[mi][ni].x << 16); g.y = __uint_as_float(gpk[mi][ni].x & 0xffff0000u); g.z = __uint_as_float(gpk[mi][ni].y << 16); g.w = __uint_as_float(gpk[mi][ni].y & 0xffff0000u);
                *(f32x4*)(O + idx) = *(const f32x4*)(O + idx) + accp[mi][ni] * g;
            }
    }
}

typedef __bf16 bf16x2v __attribute__((ext_vector_type(2)));
template <int CTRL> __device__ __forceinline__ float dpp_f(float v) { return __int_as_float(__builtin_amdgcn_update_dpp(0, __float_as_int(v), CTRL, 0xF, 0xF, false)); }
__device__ __forceinline__ float grp16_max(float v) { v = fmaxf(v, dpp_f<0xB1>(v)); v = fmaxf(v, dpp_f<0x4E>(v)); v = fmaxf(v, dpp_f<0x141>(v)); v = fmaxf(v, dpp_f<0x140>(v)); return v; }
__device__ __forceinline__ float grp16_sum(float v) { v += dpp_f<0xB1>(v); v += dpp_f<0x4E>(v); v += dpp_f<0x141>(v); v += dpp_f<0x140>(v); return v; }
#define CE_DESC(a, b) { const float _hi = fmaxf(a, b), _lo = fminf(a, b); a = _hi; b = _lo; }
__device__ __forceinline__ float grp16_top16(float (&v)[8], int lig) {
    CE_DESC(v[0], v[1]) CE_DESC(v[2], v[3]) CE_DESC(v[4], v[5]) CE_DESC(v[6], v[7])
    CE_DESC(v[0], v[2]) CE_DESC(v[1], v[3]) CE_DESC(v[4], v[6]) CE_DESC(v[5], v[7])
    CE_DESC(v[1], v[2]) CE_DESC(v[5], v[6])
    CE_DESC(v[0], v[4]) CE_DESC(v[1], v[5]) CE_DESC(v[2], v[6]) CE_DESC(v[3], v[7])
    CE_DESC(v[2], v[4]) CE_DESC(v[3], v[5])
    CE_DESC(v[1], v[2]) CE_DESC(v[3], v[4]) CE_DESC(v[5], v[6])
    float top = 0.f;
#pragma unroll
    for (int r = 0; r < 16; ++r) {
        const float m = grp16_max(v[0]);
        if (lig == r) top = m;
        const bool own = (v[0] == m);
#pragma unroll
        for (int j = 0; j < 7; ++j) v[j] = own ? v[j + 1] : v[j];
        v[7] = own ? -3.0e38f : v[7];
    }
    return top;
}
__device__ __forceinline__ void phase8(const Params& p, unsigned char* lds) {
    const bf16* PQ = (const bf16*)(p.ws + WS_PROJ); const bf16* KB = (const bf16*)(p.ws + WS_KEYB);
    int* ids = (int*)(p.ws + WS_IDS); float* wts = (float*)(p.ws + WS_WTS);
    float* S = (float*)lds;
    const int tid = threadIdx.x, lane = tid & 63, wid = tid >> 6, lig = tid & 15, gbase = lane & 48;
    for (int item = blockIdx.x; item < 2048; item += gridDim.x) {
        const int tok0 = (item >> 3) * 64, h = item & 7;
        {
            const int c = wid >> 2, key0 = (wid & 3) * 32, r = lane & 31, hh = lane >> 5;
            f32x16 acc0, acc1;
#pragma unroll
            for (int i = 0; i < 16; ++i) { acc0[i] = 0.f; acc1[i] = 0.f; }
            const bf16* bq = KB + ((size_t)(h * 2 + c) * 128 + key0 + r) * 128 + hh * 8;
            const bf16* aq0 = PQ + (size_t)(tok0 + r) * 2048 + h * 256 + c * 128 + hh * 8;
            const bf16* aq1 = aq0 + (size_t)32 * 2048;
#pragma unroll
            for (int s = 0; s < 8; ++s) {
                const bf16x8 b = *(const bf16x8*)(bq + s * 16), a0 = *(const bf16x8*)(aq0 + s * 16), a1 = *(const bf16x8*)(aq1 + s * 16);
                acc0 = __builtin_amdgcn_mfma_f32_32x32x16_bf16(a0, b, acc0, 0, 0, 0);
                acc1 = __builtin_amdgcn_mfma_f32_32x32x16_bf16(a1, b, acc1, 0, 0, 0);
            }
#pragma unroll
            for (int i = 0; i < 16; ++i) { const int tl = (i & 3) + 8 * (i >> 2) + 4 * hh; S[(c * 64 + tl) * 132 + key0 + r] = acc0[i]; S[(c * 64 + 32 + tl) * 132 + key0 + r] = acc1[i]; }
        }
        __syncthreads();
#pragma unroll 1
        for (int rd = 0; rd < 2; ++rd) {
            const int tl = (tid >> 4) + 32 * rd;
            float ts[2];
#pragma unroll
            for (int c = 0; c < 2; ++c) {
                float v[8];
                const f32x4 lo = *(const f32x4*)(S + (c * 64 + tl) * 132 + lig * 8), hi = *(const f32x4*)(S + (c * 64 + tl) * 132 + lig * 8 + 4);
                v[0] = lo.x; v[1] = lo.y; v[2] = lo.z; v[3] = lo.w; v[4] = hi.x; v[5] = hi.y; v[6] = hi.z; v[7] = hi.w;
#pragma unroll
                for (int j = 0; j < 8; ++j) v[j] = __uint_as_float((__float_as_uint(v[j]) & ~127u) | (unsigned)(lig * 8 + j));
                ts[c] = grp16_top16(v, lig);
            }
            const float t0 = ts[0], t1 = ts[1];
            int bp = 0; float my_s = 0.f; int my_eid = 0;
#pragma unroll 1
            for (int r = 0; r < 16; ++r) {
                const float other = __shfl(t1, gbase + (bp < 15 ? bp : 15));
                const float sum = t0 + other;
                const float head = (bp >= 16) ? -3.0e38f : __uint_as_float((__float_as_uint(sum) & ~15u) | (unsigned)lig);
                const int cur_eid = (int)(((__float_as_uint(t0) & 127u) << 7) | (__float_as_uint(other) & 127u));
                const float m = grp16_max(head);
                const int owner = (int)(__float_as_uint(m) & 15u);
                const int ew = __shfl(cur_eid, gbase + owner);
                if (lig == r) { my_s = m; my_eid = ew; }
                if (lig == owner) ++bp;
            }
            const float mx = grp16_max(my_s);
            const float e = __expf(my_s - mx);
            const float sm = grp16_sum(e);
            const size_t o = (size_t)(tok0 + tl) * 128 + h * 16 + lig;
            ids[o] = my_eid; wts[o] = e / sm;
        }
        __syncthreads();
    }
}

__device__ __forceinline__ void hgrn_pre_item(const Params& p, unsigned char* lds, int ci) {
    const int tid = threadIdx.x, lane = tid & 63, wid = tid >> 6, k = tid & 127, tq = tid >> 7;
    const int n = ci & 127, h = (ci >> 7) & 3, b = ci >> 9, tok0 = b * T + n * 64;
    bf16* proj = (bf16*)(p.ws + WS_PROJ);
    float* OB = p.out; bf16* KIT = (bf16*)((unsigned char*)p.out + OUT_KIT) + (size_t)ci * 8192; bf16* VTg = (bf16*)((unsigned char*)p.out + OUT_VT) + (size_t)ci * 8192;
    float* DEC = (float*)(p.ws + WS_DEC) + (size_t)ci * 128;
    bf16* QT = (bf16*)lds; bf16* KT = (bf16*)(lds + 17408); bf16* VTl = (bf16*)(lds + 34816); bf16* AM = (bf16*)(lds + 53248);
    float* part = (float*)(lds + 62464); float* gref = (float*)(lds + 64512);
    float lb; { const float l0 = p.in[4][h * 128 + k], l1 = p.in[4][512 + h * 128 + k]; const float m = fmaxf(l0, l1); const float e0 = __expf(l0 - m), e1 = __expf(l1 - m); lb = e0 / (e0 + e1); }
    float G[16], key[16], qv[16], vv[16];
    {
        float c = 0.f;
#pragma unroll
        for (int i = 0; i < 16; ++i) {
            const size_t row = (size_t)(tok0 + tq * 16 + i) * PS;
            const float fg = lb + (1.0f - lb) * sigmoidf_(bf2f(proj[row + C_HF + h * 128 + k]));
            key[i] = 1.0f - fg; c += __logf(fg); G[i] = c;
            qv[i] = siluf_(bf2f(proj[row + C_HQ + h * 128 + k])) * 0.08838834764831845f;
            vv[i] = bf2f(proj[row + C_HI + h * 128 + k]);
        }
        part[tq * 128 + k] = c;
    }
    __syncthreads();
    {
        float off = 0.f;
#pragma unroll
        for (int j = 0; j < 3; ++j) off += (j < tq) ? part[j * 128 + k] : 0.f;
#pragma unroll
        for (int i = 0; i < 16; ++i) G[i] += off;
        if (tq == 1) gref[k] = G[15];
        if (tq == 3) gref[128 + k] = G[15];
    }
    __syncthreads();
    {
        const float gr = gref[k], gl = gref[128 + k];
        const int kpos = (k & ~31) | (((k >> 2) & 3) << 3) | (((k >> 4) & 1) << 2) | (k & 3);
        unsigned kp[8], vp[8];
#pragma unroll
        for (int i = 0; i < 16; i += 2) {
            kp[i >> 1] = pk2(key[i] * __expf(gl - G[i]), key[i + 1] * __expf(gl - G[i + 1]));
            vp[i >> 1] = pk2(vv[i], vv[i + 1]);
        }
#pragma unroll
        for (int i = 0; i < 16; ++i) {
            const int t = tq * 16 + i;
            QT[t * 136 + k] = f2bf(qv[i] * __expf(G[i] - gr));
            KT[t * 136 + k] = f2bf(key[i] * __expf(gr - G[i]));
            proj[(size_t)(tok0 + t) * PS + C_HQ + h * 128 + kpos] = f2bf(qv[i] * __expf(G[i]));
        }
        u32x4 a0, a1, b0, b1; a0.x = kp[0]; a0.y = kp[1]; a0.z = kp[2]; a0.w = kp[3]; a1.x = kp[4]; a1.y = kp[5]; a1.z = kp[6]; a1.w = kp[7];
        b0.x = vp[0]; b0.y = vp[1]; b0.z = vp[2]; b0.w = vp[3]; b1.x = vp[4]; b1.y = vp[5]; b1.z = vp[6]; b1.w = vp[7];
        *(u32x4*)(KIT + k * 64 + tq * 16) = a0; *(u32x4*)(KIT + k * 64 + tq * 16 + 8) = a1;
        *(u32x4*)(VTg + k * 64 + tq * 16) = b0; *(u32x4*)(VTg + k * 64 + tq * 16 + 8) = b1;
        *(u32x4*)(VTl + k * 72 + tq * 16) = b0; *(u32x4*)(VTl + k * 72 + tq * 16 + 8) = b1;
        if (tq == 3) DEC[k] = __expf(gl);
    }
    __syncthreads();
    const int fr = lane & 15, fq = lane >> 4;
    {
        const int tt = wid >> 1;
#pragma unroll
        for (int e = 0; e < 2; ++e) {
            const int st = 2 * (wid & 1) + e;
            f32x4 acc = (f32x4){0.f, 0.f, 0.f, 0.f};
            if (st <= tt) {
#pragma unroll
                for (int s = 0; s < 4; ++s) {
                    const bf16x8 a = *(const bf16x8*)(QT + (tt * 16 + fr) * 136 + s * 32 + fq * 8), bb = *(const bf16x8*)(KT + (st * 16 + fr) * 136 + s * 32 + fq * 8);
                    acc = __builtin_amdgcn_mfma_f32_16x16x32_bf16(a, bb, acc, 0, 0, 0);
                }
            }
#pragma unroll
            for (int r = 0; r < 4; ++r) { const int t = tt * 16 + fq * 4 + r, sp = st * 16 + fr; AM[t * 72 + sp] = f2bf(sp <= t ? acc[r] : 0.f); }
        }
    }
    __syncthreads();
    {
        const int tt = wid >> 1;
        const bf16x8 a0 = *(const bf16x8*)(AM + (tt * 16 + fr) * 72 + fq * 8), a1 = *(const bf16x8*)(AM + (tt * 16 + fr) * 72 + 32 + fq * 8);
#pragma unroll
        for (int e = 0; e < 4; ++e) {
            const int vt = (wid & 1) * 4 + e;
            const bf16x8 b0 = *(const bf16x8*)(VTl + (vt * 16 + fr) * 72 + fq * 8), b1 = *(const bf16x8*)(VTl + (vt * 16 + fr) * 72 + 32 + fq * 8);
            f32x4 acc = (f32x4){0.f, 0.f, 0.f, 0.f};
            acc = __builtin_amdgcn_mfma_f32_16x16x32_bf16(a0, b0, acc, 0, 0, 0);
            acc = __builtin_amdgcn_mfma_f32_16x16x32_bf16(a1, b1, acc, 0, 0, 0);
#pragma unroll
            for (int r = 0; r < 4; ++r) OB[(size_t)(tok0 + tt * 16 + fq * 4 + r) * 512 + h * 128 + vt * 16 + fr] = acc[r];
        }
    }
    __syncthreads();
}
__device__ __forceinline__ void hgrn_scan_item(const Params& p, int wi) {
    const int lane = threadIdx.x & 63, fr = lane & 15, fq = lane >> 4;
    const int vs = wi & 7, bh = wi >> 3, h = bh & 3, b = bh >> 2;
    const bf16* proj = (const bf16*)(p.ws + WS_PROJ);
    float* OB = p.out; const bf16* KIT = (const bf16*)((unsigned char*)p.out + OUT_KIT); const bf16* VTg = (const bf16*)((unsigned char*)p.out + OUT_VT);
    const float* DEC = (const float*)(p.ws + WS_DEC);
    f32x4 S[8];
#pragma unroll
    for (int i = 0; i < 8; ++i) S[i] = (f32x4){0.f, 0.f, 0.f, 0.f};
#pragma unroll 1
    for (int n = 0; n < 128; ++n) {
        const int ci = bh * 128 + n, tok0 = b * T + n * 64;
        bf16x8 qf[4][4];
#pragma unroll
        for (int tt = 0; tt < 4; ++tt)
#pragma unroll
            for (int s = 0; s < 4; ++s) qf[tt][s] = *(const bf16x8*)(proj + (size_t)(tok0 + tt * 16 + fr) * PS + C_HQ + h * 128 + s * 32 + fq * 8);
        float oin[4][4];
#pragma unroll
        for (int tt = 0; tt < 4; ++tt)
#pragma unroll
            for (int r = 0; r < 4; ++r) oin[tt][r] = OB[(size_t)(tok0 + tt * 16 + fq * 4 + r) * 512 + h * 128 + vs * 16 + fr];
        bf16x8 Sb[4];
#pragma unroll
        for (int s = 0; s < 4; ++s) {
            u32x4 w; w.x = pk2(S[2 * s][0], S[2 * s][1]); w.y = pk2(S[2 * s][2], S[2 * s][3]); w.z = pk2(S[2 * s + 1][0], S[2 * s + 1][1]); w.w = pk2(S[2 * s + 1][2], S[2 * s + 1][3]);
            Sb[s] = __builtin_bit_cast(bf16x8, w);
        }
#pragma unroll
        for (int tt = 0; tt < 4; ++tt) {
            f32x4 acc = (f32x4){0.f, 0.f, 0.f, 0.f};
#pragma unroll
            for (int s = 0; s < 4; ++s) acc = __builtin_amdgcn_mfma_f32_16x16x32_bf16(qf[tt][s], Sb[s], acc, 0, 0, 0);
#pragma unroll
            for (int r = 0; r < 4; ++r) OB[(size_t)(tok0 + tt * 16 + fq * 4 + r) * 512 + h * 128 + vs * 16 + fr] = oin[tt][r] + acc[r];
        }
        const bf16x8 v0 = *(const bf16x8*)(VTg + (size_t)ci * 8192 + (vs * 16 + fr) * 64 + fq * 8), v1 = *(const bf16x8*)(VTg + (size_t)ci * 8192 + (vs * 16 + fr) * 64 + 32 + fq * 8);
#pragma unroll
        for (int kb = 0; kb < 8; ++kb) {
            const bf16x8 k0 = *(const bf16x8*)(KIT + (size_t)ci * 8192 + (kb * 16 + fr) * 64 + fq * 8), k1 = *(const bf16x8*)(KIT + (size_t)ci * 8192 + (kb * 16 + fr) * 64 + 32 + fq * 8);
            const f32x4 dv = *(const f32x4*)(DEC + (size_t)ci * 128 + kb * 16 + fq * 4);
            f32x4 sacc = S[kb] * dv;
            sacc = __builtin_amdgcn_mfma_f32_16x16x32_bf16(k0, v0, sacc, 0, 0, 0);
            sacc = __builtin_amdgcn_mfma_f32_16x16x32_bf16(k1, v1, sacc, 0, 0, 0);
            S[kb] = sacc;
        }
    }
}
__device__ __forceinline__ void phase4(const Params& p, unsigned char* lds) {
    const bf16* proj = (const bf16*)(p.ws + WS_PROJ); const float* OB = p.out; bf16* mixed = (bf16*)(p.ws + WS_ACT); const float* gain = p.in[5];
    const int lane = threadIdx.x & 63, gw = (blockIdx.x * NTHR + threadIdx.x) >> 6, ngw = (gridDim.x * NTHR) >> 6;
    for (int tok = gw; tok < NTOK; tok += ngw) {
        const f32x4 o0 = *(const f32x4*)(OB + (size_t)tok * 512 + lane * 8), o1 = *(const f32x4*)(OB + (size_t)tok * 512 + lane * 8 + 4);
        const u32x4 gp = *(const u32x4*)(proj + (size_t)tok * PS + C_HG + lane * 8);
        const f32x4 g0 = *(const f32x4*)(gain + lane * 8), g1 = *(const f32x4*)(gain + lane * 8 + 4);
        float ss = o0.x * o0.x + o0.y * o0.y + o0.z * o0.z + o0.w * o0.w + o1.x * o1.x + o1.y * o1.y + o1.z * o1.z + o1.w * o1.w;
        ss = grp16_sum(ss);
        const float r = rsqrtf(ss * (1.0f / 128.0f) + EPS);
        const unsigned gx = gp.x, gy = gp.y, gz = gp.z, gw_ = gp.w;
        u32x4 w;
        w.x = pk2(o0.x * r * g0.x * siluf_(__uint_as_float(gx << 16)), o0.y * r * g0.y * siluf_(__uint_as_float(gx & 0xffff0000u)));
        w.y = pk2(o0.z * r * g0.z * siluf_(__uint_as_float(gy << 16)), o0.w * r * g0.w * siluf_(__uint_as_float(gy & 0xffff0000u)));
        w.z = pk2(o1.x * r * g1.x * siluf_(__uint_as_float(gz << 16)), o1.y * r * g1.y * siluf_(__uint_as_float(gz & 0xffff0000u)));
        w.w = pk2(o1.z * r * g1.z * siluf_(__uint_as_float(gw_ << 16)), o1.w * r * g1.w * siluf_(__uint_as_float(gw_ & 0xffff0000u)));
        *(u32x4*)(mixed + (size_t)tok * D + lane * 8) = w;
    }
}

#define WAVE_LDS_SYNC() asm volatile("s_waitcnt lgkmcnt(0)" ::: "memory")
__device__ __forceinline__ void nsa_prep_item(const Params& p, unsigned char* lds, int tile) {
    const int tid = threadIdx.x, lig = tid & 15;
    const int tok0 = tile * 64;
    bf16* proj = (bf16*)(p.ws + WS_PROJ);
    for (int rho = tid >> 4; rho < 768; rho += 32) {
        const int tl = rho / 12, which = rho - tl * 12;
        int col; const float* gain; float sc = 1.0f;
        if (which < 8) { col = C_NQ + which * 64; gain = p.in[6]; sc = 0.125f; }
        else if (which < 10) { col = C_KS + (which - 8) * 64; gain = p.in[7] + 64; }
        else { col = C_KW + (which - 10) * 64; gain = p.in[7] + 128; }
        bf16* rp = proj + (size_t)(tok0 + tl) * PS + col + lig * 4;
        const u32x2 raw = *(const u32x2*)rp;
        const unsigned r0 = raw.x, r1 = raw.y;
        const float a = __uint_as_float(r0 << 16), b = __uint_as_float(r0 & 0xffff0000u), c = __uint_as_float(r1 << 16), d = __uint_as_float(r1 & 0xffff0000u);
        const float ss = grp16_sum(a * a + b * b + c * c + d * d);
        const float r = rsqrtf(ss * (1.0f / 64.0f) + EPS) * sc;
        const f32x4 gg = *(const f32x4*)(gain + lig * 4);
        u32x2 o; o.x = pk2(a * r * gg.x, b * r * gg.y); o.y = pk2(c * r * gg.z, d * r * gg.w);
        *(u32x2*)rp = o;
    }
    {
        const int c = tid & 127, tq = tid >> 7, g = c >> 6, d = c & 63, b = tok0 / T, t0 = tok0 % T;
#pragma unroll
        for (int which = 0; which < 2; ++which) {
            const int col = (which == 0 ? C_VS : C_VW) + c;
            unsigned w[8];
#pragma unroll
            for (int i = 0; i < 16; i += 2) w[i >> 1] = (unsigned)proj[(size_t)(tok0 + tq * 16 + i) * PS + col] | ((unsigned)proj[(size_t)(tok0 + tq * 16 + i + 1) * PS + col] << 16);
            bf16* dst = (bf16*)(p.ws + (which == 0 ? WS_VTS : WS_VTW)) + ((size_t)(b * 2 + g) * 64 + d) * T + t0 + tq * 16;
            u32x4 a0, a1; a0.x = w[0]; a0.y = w[1]; a0.z = w[2]; a0.w = w[3]; a1.x = w[4]; a1.y = w[5]; a1.z = w[6]; a1.w = w[7];
            *(u32x4*)dst = a0; *(u32x4*)(dst + 8) = a1;
        }
    }
}
__device__ __forceinline__ void nsa_cmp_item(const Params& p, unsigned char* lds, int item) {
    const int tid = threadIdx.x, lane = tid & 63, wid = tid >> 6, fr = lane & 15, fq = lane >> 4;
    const int nt32 = item & 15, g = (item >> 4) & 1, b = (item >> 5) & 1, which = item >> 6, n0 = nt32 * 32;
    const bf16* proj = (const bf16*)(p.ws + WS_PROJ);
    const float* pe = p.in[8] + which * 2048;
    const bf16* W1T = (const bf16*)(p.ws + WS_W1T) + (size_t)which * 64 * 2048;
    const float* w2 = p.in[10] + which * 4096;
    bf16* A = (bf16*)lds; float* H = (float*)(lds + 33280);
    const int col0 = (which == 0 ? C_KC : C_VC) + g * 64;
    const int nt = wid & 1, ct = wid >> 1;
    f32x4 acc = (f32x4){0.f, 0.f, 0.f, 0.f};
#pragma unroll 1
    for (int kc = 0; kc < 4; ++kc) {
#pragma unroll
        for (int i = 0; i < 4; ++i) {
            const int idx = tid + i * NTHR, dch = idx & 7, jj = (idx >> 3) & 7, n = idx >> 6, j = kc * 8 + jj;
            u32x4 o = (u32x4){0u, 0u, 0u, 0u};
            if (n0 + n < NCMP) {
                const u32x4 raw = *(const u32x4*)(proj + (size_t)(b * T + 16 * (n0 + n) + j) * PS + col0 + dch * 8);
                const f32x4 p0 = *(const f32x4*)(pe + j * 64 + dch * 8), p1 = *(const f32x4*)(pe + j * 64 + dch * 8 + 4);
                const unsigned r0 = raw.x, r1 = raw.y, r2 = raw.z, r3 = raw.w;
                o.x = pk2(__uint_as_float(r0 << 16) + p0.x, __uint_as_float(r0 & 0xffff0000u) + p0.y);
                o.y = pk2(__uint_as_float(r1 << 16) + p0.z, __uint_as_float(r1 & 0xffff0000u) + p0.w);
                o.z = pk2(__uint_as_float(r2 << 16) + p1.x, __uint_as_float(r2 & 0xffff0000u) + p1.y);
                o.w = pk2(__uint_as_float(r3 << 16) + p1.z, __uint_as_float(r3 & 0xffff0000u) + p1.w);
            }
            *(u32x4*)(A + n * 520 + jj * 64 + dch * 8) = o;
        }
        __syncthreads();
#pragma unroll 4
        for (int s = 0; s < 16; ++s) {
            const bf16x8 a = *(const bf16x8*)(A + (nt * 16 + fr) * 520 + s * 32 + fq * 8);
            const bf16x8 bb = *(const bf16x8*)(W1T + (size_t)(ct * 16 + fr) * 2048 + kc * 512 + s * 32 + fq * 8);
            acc = __builtin_amdgcn_mfma_f32_16x16x32_bf16(a, bb, acc, 0, 0, 0);
        }
        __syncthreads();
    }
#pragma unroll
    for (int r = 0; r < 4; ++r) H[(nt * 16 + fq * 4 + r) * 64 + ct * 16 + fr] = gelu_tanh(acc[r]);
    __syncthreads();
    {
        const int n = tid >> 4, c = (tid & 15) * 4;
        f32x4 o = (f32x4){0.f, 0.f, 0.f, 0.f};
#pragma unroll 8
        for (int i = 0; i < 64; ++i) { const float hv = H[n * 64 + i]; const f32x4 w = *(const f32x4*)(w2 + i * 64 + c); o += hv * w; }
        if (which == 0) {
            const float ss = grp16_sum(o.x * o.x + o.y * o.y + o.z * o.z + o.w * o.w);
            const float r = rsqrtf(ss * (1.0f / 64.0f) + EPS);
            const f32x4 gg = *(const f32x4*)(p.in[7] + c);
            o = o * r * gg;
        }
        if (n0 + n >= NCMP) o = (f32x4){0.f, 0.f, 0.f, 0.f};
        if (which == 0) { u32x2 w; w.x = pk2(o.x, o.y); w.y = pk2(o.z, o.w); *(u32x2*)((bf16*)(p.ws + WS_KC) + ((size_t)(b * 2 + g) * 512 + n0 + n) * 64 + c) = w; }
        else { bf16* vt = (bf16*)(p.ws + WS_VCT) + (size_t)(b * 2 + g) * 64 * 512 + n0 + n; vt[(c + 0) * 512] = f2bf(o.x); vt[(c + 1) * 512] = f2bf(o.y); vt[(c + 2) * 512] = f2bf(o.z); vt[(c + 3) * 512] = f2bf(o.w); }
    }
    __syncthreads();
}

__device__ __forceinline__ int rho16(int reg, int hh) { return (reg & 3) + 8 * (reg >> 2) + 4 * hh; }
__device__ __forceinline__ bf16x8 pack8(const float* pv) {
    u32x4 w; w.x = pk2(pv[0], pv[1]); w.y = pk2(pv[2], pv[3]); w.z = pk2(pv[4], pv[5]); w.w = pk2(pv[6], pv[7]);
    return __builtin_bit_cast(bf16x8, w);
}
__device__ __forceinline__ f32x16 score_tile(const bf16* kp, const bf16x8 (&qf)[4]) {
    f32x16 st;
#pragma unroll
    for (int i = 0; i < 16; ++i) st[i] = 0.f;
#pragma unroll
    for (int s = 0; s < 4; ++s) { const bf16x8 kf = *(const bf16x8*)(kp + s * 16); st = __builtin_amdgcn_mfma_f32_32x32x16_bf16(kf, qf[s], st, 0, 0, 0); }
    return st;
}
__device__ __forceinline__ void pv_tile(f32x16& o0, f32x16& o1, const bf16* vp, size_t vstride32, const float* pv) {
    const bf16x8 p0 = pack8(pv), p1 = pack8(pv + 8);
#pragma unroll
    for (int dt = 0; dt < 2; ++dt) {
        const bf16* v = vp + (size_t)dt * vstride32;
        const u32x2 a0 = *(const u32x2*)(v), a1 = *(const u32x2*)(v + 8), b0 = *(const u32x2*)(v + 16), b1 = *(const u32x2*)(v + 24);
        u32x4 w0, w1; w0.x = a0.x; w0.y = a0.y; w0.z = a1.x; w0.w = a1.y; w1.x = b0.x; w1.y = b0.y; w1.z = b1.x; w1.w = b1.y;
        if (dt == 0) { o0 = __builtin_amdgcn_mfma_f32_32x32x16_bf16(__builtin_bit_cast(bf16x8, w0), p0, o0, 0, 0, 0); o0 = __builtin_amdgcn_mfma_f32_32x32x16_bf16(__builtin_bit_cast(bf16x8, w1), p1, o0, 0, 0, 0); }
        else { o1 = __builtin_amdgcn_mfma_f32_32x32x16_bf16(__builtin_bit_cast(bf16x8, w0), p0, o1, 0, 0, 0); o1 = __builtin_amdgcn_mfma_f32_32x32x16_bf16(__builtin_bit_cast(bf16x8, w1), p1, o1, 0, 0, 0); }
    }
}
__device__ __forceinline__ void softmax_step(float* sv, float& m, float& l, f32x16& o0, f32x16& o1) {
    float ml = sv[0];
#pragma unroll
    for (int i = 1; i < 16; ++i) ml = fmaxf(ml, sv[i]);
    ml = fmaxf(ml, __shfl_xor(ml, 32));
    const float mn = fmaxf(m, ml), alpha = __expf(m - mn);
    m = mn;
    float ps = 0.f;
#pragma unroll
    for (int i = 0; i < 16; ++i) { const float e = (sv[i] > -1e29f) ? __expf(sv[i] - mn) : 0.f; sv[i] = e; ps += e; }
    l = l * alpha + ps;
#pragma unroll
    for (int i = 0; i < 16; ++i) { o0[i] *= alpha; o1[i] *= alpha; }
}
__device__ __forceinline__ void nsa_attn_item(const Params& p, unsigned char* wlds, int item) {
    const int lane = threadIdx.x & 63, c = lane & 31, hh = lane >> 5, jt = c >> 2, r4 = c & 3;
    const int oct = item & 1023, g = (item >> 10) & 1, b = item >> 11;
    const int t0 = oct * 8, tc = t0 + jt, h = g * 4 + r4;
    const float slope = exp2f(-(float)(h + 1));
    const bf16* proj = (const bf16*)(p.ws + WS_PROJ);
    float* impA = (float*)wlds; float* impB = impA + 1024; unsigned* msk = (unsigned*)(impB + 1024);
#pragma unroll
    for (int i = 0; i < 16; ++i) { impA[lane + 64 * i] = 0.f; impB[lane + 64 * i] = 0.f; }
    if (lane < 32) msk[lane] = 0u;
    bf16x8 qf[4];
    { const bf16* qp = proj + (size_t)(b * T + tc) * PS + C_NQ + h * 64 + hh * 8;
#pragma unroll
      for (int s = 0; s < 4; ++s) qf[s] = *(const bf16x8*)(qp + s * 16); }
    f32x16 oc0, oc1;
#pragma unroll
    for (int i = 0; i < 16; ++i) { oc0[i] = 0.f; oc1[i] = 0.f; }
    float gate[3];
    { const bf16* gp = proj + (size_t)(b * T + tc) * PS + C_GT + h * 3;
#pragma unroll
      for (int i = 0; i < 3; ++i) gate[i] = sigmoidf_(bf2f(gp[i])); }
    WAVE_LDS_SYNC();
    {
        const bf16* KC = (const bf16*)(p.ws + WS_KC) + (size_t)(b * 2 + g) * 512 * 64;
        const bf16* VCT = (const bf16*)(p.ws + WS_VCT) + (size_t)(b * 2 + g) * 64 * 512;
        const int nmax = (t0 + 7 >= 31) ? ((t0 + 7 - 31) >> 4) : -1;
        float m = -1e30f, l = 0.f;
        f32x16 o0, o1;
#pragma unroll
        for (int i = 0; i < 16; ++i) { o0[i] = 0.f; o1[i] = 0.f; }
#pragma unroll 1
        for (int n0 = 0; n0 <= nmax; n0 += 32) {
            const f32x16 st = score_tile(KC + (size_t)(n0 + c) * 64 + hh * 8, qf);
            float sv[16];
#pragma unroll
            for (int i = 0; i < 16; ++i) { const int dist = tc - (16 * (n0 + rho16(i, hh)) + 31); sv[i] = (dist >= 0) ? st[i] - slope * (float)dist : -1e30f; }
            float ml = sv[0];
#pragma unroll
            for (int i = 1; i < 16; ++i) ml = fmaxf(ml, sv[i]);
            ml = fmaxf(ml, __shfl_xor(ml, 32));
            const float mn = fmaxf(m, ml); float ps = 0.f;
#pragma unroll
            for (int i = 0; i < 16; ++i) ps += (sv[i] > -1e29f) ? __expf(sv[i] - mn) : 0.f;
            l = l * __expf(m - mn) + ps; m = mn;
        }
        l += __shfl_xor(l, 32);
        const float inv = 1.0f / fmaxf(l, 1e-30f);
#pragma unroll 1
        for (int n0 = 0; n0 <= nmax; n0 += 32) {
            const f32x16 st = score_tile(KC + (size_t)(n0 + c) * 64 + hh * 8, qf);
            float pv[16];
#pragma unroll
            for (int i = 0; i < 16; ++i) { const int dist = tc - (16 * (n0 + rho16(i, hh)) + 31); pv[i] = (dist >= 0) ? __expf(st[i] - slope * (float)dist - m) * inv : 0.f; }
            pv_tile(o0, o1, VCT + (size_t)c * 512 + n0 + 4 * hh, (size_t)32 * 512, pv);
#pragma unroll
            for (int i = 0; i < 16; ++i) { float v = pv[i]; v += dpp_f<0xB1>(v); v += dpp_f<0x4E>(v); pv[i] = v; }
            if (r4 == 0) {
#pragma unroll
                for (int rg = 0; rg < 4; ++rg) {
                    const int jb = (n0 >> 2) + 2 * rg + hh;
                    impA[jt * 128 + jb] = pv[4 * rg] + 2.f * pv[4 * rg + 1] + 2.f * pv[4 * rg + 2] + 2.f * pv[4 * rg + 3];
                    if (jb >= 1) impB[jt * 128 + jb - 1] = pv[4 * rg];
                }
            }
        }
#pragma unroll
        for (int i = 0; i < 16; ++i) { oc0[i] = gate[0] * o0[i]; oc1[i] = gate[0] * o1[i]; }
    }
    WAVE_LDS_SYNC();
    {
        const int lig = lane & 15, grp = lane >> 4;
#pragma unroll 1
        for (int half = 0; half < 2; ++half) {
            const int j2 = half * 4 + grp, cur = (t0 + j2) >> 6;
            float v[8];
#pragma unroll
            for (int e = 0; e < 8; ++e) {
                const int j = lig * 8 + e; const float val = impA[j2 * 128 + j] + impB[j2 * 128 + j];
                v[e] = (j >= 1 && j <= cur - 2) ? __uint_as_float((__float_as_uint(val) & ~127u) | (unsigned)(127 - j)) : -1.0f;
            }
            const float top = grp16_top16(v, lig);
            const int need = 16 - ((cur == 0) ? 1 : (cur == 1) ? 2 : 3);
            if (lig < need && top >= 0.f) { const int idx = 127 - (int)(__float_as_uint(top) & 127u); atomicOr(&msk[j2 * 4 + (idx >> 5)], 1u << (idx & 31)); }
            if (lig == 0) { atomicOr(&msk[j2 * 4], 1u); atomicOr(&msk[j2 * 4 + (cur >> 5)], 1u << (cur & 31)); if (cur >= 1) atomicOr(&msk[j2 * 4 + ((cur - 1) >> 5)], 1u << ((cur - 1) & 31)); }
        }
    }
    WAVE_LDS_SYNC();
    {
        unsigned mym[4], um[4];
#pragma unroll
        for (int w = 0; w < 4; ++w) { mym[w] = msk[jt * 4 + w]; unsigned u = 0u;
#pragma unroll
            for (int j = 0; j < 8; ++j) u |= msk[j * 4 + w];
            um[w] = (unsigned)__builtin_amdgcn_readfirstlane((int)u); }
        const bf16* VTS = (const bf16*)(p.ws + WS_VTS) + (size_t)(b * 2 + g) * 64 * T;
        float m = -1e30f, l = 0.f;
        f32x16 o0, o1;
#pragma unroll
        for (int i = 0; i < 16; ++i) { o0[i] = 0.f; o1[i] = 0.f; }
#pragma unroll
        for (int w = 0; w < 4; ++w) {
            unsigned u = um[w];
#pragma unroll 1
            while (u) {
                const int bit = __builtin_ctz(u); u &= u - 1u;
                const int jb = w * 32 + bit;
                const bool colsel = (mym[w] >> bit) & 1u;
#pragma unroll 1
                for (int hf = 0; hf < 2; ++hf) {
                    const int key0 = jb * 64 + hf * 32;
                    const f32x16 st = score_tile(proj + (size_t)(b * T + key0 + c) * PS + C_KS + g * 64 + hh * 8, qf);
                    float sv[16];
#pragma unroll
                    for (int i = 0; i < 16; ++i) { const int dist = tc - (key0 + rho16(i, hh)); sv[i] = (colsel && dist >= 0) ? st[i] - slope * (float)dist : -1e30f; }
                    softmax_step(sv, m, l, o0, o1);
                    pv_tile(o0, o1, VTS + (size_t)c * T + key0 + 4 * hh, (size_t)32 * T, sv);
                }
            }
        }
        l += __shfl_xor(l, 32);
        const float sc = gate[1] / fmaxf(l, 1e-30f);
#pragma unroll
        for (int i = 0; i < 16; ++i) { oc0[i] += sc * o0[i]; oc1[i] += sc * o1[i]; }
    }
    {
        const bf16* VTW = (const bf16*)(p.ws + WS_VTW) + (size_t)(b * 2 + g) * 64 * T;
        float m = -1e30f, l = 0.f;
        f32x16 o0, o1;
#pragma unroll
        for (int i = 0; i < 16; ++i) { o0[i] = 0.f; o1[i] = 0.f; }
        const int kstart = (t0 - 511 > 0 ? t0 - 511 : 0) & ~31;
#pragma unroll 1
        for (int key0 = kstart; key0 <= t0 + 7; key0 += 32) {
            const f32x16 st = score_tile(proj + (size_t)(b * T + key0 + c) * PS + C_KW + g * 64 + hh * 8, qf);
            float sv[16];
#pragma unroll
            for (int i = 0; i < 16; ++i) { const int dist = tc - (key0 + rho16(i, hh)); sv[i] = (dist >= 0 && dist < 512) ? st[i] - slope * (float)dist : -1e30f; }
            softmax_step(sv, m, l, o0, o1);
            pv_tile(o0, o1, VTW + (size_t)c * T + key0 + 4 * hh, (size_t)32 * T, sv);
        }
        l += __shfl_xor(l, 32);
        const float sc = gate[2] / fmaxf(l, 1e-30f);
#pragma unroll
        for (int i = 0; i < 16; ++i) { oc0[i] += sc * o0[i]; oc1[i] += sc * o1[i]; }
    }
    {
        float ss = 0.f;
#pragma unroll
        for (int i = 0; i < 16; ++i) ss += oc0[i] * oc0[i] + oc1[i] * oc1[i];
        ss += __shfl_xor(ss, 32);
        const float r = rsqrtf(ss * (1.0f / 64.0f) + EPS);
        const float* og = p.in[11] + h * 64;
        bf16* op = (bf16*)(p.ws + WS_ACT) + (size_t)(b * T + tc) * D + 512 + h * 64;
#pragma unroll
        for (int dt = 0; dt < 2; ++dt)
#pragma unroll
            for (int rg = 0; rg < 4; ++rg) {
                const int d0 = dt * 32 + 8 * rg + 4 * hh;
                const f32x4 gg = *(const f32x4*)(og + d0);
                u32x2 w;
                if (dt == 0) { w.x = pk2(oc0[4 * rg] * r * gg.x, oc0[4 * rg + 1] * r * gg.y); w.y = pk2(oc0[4 * rg + 2] * r * gg.z, oc0[4 * rg + 3] * r * gg.w); }
                else { w.x = pk2(oc1[4 * rg] * r * gg.x, oc1[4 * rg + 1] * r * gg.y); w.y = pk2(oc1[4 * rg + 2] * r * gg.z, oc1[4 * rg + 3] * r * gg.w); }
                *(u32x2*)(op + d0) = w;
            }
    }
    WAVE_LDS_SYNC();
}
__device__ __forceinline__ void phase2(const Params& p, unsigned char* lds) {
    for (int it = blockIdx.x; it < 128 + 256 + 1024; it += gridDim.x) {
        if (it < 128) nsa_cmp_item(p, lds, it);
        else if (it < 384) nsa_prep_item(p, lds, it - 128);
        else hgrn_pre_item(p, lds, it - 384);
    }
}
__device__ __forceinline__ void phase3(const Params& p, unsigned char* lds) {
    const int gw = (blockIdx.x * NTHR + threadIdx.x) >> 6;
    const int wid = threadIdx.x >> 6;
    if (wid == 0 && blockIdx.x < 64) hgrn_scan_item(p, blockIdx.x);
    const int ngw = (gridDim.x * NTHR) >> 6;
    for (int it = gw; it < 4096; it += ngw) nsa_attn_item(p, lds + wid * 8320, 4095 - it);
}

__device__ __forceinline__ float dot2u(unsigned a, unsigned b, float acc) { return __builtin_amdgcn_fdot2_f32_bf16(__builtin_bit_cast(bf16x2v, a), __builtin_bit_cast(bf16x2v, b), acc, false); }
__device__ __forceinline__ float dot8(u32x4 a, u32x4 b, float acc) {
    const unsigned a0 = a.x, a1 = a.y, a2 = a.z, a3 = a.w, b0 = b.x, b1 = b.y, b2 = b.z, b3 = b.w;
    acc = dot2u(a0, b0, acc); acc = dot2u(a1, b1, acc); acc = dot2u(a2, b2, acc); acc = dot2u(a3, b3, acc);
    return acc;
}
__device__ __forceinline__ void axpy8(float (&o)[8], float c, u32x4 v) {
    o[0] += c * __uint_as_float(v.x << 16); o[1] += c * __uint_as_float(v.x & 0xffff0000u);
    o[2] += c * __uint_as_float(v.y << 16); o[3] += c * __uint_as_float(v.y & 0xffff0000u);
    o[4] += c * __uint_as_float(v.z << 16); o[5] += c * __uint_as_float(v.z & 0xffff0000u);
    o[6] += c * __uint_as_float(v.w << 16); o[7] += c * __uint_as_float(v.w & 0xffff0000u);
}
__device__ __forceinline__ void phase9(const Params& p, unsigned char* lds) {
    const bf16* HN = (const bf16*)(p.ws + WS_ACT); const bf16* UB = (const bf16*)(p.ws + WS_UB); const bf16* VB = (const bf16*)(p.ws + WS_VB);
    const int* ids = (const int*)(p.ws + WS_IDS); const float* wts = (const float*)(p.ws + WS_WTS);
    float* O = p.out; bf16* HG = (bf16*)(p.ws + WS_PROJ + 64 * MiB); const float* gn = p.in[19];
    const int lane = threadIdx.x & 63, gw = (blockIdx.x * NTHR + threadIdx.x) >> 6, ngw = (gridDim.x * NTHR) >> 6;
    for (int tok = gw; tok < NTOK; tok += ngw) {
        const u32x4 x0 = *(const u32x4*)(HN + (size_t)tok * D + lane * 8), x1 = *(const u32x4*)(HN + (size_t)tok * D + 512 + lane * 8);
        float oa[8], ob[8];
#pragma unroll
        for (int j = 0; j < 8; ++j) { oa[j] = 0.f; ob[j] = 0.f; }
#pragma unroll 1
        for (int half = 0; half < 2; ++half) {
            const int myid = ids[(size_t)tok * 128 + half * 64 + lane]; const float myw = wts[(size_t)tok * 128 + half * 64 + lane];
#pragma unroll 1
            for (int eb = 0; eb < 64; eb += 8) {
                int id[8]; float d[8];
#pragma unroll
                for (int j = 0; j < 8; ++j) id[j] = __shfl(myid, eb + j);
                u32x4 ua[8], ub[8];
#pragma unroll
                for (int j = 0; j < 8; ++j) { const bf16* ur = UB + (size_t)id[j] * D; ua[j] = *(const u32x4*)(ur + lane * 8); ub[j] = *(const u32x4*)(ur + 512 + lane * 8); }
#pragma unroll
                for (int j = 0; j < 8; ++j) { d[j] = dot8(ub[j], x1, dot8(ua[j], x0, 0.f)); }
#pragma unroll
                for (int j = 0; j < 8; ++j) { const bf16* vr = VB + (size_t)id[j] * D; ua[j] = *(const u32x4*)(vr + lane * 8); ub[j] = *(const u32x4*)(vr + 512 + lane * 8); }
#pragma unroll
                for (int j = 0; j < 8; ++j) d[j] = wave_sum(d[j]);
#pragma unroll
                for (int j = 0; j < 8; ++j) { const float c = __shfl(myw, eb + j) * gelu_tanh(d[j]); axpy8(oa, c, ua[j]); axpy8(ob, c, ub[j]); }
            }
        }
        float* orow = O + (size_t)tok * D;
        f32x4 h0 = *(const f32x4*)(orow + lane * 8), h1 = *(const f32x4*)(orow + lane * 8 + 4), h2 = *(const f32x4*)(orow + 512 + lane * 8), h3 = *(const f32x4*)(orow + 512 + lane * 8 + 4);
        h0.x += oa[0]; h0.y += oa[1]; h0.z += oa[2]; h0.w += oa[3]; h1.x += oa[4]; h1.y += oa[5]; h1.z += oa[6]; h1.w += oa[7];
        h2.x += ob[0]; h2.y += ob[1]; h2.z += ob[2]; h2.w += ob[3]; h3.x += ob[4]; h3.y += ob[5]; h3.z += ob[6]; h3.w += ob[7];
        *(f32x4*)(orow + lane * 8) = h0; *(f32x4*)(orow + lane * 8 + 4) = h1; *(f32x4*)(orow + 512 + lane * 8) = h2; *(f32x4*)(orow + 512 + lane * 8 + 4) = h3;
        float ss = h0.x * h0.x + h0.y * h0.y + h0.z * h0.z + h0.w * h0.w + h1.x * h1.x + h1.y * h1.y + h1.z * h1.z + h1.w * h1.w
                 + h2.x * h2.x + h2.y * h2.y + h2.z * h2.z + h2.w * h2.w + h3.x * h3.x + h3.y * h3.y + h3.z * h3.z + h3.w * h3.w;
        ss = wave_sum(ss);
        const float r = rsqrtf(ss * (1.0f / D) + EPS);
        const f32x4 g0 = *(const f32x4*)(gn + lane * 8), g1 = *(const f32x4*)(gn + lane * 8 + 4), g2 = *(const f32x4*)(gn + 512 + lane * 8), g3 = *(const f32x4*)(gn + 512 + lane * 8 + 4);
        u32x4 q0, q1;
        q0.x = pk2(h0.x * r * g0.x, h0.y * r * g0.y); q0.y = pk2(h0.z * r * g0.z, h0.w * r * g0.w); q0.z = pk2(h1.x * r * g1.x, h1.y * r * g1.y); q0.w = pk2(h1.z * r * g1.z, h1.w * r * g1.w);
        q1.x = pk2(h2.x * r * g2.x, h2.y * r * g2.y); q1.y = pk2(h2.z * r * g2.z, h2.w * r * g2.w); q1.z = pk2(h3.x * r * g3.x, h3.y * r * g3.y); q1.w = pk2(h3.z * r * g3.z, h3.w * r * g3.w);
        *(u32x4*)(HG + (size_t)tok * D + lane * 8) = q0; *(u32x4*)(HG + (size_t)tok * D + 512 + lane * 8) = q1;
    }
}

#define XB_TMO      128
#define XB_XCNT(j)  (256  + 64 * (j))
#define XB_XSUB(j)  (1280 + 64 * (j))
#define XB_XGEN(j)  (2304 + 64 * (j))
#define XB_TOP      3328
#define XB_TOPGEN   3392
#define XCD_BAR_WORDS 3456
#define XB_SPIN_CAP (1u << 18)
#define LAS __attribute__((address_space(3)))
__device__ __forceinline__ unsigned xb_ld(unsigned* p)              { return __hip_atomic_load(p, __ATOMIC_RELAXED, __HIP_MEMORY_SCOPE_AGENT); }
__device__ __forceinline__ unsigned xb_add(unsigned* p, unsigned v) { return __hip_atomic_fetch_add(p, v, __ATOMIC_RELAXED, __HIP_MEMORY_SCOPE_AGENT); }
__device__ __forceinline__ unsigned xb_xcc_id() { return (unsigned)__builtin_amdgcn_s_getreg((3 << 11) | 20) & 0xFu; }
#define XB_SPIN(cond, bar) do { unsigned _sp = 0; while (cond) { __builtin_amdgcn_s_sleep(1); \
    if ((++_sp & 255u) == 0u) { if (xb_ld(&(bar)[XB_TMO])) break; if (_sp > XB_SPIN_CAP) { atomicAdd(&(bar)[XB_TMO], 1u); break; } } } } while (0)
struct XcdBarrier { unsigned* bar; unsigned x; volatile LAS unsigned* st; };
__device__ __forceinline__ XcdBarrier xcd_barrier_post(unsigned* bar, volatile LAS unsigned* st) {
    XcdBarrier b; b.bar = bar; b.x = xb_xcc_id(); b.st = st;
    if (threadIdx.x == 0) (void)xb_add(&bar[XB_XCNT(b.x)], 1u);
    return b;
}
__device__ __forceinline__ void xcd_barrier_complete(unsigned* bar, unsigned x, unsigned& nloc, unsigned& nx) {
    const unsigned G = gridDim.x * gridDim.y * gridDim.z;
    unsigned sum, cnt, mine, sp = 0u;
    for (;;) {
        sum = 0u; cnt = 0u; mine = 0u;
#pragma unroll
        for (unsigned j = 0; j < 16; ++j) { const unsigned c = xb_ld(&bar[XB_XCNT(j)]); sum += c; cnt += (c > 0u) ? 1u : 0u; mine = (j == x) ? c : mine; }
        if (sum == G) break;
        __builtin_amdgcn_s_sleep(1);
        if ((++sp & 255u) == 0u) { if (xb_ld(&bar[XB_TMO])) break; if (sp > XB_SPIN_CAP) { atomicAdd(&bar[XB_TMO], 1u); break; } }
    }
    nloc = mine > 0u ? mine : 1u; nx = cnt > 0u ? cnt : 1u;
}
__device__ __forceinline__ void xcd_barrier(const XcdBarrier& b) {
    asm volatile("s_waitcnt vmcnt(0)" ::: "memory");
    __syncthreads();
    if (threadIdx.x == 0) {
        unsigned* bar = b.bar;
        __builtin_amdgcn_s_waitcnt(0);
        unsigned nloc = b.st[0], nx = b.st[1];
        if (nloc == 0u) { xcd_barrier_complete(bar, b.x, nloc, nx); b.st[0] = nloc; b.st[1] = nx; }
        const unsigned old = xb_add(&bar[XB_XSUB(b.x)], 1u);
        const unsigned gen = old / nloc;
        if (old + 1u == (gen + 1u) * nloc) {
            __builtin_amdgcn_fence(__ATOMIC_RELEASE, "agent");
            asm volatile("s_waitcnt vmcnt(0)" ::: "memory");
            const unsigned og = xb_add(&bar[XB_TOP], 1u);
            const unsigned tg = og / nx;
            if (og + 1u == (tg + 1u) * nx) xb_add(&bar[XB_TOPGEN], 1u);
            else XB_SPIN(xb_ld(&bar[XB_TOPGEN]) == tg, bar);
            __builtin_amdgcn_fence(__ATOMIC_ACQUIRE, "agent");
            xb_add(&bar[XB_XGEN(b.x)], 1u);
            asm volatile("s_waitcnt vmcnt(0)" ::: "memory");
        } else {
            XB_SPIN(xb_ld(&bar[XB_XGEN(b.x)]) == gen, bar);
            __builtin_amdgcn_fence(__ATOMIC_ACQUIRE, "agent");
            asm volatile("s_waitcnt vmcnt(0)" ::: "memory");
        }
    }
    __syncthreads();
}

constexpr int REPK = 0;
__global__ void __launch_bounds__(NTHR, 2) mega(Params p, int ph_lo, int ph_hi) {
    extern __shared__ __attribute__((aligned(16))) unsigned char lds[];
    volatile LAS unsigned* st = (volatile LAS unsigned*)(LAS unsigned char*)(lds + LDS_BYTES - 16);
    if (threadIdx.x < 4) st[threadIdx.x] = 0u;
    __syncthreads();
    const XcdBarrier bar = xcd_barrier_post((unsigned*)p.ws, st);
#define RUN_PHASE(k, call) if (ph_lo <= (k) && (k) < ph_hi) { if ((k) > ph_lo) xcd_barrier(bar); call; if (REPK == (k)) { xcd_barrier(bar); call; } }
    RUN_PHASE(0, phase0(p, lds))
    RUN_PHASE(1, phase1(p, lds))
    RUN_PHASE(2, phase2(p, lds))
    RUN_PHASE(3, phase3(p, lds))
    RUN_PHASE(4, phase4(p, lds))
    RUN_PHASE(5, phase5(p, lds))
    RUN_PHASE(6, phase6(p, lds))
    RUN_PHASE(7, phase7(p, lds))
    RUN_PHASE(8, phase8(p, lds))
    RUN_PHASE(9, phase9(p, lds))
    RUN_PHASE(10, phase10(p, lds))
}

static void launch_mega(const Params& p, int lo, int hi, hipStream_t stream) {
    static int grid = 0;
    if (grid == 0) {
        int dev = 0, cus = 0, per_cu = 0;
        hipGetDevice(&dev); hipDeviceGetAttribute(&cus, hipDeviceAttributeMultiprocessorCount, dev);
        hipFuncSetAttribute((const void*)mega, hipFuncAttributeMaxDynamicSharedMemorySize, LDS_BYTES);
        hipOccupancyMaxActiveBlocksPerMultiprocessor(&per_cu, (const void*)mega, NTHR, LDS_BYTES);
        if (per_cu < 1) { fprintf(stderr, "mega: occupancy query says %d blocks/CU\n", per_cu); per_cu = 1; }
        grid = cus;
    }
    hipMemsetAsync(p.ws, 0, 65536, stream);
    Params pp = p; int l = lo, h = hi;
    void* args[] = {&pp, &l, &h};
    hipError_t e = hipLaunchCooperativeKernel((const void*)mega, dim3(grid), dim3(NTHR), args, LDS_BYTES, stream);
    if (e != hipSuccess) fprintf(stderr, "cooperative launch failed: %s (grid %d)\n", hipGetErrorString(e), grid);
}

extern "C" void kernel_launch(void* const* d_in, const int* in_sizes, int n_in, void* d_out, int out_size, void* d_ws, size_t ws_size, hipStream_t stream) {
    const float* x = (const float*)d_in[0]; const float* p = (const float*)d_in[1]; const float* mix_norm = (const float*)d_in[2]; const float* w_in = (const float*)d_in[3];
    const float* lb_logits = (const float*)d_in[4]; const float* hg_out_norm = (const float*)d_in[5]; const float* q_norm = (const float*)d_in[6]; const float* k_norm = (const float*)d_in[7];
    const float* cmp_pe = (const float*)d_in[8]; const float* cmp_w1 = (const float*)d_in[9]; const float* cmp_w2 = (const float*)d_in[10]; const float* nsa_out_norm = (const float*)d_in[11];
    const float* w_out = (const float*)d_in[12]; const float* ffn_norm = (const float*)d_in[13]; const float* peer_wq = (const float*)d_in[14]; const float* peer_keys = (const float*)d_in[15];
    const float* peer_u = (const float*)d_in[16]; const float* peer_v = (const float*)d_in[17]; const float* ple_proj = (const float*)d_in[18]; const float* ple_gate_norm = (const float*)d_in[19];
    const float* ple_gate_w = (const float*)d_in[20];
    float* out = (float*)d_out; unsigned char* ws = (unsigned char*)d_ws;
    bf16* act = (bf16*)(ws + WS_ACT); bf16* proj = (bf16*)(ws + WS_PROJ);
    bf16* pq = (bf16*)(ws + WS_PROJ); bf16* hg = (bf16*)(ws + WS_PROJ + 64 * MiB);
    int* ids = (int*)(ws + WS_IDS); float* wts = (float*)(ws + WS_WTS); float* kcf = (float*)(ws + WS_KCF); float* vcf = (float*)(ws + WS_VCF); float* gl = (float*)(ws + WS_GL);

    Params prm{}; for (int i = 0; i < 21; ++i) prm.in[i] = (const float*)d_in[i]; prm.out = out; prm.ws = ws;
    launch_mega(prm, 0, 11, stream);
}
```

```cpp
#include <hip/hip_runtime.h>
#include <hip/hip_cooperative_groups.h>
#include <cstdint>
#include <cstdio>
namespace cg = cooperative_groups;

constexpr int D = 1024, NB = 2, T = 8192, NTOK = NB * T;
constexpr int DIN = 3352, PS = 3392;
constexpr int C_HQ = 0, C_HF = 512, C_HI = 1024, C_HG = 1536, C_NQ = 2048, C_KC = 2560, C_VC = 2688,
              C_KS = 2816, C_VS = 2944, C_KW = 3072, C_VW = 3200, C_GT = 3328;
constexpr int NCMP = 511;
constexpr float EPS = 1e-6f;
typedef unsigned short bf16;

constexpr size_t MiB = 1u << 20;
constexpr size_t WS_WINT = 1 * MiB;
constexpr size_t WS_WOUTT = 8 * MiB;
constexpr size_t WS_WQT = 10 * MiB;
constexpr size_t WS_WGT = 14 * MiB;
constexpr size_t WS_WPT = 16 * MiB;
constexpr size_t WS_KEYB = 16 * MiB + 512 * 1024;
constexpr size_t WS_W1T = 17 * MiB;
constexpr size_t WS_UB = 18 * MiB;
constexpr size_t WS_VB = 50 * MiB;
constexpr size_t WS_ACT = 82 * MiB;
constexpr size_t WS_PROJ = 114 * MiB;
constexpr size_t WS_SPARE = 220 * MiB;
constexpr size_t WS_IDS = WS_SPARE;
constexpr size_t WS_WTS = WS_SPARE + 8 * MiB;
constexpr size_t WS_KCF = WS_SPARE + 16 * MiB;
constexpr size_t WS_VCF = WS_SPARE + 17 * MiB;
constexpr size_t WS_PB = WS_SPARE + 18 * MiB;
constexpr size_t WS_VTS = WS_SPARE + 26 * MiB;
constexpr size_t WS_VTW = WS_SPARE + 30 * MiB;
constexpr size_t WS_KC = WS_SPARE + 34 * MiB;
constexpr size_t WS_VCT = WS_SPARE + 34 * MiB + 256 * 1024;
constexpr size_t WS_DEC = WS_SPARE + 34 * MiB + 512 * 1024;
constexpr size_t OUT_KIT = 32 * MiB;
constexpr size_t OUT_VT = 48 * MiB;
constexpr size_t WS_GL = 18 * MiB;

__device__ __forceinline__ float bf2f(bf16 v) { return __uint_as_float(((unsigned)v) << 16); }
__device__ __forceinline__ bf16 f2bf(float f) { unsigned u = __float_as_uint(f); return (bf16)((u + 0x7fffu + ((u >> 16) & 1u)) >> 16); }
__device__ __forceinline__ float wave_sum(float v) {
#pragma unroll
    for (int o = 1; o < 64; o <<= 1) v += __shfl_xor(v, o);
    return v;
}
__device__ __forceinline__ float wave_max(float v) {
#pragma unroll
    for (int o = 1; o < 64; o <<= 1) v = fmaxf(v, __shfl_xor(v, o));
    return v;
}
__device__ __forceinline__ float sigmoidf_(float x) { return 1.0f / (1.0f + __expf(-x)); }
__device__ __forceinline__ float siluf_(float x) { return x * sigmoidf_(x); }
__device__ __forceinline__ float gelu_tanh(float x) { return 0.5f * x * (1.0f + tanhf(0.7978845608028654f * (x + 0.044715f * x * x * x))); }
__device__ __forceinline__ float toF(float v) { return v; }
__device__ __forceinline__ float toF(bf16 v) { return bf2f(v); }

__global__ void __launch_bounds__(256) k_rms_rows(const float* __restrict__ x, const float* __restrict__ g, bf16* __restrict__ out, int rows) {
    const int wave = (blockIdx.x * 256 + threadIdx.x) >> 6, lane = threadIdx.x & 63;
    if (wave >= rows) return;
    const float* xr = x + (size_t)wave * D;
    float v[16]; float s = 0.f;
#pragma unroll
    for (int j = 0; j < 16; ++j) { v[j] = xr[lane + 64 * j]; s += v[j] * v[j]; }
    s = wave_sum(s);
    const float r = rsqrtf(s * (1.0f / D) + EPS);
#pragma unroll
    for (int j = 0; j < 16; ++j) out[(size_t)wave * D + lane + 64 * j] = f2bf(v[j] * r * g[lane + 64 * j]);
}

struct EpiBf16 { bf16* C; int ldc; int pad; __device__ void operator()(int r, int c, float v) const { C[(size_t)r * ldc + c] = f2bf(v); } };
struct EpiF32 { float* C; int ldc; int pad; __device__ void operator()(int r, int c, float v) const { C[(size_t)r * ldc + c] = v; } };
struct EpiResid { const float* X; float* O; int ld; int pad; __device__ void operator()(int r, int c, float v) const { O[(size_t)r * ld + c] = X[(size_t)r * ld + c] + v; } };
struct EpiFinal { const float* G; float* O; int ld; int pad; __device__ void operator()(int r, int c, float v) const { const size_t i = (size_t)r * ld + c; O[i] = O[i] + v * sigmoidf_(G[i]); } };

template <typename AT, class Epi>
__global__ void __launch_bounds__(256) k_gemm_naive(const AT* __restrict__ A, int lda, const float* __restrict__ W, int ldw, int N, int K, Epi epi) {
    __shared__ float As[16][65];
    __shared__ float Bs[16][64];
    const int tid = threadIdx.x, tx = tid & 15, ty = tid >> 4;
    const int m0 = blockIdx.y * 64, n0 = blockIdx.x * 64;
    float acc[4][4];
#pragma unroll
    for (int i = 0; i < 4; ++i)
#pragma unroll
        for (int j = 0; j < 4; ++j) acc[i][j] = 0.f;
    for (int k0 = 0; k0 < K; k0 += 16) {
#pragma unroll
        for (int i = 0; i < 4; ++i) { const int idx = tid + i * 256, r = idx >> 4, kk = idx & 15; As[kk][r] = toF(A[(size_t)(m0 + r) * lda + k0 + kk]); }
#pragma unroll
        for (int i = 0; i < 4; ++i) { const int idx = tid + i * 256, kk = idx >> 6, c = idx & 63; Bs[kk][c] = (n0 + c < N) ? W[(size_t)(k0 + kk) * ldw + n0 + c] : 0.f; }
        __syncthreads();
#pragma unroll
        for (int kk = 0; kk < 16; ++kk) {
            float a[4], b[4];
#pragma unroll
            for (int i = 0; i < 4; ++i) a[i] = As[kk][ty * 4 + i];
#pragma unroll
            for (int j = 0; j < 4; ++j) b[j] = Bs[kk][tx * 4 + j];
#pragma unroll
            for (int i = 0; i < 4; ++i)
#pragma unroll
                for (int j = 0; j < 4; ++j) acc[i][j] += a[i] * b[j];
        }
        __syncthreads();
    }
#pragma unroll
    for (int i = 0; i < 4; ++i)
#pragma unroll
        for (int j = 0; j < 4; ++j) { const int r = m0 + ty * 4 + i, c = n0 + tx * 4 + j; if (c < N) epi(r, c, acc[i][j]); }
}

__global__ void __launch_bounds__(1024) k_hgrn_naive(const bf16* __restrict__ proj, const float* __restrict__ lb_logits, const float* __restrict__ out_gain, bf16* __restrict__ mixed) {
    const int b = blockIdx.x >> 2, h = blockIdx.x & 3, tid = threadIdx.x, v = tid & 127, kg = tid >> 7;
    __shared__ float qsh[128], ksh[128], fsh[128], vsh[128], part[8][128], red[2], lbs[128];
    if (tid < 128) { const float l0 = lb_logits[h * 128 + tid], l1 = lb_logits[512 + h * 128 + tid]; const float m = fmaxf(l0, l1); const float e0 = expf(l0 - m), e1 = expf(l1 - m); lbs[tid] = e0 / (e0 + e1); }
    float S[16];
#pragma unroll
    for (int i = 0; i < 16; ++i) S[i] = 0.f;
    __syncthreads();
    for (int t = 0; t < T; ++t) {
        const size_t row = (size_t)(b * T + t) * PS;
        if (tid < 128) {
            const float fl = bf2f(proj[row + C_HF + h * 128 + tid]); const float lb = lbs[tid];
            const float fg = lb + (1.0f - lb) * sigmoidf_(fl); fsh[tid] = fg; ksh[tid] = 1.0f - fg;
            qsh[tid] = siluf_(bf2f(proj[row + C_HQ + h * 128 + tid])) * 0.08838834764831845f;
        } else if (tid < 256) vsh[tid - 128] = bf2f(proj[row + C_HI + h * 128 + tid - 128]);
        __syncthreads();
        const float vv = vsh[v]; float p = 0.f;
#pragma unroll
        for (int i = 0; i < 16; ++i) { const int k = kg * 16 + i; S[i] = fsh[k] * S[i] + ksh[k] * vv; p += qsh[k] * S[i]; }
        part[kg][v] = p;
        __syncthreads();
        float o = 0.f;
        if (tid < 128) {
#pragma unroll
            for (int j = 0; j < 8; ++j) o += part[j][tid];
            const float ss = wave_sum(o * o); if ((tid & 63) == 0) red[tid >> 6] = ss;
        }
        __syncthreads();
        if (tid < 128) {
            const float tot = red[0] + red[1];
            const float y = o * rsqrtf(tot * (1.0f / 128.0f) + EPS) * out_gain[h * 128 + tid];
            const float gl = bf2f(proj[row + C_HG + h * 128 + tid]);
            mixed[(size_t)(b * T + t) * D + h * 128 + tid] = f2bf(y * siluf_(gl));
        }
    }
}

__global__ void __launch_bounds__(64) k_cmp_naive(const bf16* __restrict__ proj, const float* __restrict__ pe, const float* __restrict__ w1, const float* __restrict__ w2,
                                                  const float* __restrict__ k_gain, float* __restrict__ kc, float* __restrict__ vc) {
    int it = blockIdx.x; const int n = it % NCMP; it /= NCMP; const int g = it & 1; it >>= 1; const int b = it & 1; const int which = it >> 1;
    const int c = threadIdx.x;
    __shared__ float blk[2048]; __shared__ float hid[64];
    const int col0 = (which == 0 ? C_KC : C_VC) + g * 64;
    for (int i = c; i < 2048; i += 64) { const int j = i >> 6, d = i & 63; blk[i] = bf2f(proj[(size_t)(b * T + 16 * n + j) * PS + col0 + d]) + pe[which * 2048 + i]; }
    __syncthreads();
    float acc = 0.f;
    for (int i = 0; i < 2048; ++i) acc += blk[i] * w1[(size_t)which * 2048 * 64 + (size_t)i * 64 + c];
    hid[c] = gelu_tanh(acc);
    __syncthreads();
    float o = 0.f;
    for (int i = 0; i < 64; ++i) o += hid[i] * w2[which * 4096 + i * 64 + c];
    if (which == 0) { const float ss = wave_sum(o * o); o = o * rsqrtf(ss * (1.0f / 64.0f) + EPS) * k_gain[c]; }
    (which == 0 ? kc : vc)[((size_t)(b * 2 + g) * NCMP + n) * 64 + c] = o;
}

__global__ void __launch_bounds__(256) k_nsa_naive(const bf16* __restrict__ proj, const float* __restrict__ kc, const float* __restrict__ vc, const float* __restrict__ q_gain,
                                                   const float* __restrict__ k_gain, const float* __restrict__ out_gain, bf16* __restrict__ mixed) {
    const int g = blockIdx.x & 1, tok = blockIdx.x >> 1, b = tok / T, t = tok % T;
    const int tid = threadIdx.x, r = tid >> 6, lane = tid & 63, h = g * 4 + r;
    __shared__ float qs[4][64]; __shared__ float sc[4][1024]; __shared__ float P[520]; __shared__ float imp[128]; __shared__ int sel[128]; __shared__ int blist[16]; __shared__ int nbs;
    const float slope = exp2f(-(float)(h + 1));
    const float NEG = -__builtin_huge_valf();
    {
        float qv = bf2f(proj[(size_t)tok * PS + C_NQ + h * 64 + lane]);
        const float ss = wave_sum(qv * qv);
        qs[r][lane] = qv * rsqrtf(ss * (1.0f / 64.0f) + EPS) * q_gain[lane] * 0.125f;
    }
    __syncthreads();
    const int nvalid = (t >= 31) ? ((t - 31) / 16 + 1) : 0;
    const float* kcb = kc + (size_t)(b * 2 + g) * NCMP * 64; const float* vcb = vc + (size_t)(b * 2 + g) * NCMP * 64;
    float mx = NEG;
    for (int n = lane; n < 512; n += 64) {
        float s = NEG;
        if (n < nvalid) { float d = 0.f; for (int i = 0; i < 64; ++i) d += qs[r][i] * kcb[n * 64 + i]; s = d - slope * (float)(t - (16 * n + 31)); }
        sc[r][n] = s; mx = fmaxf(mx, s);
    }
    mx = wave_max(mx); if (mx == NEG) mx = 0.f;
    float sum = 0.f;
    for (int n = lane; n < 512; n += 64) { const float e = (n < nvalid) ? expf(sc[r][n] - mx) : 0.f; sc[r][n] = e; sum += e; }
    sum = wave_sum(sum); float inv = 1.0f / fmaxf(sum, 1e-30f);
    for (int n = lane; n < 512; n += 64) sc[r][n] *= inv;
    __syncthreads();
    float oc = 0.f;
    for (int n = 0; n < nvalid; ++n) oc += sc[r][n] * vcb[n * 64 + lane];
    for (int i = tid; i < 520; i += 256) P[i] = (i < 512) ? (sc[0][i] + sc[1][i] + sc[2][i] + sc[3][i]) : 0.f;
    __syncthreads();
    if (tid < 128) imp[tid] = P[4 * tid] + 2.f * P[4 * tid + 1] + 2.f * P[4 * tid + 2] + 2.f * P[4 * tid + 3] + P[4 * tid + 4];
    __syncthreads();
    const int cur = t >> 6;
    if (tid < 128) {
        const int j = tid; const bool forced = (j == 0) || (j == cur) || (j == cur - 1); const bool cand = !forced && j <= cur;
        const int nforced = (cur == 0) ? 1 : (cur == 1) ? 2 : 3; const int need = 16 - nforced;
        int rank = 0; const float mine = imp[j];
        for (int q = 1; q <= cur - 2; ++q) { if (q == j) continue; const float o = imp[q]; if (o > mine || (o == mine && q < j)) ++rank; }
        sel[j] = (forced || (cand && rank < need)) ? 1 : 0;
    }
    __syncthreads();
    if (tid == 0) { int nb = 0; for (int j = 0; j < 128; ++j) if (sel[j] && nb < 16) blist[nb++] = j; nbs = nb; }
    __syncthreads();
    const int nb = nbs;
    float os = 0.f;
    {
        float m2 = NEG;
        for (int s = 0; s < nb; ++s) {
            const int pos = blist[s] * 64 + lane; float val = NEG;
            if (pos <= t) {
                const bf16* kr = proj + (size_t)(b * T + pos) * PS + C_KS + g * 64; float d = 0.f, sq = 0.f;
                for (int i = 0; i < 64; ++i) { const float kv = bf2f(kr[i]); d += qs[r][i] * kv * k_gain[64 + i]; sq += kv * kv; }
                val = d * rsqrtf(sq * (1.0f / 64.0f) + EPS) - slope * (float)(t - pos);
            }
            sc[r][s * 64 + lane] = val; m2 = fmaxf(m2, val);
        }
        m2 = wave_max(m2); if (m2 == NEG) m2 = 0.f;
        float su = 0.f;
        for (int s = 0; s < nb; ++s) { const float v0 = sc[r][s * 64 + lane]; const float e = (v0 == NEG) ? 0.f : expf(v0 - m2); sc[r][s * 64 + lane] = e; su += e; }
        su = wave_sum(su); const float iv = 1.0f / fmaxf(su, 1e-30f);
        __syncthreads();
        for (int s = 0; s < nb; ++s) for (int i = 0; i < 64; ++i) {
            const float p = sc[r][s * 64 + i]; if (p != 0.f) os += p * bf2f(proj[(size_t)(b * T + blist[s] * 64 + i) * PS + C_VS + g * 64 + lane]); }
        os *= iv;
    }
    __syncthreads();
    float ow = 0.f;
    {
        float m2 = NEG;
        for (int i = lane; i < 512; i += 64) {
            const int pos = t - i; float val = NEG;
            if (pos >= 0) {
                const bf16* kr = proj + (size_t)(b * T + pos) * PS + C_KW + g * 64; float d = 0.f, sq = 0.f;
                for (int c = 0; c < 64; ++c) { const float kv = bf2f(kr[c]); d += qs[r][c] * kv * k_gain[128 + c]; sq += kv * kv; }
                val = d * rsqrtf(sq * (1.0f / 64.0f) + EPS) - slope * (float)i;
            }
            sc[r][i] = val; m2 = fmaxf(m2, val);
        }
        m2 = wave_max(m2);
        float su = 0.f;
        for (int i = lane; i < 512; i += 64) { const float v0 = sc[r][i]; const float e = (v0 == NEG) ? 0.f : expf(v0 - m2); sc[r][i] = e; su += e; }
        su = wave_sum(su); const float iv = 1.0f / fmaxf(su, 1e-30f);
        __syncthreads();
        for (int i = 0; i < 512; ++i) { const float p = sc[r][i]; if (p != 0.f) ow += p * bf2f(proj[(size_t)(b * T + t - i) * PS + C_VW + g * 64 + lane]); }
        ow *= iv;
    }
    const bf16* gl = proj + (size_t)tok * PS + C_GT + h * 3;
    const float o = sigmoidf_(bf2f(gl[0])) * oc + sigmoidf_(bf2f(gl[1])) * os + sigmoidf_(bf2f(gl[2])) * ow;
    const float ss = wave_sum(o * o);
    mixed[(size_t)tok * D + 512 + h * 64 + lane] = f2bf(o * rsqrtf(ss * (1.0f / 64.0f) + EPS) * out_gain[h * 64 + lane]);
}

__global__ void __launch_bounds__(128) k_peer_topk_naive(const bf16* __restrict__ pq, const float* __restrict__ keys, int* __restrict__ ids, float* __restrict__ wts) {
    const int tok = blockIdx.x >> 3, h = blockIdx.x & 7, k = threadIdx.x;
    __shared__ float q[256]; __shared__ float s[2][128]; __shared__ float ts[2][16]; __shared__ int ti[2][16]; __shared__ float cand[256]; __shared__ float bs[16]; __shared__ int bc[16];
    q[k] = bf2f(pq[(size_t)tok * 2048 + h * 256 + k]); q[k + 128] = bf2f(pq[(size_t)tok * 2048 + h * 256 + 128 + k]);
    __syncthreads();
#pragma unroll
    for (int c = 0; c < 2; ++c) { const float* kr = keys + ((size_t)(h * 2 + c) * 128 + k) * 128; float d = 0.f; for (int i = 0; i < 128; ++i) d += q[c * 128 + i] * kr[i]; s[c][k] = d; }
    __syncthreads();
#pragma unroll
    for (int c = 0; c < 2; ++c) { const float mine = s[c][k]; int rank = 0; for (int j = 0; j < 128; ++j) { const float o = s[c][j]; if (o > mine || (o == mine && j < k)) ++rank; } if (rank < 16) { ts[c][rank] = mine; ti[c][rank] = k; } }
    __syncthreads();
    cand[k] = ts[0][k >> 4] + ts[1][k & 15]; cand[k + 128] = ts[0][(k + 128) >> 4] + ts[1][(k + 128) & 15];
    __syncthreads();
#pragma unroll
    for (int e = 0; e < 2; ++e) { const int me = k + e * 128; const float mine = cand[me]; int rank = 0; for (int j = 0; j < 256; ++j) { const float o = cand[j]; if (o > mine || (o == mine && j < me)) ++rank; } if (rank < 16) { bs[rank] = mine; bc[rank] = me; } }
    __syncthreads();
    if (k < 16) {
        float mx = bs[0]; float sum = 0.f; for (int j = 0; j < 16; ++j) sum += expf(bs[j] - mx);
        const int c = bc[k]; ids[(size_t)tok * 128 + h * 16 + k] = ti[0][c >> 4] * 128 + ti[1][c & 15];
        wts[(size_t)tok * 128 + h * 16 + k] = expf(bs[k] - mx) / sum;
    }
}

__global__ void __launch_bounds__(256) k_peer_gather_naive(const bf16* __restrict__ hn, const int* __restrict__ ids, const float* __restrict__ wts, const float* __restrict__ U, const float* __restrict__ V,
                                                           const float* __restrict__ gnorm, float* __restrict__ hio, bf16* __restrict__ hg) {
    const int tok = blockIdx.x, tid = threadIdx.x, w = tid >> 6, lane = tid & 63;
    __shared__ float xs[1024]; __shared__ float coef[128]; __shared__ int eid[128]; __shared__ float red[4];
    for (int i = tid; i < 1024; i += 256) xs[i] = bf2f(hn[(size_t)tok * D + i]);
    if (tid < 128) eid[tid] = ids[(size_t)tok * 128 + tid];
    __syncthreads();
    for (int e = w * 32; e < w * 32 + 32; ++e) {
        const float* ur = U + (size_t)eid[e] * D; float d = 0.f;
        for (int i = lane; i < 1024; i += 64) d += ur[i] * xs[i];
        d = wave_sum(d);
        if (lane == 0) coef[e] = wts[(size_t)tok * 128 + e] * gelu_tanh(d);
    }
    __syncthreads();
    float o[4] = {0.f, 0.f, 0.f, 0.f};
    for (int e = 0; e < 128; ++e) { const float* vr = V + (size_t)eid[e] * D; const float c = coef[e];
#pragma unroll
        for (int j = 0; j < 4; ++j) o[j] += c * vr[tid + 256 * j]; }
    float ss = 0.f;
#pragma unroll
    for (int j = 0; j < 4; ++j) { o[j] += hio[(size_t)tok * D + tid + 256 * j]; hio[(size_t)tok * D + tid + 256 * j] = o[j]; ss += o[j] * o[j]; }
    ss = wave_sum(ss); if (lane == 0) red[w] = ss;
    __syncthreads();
    const float r = rsqrtf((red[0] + red[1] + red[2] + red[3]) * (1.0f / D) + EPS);
#pragma unroll
    for (int j = 0; j < 4; ++j) hg[(size_t)tok * D + tid + 256 * j] = f2bf(o[j] * r * gnorm[tid + 256 * j]);
}


typedef short bf16x8 __attribute__((ext_vector_type(8)));
typedef float f32x4 __attribute__((ext_vector_type(4)));
typedef float f32x16 __attribute__((ext_vector_type(16)));
typedef unsigned u32x4 __attribute__((ext_vector_type(4)));
typedef unsigned u32x2 __attribute__((ext_vector_type(2)));
constexpr int NTHR = 512;
constexpr int LDS_BYTES = 131072 + 16;
struct Params { const float* in[21]; float* out; unsigned char* ws; };

__device__ __forceinline__ unsigned pk2(float lo, float hi) { return (unsigned)f2bf(lo) | ((unsigned)f2bf(hi) << 16); }

__device__ __forceinline__ void transpose_tile(const float* __restrict__ W, int K, int N, bf16* __restrict__ Wt, int kt, int nt, float* tile) {
    const int tid = threadIdx.x, k0 = kt * 64, n0 = nt * 64;
#pragma unroll
    for (int i = 0; i < 8; ++i) { const int idx = tid + i * NTHR, kk = idx >> 6, nn = idx & 63; tile[kk * 65 + nn] = (n0 + nn < N) ? W[(size_t)(k0 + kk) * N + n0 + nn] : 0.f; }
    __syncthreads();
    { const int nn = tid >> 3, ch = tid & 7; const float* s = tile + (ch * 8) * 65 + nn;
      u32x4 o; o.x = pk2(s[0], s[65]); o.y = pk2(s[130], s[195]); o.z = pk2(s[260], s[325]); o.w = pk2(s[390], s[455]);
      *(u32x4*)(Wt + (size_t)(n0 + nn) * K + k0 + ch * 8) = o; }
    __syncthreads();
}
__device__ __forceinline__ void cvt_range(const float* __restrict__ src, bf16* __restrict__ dst, size_t n8, size_t gtid, size_t gthreads) {
    for (size_t i = gtid; i < n8; i += gthreads) {
        const f32x4 a = ((const f32x4*)src)[2 * i], b = ((const f32x4*)src)[2 * i + 1];
        u32x4 o; o.x = pk2(a.x, a.y); o.y = pk2(a.z, a.w); o.z = pk2(b.x, b.y); o.w = pk2(b.z, b.w);
        ((u32x4*)dst)[i] = o;
    }
}
__device__ __forceinline__ void rms_row_bf16(const float* __restrict__ xr, const float* __restrict__ g, bf16* __restrict__ orow, int lane) {
    f32x4 v[4]; float s = 0.f;
#pragma unroll
    for (int j = 0; j < 4; ++j) { v[j] = ((const f32x4*)xr)[lane + 64 * j]; s += v[j].x * v[j].x + v[j].y * v[j].y + v[j].z * v[j].z + v[j].w * v[j].w; }
    s = wave_sum(s);
    const float r = rsqrtf(s * (1.0f / D) + EPS);
#pragma unroll
    for (int j = 0; j < 4; ++j) { const f32x4 gg = ((const f32x4*)g)[lane + 64 * j]; u32x2 o; o.x = pk2(v[j].x * r * gg.x, v[j].y * r * gg.y); o.y = pk2(v[j].z * r * gg.z, v[j].w * r * gg.w); ((u32x2*)orow)[lane + 64 * j] = o; }
}

__device__ __forceinline__ void phase0(const Params& p, unsigned char* lds) {
    float* tile = (float*)lds;
    const int nblk = gridDim.x, blk = blockIdx.x;
    unsigned char* ws = p.ws;
    constexpr int I_WIN = 16 * 54, I_WOUT = 16 * 16, I_WQ = 16 * 32, I_WG = 16 * 16, I_WP = 4 * 16, I_W1 = 2 * 32;
    constexpr int NIT = I_WIN + I_WOUT + I_WQ + I_WG + I_WP + I_W1;
    for (int it = blk; it < NIT; it += nblk) {
        int r = it;
        if (r < I_WIN) { transpose_tile(p.in[3], 1024, DIN, (bf16*)(ws + WS_WINT), r / 54, r % 54, tile); continue; } r -= I_WIN;
        if (r < I_WOUT) { transpose_tile(p.in[12], 1024, 1024, (bf16*)(ws + WS_WOUTT), r / 16, r % 16, tile); continue; } r -= I_WOUT;
        if (r < I_WQ) { transpose_tile(p.in[14], 1024, 2048, (bf16*)(ws + WS_WQT), r / 32, r % 32, tile); continue; } r -= I_WQ;
        if (r < I_WG) { transpose_tile(p.in[20], 1024, 1024, (bf16*)(ws + WS_WGT), r / 16, r % 16, tile); continue; } r -= I_WG;
        if (r < I_WP) { transpose_tile(p.in[18], 256, 1024, (bf16*)(ws + WS_WPT), r / 16, r % 16, tile); continue; } r -= I_WP;
        { const int which = r / 32, kt = r % 32; transpose_tile(p.in[9] + (size_t)which * 2048 * 64, 2048, 64, (bf16*)(ws + WS_W1T) + (size_t)which * 64 * 2048, kt, 0, tile); }
    }
    const size_t gtid = (size_t)blk * NTHR + threadIdx.x, gthreads = (size_t)nblk * NTHR;
    cvt_range(p.in[16], (bf16*)(ws + WS_UB), (size_t)16384 * 1024 / 8, gtid, gthreads);
    cvt_range(p.in[17], (bf16*)(ws + WS_VB), (size_t)16384 * 1024 / 8, gtid, gthreads);
    cvt_range(p.in[15], (bf16*)(ws + WS_KEYB), (size_t)8 * 2 * 128 * 128 / 8, gtid, gthreads);
    cvt_range(p.in[1], (bf16*)(ws + WS_PB), (size_t)NTOK * 256 / 8, gtid, gthreads);
    const int gw = (int)(gtid >> 6), ngw = (int)(gthreads >> 6), lane = threadIdx.x & 63;
    for (int m = gw; m < NTOK; m += ngw) rms_row_bf16(p.in[0] + (size_t)m * D, p.in[2], (bf16*)(ws + WS_ACT) + (size_t)m * D, lane);
}

__device__ __forceinline__ int swz(int ob) { return ob ^ (((ob >> 9) & 1) << 5); }
constexpr int G_STAGE = 49152;
__device__ __forceinline__ void gemm_mainloop(f32x4 (&acc)[4][4], const bf16* __restrict__ A, int lda, const bf16* __restrict__ Bt, int ldb, int K, int m0, int n0, unsigned char* lds) {
    const int tid = threadIdx.x, lane = tid & 63, wid = tid >> 6, wm = wid >> 1, wn = wid & 1, fr = lane & 15, fq = lane >> 4;
    const int lrow = tid >> 3, lc = tid & 7;
    const bf16* ag = A + (size_t)(m0 + lrow) * lda + lc * 8;
    const bf16* bg = Bt + (size_t)(n0 + lrow) * ldb + lc * 8;
    const int woff = ((lrow >> 4) * 2 + (lc >> 2)) * 1024 + swz((lrow & 15) * 64 + (lc & 3) * 16);
    const int roff = swz(fr * 64 + fq * 16);
    const int nk = K >> 6;
    u32x4 ra[4], rb[2];
#pragma unroll
    for (int i = 0; i < 4; ++i) ra[i] = *(const u32x4*)(ag + (size_t)i * 64 * lda);
#pragma unroll
    for (int i = 0; i < 2; ++i) rb[i] = *(const u32x4*)(bg + (size_t)i * 64 * ldb);
#pragma unroll
    for (int i = 0; i < 4; ++i) *(u32x4*)(lds + woff + i * 8192) = ra[i];
#pragma unroll
    for (int i = 0; i < 2; ++i) *(u32x4*)(lds + 32768 + woff + i * 8192) = rb[i];
    __syncthreads();
    for (int kt = 0; kt < nk; ++kt) {
        unsigned char* cur = lds + (kt & 1) * G_STAGE; unsigned char* nxt = lds + ((kt + 1) & 1) * G_STAGE;
        const bool more = kt + 1 < nk;
        if (more) {
#pragma unroll
            for (int i = 0; i < 4; ++i) ra[i] = *(const u32x4*)(ag + (size_t)i * 64 * lda + (kt + 1) * 64);
#pragma unroll
            for (int i = 0; i < 2; ++i) rb[i] = *(const u32x4*)(bg + (size_t)i * 64 * ldb + (kt + 1) * 64);
        }
#pragma unroll
        for (int s = 0; s < 2; ++s) {
            bf16x8 af[4], bfr[4];
#pragma unroll
            for (int i = 0; i < 4; ++i) af[i] = *(const bf16x8*)(cur + ((wm * 4 + i) * 2 + s) * 1024 + roff);
#pragma unroll
            for (int i = 0; i < 4; ++i) bfr[i] = *(const bf16x8*)(cur + 32768 + ((wn * 4 + i) * 2 + s) * 1024 + roff);
#pragma unroll
            for (int mi = 0; mi < 4; ++mi)
#pragma unroll
                for (int ni = 0; ni < 4; ++ni) acc[mi][ni] = __builtin_amdgcn_mfma_f32_16x16x32_bf16(bfr[ni], af[mi], acc[mi][ni], 0, 0, 0);
        }
        if (more) {
#pragma unroll
            for (int i = 0; i < 4; ++i) *(u32x4*)(nxt + woff + i * 8192) = ra[i];
#pragma unroll
            for (int i = 0; i < 2; ++i) *(u32x4*)(nxt + 32768 + woff + i * 8192) = rb[i];
        }
        __syncthreads();
    }
}
__device__ __forceinline__ void acc_zero(f32x4 (&acc)[4][4]) {
#pragma unroll
    for (int i = 0; i < 4; ++i)
#pragma unroll
        for (int j = 0; j < 4; ++j) acc[i][j] = (f32x4){0.f, 0.f, 0.f, 0.f};
}
__device__ __forceinline__ void phase1(const Params& p, unsigned char* lds) {
    const bf16* A = (const bf16*)(p.ws + WS_ACT); const bf16* Bt = (const bf16*)(p.ws + WS_WINT); bf16* C = (bf16*)(p.ws + WS_PROJ);
    const int lane = threadIdx.x & 63, wid = threadIdx.x >> 6, wm = wid >> 1, wn = wid & 1, fr = lane & 15, fq = lane >> 4;
    constexpr int NT = 27, NTILES = 64 * NT;
    for (int t = blockIdx.x; t < NTILES; t += gridDim.x) {
        const int m0 = (t / NT) * 256, n0 = (t % NT) * 128;
        f32x4 acc[4][4]; acc_zero(acc);
        gemm_mainloop(acc, A, D, Bt, D, D, m0, n0, lds);
#pragma unroll
        for (int mi = 0; mi < 4; ++mi)
#pragma unroll
            for (int ni = 0; ni < 4; ++ni) {
                const int row = m0 + wm * 64 + mi * 16 + fr, col = n0 + wn * 64 + ni * 16 + fq * 4;
                if (col < DIN) { u32x2 o; o.x = pk2(acc[mi][ni][0], acc[mi][ni][1]); o.y = pk2(acc[mi][ni][2], acc[mi][ni][3]); *(u32x2*)(C + (size_t)row * PS + col) = o; }
            }
    }
}


__device__ __forceinline__ void phase5(const Params& p, unsigned char* lds) {
    const bf16* A = (const bf16*)(p.ws + WS_ACT); const bf16* Bt = (const bf16*)(p.ws + WS_WOUTT); const float* X = p.in[0]; float* O = p.out;
    const int lane = threadIdx.x & 63, wid = threadIdx.x >> 6, wm = wid >> 1, wn = wid & 1, fr = lane & 15, fq = lane >> 4;
    constexpr int NT = 8, NTILES = 64 * NT;
    for (int t = blockIdx.x; t < NTILES; t += gridDim.x) {
        const int m0 = (t / NT) * 256, n0 = (t % NT) * 128;
        f32x4 acc[4][4]; acc_zero(acc);
        gemm_mainloop(acc, A, D, Bt, D, D, m0, n0, lds);
#pragma unroll
        for (int mi = 0; mi < 4; ++mi)
#pragma unroll
            for (int ni = 0; ni < 4; ++ni) {
                const size_t idx = (size_t)(m0 + wm * 64 + mi * 16 + fr) * D + n0 + wn * 64 + ni * 16 + fq * 4;
                *(f32x4*)(O + idx) = *(const f32x4*)(X + idx) + acc[mi][ni];
            }
    }
}
__device__ __forceinline__ void phase6(const Params& p, unsigned char* lds) {
    const int gw = (blockIdx.x * NTHR + threadIdx.x) >> 6, ngw = (gridDim.x * NTHR) >> 6, lane = threadIdx.x & 63;
    for (int m = gw; m < NTOK; m += ngw) rms_row_bf16(p.out + (size_t)m * D, p.in[13], (bf16*)(p.ws + WS_ACT) + (size_t)m * D, lane);
}
__device__ __forceinline__ void phase7(const Params& p, unsigned char* lds) {
    const bf16* A = (const bf16*)(p.ws + WS_ACT); const bf16* Bt = (const bf16*)(p.ws + WS_WQT); bf16* C = (bf16*)(p.ws + WS_PROJ);
    const int lane = threadIdx.x & 63, wid = threadIdx.x >> 6, wm = wid >> 1, wn = wid & 1, fr = lane & 15, fq = lane >> 4;
    constexpr int NT = 16, NTILES = 64 * NT;
    for (int t = blockIdx.x; t < NTILES; t += gridDim.x) {
        const int m0 = (t / NT) * 256, n0 = (t % NT) * 128;
        f32x4 acc[4][4]; acc_zero(acc);
        gemm_mainloop(acc, A, D, Bt, D, D, m0, n0, lds);
#pragma unroll
        for (int mi = 0; mi < 4; ++mi)
#pragma unroll
            for (int ni = 0; ni < 4; ++ni) {
                const int row = m0 + wm * 64 + mi * 16 + fr, col = n0 + wn * 64 + ni * 16 + fq * 4;
                u32x2 o; o.x = pk2(acc[mi][ni][0], acc[mi][ni][1]); o.y = pk2(acc[mi][ni][2], acc[mi][ni][3]); *(u32x2*)(C + (size_t)row * 2048 + col) = o;
            }
    }
}
__device__ __forceinline__ void phase10(const Params& p, unsigned char* lds) {
    const bf16* A1 = (const bf16*)(p.ws + WS_PROJ + 64 * MiB); const bf16* B1 = (const bf16*)(p.ws + WS_WGT);
    const bf16* A2 = (const bf16*)(p.ws + WS_PB); const bf16* B2 = (const bf16*)(p.ws + WS_WPT); float* O = p.out;
    const int lane = threadIdx.x & 63, wid = threadIdx.x >> 6, wm = wid >> 1, wn = wid & 1, fr = lane & 15, fq = lane >> 4;
    constexpr int NT = 8, NTILES = 64 * NT;
    for (int t = blockIdx.x; t < NTILES; t += gridDim.x) {
        const int m0 = (t / NT) * 256, n0 = (t % NT) * 128;
        u32x2 gpk[4][4];
        {
            f32x4 accg[4][4]; acc_zero(accg);
            gemm_mainloop(accg, A1, D, B1, D, D, m0, n0, lds);
#pragma unroll
            for (int mi = 0; mi < 4; ++mi)
#pragma unroll
                for (int ni = 0; ni < 4; ++ni) { gpk[mi][ni].x = pk2(sigmoidf_(accg[mi][ni][0]), sigmoidf_(accg[mi][ni][1])); gpk[mi][ni].y = pk2(sigmoidf_(accg[mi][ni][2]), sigmoidf_(accg[mi][ni][3])); }
        }
        f32x4 accp[4][4]; acc_zero(accp);
        gemm_mainloop(accp, A2, 256, B2, 256, 256, m0, n0, lds);
#pragma unroll
        for (int mi = 0; mi < 4; ++mi)
#pragma unroll
            for (int ni = 0; ni < 4; ++ni) {
                const size_t idx = (size_t)(m0 + wm * 64 + mi * 16 + fr) * D + n0 + wn * 64 + ni * 16 + fq * 4;
                f32x4 g; g.x = __uint_as_float(gpk[mi][ni].x << 16); g.y = __uint_as_float(gpk[mi][ni].x & 0xffff0000u); g.z = __uint_as_float(gpk[mi][ni].y << 16); g.w = __uint_as_float(gpk[mi][ni].y & 0xffff0000u);
                *(f32x4*)(O + idx) = *(const f32x4*)(O + idx) + accp[mi][ni] * g;
            }
    }
}

typedef __bf16 bf16x2v __attribute__((ext_vector_type(2)));
template <int CTRL> __device__ __forceinline__ float dpp_f(float v) { return __int_as_float(__builtin_amdgcn_update_dpp(0, __float_as_int(v), CTRL, 0xF, 0xF, false)); }
__device__ __forceinline__ float grp16_max(float v) { v = fmaxf(v, dpp_f<0xB1>(v)); v = fmaxf(v, dpp_f<0x4E>(v)); v = fmaxf(v, dpp_f<0x141>(v)); v = fmaxf(v, dpp_f<0x140>(v)); return v; }
__device__ __forceinline__ float grp16_sum(float v) { v += dpp_f<0xB1>(v); v += dpp_f<0x4E>(v); v += dpp_f<0x141>(v); v += dpp_f<0x140>(v); return v; }
#define CE_DESC(a, b) { const float _hi = fmaxf(a, b), _lo = fminf(a, b); a = _hi; b = _lo; }
__device__ __forceinline__ float grp16_top16(float (&v)[8], int lig) {
    CE_DESC(v[0], v[1]) CE_DESC(v[2], v[3]) CE_DESC(v[4], v[5]) CE_DESC(v[6], v[7])
    CE_DESC(v[0], v[2]) CE_DESC(v[1], v[3]) CE_DESC(v[4], v[6]) CE_DESC(v[5], v[7])
    CE_DESC(v[1], v[2]) CE_DESC(v[5], v[6])
    CE_DESC(v[0], v[4]) CE_DESC(v[1], v[5]) CE_DESC(v[2], v[6]) CE_DESC(v[3], v[7])
    CE_DESC(v[2], v[4]) CE_DESC(v[3], v[5])
    CE_DESC(v[1], v[2]) CE_DESC(v[3], v[4]) CE_DESC(v[5], v[6])
    float top = 0.f;
#pragma unroll
    for (int r = 0; r < 16; ++r) {
        const float m = grp16_max(v[0]);
        if (lig == r) top = m;
        const bool own = (v[0] == m);
#pragma unroll
        for (int j = 0; j < 7; ++j) v[j] = own ? v[j + 1] : v[j];
        v[7] = own ? -3.0e38f : v[7];
    }
    return top;
}
__device__ __forceinline__ void phase8(const Params& p, unsigned char* lds) {
    const bf16* PQ = (const bf16*)(p.ws + WS_PROJ); const bf16* KB = (const bf16*)(p.ws + WS_KEYB);
    int* ids = (int*)(p.ws + WS_IDS); float* wts = (float*)(p.ws + WS_WTS);
    float* S = (float*)lds;
    const int tid = threadIdx.x, lane = tid & 63, wid = tid >> 6, lig = tid & 15, gbase = lane & 48;
    for (int item = blockIdx.x; item < 2048; item += gridDim.x) {
        const int tok0 = (item >> 3) * 64, h = item & 7;
        {
            const int c = wid >> 2, key0 = (wid & 3) * 32, r = lane & 31, hh = lane >> 5;
            f32x16 acc0, acc1;
#pragma unroll
            for (int i = 0; i < 16; ++i) { acc0[i] = 0.f; acc1[i] = 0.f; }
            const bf16* bq = KB + ((size_t)(h * 2 + c) * 128 + key0 + r) * 128 + hh * 8;
            const bf16* aq0 = PQ + (size_t)(tok0 + r) * 2048 + h * 256 + c * 128 + hh * 8;
            const bf16* aq1 = aq0 + (size_t)32 * 2048;
#pragma unroll
            for (int s = 0; s < 8; ++s) {
                const bf16x8 b = *(const bf16x8*)(bq + s * 16), a0 = *(const bf16x8*)(aq0 + s * 16), a1 = *(const bf16x8*)(aq1 + s * 16);
                acc0 = __builtin_amdgcn_mfma_f32_32x32x16_bf16(a0, b, acc0, 0, 0, 0);
                acc1 = __builtin_amdgcn_mfma_f32_32x32x16_bf16(a1, b, acc1, 0, 0, 0);
            }
#pragma unroll
            for (int i = 0; i < 16; ++i) { const int tl = (i & 3) + 8 * (i >> 2) + 4 * hh; S[(c * 64 + tl) * 132 + key0 + r] = acc0[i]; S[(c * 64 + 32 + tl) * 132 + key0 + r] = acc1[i]; }
        }
        __syncthreads();
#pragma unroll 1
        for (int rd = 0; rd < 2; ++rd) {
            const int tl = (tid >> 4) + 32 * rd;
            float ts[2];
#pragma unroll
            for (int c = 0; c < 2; ++c) {
                float v[8];
                const f32x4 lo = *(const f32x4*)(S + (c * 64 + tl) * 132 + lig * 8), hi = *(const f32x4*)(S + (c * 64 + tl) * 132 + lig * 8 + 4);
                v[0] = lo.x; v[1] = lo.y; v[2] = lo.z; v[3] = lo.w; v[4] = hi.x; v[5] = hi.y; v[6] = hi.z; v[7] = hi.w;
#pragma unroll
                for (int j = 0; j < 8; ++j) v[j] = __uint_as_float((__float_as_uint(v[j]) & ~127u) | (unsigned)(lig * 8 + j));
                ts[c] = grp16_top16(v, lig);
            }
            const float t0 = ts[0], t1 = ts[1];
            int bp = 0; float my_s = 0.f; int my_eid = 0;
#pragma unroll 1
            for (int r = 0; r < 16; ++r) {
                const float other = __shfl(t1, gbase + (bp < 15 ? bp : 15));
                const float sum = t0 + other;
                const float head = (bp >= 16) ? -3.0e38f : __uint_as_float((__float_as_uint(sum) & ~15u) | (unsigned)lig);
                const int cur_eid = (int)(((__float_as_uint(t0) & 127u) << 7) | (__float_as_uint(other) & 127u));
                const float m = grp16_max(head);
                const int owner = (int)(__float_as_uint(m) & 15u);
                const int ew = __shfl(cur_eid, gbase + owner);
                if (lig == r) { my_s = m; my_eid = ew; }
                if (lig == owner) ++bp;
            }
            const float mx = grp16_max(my_s);
            const float e = __expf(my_s - mx);
            const float sm = grp16_sum(e);
            const size_t o = (size_t)(tok0 + tl) * 128 + h * 16 + lig;
            ids[o] = my_eid; wts[o] = e / sm;
        }
        __syncthreads();
    }
}

__device__ __forceinline__ void hgrn_pre_item(const Params& p, unsigned char* lds, int ci) {
    const int tid = threadIdx.x, lane = tid & 63, wid = tid >> 6, k = tid & 127, tq = tid >> 7;
    const int n = ci & 127, h = (ci >> 7) & 3, b = ci >> 9, tok0 = b * T + n * 64;
    bf16* proj = (bf16*)(p.ws + WS_PROJ);
    float* OB = p.out; bf16* KIT = (bf16*)((unsigned char*)p.out + OUT_KIT) + (size_t)ci * 8192; bf16* VTg = (bf16*)((unsigned char*)p.out + OUT_VT) + (size_t)ci * 8192;
    float* DEC = (float*)(p.ws + WS_DEC) + (size_t)ci * 128;
    bf16* QT = (bf16*)lds; bf16* KT = (bf16*)(lds + 17408); bf16* VTl = (bf16*)(lds + 34816); bf16* AM = (bf16*)(lds + 53248);
    float* part = (float*)(lds + 62464); float* gref = (float*)(lds + 64512);
    float lb; { const float l0 = p.in[4][h * 128 + k], l1 = p.in[4][512 + h * 128 + k]; const float m = fmaxf(l0, l1); const float e0 = __expf(l0 - m), e1 = __expf(l1 - m); lb = e0 / (e0 + e1); }
    float G[16], key[16], qv[16], vv[16];
    {
        float c = 0.f;
#pragma unroll
        for (int i = 0; i < 16; ++i) {
            const size_t row = (size_t)(tok0 + tq * 16 + i) * PS;
            const float fg = lb + (1.0f - lb) * sigmoidf_(bf2f(proj[row + C_HF + h * 128 + k]));
            key[i] = 1.0f - fg; c += __logf(fg); G[i] = c;
            qv[i] = siluf_(bf2f(proj[row + C_HQ + h * 128 + k])) * 0.08838834764831845f;
            vv[i] = bf2f(proj[row + C_HI + h * 128 + k]);
        }
        part[tq * 128 + k] = c;
    }
    __syncthreads();
    {
        float off = 0.f;
#pragma unroll
        for (int j = 0; j < 3; ++j) off += (j < tq) ? part[j * 128 + k] : 0.f;
#pragma unroll
        for (int i = 0; i < 16; ++i) G[i] += off;
        if (tq == 1) gref[k] = G[15];
        if (tq == 3) gref[128 + k] = G[15];
    }
    __syncthreads();
    {
        const float gr = gref[k], gl = gref[128 + k];
        const int kpos = (k & ~31) | (((k >> 2) & 3) << 3) | (((k >> 4) & 1) << 2) | (k & 3);
        unsigned kp[8], vp[8];
#pragma unroll
        for (int i = 0; i < 16; i += 2) {
            kp[i >> 1] = pk2(key[i] * __expf(gl - G[i]), key[i + 1] * __expf(gl - G[i + 1]));
            vp[i >> 1] = pk2(vv[i], vv[i + 1]);
        }
#pragma unroll
        for (int i = 0; i < 16; ++i) {
            const int t = tq * 16 + i;
            QT[t * 136 + k] = f2bf(qv[i] * __expf(G[i] - gr));
            KT[t * 136 + k] = f2bf(key[i] * __expf(gr - G[i]));
            proj[(size_t)(tok0 + t) * PS + C_HQ + h * 128 + kpos] = f2bf(qv[i] * __expf(G[i]));
        }
        u32x4 a0, a1, b0, b1; a0.x = kp[0]; a0.y = kp[1]; a0.z = kp[2]; a0.w = kp[3]; a1.x = kp[4]; a1.y = kp[5]; a1.z = kp[6]; a1.w = kp[7];
        b0.x = vp[0]; b0.y = vp[1]; b0.z = vp[2]; b0.w = vp[3]; b1.x = vp[4]; b1.y = vp[5]; b1.z = vp[6]; b1.w = vp[7];
        *(u32x4*)(KIT + k * 64 + tq * 16) = a0; *(u32x4*)(KIT + k * 64 + tq * 16 + 8) = a1;
        *(u32x4*)(VTg + k * 64 + tq * 16) = b0; *(u32x4*)(VTg + k * 64 + tq * 16 + 8) = b1;
        *(u32x4*)(VTl + k * 72 + tq * 16) = b0; *(u32x4*)(VTl + k * 72 + tq * 16 + 8) = b1;
        if (tq == 3) DEC[k] = __expf(gl);
    }
    __syncthreads();
    const int fr = lane & 15, fq = lane >> 4;
    {
        const int tt = wid >> 1;
#pragma unroll
        for (int e = 0; e < 2; ++e) {
            const int st = 2 * (wid & 1) + e;
            f32x4 acc = (f32x4){0.f, 0.f, 0.f, 0.f};
            if (st <= tt) {
#pragma unroll
                for (int s = 0; s < 4; ++s) {
                    const bf16x8 a = *(const bf16x8*)(QT + (tt * 16 + fr) * 136 + s * 32 + fq * 8), bb = *(const bf16x8*)(KT + (st * 16 + fr) * 136 + s * 32 + fq * 8);
                    acc = __builtin_amdgcn_mfma_f32_16x16x32_bf16(a, bb, acc, 0, 0, 0);
                }
            }
#pragma unroll
            for (int r = 0; r < 4; ++r) { const int t = tt * 16 + fq * 4 + r, sp = st * 16 + fr; AM[t * 72 + sp] = f2bf(sp <= t ? acc[r] : 0.f); }
        }
    }
    __syncthreads();
    {
        const int tt = wid >> 1;
        const bf16x8 a0 = *(const bf16x8*)(AM + (tt * 16 + fr) * 72 + fq * 8), a1 = *(const bf16x8*)(AM + (tt * 16 + fr) * 72 + 32 + fq * 8);
#pragma unroll
        for (int e = 0; e < 4; ++e) {
            const int vt = (wid & 1) * 4 + e;
            const bf16x8 b0 = *(const bf16x8*)(VTl + (vt * 16 + fr) * 72 + fq * 8), b1 = *(const bf16x8*)(VTl + (vt * 16 + fr) * 72 + 32 + fq * 8);
            f32x4 acc = (f32x4){0.f, 0.f, 0.f, 0.f};
            acc = __builtin_amdgcn_mfma_f32_16x16x32_bf16(a0, b0, acc, 0, 0, 0);
            acc = __builtin_amdgcn_mfma_f32_16x16x32_bf16(a1, b1, acc, 0, 0, 0);
#pragma unroll
            for (int r = 0; r < 4; ++r) OB[(size_t)(tok0 + tt * 16 + fq * 4 + r) * 512 + h * 128 + vt * 16 + fr] = acc[r];
        }
    }
    __syncthreads();
}
template <bool DUMMY>
__device__ __forceinline__ void hgrn_scan_item(const Params& p, int wi) {
    const int lane = threadIdx.x & 63, fr = lane & 15, fq = lane >> 4;
    const int vs = wi & 7, bh = wi >> 3, h = bh & 3, b = bh >> 2;
    const bf16* proj = (const bf16*)(p.ws + WS_PROJ);
    float* OB = p.out; const bf16* KIT = (const bf16*)((unsigned char*)p.out + OUT_KIT); const bf16* VTg = (const bf16*)((unsigned char*)p.out + OUT_VT);
    const float* DEC = (const float*)(p.ws + WS_DEC);
    f32x4 S[8];
#pragma unroll
    for (int i = 0; i < 8; ++i) S[i] = (f32x4){0.f, 0.f, 0.f, 0.f};
#pragma unroll 1
    for (int n = 0; n < 128; ++n) {
        const int ci = bh * 128 + n, tok0 = b * T + n * 64;
        bf16x8 qf[4][4];
#pragma unroll
        for (int tt = 0; tt < 4; ++tt)
#pragma unroll
            for (int s = 0; s < 4; ++s) qf[tt][s] = *(const bf16x8*)(proj + (size_t)(tok0 + tt * 16 + fr) * PS + C_HQ + h * 128 + s * 32 + fq * 8);
        float oin[4][4];
#pragma unroll
        for (int tt = 0; tt < 4; ++tt)
#pragma unroll
            for (int r = 0; r < 4; ++r) oin[tt][r] = OB[(size_t)(tok0 + tt * 16 + fq * 4 + r) * 512 + h * 128 + vs * 16 + fr];
        bf16x8 Sb[4];
#pragma unroll
        for (int s = 0; s < 4; ++s) {
            u32x4 w; w.x = pk2(S[2 * s][0], S[2 * s][1]); w.y = pk2(S[2 * s][2], S[2 * s][3]); w.z = pk2(S[2 * s + 1][0], S[2 * s + 1][1]); w.w = pk2(S[2 * s + 1][2], S[2 * s + 1][3]);
            Sb[s] = __builtin_bit_cast(bf16x8, w);
        }
#pragma unroll
        for (int tt = 0; tt < 4; ++tt) {
            f32x4 acc = (f32x4){0.f, 0.f, 0.f, 0.f};
#pragma unroll
            for (int s = 0; s < 4; ++s) acc = __builtin_amdgcn_mfma_f32_16x16x32_bf16(qf[tt][s], Sb[s], acc, 0, 0, 0);
#pragma unroll
            for (int r = 0; r < 4; ++r) { const size_t oi = (size_t)(tok0 + tt * 16 + fq * 4 + r) * 512 + h * 128 + vs * 16 + fr; if (DUMMY) ((float*)(p.ws + WS_SPARE))[oi & 0x3fffff] = oin[tt][r] + acc[r]; else OB[oi] = oin[tt][r] + acc[r]; }
        }
        const bf16x8 v0 = *(const bf16x8*)(VTg + (size_t)ci * 8192 + (vs * 16 + fr) * 64 + fq * 8), v1 = *(const bf16x8*)(VTg + (size_t)ci * 8192 + (vs * 16 + fr) * 64 + 32 + fq * 8);
#pragma unroll
        for (int kb = 0; kb < 8; ++kb) {
            const bf16x8 k0 = *(const bf16x8*)(KIT + (size_t)ci * 8192 + (kb * 16 + fr) * 64 + fq * 8), k1 = *(const bf16x8*)(KIT + (size_t)ci * 8192 + (kb * 16 + fr) * 64 + 32 + fq * 8);
            const f32x4 dv = *(const f32x4*)(DEC + (size_t)ci * 128 + kb * 16 + fq * 4);
            f32x4 sacc = S[kb] * dv;
            sacc = __builtin_amdgcn_mfma_f32_16x16x32_bf16(k0, v0, sacc, 0, 0, 0);
            sacc = __builtin_amdgcn_mfma_f32_16x16x32_bf16(k1, v1, sacc, 0, 0, 0);
            S[kb] = sacc;
        }
    }
}
__device__ __forceinline__ void phase4(const Params& p, unsigned char* lds) {
    const bf16* proj = (const bf16*)(p.ws + WS_PROJ); const float* OB = p.out; bf16* mixed = (bf16*)(p.ws + WS_ACT); const float* gain = p.in[5];
    const int lane = threadIdx.x & 63, gw = (blockIdx.x * NTHR + threadIdx.x) >> 6, ngw = (gridDim.x * NTHR) >> 6;
    for (int tok = gw; tok < NTOK; tok += ngw) {
        const f32x4 o0 = *(const f32x4*)(OB + (size_t)tok * 512 + lane * 8), o1 = *(const f32x4*)(OB + (size_t)tok * 512 + lane * 8 + 4);
        const u32x4 gp = *(const u32x4*)(proj + (size_t)tok * PS + C_HG + lane * 8);
        const f32x4 g0 = *(const f32x4*)(gain + lane * 8), g1 = *(const f32x4*)(gain + lane * 8 + 4);
        float ss = o0.x * o0.x + o0.y * o0.y + o0.z * o0.z + o0.w * o0.w + o1.x * o1.x + o1.y * o1.y + o1.z * o1.z + o1.w * o1.w;
        ss = grp16_sum(ss);
        const float r = rsqrtf(ss * (1.0f / 128.0f) + EPS);
        const unsigned gx = gp.x, gy = gp.y, gz = gp.z, gw_ = gp.w;
        u32x4 w;
        w.x = pk2(o0.x * r * g0.x * siluf_(__uint_as_float(gx << 16)), o0.y * r * g0.y * siluf_(__uint_as_float(gx & 0xffff0000u)));
        w.y = pk2(o0.z * r * g0.z * siluf_(__uint_as_float(gy << 16)), o0.w * r * g0.w * siluf_(__uint_as_float(gy & 0xffff0000u)));
        w.z = pk2(o1.x * r * g1.x * siluf_(__uint_as_float(gz << 16)), o1.y * r * g1.y * siluf_(__uint_as_float(gz & 0xffff0000u)));
        w.w = pk2(o1.z * r * g1.z * siluf_(__uint_as_float(gw_ << 16)), o1.w * r * g1.w * siluf_(__uint_as_float(gw_ & 0xffff0000u)));
        *(u32x4*)(mixed + (size_t)tok * D + lane * 8) = w;
    }
}

#define WAVE_LDS_SYNC() asm volatile("s_waitcnt lgkmcnt(0)" ::: "memory")
__device__ __forceinline__ void nsa_prep_item(const Params& p, unsigned char* lds, int tile) {
    const int tid = threadIdx.x, lig = tid & 15;
    const int tok0 = tile * 64;
    bf16* proj = (bf16*)(p.ws + WS_PROJ);
    for (int rho = tid >> 4; rho < 768; rho += 32) {
        const int tl = rho / 12, which = rho - tl * 12;
        int col; const float* gain; float sc = 1.0f;
        if (which < 8) { col = C_NQ + which * 64; gain = p.in[6]; sc = 0.125f; }
        else if (which < 10) { col = C_KS + (which - 8) * 64; gain = p.in[7] + 64; }
        else { col = C_KW + (which - 10) * 64; gain = p.in[7] + 128; }
        bf16* rp = proj + (size_t)(tok0 + tl) * PS + col + lig * 4;
        const u32x2 raw = *(const u32x2*)rp;
        const unsigned r0 = raw.x, r1 = raw.y;
        const float a = __uint_as_float(r0 << 16), b = __uint_as_float(r0 & 0xffff0000u), c = __uint_as_float(r1 << 16), d = __uint_as_float(r1 & 0xffff0000u);
        const float ss = grp16_sum(a * a + b * b + c * c + d * d);
        const float r = rsqrtf(ss * (1.0f / 64.0f) + EPS) * sc;
        const f32x4 gg = *(const f32x4*)(gain + lig * 4);
        u32x2 o; o.x = pk2(a * r * gg.x, b * r * gg.y); o.y = pk2(c * r * gg.z, d * r * gg.w);
        *(u32x2*)rp = o;
    }
    {
        const int c = tid & 127, tq = tid >> 7, g = c >> 6, d = c & 63, b = tok0 / T, t0 = tok0 % T;
#pragma unroll
        for (int which = 0; which < 2; ++which) {
            const int col = (which == 0 ? C_VS : C_VW) + c;
            unsigned w[8];
#pragma unroll
            for (int i = 0; i < 16; i += 2) w[i >> 1] = (unsigned)proj[(size_t)(tok0 + tq * 16 + i) * PS + col] | ((unsigned)proj[(size_t)(tok0 + tq * 16 + i + 1) * PS + col] << 16);
            bf16* dst = (bf16*)(p.ws + (which == 0 ? WS_VTS : WS_VTW)) + ((size_t)(b * 2 + g) * 64 + d) * T + t0 + tq * 16;
            u32x4 a0, a1; a0.x = w[0]; a0.y = w[1]; a0.z = w[2]; a0.w = w[3]; a1.x = w[4]; a1.y = w[5]; a1.z = w[6]; a1.w = w[7];
            *(u32x4*)dst = a0; *(u32x4*)(dst + 8) = a1;
        }
    }
}
__device__ __forceinline__ void nsa_cmp_item(const Params& p, unsigned char* lds, int item) {
    const int tid = threadIdx.x, lane = tid & 63, wid = tid >> 6, fr = lane & 15, fq = lane >> 4;
    const int nt32 = item & 15, g = (item >> 4) & 1, b = (item >> 5) & 1, which = item >> 6, n0 = nt32 * 32;
    const bf16* proj = (const bf16*)(p.ws + WS_PROJ);
    const float* pe = p.in[8] + which * 2048;
    const bf16* W1T = (const bf16*)(p.ws + WS_W1T) + (size_t)which * 64 * 2048;
    const float* w2 = p.in[10] + which * 4096;
    bf16* A = (bf16*)lds; float* H = (float*)(lds + 33280);
    const int col0 = (which == 0 ? C_KC : C_VC) + g * 64;
    const int nt = wid & 1, ct = wid >> 1;
    f32x4 acc = (f32x4){0.f, 0.f, 0.f, 0.f};
#pragma unroll 1
    for (int kc = 0; kc < 4; ++kc) {
#pragma unroll
        for (int i = 0; i < 4; ++i) {
            const int idx = tid + i * NTHR, dch = idx & 7, jj = (idx >> 3) & 7, n = idx >> 6, j = kc * 8 + jj;
            u32x4 o = (u32x4){0u, 0u, 0u, 0u};
            if (n0 + n < NCMP) {
                const u32x4 raw = *(const u32x4*)(proj + (size_t)(b * T + 16 * (n0 + n) + j) * PS + col0 + dch * 8);
                const f32x4 p0 = *(const f32x4*)(pe + j * 64 + dch * 8), p1 = *(const f32x4*)(pe + j * 64 + dch * 8 + 4);
                const unsigned r0 = raw.x, r1 = raw.y, r2 = raw.z, r3 = raw.w;
                o.x = pk2(__uint_as_float(r0 << 16) + p0.x, __uint_as_float(r0 & 0xffff0000u) + p0.y);
                o.y = pk2(__uint_as_float(r1 << 16) + p0.z, __uint_as_float(r1 & 0xffff0000u) + p0.w);
                o.z = pk2(__uint_as_float(r2 << 16) + p1.x, __uint_as_float(r2 & 0xffff0000u) + p1.y);
                o.w = pk2(__uint_as_float(r3 << 16) + p1.z, __uint_as_float(r3 & 0xffff0000u) + p1.w);
            }
            *(u32x4*)(A + n * 520 + jj * 64 + dch * 8) = o;
        }
        __syncthreads();
#pragma unroll 4
        for (int s = 0; s < 16; ++s) {
            const bf16x8 a = *(const bf16x8*)(A + (nt * 16 + fr) * 520 + s * 32 + fq * 8);
            const bf16x8 bb = *(const bf16x8*)(W1T + (size_t)(ct * 16 + fr) * 2048 + kc * 512 + s * 32 + fq * 8);
            acc = __builtin_amdgcn_mfma_f32_16x16x32_bf16(a, bb, acc, 0, 0, 0);
        }
        __syncthreads();
    }
#pragma unroll
    for (int r = 0; r < 4; ++r) H[(nt * 16 + fq * 4 + r) * 64 + ct * 16 + fr] = gelu_tanh(acc[r]);
    __syncthreads();
    {
        const int n = tid >> 4, c = (tid & 15) * 4;
        f32x4 o = (f32x4){0.f, 0.f, 0.f, 0.f};
#pragma unroll 8
        for (int i = 0; i < 64; ++i) { const float hv = H[n * 64 + i]; const f32x4 w = *(const f32x4*)(w2 + i * 64 + c); o += hv * w; }
        if (which == 0) {
            const float ss = grp16_sum(o.x * o.x + o.y * o.y + o.z * o.z + o.w * o.w);
            const float r = rsqrtf(ss * (1.0f / 64.0f) + EPS);
            const f32x4 gg = *(const f32x4*)(p.in[7] + c);
            o = o * r * gg;
        }
        if (n0 + n >= NCMP) o = (f32x4){0.f, 0.f, 0.f, 0.f};
        if (which == 0) { u32x2 w; w.x = pk2(o.x, o.y); w.y = pk2(o.z, o.w); *(u32x2*)((bf16*)(p.ws + WS_KC) + ((size_t)(b * 2 + g) * 512 + n0 + n) * 64 + c) = w; }
        else { bf16* vt = (bf16*)(p.ws + WS_VCT) + (size_t)(b * 2 + g) * 64 * 512 + n0 + n; vt[(c + 0) * 512] = f2bf(o.x); vt[(c + 1) * 512] = f2bf(o.y); vt[(c + 2) * 512] = f2bf(o.z); vt[(c + 3) * 512] = f2bf(o.w); }
    }
    __syncthreads();
}

__device__ __forceinline__ int rho16(int reg, int hh) { return (reg & 3) + 8 * (reg >> 2) + 4 * hh; }
__device__ __forceinline__ bf16x8 pack8(const float* pv) {
    u32x4 w; w.x = pk2(pv[0], pv[1]); w.y = pk2(pv[2], pv[3]); w.z = pk2(pv[4], pv[5]); w.w = pk2(pv[6], pv[7]);
    return __builtin_bit_cast(bf16x8, w);
}
__device__ __forceinline__ f32x16 score_tile(const bf16* kp, const bf16x8 (&qf)[4]) {
    f32x16 st;
#pragma unroll
    for (int i = 0; i < 16; ++i) st[i] = 0.f;
#pragma unroll
    for (int s = 0; s < 4; ++s) { const bf16x8 kf = *(const bf16x8*)(kp + s * 16); st = __builtin_amdgcn_mfma_f32_32x32x16_bf16(kf, qf[s], st, 0, 0, 0); }
    return st;
}
__device__ __forceinline__ void pv_tile(f32x16& o0, f32x16& o1, const bf16* vp, size_t vstride32, const float* pv) {
    const bf16x8 p0 = pack8(pv), p1 = pack8(pv + 8);
#pragma unroll
    for (int dt = 0; dt < 2; ++dt) {
        const bf16* v = vp + (size_t)dt * vstride32;
        const u32x2 a0 = *(const u32x2*)(v), a1 = *(const u32x2*)(v + 8), b0 = *(const u32x2*)(v + 16), b1 = *(const u32x2*)(v + 24);
        u32x4 w0, w1; w0.x = a0.x; w0.y = a0.y; w0.z = a1.x; w0.w = a1.y; w1.x = b0.x; w1.y = b0.y; w1.z = b1.x; w1.w = b1.y;
        if (dt == 0) { o0 = __builtin_amdgcn_mfma_f32_32x32x16_bf16(__builtin_bit_cast(bf16x8, w0), p0, o0, 0, 0, 0); o0 = __builtin_amdgcn_mfma_f32_32x32x16_bf16(__builtin_bit_cast(bf16x8, w1), p1, o0, 0, 0, 0); }
        else { o1 = __builtin_amdgcn_mfma_f32_32x32x16_bf16(__builtin_bit_cast(bf16x8, w0), p0, o1, 0, 0, 0); o1 = __builtin_amdgcn_mfma_f32_32x32x16_bf16(__builtin_bit_cast(bf16x8, w1), p1, o1, 0, 0, 0); }
    }
}
__device__ __forceinline__ void softmax_step(float* sv, float& m, float& l, f32x16& o0, f32x16& o1) {
    float ml = sv[0];
#pragma unroll
    for (int i = 1; i < 16; ++i) ml = fmaxf(ml, sv[i]);
    ml = fmaxf(ml, __shfl_xor(ml, 32));
    const float mn = fmaxf(m, ml), alpha = __expf(m - mn);
    m = mn;
    float ps = 0.f;
#pragma unroll
    for (int i = 0; i < 16; ++i) { const float e = (sv[i] > -1e29f) ? __expf(sv[i] - mn) : 0.f; sv[i] = e; ps += e; }
    l = l * alpha + ps;
#pragma unroll
    for (int i = 0; i < 16; ++i) { o0[i] *= alpha; o1[i] *= alpha; }
}
__device__ __forceinline__ void nsa_attn_item(const Params& p, unsigned char* wlds, int item) {
    const int lane = threadIdx.x & 63, c = lane & 31, hh = lane >> 5, jt = c >> 2, r4 = c & 3;
    const int oct = item & 1023, g = (item >> 10) & 1, b = item >> 11;
    const int t0 = oct * 8, tc = t0 + jt, h = g * 4 + r4;
    const float slope = exp2f(-(float)(h + 1));
    const bf16* proj = (const bf16*)(p.ws + WS_PROJ);
    float* impA = (float*)wlds; float* impB = impA + 1024; unsigned* msk = (unsigned*)(impB + 1024);
#pragma unroll
    for (int i = 0; i < 16; ++i) { impA[lane + 64 * i] = 0.f; impB[lane + 64 * i] = 0.f; }
    if (lane < 32) msk[lane] = 0u;
    bf16x8 qf[4];
    { const bf16* qp = proj + (size_t)(b * T + tc) * PS + C_NQ + h * 64 + hh * 8;
#pragma unroll
      for (int s = 0; s < 4; ++s) qf[s] = *(const bf16x8*)(qp + s * 16); }
    f32x16 oc0, oc1;
#pragma unroll
    for (int i = 0; i < 16; ++i) { oc0[i] = 0.f; oc1[i] = 0.f; }
    float gate[3];
    { const bf16* gp = proj + (size_t)(b * T + tc) * PS + C_GT + h * 3;
#pragma unroll
      for (int i = 0; i < 3; ++i) gate[i] = sigmoidf_(bf2f(gp[i])); }
    WAVE_LDS_SYNC();
    {
        const bf16* KC = (const bf16*)(p.ws + WS_KC) + (size_t)(b * 2 + g) * 512 * 64;
        const bf16* VCT = (const bf16*)(p.ws + WS_VCT) + (size_t)(b * 2 + g) * 64 * 512;
        const int nmax = (t0 + 7 >= 31) ? ((t0 + 7 - 31) >> 4) : -1;
        float m = -1e30f, l = 0.f;
        f32x16 o0, o1;
#pragma unroll
        for (int i = 0; i < 16; ++i) { o0[i] = 0.f; o1[i] = 0.f; }
#pragma unroll 1
        for (int n0 = 0; n0 <= nmax; n0 += 32) {
            const f32x16 st = score_tile(KC + (size_t)(n0 + c) * 64 + hh * 8, qf);
            float sv[16];
#pragma unroll
            for (int i = 0; i < 16; ++i) { const int dist = tc - (16 * (n0 + rho16(i, hh)) + 31); sv[i] = (dist >= 0) ? st[i] - slope * (float)dist : -1e30f; }
            float ml = sv[0];
#pragma unroll
            for (int i = 1; i < 16; ++i) ml = fmaxf(ml, sv[i]);
            ml = fmaxf(ml, __shfl_xor(ml, 32));
            const float mn = fmaxf(m, ml); float ps = 0.f;
#pragma unroll
            for (int i = 0; i < 16; ++i) ps += (sv[i] > -1e29f) ? __expf(sv[i] - mn) : 0.f;
            l = l * __expf(m - mn) + ps; m = mn;
        }
        l += __shfl_xor(l, 32);
        const float inv = 1.0f / fmaxf(l, 1e-30f);
#pragma unroll 1
        for (int n0 = 0; n0 <= nmax; n0 += 32) {
            const f32x16 st = score_tile(KC + (size_t)(n0 + c) * 64 + hh * 8, qf);
            float pv[16];
#pragma unroll
            for (int i = 0; i < 16; ++i) { const int dist = tc - (16 * (n0 + rho16(i, hh)) + 31); pv[i] = (dist >= 0) ? __expf(st[i] - slope * (float)dist - m) * inv : 0.f; }
            pv_tile(o0, o1, VCT + (size_t)c * 512 + n0 + 4 * hh, (size_t)32 * 512, pv);
#pragma unroll
            for (int i = 0; i < 16; ++i) { float v = pv[i]; v += dpp_f<0xB1>(v); v += dpp_f<0x4E>(v); pv[i] = v; }
            if (r4 == 0) {
#pragma unroll
                for (int rg = 0; rg < 4; ++rg) {
                    const int jb = (n0 >> 2) + 2 * rg + hh;
                    impA[jt * 128 + jb] = pv[4 * rg] + 2.f * pv[4 * rg + 1] + 2.f * pv[4 * rg + 2] + 2.f * pv[4 * rg + 3];
                    if (jb >= 1) impB[jt * 128 + jb - 1] = pv[4 * rg];
                }
            }
        }
#pragma unroll
        for (int i = 0; i < 16; ++i) { oc0[i] = gate[0] * o0[i]; oc1[i] = gate[0] * o1[i]; }
    }
    WAVE_LDS_SYNC();
    {
        const int lig = lane & 15, grp = lane >> 4;
#pragma unroll 1
        for (int half = 0; half < 2; ++half) {
            const int j2 = half * 4 + grp, cur = (t0 + j2) >> 6;
            float v[8];
#pragma unroll
            for (int e = 0; e < 8; ++e) {
                const int j = lig * 8 + e; const float val = impA[j2 * 128 + j] + impB[j2 * 128 + j];
                v[e] = (j >= 1 && j <= cur - 2) ? __uint_as_float((__float_as_uint(val) & ~127u) | (unsigned)(127 - j)) : -1.0f;
            }
            const float top = grp16_top16(v, lig);
            const int need = 16 - ((cur == 0) ? 1 : (cur == 1) ? 2 : 3);
            if (lig < need && top >= 0.f) { const int idx = 127 - (int)(__float_as_uint(top) & 127u); atomicOr(&msk[j2 * 4 + (idx >> 5)], 1u << (idx & 31)); }
            if (lig == 0) { atomicOr(&msk[j2 * 4], 1u); atomicOr(&msk[j2 * 4 + (cur >> 5)], 1u << (cur & 31)); if (cur >= 1) atomicOr(&msk[j2 * 4 + ((cur - 1) >> 5)], 1u << ((cur - 1) & 31)); }
        }
    }
    WAVE_LDS_SYNC();
    {
        unsigned mym[4], um[4];
#pragma unroll
        for (int w = 0; w < 4; ++w) { mym[w] = msk[jt * 4 + w]; unsigned u = 0u;
#pragma unroll
            for (int j = 0; j < 8; ++j) u |= msk[j * 4 + w];
            um[w] = (unsigned)__builtin_amdgcn_readfirstlane((int)u); }
        const bf16* VTS = (const bf16*)(p.ws + WS_VTS) + (size_t)(b * 2 + g) * 64 * T;
        float m = -1e30f, l = 0.f;
        f32x16 o0, o1;
#pragma unroll
        for (int i = 0; i < 16; ++i) { o0[i] = 0.f; o1[i] = 0.f; }
#pragma unroll
        for (int w = 0; w < 4; ++w) {
            unsigned u = um[w];
#pragma unroll 1
            while (u) {
                const int bit = __builtin_ctz(u); u &= u - 1u;
                const int jb = w * 32 + bit;
                const bool colsel = (mym[w] >> bit) & 1u;
#pragma unroll 1
                for (int hf = 0; hf < 2; ++hf) {
                    const int key0 = jb * 64 + hf * 32;
                    const f32x16 st = score_tile(proj + (size_t)(b * T + key0 + c) * PS + C_KS + g * 64 + hh * 8, qf);
                    float sv[16];
#pragma unroll
                    for (int i = 0; i < 16; ++i) { const int dist = tc - (key0 + rho16(i, hh)); sv[i] = (colsel && dist >= 0) ? st[i] - slope * (float)dist : -1e30f; }
                    softmax_step(sv, m, l, o0, o1);
                    pv_tile(o0, o1, VTS + (size_t)c * T + key0 + 4 * hh, (size_t)32 * T, sv);
                }
            }
        }
        l += __shfl_xor(l, 32);
        const float sc = gate[1] / fmaxf(l, 1e-30f);
#pragma unroll
        for (int i = 0; i < 16; ++i) { oc0[i] += sc * o0[i]; oc1[i] += sc * o1[i]; }
    }
    {
        const bf16* VTW = (const bf16*)(p.ws + WS_VTW) + (size_t)(b * 2 + g) * 64 * T;
        float m = -1e30f, l = 0.f;
        f32x16 o0, o1;
#pragma unroll
        for (int i = 0; i < 16; ++i) { o0[i] = 0.f; o1[i] = 0.f; }
        const int kstart = (t0 - 511 > 0 ? t0 - 511 : 0) & ~31;
#pragma unroll 1
        for (int key0 = kstart; key0 <= t0 + 7; key0 += 32) {
            const f32x16 st = score_tile(proj + (size_t)(b * T + key0 + c) * PS + C_KW + g * 64 + hh * 8, qf);
            float sv[16];
#pragma unroll
            for (int i = 0; i < 16; ++i) { const int dist = tc - (key0 + rho16(i, hh)); sv[i] = (dist >= 0 && dist < 512) ? st[i] - slope * (float)dist : -1e30f; }
            softmax_step(sv, m, l, o0, o1);
            pv_tile(o0, o1, VTW + (size_t)c * T + key0 + 4 * hh, (size_t)32 * T, sv);
        }
        l += __shfl_xor(l, 32);
        const float sc = gate[2] / fmaxf(l, 1e-30f);
#pragma unroll
        for (int i = 0; i < 16; ++i) { oc0[i] += sc * o0[i]; oc1[i] += sc * o1[i]; }
    }
    {
        float ss = 0.f;
#pragma unroll
        for (int i = 0; i < 16; ++i) ss += oc0[i] * oc0[i] + oc1[i] * oc1[i];
        ss += __shfl_xor(ss, 32);
        const float r = rsqrtf(ss * (1.0f / 64.0f) + EPS);
        const float* og = p.in[11] + h * 64;
        bf16* op = (bf16*)(p.ws + WS_ACT) + (size_t)(b * T + tc) * D + 512 + h * 64;
#pragma unroll
        for (int dt = 0; dt < 2; ++dt)
#pragma unroll
            for (int rg = 0; rg < 4; ++rg) {
                const int d0 = dt * 32 + 8 * rg + 4 * hh;
                const f32x4 gg = *(const f32x4*)(og + d0);
                u32x2 w;
                if (dt == 0) { w.x = pk2(oc0[4 * rg] * r * gg.x, oc0[4 * rg + 1] * r * gg.y); w.y = pk2(oc0[4 * rg + 2] * r * gg.z, oc0[4 * rg + 3] * r * gg.w); }
                else { w.x = pk2(oc1[4 * rg] * r * gg.x, oc1[4 * rg + 1] * r * gg.y); w.y = pk2(oc1[4 * rg + 2] * r * gg.z, oc1[4 * rg + 3] * r * gg.w); }
                *(u32x2*)(op + d0) = w;
            }
    }
    WAVE_LDS_SYNC();
}
__device__ __forceinline__ void phase2(const Params& p, unsigned char* lds) {
    for (int it = blockIdx.x; it < 128 + 256 + 1024; it += gridDim.x) {
        if (it < 128) nsa_cmp_item(p, lds, it);
        else if (it < 384) nsa_prep_item(p, lds, it - 128);
        else hgrn_pre_item(p, lds, it - 384);
    }
}
template <bool SCAN>
__device__ __forceinline__ void phase3(const Params& p, unsigned char* lds) {
    const int gw = (blockIdx.x * NTHR + threadIdx.x) >> 6;
    const int wid = threadIdx.x >> 6;
    if (SCAN && wid == 0 && blockIdx.x < 64) hgrn_scan_item<false>(p, blockIdx.x);
    const int ngw = (gridDim.x * NTHR) >> 6;
    for (int it = gw; it < 4096; it += ngw) nsa_attn_item(p, lds + wid * 8320, 4095 - it);
}

__device__ __forceinline__ float dot2u(unsigned a, unsigned b, float acc) { return __builtin_amdgcn_fdot2_f32_bf16(__builtin_bit_cast(bf16x2v, a), __builtin_bit_cast(bf16x2v, b), acc, false); }
__device__ __forceinline__ float dot8(u32x4 a, u32x4 b, float acc) {
    const unsigned a0 = a.x, a1 = a.y, a2 = a.z, a3 = a.w, b0 = b.x, b1 = b.y, b2 = b.z, b3 = b.w;
    acc = dot2u(a0, b0, acc); acc = dot2u(a1, b1, acc); acc = dot2u(a2, b2, acc); acc = dot2u(a3, b3, acc);
    return acc;
}
__device__ __forceinline__ void axpy8(float (&o)[8], float c, u32x4 v) {
    o[0] += c * __uint_as_float(v.x << 16); o[1] += c * __uint_as_float(v.x & 0xffff0000u);
    o[2] += c * __uint_as_float(v.y << 16); o[3] += c * __uint_as_float(v.y & 0xffff0000u);
    o[4] += c * __uint_as_float(v.z << 16); o[5] += c * __uint_as_float(v.z & 0xffff0000u);
    o[6] += c * __uint_as_float(v.w << 16); o[7] += c * __uint_as_float(v.w & 0xffff0000u);
}
template <bool DUMMY>
__device__ __forceinline__ void phase9(const Params& p, unsigned char* lds) {
    const bf16* HN = (const bf16*)(p.ws + WS_ACT); const bf16* UB = (const bf16*)(p.ws + WS_UB); const bf16* VB = (const bf16*)(p.ws + WS_VB);
    const int* ids = (const int*)(p.ws + WS_IDS); const float* wts = (const float*)(p.ws + WS_WTS);
    float* O = p.out; bf16* HG = (bf16*)(p.ws + WS_PROJ + 64 * MiB); const float* gn = p.in[19];
    const int lane = threadIdx.x & 63, gw = (blockIdx.x * NTHR + threadIdx.x) >> 6, ngw = (gridDim.x * NTHR) >> 6;
    for (int tok = gw; tok < NTOK; tok += ngw) {
        const u32x4 x0 = *(const u32x4*)(HN + (size_t)tok * D + lane * 8), x1 = *(const u32x4*)(HN + (size_t)tok * D + 512 + lane * 8);
        float oa[8], ob[8];
#pragma unroll
        for (int j = 0; j < 8; ++j) { oa[j] = 0.f; ob[j] = 0.f; }
#pragma unroll 1
        for (int half = 0; half < 2; ++half) {
            const int myid = ids[(size_t)tok * 128 + half * 64 + lane]; const float myw = wts[(size_t)tok * 128 + half * 64 + lane];
#pragma unroll 1
            for (int eb = 0; eb < 64; eb += 8) {
                int id[8]; float d[8];
#pragma unroll
                for (int j = 0; j < 8; ++j) id[j] = __shfl(myid, eb + j);
                u32x4 ua[8], ub[8];
#pragma unroll
                for (int j = 0; j < 8; ++j) { const bf16* ur = UB + (size_t)id[j] * D; ua[j] = *(const u32x4*)(ur + lane * 8); ub[j] = *(const u32x4*)(ur + 512 + lane * 8); }
#pragma unroll
                for (int j = 0; j < 8; ++j) { d[j] = dot8(ub[j], x1, dot8(ua[j], x0, 0.f)); }
#pragma unroll
                for (int j = 0; j < 8; ++j) { const bf16* vr = VB + (size_t)id[j] * D; ua[j] = *(const u32x4*)(vr + lane * 8); ub[j] = *(const u32x4*)(vr + 512 + lane * 8); }
#pragma unroll
                for (int j = 0; j < 8; ++j) d[j] = wave_sum(d[j]);
#pragma unroll
                for (int j = 0; j < 8; ++j) { const float c = __shfl(myw, eb + j) * gelu_tanh(d[j]); axpy8(oa, c, ua[j]); axpy8(ob, c, ub[j]); }
            }
        }
        float* orow = O + (size_t)tok * D; float* wrow = DUMMY ? (float*)(p.ws + WS_PROJ) + (size_t)tok * D : orow;
        f32x4 h0 = *(const f32x4*)(orow + lane * 8), h1 = *(const f32x4*)(orow + lane * 8 + 4), h2 = *(const f32x4*)(orow + 512 + lane * 8), h3 = *(const f32x4*)(orow + 512 + lane * 8 + 4);
        h0.x += oa[0]; h0.y += oa[1]; h0.z += oa[2]; h0.w += oa[3]; h1.x += oa[4]; h1.y += oa[5]; h1.z += oa[6]; h1.w += oa[7];
        h2.x += ob[0]; h2.y += ob[1]; h2.z += ob[2]; h2.w += ob[3]; h3.x += ob[4]; h3.y += ob[5]; h3.z += ob[6]; h3.w += ob[7];
        *(f32x4*)(wrow + lane * 8) = h0; *(f32x4*)(wrow + lane * 8 + 4) = h1; *(f32x4*)(wrow + 512 + lane * 8) = h2; *(f32x4*)(wrow + 512 + lane * 8 + 4) = h3;
        float ss = h0.x * h0.x + h0.y * h0.y + h0.z * h0.z + h0.w * h0.w + h1.x * h1.x + h1.y * h1.y + h1.z * h1.z + h1.w * h1.w
                 + h2.x * h2.x + h2.y * h2.y + h2.z * h2.z + h2.w * h2.w + h3.x * h3.x + h3.y * h3.y + h3.z * h3.z + h3.w * h3.w;
        ss = wave_sum(ss);
        const float r = rsqrtf(ss * (1.0f / D) + EPS);
        const f32x4 g0 = *(const f32x4*)(gn + lane * 8), g1 = *(const f32x4*)(gn + lane * 8 + 4), g2 = *(const f32x4*)(gn + 512 + lane * 8), g3 = *(const f32x4*)(gn + 512 + lane * 8 + 4);
        u32x4 q0, q1;
        q0.x = pk2(h0.x * r * g0.x, h0.y * r * g0.y); q0.y = pk2(h0.z * r * g0.z, h0.w * r * g0.w); q0.z = pk2(h1.x * r * g1.x, h1.y * r * g1.y); q0.w = pk2(h1.z * r * g1.z, h1.w * r * g1.w);
        q1.x = pk2(h2.x * r * g2.x, h2.y * r * g2.y); q1.y = pk2(h2.z * r * g2.z, h2.w * r * g2.w); q1.z = pk2(h3.x * r * g3.x, h3.y * r * g3.y); q1.w = pk2(h3.z * r * g3.z, h3.w * r * g3.w);
        *(u32x4*)(HG + (size_t)tok * D + lane * 8) = q0; *(u32x4*)(HG + (size_t)tok * D + 512 + lane * 8) = q1;
    }
}

#define XB_TMO      128
#define XB_XCNT(j)  (256  + 64 * (j))
#define XB_XSUB(j)  (1280 + 64 * (j))
#define XB_XGEN(j)  (2304 + 64 * (j))
#define XB_TOP      3328
#define XB_TOPGEN   3392
#define XCD_BAR_WORDS 3456
#define XB_SPIN_CAP (1u << 18)
#define LAS __attribute__((address_space(3)))
__device__ __forceinline__ unsigned xb_ld(unsigned* p)              { return __hip_atomic_load(p, __ATOMIC_RELAXED, __HIP_MEMORY_SCOPE_AGENT); }
__device__ __forceinline__ unsigned xb_add(unsigned* p, unsigned v) { return __hip_atomic_fetch_add(p, v, __ATOMIC_RELAXED, __HIP_MEMORY_SCOPE_AGENT); }
__device__ __forceinline__ unsigned xb_xcc_id() { return (unsigned)__builtin_amdgcn_s_getreg((3 << 11) | 20) & 0xFu; }
#define XB_SPIN(cond, bar) do { unsigned _sp = 0; while (cond) { __builtin_amdgcn_s_sleep(1); \
    if ((++_sp & 255u) == 0u) { if (xb_ld(&(bar)[XB_TMO])) break; if (_sp > XB_SPIN_CAP) { atomicAdd(&(bar)[XB_TMO], 1u); break; } } } } while (0)
struct XcdBarrier { unsigned* bar; unsigned x; volatile LAS unsigned* st; };
__device__ __forceinline__ XcdBarrier xcd_barrier_post(unsigned* bar, volatile LAS unsigned* st) {
    XcdBarrier b; b.bar = bar; b.x = xb_xcc_id(); b.st = st;
    if (threadIdx.x == 0) (void)xb_add(&bar[XB_XCNT(b.x)], 1u);
    return b;
}
__device__ __forceinline__ void xcd_barrier_complete(unsigned* bar, unsigned x, unsigned& nloc, unsigned& nx) {
    const unsigned G = gridDim.x * gridDim.y * gridDim.z;
    unsigned sum, cnt, mine, sp = 0u;
    for (;;) {
        sum = 0u; cnt = 0u; mine = 0u;
#pragma unroll
        for (unsigned j = 0; j < 16; ++j) { const unsigned c = xb_ld(&bar[XB_XCNT(j)]); sum += c; cnt += (c > 0u) ? 1u : 0u; mine = (j == x) ? c : mine; }
        if (sum == G) break;
        __builtin_amdgcn_s_sleep(1);
        if ((++sp & 255u) == 0u) { if (xb_ld(&bar[XB_TMO])) break; if (sp > XB_SPIN_CAP) { atomicAdd(&bar[XB_TMO], 1u); break; } }
    }
    nloc = mine > 0u ? mine : 1u; nx = cnt > 0u ? cnt : 1u;
}
__device__ __forceinline__ void xcd_barrier(const XcdBarrier& b) {
    asm volatile("s_waitcnt vmcnt(0)" ::: "memory");
    __syncthreads();
    if (threadIdx.x == 0) {
        unsigned* bar = b.bar;
        __builtin_amdgcn_s_waitcnt(0);
        unsigned nloc = b.st[0], nx = b.st[1];
        if (nloc == 0u) { xcd_barrier_complete(bar, b.x, nloc, nx); b.st[0] = nloc; b.st[1] = nx; }
        const unsigned old = xb_add(&bar[XB_XSUB(b.x)], 1u);
        const unsigned gen = old / nloc;
        if (old + 1u == (gen + 1u) * nloc) {
            __builtin_amdgcn_fence(__ATOMIC_RELEASE, "agent");
            asm volatile("s_waitcnt vmcnt(0)" ::: "memory");
            const unsigned og = xb_add(&bar[XB_TOP], 1u);
            const unsigned tg = og / nx;
            if (og + 1u == (tg + 1u) * nx) xb_add(&bar[XB_TOPGEN], 1u);
            else XB_SPIN(xb_ld(&bar[XB_TOPGEN]) == tg, bar);
            __builtin_amdgcn_fence(__ATOMIC_ACQUIRE, "agent");
            xb_add(&bar[XB_XGEN(b.x)], 1u);
            asm volatile("s_waitcnt vmcnt(0)" ::: "memory");
        } else {
            XB_SPIN(xb_ld(&bar[XB_XGEN(b.x)]) == gen, bar);
            __builtin_amdgcn_fence(__ATOMIC_ACQUIRE, "agent");
            asm volatile("s_waitcnt vmcnt(0)" ::: "memory");
        }
    }
    __syncthreads();
}

constexpr int REPK = -1;
__global__ void __launch_bounds__(NTHR, 2) mega(Params p, int ph_lo, int ph_hi) {
    extern __shared__ __attribute__((aligned(16))) unsigned char lds[];
    volatile LAS unsigned* st = (volatile LAS unsigned*)(LAS unsigned char*)(lds + LDS_BYTES - 16);
    if (threadIdx.x < 4) st[threadIdx.x] = 0u;
    __syncthreads();
    const XcdBarrier bar = xcd_barrier_post((unsigned*)p.ws, st);
#define RUN_PHASE(k, call) if (ph_lo <= (k) && (k) < ph_hi) { if ((k) > ph_lo) xcd_barrier(bar); call; if (REPK == (k)) { xcd_barrier(bar); call; } }
    RUN_PHASE(0, phase0(p, lds))
    RUN_PHASE(1, phase1(p, lds))
    RUN_PHASE(2, phase2(p, lds))
    if (REPK == 30) { xcd_barrier(bar); if ((threadIdx.x >> 6) == 0 && blockIdx.x < 64) hgrn_scan_item<true>(p, blockIdx.x); }
    if (ph_lo <= 3 && 3 < ph_hi) { if (3 > ph_lo) xcd_barrier(bar); phase3<true>(p, lds); if (REPK == 3) { xcd_barrier(bar); phase3<false>(p, lds); } }
    RUN_PHASE(4, phase4(p, lds))
    RUN_PHASE(5, phase5(p, lds))
    RUN_PHASE(6, phase6(p, lds))
    RUN_PHASE(7, phase7(p, lds))
    RUN_PHASE(8, phase8(p, lds))
    if (REPK == 9) { xcd_barrier(bar); phase9<true>(p, lds); }
    if (ph_lo <= 9 && 9 < ph_hi) { if (9 > ph_lo) xcd_barrier(bar); phase9<false>(p, lds); }
    RUN_PHASE(10, phase10(p, lds))
}

static void launch_mega(const Params& p, int lo, int hi, hipStream_t stream) {
    static int grid = 0;
    if (grid == 0) {
        int dev = 0, cus = 0, per_cu = 0;
        hipGetDevice(&dev); hipDeviceGetAttribute(&cus, hipDeviceAttributeMultiprocessorCount, dev);
        hipFuncSetAttribute((const void*)mega, hipFuncAttributeMaxDynamicSharedMemorySize, LDS_BYTES);
        hipOccupancyMaxActiveBlocksPerMultiprocessor(&per_cu, (const void*)mega, NTHR, LDS_BYTES);
        if (per_cu < 1) { fprintf(stderr, "mega: occupancy query says %d blocks/CU\n", per_cu); per_cu = 1; }
        grid = cus;
    }
    hipMemsetAsync(p.ws, 0, 65536, stream);
    Params pp = p; int l = lo, h = hi;
    void* args[] = {&pp, &l, &h};
    hipError_t e = hipLaunchCooperativeKernel((const void*)mega, dim3(grid), dim3(NTHR), args, LDS_BYTES, stream);
    if (e != hipSuccess) fprintf(stderr, "cooperative launch failed: %s (grid %d)\n", hipGetErrorString(e), grid);
}

extern "C" void kernel_launch(void* const* d_in, const int* in_sizes, int n_in, void* d_out, int out_size, void* d_ws, size_t ws_size, hipStream_t stream) {
    const float* x = (const float*)d_in[0]; const float* p = (const float*)d_in[1]; const float* mix_norm = (const float*)d_in[2]; const float* w_in = (const float*)d_in[3];
    const float* lb_logits = (const float*)d_in[4]; const float* hg_out_norm = (const float*)d_in[5]; const float* q_norm = (const float*)d_in[6]; const float* k_norm = (const float*)d_in[7];
    const float* cmp_pe = (const float*)d_in[8]; const float* cmp_w1 = (const float*)d_in[9]; const float* cmp_w2 = (const float*)d_in[10]; const float* nsa_out_norm = (const float*)d_in[11];
    const float* w_out = (const float*)d_in[12]; const float* ffn_norm = (const float*)d_in[13]; const float* peer_wq = (const float*)d_in[14]; const float* peer_keys = (const float*)d_in[15];
    const float* peer_u = (const float*)d_in[16]; const float* peer_v = (const float*)d_in[17]; const float* ple_proj = (const float*)d_in[18]; const float* ple_gate_norm = (const float*)d_in[19];
    const float* ple_gate_w = (const float*)d_in[20];
    float* out = (float*)d_out; unsigned char* ws = (unsigned char*)d_ws;
    bf16* act = (bf16*)(ws + WS_ACT); bf16* proj = (bf16*)(ws + WS_PROJ);
    bf16* pq = (bf16*)(ws + WS_PROJ); bf16* hg = (bf16*)(ws + WS_PROJ + 64 * MiB);
    int* ids = (int*)(ws + WS_IDS); float* wts = (float*)(ws + WS_WTS); float* kcf = (float*)(ws + WS_KCF); float* vcf = (float*)(ws + WS_VCF); float* gl = (float*)(ws + WS_GL);

    Params prm{}; for (int i = 0; i < 21; ++i) prm.in[i] = (const float*)d_in[i]; prm.out = out; prm.ws = ws;
    launch_mega(prm, 0, 11, stream);
}
```

```cpp
#include <hip/hip_runtime.h>
#include <hip/hip_cooperative_groups.h>
#include <cstdint>
#include <cstdio>
namespace cg = cooperative_groups;

constexpr int D = 1024, NB = 2, T = 8192, NTOK = NB * T;
constexpr int DIN = 3352, PS = 3392;
constexpr int C_HQ = 0, C_HF = 512, C_HI = 1024, C_HG = 1536, C_NQ = 2048, C_KC = 2560, C_VC = 2688,
              C_KS = 2816, C_VS = 2944, C_KW = 3072, C_VW = 3200, C_GT = 3328;
constexpr int NCMP = 511;
constexpr float EPS = 1e-6f;
typedef unsigned short bf16;

constexpr size_t MiB = 1u << 20;
constexpr size_t WS_WINT = 1 * MiB;
constexpr size_t WS_WOUTT = 8 * MiB;
constexpr size_t WS_WQT = 10 * MiB;
constexpr size_t WS_WGT = 14 * MiB;
constexpr size_t WS_WPT = 16 * MiB;
constexpr size_t WS_KEYB = 16 * MiB + 512 * 1024;
constexpr size_t WS_W1T = 17 * MiB;
constexpr size_t WS_CTR = 16384;
constexpr size_t WS_US = 256 * 1024;
constexpr size_t WS_VS = 320 * 1024;
constexpr size_t WS_UB = 18 * MiB;
constexpr size_t WS_VB = 50 * MiB;
constexpr size_t WS_ACT = 82 * MiB;
constexpr size_t WS_PROJ = 114 * MiB;
constexpr size_t WS_SPARE = 220 * MiB;
constexpr size_t WS_IDS = WS_SPARE;
constexpr size_t WS_WTS = WS_SPARE + 8 * MiB;
constexpr size_t WS_KCF = WS_SPARE + 16 * MiB;
constexpr size_t WS_VCF = WS_SPARE + 17 * MiB;
constexpr size_t WS_PB = WS_SPARE + 18 * MiB;
constexpr size_t WS_VTS = WS_SPARE + 26 * MiB;
constexpr size_t WS_VTW = WS_SPARE + 30 * MiB;
constexpr size_t WS_KC = WS_SPARE + 34 * MiB;
constexpr size_t WS_VCT = WS_SPARE + 34 * MiB + 256 * 1024;
constexpr size_t WS_DEC = WS_SPARE + 34 * MiB + 512 * 1024;
constexpr size_t OUT_KIT = 32 * MiB;
constexpr size_t OUT_VT = 48 * MiB;
constexpr size_t WS_GL = 18 * MiB;

__device__ __forceinline__ float bf2f(bf16 v) { return __uint_as_float(((unsigned)v) << 16); }
__device__ __forceinline__ bf16 f2bf(float f) { unsigned u = __float_as_uint(f); return (bf16)((u + 0x7fffu + ((u >> 16) & 1u)) >> 16); }
__device__ __forceinline__ float wave_sum(float v) {
#pragma unroll
    for (int o = 1; o < 64; o <<= 1) v += __shfl_xor(v, o);
    return v;
}
__device__ __forceinline__ float wave_max(float v) {
#pragma unroll
    for (int o = 1; o < 64; o <<= 1) v = fmaxf(v, __shfl_xor(v, o));
    return v;
}
__device__ __forceinline__ float sigmoidf_(float x) { return 1.0f / (1.0f + __expf(-x)); }
__device__ __forceinline__ float siluf_(float x) { return x * sigmoidf_(x); }
__device__ __forceinline__ float gelu_tanh(float x) { return 0.5f * x * (1.0f + tanhf(0.7978845608028654f * (x + 0.044715f * x * x * x))); }
__device__ __forceinline__ float toF(float v) { return v; }
__device__ __forceinline__ float toF(bf16 v) { return bf2f(v); }

__global__ void __launch_bounds__(256) k_rms_rows(const float* __restrict__ x, const float* __restrict__ g, bf16* __restrict__ out, int rows) {
    const int wave = (blockIdx.x * 256 + threadIdx.x) >> 6, lane = threadIdx.x & 63;
    if (wave >= rows) return;
    const float* xr = x + (size_t)wave * D;
    float v[16]; float s = 0.f;
#pragma unroll
    for (int j = 0; j < 16; ++j) { v[j] = xr[lane + 64 * j]; s += v[j] * v[j]; }
    s = wave_sum(s);
    const float r = rsqrtf(s * (1.0f / D) + EPS);
#pragma unroll
    for (int j = 0; j < 16; ++j) out[(size_t)wave * D + lane + 64 * j] = f2bf(v[j] * r * g[lane + 64 * j]);
}

struct EpiBf16 { bf16* C; int ldc; int pad; __device__ void operator()(int r, int c, float v) const { C[(size_t)r * ldc + c] = f2bf(v); } };
struct EpiF32 { float* C; int ldc; int pad; __device__ void operator()(int r, int c, float v) const { C[(size_t)r * ldc + c] = v; } };
struct EpiResid { const float* X; float* O; int ld; int pad; __device__ void operator()(int r, int c, float v) const { O[(size_t)r * ld + c] = X[(size_t)r * ld + c] + v; } };
struct EpiFinal { const float* G; float* O; int ld; int pad; __device__ void operator()(int r, int c, float v) const { const size_t i = (size_t)r * ld + c; O[i] = O[i] + v * sigmoidf_(G[i]); } };

template <typename AT, class Epi>
__global__ void __launch_bounds__(256) k_gemm_naive(const AT* __restrict__ A, int lda, const float* __restrict__ W, int ldw, int N, int K, Epi epi) {
    __shared__ float As[16][65];
    __shared__ float Bs[16][64];
    const int tid = threadIdx.x, tx = tid & 15, ty = tid >> 4;
    const int m0 = blockIdx.y * 64, n0 = blockIdx.x * 64;
    float acc[4][4];
#pragma unroll
    for (int i = 0; i < 4; ++i)
#pragma unroll
        for (int j = 0; j < 4; ++j) acc[i][j] = 0.f;
    for (int k0 = 0; k0 < K; k0 += 16) {
#pragma unroll
        for (int i = 0; i < 4; ++i) { const int idx = tid + i * 256, r = idx >> 4, kk = idx & 15; As[kk][r] = toF(A[(size_t)(m0 + r) * lda + k0 + kk]); }
#pragma unroll
        for (int i = 0; i < 4; ++i) { const int idx = tid + i * 256, kk = idx >> 6, c = idx & 63; Bs[kk][c] = (n0 + c < N) ? W[(size_t)(k0 + kk) * ldw + n0 + c] : 0.f; }
        __syncthreads();
#pragma unroll
        for (int kk = 0; kk < 16; ++kk) {
            float a[4], b[4];
#pragma unroll
            for (int i = 0; i < 4; ++i) a[i] = As[kk][ty * 4 + i];
#pragma unroll
            for (int j = 0; j < 4; ++j) b[j] = Bs[kk][tx * 4 + j];
#pragma unroll
            for (int i = 0; i < 4; ++i)
#pragma unroll
                for (int j = 0; j < 4; ++j) acc[i][j] += a[i] * b[j];
        }
        __syncthreads();
    }
#pragma unroll
    for (int i = 0; i < 4; ++i)
#pragma unroll
        for (int j = 0; j < 4; ++j) { const int r = m0 + ty * 4 + i, c = n0 + tx * 4 + j; if (c < N) epi(r, c, acc[i][j]); }
}

__global__ void __launch_bounds__(1024) k_hgrn_naive(const bf16* __restrict__ proj, const float* __restrict__ lb_logits, const float* __restrict__ out_gain, bf16* __restrict__ mixed) {
    const int b = blockIdx.x >> 2, h = blockIdx.x & 3, tid = threadIdx.x, v = tid & 127, kg = tid >> 7;
    __shared__ float qsh[128], ksh[128], fsh[128], vsh[128], part[8][128], red[2], lbs[128];
    if (tid < 128) { const float l0 = lb_logits[h * 128 + tid], l1 = lb_logits[512 + h * 128 + tid]; const float m = fmaxf(l0, l1); const float e0 = expf(l0 - m), e1 = expf(l1 - m); lbs[tid] = e0 / (e0 + e1); }
    float S[16];
#pragma unroll
    for (int i = 0; i < 16; ++i) S[i] = 0.f;
    __syncthreads();
    for (int t = 0; t < T; ++t) {
        const size_t row = (size_t)(b * T + t) * PS;
        if (tid < 128) {
            const float fl = bf2f(proj[row + C_HF + h * 128 + tid]); const float lb = lbs[tid];
            const float fg = lb + (1.0f - lb) * sigmoidf_(fl); fsh[tid] = fg; ksh[tid] = 1.0f - fg;
            qsh[tid] = siluf_(bf2f(proj[row + C_HQ + h * 128 + tid])) * 0.08838834764831845f;
        } else if (tid < 256) vsh[tid - 128] = bf2f(proj[row + C_HI + h * 128 + tid - 128]);
        __syncthreads();
        const float vv = vsh[v]; float p = 0.f;
#pragma unroll
        for (int i = 0; i < 16; ++i) { const int k = kg * 16 + i; S[i] = fsh[k] * S[i] + ksh[k] * vv; p += qsh[k] * S[i]; }
        part[kg][v] = p;
        __syncthreads();
        float o = 0.f;
        if (tid < 128) {
#pragma unroll
            for (int j = 0; j < 8; ++j) o += part[j][tid];
            const float ss = wave_sum(o * o); if ((tid & 63) == 0) red[tid >> 6] = ss;
        }
        __syncthreads();
        if (tid < 128) {
            const float tot = red[0] + red[1];
            const float y = o * rsqrtf(tot * (1.0f / 128.0f) + EPS) * out_gain[h * 128 + tid];
            const float gl = bf2f(proj[row + C_HG + h * 128 + tid]);
            mixed[(size_t)(b * T + t) * D + h * 128 + tid] = f2bf(y * siluf_(gl));
        }
    }
}

__global__ void __launch_bounds__(64) k_cmp_naive(const bf16* __restrict__ proj, const float* __restrict__ pe, const float* __restrict__ w1, const float* __restrict__ w2,
                                                  const float* __restrict__ k_gain, float* __restrict__ kc, float* __restrict__ vc) {
    int it = blockIdx.x; const int n = it % NCMP; it /= NCMP; const int g = it & 1; it >>= 1; const int b = it & 1; const int which = it >> 1;
    const int c = threadIdx.x;
    __shared__ float blk[2048]; __shared__ float hid[64];
    const int col0 = (which == 0 ? C_KC : C_VC) + g * 64;
    for (int i = c; i < 2048; i += 64) { const int j = i >> 6, d = i & 63; blk[i] = bf2f(proj[(size_t)(b * T + 16 * n + j) * PS + col0 + d]) + pe[which * 2048 + i]; }
    __syncthreads();
    float acc = 0.f;
    for (int i = 0; i < 2048; ++i) acc += blk[i] * w1[(size_t)which * 2048 * 64 + (size_t)i * 64 + c];
    hid[c] = gelu_tanh(acc);
    __syncthreads();
    float o = 0.f;
    for (int i = 0; i < 64; ++i) o += hid[i] * w2[which * 4096 + i * 64 + c];
    if (which == 0) { const float ss = wave_sum(o * o); o = o * rsqrtf(ss * (1.0f / 64.0f) + EPS) * k_gain[c]; }
    (which == 0 ? kc : vc)[((size_t)(b * 2 + g) * NCMP + n) * 64 + c] = o;
}

__global__ void __launch_bounds__(256) k_nsa_naive(const bf16* __restrict__ proj, const float* __restrict__ kc, const float* __restrict__ vc, const float* __restrict__ q_gain,
                                                   const float* __restrict__ k_gain, const float* __restrict__ out_gain, bf16* __restrict__ mixed) {
    const int g = blockIdx.x & 1, tok = blockIdx.x >> 1, b = tok / T, t = tok % T;
    const int tid = threadIdx.x, r = tid >> 6, lane = tid & 63, h = g * 4 + r;
    __shared__ float qs[4][64]; __shared__ float sc[4][1024]; __shared__ float P[520]; __shared__ float imp[128]; __shared__ int sel[128]; __shared__ int blist[16]; __shared__ int nbs;
    const float slope = exp2f(-(float)(h + 1));
    const float NEG = -__builtin_huge_valf();
    {
        float qv = bf2f(proj[(size_t)tok * PS + C_NQ + h * 64 + lane]);
        const float ss = wave_sum(qv * qv);
        qs[r][lane] = qv * rsqrtf(ss * (1.0f / 64.0f) + EPS) * q_gain[lane] * 0.125f;
    }
    __syncthreads();
    const int nvalid = (t >= 31) ? ((t - 31) / 16 + 1) : 0;
    const float* kcb = kc + (size_t)(b * 2 + g) * NCMP * 64; const float* vcb = vc + (size_t)(b * 2 + g) * NCMP * 64;
    float mx = NEG;
    for (int n = lane; n < 512; n += 64) {
        float s = NEG;
        if (n < nvalid) { float d = 0.f; for (int i = 0; i < 64; ++i) d += qs[r][i] * kcb[n * 64 + i]; s = d - slope * (float)(t - (16 * n + 31)); }
        sc[r][n] = s; mx = fmaxf(mx, s);
    }
    mx = wave_max(mx); if (mx == NEG) mx = 0.f;
    float sum = 0.f;
    for (int n = lane; n < 512; n += 64) { const float e = (n < nvalid) ? expf(sc[r][n] - mx) : 0.f; sc[r][n] = e; sum += e; }
    sum = wave_sum(sum); float inv = 1.0f / fmaxf(sum, 1e-30f);
    for (int n = lane; n < 512; n += 64) sc[r][n] *= inv;
    __syncthreads();
    float oc = 0.f;
    for (int n = 0; n < nvalid; ++n) oc += sc[r][n] * vcb[n * 64 + lane];
    for (int i = tid; i < 520; i += 256) P[i] = (i < 512) ? (sc[0][i] + sc[1][i] + sc[2][i] + sc[3][i]) : 0.f;
    __syncthreads();
    if (tid < 128) imp[tid] = P[4 * tid] + 2.f * P[4 * tid + 1] + 2.f * P[4 * tid + 2] + 2.f * P[4 * tid + 3] + P[4 * tid + 4];
    __syncthreads();
    const int cur = t >> 6;
    if (tid < 128) {
        const int j = tid; const bool forced = (j == 0) || (j == cur) || (j == cur - 1); const bool cand = !forced && j <= cur;
        const int nforced = (cur == 0) ? 1 : (cur == 1) ? 2 : 3; const int need = 16 - nforced;
        int rank = 0; const float mine = imp[j];
        for (int q = 1; q <= cur - 2; ++q) { if (q == j) continue; const float o = imp[q]; if (o > mine || (o == mine && q < j)) ++rank; }
        sel[j] = (forced || (cand && rank < need)) ? 1 : 0;
    }
    __syncthreads();
    if (tid == 0) { int nb = 0; for (int j = 0; j < 128; ++j) if (sel[j] && nb < 16) blist[nb++] = j; nbs = nb; }
    __syncthreads();
    const int nb = nbs;
    float os = 0.f;
    {
        float m2 = NEG;
        for (int s = 0; s < nb; ++s) {
            const int pos = blist[s] * 64 + lane; float val = NEG;
            if (pos <= t) {
                const bf16* kr = proj + (size_t)(b * T + pos) * PS + C_KS + g * 64; float d = 0.f, sq = 0.f;
                for (int i = 0; i < 64; ++i) { const float kv = bf2f(kr[i]); d += qs[r][i] * kv * k_gain[64 + i]; sq += kv * kv; }
                val = d * rsqrtf(sq * (1.0f / 64.0f) + EPS) - slope * (float)(t - pos);
            }
            sc[r][s * 64 + lane] = val; m2 = fmaxf(m2, val);
        }
        m2 = wave_max(m2); if (m2 == NEG) m2 = 0.f;
        float su = 0.f;
        for (int s = 0; s < nb; ++s) { const float v0 = sc[r][s * 64 + lane]; const float e = (v0 == NEG) ? 0.f : expf(v0 - m2); sc[r][s * 64 + lane] = e; su += e; }
        su = wave_sum(su); const float iv = 1.0f / fmaxf(su, 1e-30f);
        __syncthreads();
        for (int s = 0; s < nb; ++s) for (int i = 0; i < 64; ++i) {
            const float p = sc[r][s * 64 + i]; if (p != 0.f) os += p * bf2f(proj[(size_t)(b * T + blist[s] * 64 + i) * PS + C_VS + g * 64 + lane]); }
        os *= iv;
    }
    __syncthreads();
    float ow = 0.f;
    {
        float m2 = NEG;
        for (int i = lane; i < 512; i += 64) {
            const int pos = t - i; float val = NEG;
            if (pos >= 0) {
                const bf16* kr = proj + (size_t)(b * T + pos) * PS + C_KW + g * 64; float d = 0.f, sq = 0.f;
                for (int c = 0; c < 64; ++c) { const float kv = bf2f(kr[c]); d += qs[r][c] * kv * k_gain[128 + c]; sq += kv * kv; }
                val = d * rsqrtf(sq * (1.0f / 64.0f) + EPS) - slope * (float)i;
            }
            sc[r][i] = val; m2 = fmaxf(m2, val);
        }
        m2 = wave_max(m2);
        float su = 0.f;
        for (int i = lane; i < 512; i += 64) { const float v0 = sc[r][i]; const float e = (v0 == NEG) ? 0.f : expf(v0 - m2); sc[r][i] = e; su += e; }
        su = wave_sum(su); const float iv = 1.0f / fmaxf(su, 1e-30f);
        __syncthreads();
        for (int i = 0; i < 512; ++i) { const float p = sc[r][i]; if (p != 0.f) ow += p * bf2f(proj[(size_t)(b * T + t - i) * PS + C_VW + g * 64 + lane]); }
        ow *= iv;
    }
    const bf16* gl = proj + (size_t)tok * PS + C_GT + h * 3;
    const float o = sigmoidf_(bf2f(gl[0])) * oc + sigmoidf_(bf2f(gl[1])) * os + sigmoidf_(bf2f(gl[2])) * ow;
    const float ss = wave_sum(o * o);
    mixed[(size_t)tok * D + 512 + h * 64 + lane] = f2bf(o * rsqrtf(ss * (1.0f / 64.0f) + EPS) * out_gain[h * 64 + lane]);
}

__global__ void __launch_bounds__(128) k_peer_topk_naive(const bf16* __restrict__ pq, const float* __restrict__ keys, int* __restrict__ ids, float* __restrict__ wts) {
    const int tok = blockIdx.x >> 3, h = blockIdx.x & 7, k = threadIdx.x;
    __shared__ float q[256]; __shared__ float s[2][128]; __shared__ float ts[2][16]; __shared__ int ti[2][16]; __shared__ float cand[256]; __shared__ float bs[16]; __shared__ int bc[16];
    q[k] = bf2f(pq[(size_t)tok * 2048 + h * 256 + k]); q[k + 128] = bf2f(pq[(size_t)tok * 2048 + h * 256 + 128 + k]);
    __syncthreads();
#pragma unroll
    for (int c = 0; c < 2; ++c) { const float* kr = keys + ((size_t)(h * 2 + c) * 128 + k) * 128; float d = 0.f; for (int i = 0; i < 128; ++i) d += q[c * 128 + i] * kr[i]; s[c][k] = d; }
    __syncthreads();
#pragma unroll
    for (int c = 0; c < 2; ++c) { const float mine = s[c][k]; int rank = 0; for (int j = 0; j < 128; ++j) { const float o = s[c][j]; if (o > mine || (o == mine && j < k)) ++rank; } if (rank < 16) { ts[c][rank] = mine; ti[c][rank] = k; } }
    __syncthreads();
    cand[k] = ts[0][k >> 4] + ts[1][k & 15]; cand[k + 128] = ts[0][(k + 128) >> 4] + ts[1][(k + 128) & 15];
    __syncthreads();
#pragma unroll
    for (int e = 0; e < 2; ++e) { const int me = k + e * 128; const float mine = cand[me]; int rank = 0; for (int j = 0; j < 256; ++j) { const float o = cand[j]; if (o > mine || (o == mine && j < me)) ++rank; } if (rank < 16) { bs[rank] = mine; bc[rank] = me; } }
    __syncthreads();
    if (k < 16) {
        float mx = bs[0]; float sum = 0.f; for (int j = 0; j < 16; ++j) sum += expf(bs[j] - mx);
        const int c = bc[k]; ids[(size_t)tok * 128 + h * 16 + k] = ti[0][c >> 4] * 128 + ti[1][c & 15];
        wts[(size_t)tok * 128 + h * 16 + k] = expf(bs[k] - mx) / sum;
    }
}

__global__ void __launch_bounds__(256) k_peer_gather_naive(const bf16* __restrict__ hn, const int* __restrict__ ids, const float* __restrict__ wts, const float* __restrict__ U, const float* __restrict__ V,
                                                           const float* __restrict__ gnorm, float* __restrict__ hio, bf16* __restrict__ hg) {
    const int tok = blockIdx.x, tid = threadIdx.x, w = tid >> 6, lane = tid & 63;
    __shared__ float xs[1024]; __shared__ float coef[128]; __shared__ int eid[128]; __shared__ float red[4];
    for (int i = tid; i < 1024; i += 256) xs[i] = bf2f(hn[(size_t)tok * D + i]);
    if (tid < 128) eid[tid] = ids[(size_t)tok * 128 + tid];
    __syncthreads();
    for (int e = w * 32; e < w * 32 + 32; ++e) {
        const float* ur = U + (size_t)eid[e] * D; float d = 0.f;
        for (int i = lane; i < 1024; i += 64) d += ur[i] * xs[i];
        d = wave_sum(d);
        if (lane == 0) coef[e] = wts[(size_t)tok * 128 + e] * gelu_tanh(d);
    }
    __syncthreads();
    float o[4] = {0.f, 0.f, 0.f, 0.f};
    for (int e = 0; e < 128; ++e) { const float* vr = V + (size_t)eid[e] * D; const float c = coef[e];
#pragma unroll
        for (int j = 0; j < 4; ++j) o[j] += c * vr[tid + 256 * j]; }
    float ss = 0.f;
#pragma unroll
    for (int j = 0; j < 4; ++j) { o[j] += hio[(size_t)tok * D + tid + 256 * j]; hio[(size_t)tok * D + tid + 256 * j] = o[j]; ss += o[j] * o[j]; }
    ss = wave_sum(ss); if (lane == 0) red[w] = ss;
    __syncthreads();
    const float r = rsqrtf((red[0] + red[1] + red[2] + red[3]) * (1.0f / D) + EPS);
#pragma unroll
    for (int j = 0; j < 4; ++j) hg[(size_t)tok * D + tid + 256 * j] = f2bf(o[j] * r * gnorm[tid + 256 * j]);
}


typedef short bf16x8 __attribute__((ext_vector_type(8)));
typedef float f32x4 __attribute__((ext_vector_type(4)));
typedef float f32x16 __attribute__((ext_vector_type(16)));
typedef unsigned u32x4 __attribute__((ext_vector_type(4)));
typedef unsigned u32x2 __attribute__((ext_vector_type(2)));
constexpr int NTHR = 512;
constexpr int LDS_BYTES = 131072 + 16;
struct Params { const float* in[21]; float* out; unsigned char* ws; };

__device__ __forceinline__ unsigned pk2(float lo, float hi) { return (unsigned)f2bf(lo) | ((unsigned)f2bf(hi) << 16); }

__device__ __forceinline__ void transpose_tile(const float* __restrict__ W, int K, int N, bf16* __restrict__ Wt, int kt, int nt, float* tile) {
    const int tid = threadIdx.x, k0 = kt * 64, n0 = nt * 64;
#pragma unroll
    for (int i = 0; i < 8; ++i) { const int idx = tid + i * NTHR, kk = idx >> 6, nn = idx & 63; tile[kk * 65 + nn] = (n0 + nn < N) ? W[(size_t)(k0 + kk) * N + n0 + nn] : 0.f; }
    __syncthreads();
    { const int nn = tid >> 3, ch = tid & 7; const float* s = tile + (ch * 8) * 65 + nn;
      u32x4 o; o.x = pk2(s[0], s[65]); o.y = pk2(s[130], s[195]); o.z = pk2(s[260], s[325]); o.w = pk2(s[390], s[455]);
      *(u32x4*)(Wt + (size_t)(n0 + nn) * K + k0 + ch * 8) = o; }
    __syncthreads();
}
__device__ __forceinline__ void cvt_range(const float* __restrict__ src, bf16* __restrict__ dst, size_t n8, size_t gtid, size_t gthreads) {
    for (size_t i = gtid; i < n8; i += gthreads) {
        const f32x4 a = ((const f32x4*)src)[2 * i], b = ((const f32x4*)src)[2 * i + 1];
        u32x4 o; o.x = pk2(a.x, a.y); o.y = pk2(a.z, a.w); o.z = pk2(b.x, b.y); o.w = pk2(b.z, b.w);
        ((u32x4*)dst)[i] = o;
    }
}
__device__ __forceinline__ void rms_row_bf16(const float* __restrict__ xr, const float* __restrict__ g, bf16* __restrict__ orow, int lane) {
    f32x4 v[4]; float s = 0.f;
#pragma unroll
    for (int j = 0; j < 4; ++j) { v[j] = ((const f32x4*)xr)[lane + 64 * j]; s += v[j].x * v[j].x + v[j].y * v[j].y + v[j].z * v[j].z + v[j].w * v[j].w; }
    s = wave_sum(s);
    const float r = rsqrtf(s * (1.0f / D) + EPS);
#pragma unroll
    for (int j = 0; j < 4; ++j) { const f32x4 gg = ((const f32x4*)g)[lane + 64 * j]; u32x2 o; o.x = pk2(v[j].x * r * gg.x, v[j].y * r * gg.y); o.y = pk2(v[j].z * r * gg.z, v[j].w * r * gg.w); ((u32x2*)orow)[lane + 64 * j] = o; }
}

__device__ __forceinline__ void phase0(const Params& p, unsigned char* lds) {
    float* tile = (float*)lds;
    const int nblk = gridDim.x, blk = blockIdx.x;
    unsigned char* ws = p.ws;
    constexpr int I_WIN = 16 * 54, I_WOUT = 16 * 16, I_WQ = 16 * 32, I_WG = 16 * 16, I_WP = 4 * 16, I_W1 = 2 * 32;
    constexpr int NIT = I_WIN + I_WOUT + I_WQ + I_WG + I_WP + I_W1;
    for (int it = blk; it < NIT; it += nblk) {
        int r = it;
        if (r < I_WIN) { transpose_tile(p.in[3], 1024, DIN, (bf16*)(ws + WS_WINT), r / 54, r % 54, tile); continue; } r -= I_WIN;
        if (r < I_WOUT) { transpose_tile(p.in[12], 1024, 1024, (bf16*)(ws + WS_WOUTT), r / 16, r % 16, tile); continue; } r -= I_WOUT;
        if (r < I_WQ) { transpose_tile(p.in[14], 1024, 2048, (bf16*)(ws + WS_WQT), r / 32, r % 32, tile); continue; } r -= I_WQ;
        if (r < I_WG) { transpose_tile(p.in[20], 1024, 1024, (bf16*)(ws + WS_WGT), r / 16, r % 16, tile); continue; } r -= I_WG;
        if (r < I_WP) { transpose_tile(p.in[18], 256, 1024, (bf16*)(ws + WS_WPT), r / 16, r % 16, tile); continue; } r -= I_WP;
        { const int which = r / 32, kt = r % 32; transpose_tile(p.in[9] + (size_t)which * 2048 * 64, 2048, 64, (bf16*)(ws + WS_W1T) + (size_t)which * 64 * 2048, kt, 0, tile); }
    }
    const size_t gtid = (size_t)blk * NTHR + threadIdx.x, gthreads = (size_t)nblk * NTHR;
    cvt_range(p.in[15], (bf16*)(ws + WS_KEYB), (size_t)8 * 2 * 128 * 128 / 8, gtid, gthreads);
    cvt_range(p.in[1], (bf16*)(ws + WS_PB), (size_t)NTOK * 256 / 8, gtid, gthreads);
    const int gw = (int)(gtid >> 6), ngw = (int)(gthreads >> 6), lane = threadIdx.x & 63;
    for (int m = gw; m < NTOK; m += ngw) rms_row_bf16(p.in[0] + (size_t)m * D, p.in[2], (bf16*)(ws + WS_ACT) + (size_t)m * D, lane);
    for (int m = gw; m < 2 * 16384; m += ngw) {
        const int which = m >> 14, row = m & 16383;
        const float* src = p.in[16 + which] + (size_t)row * D + lane * 16;
        const f32x4 a = *(const f32x4*)src, b = *(const f32x4*)(src + 4), c = *(const f32x4*)(src + 8), d = *(const f32x4*)(src + 12);
        float mx = fmaxf(fmaxf(fmaxf(fabsf(a.x), fabsf(a.y)), fmaxf(fabsf(a.z), fabsf(a.w))), fmaxf(fmaxf(fabsf(b.x), fabsf(b.y)), fmaxf(fabsf(b.z), fabsf(b.w))));
        mx = fmaxf(mx, fmaxf(fmaxf(fmaxf(fabsf(c.x), fabsf(c.y)), fmaxf(fabsf(c.z), fabsf(c.w))), fmaxf(fmaxf(fabsf(d.x), fabsf(d.y)), fmaxf(fabsf(d.z), fabsf(d.w)))));
        mx = fmaxf(wave_max(mx), 1e-30f);
        const float sc = 224.0f / mx;
        u32x4 o; int w;
        w = __builtin_amdgcn_cvt_pk_fp8_f32(a.x * sc, a.y * sc, 0, false); w = __builtin_amdgcn_cvt_pk_fp8_f32(a.z * sc, a.w * sc, w, true); o.x = (unsigned)w;
        w = __builtin_amdgcn_cvt_pk_fp8_f32(b.x * sc, b.y * sc, 0, false); w = __builtin_amdgcn_cvt_pk_fp8_f32(b.z * sc, b.w * sc, w, true); o.y = (unsigned)w;
        w = __builtin_amdgcn_cvt_pk_fp8_f32(c.x * sc, c.y * sc, 0, false); w = __builtin_amdgcn_cvt_pk_fp8_f32(c.z * sc, c.w * sc, w, true); o.z = (unsigned)w;
        w = __builtin_amdgcn_cvt_pk_fp8_f32(d.x * sc, d.y * sc, 0, false); w = __builtin_amdgcn_cvt_pk_fp8_f32(d.z * sc, d.w * sc, w, true); o.w = (unsigned)w;
        *(u32x4*)(ws + (which ? WS_VB : WS_UB) + (size_t)row * D + lane * 16) = o;
        if (lane == 0) ((float*)(ws + (which ? WS_VS : WS_US)))[row] = mx * (1.0f / 224.0f);
    }
}

__device__ __forceinline__ int swz(int ob) { return ob ^ (((ob >> 9) & 1) << 5); }
constexpr int G_STAGE = 49152;
__device__ __forceinline__ void gemm_mainloop(f32x4 (&acc)[4][4], const bf16* __restrict__ A, int lda, const bf16* __restrict__ Bt, int ldb, int K, int m0, int n0, unsigned char* lds) {
    const int tid = threadIdx.x, lane = tid & 63, wid = tid >> 6, wm = wid >> 1, wn = wid & 1, fr = lane & 15, fq = lane >> 4;
    const int lrow = tid >> 3, lc = tid & 7;
    const bf16* ag = A + (size_t)(m0 + lrow) * lda + lc * 8;
    const bf16* bg = Bt + (size_t)(n0 + lrow) * ldb + lc * 8;
    const int woff = ((lrow >> 4) * 2 + (lc >> 2)) * 1024 + swz((lrow & 15) * 64 + (lc & 3) * 16);
    const int roff = swz(fr * 64 + fq * 16);
    const int nk = K >> 6;
    u32x4 ra[4], rb[2];
#pragma unroll
    for (int i = 0; i < 4; ++i) ra[i] = *(const u32x4*)(ag + (size_t)i * 64 * lda);
#pragma unroll
    for (int i = 0; i < 2; ++i) rb[i] = *(const u32x4*)(bg + (size_t)i * 64 * ldb);
#pragma unroll
    for (int i = 0; i < 4; ++i) *(u32x4*)(lds + woff + i * 8192) = ra[i];
#pragma unroll
    for (int i = 0; i < 2; ++i) *(u32x4*)(lds + 32768 + woff + i * 8192) = rb[i];
    __syncthreads();
    for (int kt = 0; kt < nk; ++kt) {
        unsigned char* cur = lds + (kt & 1) * G_STAGE; unsigned char* nxt = lds + ((kt + 1) & 1) * G_STAGE;
        const bool more = kt + 1 < nk;
        if (more) {
#pragma unroll
            for (int i = 0; i < 4; ++i) ra[i] = *(const u32x4*)(ag + (size_t)i * 64 * lda + (kt + 1) * 64);
#pragma unroll
            for (int i = 0; i < 2; ++i) rb[i] = *(const u32x4*)(bg + (size_t)i * 64 * ldb + (kt + 1) * 64);
        }
#pragma unroll
        for (int s = 0; s < 2; ++s) {
            bf16x8 af[4], bfr[4];
#pragma unroll
            for (int i = 0; i < 4; ++i) af[i] = *(const bf16x8*)(cur + ((wm * 4 + i) * 2 + s) * 1024 + roff);
#pragma unroll
            for (int i = 0; i < 4; ++i) bfr[i] = *(const bf16x8*)(cur + 32768 + ((wn * 4 + i) * 2 + s) * 1024 + roff);
#pragma unroll
            for (int mi = 0; mi < 4; ++mi)
#pragma unroll
                for (int ni = 0; ni < 4; ++ni) acc[mi][ni] = __builtin_amdgcn_mfma_f32_16x16x32_bf16(bfr[ni], af[mi], acc[mi][ni], 0, 0, 0);
        }
        if (more) {
#pragma unroll
            for (int i = 0; i < 4; ++i) *(u32x4*)(nxt + woff + i * 8192) = ra[i];
#pragma unroll
            for (int i = 0; i < 2; ++i) *(u32x4*)(nxt + 32768 + woff + i * 8192) = rb[i];
        }
        __syncthreads();
    }
}
__device__ __forceinline__ void acc_zero(f32x4 (&acc)[4][4]) {
#pragma unroll
    for (int i = 0; i < 4; ++i)
#pragma unroll
        for (int j = 0; j < 4; ++j) acc[i][j] = (f32x4){0.f, 0.f, 0.f, 0.f};
}
__device__ __forceinline__ void phase1(const Params& p, unsigned char* lds) {
    const bf16* A = (const bf16*)(p.ws + WS_ACT); const bf16* Bt = (const bf16*)(p.ws + WS_WINT); bf16* C = (bf16*)(p.ws + WS_PROJ);
    const int lane = threadIdx.x & 63, wid = threadIdx.x >> 6, wm = wid >> 1, wn = wid & 1, fr = lane & 15, fq = lane >> 4;
    constexpr int NT = 27, NTILES = 64 * NT;
    for (int t = blockIdx.x; t < NTILES; t += gridDim.x) {
        const int m0 = (t / NT) * 256, n0 = (t % NT) * 128;
        f32x4 acc[4][4]; acc_zero(acc);
        gemm_mainloop(acc, A, D, Bt, D, D, m0, n0, lds);
#pragma unroll
        for (int mi = 0; mi < 4; ++mi)
#pragma unroll
            for (int ni = 0; ni < 4; ++ni) {
                const int row = m0 + wm * 64 + mi * 16 + fr, col = n0 + wn * 64 + ni * 16 + fq * 4;
                if (col < DIN) { u32x2 o; o.x = pk2(acc[mi][ni][0], acc[mi][ni][1]); o.y = pk2(acc[mi][ni][2], acc[mi][ni][3]); *(u32x2*)(C + (size_t)row * PS + col) = o; }
            }
    }
}


__device__ __forceinline__ void phase5(const Params& p, unsigned char* lds) {
    const bf16* A = (const bf16*)(p.ws + WS_ACT); const bf16* Bt = (const bf16*)(p.ws + WS_WOUTT); const float* X = p.in[0]; float* O = p.out;
    const int lane = threadIdx.x & 63, wid = threadIdx.x >> 6, wm = wid >> 1, wn = wid & 1, fr = lane & 15, fq = lane >> 4;
    constexpr int NT = 8, NTILES = 64 * NT;
    for (int t = blockIdx.x; t < NTILES; t += gridDim.x) {
        const int m0 = (t / NT) * 256, n0 = (t % NT) * 128;
        f32x4 acc[4][4]; acc_zero(acc);
        gemm_mainloop(acc, A, D, Bt, D, D, m0, n0, lds);
#pragma unroll
        for (int mi = 0; mi < 4; ++mi)
#pragma unroll
            for (int ni = 0; ni < 4; ++ni) {
                const size_t idx = (size_t)(m0 + wm * 64 + mi * 16 + fr) * D + n0 + wn * 64 + ni * 16 + fq * 4;
                *(f32x4*)(O + idx) = *(const f32x4*)(X + idx) + acc[mi][ni];
            }
    }
}
__device__ __forceinline__ void phase6(const Params& p, unsigned char* lds) {
    const int gw = (blockIdx.x * NTHR + threadIdx.x) >> 6, ngw = (gridDim.x * NTHR) >> 6, lane = threadIdx.x & 63;
    for (int m = gw; m < NTOK; m += ngw) rms_row_bf16(p.out + (size_t)m * D, p.in[13], (bf16*)(p.ws + WS_ACT) + (size_t)m * D, lane);
}
__device__ __forceinline__ void phase7(const Params& p, unsigned char* lds) {
    const bf16* A = (const bf16*)(p.ws + WS_ACT); const bf16* Bt = (const bf16*)(p.ws + WS_WQT); bf16* C = (bf16*)(p.ws + WS_PROJ);
    const int lane = threadIdx.x & 63, wid = threadIdx.x >> 6, wm = wid >> 1, wn = wid & 1, fr = lane & 15, fq = lane >> 4;
    constexpr int NT = 16, NTILES = 64 * NT;
    for (int t = blockIdx.x; t < NTILES; t += gridDim.x) {
        const int m0 = (t / NT) * 256, n0 = (t % NT) * 128;
        f32x4 acc[4][4]; acc_zero(acc);
        gemm_mainloop(acc, A, D, Bt, D, D, m0, n0, lds);
#pragma unroll
        for (int mi = 0; mi < 4; ++mi)
#pragma unroll
            for (int ni = 0; ni < 4; ++ni) {
                const int row = m0 + wm * 64 + mi * 16 + fr, col = n0 + wn * 64 + ni * 16 + fq * 4;
                u32x2 o; o.x = pk2(acc[mi][ni][0], acc[mi][ni][1]); o.y = pk2(acc[mi][ni][2], acc[mi][ni][3]); *(u32x2*)(C + (size_t)row * 2048 + col) = o;
            }
    }
}
__device__ __forceinline__ void phase10(const Params& p, unsigned char* lds) {
    const bf16* A1 = (const bf16*)(p.ws + WS_PROJ + 64 * MiB); const bf16* B1 = (const bf16*)(p.ws + WS_WGT);
    const bf16* A2 = (const bf16*)(p.ws + WS_PB); const bf16* B2 = (const bf16*)(p.ws + WS_WPT); float* O = p.out;
    const int lane = threadIdx.x & 63, wid = threadIdx.x >> 6, wm = wid >> 1, wn = wid & 1, fr = lane & 15, fq = lane >> 4;
    constexpr int NT = 8, NTILES = 64 * NT;
    for (int t = blockIdx.x; t < NTILES; t += gridDim.x) {
        const int m0 = (t / NT) * 256, n0 = (t % NT) * 128;
        u32x2 gpk[4][4];
        {
            f32x4 accg[4][4]; acc_zero(accg);
            gemm_mainloop(accg, A1, D, B1, D, D, m0, n0, lds);
#pragma unroll
            for (int mi = 0; mi < 4; ++mi)
#pragma unroll
                for (int ni = 0; ni < 4; ++ni) { gpk[mi][ni].x = pk2(sigmoidf_(accg[mi][ni][0]), sigmoidf_(accg[mi][ni][1])); gpk[mi][ni].y = pk2(sigmoidf_(accg[mi][ni][2]), sigmoidf_(accg[mi][ni][3])); }
        }
        f32x4 accp[4][4]; acc_zero(accp);
        gemm_mainloop(accp, A2, 256, B2, 256, 256, m0, n0, lds);
#pragma unroll
        for (int mi = 0; mi < 4; ++mi)
#pragma unroll
            for (int ni = 0; ni < 4; ++ni) {
                const size_t idx = (size_t)(m0 + wm * 64 + mi * 16 + fr) * D + n0 + wn * 64 + ni * 16 + fq * 4;
                f32x4 g; g.x = __uint_as_float(gpk[mi][ni].x << 16); g.y = __uint_as_float(gpk[mi][ni].x & 0xffff0000u); g.z = __uint_as_float(gpk[mi][ni].y << 16); g.w = __uint_as_float(gpk[mi][ni].y & 0xffff0000u);
                *(f32x4*)(O + idx) = *(const f32x4*)(O + idx) + accp[mi][ni] * g;
            }
    }
}

typedef __bf16 bf16x2v __attribute__((ext_vector_type(2)));
template <int CTRL> __device__ __forceinline__ float dpp_f(float v) { return __int_as_float(__builtin_amdgcn_update_dpp(0, __float_as_int(v), CTRL, 0xF, 0xF, false)); }
__device__ __forceinline__ float grp16_max(float v) { v = fmaxf(v, dpp_f<0xB1>(v)); v = fmaxf(v, dpp_f<0x4E>(v)); v = fmaxf(v, dpp_f<0x141>(v)); v = fmaxf(v, dpp_f<0x140>(v)); return v; }
__device__ __forceinline__ float grp16_sum(float v) { v += dpp_f<0xB1>(v); v += dpp_f<0x4E>(v); v += dpp_f<0x141>(v); v += dpp_f<0x140>(v); return v; }
#define CE_DESC(a, b) { const float _hi = fmaxf(a, b), _lo = fminf(a, b); a = _hi; b = _lo; }
__device__ __forceinline__ float grp16_top16(float (&v)[8], int lig) {
    CE_DESC(v[0], v[1]) CE_DESC(v[2], v[3]) CE_DESC(v[4], v[5]) CE_DESC(v[6], v[7])
    CE_DESC(v[0], v[2]) CE_DESC(v[1], v[3]) CE_DESC(v[4], v[6]) CE_DESC(v[5], v[7])
    CE_DESC(v[1], v[2]) CE_DESC(v[5], v[6])
    CE_DESC(v[0], v[4]) CE_DESC(v[1], v[5]) CE_DESC(v[2], v[6]) CE_DESC(v[3], v[7])
    CE_DESC(v[2], v[4]) CE_DESC(v[3], v[5])
    CE_DESC(v[1], v[2]) CE_DESC(v[3], v[4]) CE_DESC(v[5], v[6])
    float top = 0.f;
#pragma unroll
    for (int r = 0; r < 16; ++r) {
        const float m = grp16_max(v[0]);
        if (lig == r) top = m;
        const bool own = (v[0] == m);
#pragma unroll
        for (int j = 0; j < 7; ++j) v[j] = own ? v[j + 1] : v[j];
        v[7] = own ? -3.0e38f : v[7];
    }
    return top;
}
__device__ __forceinline__ void phase8(const Params& p, unsigned char* lds) {
    const bf16* PQ = (const bf16*)(p.ws + WS_PROJ); const bf16* KB = (const bf16*)(p.ws + WS_KEYB);
    int* ids = (int*)(p.ws + WS_IDS); float* wts = (float*)(p.ws + WS_WTS);
    float* S = (float*)lds;
    const int tid = threadIdx.x, lane = tid & 63, wid = tid >> 6, lig = tid & 15, gbase = lane & 48;
    for (int item = blockIdx.x; item < 2048; item += gridDim.x) {
        const int tok0 = (item >> 3) * 64, h = item & 7;
        {
            const int c = wid >> 2, key0 = (wid & 3) * 32, r = lane & 31, hh = lane >> 5;
            f32x16 acc0, acc1;
#pragma unroll
            for (int i = 0; i < 16; ++i) { acc0[i] = 0.f; acc1[i] = 0.f; }
            const bf16* bq = KB + ((size_t)(h * 2 + c) * 128 + key0 + r) * 128 + hh * 8;
            const bf16* aq0 = PQ + (size_t)(tok0 + r) * 2048 + h * 256 + c * 128 + hh * 8;
            const bf16* aq1 = aq0 + (size_t)32 * 2048;
#pragma unroll
            for (int s = 0; s < 8; ++s) {
                const bf16x8 b = *(const bf16x8*)(bq + s * 16), a0 = *(const bf16x8*)(aq0 + s * 16), a1 = *(const bf16x8*)(aq1 + s * 16);
                acc0 = __builtin_amdgcn_mfma_f32_32x32x16_bf16(a0, b, acc0, 0, 0, 0);
                acc1 = __builtin_amdgcn_mfma_f32_32x32x16_bf16(a1, b, acc1, 0, 0, 0);
            }
#pragma unroll
            for (int i = 0; i < 16; ++i) { const int tl = (i & 3) + 8 * (i >> 2) + 4 * hh; S[(c * 64 + tl) * 132 + key0 + r] = acc0[i]; S[(c * 64 + 32 + tl) * 132 + key0 + r] = acc1[i]; }
        }
        __syncthreads();
#pragma unroll 1
        for (int rd = 0; rd < 2; ++rd) {
            const int tl = (tid >> 4) + 32 * rd;
            float ts[2];
#pragma unroll
            for (int c = 0; c < 2; ++c) {
                float v[8];
                const f32x4 lo = *(const f32x4*)(S + (c * 64 + tl) * 132 + lig * 8), hi = *(const f32x4*)(S + (c * 64 + tl) * 132 + lig * 8 + 4);
                v[0] = lo.x; v[1] = lo.y; v[2] = lo.z; v[3] = lo.w; v[4] = hi.x; v[5] = hi.y; v[6] = hi.z; v[7] = hi.w;
#pragma unroll
                for (int j = 0; j < 8; ++j) v[j] = __uint_as_float((__float_as_uint(v[j]) & ~127u) | (unsigned)(lig * 8 + j));
                ts[c] = grp16_top16(v, lig);
            }
            const float t0 = ts[0], t1 = ts[1];
            int bp = 0; float my_s = 0.f; int my_eid = 0;
#pragma unroll 1
            for (int r = 0; r < 16; ++r) {
                const float other = __shfl(t1, gbase + (bp < 15 ? bp : 15));
                const float sum = t0 + other;
                const float head = (bp >= 16) ? -3.0e38f : __uint_as_float((__float_as_uint(sum) & ~15u) | (unsigned)lig);
                const int cur_eid = (int)(((__float_as_uint(t0) & 127u) << 7) | (__float_as_uint(other) & 127u));
                const float m = grp16_max(head);
                const int owner = (int)(__float_as_uint(m) & 15u);
                const int ew = __shfl(cur_eid, gbase + owner);
                if (lig == r) { my_s = m; my_eid = ew; }
                if (lig == owner) ++bp;
            }
            const float mx = grp16_max(my_s);
            const float e = __expf(my_s - mx);
            const float sm = grp16_sum(e);
            const size_t o = (size_t)(tok0 + tl) * 128 + h * 16 + lig;
            ids[o] = my_eid; wts[o] = e / sm;
        }
        __syncthreads();
    }
}

__device__ __forceinline__ void hgrn_pre_item(const Params& p, unsigned char* lds, int ci) {
    const int tid = threadIdx.x, lane = tid & 63, wid = tid >> 6, k = tid & 127, tq = tid >> 7;
    const int n = ci & 127, h = (ci >> 7) & 3, b = ci >> 9, tok0 = b * T + n * 64;
    bf16* proj = (bf16*)(p.ws + WS_PROJ);
    float* OB = p.out; bf16* KIT = (bf16*)((unsigned char*)p.out + OUT_KIT) + (size_t)ci * 8192; bf16* VTg = (bf16*)((unsigned char*)p.out + OUT_VT) + (size_t)ci * 8192;
    float* DEC = (float*)(p.ws + WS_DEC) + (size_t)ci * 128;
    bf16* QT = (bf16*)lds; bf16* KT = (bf16*)(lds + 17408); bf16* VTl = (bf16*)(lds + 34816); bf16* AM = (bf16*)(lds + 53248);
    float* part = (float*)(lds + 62464); float* gref = (float*)(lds + 64512);
    float lb; { const float l0 = p.in[4][h * 128 + k], l1 = p.in[4][512 + h * 128 + k]; const float m = fmaxf(l0, l1); const float e0 = __expf(l0 - m), e1 = __expf(l1 - m); lb = e0 / (e0 + e1); }
    float G[16], key[16], qv[16], vv[16];
    {
        float c = 0.f;
#pragma unroll
        for (int i = 0; i < 16; ++i) {
            const size_t row = (size_t)(tok0 + tq * 16 + i) * PS;
            const float fg = lb + (1.0f - lb) * sigmoidf_(bf2f(proj[row + C_HF + h * 128 + k]));
            key[i] = 1.0f - fg; c += __logf(fg); G[i] = c;
            qv[i] = siluf_(bf2f(proj[row + C_HQ + h * 128 + k])) * 0.08838834764831845f;
            vv[i] = bf2f(proj[row + C_HI + h * 128 + k]);
        }
        part[tq * 128 + k] = c;
    }
    __syncthreads();
    {
        float off = 0.f;
#pragma unroll
        for (int j = 0; j < 3; ++j) off += (j < tq) ? part[j * 128 + k] : 0.f;
#pragma unroll
        for (int i = 0; i < 16; ++i) G[i] += off;
        if (tq == 1) gref[k] = G[15];
        if (tq == 3) gref[128 + k] = G[15];
    }
    __syncthreads();
    {
        const float gr = gref[k], gl = gref[128 + k];
        const int kpos = (k & ~31) | (((k >> 2) & 3) << 3) | (((k >> 4) & 1) << 2) | (k & 3);
        unsigned kp[8], vp[8];
#pragma unroll
        for (int i = 0; i < 16; i += 2) {
            kp[i >> 1] = pk2(key[i] * __expf(gl - G[i]), key[i + 1] * __expf(gl - G[i + 1]));
            vp[i >> 1] = pk2(vv[i], vv[i + 1]);
        }
#pragma unroll
        for (int i = 0; i < 16; ++i) {
            const int t = tq * 16 + i;
            QT[t * 136 + k] = f2bf(qv[i] * __expf(G[i] - gr));
            KT[t * 136 + k] = f2bf(key[i] * __expf(gr - G[i]));
            proj[(size_t)(tok0 + t) * PS + C_HQ + h * 128 + kpos] = f2bf(qv[i] * __expf(G[i]));
        }
        u32x4 a0, a1, b0, b1; a0.x = kp[0]; a0.y = kp[1]; a0.z = kp[2]; a0.w = kp[3]; a1.x = kp[4]; a1.y = kp[5]; a1.z = kp[6]; a1.w = kp[7];
        b0.x = vp[0]; b0.y = vp[1]; b0.z = vp[2]; b0.w = vp[3]; b1.x = vp[4]; b1.y = vp[5]; b1.z = vp[6]; b1.w = vp[7];
        *(u32x4*)(KIT + k * 64 + tq * 16) = a0; *(u32x4*)(KIT + k * 64 + tq * 16 + 8) = a1;
        *(u32x4*)(VTg + k * 64 + tq * 16) = b0; *(u32x4*)(VTg + k * 64 + tq * 16 + 8) = b1;
        *(u32x4*)(VTl + k * 72 + tq * 16) = b0; *(u32x4*)(VTl + k * 72 + tq * 16 + 8) = b1;
        if (tq == 3) DEC[k] = __expf(gl);
    }
    __syncthreads();
    const int fr = lane & 15, fq = lane >> 4;
    {
        const int tt = wid >> 1;
#pragma unroll
        for (int e = 0; e < 2; ++e) {
            const int st = 2 * (wid & 1) + e;
            f32x4 acc = (f32x4){0.f, 0.f, 0.f, 0.f};
            if (st <= tt) {
#pragma unroll
                for (int s = 0; s < 4; ++s) {
                    const bf16x8 a = *(const bf16x8*)(QT + (tt * 16 + fr) * 136 + s * 32 + fq * 8), bb = *(const bf16x8*)(KT + (st * 16 + fr) * 136 + s * 32 + fq * 8);
                    acc = __builtin_amdgcn_mfma_f32_16x16x32_bf16(a, bb, acc, 0, 0, 0);
                }
            }
#pragma unroll
            for (int r = 0; r < 4; ++r) { const int t = tt * 16 + fq * 4 + r, sp = st * 16 + fr; AM[t * 72 + sp] = f2bf(sp <= t ? acc[r] : 0.f); }
        }
    }
    __syncthreads();
    {
        const int tt = wid >> 1;
        const bf16x8 a0 = *(const bf16x8*)(AM + (tt * 16 + fr) * 72 + fq * 8), a1 = *(const bf16x8*)(AM + (tt * 16 + fr) * 72 + 32 + fq * 8);
#pragma unroll
        for (int e = 0; e < 4; ++e) {
            const int vt = (wid & 1) * 4 + e;
            const bf16x8 b0 = *(const bf16x8*)(VTl + (vt * 16 + fr) * 72 + fq * 8), b1 = *(const bf16x8*)(VTl + (vt * 16 + fr) * 72 + 32 + fq * 8);
            f32x4 acc = (f32x4){0.f, 0.f, 0.f, 0.f};
            acc = __builtin_amdgcn_mfma_f32_16x16x32_bf16(a0, b0, acc, 0, 0, 0);
            acc = __builtin_amdgcn_mfma_f32_16x16x32_bf16(a1, b1, acc, 0, 0, 0);
#pragma unroll
            for (int r = 0; r < 4; ++r) OB[(size_t)(tok0 + tt * 16 + fq * 4 + r) * 512 + h * 128 + vt * 16 + fr] = acc[r];
        }
    }
    __syncthreads();
}
template <bool DUMMY>
__device__ __forceinline__ void hgrn_scan_item(const Params& p, int wi) {
    const int lane = threadIdx.x & 63, fr = lane & 15, fq = lane >> 4;
    const int vs = wi & 7, bh = wi >> 3, h = bh & 3, b = bh >> 2;
    const bf16* proj = (const bf16*)(p.ws + WS_PROJ);
    float* OB = p.out; const bf16* KIT = (const bf16*)((unsigned char*)p.out + OUT_KIT); const bf16* VTg = (const bf16*)((unsigned char*)p.out + OUT_VT);
    const float* DEC = (const float*)(p.ws + WS_DEC);
    f32x4 S[8];
#pragma unroll
    for (int i = 0; i < 8; ++i) S[i] = (f32x4){0.f, 0.f, 0.f, 0.f};
#pragma unroll 1
    for (int n = 0; n < 128; ++n) {
        const int ci = bh * 128 + n, tok0 = b * T + n * 64;
        bf16x8 qf[4][4];
#pragma unroll
        for (int tt = 0; tt < 4; ++tt)
#pragma unroll
            for (int s = 0; s < 4; ++s) qf[tt][s] = *(const bf16x8*)(proj + (size_t)(tok0 + tt * 16 + fr) * PS + C_HQ + h * 128 + s * 32 + fq * 8);
        float oin[4][4];
#pragma unroll
        for (int tt = 0; tt < 4; ++tt)
#pragma unroll
            for (int r = 0; r < 4; ++r) oin[tt][r] = OB[(size_t)(tok0 + tt * 16 + fq * 4 + r) * 512 + h * 128 + vs * 16 + fr];
        bf16x8 Sb[4];
#pragma unroll
        for (int s = 0; s < 4; ++s) {
            u32x4 w; w.x = pk2(S[2 * s][0], S[2 * s][1]); w.y = pk2(S[2 * s][2], S[2 * s][3]); w.z = pk2(S[2 * s + 1][0], S[2 * s + 1][1]); w.w = pk2(S[2 * s + 1][2], S[2 * s + 1][3]);
            Sb[s] = __builtin_bit_cast(bf16x8, w);
        }
#pragma unroll
        for (int tt = 0; tt < 4; ++tt) {
            f32x4 acc = (f32x4){0.f, 0.f, 0.f, 0.f};
#pragma unroll
            for (int s = 0; s < 4; ++s) acc = __builtin_amdgcn_mfma_f32_16x16x32_bf16(qf[tt][s], Sb[s], acc, 0, 0, 0);
#pragma unroll
            for (int r = 0; r < 4; ++r) { const size_t oi = (size_t)(tok0 + tt * 16 + fq * 4 + r) * 512 + h * 128 + vs * 16 + fr; if (DUMMY) ((float*)(p.ws + WS_SPARE))[oi & 0x3fffff] = oin[tt][r] + acc[r]; else OB[oi] = oin[tt][r] + acc[r]; }
        }
        const bf16x8 v0 = *(const bf16x8*)(VTg + (size_t)ci * 8192 + (vs * 16 + fr) * 64 + fq * 8), v1 = *(const bf16x8*)(VTg + (size_t)ci * 8192 + (vs * 16 + fr) * 64 + 32 + fq * 8);
#pragma unroll
        for (int kb = 0; kb < 8; ++kb) {
            const bf16x8 k0 = *(const bf16x8*)(KIT + (size_t)ci * 8192 + (kb * 16 + fr) * 64 + fq * 8), k1 = *(const bf16x8*)(KIT + (size_t)ci * 8192 + (kb * 16 + fr) * 64 + 32 + fq * 8);
            const f32x4 dv = *(const f32x4*)(DEC + (size_t)ci * 128 + kb * 16 + fq * 4);
            f32x4 sacc = S[kb] * dv;
            sacc = __builtin_amdgcn_mfma_f32_16x16x32_bf16(k0, v0, sacc, 0, 0, 0);
            sacc = __builtin_amdgcn_mfma_f32_16x16x32_bf16(k1, v1, sacc, 0, 0, 0);
            S[kb] = sacc;
        }
    }
}
__device__ __forceinline__ void phase4(const Params& p, unsigned char* lds) {
    const bf16* proj = (const bf16*)(p.ws + WS_PROJ); const float* OB = p.out; bf16* mixed = (bf16*)(p.ws + WS_ACT); const float* gain = p.in[5];
    const int lane = threadIdx.x & 63, gw = (blockIdx.x * NTHR + threadIdx.x) >> 6, ngw = (gridDim.x * NTHR) >> 6;
    for (int tok = gw; tok < NTOK; tok += ngw) {
        const f32x4 o0 = *(const f32x4*)(OB + (size_t)tok * 512 + lane * 8), o1 = *(const f32x4*)(OB + (size_t)tok * 512 + lane * 8 + 4);
        const u32x4 gp = *(const u32x4*)(proj + (size_t)tok * PS + C_HG + lane * 8);
        const f32x4 g0 = *(const f32x4*)(gain + lane * 8), g1 = *(const f32x4*)(gain + lane * 8 + 4);
        float ss = o0.x * o0.x + o0.y * o0.y + o0.z * o0.z + o0.w * o0.w + o1.x * o1.x + o1.y * o1.y + o1.z * o1.z + o1.w * o1.w;
        ss = grp16_sum(ss);
        const float r = rsqrtf(ss * (1.0f / 128.0f) + EPS);
        const unsigned gx = gp.x, gy = gp.y, gz = gp.z, gw_ = gp.w;
        u32x4 w;
        w.x = pk2(o0.x * r * g0.x * siluf_(__uint_as_float(gx << 16)), o0.y * r * g0.y * siluf_(__uint_as_float(gx & 0xffff0000u)));
        w.y = pk2(o0.z * r * g0.z * siluf_(__uint_as_float(gy << 16)), o0.w * r * g0.w * siluf_(__uint_as_float(gy & 0xffff0000u)));
        w.z = pk2(o1.x * r * g1.x * siluf_(__uint_as_float(gz << 16)), o1.y * r * g1.y * siluf_(__uint_as_float(gz & 0xffff0000u)));
        w.w = pk2(o1.z * r * g1.z * siluf_(__uint_as_float(gw_ << 16)), o1.w * r * g1.w * siluf_(__uint_as_float(gw_ & 0xffff0000u)));
        *(u32x4*)(mixed + (size_t)tok * D + lane * 8) = w;
    }
}

#define WAVE_LDS_SYNC() asm volatile("s_waitcnt lgkmcnt(0)" ::: "memory")
__device__ __forceinline__ void nsa_prep_item(const Params& p, unsigned char* lds, int tile) {
    const int tid = threadIdx.x, lig = tid & 15;
    const int tok0 = tile * 64;
    bf16* proj = (bf16*)(p.ws + WS_PROJ);
    for (int rho = tid >> 4; rho < 768; rho += 32) {
        const int tl = rho / 12, which = rho - tl * 12;
        int col; const float* gain; float sc = 1.0f;
        if (which < 8) { col = C_NQ + which * 64; gain = p.in[6]; sc = 0.125f; }
        else if (which < 10) { col = C_KS + (which - 8) * 64; gain = p.in[7] + 64; }
        else { col = C_KW + (which - 10) * 64; gain = p.in[7] + 128; }
        bf16* rp = proj + (size_t)(tok0 + tl) * PS + col + lig * 4;
        const u32x2 raw = *(const u32x2*)rp;
        const unsigned r0 = raw.x, r1 = raw.y;
        const float a = __uint_as_float(r0 << 16), b = __uint_as_float(r0 & 0xffff0000u), c = __uint_as_float(r1 << 16), d = __uint_as_float(r1 & 0xffff0000u);
        const float ss = grp16_sum(a * a + b * b + c * c + d * d);
        const float r = rsqrtf(ss * (1.0f / 64.0f) + EPS) * sc;
        const f32x4 gg = *(const f32x4*)(gain + lig * 4);
        u32x2 o; o.x = pk2(a * r * gg.x, b * r * gg.y); o.y = pk2(c * r * gg.z, d * r * gg.w);
        *(u32x2*)rp = o;
    }
    {
        const int c = tid & 127, tq = tid >> 7, g = c >> 6, d = c & 63, b = tok0 / T, t0 = tok0 % T;
#pragma unroll
        for (int which = 0; which < 2; ++which) {
            const int col = (which == 0 ? C_VS : C_VW) + c;
            unsigned w[8];
#pragma unroll
            for (int i = 0; i < 16; i += 2) w[i >> 1] = (unsigned)proj[(size_t)(tok0 + tq * 16 + i) * PS + col] | ((unsigned)proj[(size_t)(tok0 + tq * 16 + i + 1) * PS + col] << 16);
            bf16* dst = (bf16*)(p.ws + (which == 0 ? WS_VTS : WS_VTW)) + ((size_t)(b * 2 + g) * 64 + d) * T + t0 + tq * 16;
            u32x4 a0, a1; a0.x = w[0]; a0.y = w[1]; a0.z = w[2]; a0.w = w[3]; a1.x = w[4]; a1.y = w[5]; a1.z = w[6]; a1.w = w[7];
            *(u32x4*)dst = a0; *(u32x4*)(dst + 8) = a1;
        }
    }
}
__device__ __forceinline__ void nsa_cmp_item(const Params& p, unsigned char* lds, int item) {
    const int tid = threadIdx.x, lane = tid & 63, wid = tid >> 6, fr = lane & 15, fq = lane >> 4;
    const int nt32 = item & 15, g = (item >> 4) & 1, b = (item >> 5) & 1, which = item >> 6, n0 = nt32 * 32;
    const bf16* proj = (const bf16*)(p.ws + WS_PROJ);
    const float* pe = p.in[8] + which * 2048;
    const bf16* W1T = (const bf16*)(p.ws + WS_W1T) + (size_t)which * 64 * 2048;
    const float* w2 = p.in[10] + which * 4096;
    bf16* A = (bf16*)lds; float* H = (float*)(lds + 33280);
    const int col0 = (which == 0 ? C_KC : C_VC) + g * 64;
    const int nt = wid & 1, ct = wid >> 1;
    f32x4 acc = (f32x4){0.f, 0.f, 0.f, 0.f};
#pragma unroll 1
    for (int kc = 0; kc < 4; ++kc) {
#pragma unroll
        for (int i = 0; i < 4; ++i) {
            const int idx = tid + i * NTHR, dch = idx & 7, jj = (idx >> 3) & 7, n = idx >> 6, j = kc * 8 + jj;
            u32x4 o = (u32x4){0u, 0u, 0u, 0u};
            if (n0 + n < NCMP) {
                const u32x4 raw = *(const u32x4*)(proj + (size_t)(b * T + 16 * (n0 + n) + j) * PS + col0 + dch * 8);
                const f32x4 p0 = *(const f32x4*)(pe + j * 64 + dch * 8), p1 = *(const f32x4*)(pe + j * 64 + dch * 8 + 4);
                const unsigned r0 = raw.x, r1 = raw.y, r2 = raw.z, r3 = raw.w;
                o.x = pk2(__uint_as_float(r0 << 16) + p0.x, __uint_as_float(r0 & 0xffff0000u) + p0.y);
                o.y = pk2(__uint_as_float(r1 << 16) + p0.z, __uint_as_float(r1 & 0xffff0000u) + p0.w);
                o.z = pk2(__uint_as_float(r2 << 16) + p1.x, __uint_as_float(r2 & 0xffff0000u) + p1.y);
                o.w = pk2(__uint_as_float(r3 << 16) + p1.z, __uint_as_float(r3 & 0xffff0000u) + p1.w);
            }
            *(u32x4*)(A + n * 520 + jj * 64 + dch * 8) = o;
        }
        __syncthreads();
#pragma unroll 4
        for (int s = 0; s < 16; ++s) {
            const bf16x8 a = *(const bf16x8*)(A + (nt * 16 + fr) * 520 + s * 32 + fq * 8);
            const bf16x8 bb = *(const bf16x8*)(W1T + (size_t)(ct * 16 + fr) * 2048 + kc * 512 + s * 32 + fq * 8);
            acc = __builtin_amdgcn_mfma_f32_16x16x32_bf16(a, bb, acc, 0, 0, 0);
        }
        __syncthreads();
    }
#pragma unroll
    for (int r = 0; r < 4; ++r) H[(nt * 16 + fq * 4 + r) * 64 + ct * 16 + fr] = gelu_tanh(acc[r]);
    __syncthreads();
    {
        const int n = tid >> 4, c = (tid & 15) * 4;
        f32x4 o = (f32x4){0.f, 0.f, 0.f, 0.f};
#pragma unroll 8
        for (int i = 0; i < 64; ++i) { const float hv = H[n * 64 + i]; const f32x4 w = *(const f32x4*)(w2 + i * 64 + c); o += hv * w; }
        if (which == 0) {
            const float ss = grp16_sum(o.x * o.x + o.y * o.y + o.z * o.z + o.w * o.w);
            const float r = rsqrtf(ss * (1.0f / 64.0f) + EPS);
            const f32x4 gg = *(const f32x4*)(p.in[7] + c);
            o = o * r * gg;
        }
        if (n0 + n >= NCMP) o = (f32x4){0.f, 0.f, 0.f, 0.f};
        if (which == 0) { u32x2 w; w.x = pk2(o.x, o.y); w.y = pk2(o.z, o.w); *(u32x2*)((bf16*)(p.ws + WS_KC) + ((size_t)(b * 2 + g) * 512 + n0 + n) * 64 + c) = w; }
        else { bf16* vt = (bf16*)(p.ws + WS_VCT) + (size_t)(b * 2 + g) * 64 * 512 + n0 + n; vt[(c + 0) * 512] = f2bf(o.x); vt[(c + 1) * 512] = f2bf(o.y); vt[(c + 2) * 512] = f2bf(o.z); vt[(c + 3) * 512] = f2bf(o.w); }
    }
    __syncthreads();
}

__device__ __forceinline__ int rho16(int reg, int hh) { return (reg & 3) + 8 * (reg >> 2) + 4 * hh; }
__device__ __forceinline__ bf16x8 pack8(const float* pv) {
    u32x4 w; w.x = pk2(pv[0], pv[1]); w.y = pk2(pv[2], pv[3]); w.z = pk2(pv[4], pv[5]); w.w = pk2(pv[6], pv[7]);
    return __builtin_bit_cast(bf16x8, w);
}
__device__ __forceinline__ f32x16 score_tile(const bf16* kp, const bf16x8 (&qf)[4]) {
    f32x16 st;
#pragma unroll
    for (int i = 0; i < 16; ++i) st[i] = 0.f;
#pragma unroll
    for (int s = 0; s < 4; ++s) { const bf16x8 kf = *(const bf16x8*)(kp + s * 16); st = __builtin_amdgcn_mfma_f32_32x32x16_bf16(kf, qf[s], st, 0, 0, 0); }
    return st;
}
__device__ __forceinline__ void pv_tile(f32x16& o0, f32x16& o1, const bf16* vp, size_t vstride32, const float* pv) {
    const bf16x8 p0 = pack8(pv), p1 = pack8(pv + 8);
#pragma unroll
    for (int dt = 0; dt < 2; ++dt) {
        const bf16* v = vp + (size_t)dt * vstride32;
        const u32x2 a0 = *(const u32x2*)(v), a1 = *(const u32x2*)(v + 8), b0 = *(const u32x2*)(v + 16), b1 = *(const u32x2*)(v + 24);
        u32x4 w0, w1; w0.x = a0.x; w0.y = a0.y; w0.z = a1.x; w0.w = a1.y; w1.x = b0.x; w1.y = b0.y; w1.z = b1.x; w1.w = b1.y;
        if (dt == 0) { o0 = __builtin_amdgcn_mfma_f32_32x32x16_bf16(__builtin_bit_cast(bf16x8, w0), p0, o0, 0, 0, 0); o0 = __builtin_amdgcn_mfma_f32_32x32x16_bf16(__builtin_bit_cast(bf16x8, w1), p1, o0, 0, 0, 0); }
        else { o1 = __builtin_amdgcn_mfma_f32_32x32x16_bf16(__builtin_bit_cast(bf16x8, w0), p0, o1, 0, 0, 0); o1 = __builtin_amdgcn_mfma_f32_32x32x16_bf16(__builtin_bit_cast(bf16x8, w1), p1, o1, 0, 0, 0); }
    }
}
__device__ __forceinline__ void softmax_step(float* sv, float& m, float& l, f32x16& o0, f32x16& o1) {
    float ml = sv[0];
#pragma unroll
    for (int i = 1; i < 16; ++i) ml = fmaxf(ml, sv[i]);
    ml = fmaxf(ml, __shfl_xor(ml, 32));
    const float mn = fmaxf(m, ml), alpha = __expf(m - mn);
    m = mn;
    float ps = 0.f;
#pragma unroll
    for (int i = 0; i < 16; ++i) { const float e = (sv[i] > -1e29f) ? __expf(sv[i] - mn) : 0.f; sv[i] = e; ps += e; }
    l = l * alpha + ps;
#pragma unroll
    for (int i = 0; i < 16; ++i) { o0[i] *= alpha; o1[i] *= alpha; }
}
__device__ __forceinline__ void nsa_attn_item(const Params& p, unsigned char* wlds, int item) {
    const int lane = threadIdx.x & 63, c = lane & 31, hh = lane >> 5, jt = c >> 2, r4 = c & 3;
    const int oct = item & 1023, g = (item >> 10) & 1, b = item >> 11;
    const int t0 = oct * 8, tc = t0 + jt, h = g * 4 + r4;
    const float slope = exp2f(-(float)(h + 1));
    const bf16* proj = (const bf16*)(p.ws + WS_PROJ);
    float* impA = (float*)wlds; float* impB = impA + 1024; unsigned* msk = (unsigned*)(impB + 1024);
#pragma unroll
    for (int i = 0; i < 16; ++i) { impA[lane + 64 * i] = 0.f; impB[lane + 64 * i] = 0.f; }
    if (lane < 32) msk[lane] = 0u;
    bf16x8 qf[4];
    { const bf16* qp = proj + (size_t)(b * T + tc) * PS + C_NQ + h * 64 + hh * 8;
#pragma unroll
      for (int s = 0; s < 4; ++s) qf[s] = *(const bf16x8*)(qp + s * 16); }
    f32x16 oc0, oc1;
#pragma unroll
    for (int i = 0; i < 16; ++i) { oc0[i] = 0.f; oc1[i] = 0.f; }
    float gate[3];
    { const bf16* gp = proj + (size_t)(b * T + tc) * PS + C_GT + h * 3;
#pragma unroll
      for (int i = 0; i < 3; ++i) gate[i] = sigmoidf_(bf2f(gp[i])); }
    WAVE_LDS_SYNC();
    {
        const bf16* KC = (const bf16*)(p.ws + WS_KC) + (size_t)(b * 2 + g) * 512 * 64;
        const bf16* VCT = (const bf16*)(p.ws + WS_VCT) + (size_t)(b * 2 + g) * 64 * 512;
        const int nmax = (t0 + 7 >= 31) ? ((t0 + 7 - 31) >> 4) : -1;
        float m = -1e30f, l = 0.f;
        f32x16 o0, o1;
#pragma unroll
        for (int i = 0; i < 16; ++i) { o0[i] = 0.f; o1[i] = 0.f; }
#pragma unroll 1
        for (int n0 = 0; n0 <= nmax; n0 += 32) {
            const f32x16 st = score_tile(KC + (size_t)(n0 + c) * 64 + hh * 8, qf);
            float sv[16];
#pragma unroll
            for (int i = 0; i < 16; ++i) { const int dist = tc - (16 * (n0 + rho16(i, hh)) + 31); sv[i] = (dist >= 0) ? st[i] - slope * (float)dist : -1e30f; }
            float ml = sv[0];
#pragma unroll
            for (int i = 1; i < 16; ++i) ml = fmaxf(ml, sv[i]);
            ml = fmaxf(ml, __shfl_xor(ml, 32));
            const float mn = fmaxf(m, ml); float ps = 0.f;
#pragma unroll
            for (int i = 0; i < 16; ++i) ps += (sv[i] > -1e29f) ? __expf(sv[i] - mn) : 0.f;
            l = l * __expf(m - mn) + ps; m = mn;
        }
        l += __shfl_xor(l, 32);
        const float inv = 1.0f / fmaxf(l, 1e-30f);
#pragma unroll 1
        for (int n0 = 0; n0 <= nmax; n0 += 32) {
            const f32x16 st = score_tile(KC + (size_t)(n0 + c) * 64 + hh * 8, qf);
            float pv[16];
#pragma unroll
            for (int i = 0; i < 16; ++i) { const int dist = tc - (16 * (n0 + rho16(i, hh)) + 31); pv[i] = (dist >= 0) ? __expf(st[i] - slope * (float)dist - m) * inv : 0.f; }
            pv_tile(o0, o1, VCT + (size_t)c * 512 + n0 + 4 * hh, (size_t)32 * 512, pv);
#pragma unroll
            for (int i = 0; i < 16; ++i) { float v = pv[i]; v += dpp_f<0xB1>(v); v += dpp_f<0x4E>(v); pv[i] = v; }
            if (r4 == 0) {
#pragma unroll
                for (int rg = 0; rg < 4; ++rg) {
                    const int jb = (n0 >> 2) + 2 * rg + hh;
                    impA[jt * 128 + jb] = pv[4 * rg] + 2.f * pv[4 * rg + 1] + 2.f * pv[4 * rg + 2] + 2.f * pv[4 * rg + 3];
                    if (jb >= 1) impB[jt * 128 + jb - 1] = pv[4 * rg];
                }
            }
        }
#pragma unroll
        for (int i = 0; i < 16; ++i) { oc0[i] = gate[0] * o0[i]; oc1[i] = gate[0] * o1[i]; }
    }
    WAVE_LDS_SYNC();
    {
        const int lig = lane & 15, grp = lane >> 4;
#pragma unroll 1
        for (int half = 0; half < 2; ++half) {
            const int j2 = half * 4 + grp, cur = (t0 + j2) >> 6;
            float v[8];
#pragma unroll
            for (int e = 0; e < 8; ++e) {
                const int j = lig * 8 + e; const float val = impA[j2 * 128 + j] + impB[j2 * 128 + j];
                v[e] = (j >= 1 && j <= cur - 2) ? __uint_as_float((__float_as_uint(val) & ~127u) | (unsigned)(127 - j)) : -1.0f;
            }
            const float top = grp16_top16(v, lig);
            const int need = 16 - ((cur == 0) ? 1 : (cur == 1) ? 2 : 3);
            if (lig < need && top >= 0.f) { const int idx = 127 - (int)(__float_as_uint(top) & 127u); atomicOr(&msk[j2 * 4 + (idx >> 5)], 1u << (idx & 31)); }
            if (lig == 0) { atomicOr(&msk[j2 * 4], 1u); atomicOr(&msk[j2 * 4 + (cur >> 5)], 1u << (cur & 31)); if (cur >= 1) atomicOr(&msk[j2 * 4 + ((cur - 1) >> 5)], 1u << ((cur - 1) & 31)); }
        }
    }
    WAVE_LDS_SYNC();
    {
        unsigned mym[4], um[4];
#pragma unroll
        for (int w = 0; w < 4; ++w) { mym[w] = msk[jt * 4 + w]; unsigned u = 0u;
#pragma unroll
            for (int j = 0; j < 8; ++j) u |= msk[j * 4 + w];
            um[w] = (unsigned)__builtin_amdgcn_readfirstlane((int)u); }
        const bf16* VTS = (const bf16*)(p.ws + WS_VTS) + (size_t)(b * 2 + g) * 64 * T;
        float m = -1e30f, l = 0.f;
        f32x16 o0, o1;
#pragma unroll
        for (int i = 0; i < 16; ++i) { o0[i] = 0.f; o1[i] = 0.f; }
#pragma unroll
        for (int w = 0; w < 4; ++w) {
            unsigned u = um[w];
#pragma unroll 1
            while (u) {
                const int bit = __builtin_ctz(u); u &= u - 1u;
                const int jb = w * 32 + bit;
                const bool colsel = (mym[w] >> bit) & 1u;
#pragma unroll 1
                for (int hf = 0; hf < 2; ++hf) {
                    const int key0 = jb * 64 + hf * 32;
                    const f32x16 st = score_tile(proj + (size_t)(b * T + key0 + c) * PS + C_KS + g * 64 + hh * 8, qf);
                    float sv[16];
#pragma unroll
                    for (int i = 0; i < 16; ++i) { const int dist = tc - (key0 + rho16(i, hh)); sv[i] = (colsel && dist >= 0) ? st[i] - slope * (float)dist : -1e30f; }
                    softmax_step(sv, m, l, o0, o1);
                    pv_tile(o0, o1, VTS + (size_t)c * T + key0 + 4 * hh, (size_t)32 * T, sv);
                }
            }
        }
        l += __shfl_xor(l, 32);
        const float sc = gate[1] / fmaxf(l, 1e-30f);
#pragma unroll
        for (int i = 0; i < 16; ++i) { oc0[i] += sc * o0[i]; oc1[i] += sc * o1[i]; }
    }
    {
        const bf16* VTW = (const bf16*)(p.ws + WS_VTW) + (size_t)(b * 2 + g) * 64 * T;
        float m = -1e30f, l = 0.f;
        f32x16 o0, o1;
#pragma unroll
        for (int i = 0; i < 16; ++i) { o0[i] = 0.f; o1[i] = 0.f; }
        const int kstart = (t0 - 511 > 0 ? t0 - 511 : 0) & ~31;
#pragma unroll 1
        for (int key0 = kstart; key0 <= t0 + 7; key0 += 32) {
            const f32x16 st = score_tile(proj + (size_t)(b * T + key0 + c) * PS + C_KW + g * 64 + hh * 8, qf);
            float sv[16];
#pragma unroll
            for (int i = 0; i < 16; ++i) { const int dist = tc - (key0 + rho16(i, hh)); sv[i] = (dist >= 0 && dist < 512) ? st[i] - slope * (float)dist : -1e30f; }
            softmax_step(sv, m, l, o0, o1);
            pv_tile(o0, o1, VTW + (size_t)c * T + key0 + 4 * hh, (size_t)32 * T, sv);
        }
        l += __shfl_xor(l, 32);
        const float sc = gate[2] / fmaxf(l, 1e-30f);
#pragma unroll
        for (int i = 0; i < 16; ++i) { oc0[i] += sc * o0[i]; oc1[i] += sc * o1[i]; }
    }
    {
        float ss = 0.f;
#pragma unroll
        for (int i = 0; i < 16; ++i) ss += oc0[i] * oc0[i] + oc1[i] * oc1[i];
        ss += __shfl_xor(ss, 32);
        const float r = rsqrtf(ss * (1.0f / 64.0f) + EPS);
        const float* og = p.in[11] + h * 64;
        bf16* op = (bf16*)(p.ws + WS_ACT) + (size_t)(b * T + tc) * D + 512 + h * 64;
#pragma unroll
        for (int dt = 0; dt < 2; ++dt)
#pragma unroll
            for (int rg = 0; rg < 4; ++rg) {
                const int d0 = dt * 32 + 8 * rg + 4 * hh;
                const f32x4 gg = *(const f32x4*)(og + d0);
                u32x2 w;
                if (dt == 0) { w.x = pk2(oc0[4 * rg] * r * gg.x, oc0[4 * rg + 1] * r * gg.y); w.y = pk2(oc0[4 * rg + 2] * r * gg.z, oc0[4 * rg + 3] * r * gg.w); }
                else { w.x = pk2(oc1[4 * rg] * r * gg.x, oc1[4 * rg + 1] * r * gg.y); w.y = pk2(oc1[4 * rg + 2] * r * gg.z, oc1[4 * rg + 3] * r * gg.w); }
                *(u32x2*)(op + d0) = w;
            }
    }
    WAVE_LDS_SYNC();
}
__device__ __forceinline__ void phase2(const Params& p, unsigned char* lds) {
    for (int it = blockIdx.x; it < 128 + 256 + 1024; it += gridDim.x) {
        if (it < 128) nsa_cmp_item(p, lds, it);
        else if (it < 384) nsa_prep_item(p, lds, it - 128);
        else hgrn_pre_item(p, lds, it - 384);
    }
}
template <bool SCAN>
__device__ __forceinline__ void phase3(const Params& p, unsigned char* lds) {
    const int gw = (blockIdx.x * NTHR + threadIdx.x) >> 6;
    const int wid = threadIdx.x >> 6;
    if (SCAN && wid == 0 && blockIdx.x < 64) hgrn_scan_item<false>(p, blockIdx.x);
    unsigned* ctr = (unsigned*)(p.ws + WS_CTR) + (SCAN ? 0 : 64);
    for (;;) {
        int it = 0;
        if ((threadIdx.x & 63) == 0) it = (int)atomicAdd(ctr, 1u);
        it = __builtin_amdgcn_readfirstlane(it);
        if (it >= 4096) break;
        nsa_attn_item(p, lds + wid * 8320, 4095 - it);
    }
}

__device__ __forceinline__ float dot2u(unsigned a, unsigned b, float acc) { return __builtin_amdgcn_fdot2_f32_bf16(__builtin_bit_cast(bf16x2v, a), __builtin_bit_cast(bf16x2v, b), acc, false); }
__device__ __forceinline__ float dot8(u32x4 a, u32x4 b, float acc) {
    const unsigned a0 = a.x, a1 = a.y, a2 = a.z, a3 = a.w, b0 = b.x, b1 = b.y, b2 = b.z, b3 = b.w;
    acc = dot2u(a0, b0, acc); acc = dot2u(a1, b1, acc); acc = dot2u(a2, b2, acc); acc = dot2u(a3, b3, acc);
    return acc;
}
__device__ __forceinline__ void axpy8(float (&o)[8], float c, u32x4 v) {
    o[0] += c * __uint_as_float(v.x << 16); o[1] += c * __uint_as_float(v.x & 0xffff0000u);
    o[2] += c * __uint_as_float(v.y << 16); o[3] += c * __uint_as_float(v.y & 0xffff0000u);
    o[4] += c * __uint_as_float(v.z << 16); o[5] += c * __uint_as_float(v.z & 0xffff0000u);
    o[6] += c * __uint_as_float(v.w << 16); o[7] += c * __uint_as_float(v.w & 0xffff0000u);
}
typedef float f32x2 __attribute__((ext_vector_type(2)));
__device__ __forceinline__ float dot16_fp8(u32x4 r, const float* xf) {
    const unsigned r0 = r.x, r1 = r.y, r2 = r.z, r3 = r.w; float acc = 0.f; f32x2 t;
    t = __builtin_amdgcn_cvt_pk_f32_fp8((int)r0, false); acc += t.x * xf[0] + t.y * xf[1]; t = __builtin_amdgcn_cvt_pk_f32_fp8((int)r0, true); acc += t.x * xf[2] + t.y * xf[3];
    t = __builtin_amdgcn_cvt_pk_f32_fp8((int)r1, false); acc += t.x * xf[4] + t.y * xf[5]; t = __builtin_amdgcn_cvt_pk_f32_fp8((int)r1, true); acc += t.x * xf[6] + t.y * xf[7];
    t = __builtin_amdgcn_cvt_pk_f32_fp8((int)r2, false); acc += t.x * xf[8] + t.y * xf[9]; t = __builtin_amdgcn_cvt_pk_f32_fp8((int)r2, true); acc += t.x * xf[10] + t.y * xf[11];
    t = __builtin_amdgcn_cvt_pk_f32_fp8((int)r3, false); acc += t.x * xf[12] + t.y * xf[13]; t = __builtin_amdgcn_cvt_pk_f32_fp8((int)r3, true); acc += t.x * xf[14] + t.y * xf[15];
    return acc;
}
__device__ __forceinline__ void axpy16_fp8(float* o, float c, u32x4 r) {
    const unsigned r0 = r.x, r1 = r.y, r2 = r.z, r3 = r.w; f32x2 t;
    t = __builtin_amdgcn_cvt_pk_f32_fp8((int)r0, false); o[0] += c * t.x; o[1] += c * t.y; t = __builtin_amdgcn_cvt_pk_f32_fp8((int)r0, true); o[2] += c * t.x; o[3] += c * t.y;
    t = __builtin_amdgcn_cvt_pk_f32_fp8((int)r1, false); o[4] += c * t.x; o[5] += c * t.y; t = __builtin_amdgcn_cvt_pk_f32_fp8((int)r1, true); o[6] += c * t.x; o[7] += c * t.y;
    t = __builtin_amdgcn_cvt_pk_f32_fp8((int)r2, false); o[8] += c * t.x; o[9] += c * t.y; t = __builtin_amdgcn_cvt_pk_f32_fp8((int)r2, true); o[10] += c * t.x; o[11] += c * t.y;
    t = __builtin_amdgcn_cvt_pk_f32_fp8((int)r3, false); o[12] += c * t.x; o[13] += c * t.y; t = __builtin_amdgcn_cvt_pk_f32_fp8((int)r3, true); o[14] += c * t.x; o[15] += c * t.y;
}
template <bool DUMMY>
__device__ __forceinline__ void phase9(const Params& p, unsigned char* lds) {
    const bf16* HN = (const bf16*)(p.ws + WS_ACT); const unsigned char* UB = p.ws + WS_UB; const unsigned char* VB = p.ws + WS_VB;
    const float* US = (const float*)(p.ws + WS_US); const float* VS = (const float*)(p.ws + WS_VS);
    const int* ids = (const int*)(p.ws + WS_IDS); const float* wts = (const float*)(p.ws + WS_WTS);
    float* O = p.out; bf16* HG = (bf16*)(p.ws + WS_PROJ + 64 * MiB); const float* gn = p.in[19];
    const int lane = threadIdx.x & 63, gw = (blockIdx.x * NTHR + threadIdx.x) >> 6, ngw = (gridDim.x * NTHR) >> 6;
    for (int tok = gw; tok < NTOK; tok += ngw) {
        float xf[16], oa[16];
        {
            const u32x4 x0 = *(const u32x4*)(HN + (size_t)tok * D + lane * 16), x1 = *(const u32x4*)(HN + (size_t)tok * D + lane * 16 + 8);
            const unsigned a0 = x0.x, a1 = x0.y, a2 = x0.z, a3 = x0.w, b0 = x1.x, b1 = x1.y, b2 = x1.z, b3 = x1.w;
            xf[0] = __uint_as_float(a0 << 16); xf[1] = __uint_as_float(a0 & 0xffff0000u); xf[2] = __uint_as_float(a1 << 16); xf[3] = __uint_as_float(a1 & 0xffff0000u);
            xf[4] = __uint_as_float(a2 << 16); xf[5] = __uint_as_float(a2 & 0xffff0000u); xf[6] = __uint_as_float(a3 << 16); xf[7] = __uint_as_float(a3 & 0xffff0000u);
            xf[8] = __uint_as_float(b0 << 16); xf[9] = __uint_as_float(b0 & 0xffff0000u); xf[10] = __uint_as_float(b1 << 16); xf[11] = __uint_as_float(b1 & 0xffff0000u);
            xf[12] = __uint_as_float(b2 << 16); xf[13] = __uint_as_float(b2 & 0xffff0000u); xf[14] = __uint_as_float(b3 << 16); xf[15] = __uint_as_float(b3 & 0xffff0000u);
        }
#pragma unroll
        for (int j = 0; j < 16; ++j) oa[j] = 0.f;
#pragma unroll 1
        for (int half = 0; half < 2; ++half) {
            const int myid = ids[(size_t)tok * 128 + half * 64 + lane];
            const float myw = wts[(size_t)tok * 128 + half * 64 + lane] * VS[myid];
            const float myus = US[myid];
#pragma unroll 1
            for (int eb = 0; eb < 64; eb += 16) {
                int id[16]; float d[16]; u32x4 ur[16];
#pragma unroll
                for (int j = 0; j < 16; ++j) id[j] = __shfl(myid, eb + j);
#pragma unroll
                for (int j = 0; j < 16; ++j) ur[j] = *(const u32x4*)(UB + (size_t)id[j] * D + lane * 16);
#pragma unroll
                for (int j = 0; j < 16; ++j) d[j] = dot16_fp8(ur[j], xf);
#pragma unroll
                for (int j = 0; j < 16; ++j) ur[j] = *(const u32x4*)(VB + (size_t)id[j] * D + lane * 16);
#pragma unroll
                for (int j = 0; j < 16; ++j) d[j] = wave_sum(d[j]);
#pragma unroll
                for (int j = 0; j < 16; ++j) { const float c = __shfl(myw, eb + j) * gelu_tanh(d[j] * __shfl(myus, eb + j)); axpy16_fp8(oa, c, ur[j]); }
            }
        }
        float* orow = O + (size_t)tok * D + lane * 16; float* wrow = DUMMY ? (float*)(p.ws + WS_PROJ) + (size_t)tok * D + lane * 16 : orow;
        float ss = 0.f; f32x4 hv[4];
#pragma unroll
        for (int q = 0; q < 4; ++q) {
            f32x4 h = *(const f32x4*)(orow + 4 * q);
            h.x += oa[4 * q]; h.y += oa[4 * q + 1]; h.z += oa[4 * q + 2]; h.w += oa[4 * q + 3];
            *(f32x4*)(wrow + 4 * q) = h; hv[q] = h;
            ss += h.x * h.x + h.y * h.y + h.z * h.z + h.w * h.w;
        }
        ss = wave_sum(ss);
        const float r = rsqrtf(ss * (1.0f / D) + EPS);
        u32x4 q0, q1;
        { const f32x4 g0 = *(const f32x4*)(gn + lane * 16), g1 = *(const f32x4*)(gn + lane * 16 + 4), g2 = *(const f32x4*)(gn + lane * 16 + 8), g3 = *(const f32x4*)(gn + lane * 16 + 12);
          q0.x = pk2(hv[0].x * r * g0.x, hv[0].y * r * g0.y); q0.y = pk2(hv[0].z * r * g0.z, hv[0].w * r * g0.w); q0.z = pk2(hv[1].x * r * g1.x, hv[1].y * r * g1.y); q0.w = pk2(hv[1].z * r * g1.z, hv[1].w * r * g1.w);
          q1.x = pk2(hv[2].x * r * g2.x, hv[2].y * r * g2.y); q1.y = pk2(hv[2].z * r * g2.z, hv[2].w * r * g2.w); q1.z = pk2(hv[3].x * r * g3.x, hv[3].y * r * g3.y); q1.w = pk2(hv[3].z * r * g3.z, hv[3].w * r * g3.w); }
        *(u32x4*)(HG + (size_t)tok * D + lane * 16) = q0; *(u32x4*)(HG + (size_t)tok * D + lane * 16 + 8) = q1;
    }
}

#define XB_TMO      128
#define XB_XCNT(j)  (256  + 64 * (j))
#define XB_XSUB(j)  (1280 + 64 * (j))
#define XB_XGEN(j)  (2304 + 64 * (j))
#define XB_TOP      3328
#define XB_TOPGEN   3392
#define XCD_BAR_WORDS 3456
#define XB_SPIN_CAP (1u << 18)
#define LAS __attribute__((address_space(3)))
__device__ __forceinline__ unsigned xb_ld(unsigned* p)              { return __hip_atomic_load(p, __ATOMIC_RELAXED, __HIP_MEMORY_SCOPE_AGENT); }
__device__ __forceinline__ unsigned xb_add(unsigned* p, unsigned v) { return __hip_atomic_fetch_add(p, v, __ATOMIC_RELAXED, __HIP_MEMORY_SCOPE_AGENT); }
__device__ __forceinline__ unsigned xb_xcc_id() { return (unsigned)__builtin_amdgcn_s_getreg((3 << 11) | 20) & 0xFu; }
#define XB_SPIN(cond, bar) do { unsigned _sp = 0; while (cond) { __builtin_amdgcn_s_sleep(1); \
    if ((++_sp & 255u) == 0u) { if (xb_ld(&(bar)[XB_TMO])) break; if (_sp > XB_SPIN_CAP) { atomicAdd(&(bar)[XB_TMO], 1u); break; } } } } while (0)
struct XcdBarrier { unsigned* bar; unsigned x; volatile LAS unsigned* st; };
__device__ __forceinline__ XcdBarrier xcd_barrier_post(unsigned* bar, volatile LAS unsigned* st) {
    XcdBarrier b; b.bar = bar; b.x = xb_xcc_id(); b.st = st;
    if (threadIdx.x == 0) (void)xb_add(&bar[XB_XCNT(b.x)], 1u);
    return b;
}
__device__ __forceinline__ void xcd_barrier_complete(unsigned* bar, unsigned x, unsigned& nloc, unsigned& nx) {
    const unsigned G = gridDim.x * gridDim.y * gridDim.z;
    unsigned sum, cnt, mine, sp = 0u;
    for (;;) {
        sum = 0u; cnt = 0u; mine = 0u;
#pragma unroll
        for (unsigned j = 0; j < 16; ++j) { const unsigned c = xb_ld(&bar[XB_XCNT(j)]); sum += c; cnt += (c > 0u) ? 1u : 0u; mine = (j == x) ? c : mine; }
        if (sum == G) break;
        __builtin_amdgcn_s_sleep(1);
        if ((++sp & 255u) == 0u) { if (xb_ld(&bar[XB_TMO])) break; if (sp > XB_SPIN_CAP) { atomicAdd(&bar[XB_TMO], 1u); break; } }
    }
    nloc = mine > 0u ? mine : 1u; nx = cnt > 0u ? cnt : 1u;
}
__device__ __forceinline__ void xcd_barrier(const XcdBarrier& b) {
    asm volatile("s_waitcnt vmcnt(0)" ::: "memory");
    __syncthreads();
    if (threadIdx.x == 0) {
        unsigned* bar = b.bar;
        __builtin_amdgcn_s_waitcnt(0);
        unsigned nloc = b.st[0], nx = b.st[1];
        if (nloc == 0u) { xcd_barrier_complete(bar, b.x, nloc, nx); b.st[0] = nloc; b.st[1] = nx; }
        const unsigned old = xb_add(&bar[XB_XSUB(b.x)], 1u);
        const unsigned gen = old / nloc;
        if (old + 1u == (gen + 1u) * nloc) {
            __builtin_amdgcn_fence(__ATOMIC_RELEASE, "agent");
            asm volatile("s_waitcnt vmcnt(0)" ::: "memory");
            const unsigned og = xb_add(&bar[XB_TOP], 1u);
            const unsigned tg = og / nx;
            if (og + 1u == (tg + 1u) * nx) xb_add(&bar[XB_TOPGEN], 1u);
            else XB_SPIN(xb_ld(&bar[XB_TOPGEN]) == tg, bar);
            __builtin_amdgcn_fence(__ATOMIC_ACQUIRE, "agent");
            xb_add(&bar[XB_XGEN(b.x)], 1u);
            asm volatile("s_waitcnt vmcnt(0)" ::: "memory");
        } else {
            XB_SPIN(xb_ld(&bar[XB_XGEN(b.x)]) == gen, bar);
            __builtin_amdgcn_fence(__ATOMIC_ACQUIRE, "agent");
            asm volatile("s_waitcnt vmcnt(0)" ::: "memory");
        }
    }
    __syncthreads();
}

constexpr int REPK = -1;
__global__ void __launch_bounds__(NTHR, 2) mega(Params p, int ph_lo, int ph_hi) {
    extern __shared__ __attribute__((aligned(16))) unsigned char lds[];
    volatile LAS unsigned* st = (volatile LAS unsigned*)(LAS unsigned char*)(lds + LDS_BYTES - 16);
    if (threadIdx.x < 4) st[threadIdx.x] = 0u;
    __syncthreads();
    const XcdBarrier bar = xcd_barrier_post((unsigned*)p.ws, st);
#define RUN_PHASE(k, call) if (ph_lo <= (k) && (k) < ph_hi) { if ((k) > ph_lo) xcd_barrier(bar); call; if (REPK == (k)) { xcd_barrier(bar); call; } }
    RUN_PHASE(0, phase0(p, lds))
    RUN_PHASE(1, phase1(p, lds))
    RUN_PHASE(2, phase2(p, lds))
    if (REPK == 30) { xcd_barrier(bar); if ((threadIdx.x >> 6) == 0 && blockIdx.x < 64) hgrn_scan_item<true>(p, blockIdx.x); }
    if (ph_lo <= 3 && 3 < ph_hi) { if (3 > ph_lo) xcd_barrier(bar); phase3<true>(p, lds); if (REPK == 3) { xcd_barrier(bar); phase3<false>(p, lds); } }
    RUN_PHASE(4, phase4(p, lds))
    RUN_PHASE(5, phase5(p, lds))
    RUN_PHASE(6, phase6(p, lds))
    RUN_PHASE(7, phase7(p, lds))
    RUN_PHASE(8, phase8(p, lds))
    if (REPK == 9) { xcd_barrier(bar); phase9<true>(p, lds); }
    if (ph_lo <= 9 && 9 < ph_hi) { if (9 > ph_lo) xcd_barrier(bar); phase9<false>(p, lds); }
    RUN_PHASE(10, phase10(p, lds))
}

static void launch_mega(const Params& p, int lo, int hi, hipStream_t stream) {
    static int grid = 0;
    if (grid == 0) {
        int dev = 0, cus = 0, per_cu = 0;
        hipGetDevice(&dev); hipDeviceGetAttribute(&cus, hipDeviceAttributeMultiprocessorCount, dev);
        hipFuncSetAttribute((const void*)mega, hipFuncAttributeMaxDynamicSharedMemorySize, LDS_BYTES);
        hipOccupancyMaxActiveBlocksPerMultiprocessor(&per_cu, (const void*)mega, NTHR, LDS_BYTES);
        if (per_cu < 1) { fprintf(stderr, "mega: occupancy query says %d blocks/CU\n", per_cu); per_cu = 1; }
        grid = cus;
    }
    hipMemsetAsync(p.ws, 0, 65536, stream);
    Params pp = p; int l = lo, h = hi;
    void* args[] = {&pp, &l, &h};
    hipError_t e = hipLaunchCooperativeKernel((const void*)mega, dim3(grid), dim3(NTHR), args, LDS_BYTES, stream);
    if (e != hipSuccess) fprintf(stderr, "cooperative launch failed: %s (grid %d)\n", hipGetErrorString(e), grid);
}

extern "C" void kernel_launch(void* const* d_in, const int* in_sizes, int n_in, void* d_out, int out_size, void* d_ws, size_t ws_size, hipStream_t stream) {
    const float* x = (const float*)d_in[0]; const float* p = (const float*)d_in[1]; const float* mix_norm = (const float*)d_in[2]; const float* w_in = (const float*)d_in[3];
    const float* lb_logits = (const float*)d_in[4]; const float* hg_out_norm = (const float*)d_in[5]; const float* q_norm = (const float*)d_in[6]; const float* k_norm = (const float*)d_in[7];
    const float* cmp_pe = (const float*)d_in[8]; const float* cmp_w1 = (const float*)d_in[9]; const float* cmp_w2 = (const float*)d_in[10]; const float* nsa_out_norm = (const float*)d_in[11];
    const float* w_out = (const float*)d_in[12]; const float* ffn_norm = (const float*)d_in[13]; const float* peer_wq = (const float*)d_in[14]; const float* peer_keys = (const float*)d_in[15];
    const float* peer_u = (const float*)d_in[16]; const float* peer_v = (const float*)d_in[17]; const float* ple_proj = (const float*)d_in[18]; const float* ple_gate_norm = (const float*)d_in[19];
    const float* ple_gate_w = (const float*)d_in[20];
    float* out = (float*)d_out; unsigned char* ws = (unsigned char*)d_ws;
    bf16* act = (bf16*)(ws + WS_ACT); bf16* proj = (bf16*)(ws + WS_PROJ);
    bf16* pq = (bf16*)(ws + WS_PROJ); bf16* hg = (bf16*)(ws + WS_PROJ + 64 * MiB);
    int* ids = (int*)(ws + WS_IDS); float* wts = (float*)(ws + WS_WTS); float* kcf = (float*)(ws + WS_KCF); float* vcf = (float*)(ws + WS_VCF); float* gl = (float*)(ws + WS_GL);

    Params prm{}; for (int i = 0; i < 21; ++i) prm.in[i] = (const float*)d_in[i]; prm.out = out; prm.ws = ws;
    launch_mega(prm, 0, 11, stream);
}
```

```cpp
#include <hip/hip_runtime.h>
#include <hip/hip_cooperative_groups.h>
#include <cstdint>
#include <cstdio>
namespace cg = cooperative_groups;

constexpr int D = 1024, NB = 2, T = 8192, NTOK = NB * T;
constexpr int DIN = 3352, PS = 3392;
constexpr int C_HQ = 0, C_HF = 512, C_HI = 1024, C_HG = 1536, C_NQ = 2048, C_KC = 2560, C_VC = 2688,
              C_KS = 2816, C_VS = 2944, C_KW = 3072, C_VW = 3200, C_GT = 3328;
constexpr int NCMP = 511;
constexpr float EPS = 1e-6f;
typedef unsigned short bf16;

constexpr size_t MiB = 1u << 20;
constexpr size_t WS_WINT = 1 * MiB;
constexpr size_t WS_WOUTT = 8 * MiB;
constexpr size_t WS_WQT = 10 * MiB;
constexpr size_t WS_WGT = 14 * MiB;
constexpr size_t WS_WPT = 16 * MiB;
constexpr size_t WS_KEYB = 16 * MiB + 512 * 1024;
constexpr size_t WS_W1T = 17 * MiB;
constexpr size_t WS_CTR = 16384;
constexpr size_t WS_US = 256 * 1024;
constexpr size_t WS_VS = 320 * 1024;
constexpr size_t WS_UB = 18 * MiB;
constexpr size_t WS_VB = 50 * MiB;
constexpr size_t WS_ACT = 82 * MiB;
constexpr size_t WS_PROJ = 114 * MiB;
constexpr size_t WS_SPARE = 220 * MiB;
constexpr size_t WS_IDS = WS_SPARE;
constexpr size_t WS_WTS = WS_SPARE + 8 * MiB;
constexpr size_t WS_KCF = WS_SPARE + 16 * MiB;
constexpr size_t WS_VCF = WS_SPARE + 17 * MiB;
constexpr size_t WS_PB = WS_SPARE + 18 * MiB;
constexpr size_t WS_VTS = WS_SPARE + 26 * MiB;
constexpr size_t WS_VTW = WS_SPARE + 30 * MiB;
constexpr size_t WS_KC = WS_SPARE + 34 * MiB;
constexpr size_t WS_VCT = WS_SPARE + 34 * MiB + 256 * 1024;
constexpr size_t WS_DEC = WS_SPARE + 34 * MiB + 512 * 1024;
constexpr size_t OUT_KIT = 32 * MiB;
constexpr size_t OUT_VT = 48 * MiB;
constexpr size_t WS_GL = 18 * MiB;

__device__ __forceinline__ float bf2f(bf16 v) { return __uint_as_float(((unsigned)v) << 16); }
__device__ __forceinline__ bf16 f2bf(float f) { return __builtin_bit_cast(bf16, (__bf16)f); }
__device__ __forceinline__ float wave_sum(float v) {
#pragma unroll
    for (int o = 1; o < 64; o <<= 1) v += __shfl_xor(v, o);
    return v;
}
__device__ __forceinline__ float wave_max(float v) {
#pragma unroll
    for (int o = 1; o < 64; o <<= 1) v = fmaxf(v, __shfl_xor(v, o));
    return v;
}
__device__ __forceinline__ float sigmoidf_(float x) { return 1.0f / (1.0f + __expf(-x)); }
__device__ __forceinline__ float siluf_(float x) { return x * sigmoidf_(x); }
__device__ __forceinline__ float gelu_tanh(float x) { return 0.5f * x * (1.0f + tanhf(0.7978845608028654f * (x + 0.044715f * x * x * x))); }
__device__ __forceinline__ float toF(float v) { return v; }
__device__ __forceinline__ float toF(bf16 v) { return bf2f(v); }

__global__ void __launch_bounds__(256) k_rms_rows(const float* __restrict__ x, const float* __restrict__ g, bf16* __restrict__ out, int rows) {
    const int wave = (blockIdx.x * 256 + threadIdx.x) >> 6, lane = threadIdx.x & 63;
    if (wave >= rows) return;
    const float* xr = x + (size_t)wave * D;
    float v[16]; float s = 0.f;
#pragma unroll
    for (int j = 0; j < 16; ++j) { v[j] = xr[lane + 64 * j]; s += v[j] * v[j]; }
    s = wave_sum(s);
    const float r = rsqrtf(s * (1.0f / D) + EPS);
#pragma unroll
    for (int j = 0; j < 16; ++j) out[(size_t)wave * D + lane + 64 * j] = f2bf(v[j] * r * g[lane + 64 * j]);
}

struct EpiBf16 { bf16* C; int ldc; int pad; __device__ void operator()(int r, int c, float v) const { C[(size_t)r * ldc + c] = f2bf(v); } };
struct EpiF32 { float* C; int ldc; int pad; __device__ void operator()(int r, int c, float v) const { C[(size_t)r * ldc + c] = v; } };
struct EpiResid { const float* X; float* O; int ld; int pad; __device__ void operator()(int r, int c, float v) const { O[(size_t)r * ld + c] = X[(size_t)r * ld + c] + v; } };
struct EpiFinal { const float* G; float* O; int ld; int pad; __device__ void operator()(int r, int c, float v) const { const size_t i = (size_t)r * ld + c; O[i] = O[i] + v * sigmoidf_(G[i]); } };

template <typename AT, class Epi>
__global__ void __launch_bounds__(256) k_gemm_naive(const AT* __restrict__ A, int lda, const float* __restrict__ W, int ldw, int N, int K, Epi epi) {
    __shared__ float As[16][65];
    __shared__ float Bs[16][64];
    const int tid = threadIdx.x, tx = tid & 15, ty = tid >> 4;
    const int m0 = blockIdx.y * 64, n0 = blockIdx.x * 64;
    float acc[4][4];
#pragma unroll
    for (int i = 0; i < 4; ++i)
#pragma unroll
        for (int j = 0; j < 4; ++j) acc[i][j] = 0.f;
    for (int k0 = 0; k0 < K; k0 += 16) {
#pragma unroll
        for (int i = 0; i < 4; ++i) { const int idx = tid + i * 256, r = idx >> 4, kk = idx & 15; As[kk][r] = toF(A[(size_t)(m0 + r) * lda + k0 + kk]); }
#pragma unroll
        for (int i = 0; i < 4; ++i) { const int idx = tid + i * 256, kk = idx >> 6, c = idx & 63; Bs[kk][c] = (n0 + c < N) ? W[(size_t)(k0 + kk) * ldw + n0 + c] : 0.f; }
        __syncthreads();
#pragma unroll
        for (int kk = 0; kk < 16; ++kk) {
            float a[4], b[4];
#pragma unroll
            for (int i = 0; i < 4; ++i) a[i] = As[kk][ty * 4 + i];
#pragma unroll
            for (int j = 0; j < 4; ++j) b[j] = Bs[kk][tx * 4 + j];
#pragma unroll
            for (int i = 0; i < 4; ++i)
#pragma unroll
                for (int j = 0; j < 4; ++j) acc[i][j] += a[i] * b[j];
        }
        __syncthreads();
    }
#pragma unroll
    for (int i = 0; i < 4; ++i)
#pragma unroll
        for (int j = 0; j < 4; ++j) { const int r = m0 + ty * 4 + i, c = n0 + tx * 4 + j; if (c < N) epi(r, c, acc[i][j]); }
}

__global__ void __launch_bounds__(1024) k_hgrn_naive(const bf16* __restrict__ proj, const float* __restrict__ lb_logits, const float* __restrict__ out_gain, bf16* __restrict__ mixed) {
    const int b = blockIdx.x >> 2, h = blockIdx.x & 3, tid = threadIdx.x, v = tid & 127, kg = tid >> 7;
    __shared__ float qsh[128], ksh[128], fsh[128], vsh[128], part[8][128], red[2], lbs[128];
    if (tid < 128) { const float l0 = lb_logits[h * 128 + tid], l1 = lb_logits[512 + h * 128 + tid]; const float m = fmaxf(l0, l1); const float e0 = expf(l0 - m), e1 = expf(l1 - m); lbs[tid] = e0 / (e0 + e1); }
    float S[16];
#pragma unroll
    for (int i = 0; i < 16; ++i) S[i] = 0.f;
    __syncthreads();
    for (int t = 0; t < T; ++t) {
        const size_t row = (size_t)(b * T + t) * PS;
        if (tid < 128) {
            const float fl = bf2f(proj[row + C_HF + h * 128 + tid]); const float lb = lbs[tid];
            const float fg = lb + (1.0f - lb) * sigmoidf_(fl); fsh[tid] = fg; ksh[tid] = 1.0f - fg;
            qsh[tid] = siluf_(bf2f(proj[row + C_HQ + h * 128 + tid])) * 0.08838834764831845f;
        } else if (tid < 256) vsh[tid - 128] = bf2f(proj[row + C_HI + h * 128 + tid - 128]);
        __syncthreads();
        const float vv = vsh[v]; float p = 0.f;
#pragma unroll
        for (int i = 0; i < 16; ++i) { const int k = kg * 16 + i; S[i] = fsh[k] * S[i] + ksh[k] * vv; p += qsh[k] * S[i]; }
        part[kg][v] = p;
        __syncthreads();
        float o = 0.f;
        if (tid < 128) {
#pragma unroll
            for (int j = 0; j < 8; ++j) o += part[j][tid];
            const float ss = wave_sum(o * o); if ((tid & 63) == 0) red[tid >> 6] = ss;
        }
        __syncthreads();
        if (tid < 128) {
            const float tot = red[0] + red[1];
            const float y = o * rsqrtf(tot * (1.0f / 128.0f) + EPS) * out_gain[h * 128 + tid];
            const float gl = bf2f(proj[row + C_HG + h * 128 + tid]);
            mixed[(size_t)(b * T + t) * D + h * 128 + tid] = f2bf(y * siluf_(gl));
        }
    }
}

__global__ void __launch_bounds__(64) k_cmp_naive(const bf16* __restrict__ proj, const float* __restrict__ pe, const float* __restrict__ w1, const float* __restrict__ w2,
                                                  const float* __restrict__ k_gain, float* __restrict__ kc, float* __restrict__ vc) {
    int it = blockIdx.x; const int n = it % NCMP; it /= NCMP; const int g = it & 1; it >>= 1; const int b = it & 1; const int which = it >> 1;
    const int c = threadIdx.x;
    __shared__ float blk[2048]; __shared__ float hid[64];
    const int col0 = (which == 0 ? C_KC : C_VC) + g * 64;
    for (int i = c; i < 2048; i += 64) { const int j = i >> 6, d = i & 63; blk[i] = bf2f(proj[(size_t)(b * T + 16 * n + j) * PS + col0 + d]) + pe[which * 2048 + i]; }
    __syncthreads();
    float acc = 0.f;
    for (int i = 0; i < 2048; ++i) acc += blk[i] * w1[(size_t)which * 2048 * 64 + (size_t)i * 64 + c];
    hid[c] = gelu_tanh(acc);
    __syncthreads();
    float o = 0.f;
    for (int i = 0; i < 64; ++i) o += hid[i] * w2[which * 4096 + i * 64 + c];
    if (which == 0) { const float ss = wave_sum(o * o); o = o * rsqrtf(ss * (1.0f / 64.0f) + EPS) * k_gain[c]; }
    (which == 0 ? kc : vc)[((size_t)(b * 2 + g) * NCMP + n) * 64 + c] = o;
}

__global__ void __launch_bounds__(256) k_nsa_naive(const bf16* __restrict__ proj, const float* __restrict__ kc, const float* __restrict__ vc, const float* __restrict__ q_gain,
                                                   const float* __restrict__ k_gain, const float* __restrict__ out_gain, bf16* __restrict__ mixed) {
    const int g = blockIdx.x & 1, tok = blockIdx.x >> 1, b = tok / T, t = tok % T;
    const int tid = threadIdx.x, r = tid >> 6, lane = tid & 63, h = g * 4 + r;
    __shared__ float qs[4][64]; __shared__ float sc[4][1024]; __shared__ float P[520]; __shared__ float imp[128]; __shared__ int sel[128]; __shared__ int blist[16]; __shared__ int nbs;
    const float slope = exp2f(-(float)(h + 1));
    const float NEG = -__builtin_huge_valf();
    {
        float qv = bf2f(proj[(size_t)tok * PS + C_NQ + h * 64 + lane]);
        const float ss = wave_sum(qv * qv);
        qs[r][lane] = qv * rsqrtf(ss * (1.0f / 64.0f) + EPS) * q_gain[lane] * 0.125f;
    }
    __syncthreads();
    const int nvalid = (t >= 31) ? ((t - 31) / 16 + 1) : 0;
    const float* kcb = kc + (size_t)(b * 2 + g) * NCMP * 64; const float* vcb = vc + (size_t)(b * 2 + g) * NCMP * 64;
    float mx = NEG;
    for (int n = lane; n < 512; n += 64) {
        float s = NEG;
        if (n < nvalid) { float d = 0.f; for (int i = 0; i < 64; ++i) d += qs[r][i] * kcb[n * 64 + i]; s = d - slope * (float)(t - (16 * n + 31)); }
        sc[r][n] = s; mx = fmaxf(mx, s);
    }
    mx = wave_max(mx); if (mx == NEG) mx = 0.f;
    float sum = 0.f;
    for (int n = lane; n < 512; n += 64) { const float e = (n < nvalid) ? expf(sc[r][n] - mx) : 0.f; sc[r][n] = e; sum += e; }
    sum = wave_sum(sum); float inv = 1.0f / fmaxf(sum, 1e-30f);
    for (int n = lane; n < 512; n += 64) sc[r][n] *= inv;
    __syncthreads();
    float oc = 0.f;
    for (int n = 0; n < nvalid; ++n) oc += sc[r][n] * vcb[n * 64 + lane];
    for (int i = tid; i < 520; i += 256) P[i] = (i < 512) ? (sc[0][i] + sc[1][i] + sc[2][i] + sc[3][i]) : 0.f;
    __syncthreads();
    if (tid < 128) imp[tid] = P[4 * tid] + 2.f * P[4 * tid + 1] + 2.f * P[4 * tid + 2] + 2.f * P[4 * tid + 3] + P[4 * tid + 4];
    __syncthreads();
    const int cur = t >> 6;
    if (tid < 128) {
        const int j = tid; const bool forced = (j == 0) || (j == cur) || (j == cur - 1); const bool cand = !forced && j <= cur;
        const int nforced = (cur == 0) ? 1 : (cur == 1) ? 2 : 3; const int need = 16 - nforced;
        int rank = 0; const float mine = imp[j];
        for (int q = 1; q <= cur - 2; ++q) { if (q == j) continue; const float o = imp[q]; if (o > mine || (o == mine && q < j)) ++rank; }
        sel[j] = (forced || (cand && rank < need)) ? 1 : 0;
    }
    __syncthreads();
    if (tid == 0) { int nb = 0; for (int j = 0; j < 128; ++j) if (sel[j] && nb < 16) blist[nb++] = j; nbs = nb; }
    __syncthreads();
    const int nb = nbs;
    float os = 0.f;
    {
        float m2 = NEG;
        for (int s = 0; s < nb; ++s) {
            const int pos = blist[s] * 64 + lane; float val = NEG;
            if (pos <= t) {
                const bf16* kr = proj + (size_t)(b * T + pos) * PS + C_KS + g * 64; float d = 0.f, sq = 0.f;
                for (int i = 0; i < 64; ++i) { const float kv = bf2f(kr[i]); d += qs[r][i] * kv * k_gain[64 + i]; sq += kv * kv; }
                val = d * rsqrtf(sq * (1.0f / 64.0f) + EPS) - slope * (float)(t - pos);
            }
            sc[r][s * 64 + lane] = val; m2 = fmaxf(m2, val);
        }
        m2 = wave_max(m2); if (m2 == NEG) m2 = 0.f;
        float su = 0.f;
        for (int s = 0; s < nb; ++s) { const float v0 = sc[r][s * 64 + lane]; const float e = (v0 == NEG) ? 0.f : expf(v0 - m2); sc[r][s * 64 + lane] = e; su += e; }
        su = wave_sum(su); const float iv = 1.0f / fmaxf(su, 1e-30f);
        __syncthreads();
        for (int s = 0; s < nb; ++s) for (int i = 0; i < 64; ++i) {
            const float p = sc[r][s * 64 + i]; if (p != 0.f) os += p * bf2f(proj[(size_t)(b * T + blist[s] * 64 + i) * PS + C_VS + g * 64 + lane]); }
        os *= iv;
    }
    __syncthreads();
    float ow = 0.f;
    {
        float m2 = NEG;
        for (int i = lane; i < 512; i += 64) {
            const int pos = t - i; float val = NEG;
            if (pos >= 0) {
                const bf16* kr = proj + (size_t)(b * T + pos) * PS + C_KW + g * 64; float d = 0.f, sq = 0.f;
                for (int c = 0; c < 64; ++c) { const float kv = bf2f(kr[c]); d += qs[r][c] * kv * k_gain[128 + c]; sq += kv * kv; }
                val = d * rsqrtf(sq * (1.0f / 64.0f) + EPS) - slope * (float)i;
            }
            sc[r][i] = val; m2 = fmaxf(m2, val);
        }
        m2 = wave_max(m2);
        float su = 0.f;
        for (int i = lane; i < 512; i += 64) { const float v0 = sc[r][i]; const float e = (v0 == NEG) ? 0.f : expf(v0 - m2); sc[r][i] = e; su += e; }
        su = wave_sum(su); const float iv = 1.0f / fmaxf(su, 1e-30f);
        __syncthreads();
        for (int i = 0; i < 512; ++i) { const float p = sc[r][i]; if (p != 0.f) ow += p * bf2f(proj[(size_t)(b * T + t - i) * PS + C_VW + g * 64 + lane]); }
        ow *= iv;
    }
    const bf16* gl = proj + (size_t)tok * PS + C_GT + h * 3;
    const float o = sigmoidf_(bf2f(gl[0])) * oc + sigmoidf_(bf2f(gl[1])) * os + sigmoidf_(bf2f(gl[2])) * ow;
    const float ss = wave_sum(o * o);
    mixed[(size_t)tok * D + 512 + h * 64 + lane] = f2bf(o * rsqrtf(ss * (1.0f / 64.0f) + EPS) * out_gain[h * 64 + lane]);
}

__global__ void __launch_bounds__(128) k_peer_topk_naive(const bf16* __restrict__ pq, const float* __restrict__ keys, int* __restrict__ ids, float* __restrict__ wts) {
    const int tok = blockIdx.x >> 3, h = blockIdx.x & 7, k = threadIdx.x;
    __shared__ float q[256]; __shared__ float s[2][128]; __shared__ float ts[2][16]; __shared__ int ti[2][16]; __shared__ float cand[256]; __shared__ float bs[16]; __shared__ int bc[16];
    q[k] = bf2f(pq[(size_t)tok * 2048 + h * 256 + k]); q[k + 128] = bf2f(pq[(size_t)tok * 2048 + h * 256 + 128 + k]);
    __syncthreads();
#pragma unroll
    for (int c = 0; c < 2; ++c) { const float* kr = keys + ((size_t)(h * 2 + c) * 128 + k) * 128; float d = 0.f; for (int i = 0; i < 128; ++i) d += q[c * 128 + i] * kr[i]; s[c][k] = d; }
    __syncthreads();
#pragma unroll
    for (int c = 0; c < 2; ++c) { const float mine = s[c][k]; int rank = 0; for (int j = 0; j < 128; ++j) { const float o = s[c][j]; if (o > mine || (o == mine && j < k)) ++rank; } if (rank < 16) { ts[c][rank] = mine; ti[c][rank] = k; } }
    __syncthreads();
    cand[k] = ts[0][k >> 4] + ts[1][k & 15]; cand[k + 128] = ts[0][(k + 128) >> 4] + ts[1][(k + 128) & 15];
    __syncthreads();
#pragma unroll
    for (int e = 0; e < 2; ++e) { const int me = k + e * 128; const float mine = cand[me]; int rank = 0; for (int j = 0; j < 256; ++j) { const float o = cand[j]; if (o > mine || (o == mine && j < me)) ++rank; } if (rank < 16) { bs[rank] = mine; bc[rank] = me; } }
    __syncthreads();
    if (k < 16) {
        float mx = bs[0]; float sum = 0.f; for (int j = 0; j < 16; ++j) sum += expf(bs[j] - mx);
        const int c = bc[k]; ids[(size_t)tok * 128 + h * 16 + k] = ti[0][c >> 4] * 128 + ti[1][c & 15];
        wts[(size_t)tok * 128 + h * 16 + k] = expf(bs[k] - mx) / sum;
    }
}

__global__ void __launch_bounds__(256) k_peer_gather_naive(const bf16* __restrict__ hn, const int* __restrict__ ids, const float* __restrict__ wts, const float* __restrict__ U, const float* __restrict__ V,
                                                           const float* __restrict__ gnorm, float* __restrict__ hio, bf16* __restrict__ hg) {
    const int tok = blockIdx.x, tid = threadIdx.x, w = tid >> 6, lane = tid & 63;
    __shared__ float xs[1024]; __shared__ float coef[128]; __shared__ int eid[128]; __shared__ float red[4];
    for (int i = tid; i < 1024; i += 256) xs[i] = bf2f(hn[(size_t)tok * D + i]);
    if (tid < 128) eid[tid] = ids[(size_t)tok * 128 + tid];
    __syncthreads();
    for (int e = w * 32; e < w * 32 + 32; ++e) {
        const float* ur = U + (size_t)eid[e] * D; float d = 0.f;
        for (int i = lane; i < 1024; i += 64) d += ur[i] * xs[i];
        d = wave_sum(d);
        if (lane == 0) coef[e] = wts[(size_t)tok * 128 + e] * gelu_tanh(d);
    }
    __syncthreads();
    float o[4] = {0.f, 0.f, 0.f, 0.f};
    for (int e = 0; e < 128; ++e) { const float* vr = V + (size_t)eid[e] * D; const float c = coef[e];
#pragma unroll
        for (int j = 0; j < 4; ++j) o[j] += c * vr[tid + 256 * j]; }
    float ss = 0.f;
#pragma unroll
    for (int j = 0; j < 4; ++j) { o[j] += hio[(size_t)tok * D + tid + 256 * j]; hio[(size_t)tok * D + tid + 256 * j] = o[j]; ss += o[j] * o[j]; }
    ss = wave_sum(ss); if (lane == 0) red[w] = ss;
    __syncthreads();
    const float r = rsqrtf((red[0] + red[1] + red[2] + red[3]) * (1.0f / D) + EPS);
#pragma unroll
    for (int j = 0; j < 4; ++j) hg[(size_t)tok * D + tid + 256 * j] = f2bf(o[j] * r * gnorm[tid + 256 * j]);
}


typedef short bf16x8 __attribute__((ext_vector_type(8)));
typedef float f32x4 __attribute__((ext_vector_type(4)));
typedef float f32x16 __attribute__((ext_vector_type(16)));
typedef unsigned u32x4 __attribute__((ext_vector_type(4)));
typedef unsigned u32x2 __attribute__((ext_vector_type(2)));
constexpr int NTHR = 512;
constexpr int LDS_BYTES = 143360 + 16;
struct Params { const float* in[21]; float* out; unsigned char* ws; };

typedef __bf16 bf16x2c __attribute__((ext_vector_type(2)));
__device__ __forceinline__ unsigned pk2(float lo, float hi) { bf16x2c v = { (__bf16)lo, (__bf16)hi }; return __builtin_bit_cast(unsigned, v); }

__device__ __forceinline__ void transpose_tile(const float* __restrict__ W, int K, int N, bf16* __restrict__ Wt, int kt, int nt, float* tile) {
    const int tid = threadIdx.x, k0 = kt * 64, n0 = nt * 64;
#pragma unroll
    for (int i = 0; i < 8; ++i) { const int idx = tid + i * NTHR, kk = idx >> 6, nn = idx & 63; tile[kk * 65 + nn] = (n0 + nn < N) ? W[(size_t)(k0 + kk) * N + n0 + nn] : 0.f; }
    __syncthreads();
    { const int nn = tid >> 3, ch = tid & 7; const float* s = tile + (ch * 8) * 65 + nn;
      u32x4 o; o.x = pk2(s[0], s[65]); o.y = pk2(s[130], s[195]); o.z = pk2(s[260], s[325]); o.w = pk2(s[390], s[455]);
      *(u32x4*)(Wt + (size_t)(n0 + nn) * K + k0 + ch * 8) = o; }
    __syncthreads();
}
__device__ __forceinline__ void cvt_range(const float* __restrict__ src, bf16* __restrict__ dst, size_t n8, size_t gtid, size_t gthreads) {
    for (size_t i = gtid; i < n8; i += gthreads) {
        const f32x4 a = ((const f32x4*)src)[2 * i], b = ((const f32x4*)src)[2 * i + 1];
        u32x4 o; o.x = pk2(a.x, a.y); o.y = pk2(a.z, a.w); o.z = pk2(b.x, b.y); o.w = pk2(b.z, b.w);
        ((u32x4*)dst)[i] = o;
    }
}
__device__ __forceinline__ void rms_row_bf16(const float* __restrict__ xr, const float* __restrict__ g, bf16* __restrict__ orow, int lane) {
    f32x4 v[4]; float s = 0.f;
#pragma unroll
    for (int j = 0; j < 4; ++j) { v[j] = ((const f32x4*)xr)[lane + 64 * j]; s += v[j].x * v[j].x + v[j].y * v[j].y + v[j].z * v[j].z + v[j].w * v[j].w; }
    s = wave_sum(s);
    const float r = rsqrtf(s * (1.0f / D) + EPS);
#pragma unroll
    for (int j = 0; j < 4; ++j) { const f32x4 gg = ((const f32x4*)g)[lane + 64 * j]; u32x2 o; o.x = pk2(v[j].x * r * gg.x, v[j].y * r * gg.y); o.y = pk2(v[j].z * r * gg.z, v[j].w * r * gg.w); ((u32x2*)orow)[lane + 64 * j] = o; }
}

__device__ __forceinline__ void phase0(const Params& p, unsigned char* lds) {
    float* tile = (float*)lds;
    const int nblk = gridDim.x, blk = blockIdx.x;
    unsigned char* ws = p.ws;
    constexpr int I_WIN = 16 * 54, I_WOUT = 16 * 16, I_WQ = 16 * 32, I_WG = 16 * 16, I_WP = 4 * 16, I_W1 = 2 * 32;
    constexpr int NIT = I_WIN + I_WOUT + I_WQ + I_WG + I_WP + I_W1;
    for (int it = blk; it < NIT; it += nblk) {
        int r = it;
        if (r < I_WIN) { transpose_tile(p.in[3], 1024, DIN, (bf16*)(ws + WS_WINT), r / 54, r % 54, tile); continue; } r -= I_WIN;
        if (r < I_WOUT) { transpose_tile(p.in[12], 1024, 1024, (bf16*)(ws + WS_WOUTT), r / 16, r % 16, tile); continue; } r -= I_WOUT;
        if (r < I_WQ) { transpose_tile(p.in[14], 1024, 2048, (bf16*)(ws + WS_WQT), r / 32, r % 32, tile); continue; } r -= I_WQ;
        if (r < I_WG) { transpose_tile(p.in[20], 1024, 1024, (bf16*)(ws + WS_WGT), r / 16, r % 16, tile); continue; } r -= I_WG;
        if (r < I_WP) { transpose_tile(p.in[18], 256, 1024, (bf16*)(ws + WS_WPT), r / 16, r % 16, tile); continue; } r -= I_WP;
        { const int which = r / 32, kt = r % 32; transpose_tile(p.in[9] + (size_t)which * 2048 * 64, 2048, 64, (bf16*)(ws + WS_W1T) + (size_t)which * 64 * 2048, kt, 0, tile); }
    }
    const size_t gtid = (size_t)blk * NTHR + threadIdx.x, gthreads = (size_t)nblk * NTHR;
    cvt_range(p.in[15], (bf16*)(ws + WS_KEYB), (size_t)8 * 2 * 128 * 128 / 8, gtid, gthreads);
    cvt_range(p.in[1], (bf16*)(ws + WS_PB), (size_t)NTOK * 256 / 8, gtid, gthreads);
    const int gw = (int)(gtid >> 6), ngw = (int)(gthreads >> 6), lane = threadIdx.x & 63;
    for (int m = gw; m < NTOK; m += ngw) rms_row_bf16(p.in[0] + (size_t)m * D, p.in[2], (bf16*)(ws + WS_ACT) + (size_t)m * D, lane);
    for (int m = gw; m < 2 * 16384; m += ngw) {
        const int which = m >> 14, row = m & 16383;
        const float* src = p.in[16 + which] + (size_t)row * D + lane * 16;
        const f32x4 a = *(const f32x4*)src, b = *(const f32x4*)(src + 4), c = *(const f32x4*)(src + 8), d = *(const f32x4*)(src + 12);
        float mx = fmaxf(fmaxf(fmaxf(fabsf(a.x), fabsf(a.y)), fmaxf(fabsf(a.z), fabsf(a.w))), fmaxf(fmaxf(fabsf(b.x), fabsf(b.y)), fmaxf(fabsf(b.z), fabsf(b.w))));
        mx = fmaxf(mx, fmaxf(fmaxf(fmaxf(fabsf(c.x), fabsf(c.y)), fmaxf(fabsf(c.z), fabsf(c.w))), fmaxf(fmaxf(fabsf(d.x), fabsf(d.y)), fmaxf(fabsf(d.z), fabsf(d.w)))));
        mx = fmaxf(wave_max(mx), 1e-30f);
        const float sc = 224.0f / mx;
        u32x4 o; int w;
        w = __builtin_amdgcn_cvt_pk_fp8_f32(a.x * sc, a.y * sc, 0, false); w = __builtin_amdgcn_cvt_pk_fp8_f32(a.z * sc, a.w * sc, w, true); o.x = (unsigned)w;
        w = __builtin_amdgcn_cvt_pk_fp8_f32(b.x * sc, b.y * sc, 0, false); w = __builtin_amdgcn_cvt_pk_fp8_f32(b.z * sc, b.w * sc, w, true); o.y = (unsigned)w;
        w = __builtin_amdgcn_cvt_pk_fp8_f32(c.x * sc, c.y * sc, 0, false); w = __builtin_amdgcn_cvt_pk_fp8_f32(c.z * sc, c.w * sc, w, true); o.z = (unsigned)w;
        w = __builtin_amdgcn_cvt_pk_fp8_f32(d.x * sc, d.y * sc, 0, false); w = __builtin_amdgcn_cvt_pk_fp8_f32(d.z * sc, d.w * sc, w, true); o.w = (unsigned)w;
        *(u32x4*)(ws + (which ? WS_VB : WS_UB) + (size_t)row * D + lane * 16) = o;
        if (lane == 0) ((float*)(ws + (which ? WS_VS : WS_US)))[row] = mx * (1.0f / 224.0f);
    }
}

__device__ __forceinline__ int swz(int ob) { return ob ^ (((ob >> 9) & 1) << 5); }
constexpr int G_STAGE = 49152;
__device__ __forceinline__ void gemm_mainloop(f32x4 (&acc)[4][4], const bf16* __restrict__ A, int lda, const bf16* __restrict__ Bt, int ldb, int K, int m0, int n0, unsigned char* lds) {
    const int tid = threadIdx.x, lane = tid & 63, wid = tid >> 6, wm = wid >> 1, wn = wid & 1, fr = lane & 15, fq = lane >> 4;
    const int lrow = tid >> 3, lc = tid & 7;
    const bf16* ag = A + (size_t)(m0 + lrow) * lda + lc * 8;
    const bf16* bg = Bt + (size_t)(n0 + lrow) * ldb + lc * 8;
    const int woff = ((lrow >> 4) * 2 + (lc >> 2)) * 1024 + swz((lrow & 15) * 64 + (lc & 3) * 16);
    const int roff = swz(fr * 64 + fq * 16);
    const int nk = K >> 6;
    u32x4 ra[4], rb[2];
#pragma unroll
    for (int i = 0; i < 4; ++i) ra[i] = *(const u32x4*)(ag + (size_t)i * 64 * lda);
#pragma unroll
    for (int i = 0; i < 2; ++i) rb[i] = *(const u32x4*)(bg + (size_t)i * 64 * ldb);
#pragma unroll
    for (int i = 0; i < 4; ++i) *(u32x4*)(lds + woff + i * 8192) = ra[i];
#pragma unroll
    for (int i = 0; i < 2; ++i) *(u32x4*)(lds + 32768 + woff + i * 8192) = rb[i];
    __syncthreads();
    for (int kt = 0; kt < nk; ++kt) {
        unsigned char* cur = lds + (kt & 1) * G_STAGE; unsigned char* nxt = lds + ((kt + 1) & 1) * G_STAGE;
        const bool more = kt + 1 < nk;
        if (more) {
#pragma unroll
            for (int i = 0; i < 4; ++i) ra[i] = *(const u32x4*)(ag + (size_t)i * 64 * lda + (kt + 1) * 64);
#pragma unroll
            for (int i = 0; i < 2; ++i) rb[i] = *(const u32x4*)(bg + (size_t)i * 64 * ldb + (kt + 1) * 64);
        }
#pragma unroll
        for (int s = 0; s < 2; ++s) {
            bf16x8 af[4], bfr[4];
#pragma unroll
            for (int i = 0; i < 4; ++i) af[i] = *(const bf16x8*)(cur + ((wm * 4 + i) * 2 + s) * 1024 + roff);
#pragma unroll
            for (int i = 0; i < 4; ++i) bfr[i] = *(const bf16x8*)(cur + 32768 + ((wn * 4 + i) * 2 + s) * 1024 + roff);
#pragma unroll
            for (int mi = 0; mi < 4; ++mi)
#pragma unroll
                for (int ni = 0; ni < 4; ++ni) acc[mi][ni] = __builtin_amdgcn_mfma_f32_16x16x32_bf16(bfr[ni], af[mi], acc[mi][ni], 0, 0, 0);
        }
        if (more) {
#pragma unroll
            for (int i = 0; i < 4; ++i) *(u32x4*)(nxt + woff + i * 8192) = ra[i];
#pragma unroll
            for (int i = 0; i < 2; ++i) *(u32x4*)(nxt + 32768 + woff + i * 8192) = rb[i];
        }
        __syncthreads();
    }
}
__device__ __forceinline__ void acc_zero(f32x4 (&acc)[4][4]) {
#pragma unroll
    for (int i = 0; i < 4; ++i)
#pragma unroll
        for (int j = 0; j < 4; ++j) acc[i][j] = (f32x4){0.f, 0.f, 0.f, 0.f};
}
__device__ __forceinline__ void phase1(const Params& p, unsigned char* lds) {
    const bf16* A = (const bf16*)(p.ws + WS_ACT); const bf16* Bt = (const bf16*)(p.ws + WS_WINT); bf16* C = (bf16*)(p.ws + WS_PROJ);
    const int lane = threadIdx.x & 63, wid = threadIdx.x >> 6, wm = wid >> 1, wn = wid & 1, fr = lane & 15, fq = lane >> 4;
    constexpr int NT = 27, NTILES = 64 * NT;
    for (int t = blockIdx.x; t < NTILES; t += gridDim.x) {
        const int m0 = (t / NT) * 256, n0 = (t % NT) * 128;
        f32x4 acc[4][4]; acc_zero(acc);
        gemm_mainloop(acc, A, D, Bt, D, D, m0, n0, lds);
#pragma unroll
        for (int mi = 0; mi < 4; ++mi)
#pragma unroll
            for (int ni = 0; ni < 4; ++ni) {
                const int row = m0 + wm * 64 + mi * 16 + fr, col = n0 + wn * 64 + ni * 16 + fq * 4;
                if (col < DIN) { u32x2 o; o.x = pk2(acc[mi][ni][0], acc[mi][ni][1]); o.y = pk2(acc[mi][ni][2], acc[mi][ni][3]); *(u32x2*)(C + (size_t)row * PS + col) = o; }
            }
    }
}


__device__ __forceinline__ void phase5(const Params& p, unsigned char* lds) {
    const bf16* A = (const bf16*)(p.ws + WS_ACT); const bf16* Bt = (const bf16*)(p.ws + WS_WOUTT); const float* X = p.in[0]; float* O = p.out;
    const int lane = threadIdx.x & 63, wid = threadIdx.x >> 6, wm = wid >> 1, wn = wid & 1, fr = lane & 15, fq = lane >> 4;
    constexpr int NT = 8, NTILES = 64 * NT;
    for (int t = blockIdx.x; t < NTILES; t += gridDim.x) {
        const int m0 = (t / NT) * 256, n0 = (t % NT) * 128;
        f32x4 acc[4][4]; acc_zero(acc);
        gemm_mainloop(acc, A, D, Bt, D, D, m0, n0, lds);
#pragma unroll
        for (int mi = 0; mi < 4; ++mi)
#pragma unroll
            for (int ni = 0; ni < 4; ++ni) {
                const size_t idx = (size_t)(m0 + wm * 64 + mi * 16 + fr) * D + n0 + wn * 64 + ni * 16 + fq * 4;
                *(f32x4*)(O + idx) = *(const f32x4*)(X + idx) + acc[mi][ni];
            }
    }
}
__device__ __forceinline__ void phase6(const Params& p, unsigned char* lds) {
    const int gw = (blockIdx.x * NTHR + threadIdx.x) >> 6, ngw = (gridDim.x * NTHR) >> 6, lane = threadIdx.x & 63;
    for (int m = gw; m < NTOK; m += ngw) rms_row_bf16(p.out + (size_t)m * D, p.in[13], (bf16*)(p.ws + WS_ACT) + (size_t)m * D, lane);
}
__device__ __forceinline__ void phase7(const Params& p, unsigned char* lds) {
    const bf16* A = (const bf16*)(p.ws + WS_ACT); const bf16* Bt = (const bf16*)(p.ws + WS_WQT); bf16* C = (bf16*)(p.ws + WS_PROJ);
    const int lane = threadIdx.x & 63, wid = threadIdx.x >> 6, wm = wid >> 1, wn = wid & 1, fr = lane & 15, fq = lane >> 4;
    constexpr int NT = 16, NTILES = 64 * NT;
    for (int t = blockIdx.x; t < NTILES; t += gridDim.x) {
        const int m0 = (t / NT) * 256, n0 = (t % NT) * 128;
        f32x4 acc[4][4]; acc_zero(acc);
        gemm_mainloop(acc, A, D, Bt, D, D, m0, n0, lds);
#pragma unroll
        for (int mi = 0; mi < 4; ++mi)
#pragma unroll
            for (int ni = 0; ni < 4; ++ni) {
                const int row = m0 + wm * 64 + mi * 16 + fr, col = n0 + wn * 64 + ni * 16 + fq * 4;
                u32x2 o; o.x = pk2(acc[mi][ni][0], acc[mi][ni][1]); o.y = pk2(acc[mi][ni][2], acc[mi][ni][3]); *(u32x2*)(C + (size_t)row * 2048 + col) = o;
            }
    }
}
__device__ __forceinline__ void phase10(const Params& p, unsigned char* lds) {
    const bf16* A1 = (const bf16*)(p.ws + WS_PROJ + 64 * MiB); const bf16* B1 = (const bf16*)(p.ws + WS_WGT);
    const bf16* A2 = (const bf16*)(p.ws + WS_PB); const bf16* B2 = (const bf16*)(p.ws + WS_WPT); float* O = p.out;
    const int lane = threadIdx.x & 63, wid = threadIdx.x >> 6, wm = wid >> 1, wn = wid & 1, fr = lane & 15, fq = lane >> 4;
    constexpr int NT = 8, NTILES = 64 * NT;
    for (int t = blockIdx.x; t < NTILES; t += gridDim.x) {
        const int m0 = (t / NT) * 256, n0 = (t % NT) * 128;
        u32x2 gpk[4][4];
        {
            f32x4 accg[4][4]; acc_zero(accg);
            gemm_mainloop(accg, A1, D, B1, D, D, m0, n0, lds);
#pragma unroll
            for (int mi = 0; mi < 4; ++mi)
#pragma unroll
                for (int ni = 0; ni < 4; ++ni) { gpk[mi][ni].x = pk2(sigmoidf_(accg[mi][ni][0]), sigmoidf_(accg[mi][ni][1])); gpk[mi][ni].y = pk2(sigmoidf_(accg[mi][ni][2]), sigmoidf_(accg[mi][ni][3])); }
        }
        f32x4 accp[4][4]; acc_zero(accp);
        gemm_mainloop(accp, A2, 256, B2, 256, 256, m0, n0, lds);
#pragma unroll
        for (int mi = 0; mi < 4; ++mi)
#pragma unroll
            for (int ni = 0; ni < 4; ++ni) {
                const size_t idx = (size_t)(m0 + wm * 64 + mi * 16 + fr) * D + n0 + wn * 64 + ni * 16 + fq * 4;
                f32x4 g; g.x = __uint_as_float(gpk[mi][ni].x << 16); g.y = __uint_as_float(gpk[mi][ni].x & 0xffff0000u); g.z = __uint_as_float(gpk[mi][ni].y << 16); g.w = __uint_as_float(gpk[mi][ni].y & 0xffff0000u);
                *(f32x4*)(O + idx) = *(const f32x4*)(O + idx) + accp[mi][ni] * g;
            }
    }
}

typedef __bf16 bf16x2v __attribute__((ext_vector_type(2)));
template <int CTRL> __device__ __forceinline__ float dpp_f(float v) { return __int_as_float(__builtin_amdgcn_update_dpp(0, __float_as_int(v), CTRL, 0xF, 0xF, false)); }
__device__ __forceinline__ float grp16_max(float v) { v = fmaxf(v, dpp_f<0xB1>(v)); v = fmaxf(v, dpp_f<0x4E>(v)); v = fmaxf(v, dpp_f<0x141>(v)); v = fmaxf(v, dpp_f<0x140>(v)); return v; }
__device__ __forceinline__ float grp16_sum(float v) { v += dpp_f<0xB1>(v); v += dpp_f<0x4E>(v); v += dpp_f<0x141>(v); v += dpp_f<0x140>(v); return v; }
#define CE_DESC(a, b) { const float _hi = fmaxf(a, b), _lo = fminf(a, b); a = _hi; b = _lo; }
__device__ __forceinline__ float grp16_top16(float (&v)[8], int lig) {
    CE_DESC(v[0], v[1]) CE_DESC(v[2], v[3]) CE_DESC(v[4], v[5]) CE_DESC(v[6], v[7])
    CE_DESC(v[0], v[2]) CE_DESC(v[1], v[3]) CE_DESC(v[4], v[6]) CE_DESC(v[5], v[7])
    CE_DESC(v[1], v[2]) CE_DESC(v[5], v[6])
    CE_DESC(v[0], v[4]) CE_DESC(v[1], v[5]) CE_DESC(v[2], v[6]) CE_DESC(v[3], v[7])
    CE_DESC(v[2], v[4]) CE_DESC(v[3], v[5])
    CE_DESC(v[1], v[2]) CE_DESC(v[3], v[4]) CE_DESC(v[5], v[6])
    float top = 0.f;
#pragma unroll
    for (int r = 0; r < 16; ++r) {
        const float m = grp16_max(v[0]);
        if (lig == r) top = m;
        const bool own = (v[0] == m);
#pragma unroll
        for (int j = 0; j < 7; ++j) v[j] = own ? v[j + 1] : v[j];
        v[7] = own ? -3.0e38f : v[7];
    }
    return top;
}
__device__ __forceinline__ void phase8(const Params& p, unsigned char* lds) {
    const bf16* PQ = (const bf16*)(p.ws + WS_PROJ); const bf16* KB = (const bf16*)(p.ws + WS_KEYB);
    int* ids = (int*)(p.ws + WS_IDS); float* wts = (float*)(p.ws + WS_WTS);
    float* S = (float*)lds;
    const int tid = threadIdx.x, lane = tid & 63, wid = tid >> 6, lig = tid & 15, gbase = lane & 48;
    for (int item = blockIdx.x; item < 2048; item += gridDim.x) {
        const int tok0 = (item >> 3) * 64, h = item & 7;
        {
            const int c = wid >> 2, key0 = (wid & 3) * 32, r = lane & 31, hh = lane >> 5;
            f32x16 acc0, acc1;
#pragma unroll
            for (int i = 0; i < 16; ++i) { acc0[i] = 0.f; acc1[i] = 0.f; }
            const bf16* bq = KB + ((size_t)(h * 2 + c) * 128 + key0 + r) * 128 + hh * 8;
            const bf16* aq0 = PQ + (size_t)(tok0 + r) * 2048 + h * 256 + c * 128 + hh * 8;
            const bf16* aq1 = aq0 + (size_t)32 * 2048;
#pragma unroll
            for (int s = 0; s < 8; ++s) {
                const bf16x8 b = *(const bf16x8*)(bq + s * 16), a0 = *(const bf16x8*)(aq0 + s * 16), a1 = *(const bf16x8*)(aq1 + s * 16);
                acc0 = __builtin_amdgcn_mfma_f32_32x32x16_bf16(a0, b, acc0, 0, 0, 0);
                acc1 = __builtin_amdgcn_mfma_f32_32x32x16_bf16(a1, b, acc1, 0, 0, 0);
            }
#pragma unroll
            for (int i = 0; i < 16; ++i) { const int tl = (i & 3) + 8 * (i >> 2) + 4 * hh; S[(c * 64 + tl) * 132 + key0 + r] = acc0[i]; S[(c * 64 + 32 + tl) * 132 + key0 + r] = acc1[i]; }
        }
        __syncthreads();
#pragma unroll 1
        for (int rd = 0; rd < 2; ++rd) {
            const int tl = (tid >> 4) + 32 * rd;
            float ts[2];
#pragma unroll
            for (int c = 0; c < 2; ++c) {
                float v[8];
                const f32x4 lo = *(const f32x4*)(S + (c * 64 + tl) * 132 + lig * 8), hi = *(const f32x4*)(S + (c * 64 + tl) * 132 + lig * 8 + 4);
                v[0] = lo.x; v[1] = lo.y; v[2] = lo.z; v[3] = lo.w; v[4] = hi.x; v[5] = hi.y; v[6] = hi.z; v[7] = hi.w;
#pragma unroll
                for (int j = 0; j < 8; ++j) v[j] = __uint_as_float((__float_as_uint(v[j]) & ~127u) | (unsigned)(lig * 8 + j));
                ts[c] = grp16_top16(v, lig);
            }
            const float t0 = ts[0], t1 = ts[1];
            int bp = 0; float my_s = 0.f; int my_eid = 0;
#pragma unroll 1
            for (int r = 0; r < 16; ++r) {
                const float other = __shfl(t1, gbase + (bp < 15 ? bp : 15));
                const float sum = t0 + other;
                const float head = (bp >= 16) ? -3.0e38f : __uint_as_float((__float_as_uint(sum) & ~15u) | (unsigned)lig);
                const int cur_eid = (int)(((__float_as_uint(t0) & 127u) << 7) | (__float_as_uint(other) & 127u));
                const float m = grp16_max(head);
                const int owner = (int)(__float_as_uint(m) & 15u);
                const int ew = __shfl(cur_eid, gbase + owner);
                if (lig == r) { my_s = m; my_eid = ew; }
                if (lig == owner) ++bp;
            }
            const float mx = grp16_max(my_s);
            const float e = __expf(my_s - mx);
            const float sm = grp16_sum(e);
            const size_t o = (size_t)(tok0 + tl) * 128 + h * 16 + lig;
            ids[o] = my_eid; wts[o] = e / sm;
        }
        __syncthreads();
    }
}

__device__ __forceinline__ void hgrn_pre_item(const Params& p, unsigned char* lds, int ci) {
    const int tid = threadIdx.x, lane = tid & 63, wid = tid >> 6, k = tid & 127, tq = tid >> 7;
    const int n = ci & 127, h = (ci >> 7) & 3, b = ci >> 9, tok0 = b * T + n * 64;
    bf16* proj = (bf16*)(p.ws + WS_PROJ);
    float* OB = p.out; bf16* KIT = (bf16*)((unsigned char*)p.out + OUT_KIT) + (size_t)ci * 8192; bf16* VTg = (bf16*)((unsigned char*)p.out + OUT_VT) + (size_t)ci * 8192;
    float* DEC = (float*)(p.ws + WS_DEC) + (size_t)ci * 128;
    bf16* QT = (bf16*)lds; bf16* KT = (bf16*)(lds + 17408); bf16* VTl = (bf16*)(lds + 34816); bf16* AM = (bf16*)(lds + 53248);
    float* part = (float*)(lds + 62464); float* gref = (float*)(lds + 64512);
    float lb; { const float l0 = p.in[4][h * 128 + k], l1 = p.in[4][512 + h * 128 + k]; const float m = fmaxf(l0, l1); const float e0 = __expf(l0 - m), e1 = __expf(l1 - m); lb = e0 / (e0 + e1); }
    float G[16], key[16], qv[16], vv[16];
    {
        float c = 0.f;
#pragma unroll
        for (int i = 0; i < 16; ++i) {
            const size_t row = (size_t)(tok0 + tq * 16 + i) * PS;
            const float fg = lb + (1.0f - lb) * sigmoidf_(bf2f(proj[row + C_HF + h * 128 + k]));
            key[i] = 1.0f - fg; c += __logf(fg); G[i] = c;
            qv[i] = siluf_(bf2f(proj[row + C_HQ + h * 128 + k])) * 0.08838834764831845f;
            vv[i] = bf2f(proj[row + C_HI + h * 128 + k]);
        }
        part[tq * 128 + k] = c;
    }
    __syncthreads();
    {
        float off = 0.f;
#pragma unroll
        for (int j = 0; j < 3; ++j) off += (j < tq) ? part[j * 128 + k] : 0.f;
#pragma unroll
        for (int i = 0; i < 16; ++i) G[i] += off;
        if (tq == 1) gref[k] = G[15];
        if (tq == 3) gref[128 + k] = G[15];
    }
    __syncthreads();
    {
        const float gr = gref[k], gl = gref[128 + k];
        const int kpos = (k & ~31) | (((k >> 2) & 3) << 3) | (((k >> 4) & 1) << 2) | (k & 3);
        unsigned kp[8], vp[8];
#pragma unroll
        for (int i = 0; i < 16; i += 2) {
            kp[i >> 1] = pk2(key[i] * __expf(gl - G[i]), key[i + 1] * __expf(gl - G[i + 1]));
            vp[i >> 1] = pk2(vv[i], vv[i + 1]);
        }
#pragma unroll
        for (int i = 0; i < 16; ++i) {
            const int t = tq * 16 + i;
            QT[t * 136 + k] = f2bf(qv[i] * __expf(G[i] - gr));
            KT[t * 136 + k] = f2bf(key[i] * __expf(gr - G[i]));
            proj[(size_t)(tok0 + t) * PS + C_HQ + h * 128 + kpos] = f2bf(qv[i] * __expf(G[i]));
        }
        u32x4 a0, a1, b0, b1; a0.x = kp[0]; a0.y = kp[1]; a0.z = kp[2]; a0.w = kp[3]; a1.x = kp[4]; a1.y = kp[5]; a1.z = kp[6]; a1.w = kp[7];
        b0.x = vp[0]; b0.y = vp[1]; b0.z = vp[2]; b0.w = vp[3]; b1.x = vp[4]; b1.y = vp[5]; b1.z = vp[6]; b1.w = vp[7];
        *(u32x4*)(KIT + k * 64 + tq * 16) = a0; *(u32x4*)(KIT + k * 64 + tq * 16 + 8) = a1;
        *(u32x4*)(VTg + k * 64 + tq * 16) = b0; *(u32x4*)(VTg + k * 64 + tq * 16 + 8) = b1;
        *(u32x4*)(VTl + k * 72 + tq * 16) = b0; *(u32x4*)(VTl + k * 72 + tq * 16 + 8) = b1;
        if (tq == 3) DEC[k] = __expf(gl);
    }
    __syncthreads();
    const int fr = lane & 15, fq = lane >> 4;
    {
        const int tt = wid >> 1;
#pragma unroll
        for (int e = 0; e < 2; ++e) {
            const int st = 2 * (wid & 1) + e;
            f32x4 acc = (f32x4){0.f, 0.f, 0.f, 0.f};
            if (st <= tt) {
#pragma unroll
                for (int s = 0; s < 4; ++s) {
                    const bf16x8 a = *(const bf16x8*)(QT + (tt * 16 + fr) * 136 + s * 32 + fq * 8), bb = *(const bf16x8*)(KT + (st * 16 + fr) * 136 + s * 32 + fq * 8);
                    acc = __builtin_amdgcn_mfma_f32_16x16x32_bf16(a, bb, acc, 0, 0, 0);
                }
            }
#pragma unroll
            for (int r = 0; r < 4; ++r) { const int t = tt * 16 + fq * 4 + r, sp = st * 16 + fr; AM[t * 72 + sp] = f2bf(sp <= t ? acc[r] : 0.f); }
        }
    }
    __syncthreads();
    {
        const int tt = wid >> 1;
        const bf16x8 a0 = *(const bf16x8*)(AM + (tt * 16 + fr) * 72 + fq * 8), a1 = *(const bf16x8*)(AM + (tt * 16 + fr) * 72 + 32 + fq * 8);
#pragma unroll
        for (int e = 0; e < 4; ++e) {
            const int vt = (wid & 1) * 4 + e;
            const bf16x8 b0 = *(const bf16x8*)(VTl + (vt * 16 + fr) * 72 + fq * 8), b1 = *(const bf16x8*)(VTl + (vt * 16 + fr) * 72 + 32 + fq * 8);
            f32x4 acc = (f32x4){0.f, 0.f, 0.f, 0.f};
            acc = __builtin_amdgcn_mfma_f32_16x16x32_bf16(a0, b0, acc, 0, 0, 0);
            acc = __builtin_amdgcn_mfma_f32_16x16x32_bf16(a1, b1, acc, 0, 0, 0);
#pragma unroll
            for (int r = 0; r < 4; ++r) OB[(size_t)(tok0 + tt * 16 + fq * 4 + r) * 512 + h * 128 + vt * 16 + fr] = acc[r];
        }
    }
    __syncthreads();
}
template <bool DUMMY>
__device__ __forceinline__ void hgrn_scan_item(const Params& p, int wi) {
    const int lane = threadIdx.x & 63, fr = lane & 15, fq = lane >> 4;
    const int vs = wi & 7, bh = wi >> 3, h = bh & 3, b = bh >> 2;
    const bf16* proj = (const bf16*)(p.ws + WS_PROJ);
    float* OB = p.out; const bf16* KIT = (const bf16*)((unsigned char*)p.out + OUT_KIT); const bf16* VTg = (const bf16*)((unsigned char*)p.out + OUT_VT);
    const float* DEC = (const float*)(p.ws + WS_DEC);
    f32x4 S[8];
#pragma unroll
    for (int i = 0; i < 8; ++i) S[i] = (f32x4){0.f, 0.f, 0.f, 0.f};
#pragma unroll 1
    for (int n = 0; n < 128; ++n) {
        const int ci = bh * 128 + n, tok0 = b * T + n * 64;
        bf16x8 qf[4][4];
#pragma unroll
        for (int tt = 0; tt < 4; ++tt)
#pragma unroll
            for (int s = 0; s < 4; ++s) qf[tt][s] = *(const bf16x8*)(proj + (size_t)(tok0 + tt * 16 + fr) * PS + C_HQ + h * 128 + s * 32 + fq * 8);
        float oin[4][4];
#pragma unroll
        for (int tt = 0; tt < 4; ++tt)
#pragma unroll
            for (int r = 0; r < 4; ++r) oin[tt][r] = OB[(size_t)(tok0 + tt * 16 + fq * 4 + r) * 512 + h * 128 + vs * 16 + fr];
        bf16x8 Sb[4];
#pragma unroll
        for (int s = 0; s < 4; ++s) {
            u32x4 w; w.x = pk2(S[2 * s][0], S[2 * s][1]); w.y = pk2(S[2 * s][2], S[2 * s][3]); w.z = pk2(S[2 * s + 1][0], S[2 * s + 1][1]); w.w = pk2(S[2 * s + 1][2], S[2 * s + 1][3]);
            Sb[s] = __builtin_bit_cast(bf16x8, w);
        }
#pragma unroll
        for (int tt = 0; tt < 4; ++tt) {
            f32x4 acc = (f32x4){0.f, 0.f, 0.f, 0.f};
#pragma unroll
            for (int s = 0; s < 4; ++s) acc = __builtin_amdgcn_mfma_f32_16x16x32_bf16(qf[tt][s], Sb[s], acc, 0, 0, 0);
#pragma unroll
            for (int r = 0; r < 4; ++r) { const size_t oi = (size_t)(tok0 + tt * 16 + fq * 4 + r) * 512 + h * 128 + vs * 16 + fr; if (DUMMY) ((float*)(p.ws + WS_SPARE))[oi & 0x3fffff] = oin[tt][r] + acc[r]; else OB[oi] = oin[tt][r] + acc[r]; }
        }
        const bf16x8 v0 = *(const bf16x8*)(VTg + (size_t)ci * 8192 + (vs * 16 + fr) * 64 + fq * 8), v1 = *(const bf16x8*)(VTg + (size_t)ci * 8192 + (vs * 16 + fr) * 64 + 32 + fq * 8);
#pragma unroll
        for (int kb = 0; kb < 8; ++kb) {
            const bf16x8 k0 = *(const bf16x8*)(KIT + (size_t)ci * 8192 + (kb * 16 + fr) * 64 + fq * 8), k1 = *(const bf16x8*)(KIT + (size_t)ci * 8192 + (kb * 16 + fr) * 64 + 32 + fq * 8);
            const f32x4 dv = *(const f32x4*)(DEC + (size_t)ci * 128 + kb * 16 + fq * 4);
            f32x4 sacc = S[kb] * dv;
            sacc = __builtin_amdgcn_mfma_f32_16x16x32_bf16(k0, v0, sacc, 0, 0, 0);
            sacc = __builtin_amdgcn_mfma_f32_16x16x32_bf16(k1, v1, sacc, 0, 0, 0);
            S[kb] = sacc;
        }
    }
}

__device__ __forceinline__ void hgrn_scan_block(const Params& p, unsigned char* lds, int bh) {
    const int tid = threadIdx.x, lane = tid & 63, vs = tid >> 6, fr = lane & 15, fq = lane >> 4;
    const int h = bh & 3, b = bh >> 2;
    const bf16* proj = (const bf16*)(p.ws + WS_PROJ);
    float* OB = p.out; const bf16* KIT = (const bf16*)((unsigned char*)p.out + OUT_KIT); const bf16* VTg = (const bf16*)((unsigned char*)p.out + OUT_VT);
    const float* DEC = (const float*)(p.ws + WS_DEC);
    constexpr int BUF = 54784, O_KIT = 17408, O_VT = 17408 + 18432, O_DEC = 17408 + 2 * 18432;
    u32x4 rq[2], rk[2], rv[2], rd;
    float oin[4][4];
    auto issue = [&](int n) {
        const int ci = bh * 128 + n, tok0 = b * T + n * 64;
#pragma unroll
        for (int i = 0; i < 2; ++i) {
            const int id = tid + i * NTHR;
            rq[i] = *(const u32x4*)(proj + (size_t)(tok0 + (id >> 4)) * PS + C_HQ + h * 128 + (id & 15) * 8);
            rk[i] = *(const u32x4*)(KIT + (size_t)ci * 8192 + id * 8);
            rv[i] = *(const u32x4*)(VTg + (size_t)ci * 8192 + id * 8);
        }
        if (tid < 32) rd = *(const u32x4*)(DEC + (size_t)ci * 128 + tid * 4);
    };
    auto stash = [&](unsigned char* buf) {
#pragma unroll
        for (int i = 0; i < 2; ++i) {
            const int id = tid + i * NTHR;
            *(u32x4*)(buf + (id >> 4) * 272 + (id & 15) * 16) = rq[i];
            *(u32x4*)(buf + O_KIT + (id >> 3) * 144 + (id & 7) * 16) = rk[i];
            *(u32x4*)(buf + O_VT + (id >> 3) * 144 + (id & 7) * 16) = rv[i];
        }
        if (tid < 32) *(u32x4*)(buf + O_DEC + tid * 16) = rd;
    };
    auto load_oin = [&](int n) {
        const int tok0 = b * T + n * 64;
#pragma unroll
        for (int tt = 0; tt < 4; ++tt)
#pragma unroll
            for (int r = 0; r < 4; ++r) oin[tt][r] = OB[(size_t)(tok0 + tt * 16 + fq * 4 + r) * 512 + h * 128 + vs * 16 + fr];
    };
    f32x4 S[8];
#pragma unroll
    for (int i = 0; i < 8; ++i) S[i] = (f32x4){0.f, 0.f, 0.f, 0.f};
    issue(0); stash(lds); load_oin(0);
    __syncthreads();
#pragma unroll 1
    for (int n = 0; n < 128; ++n) {
        unsigned char* cur = lds + (n & 1) * BUF; unsigned char* nxt = lds + ((n + 1) & 1) * BUF;
        const int tok0 = b * T + n * 64;
        const int nn = (n + 1 < 128) ? n + 1 : n;
        issue(nn);
        bf16x8 Sb[4];
#pragma unroll
        for (int s = 0; s < 4; ++s) {
            u32x4 w; w.x = pk2(S[2 * s][0], S[2 * s][1]); w.y = pk2(S[2 * s][2], S[2 * s][3]); w.z = pk2(S[2 * s + 1][0], S[2 * s + 1][1]); w.w = pk2(S[2 * s + 1][2], S[2 * s + 1][3]);
            Sb[s] = __builtin_bit_cast(bf16x8, w);
        }
        float ores[4][4];
#pragma unroll
        for (int tt = 0; tt < 4; ++tt) {
            f32x4 acc = (f32x4){0.f, 0.f, 0.f, 0.f};
#pragma unroll
            for (int s = 0; s < 4; ++s) { const bf16x8 qf = *(const bf16x8*)(cur + (tt * 16 + fr) * 272 + (s * 32 + fq * 8) * 2); acc = __builtin_amdgcn_mfma_f32_16x16x32_bf16(qf, Sb[s], acc, 0, 0, 0); }
#pragma unroll
            for (int r = 0; r < 4; ++r) ores[tt][r] = oin[tt][r] + acc[r];
        }
#pragma unroll
        for (int tt = 0; tt < 4; ++tt)
#pragma unroll
            for (int r = 0; r < 4; ++r) OB[(size_t)(tok0 + tt * 16 + fq * 4 + r) * 512 + h * 128 + vs * 16 + fr] = ores[tt][r];
        load_oin(nn);
        const bf16x8 v0 = *(const bf16x8*)(cur + O_VT + (vs * 16 + fr) * 144 + fq * 16), v1 = *(const bf16x8*)(cur + O_VT + (vs * 16 + fr) * 144 + 64 + fq * 16);
#pragma unroll
        for (int kb = 0; kb < 8; ++kb) {
            const bf16x8 k0 = *(const bf16x8*)(cur + O_KIT + (kb * 16 + fr) * 144 + fq * 16), k1 = *(const bf16x8*)(cur + O_KIT + (kb * 16 + fr) * 144 + 64 + fq * 16);
            const f32x4 dv = *(const f32x4*)(cur + O_DEC + (kb * 16 + fq * 4) * 4);
            f32x4 sacc = S[kb] * dv;
            sacc = __builtin_amdgcn_mfma_f32_16x16x32_bf16(k0, v0, sacc, 0, 0, 0);
            sacc = __builtin_amdgcn_mfma_f32_16x16x32_bf16(k1, v1, sacc, 0, 0, 0);
            S[kb] = sacc;
        }
        stash(nxt);
        __syncthreads();
    }
}
__device__ __forceinline__ void phase4(const Params& p, unsigned char* lds) {
    const bf16* proj = (const bf16*)(p.ws + WS_PROJ); const float* OB = p.out; bf16* mixed = (bf16*)(p.ws + WS_ACT); const float* gain = p.in[5];
    const int lane = threadIdx.x & 63, gw = (blockIdx.x * NTHR + threadIdx.x) >> 6, ngw = (gridDim.x * NTHR) >> 6;
    for (int tok = gw; tok < NTOK; tok += ngw) {
        const f32x4 o0 = *(const f32x4*)(OB + (size_t)tok * 512 + lane * 8), o1 = *(const f32x4*)(OB + (size_t)tok * 512 + lane * 8 + 4);
        const u32x4 gp = *(const u32x4*)(proj + (size_t)tok * PS + C_HG + lane * 8);
        const f32x4 g0 = *(const f32x4*)(gain + lane * 8), g1 = *(const f32x4*)(gain + lane * 8 + 4);
        float ss = o0.x * o0.x + o0.y * o0.y + o0.z * o0.z + o0.w * o0.w + o1.x * o1.x + o1.y * o1.y + o1.z * o1.z + o1.w * o1.w;
        ss = grp16_sum(ss);
        const float r = rsqrtf(ss * (1.0f / 128.0f) + EPS);
        const unsigned gx = gp.x, gy = gp.y, gz = gp.z, gw_ = gp.w;
        u32x4 w;
        w.x = pk2(o0.x * r * g0.x * siluf_(__uint_as_float(gx << 16)), o0.y * r * g0.y * siluf_(__uint_as_float(gx & 0xffff0000u)));
        w.y = pk2(o0.z * r * g0.z * siluf_(__uint_as_float(gy << 16)), o0.w * r * g0.w * siluf_(__uint_as_float(gy & 0xffff0000u)));
        w.z = pk2(o1.x * r * g1.x * siluf_(__uint_as_float(gz << 16)), o1.y * r * g1.y * siluf_(__uint_as_float(gz & 0xffff0000u)));
        w.w = pk2(o1.z * r * g1.z * siluf_(__uint_as_float(gw_ << 16)), o1.w * r * g1.w * siluf_(__uint_as_float(gw_ & 0xffff0000u)));
        *(u32x4*)(mixed + (size_t)tok * D + lane * 8) = w;
    }
}

#define WAVE_LDS_SYNC() asm volatile("s_waitcnt lgkmcnt(0)" ::: "memory")
__device__ __forceinline__ void nsa_prep_item(const Params& p, unsigned char* lds, int tile) {
    const int tid = threadIdx.x, lig = tid & 15;
    const int tok0 = tile * 64;
    bf16* proj = (bf16*)(p.ws + WS_PROJ);
    for (int rho = tid >> 4; rho < 768; rho += 32) {
        const int tl = rho / 12, which = rho - tl * 12;
        int col; const float* gain; float sc = 1.0f;
        if (which < 8) { col = C_NQ + which * 64; gain = p.in[6]; sc = 0.125f * 1.4426950408889634f; }
        else if (which < 10) { col = C_KS + (which - 8) * 64; gain = p.in[7] + 64; }
        else { col = C_KW + (which - 10) * 64; gain = p.in[7] + 128; }
        bf16* rp = proj + (size_t)(tok0 + tl) * PS + col + lig * 4;
        const u32x2 raw = *(const u32x2*)rp;
        const unsigned r0 = raw.x, r1 = raw.y;
        const float a = __uint_as_float(r0 << 16), b = __uint_as_float(r0 & 0xffff0000u), c = __uint_as_float(r1 << 16), d = __uint_as_float(r1 & 0xffff0000u);
        const float ss = grp16_sum(a * a + b * b + c * c + d * d);
        const float r = rsqrtf(ss * (1.0f / 64.0f) + EPS) * sc;
        const f32x4 gg = *(const f32x4*)(gain + lig * 4);
        u32x2 o; o.x = pk2(a * r * gg.x, b * r * gg.y); o.y = pk2(c * r * gg.z, d * r * gg.w);
        *(u32x2*)rp = o;
    }
    {
        const int c = tid & 127, tq = tid >> 7, g = c >> 6, d = c & 63, b = tok0 / T, t0 = tok0 % T;
#pragma unroll
        for (int which = 0; which < 2; ++which) {
            const int col = (which == 0 ? C_VS : C_VW) + c;
            unsigned w[8];
#pragma unroll
            for (int i = 0; i < 16; i += 2) w[i >> 1] = (unsigned)proj[(size_t)(tok0 + tq * 16 + i) * PS + col] | ((unsigned)proj[(size_t)(tok0 + tq * 16 + i + 1) * PS + col] << 16);
            bf16* dst = (bf16*)(p.ws + (which == 0 ? WS_VTS : WS_VTW)) + ((size_t)(b * 2 + g) * 64 + d) * T + t0 + tq * 16;
            u32x4 a0, a1; a0.x = w[0]; a0.y = w[1]; a0.z = w[2]; a0.w = w[3]; a1.x = w[4]; a1.y = w[5]; a1.z = w[6]; a1.w = w[7];
            *(u32x4*)dst = a0; *(u32x4*)(dst + 8) = a1;
        }
    }
}
__device__ __forceinline__ void nsa_cmp_item(const Params& p, unsigned char* lds, int item) {
    const int tid = threadIdx.x, lane = tid & 63, wid = tid >> 6, fr = lane & 15, fq = lane >> 4;
    const int nt32 = item & 15, g = (item >> 4) & 1, b = (item >> 5) & 1, which = item >> 6, n0 = nt32 * 32;
    const bf16* proj = (const bf16*)(p.ws + WS_PROJ);
    const float* pe = p.in[8] + which * 2048;
    const bf16* W1T = (const bf16*)(p.ws + WS_W1T) + (size_t)which * 64 * 2048;
    const float* w2 = p.in[10] + which * 4096;
    bf16* A = (bf16*)lds; float* H = (float*)(lds + 33280);
    const int col0 = (which == 0 ? C_KC : C_VC) + g * 64;
    const int nt = wid & 1, ct = wid >> 1;
    f32x4 acc = (f32x4){0.f, 0.f, 0.f, 0.f};
#pragma unroll 1
    for (int kc = 0; kc < 4; ++kc) {
#pragma unroll
        for (int i = 0; i < 4; ++i) {
            const int idx = tid + i * NTHR, dch = idx & 7, jj = (idx >> 3) & 7, n = idx >> 6, j = kc * 8 + jj;
            u32x4 o = (u32x4){0u, 0u, 0u, 0u};
            if (n0 + n < NCMP) {
                const u32x4 raw = *(const u32x4*)(proj + (size_t)(b * T + 16 * (n0 + n) + j) * PS + col0 + dch * 8);
                const f32x4 p0 = *(const f32x4*)(pe + j * 64 + dch * 8), p1 = *(const f32x4*)(pe + j * 64 + dch * 8 + 4);
                const unsigned r0 = raw.x, r1 = raw.y, r2 = raw.z, r3 = raw.w;
                o.x = pk2(__uint_as_float(r0 << 16) + p0.x, __uint_as_float(r0 & 0xffff0000u) + p0.y);
                o.y = pk2(__uint_as_float(r1 << 16) + p0.z, __uint_as_float(r1 & 0xffff0000u) + p0.w);
                o.z = pk2(__uint_as_float(r2 << 16) + p1.x, __uint_as_float(r2 & 0xffff0000u) + p1.y);
                o.w = pk2(__uint_as_float(r3 << 16) + p1.z, __uint_as_float(r3 & 0xffff0000u) + p1.w);
            }
            *(u32x4*)(A + n * 520 + jj * 64 + dch * 8) = o;
        }
        __syncthreads();
#pragma unroll 4
        for (int s = 0; s < 16; ++s) {
            const bf16x8 a = *(const bf16x8*)(A + (nt * 16 + fr) * 520 + s * 32 + fq * 8);
            const bf16x8 bb = *(const bf16x8*)(W1T + (size_t)(ct * 16 + fr) * 2048 + kc * 512 + s * 32 + fq * 8);
            acc = __builtin_amdgcn_mfma_f32_16x16x32_bf16(a, bb, acc, 0, 0, 0);
        }
        __syncthreads();
    }
#pragma unroll
    for (int r = 0; r < 4; ++r) H[(nt * 16 + fq * 4 + r) * 64 + ct * 16 + fr] = gelu_tanh(acc[r]);
    __syncthreads();
    {
        const int n = tid >> 4, c = (tid & 15) * 4;
        f32x4 o = (f32x4){0.f, 0.f, 0.f, 0.f};
#pragma unroll 8
        for (int i = 0; i < 64; ++i) { const float hv = H[n * 64 + i]; const f32x4 w = *(const f32x4*)(w2 + i * 64 + c); o += hv * w; }
        if (which == 0) {
            const float ss = grp16_sum(o.x * o.x + o.y * o.y + o.z * o.z + o.w * o.w);
            const float r = rsqrtf(ss * (1.0f / 64.0f) + EPS);
            const f32x4 gg = *(const f32x4*)(p.in[7] + c);
            o = o * r * gg;
        }
        if (n0 + n >= NCMP) o = (f32x4){0.f, 0.f, 0.f, 0.f};
        if (which == 0) { u32x2 w; w.x = pk2(o.x, o.y); w.y = pk2(o.z, o.w); *(u32x2*)((bf16*)(p.ws + WS_KC) + ((size_t)(b * 2 + g) * 512 + n0 + n) * 64 + c) = w; }
        else { bf16* vt = (bf16*)(p.ws + WS_VCT) + (size_t)(b * 2 + g) * 64 * 512 + n0 + n; vt[(c + 0) * 512] = f2bf(o.x); vt[(c + 1) * 512] = f2bf(o.y); vt[(c + 2) * 512] = f2bf(o.z); vt[(c + 3) * 512] = f2bf(o.w); }
    }
    __syncthreads();
}

constexpr float LOG2E = 1.4426950408889634f;
__device__ __forceinline__ int rho16(int reg, int hh) { return (reg & 3) + 8 * (reg >> 2) + 4 * hh; }
__device__ __forceinline__ bf16x8 pack8(const float* pv) {
    u32x4 w; w.x = pk2(pv[0], pv[1]); w.y = pk2(pv[2], pv[3]); w.z = pk2(pv[4], pv[5]); w.w = pk2(pv[6], pv[7]);
    return __builtin_bit_cast(bf16x8, w);
}
struct KF { bf16x8 f[4]; };
struct VF { u32x2 a[2][4]; };
__device__ __forceinline__ void load_k(KF& k, const bf16* kp) {
#pragma unroll
    for (int s = 0; s < 4; ++s) k.f[s] = *(const bf16x8*)(kp + s * 16);
}
__device__ __forceinline__ void load_v(VF& v, const bf16* vp, size_t vstride32) {
#pragma unroll
    for (int dt = 0; dt < 2; ++dt)
#pragma unroll
        for (int q = 0; q < 4; ++q) v.a[dt][q] = *(const u32x2*)(vp + (size_t)dt * vstride32 + q * 8);
}
__device__ __forceinline__ f32x16 score_tile(const KF& k, const bf16x8 (&qf)[4]) {
    f32x16 st;
#pragma unroll
    for (int i = 0; i < 16; ++i) st[i] = 0.f;
#pragma unroll
    for (int s = 0; s < 4; ++s) st = __builtin_amdgcn_mfma_f32_32x32x16_bf16(k.f[s], qf[s], st, 0, 0, 0);
    return st;
}
__device__ __forceinline__ void pv_tile(f32x16& o0, f32x16& o1, const VF& v, const float* pv) {
    const bf16x8 p0 = pack8(pv), p1 = pack8(pv + 8);
    u32x4 w0, w1;
    w0.x = v.a[0][0].x; w0.y = v.a[0][0].y; w0.z = v.a[0][1].x; w0.w = v.a[0][1].y; w1.x = v.a[0][2].x; w1.y = v.a[0][2].y; w1.z = v.a[0][3].x; w1.w = v.a[0][3].y;
    o0 = __builtin_amdgcn_mfma_f32_32x32x16_bf16(__builtin_bit_cast(bf16x8, w0), p0, o0, 0, 0, 0); o0 = __builtin_amdgcn_mfma_f32_32x32x16_bf16(__builtin_bit_cast(bf16x8, w1), p1, o0, 0, 0, 0);
    w0.x = v.a[1][0].x; w0.y = v.a[1][0].y; w0.z = v.a[1][1].x; w0.w = v.a[1][1].y; w1.x = v.a[1][2].x; w1.y = v.a[1][2].y; w1.z = v.a[1][3].x; w1.w = v.a[1][3].y;
    o1 = __builtin_amdgcn_mfma_f32_32x32x16_bf16(__builtin_bit_cast(bf16x8, w0), p0, o1, 0, 0, 0); o1 = __builtin_amdgcn_mfma_f32_32x32x16_bf16(__builtin_bit_cast(bf16x8, w1), p1, o1, 0, 0, 0);
}
template <bool FAST>
__device__ __forceinline__ void attn_tile(const KF& kc, const VF& vf, const bf16x8 (&qf)[4], float slope, float base, int distbase, bool colsel, int wlimit,
                                          float& m, float& l, f32x16& o0, f32x16& o1) {
    const f32x16 st = score_tile(kc, qf);
    float sv[16];
#pragma unroll
    for (int i = 0; i < 16; ++i) {
        const int rc = (i & 3) + 8 * (i >> 2);
        const float v = st[i] + fmaf(slope, (float)rc, base);
        if (FAST) sv[i] = v;
        else { const int dist = distbase - rc; sv[i] = (colsel && dist >= 0 && dist < wlimit) ? v : -1e30f; }
    }
    float ml = sv[0];
#pragma unroll
    for (int i = 1; i < 16; ++i) ml = fmaxf(ml, sv[i]);
    ml = fmaxf(ml, __shfl_xor(ml, 32));
    if (__any(ml > m)) {
        const float mn = fmaxf(m, ml), alpha = __builtin_amdgcn_exp2f(m - mn);
        m = mn; l *= alpha;
#pragma unroll
        for (int i = 0; i < 16; ++i) { o0[i] *= alpha; o1[i] *= alpha; }
    }
    float ps = 0.f;
#pragma unroll
    for (int i = 0; i < 16; ++i) { float e = __builtin_amdgcn_exp2f(sv[i] - m); if (!FAST) e = (sv[i] > -1e29f) ? e : 0.f; sv[i] = e; ps += e; }
    l += ps;
    pv_tile(o0, o1, vf, sv);
}
__device__ __forceinline__ void nsa_attn_item(const Params& p, unsigned char* wlds, int item) {
    const int lane = threadIdx.x & 63, c = lane & 31, hh = lane >> 5, jt = c >> 2, r4 = c & 3;
    const int oct = item & 1023, g = (item >> 10) & 1, b = item >> 11;
    const int t0 = oct * 8, tc = t0 + jt, h = g * 4 + r4;
    const float slope = exp2f(-(float)(h + 1)) * LOG2E;
    const bf16* proj = (const bf16*)(p.ws + WS_PROJ);
    float* impA = (float*)wlds; float* impB = impA + 1024; unsigned* msk = (unsigned*)(impB + 1024);
    unsigned char* blist = (unsigned char*)(msk + 32);
    float* ocl = (float*)(wlds + 8448) + lane;
#pragma unroll
    for (int i = 0; i < 16; ++i) { impA[lane + 64 * i] = 0.f; impB[lane + 64 * i] = 0.f; }
    if (lane < 32) msk[lane] = 0u;
    bf16x8 qf[4];
    { const bf16* qp = proj + (size_t)(b * T + tc) * PS + C_NQ + h * 64 + hh * 8;
#pragma unroll
      for (int s = 0; s < 4; ++s) qf[s] = *(const bf16x8*)(qp + s * 16); }
    float gate[3];
    { const bf16* gp = proj + (size_t)(b * T + tc) * PS + C_GT + h * 3;
#pragma unroll
      for (int i = 0; i < 3; ++i) gate[i] = sigmoidf_(bf2f(gp[i])); }
    WAVE_LDS_SYNC();
    {
        const bf16* KC = (const bf16*)(p.ws + WS_KC) + (size_t)(b * 2 + g) * 512 * 64 + (size_t)c * 64 + hh * 8;
        const bf16* VCT = (const bf16*)(p.ws + WS_VCT) + (size_t)(b * 2 + g) * 64 * 512 + (size_t)c * 512 + 4 * hh;
        const int nmax = (t0 + 7 >= 31) ? ((t0 + 7 - 31) >> 4) : -1;
        const int nlast = (nmax >= 0) ? (nmax & ~31) : -32;
        float m = -1e30f, l = 0.f;
        f32x16 o0, o1;
#pragma unroll
        for (int i = 0; i < 16; ++i) { o0[i] = 0.f; o1[i] = 0.f; }
        KF kn;
        if (nlast >= 0) load_k(kn, KC + (size_t)nlast * 64);
#pragma unroll 1
        for (int n0 = nlast; n0 >= 0; n0 -= 32) {
            const KF kc = kn;
            load_k(kn, KC + (size_t)(n0 >= 32 ? n0 - 32 : n0) * 64);
            const f32x16 st = score_tile(kc, qf);
            float sv[16];
#pragma unroll
            for (int i = 0; i < 16; ++i) { const int dist = tc - (16 * (n0 + rho16(i, hh)) + 31); sv[i] = (dist >= 0) ? st[i] - slope * (float)dist : -1e30f; }
            float ml = sv[0];
#pragma unroll
            for (int i = 1; i < 16; ++i) ml = fmaxf(ml, sv[i]);
            ml = fmaxf(ml, __shfl_xor(ml, 32));
            const float mn = fmaxf(m, ml); float ps = 0.f;
#pragma unroll
            for (int i = 0; i < 16; ++i) ps += (sv[i] > -1e29f) ? __builtin_amdgcn_exp2f(sv[i] - mn) : 0.f;
            l = l * __builtin_amdgcn_exp2f(m - mn) + ps; m = mn;
        }
        l += __shfl_xor(l, 32);
        const float inv = 1.0f / fmaxf(l, 1e-30f);
        if (nlast >= 0) load_k(kn, KC + (size_t)nlast * 64);
#pragma unroll 1
        for (int n0 = nlast; n0 >= 0; n0 -= 32) {
            const KF kc = kn; VF vf;
            load_v(vf, VCT + n0, (size_t)32 * 512);
            load_k(kn, KC + (size_t)(n0 >= 32 ? n0 - 32 : n0) * 64);
            const f32x16 st = score_tile(kc, qf);
            float pv[16];
#pragma unroll
            for (int i = 0; i < 16; ++i) { const int dist = tc - (16 * (n0 + rho16(i, hh)) + 31); pv[i] = (dist >= 0) ? __builtin_amdgcn_exp2f(st[i] - slope * (float)dist - m) * inv : 0.f; }
            pv_tile(o0, o1, vf, pv);
#pragma unroll
            for (int i = 0; i < 16; ++i) { float v = pv[i]; v += dpp_f<0xB1>(v); v += dpp_f<0x4E>(v); pv[i] = v; }
            if (r4 == 0) {
#pragma unroll
                for (int rg = 0; rg < 4; ++rg) {
                    const int jb = (n0 >> 2) + 2 * rg + hh;
                    impA[jt * 128 + jb] = pv[4 * rg] + 2.f * pv[4 * rg + 1] + 2.f * pv[4 * rg + 2] + 2.f * pv[4 * rg + 3];
                    if (jb >= 1) impB[jt * 128 + jb - 1] = pv[4 * rg];
                }
            }
        }
#pragma unroll
        for (int i = 0; i < 16; ++i) { ocl[i * 64] = gate[0] * o0[i]; ocl[(16 + i) * 64] = gate[0] * o1[i]; }
    }
    WAVE_LDS_SYNC();
    {
        const int lig = lane & 15, grp = lane >> 4;
#pragma unroll 1
        for (int half = 0; half < 2; ++half) {
            const int j2 = half * 4 + grp, cur = (t0 + j2) >> 6;
            float v[8];
#pragma unroll
            for (int e = 0; e < 8; ++e) {
                const int j = lig * 8 + e; const float val = impA[j2 * 128 + j] + impB[j2 * 128 + j];
                v[e] = (j >= 1 && j <= cur - 2) ? __uint_as_float((__float_as_uint(val) & ~127u) | (unsigned)(127 - j)) : -1.0f;
            }
            const float top = grp16_top16(v, lig);
            const int need = 16 - ((cur == 0) ? 1 : (cur == 1) ? 2 : 3);
            if (lig < need && top >= 0.f) { const int idx = 127 - (int)(__float_as_uint(top) & 127u); atomicOr(&msk[j2 * 4 + (idx >> 5)], 1u << (idx & 31)); }
            if (lig == 0) { atomicOr(&msk[j2 * 4], 1u); atomicOr(&msk[j2 * 4 + (cur >> 5)], 1u << (cur & 31)); if (cur >= 1) atomicOr(&msk[j2 * 4 + ((cur - 1) >> 5)], 1u << ((cur - 1) & 31)); }
        }
    }
    WAVE_LDS_SYNC();
    {
        int nblk = 0;
#pragma unroll
        for (int w = 3; w >= 0; --w) {
            unsigned u = 0u;
#pragma unroll
            for (int j = 0; j < 8; ++j) u |= msk[j * 4 + w];
            u = (unsigned)__builtin_amdgcn_readfirstlane((int)u);
            while (u) { const int bit = 31 - __builtin_clz(u); u &= ~(1u << bit); if (lane == 0) blist[nblk] = (unsigned char)(w * 32 + bit); ++nblk; }
        }
        WAVE_LDS_SYNC();
        const bf16* KS = proj + (size_t)(b * T + c) * PS + C_KS + g * 64 + hh * 8;
        const bf16* VTS = (const bf16*)(p.ws + WS_VTS) + (size_t)(b * 2 + g) * 64 * T + (size_t)c * T + 4 * hh;
        float m = -1e30f, l = 0.f;
        f32x16 o0, o1;
#pragma unroll
        for (int i = 0; i < 16; ++i) { o0[i] = 0.f; o1[i] = 0.f; }
        const int ntile = 2 * nblk;
        KF kn;
        { const int jb0 = blist[0]; load_k(kn, KS + (size_t)(jb0 * 64 + 32) * PS); }
#pragma unroll 1
        for (int ti = 0; ti < ntile; ++ti) {
            const int jb = __builtin_amdgcn_readfirstlane((int)blist[ti >> 1]);
            const int key0 = jb * 64 + 32 - 32 * (ti & 1);
            const KF kc = kn; VF vf;
            load_v(vf, VTS + key0, (size_t)32 * T);
            { const int tn = (ti + 1 < ntile) ? ti + 1 : ti; const int jn = __builtin_amdgcn_readfirstlane((int)blist[tn >> 1]); load_k(kn, KS + (size_t)(jn * 64 + 32 - 32 * (tn & 1)) * PS); }
            const bool colsel = (msk[jt * 4 + (jb >> 5)] >> (jb & 31)) & 1u;
            const int distbase = tc - key0 - 4 * hh;
            if (key0 + 31 <= t0) attn_tile<true>(kc, vf, qf, slope, colsel ? -slope * (float)distbase : -1e30f, distbase, true, 1 << 30, m, l, o0, o1);
            else attn_tile<false>(kc, vf, qf, slope, -slope * (float)distbase, distbase, colsel, 1 << 30, m, l, o0, o1);
        }
        l += __shfl_xor(l, 32);
        const float sc = gate[1] / fmaxf(l, 1e-30f);
#pragma unroll
        for (int i = 0; i < 16; ++i) { ocl[i * 64] += sc * o0[i]; ocl[(16 + i) * 64] += sc * o1[i]; }
    }
    {
        const bf16* KW = proj + (size_t)(b * T + c) * PS + C_KW + g * 64 + hh * 8;
        const bf16* VTW = (const bf16*)(p.ws + WS_VTW) + (size_t)(b * 2 + g) * 64 * T + (size_t)c * T + 4 * hh;
        float m = -1e30f, l = 0.f;
        f32x16 o0, o1;
#pragma unroll
        for (int i = 0; i < 16; ++i) { o0[i] = 0.f; o1[i] = 0.f; }
        const int kstart = (t0 - 511 > 0 ? t0 - 511 : 0) & ~31, kfirst = t0 & ~31;
        KF kn;
        load_k(kn, KW + (size_t)kfirst * PS);
#pragma unroll 1
        for (int key0 = kfirst; key0 >= kstart; key0 -= 32) {
            const KF kc = kn; VF vf;
            load_v(vf, VTW + key0, (size_t)32 * T);
            { const int kn0 = (key0 - 32 >= kstart) ? key0 - 32 : key0; load_k(kn, KW + (size_t)kn0 * PS); }
            const int distbase = tc - key0 - 4 * hh;
            if (key0 + 31 <= t0 && key0 >= t0 - 504) attn_tile<true>(kc, vf, qf, slope, -slope * (float)distbase, distbase, true, 512, m, l, o0, o1);
            else attn_tile<false>(kc, vf, qf, slope, -slope * (float)distbase, distbase, true, 512, m, l, o0, o1);
        }
        l += __shfl_xor(l, 32);
        const float sc = gate[2] / fmaxf(l, 1e-30f);
#pragma unroll
        for (int i = 0; i < 16; ++i) { o0[i] = ocl[i * 64] + sc * o0[i]; o1[i] = ocl[(16 + i) * 64] + sc * o1[i]; }
        float ss = 0.f;
#pragma unroll
        for (int i = 0; i < 16; ++i) ss += o0[i] * o0[i] + o1[i] * o1[i];
        ss += __shfl_xor(ss, 32);
        const float r = rsqrtf(ss * (1.0f / 64.0f) + EPS);
        const float* og = p.in[11] + h * 64;
        bf16* op = (bf16*)(p.ws + WS_ACT) + (size_t)(b * T + tc) * D + 512 + h * 64;
#pragma unroll
        for (int dt = 0; dt < 2; ++dt)
#pragma unroll
            for (int rg = 0; rg < 4; ++rg) {
                const int d0 = dt * 32 + 8 * rg + 4 * hh;
                const f32x4 gg = *(const f32x4*)(og + d0);
                u32x2 w;
                if (dt == 0) { w.x = pk2(o0[4 * rg] * r * gg.x, o0[4 * rg + 1] * r * gg.y); w.y = pk2(o0[4 * rg + 2] * r * gg.z, o0[4 * rg + 3] * r * gg.w); }
                else { w.x = pk2(o1[4 * rg] * r * gg.x, o1[4 * rg + 1] * r * gg.y); w.y = pk2(o1[4 * rg + 2] * r * gg.z, o1[4 * rg + 3] * r * gg.w); }
                *(u32x2*)(op + d0) = w;
            }
    }
    WAVE_LDS_SYNC();
}
__device__ __forceinline__ void phase2(const Params& p, unsigned char* lds) {
    for (int it = blockIdx.x; it < 128 + 256 + 1024; it += gridDim.x) {
        if (it < 128) nsa_cmp_item(p, lds, it);
        else if (it < 384) nsa_prep_item(p, lds, it - 128);
        else hgrn_pre_item(p, lds, it - 384);
    }
}
template <bool SCAN>
__device__ __forceinline__ void phase3(const Params& p, unsigned char* lds) {
    const int gw = (blockIdx.x * NTHR + threadIdx.x) >> 6;
    const int wid = threadIdx.x >> 6;
    if (SCAN && blockIdx.x < 8) hgrn_scan_block(p, lds, blockIdx.x);
    unsigned* ctr = (unsigned*)(p.ws + WS_CTR) + (SCAN ? 0 : 64);
    for (;;) {
        int it = 0;
        if ((threadIdx.x & 63) == 0) it = (int)atomicAdd(ctr, 1u);
        it = __builtin_amdgcn_readfirstlane(it);
        if (it >= 4096) break;
        nsa_attn_item(p, lds + wid * 16640, 4095 - it);
    }
}

__device__ __forceinline__ float dot2u(unsigned a, unsigned b, float acc) { return __builtin_amdgcn_fdot2_f32_bf16(__builtin_bit_cast(bf16x2v, a), __builtin_bit_cast(bf16x2v, b), acc, false); }
__device__ __forceinline__ float dot8(u32x4 a, u32x4 b, float acc) {
    const unsigned a0 = a.x, a1 = a.y, a2 = a.z, a3 = a.w, b0 = b.x, b1 = b.y, b2 = b.z, b3 = b.w;
    acc = dot2u(a0, b0, acc); acc = dot2u(a1, b1, acc); acc = dot2u(a2, b2, acc); acc = dot2u(a3, b3, acc);
    return acc;
}
__device__ __forceinline__ void axpy8(float (&o)[8], float c, u32x4 v) {
    o[0] += c * __uint_as_float(v.x << 16); o[1] += c * __uint_as_float(v.x & 0xffff0000u);
    o[2] += c * __uint_as_float(v.y << 16); o[3] += c * __uint_as_float(v.y & 0xffff0000u);
    o[4] += c * __uint_as_float(v.z << 16); o[5] += c * __uint_as_float(v.z & 0xffff0000u);
    o[6] += c * __uint_as_float(v.w << 16); o[7] += c * __uint_as_float(v.w & 0xffff0000u);
}
typedef float f32x2 __attribute__((ext_vector_type(2)));
__device__ __forceinline__ float dot16_fp8(u32x4 r, const float* xf) {
    const unsigned r0 = r.x, r1 = r.y, r2 = r.z, r3 = r.w; float acc = 0.f; f32x2 t;
    t = __builtin_amdgcn_cvt_pk_f32_fp8((int)r0, false); acc += t.x * xf[0] + t.y * xf[1]; t = __builtin_amdgcn_cvt_pk_f32_fp8((int)r0, true); acc += t.x * xf[2] + t.y * xf[3];
    t = __builtin_amdgcn_cvt_pk_f32_fp8((int)r1, false); acc += t.x * xf[4] + t.y * xf[5]; t = __builtin_amdgcn_cvt_pk_f32_fp8((int)r1, true); acc += t.x * xf[6] + t.y * xf[7];
    t = __builtin_amdgcn_cvt_pk_f32_fp8((int)r2, false); acc += t.x * xf[8] + t.y * xf[9]; t = __builtin_amdgcn_cvt_pk_f32_fp8((int)r2, true); acc += t.x * xf[10] + t.y * xf[11];
    t = __builtin_amdgcn_cvt_pk_f32_fp8((int)r3, false); acc += t.x * xf[12] + t.y * xf[13]; t = __builtin_amdgcn_cvt_pk_f32_fp8((int)r3, true); acc += t.x * xf[14] + t.y * xf[15];
    return acc;
}
__device__ __forceinline__ void axpy16_fp8(float* o, float c, u32x4 r) {
    const unsigned r0 = r.x, r1 = r.y, r2 = r.z, r3 = r.w; f32x2 t;
    t = __builtin_amdgcn_cvt_pk_f32_fp8((int)r0, false); o[0] += c * t.x; o[1] += c * t.y; t = __builtin_amdgcn_cvt_pk_f32_fp8((int)r0, true); o[2] += c * t.x; o[3] += c * t.y;
    t = __builtin_amdgcn_cvt_pk_f32_fp8((int)r1, false); o[4] += c * t.x; o[5] += c * t.y; t = __builtin_amdgcn_cvt_pk_f32_fp8((int)r1, true); o[6] += c * t.x; o[7] += c * t.y;
    t = __builtin_amdgcn_cvt_pk_f32_fp8((int)r2, false); o[8] += c * t.x; o[9] += c * t.y; t = __builtin_amdgcn_cvt_pk_f32_fp8((int)r2, true); o[10] += c * t.x; o[11] += c * t.y;
    t = __builtin_amdgcn_cvt_pk_f32_fp8((int)r3, false); o[12] += c * t.x; o[13] += c * t.y; t = __builtin_amdgcn_cvt_pk_f32_fp8((int)r3, true); o[14] += c * t.x; o[15] += c * t.y;
}
template <bool DUMMY>
__device__ __forceinline__ void phase9(const Params& p, unsigned char* lds) {
    const bf16* HN = (const bf16*)(p.ws + WS_ACT); const unsigned char* UB = p.ws + WS_UB; const unsigned char* VB = p.ws + WS_VB;
    const float* US = (const float*)(p.ws + WS_US); const float* VS = (const float*)(p.ws + WS_VS);
    const int* ids = (const int*)(p.ws + WS_IDS); const float* wts = (const float*)(p.ws + WS_WTS);
    float* O = p.out; bf16* HG = (bf16*)(p.ws + WS_PROJ + 64 * MiB); const float* gn = p.in[19];
    const int lane = threadIdx.x & 63, gw = (blockIdx.x * NTHR + threadIdx.x) >> 6, ngw = (gridDim.x * NTHR) >> 6;
    for (int tok = gw; tok < NTOK; tok += ngw) {
        float xf[16], oa[16];
        {
            const u32x4 x0 = *(const u32x4*)(HN + (size_t)tok * D + lane * 16), x1 = *(const u32x4*)(HN + (size_t)tok * D + lane * 16 + 8);
            const unsigned a0 = x0.x, a1 = x0.y, a2 = x0.z, a3 = x0.w, b0 = x1.x, b1 = x1.y, b2 = x1.z, b3 = x1.w;
            xf[0] = __uint_as_float(a0 << 16); xf[1] = __uint_as_float(a0 & 0xffff0000u); xf[2] = __uint_as_float(a1 << 16); xf[3] = __uint_as_float(a1 & 0xffff0000u);
            xf[4] = __uint_as_float(a2 << 16); xf[5] = __uint_as_float(a2 & 0xffff0000u); xf[6] = __uint_as_float(a3 << 16); xf[7] = __uint_as_float(a3 & 0xffff0000u);
            xf[8] = __uint_as_float(b0 << 16); xf[9] = __uint_as_float(b0 & 0xffff0000u); xf[10] = __uint_as_float(b1 << 16); xf[11] = __uint_as_float(b1 & 0xffff0000u);
            xf[12] = __uint_as_float(b2 << 16); xf[13] = __uint_as_float(b2 & 0xffff0000u); xf[14] = __uint_as_float(b3 << 16); xf[15] = __uint_as_float(b3 & 0xffff0000u);
        }
#pragma unroll
        for (int j = 0; j < 16; ++j) oa[j] = 0.f;
#pragma unroll 1
        for (int half = 0; half < 2; ++half) {
            const int myid = ids[(size_t)tok * 128 + half * 64 + lane];
            const float myw = wts[(size_t)tok * 128 + half * 64 + lane] * VS[myid];
            const float myus = US[myid];
#pragma unroll 1
            for (int eb = 0; eb < 64; eb += 16) {
                int id[16]; float d[16]; u32x4 ur[16];
#pragma unroll
                for (int j = 0; j < 16; ++j) id[j] = __shfl(myid, eb + j);
#pragma unroll
                for (int j = 0; j < 16; ++j) ur[j] = *(const u32x4*)(UB + (size_t)id[j] * D + lane * 16);
#pragma unroll
                for (int j = 0; j < 16; ++j) d[j] = dot16_fp8(ur[j], xf);
#pragma unroll
                for (int j = 0; j < 16; ++j) ur[j] = *(const u32x4*)(VB + (size_t)id[j] * D + lane * 16);
#pragma unroll
                for (int j = 0; j < 16; ++j) d[j] = wave_sum(d[j]);
#pragma unroll
                for (int j = 0; j < 16; ++j) { const float c = __shfl(myw, eb + j) * gelu_tanh(d[j] * __shfl(myus, eb + j)); axpy16_fp8(oa, c, ur[j]); }
            }
        }
        float* orow = O + (size_t)tok * D + lane * 16; float* wrow = DUMMY ? (float*)(p.ws + WS_PROJ) + (size_t)tok * D + lane * 16 : orow;
        float ss = 0.f; f32x4 hv[4];
#pragma unroll
        for (int q = 0; q < 4; ++q) {
            f32x4 h = *(const f32x4*)(orow + 4 * q);
            h.x += oa[4 * q]; h.y += oa[4 * q + 1]; h.z += oa[4 * q + 2]; h.w += oa[4 * q + 3];
            *(f32x4*)(wrow + 4 * q) = h; hv[q] = h;
            ss += h.x * h.x + h.y * h.y + h.z * h.z + h.w * h.w;
        }
        ss = wave_sum(ss);
        const float r = rsqrtf(ss * (1.0f / D) + EPS);
        u32x4 q0, q1;
        { const f32x4 g0 = *(const f32x4*)(gn + lane * 16), g1 = *(const f32x4*)(gn + lane * 16 + 4), g2 = *(const f32x4*)(gn + lane * 16 + 8), g3 = *(const f32x4*)(gn + lane * 16 + 12);
          q0.x = pk2(hv[0].x * r * g0.x, hv[0].y * r * g0.y); q0.y = pk2(hv[0].z * r * g0.z, hv[0].w * r * g0.w); q0.z = pk2(hv[1].x * r * g1.x, hv[1].y * r * g1.y); q0.w = pk2(hv[1].z * r * g1.z, hv[1].w * r * g1.w);
          q1.x = pk2(hv[2].x * r * g2.x, hv[2].y * r * g2.y); q1.y = pk2(hv[2].z * r * g2.z, hv[2].w * r * g2.w); q1.z = pk2(hv[3].x * r * g3.x, hv[3].y * r * g3.y); q1.w = pk2(hv[3].z * r * g3.z, hv[3].w * r * g3.w); }
        *(u32x4*)(HG + (size_t)tok * D + lane * 16) = q0; *(u32x4*)(HG + (size_t)tok * D + lane * 16 + 8) = q1;
    }
}

#define XB_TMO      128
#define XB_XCNT(j)  (256  + 64 * (j))
#define XB_XSUB(j)  (1280 + 64 * (j))
#define XB_XGEN(j)  (2304 + 64 * (j))
#define XB_TOP      3328
#define XB_TOPGEN   3392
#define XCD_BAR_WORDS 3456
#define XB_SPIN_CAP (1u << 18)
#define LAS __attribute__((address_space(3)))
__device__ __forceinline__ unsigned xb_ld(unsigned* p)              { return __hip_atomic_load(p, __ATOMIC_RELAXED, __HIP_MEMORY_SCOPE_AGENT); }
__device__ __forceinline__ unsigned xb_add(unsigned* p, unsigned v) { return __hip_atomic_fetch_add(p, v, __ATOMIC_RELAXED, __HIP_MEMORY_SCOPE_AGENT); }
__device__ __forceinline__ unsigned xb_xcc_id() { return (unsigned)__builtin_amdgcn_s_getreg((3 << 11) | 20) & 0xFu; }
#define XB_SPIN(cond, bar) do { unsigned _sp = 0; while (cond) { __builtin_amdgcn_s_sleep(1); \
    if ((++_sp & 255u) == 0u) { if (xb_ld(&(bar)[XB_TMO])) break; if (_sp > XB_SPIN_CAP) { atomicAdd(&(bar)[XB_TMO], 1u); break; } } } } while (0)
struct XcdBarrier { unsigned* bar; unsigned x; volatile LAS unsigned* st; };
__device__ __forceinline__ XcdBarrier xcd_barrier_post(unsigned* bar, volatile LAS unsigned* st) {
    XcdBarrier b; b.bar = bar; b.x = xb_xcc_id(); b.st = st;
    if (threadIdx.x == 0) (void)xb_add(&bar[XB_XCNT(b.x)], 1u);
    return b;
}
__device__ __forceinline__ void xcd_barrier_complete(unsigned* bar, unsigned x, unsigned& nloc, unsigned& nx) {
    const unsigned G = gridDim.x * gridDim.y * gridDim.z;
    unsigned sum, cnt, mine, sp = 0u;
    for (;;) {
        sum = 0u; cnt = 0u; mine = 0u;
#pragma unroll
        for (unsigned j = 0; j < 16; ++j) { const unsigned c = xb_ld(&bar[XB_XCNT(j)]); sum += c; cnt += (c > 0u) ? 1u : 0u; mine = (j == x) ? c : mine; }
        if (sum == G) break;
        __builtin_amdgcn_s_sleep(1);
        if ((++sp & 255u) == 0u) { if (xb_ld(&bar[XB_TMO])) break; if (sp > XB_SPIN_CAP) { atomicAdd(&bar[XB_TMO], 1u); break; } }
    }
    nloc = mine > 0u ? mine : 1u; nx = cnt > 0u ? cnt : 1u;
}
__device__ __forceinline__ void xcd_barrier(const XcdBarrier& b) {
    asm volatile("s_waitcnt vmcnt(0)" ::: "memory");
    __syncthreads();
    if (threadIdx.x == 0) {
        unsigned* bar = b.bar;
        __builtin_amdgcn_s_waitcnt(0);
        unsigned nloc = b.st[0], nx = b.st[1];
        if (nloc == 0u) { xcd_barrier_complete(bar, b.x, nloc, nx); b.st[0] = nloc; b.st[1] = nx; }
        const unsigned old = xb_add(&bar[XB_XSUB(b.x)], 1u);
        const unsigned gen = old / nloc;
        if (old + 1u == (gen + 1u) * nloc) {
            __builtin_amdgcn_fence(__ATOMIC_RELEASE, "agent");
            asm volatile("s_waitcnt vmcnt(0)" ::: "memory");
            const unsigned og = xb_add(&bar[XB_TOP], 1u);
            const unsigned tg = og / nx;
            if (og + 1u == (tg + 1u) * nx) xb_add(&bar[XB_TOPGEN], 1u);
            else XB_SPIN(xb_ld(&bar[XB_TOPGEN]) == tg, bar);
            __builtin_amdgcn_fence(__ATOMIC_ACQUIRE, "agent");
            xb_add(&bar[XB_XGEN(b.x)], 1u);
            asm volatile("s_waitcnt vmcnt(0)" ::: "memory");
        } else {
            XB_SPIN(xb_ld(&bar[XB_XGEN(b.x)]) == gen, bar);
            __builtin_amdgcn_fence(__ATOMIC_ACQUIRE, "agent");
            asm volatile("s_waitcnt vmcnt(0)" ::: "memory");
        }
    }
    __syncthreads();
}

constexpr int REPK = -1;
__global__ void __launch_bounds__(NTHR, 2) mega(Params p, int ph_lo, int ph_hi) {
    extern __shared__ __attribute__((aligned(16))) unsigned char lds[];
    volatile LAS unsigned* st = (volatile LAS unsigned*)(LAS unsigned char*)(lds + LDS_BYTES - 16);
    if (threadIdx.x < 4) st[threadIdx.x] = 0u;
    __syncthreads();
    const XcdBarrier bar = xcd_barrier_post((unsigned*)p.ws, st);
#define RUN_PHASE(k, call) if (ph_lo <= (k) && (k) < ph_hi) { if ((k) > ph_lo) xcd_barrier(bar); call; if (REPK == (k)) { xcd_barrier(bar); call; } }
    RUN_PHASE(0, phase0(p, lds))
    RUN_PHASE(1, phase1(p, lds))
    RUN_PHASE(2, phase2(p, lds))
    if (REPK == 30) { xcd_barrier(bar); if ((threadIdx.x >> 6) == 0 && blockIdx.x < 64) hgrn_scan_item<true>(p, blockIdx.x); }
    if (ph_lo <= 3 && 3 < ph_hi) { if (3 > ph_lo) xcd_barrier(bar); phase3<true>(p, lds); if (REPK == 3) { xcd_barrier(bar); phase3<false>(p, lds); } }
    RUN_PHASE(4, phase4(p, lds))
    RUN_PHASE(5, phase5(p, lds))
    RUN_PHASE(6, phase6(p, lds))
    RUN_PHASE(7, phase7(p, lds))
    RUN_PHASE(8, phase8(p, lds))
    if (REPK == 9) { xcd_barrier(bar); phase9<true>(p, lds); }
    if (ph_lo <= 9 && 9 < ph_hi) { if (9 > ph_lo) xcd_barrier(bar); phase9<false>(p, lds); }
    RUN_PHASE(10, phase10(p, lds))
}

static void launch_mega(const Params& p, int lo, int hi, hipStream_t stream) {
    static int grid = 0;
    if (grid == 0) {
        int dev = 0, cus = 0, per_cu = 0;
        hipGetDevice(&dev); hipDeviceGetAttribute(&cus, hipDeviceAttributeMultiprocessorCount, dev);
        hipFuncSetAttribute((const void*)mega, hipFuncAttributeMaxDynamicSharedMemorySize, LDS_BYTES);
        hipOccupancyMaxActiveBlocksPerMultiprocessor(&per_cu, (const void*)mega, NTHR, LDS_BYTES);
        if (per_cu < 1) { fprintf(stderr, "mega: occupancy query says %d blocks/CU\n", per_cu); per_cu = 1; }
        grid = cus;
    }
    hipMemsetAsync(p.ws, 0, 65536, stream);
    Params pp = p; int l = lo, h = hi;
    void* args[] = {&pp, &l, &h};
    hipError_t e = hipLaunchCooperativeKernel((const void*)mega, dim3(grid), dim3(NTHR), args, LDS_BYTES, stream);
    if (e != hipSuccess) fprintf(stderr, "cooperative launch failed: %s (grid %d)\n", hipGetErrorString(e), grid);
}

extern "C" void kernel_launch(void* const* d_in, const int* in_sizes, int n_in, void* d_out, int out_size, void* d_ws, size_t ws_size, hipStream_t stream) {
    const float* x = (const float*)d_in[0]; const float* p = (const float*)d_in[1]; const float* mix_norm = (const float*)d_in[2]; const float* w_in = (const float*)d_in[3];
    const float* lb_logits = (const float*)d_in[4]; const float* hg_out_norm = (const float*)d_in[5]; const float* q_norm = (const float*)d_in[6]; const float* k_norm = (const float*)d_in[7];
    const float* cmp_pe = (const float*)d_in[8]; const float* cmp_w1 = (const float*)d_in[9]; const float* cmp_w2 = (const float*)d_in[10]; const float* nsa_out_norm = (const float*)d_in[11];
    const float* w_out = (const float*)d_in[12]; const float* ffn_norm = (const float*)d_in[13]; const float* peer_wq = (const float*)d_in[14]; const float* peer_keys = (const float*)d_in[15];
    const float* peer_u = (const float*)d_in[16]; const float* peer_v = (const float*)d_in[17]; const float* ple_proj = (const float*)d_in[18]; const float* ple_gate_norm = (const float*)d_in[19];
    const float* ple_gate_w = (const float*)d_in[20];
    float* out = (float*)d_out; unsigned char* ws = (unsigned char*)d_ws;
    bf16* act = (bf16*)(ws + WS_ACT); bf16* proj = (bf16*)(ws + WS_PROJ);
    bf16* pq = (bf16*)(ws + WS_PROJ); bf16* hg = (bf16*)(ws + WS_PROJ + 64 * MiB);
    int* ids = (int*)(ws + WS_IDS); float* wts = (float*)(ws + WS_WTS); float* kcf = (float*)(ws + WS_KCF); float* vcf = (float*)(ws + WS_VCF); float* gl = (float*)(ws + WS_GL);

    Params prm{}; for (int i = 0; i < 21; ++i) prm.in[i] = (const float*)d_in[i]; prm.out = out; prm.ws = ws;
    launch_mega(prm, 0, 11, stream);
}
```

```cpp
#include <hip/hip_runtime.h>
#include <hip/hip_cooperative_groups.h>
#include <cstdint>
#include <cstdio>
namespace cg = cooperative_groups;

constexpr int D = 1024, NB = 2, T = 8192, NTOK = NB * T;
constexpr int DIN = 3352, PS = 3392;
constexpr int C_HQ = 0, C_HF = 512, C_HI = 1024, C_HG = 1536, C_NQ = 2048, C_KC = 2560, C_VC = 2688,
              C_KS = 2816, C_VS = 2944, C_KW = 3072, C_VW = 3200, C_GT = 3328;
constexpr int NCMP = 511;
constexpr float EPS = 1e-6f;
typedef unsigned short bf16;

constexpr size_t MiB = 1u << 20;
constexpr size_t WS_WINT = 1 * MiB;
constexpr size_t WS_WOUTT = 8 * MiB;
constexpr size_t WS_WQT = 10 * MiB;
constexpr size_t WS_WGT = 14 * MiB;
constexpr size_t WS_WPT = 16 * MiB;
constexpr size_t WS_KEYB = 16 * MiB + 512 * 1024;
constexpr size_t WS_W1T = 17 * MiB;
constexpr size_t WS_CTR = 16384;
constexpr size_t WS_SSQ = 512 * 1024;
constexpr size_t WS_US = 256 * 1024;
constexpr size_t WS_VS = 320 * 1024;
constexpr size_t WS_UB = 18 * MiB;
constexpr size_t WS_VB = 50 * MiB;
constexpr size_t WS_ACT = 82 * MiB;
constexpr size_t WS_PROJ = 114 * MiB;
constexpr size_t WS_SPARE = 220 * MiB;
constexpr size_t WS_IDS = WS_SPARE;
constexpr size_t WS_WTS = WS_SPARE + 8 * MiB;
constexpr size_t WS_KCF = WS_SPARE + 16 * MiB;
constexpr size_t WS_VCF = WS_SPARE + 17 * MiB;
constexpr size_t WS_PB = WS_SPARE + 18 * MiB;
constexpr size_t WS_VTS = WS_SPARE + 26 * MiB;
constexpr size_t WS_VTW = WS_SPARE + 30 * MiB;
constexpr size_t WS_KC = WS_SPARE + 34 * MiB;
constexpr size_t WS_VCT = WS_SPARE + 34 * MiB + 256 * 1024;
constexpr size_t WS_DEC = WS_SPARE + 34 * MiB + 512 * 1024;
constexpr size_t OUT_KIT = 32 * MiB;
constexpr size_t OUT_VT = 48 * MiB;
constexpr size_t WS_GL = 18 * MiB;

__device__ __forceinline__ float bf2f(bf16 v) { return __uint_as_float(((unsigned)v) << 16); }
__device__ __forceinline__ bf16 f2bf(float f) { return __builtin_bit_cast(bf16, (__bf16)f); }
__device__ __forceinline__ float wave_sum(float v) {
#pragma unroll
    for (int o = 1; o < 64; o <<= 1) v += __shfl_xor(v, o);
    return v;
}
__device__ __forceinline__ float wave_max(float v) {
#pragma unroll
    for (int o = 1; o < 64; o <<= 1) v = fmaxf(v, __shfl_xor(v, o));
    return v;
}
__device__ __forceinline__ float sigmoidf_(float x) { return 1.0f / (1.0f + __expf(-x)); }
__device__ __forceinline__ float siluf_(float x) { return x * sigmoidf_(x); }
__device__ __forceinline__ float gelu_tanh(float x) { return 0.5f * x * (1.0f + tanhf(0.7978845608028654f * (x + 0.044715f * x * x * x))); }
__device__ __forceinline__ float toF(float v) { return v; }
__device__ __forceinline__ float toF(bf16 v) { return bf2f(v); }

__global__ void __launch_bounds__(256) k_rms_rows(const float* __restrict__ x, const float* __restrict__ g, bf16* __restrict__ out, int rows) {
    const int wave = (blockIdx.x * 256 + threadIdx.x) >> 6, lane = threadIdx.x & 63;
    if (wave >= rows) return;
    const float* xr = x + (size_t)wave * D;
    float v[16]; float s = 0.f;
#pragma unroll
    for (int j = 0; j < 16; ++j) { v[j] = xr[lane + 64 * j]; s += v[j] * v[j]; }
    s = wave_sum(s);
    const float r = rsqrtf(s * (1.0f / D) + EPS);
#pragma unroll
    for (int j = 0; j < 16; ++j) out[(size_t)wave * D + lane + 64 * j] = f2bf(v[j] * r * g[lane + 64 * j]);
}

struct EpiBf16 { bf16* C; int ldc; int pad; __device__ void operator()(int r, int c, float v) const { C[(size_t)r * ldc + c] = f2bf(v); } };
struct EpiF32 { float* C; int ldc; int pad; __device__ void operator()(int r, int c, float v) const { C[(size_t)r * ldc + c] = v; } };
struct EpiResid { const float* X; float* O; int ld; int pad; __device__ void operator()(int r, int c, float v) const { O[(size_t)r * ld + c] = X[(size_t)r * ld + c] + v; } };
struct EpiFinal { const float* G; float* O; int ld; int pad; __device__ void operator()(int r, int c, float v) const { const size_t i = (size_t)r * ld + c; O[i] = O[i] + v * sigmoidf_(G[i]); } };

template <typename AT, class Epi>
__global__ void __launch_bounds__(256) k_gemm_naive(const AT* __restrict__ A, int lda, const float* __restrict__ W, int ldw, int N, int K, Epi epi) {
    __shared__ float As[16][65];
    __shared__ float Bs[16][64];
    const int tid = threadIdx.x, tx = tid & 15, ty = tid >> 4;
    const int m0 = blockIdx.y * 64, n0 = blockIdx.x * 64;
    float acc[4][4];
#pragma unroll
    for (int i = 0; i < 4; ++i)
#pragma unroll
        for (int j = 0; j < 4; ++j) acc[i][j] = 0.f;
    for (int k0 = 0; k0 < K; k0 += 16) {
#pragma unroll
        for (int i = 0; i < 4; ++i) { const int idx = tid + i * 256, r = idx >> 4, kk = idx & 15; As[kk][r] = toF(A[(size_t)(m0 + r) * lda + k0 + kk]); }
#pragma unroll
        for (int i = 0; i < 4; ++i) { const int idx = tid + i * 256, kk = idx >> 6, c = idx & 63; Bs[kk][c] = (n0 + c < N) ? W[(size_t)(k0 + kk) * ldw + n0 + c] : 0.f; }
        __syncthreads();
#pragma unroll
        for (int kk = 0; kk < 16; ++kk) {
            float a[4], b[4];
#pragma unroll
            for (int i = 0; i < 4; ++i) a[i] = As[kk][ty * 4 + i];
#pragma unroll
            for (int j = 0; j < 4; ++j) b[j] = Bs[kk][tx * 4 + j];
#pragma unroll
            for (int i = 0; i < 4; ++i)
#pragma unroll
                for (int j = 0; j < 4; ++j) acc[i][j] += a[i] * b[j];
        }
        __syncthreads();
    }
#pragma unroll
    for (int i = 0; i < 4; ++i)
#pragma unroll
        for (int j = 0; j < 4; ++j) { const int r = m0 + ty * 4 + i, c = n0 + tx * 4 + j; if (c < N) epi(r, c, acc[i][j]); }
}

__global__ void __launch_bounds__(1024) k_hgrn_naive(const bf16* __restrict__ proj, const float* __restrict__ lb_logits, const float* __restrict__ out_gain, bf16* __restrict__ mixed) {
    const int b = blockIdx.x >> 2, h = blockIdx.x & 3, tid = threadIdx.x, v = tid & 127, kg = tid >> 7;
    __shared__ float qsh[128], ksh[128], fsh[128], vsh[128], part[8][128], red[2], lbs[128];
    if (tid < 128) { const float l0 = lb_logits[h * 128 + tid], l1 = lb_logits[512 + h * 128 + tid]; const float m = fmaxf(l0, l1); const float e0 = expf(l0 - m), e1 = expf(l1 - m); lbs[tid] = e0 / (e0 + e1); }
    float S[16];
#pragma unroll
    for (int i = 0; i < 16; ++i) S[i] = 0.f;
    __syncthreads();
    for (int t = 0; t < T; ++t) {
        const size_t row = (size_t)(b * T + t) * PS;
        if (tid < 128) {
            const float fl = bf2f(proj[row + C_HF + h * 128 + tid]); const float lb = lbs[tid];
            const float fg = lb + (1.0f - lb) * sigmoidf_(fl); fsh[tid] = fg; ksh[tid] = 1.0f - fg;
            qsh[tid] = siluf_(bf2f(proj[row + C_HQ + h * 128 + tid])) * 0.08838834764831845f;
        } else if (tid < 256) vsh[tid - 128] = bf2f(proj[row + C_HI + h * 128 + tid - 128]);
        __syncthreads();
        const float vv = vsh[v]; float p = 0.f;
#pragma unroll
        for (int i = 0; i < 16; ++i) { const int k = kg * 16 + i; S[i] = fsh[k] * S[i] + ksh[k] * vv; p += qsh[k] * S[i]; }
        part[kg][v] = p;
        __syncthreads();
        float o = 0.f;
        if (tid < 128) {
#pragma unroll
            for (int j = 0; j < 8; ++j) o += part[j][tid];
            const float ss = wave_sum(o * o); if ((tid & 63) == 0) red[tid >> 6] = ss;
        }
        __syncthreads();
        if (tid < 128) {
            const float tot = red[0] + red[1];
            const float y = o * rsqrtf(tot * (1.0f / 128.0f) + EPS) * out_gain[h * 128 + tid];
            const float gl = bf2f(proj[row + C_HG + h * 128 + tid]);
            mixed[(size_t)(b * T + t) * D + h * 128 + tid] = f2bf(y * siluf_(gl));
        }
    }
}

__global__ void __launch_bounds__(64) k_cmp_naive(const bf16* __restrict__ proj, const float* __restrict__ pe, const float* __restrict__ w1, const float* __restrict__ w2,
                                                  const float* __restrict__ k_gain, float* __restrict__ kc, float* __restrict__ vc) {
    int it = blockIdx.x; const int n = it % NCMP; it /= NCMP; const int g = it & 1; it >>= 1; const int b = it & 1; const int which = it >> 1;
    const int c = threadIdx.x;
    __shared__ float blk[2048]; __shared__ float hid[64];
    const int col0 = (which == 0 ? C_KC : C_VC) + g * 64;
    for (int i = c; i < 2048; i += 64) { const int j = i >> 6, d = i & 63; blk[i] = bf2f(proj[(size_t)(b * T + 16 * n + j) * PS + col0 + d]) + pe[which * 2048 + i]; }
    __syncthreads();
    float acc = 0.f;
    for (int i = 0; i < 2048; ++i) acc += blk[i] * w1[(size_t)which * 2048 * 64 + (size_t)i * 64 + c];
    hid[c] = gelu_tanh(acc);
    __syncthreads();
    float o = 0.f;
    for (int i = 0; i < 64; ++i) o += hid[i] * w2[which * 4096 + i * 64 + c];
    if (which == 0) { const float ss = wave_sum(o * o); o = o * rsqrtf(ss * (1.0f / 64.0f) + EPS) * k_gain[c]; }
    (which == 0 ? kc : vc)[((size_t)(b * 2 + g) * NCMP + n) * 64 + c] = o;
}

__global__ void __launch_bounds__(256) k_nsa_naive(const bf16* __restrict__ proj, const float* __restrict__ kc, const float* __restrict__ vc, const float* __restrict__ q_gain,
                                                   const float* __restrict__ k_gain, const float* __restrict__ out_gain, bf16* __restrict__ mixed) {
    const int g = blockIdx.x & 1, tok = blockIdx.x >> 1, b = tok / T, t = tok % T;
    const int tid = threadIdx.x, r = tid >> 6, lane = tid & 63, h = g * 4 + r;
    __shared__ float qs[4][64]; __shared__ float sc[4][1024]; __shared__ float P[520]; __shared__ float imp[128]; __shared__ int sel[128]; __shared__ int blist[16]; __shared__ int nbs;
    const float slope = exp2f(-(float)(h + 1));
    const float NEG = -__builtin_huge_valf();
    {
        float qv = bf2f(proj[(size_t)tok * PS + C_NQ + h * 64 + lane]);
        const float ss = wave_sum(qv * qv);
        qs[r][lane] = qv * rsqrtf(ss * (1.0f / 64.0f) + EPS) * q_gain[lane] * 0.125f;
    }
    __syncthreads();
    const int nvalid = (t >= 31) ? ((t - 31) / 16 + 1) : 0;
    const float* kcb = kc + (size_t)(b * 2 + g) * NCMP * 64; const float* vcb = vc + (size_t)(b * 2 + g) * NCMP * 64;
    float mx = NEG;
    for (int n = lane; n < 512; n += 64) {
        float s = NEG;
        if (n < nvalid) { float d = 0.f; for (int i = 0; i < 64; ++i) d += qs[r][i] * kcb[n * 64 + i]; s = d - slope * (float)(t - (16 * n + 31)); }
        sc[r][n] = s; mx = fmaxf(mx, s);
    }
    mx = wave_max(mx); if (mx == NEG) mx = 0.f;
    float sum = 0.f;
    for (int n = lane; n < 512; n += 64) { const float e = (n < nvalid) ? expf(sc[r][n] - mx) : 0.f; sc[r][n] = e; sum += e; }
    sum = wave_sum(sum); float inv = 1.0f / fmaxf(sum, 1e-30f);
    for (int n = lane; n < 512; n += 64) sc[r][n] *= inv;
    __syncthreads();
    float oc = 0.f;
    for (int n = 0; n < nvalid; ++n) oc += sc[r][n] * vcb[n * 64 + lane];
    for (int i = tid; i < 520; i += 256) P[i] = (i < 512) ? (sc[0][i] + sc[1][i] + sc[2][i] + sc[3][i]) : 0.f;
    __syncthreads();
    if (tid < 128) imp[tid] = P[4 * tid] + 2.f * P[4 * tid + 1] + 2.f * P[4 * tid + 2] + 2.f * P[4 * tid + 3] + P[4 * tid + 4];
    __syncthreads();
    const int cur = t >> 6;
    if (tid < 128) {
        const int j = tid; const bool forced = (j == 0) || (j == cur) || (j == cur - 1); const bool cand = !forced && j <= cur;
        const int nforced = (cur == 0) ? 1 : (cur == 1) ? 2 : 3; const int need = 16 - nforced;
        int rank = 0; const float mine = imp[j];
        for (int q = 1; q <= cur - 2; ++q) { if (q == j) continue; const float o = imp[q]; if (o > mine || (o == mine && q < j)) ++rank; }
        sel[j] = (forced || (cand && rank < need)) ? 1 : 0;
    }
    __syncthreads();
    if (tid == 0) { int nb = 0; for (int j = 0; j < 128; ++j) if (sel[j] && nb < 16) blist[nb++] = j; nbs = nb; }
    __syncthreads();
    const int nb = nbs;
    float os = 0.f;
    {
        float m2 = NEG;
        for (int s = 0; s < nb; ++s) {
            const int pos = blist[s] * 64 + lane; float val = NEG;
            if (pos <= t) {
                const bf16* kr = proj + (size_t)(b * T + pos) * PS + C_KS + g * 64; float d = 0.f, sq = 0.f;
                for (int i = 0; i < 64; ++i) { const float kv = bf2f(kr[i]); d += qs[r][i] * kv * k_gain[64 + i]; sq += kv * kv; }
                val = d * rsqrtf(sq * (1.0f / 64.0f) + EPS) - slope * (float)(t - pos);
            }
            sc[r][s * 64 + lane] = val; m2 = fmaxf(m2, val);
        }
        m2 = wave_max(m2); if (m2 == NEG) m2 = 0.f;
        float su = 0.f;
        for (int s = 0; s < nb; ++s) { const float v0 = sc[r][s * 64 + lane]; const float e = (v0 == NEG) ? 0.f : expf(v0 - m2); sc[r][s * 64 + lane] = e; su += e; }
        su = wave_sum(su); const float iv = 1.0f / fmaxf(su, 1e-30f);
        __syncthreads();
        for (int s = 0; s < nb; ++s) for (int i = 0; i < 64; ++i) {
            const float p = sc[r][s * 64 + i]; if (p != 0.f) os += p * bf2f(proj[(size_t)(b * T + blist[s] * 64 + i) * PS + C_VS + g * 64 + lane]); }
        os *= iv;
    }
    __syncthreads();
    float ow = 0.f;
    {
        float m2 = NEG;
        for (int i = lane; i < 512; i += 64) {
            const int pos = t - i; float val = NEG;
            if (pos >= 0) {
                const bf16* kr = proj + (size_t)(b * T + pos) * PS + C_KW + g * 64; float d = 0.f, sq = 0.f;
                for (int c = 0; c < 64; ++c) { const float kv = bf2f(kr[c]); d += qs[r][c] * kv * k_gain[128 + c]; sq += kv * kv; }
                val = d * rsqrtf(sq * (1.0f / 64.0f) + EPS) - slope * (float)i;
            }
            sc[r][i] = val; m2 = fmaxf(m2, val);
        }
        m2 = wave_max(m2);
        float su = 0.f;
        for (int i = lane; i < 512; i += 64) { const float v0 = sc[r][i]; const float e = (v0 == NEG) ? 0.f : expf(v0 - m2); sc[r][i] = e; su += e; }
        su = wave_sum(su); const float iv = 1.0f / fmaxf(su, 1e-30f);
        __syncthreads();
        for (int i = 0; i < 512; ++i) { const float p = sc[r][i]; if (p != 0.f) ow += p * bf2f(proj[(size_t)(b * T + t - i) * PS + C_VW + g * 64 + lane]); }
        ow *= iv;
    }
    const bf16* gl = proj + (size_t)tok * PS + C_GT + h * 3;
    const float o = sigmoidf_(bf2f(gl[0])) * oc + sigmoidf_(bf2f(gl[1])) * os + sigmoidf_(bf2f(gl[2])) * ow;
    const float ss = wave_sum(o * o);
    mixed[(size_t)tok * D + 512 + h * 64 + lane] = f2bf(o * rsqrtf(ss * (1.0f / 64.0f) + EPS) * out_gain[h * 64 + lane]);
}

__global__ void __launch_bounds__(128) k_peer_topk_naive(const bf16* __restrict__ pq, const float* __restrict__ keys, int* __restrict__ ids, float* __restrict__ wts) {
    const int tok = blockIdx.x >> 3, h = blockIdx.x & 7, k = threadIdx.x;
    __shared__ float q[256]; __shared__ float s[2][128]; __shared__ float ts[2][16]; __shared__ int ti[2][16]; __shared__ float cand[256]; __shared__ float bs[16]; __shared__ int bc[16];
    q[k] = bf2f(pq[(size_t)tok * 2048 + h * 256 + k]); q[k + 128] = bf2f(pq[(size_t)tok * 2048 + h * 256 + 128 + k]);
    __syncthreads();
#pragma unroll
    for (int c = 0; c < 2; ++c) { const float* kr = keys + ((size_t)(h * 2 + c) * 128 + k) * 128; float d = 0.f; for (int i = 0; i < 128; ++i) d += q[c * 128 + i] * kr[i]; s[c][k] = d; }
    __syncthreads();
#pragma unroll
    for (int c = 0; c < 2; ++c) { const float mine = s[c][k]; int rank = 0; for (int j = 0; j < 128; ++j) { const float o = s[c][j]; if (o > mine || (o == mine && j < k)) ++rank; } if (rank < 16) { ts[c][rank] = mine; ti[c][rank] = k; } }
    __syncthreads();
    cand[k] = ts[0][k >> 4] + ts[1][k & 15]; cand[k + 128] = ts[0][(k + 128) >> 4] + ts[1][(k + 128) & 15];
    __syncthreads();
#pragma unroll
    for (int e = 0; e < 2; ++e) { const int me = k + e * 128; const float mine = cand[me]; int rank = 0; for (int j = 0; j < 256; ++j) { const float o = cand[j]; if (o > mine || (o == mine && j < me)) ++rank; } if (rank < 16) { bs[rank] = mine; bc[rank] = me; } }
    __syncthreads();
    if (k < 16) {
        float mx = bs[0]; float sum = 0.f; for (int j = 0; j < 16; ++j) sum += expf(bs[j] - mx);
        const int c = bc[k]; ids[(size_t)tok * 128 + h * 16 + k] = ti[0][c >> 4] * 128 + ti[1][c & 15];
        wts[(size_t)tok * 128 + h * 16 + k] = expf(bs[k] - mx) / sum;
    }
}

__global__ void __launch_bounds__(256) k_peer_gather_naive(const bf16* __restrict__ hn, const int* __restrict__ ids, const float* __restrict__ wts, const float* __restrict__ U, const float* __restrict__ V,
                                                           const float* __restrict__ gnorm, float* __restrict__ hio, bf16* __restrict__ hg) {
    const int tok = blockIdx.x, tid = threadIdx.x, w = tid >> 6, lane = tid & 63;
    __shared__ float xs[1024]; __shared__ float coef[128]; __shared__ int eid[128]; __shared__ float red[4];
    for (int i = tid; i < 1024; i += 256) xs[i] = bf2f(hn[(size_t)tok * D + i]);
    if (tid < 128) eid[tid] = ids[(size_t)tok * 128 + tid];
    __syncthreads();
    for (int e = w * 32; e < w * 32 + 32; ++e) {
        const float* ur = U + (size_t)eid[e] * D; float d = 0.f;
        for (int i = lane; i < 1024; i += 64) d += ur[i] * xs[i];
        d = wave_sum(d);
        if (lane == 0) coef[e] = wts[(size_t)tok * 128 + e] * gelu_tanh(d);
    }
    __syncthreads();
    float o[4] = {0.f, 0.f, 0.f, 0.f};
    for (int e = 0; e < 128; ++e) { const float* vr = V + (size_t)eid[e] * D; const float c = coef[e];
#pragma unroll
        for (int j = 0; j < 4; ++j) o[j] += c * vr[tid + 256 * j]; }
    float ss = 0.f;
#pragma unroll
    for (int j = 0; j < 4; ++j) { o[j] += hio[(size_t)tok * D + tid + 256 * j]; hio[(size_t)tok * D + tid + 256 * j] = o[j]; ss += o[j] * o[j]; }
    ss = wave_sum(ss); if (lane == 0) red[w] = ss;
    __syncthreads();
    const float r = rsqrtf((red[0] + red[1] + red[2] + red[3]) * (1.0f / D) + EPS);
#pragma unroll
    for (int j = 0; j < 4; ++j) hg[(size_t)tok * D + tid + 256 * j] = f2bf(o[j] * r * gnorm[tid + 256 * j]);
}


typedef short bf16x8 __attribute__((ext_vector_type(8)));
typedef float f32x4 __attribute__((ext_vector_type(4)));
typedef float f32x16 __attribute__((ext_vector_type(16)));
typedef unsigned u32x4 __attribute__((ext_vector_type(4)));
typedef unsigned u32x2 __attribute__((ext_vector_type(2)));
constexpr int NTHR = 512;
constexpr int LDS_BYTES = 143360 + 16;
struct Params { const float* in[21]; float* out; unsigned char* ws; };

typedef __bf16 bf16x2c __attribute__((ext_vector_type(2)));
__device__ __forceinline__ unsigned pk2(float lo, float hi) { bf16x2c v = { (__bf16)lo, (__bf16)hi }; return __builtin_bit_cast(unsigned, v); }

__device__ __forceinline__ void transpose_tile(const float* __restrict__ W, int K, int N, bf16* __restrict__ Wt, int kt, int nt, float* tile) {
    const int tid = threadIdx.x, k0 = kt * 64, n0 = nt * 64;
#pragma unroll
    for (int i = 0; i < 8; ++i) { const int idx = tid + i * NTHR, kk = idx >> 6, nn = idx & 63; tile[kk * 65 + nn] = (n0 + nn < N) ? W[(size_t)(k0 + kk) * N + n0 + nn] : 0.f; }
    __syncthreads();
    { const int nn = tid >> 3, ch = tid & 7; const float* s = tile + (ch * 8) * 65 + nn;
      u32x4 o; o.x = pk2(s[0], s[65]); o.y = pk2(s[130], s[195]); o.z = pk2(s[260], s[325]); o.w = pk2(s[390], s[455]);
      *(u32x4*)(Wt + (size_t)(n0 + nn) * K + k0 + ch * 8) = o; }
    __syncthreads();
}
__device__ __forceinline__ void cvt_range(const float* __restrict__ src, bf16* __restrict__ dst, size_t n8, size_t gtid, size_t gthreads) {
    for (size_t i = gtid; i < n8; i += gthreads) {
        const f32x4 a = ((const f32x4*)src)[2 * i], b = ((const f32x4*)src)[2 * i + 1];
        u32x4 o; o.x = pk2(a.x, a.y); o.y = pk2(a.z, a.w); o.z = pk2(b.x, b.y); o.w = pk2(b.z, b.w);
        ((u32x4*)dst)[i] = o;
    }
}
__device__ __forceinline__ void rms_row_bf16(const float* __restrict__ xr, const float* __restrict__ g, bf16* __restrict__ orow, int lane) {
    f32x4 v[4]; float s = 0.f;
#pragma unroll
    for (int j = 0; j < 4; ++j) { v[j] = ((const f32x4*)xr)[lane + 64 * j]; s += v[j].x * v[j].x + v[j].y * v[j].y + v[j].z * v[j].z + v[j].w * v[j].w; }
    s = wave_sum(s);
    const float r = rsqrtf(s * (1.0f / D) + EPS);
#pragma unroll
    for (int j = 0; j < 4; ++j) { const f32x4 gg = ((const f32x4*)g)[lane + 64 * j]; u32x2 o; o.x = pk2(v[j].x * r * gg.x, v[j].y * r * gg.y); o.y = pk2(v[j].z * r * gg.z, v[j].w * r * gg.w); ((u32x2*)orow)[lane + 64 * j] = o; }
}

__device__ __forceinline__ void phase0(const Params& p, unsigned char* lds) {
    float* tile = (float*)lds;
    const int nblk = gridDim.x, blk = blockIdx.x;
    unsigned char* ws = p.ws;
    constexpr int I_WIN = 16 * 56, I_WOUT = 16 * 16, I_WQ = 16 * 32, I_WG = 16 * 16, I_WP = 4 * 16, I_W1 = 2 * 32;
    constexpr int NIT = I_WIN + I_WOUT + I_WQ + I_WG + I_WP + I_W1;
    for (int it = blk; it < NIT; it += nblk) {
        int r = it;
        if (r < I_WIN) { transpose_tile(p.in[3], 1024, DIN, (bf16*)(ws + WS_WINT), r / 56, r % 56, tile); continue; } r -= I_WIN;
        if (r < I_WOUT) { transpose_tile(p.in[12], 1024, 1024, (bf16*)(ws + WS_WOUTT), r / 16, r % 16, tile); continue; } r -= I_WOUT;
        if (r < I_WQ) { transpose_tile(p.in[14], 1024, 2048, (bf16*)(ws + WS_WQT), r / 32, r % 32, tile); continue; } r -= I_WQ;
        if (r < I_WG) { transpose_tile(p.in[20], 1024, 1024, (bf16*)(ws + WS_WGT), r / 16, r % 16, tile); continue; } r -= I_WG;
        if (r < I_WP) { transpose_tile(p.in[18], 256, 1024, (bf16*)(ws + WS_WPT), r / 16, r % 16, tile); continue; } r -= I_WP;
        { const int which = r / 32, kt = r % 32; transpose_tile(p.in[9] + (size_t)which * 2048 * 64, 2048, 64, (bf16*)(ws + WS_W1T) + (size_t)which * 64 * 2048, kt, 0, tile); }
    }
    const size_t gtid = (size_t)blk * NTHR + threadIdx.x, gthreads = (size_t)nblk * NTHR;
    cvt_range(p.in[15], (bf16*)(ws + WS_KEYB), (size_t)8 * 2 * 128 * 128 / 8, gtid, gthreads);
    cvt_range(p.in[1], (bf16*)(ws + WS_PB), (size_t)NTOK * 256 / 8, gtid, gthreads);
    const int gw = (int)(gtid >> 6), ngw = (int)(gthreads >> 6), lane = threadIdx.x & 63;
    for (int m = gw; m < NTOK; m += ngw) rms_row_bf16(p.in[0] + (size_t)m * D, p.in[2], (bf16*)(ws + WS_ACT) + (size_t)m * D, lane);
    for (int m = gw; m < 2 * 16384; m += ngw) {
        const int which = m >> 14, row = m & 16383;
        const float* src = p.in[16 + which] + (size_t)row * D + lane * 16;
        const f32x4 a = *(const f32x4*)src, b = *(const f32x4*)(src + 4), c = *(const f32x4*)(src + 8), d = *(const f32x4*)(src + 12);
        float mx = fmaxf(fmaxf(fmaxf(fabsf(a.x), fabsf(a.y)), fmaxf(fabsf(a.z), fabsf(a.w))), fmaxf(fmaxf(fabsf(b.x), fabsf(b.y)), fmaxf(fabsf(b.z), fabsf(b.w))));
        mx = fmaxf(mx, fmaxf(fmaxf(fmaxf(fabsf(c.x), fabsf(c.y)), fmaxf(fabsf(c.z), fabsf(c.w))), fmaxf(fmaxf(fabsf(d.x), fabsf(d.y)), fmaxf(fabsf(d.z), fabsf(d.w)))));
        mx = fmaxf(wave_max(mx), 1e-30f);
        const float sc = 224.0f / mx;
        u32x4 o; int w;
        w = __builtin_amdgcn_cvt_pk_fp8_f32(a.x * sc, a.y * sc, 0, false); w = __builtin_amdgcn_cvt_pk_fp8_f32(a.z * sc, a.w * sc, w, true); o.x = (unsigned)w;
        w = __builtin_amdgcn_cvt_pk_fp8_f32(b.x * sc, b.y * sc, 0, false); w = __builtin_amdgcn_cvt_pk_fp8_f32(b.z * sc, b.w * sc, w, true); o.y = (unsigned)w;
        w = __builtin_amdgcn_cvt_pk_fp8_f32(c.x * sc, c.y * sc, 0, false); w = __builtin_amdgcn_cvt_pk_fp8_f32(c.z * sc, c.w * sc, w, true); o.z = (unsigned)w;
        w = __builtin_amdgcn_cvt_pk_fp8_f32(d.x * sc, d.y * sc, 0, false); w = __builtin_amdgcn_cvt_pk_fp8_f32(d.z * sc, d.w * sc, w, true); o.w = (unsigned)w;
        *(u32x4*)(ws + (which ? WS_VB : WS_UB) + (size_t)(lane >> 3) * (16384 * 128) + (size_t)row * 128 + (lane & 7) * 16) = o;
        if (lane == 0) ((float*)(ws + (which ? WS_VS : WS_US)))[row] = mx * (1.0f / 224.0f);
    }
}

__device__ __forceinline__ int swz(int ob) { return ob ^ (((ob >> 9) & 1) << 5); }
constexpr int G_STAGE = 49152;
__device__ __forceinline__ void gemm_mainloop(f32x4 (&acc)[4][4], const bf16* __restrict__ A, int lda, const bf16* __restrict__ Bt, int ldb, int K, int m0, int n0, unsigned char* lds) {
    const int tid = threadIdx.x, lane = tid & 63, wid = tid >> 6, wm = wid >> 1, wn = wid & 1, fr = lane & 15, fq = lane >> 4;
    const int lrow = tid >> 3, lc = tid & 7;
    const bf16* ag = A + (size_t)(m0 + lrow) * lda + lc * 8;
    const bf16* bg = Bt + (size_t)(n0 + lrow) * ldb + lc * 8;
    const int woff = ((lrow >> 4) * 2 + (lc >> 2)) * 1024 + swz((lrow & 15) * 64 + (lc & 3) * 16);
    const int roff = swz(fr * 64 + fq * 16);
    const int nk = K >> 6;
    u32x4 ra0[4], rb0[2], ra1[4], rb1[2];
#define GM_LOAD(ra, rb, kt) { _Pragma("unroll") for (int i = 0; i < 4; ++i) ra[i] = *(const u32x4*)(ag + (size_t)i * 64 * lda + (kt) * 64); \
                              _Pragma("unroll") for (int i = 0; i < 2; ++i) rb[i] = *(const u32x4*)(bg + (size_t)i * 64 * ldb + (kt) * 64); }
#define GM_STORE(ra, rb, buf) { _Pragma("unroll") for (int i = 0; i < 4; ++i) *(u32x4*)((buf) + woff + i * 8192) = ra[i]; \
                                _Pragma("unroll") for (int i = 0; i < 2; ++i) *(u32x4*)((buf) + 32768 + woff + i * 8192) = rb[i]; }
#define GM_COMPUTE(cur) { _Pragma("unroll") for (int s = 0; s < 2; ++s) { bf16x8 af[4], bfr[4]; \
        _Pragma("unroll") for (int i = 0; i < 4; ++i) af[i] = *(const bf16x8*)((cur) + ((wm * 4 + i) * 2 + s) * 1024 + roff); \
        _Pragma("unroll") for (int i = 0; i < 4; ++i) bfr[i] = *(const bf16x8*)((cur) + 32768 + ((wn * 4 + i) * 2 + s) * 1024 + roff); \
        _Pragma("unroll") for (int mi = 0; mi < 4; ++mi) _Pragma("unroll") for (int ni = 0; ni < 4; ++ni) acc[mi][ni] = __builtin_amdgcn_mfma_f32_16x16x32_bf16(bfr[ni], af[mi], acc[mi][ni], 0, 0, 0); } }
    unsigned char* buf0 = lds; unsigned char* buf1 = lds + G_STAGE;
    GM_LOAD(ra0, rb0, 0)
    GM_LOAD(ra1, rb1, 1)
    GM_STORE(ra0, rb0, buf0)
    __syncthreads();
    for (int kt = 0; kt < nk; kt += 2) {
        { const int kp = (kt + 2 < nk) ? kt + 2 : kt; GM_LOAD(ra0, rb0, kp) }
        GM_COMPUTE(buf0)
        GM_STORE(ra1, rb1, buf1)
        __syncthreads();
        { const int kp = (kt + 3 < nk) ? kt + 3 : kt + 1; GM_LOAD(ra1, rb1, kp) }
        GM_COMPUTE(buf1)
        if (kt + 2 < nk) GM_STORE(ra0, rb0, buf0)
        __syncthreads();
    }
}
__device__ __forceinline__ void acc_zero(f32x4 (&acc)[4][4]) {
#pragma unroll
    for (int i = 0; i < 4; ++i)
#pragma unroll
        for (int j = 0; j < 4; ++j) acc[i][j] = (f32x4){0.f, 0.f, 0.f, 0.f};
}
namespace pg8 {
#define PG8_LAS __attribute__((address_space(3)))
typedef unsigned short bf16_t;
typedef short bf16x8 __attribute__((ext_vector_type(8)));
typedef float f32x4 __attribute__((ext_vector_type(4)));
typedef unsigned u32x4 __attribute__((ext_vector_type(4)));
constexpr int BM = 256, BK = 64, HALF = 128, HTB = HALF * BK * 2  , STAGE_BYTES = 8 * HTB, NXCD = 8, WGM = 8;

__host__ __device__ __forceinline__ int lds_byte(int r, int c) { const int st = (r >> 4) * 2 + (c >> 5), rr = r & 15, cc = c & 31, ob = rr * 64 + cc * 2; return st * 1024 + (ob ^ (((ob >> 9) & 1) << 5)); }
__host__ __device__ __forceinline__ void stage_rc(int b, int& R, int& C) { const int st = b / 1024, sb = b % 1024, swz = sb ^ (((sb >> 9) & 1) << 5); R = (st >> 1) * 16 + swz / 64; C = (st & 1) * 32 + (swz % 64) / 2; }
__host__ __device__ __forceinline__ int perm32(int rho) { const int n = rho >> 4, i = rho & 15; return 8 * (i >> 2) + 4 * n + (i & 3); }

struct Unit { int pm, pn; };
struct Gemm { const bf16_t* A; const bf16_t* Bt; int M, N, K; };

struct StaticOrder {
    int nM, nN, nwg, G, c;
    __host__ __device__ void init(int M, int N, int G_, int c_) { nM = M / BM; nN = N / BM; nwg = nM * nN; G = G_; c = c_; }
    __host__ __device__ bool next(int i, Unit& u) const {
        const long L = (long)i * G + c; if (L >= nwg) return false;
        int wgid = (int)L; { const int q = nwg / NXCD, r = nwg % NXCD, xcd = wgid % NXCD, off = wgid / NXCD; wgid = (xcd < r ? xcd * (q + 1) : r * (q + 1) + (xcd - r) * q) + off; }
        const int nig = WGM * nN, gid = wgid / nig, fm = gid * WGM, gsz = (nM - fm) < WGM ? (nM - fm) : WGM;
        u.pm = fm + ((wgid % nig) % gsz); u.pn = (wgid % nig) / gsz; return true;
    }
    __device__ __forceinline__ void a_ready(const Unit&) const {}
    __device__ __forceinline__ void done(const Unit&) const {}
};

__device__ __forceinline__ unsigned pk2b(float lo, float hi) { typedef __bf16 b2 __attribute__((ext_vector_type(2))); b2 v = { (__bf16)lo, (__bf16)hi }; return __builtin_bit_cast(unsigned, v); }
typedef unsigned u32x2 __attribute__((ext_vector_type(2)));
struct EpiStoreBf16 {
    static constexpr bool PERM = false, AFTER_DRAIN = false;
    bf16_t* C; int ldc; int ncols;
    __device__ __forceinline__ void operator()(const f32x4 (&acc)[2][2][4][2], const Unit& u, int wr, int wc, int fr, int fq) const {
#pragma unroll
        for (int ai = 0; ai < 2; ++ai)
#pragma unroll
            for (int m = 0; m < 4; ++m) { bf16_t* rowp = C + (size_t)(u.pm * BM + ai * HALF + wr * 64 + m * 16 + fr) * ldc;
#pragma unroll
                for (int bj = 0; bj < 2; ++bj)
#pragma unroll
                    for (int n = 0; n < 2; ++n) { const int col = u.pn * BM + bj * HALF + wc * 32 + n * 16 + fq * 4;
                        if (col < ncols) { u32x2 w; w.x = pk2b(acc[ai][bj][m][n][0], acc[ai][bj][m][n][1]); w.y = pk2b(acc[ai][bj][m][n][2], acc[ai][bj][m][n][3]); *(u32x2*)(rowp + col) = w; } } }
    }
};
struct EpiResidF32 {
    static constexpr bool PERM = false, AFTER_DRAIN = false;
    const float* X; float* O; int ld; int pad;
    __device__ __forceinline__ void operator()(const f32x4 (&acc)[2][2][4][2], const Unit& u, int wr, int wc, int fr, int fq) const {
#pragma unroll
        for (int ai = 0; ai < 2; ++ai)
#pragma unroll
            for (int m = 0; m < 4; ++m) { const size_t ro = (size_t)(u.pm * BM + ai * HALF + wr * 64 + m * 16 + fr) * ld;
#pragma unroll
                for (int bj = 0; bj < 2; ++bj)
#pragma unroll
                    for (int n = 0; n < 2; ++n) { const size_t idx = ro + u.pn * BM + bj * HALF + wc * 32 + n * 16 + fq * 4; *(f32x4*)(O + idx) = *(const f32x4*)(X + idx) + acc[ai][bj][m][n]; } }
    }
};
struct EpiFinalGate {
    static constexpr bool PERM = false, AFTER_DRAIN = false;
    const bf16_t* PL; const float* SSQ; float* O; int ld; int ntok; float eps; int pad;
    __device__ __forceinline__ void operator()(const f32x4 (&acc)[2][2][4][2], const Unit& u, int wr, int wc, int fr, int fq) const {
#pragma unroll
        for (int ai = 0; ai < 2; ++ai)
#pragma unroll
            for (int m = 0; m < 4; ++m) { const int row = u.pm * BM + ai * HALF + wr * 64 + m * 16 + fr; const size_t ro = (size_t)row * ld;
                float tot = 0.f;
#pragma unroll
                for (int x = 0; x < 8; ++x) tot += SSQ[(size_t)x * ntok + row];
                const float rs = 1.0f / sqrtf(tot * (1.0f / 1024.0f) + eps);
#pragma unroll
                for (int bj = 0; bj < 2; ++bj)
#pragma unroll
                    for (int n = 0; n < 2; ++n) { const size_t idx = ro + u.pn * BM + bj * HALF + wc * 32 + n * 16 + fq * 4;
                        const u32x2 pw = *(const u32x2*)(PL + idx); const unsigned px = pw.x, py = pw.y;
                        f32x4 pv; pv.x = __uint_as_float(px << 16); pv.y = __uint_as_float(px & 0xffff0000u); pv.z = __uint_as_float(py << 16); pv.w = __uint_as_float(py & 0xffff0000u);
                        f32x4 g;
#pragma unroll
                        for (int e = 0; e < 4; ++e) g[e] = 1.0f / (1.0f + __expf(-rs * acc[ai][bj][m][n][e]));
                        *(f32x4*)(O + idx) = *(const f32x4*)(O + idx) + pv * g; } }
    }
};

template <class Epi, class Sched, bool ALIGN_EPI = false, bool SP2 = false>
__device__ __forceinline__ void gemm_phase(PG8_LAS unsigned char* lds, const Gemm g, const Sched& S, const Epi& E) {
    const int tid = threadIdx.x, wid = __builtin_amdgcn_readfirstlane(tid >> 6), lane = tid & 63, wr = wid >> 2, wc = wid & 3, fr = lane & 15, fq = lane >> 4;
    const int K = g.K, nt = K / BK;
    unsigned voffA[2], voffB[2];
#pragma unroll
    for (int i = 0; i < 2; ++i) { int R, C; stage_rc(tid * 16 + i * 8192, R, C); const int Rb = Epi::PERM ? ((R & ~31) + perm32(R & 31)) : R;
        voffA[i] = (unsigned)(R * K + C) * 2u; voffB[i] = (unsigned)(Rb * K + C) * 2u; }
    const size_t kstep = (size_t)(BK * 2);
    const size_t hstep = (size_t)HALF * K * 2;
    const size_t tstep = 2 * hstep;
    const unsigned ldsw = (unsigned)wid * 1024u;
    const int aoff = lds_byte(wr * 64 + fr, fq * 8), boff = lds_byte(wc * 32 + fr, fq * 8);
#define PG8_SA(b, h) (((b) * 2 + (h)) * HTB)
#define PG8_SB(b, h) ((4 + (b) * 2 + (h)) * HTB)
#define PG8_STAGE(bufoff, gbase, voff) do { _Pragma("unroll") for (int _i = 0; _i < 2; ++_i) \
        __builtin_amdgcn_global_load_lds((const unsigned*)((const char*)(gbase) + (voff)[_i]), (PG8_LAS unsigned*)(lds + (bufoff) + ldsw + _i * 8192), 16, 0, 0); } while (0)
#define PG8_LDA(dst, b, h) do { _Pragma("unroll") for (int m = 0; m < 4; ++m) _Pragma("unroll") for (int k = 0; k < 2; ++k) dst[m][k] = *(const PG8_LAS bf16x8*)(lds + PG8_SA(b, h) + aoff + m * 2048 + k * 1024); } while (0)
#define PG8_LDB(dst, b, h) do { _Pragma("unroll") for (int n = 0; n < 2; ++n) _Pragma("unroll") for (int k = 0; k < 2; ++k) dst[n][k] = *(const PG8_LAS bf16x8*)(lds + PG8_SB(b, h) + boff + n * 2048 + k * 1024); } while (0)
#define PG8_MMA(ai, bj, At, Bt) do { __builtin_amdgcn_s_setprio(1); _Pragma("unroll") for (int m = 0; m < 4; ++m) _Pragma("unroll") for (int n = 0; n < 2; ++n) _Pragma("unroll") for (int k = 0; k < 2; ++k) \
        acc[ai][bj][m][n] = __builtin_amdgcn_mfma_f32_16x16x32_bf16(Bt[n][k], At[m][k], acc[ai][bj][m][n], 0, 0, 0); __builtin_amdgcn_s_setprio(0); } while (0)
#define PG8_WAIT_V(n) asm volatile("s_waitcnt vmcnt(" #n ")" ::: "memory")
#define PG8_WAIT_L(n) asm volatile("s_waitcnt lgkmcnt(" #n ")" ::: "memory")
#define PG8_BAR __builtin_amdgcn_s_barrier()
#define PG8_SCHED __builtin_amdgcn_sched_barrier(0)
    Unit cur, nxt; int ui = 0;
    if (!S.next(0, cur)) return;
    f32x4 acc[2][2][4][2];
#pragma unroll
    for (int a = 0; a < 2; ++a)
#pragma unroll
        for (int b = 0; b < 2; ++b)
#pragma unroll
            for (int m = 0; m < 4; ++m)
#pragma unroll
                for (int n = 0; n < 2; ++n) acc[a][b][m][n] = (f32x4){0.f, 0.f, 0.f, 0.f};
    bf16x8 At[4][2], B0[2][2], B1[2][2];
    const char* cA = (const char*)g.A + (size_t)cur.pm * tstep; const char* cB = (const char*)g.Bt + (size_t)cur.pn * tstep;
    S.a_ready(cur);
    if constexpr (SP2) {
        PG8_STAGE(PG8_SB(0, 0), cB, voffB); PG8_STAGE(PG8_SB(0, 1), cB + hstep, voffB); PG8_STAGE(PG8_SA(0, 0), cA, voffA); PG8_STAGE(PG8_SA(0, 1), cA + hstep, voffA);
        if (wr == 1) PG8_BAR;
        PG8_WAIT_V(2); PG8_BAR;
        PG8_STAGE(PG8_SB(1, 0), cB + kstep, voffB); PG8_STAGE(PG8_SA(1, 0), cA + kstep, voffA); PG8_STAGE(PG8_SB(1, 1), cB + hstep + kstep, voffB);
        PG8_WAIT_V(6); PG8_BAR;
    } else {
        PG8_STAGE(PG8_SB(0, 0), cB, voffB); PG8_STAGE(PG8_SA(0, 0), cA, voffA); PG8_STAGE(PG8_SB(0, 1), cB + hstep, voffB); PG8_STAGE(PG8_SA(0, 1), cA + hstep, voffA);
        if (wr == 1) PG8_BAR;
        PG8_WAIT_V(4); PG8_BAR;
        PG8_STAGE(PG8_SB(1, 0), cB + kstep, voffB); PG8_STAGE(PG8_SA(1, 0), cA + kstep, voffA); PG8_STAGE(PG8_SB(1, 1), cB + hstep + kstep, voffB);
        PG8_WAIT_V(6); PG8_BAR;
    }
    for (;;) {
        const bool has_next = S.next(ui + 1, nxt);
        const char* nA = has_next ? (const char*)g.A + (size_t)nxt.pm * tstep : cA; const char* nB = has_next ? (const char*)g.Bt + (size_t)nxt.pn * tstep : cB;
        for (int t = 0; t < nt; t += 2) {
            const bool last = (t == nt - 2);
            const char* a1 = cA + (size_t)(t + 1) * kstep;
            const char* a2 = last ? nA : cA + (size_t)(t + 2) * kstep; const char* b2 = last ? nB : cB + (size_t)(t + 2) * kstep;
            const char* a3 = a2 + kstep; const char* b3 = b2 + kstep;
            if (last && has_next) S.a_ready(nxt);
            if constexpr (SP2) {
            PG8_LDB(B0, 0, 0); PG8_LDB(B1, 0, 1); PG8_SCHED; PG8_LDA(At, 0, 0); PG8_STAGE(PG8_SA(1, 1), a1 + hstep, voffA);
            PG8_WAIT_V(8); PG8_WAIT_L(0); PG8_BAR; PG8_MMA(0, 0, At, B0); PG8_MMA(0, 1, At, B1); PG8_BAR; PG8_SCHED;
            PG8_LDA(At, 0, 1); PG8_STAGE(PG8_SB(0, 0), b2, voffB); PG8_STAGE(PG8_SB(0, 1), b2 + hstep, voffB); PG8_STAGE(PG8_SA(0, 0), a2, voffA);
            PG8_WAIT_V(8); PG8_WAIT_L(0); PG8_BAR; PG8_MMA(1, 0, At, B0); PG8_MMA(1, 1, At, B1); PG8_BAR; PG8_SCHED;
            PG8_LDB(B0, 1, 0); PG8_LDB(B1, 1, 1); PG8_SCHED; PG8_LDA(At, 1, 0); PG8_STAGE(PG8_SA(0, 1), a2 + hstep, voffA);
            PG8_WAIT_V(8); PG8_WAIT_L(0); PG8_BAR; PG8_MMA(0, 0, At, B0); PG8_MMA(0, 1, At, B1); PG8_BAR; PG8_SCHED;
            PG8_LDA(At, 1, 1); PG8_STAGE(PG8_SB(1, 0), b3, voffB); PG8_STAGE(PG8_SB(1, 1), b3 + hstep, voffB); PG8_STAGE(PG8_SA(1, 0), a3, voffA);
            PG8_WAIT_V(8); PG8_WAIT_L(0); PG8_BAR; PG8_MMA(1, 0, At, B0); PG8_MMA(1, 1, At, B1); PG8_BAR; PG8_SCHED;
            } else {
            PG8_LDB(B0, 0, 0); PG8_SCHED; PG8_LDA(At, 0, 0); PG8_STAGE(PG8_SA(1, 1), a1 + hstep, voffA);
            PG8_WAIT_L(8); PG8_BAR; PG8_WAIT_L(0); PG8_MMA(0, 0, At, B0); PG8_BAR; PG8_SCHED;
            PG8_LDB(B1, 0, 1); PG8_STAGE(PG8_SB(0, 0), b2, voffB);
            PG8_BAR; PG8_WAIT_L(0); PG8_MMA(0, 1, At, B1); PG8_BAR;
            PG8_LDA(At, 0, 1); PG8_STAGE(PG8_SA(0, 0), a2, voffA);
            PG8_BAR; PG8_WAIT_L(0); PG8_MMA(1, 0, At, B0); PG8_BAR; PG8_SCHED;
            PG8_STAGE(PG8_SB(0, 1), b2 + hstep, voffB);
            PG8_WAIT_V(6); PG8_BAR; PG8_MMA(1, 1, At, B1); PG8_BAR;
            PG8_LDB(B0, 1, 0); PG8_SCHED; PG8_LDA(At, 1, 0); PG8_STAGE(PG8_SA(0, 1), a2 + hstep, voffA);
            PG8_WAIT_L(8); PG8_BAR; PG8_WAIT_L(0); PG8_MMA(0, 0, At, B0); PG8_BAR; PG8_SCHED;
            PG8_LDB(B1, 1, 1); PG8_STAGE(PG8_SB(1, 0), b3, voffB);
            PG8_BAR; PG8_WAIT_L(0); PG8_MMA(0, 1, At, B1); PG8_BAR;
            PG8_LDA(At, 1, 1); PG8_STAGE(PG8_SA(1, 0), a3, voffA);
            PG8_BAR; PG8_WAIT_L(0); PG8_MMA(1, 0, At, B0); PG8_BAR; PG8_SCHED;
            PG8_STAGE(PG8_SB(1, 1), b3 + hstep, voffB);
            PG8_WAIT_V(6); PG8_BAR; PG8_MMA(1, 1, At, B1); PG8_BAR;
            }
        }
        if constexpr (ALIGN_EPI) { if (wr == 0) PG8_BAR; }
        if constexpr (!Epi::AFTER_DRAIN) { E(acc, cur, wr, wc, fr, fq); S.done(cur); }
        if (!has_next) break;
#pragma unroll
        for (int a = 0; a < 2; ++a)
#pragma unroll
            for (int b = 0; b < 2; ++b)
#pragma unroll
                for (int m = 0; m < 4; ++m)
#pragma unroll
                    for (int n = 0; n < 2; ++n) acc[a][b][m][n] = (f32x4){0.f, 0.f, 0.f, 0.f};
        cur = nxt; cA = nA; cB = nB; ++ui;
        if constexpr (ALIGN_EPI) { if (wr == 1) PG8_BAR; }
    }
    PG8_WAIT_V(0);
    if constexpr (!ALIGN_EPI) { if (wr == 0) PG8_BAR; }
    PG8_BAR;
    if constexpr (Epi::AFTER_DRAIN) { E.fused(acc, cur, wr, wc, fr, fq, lds, wid, lane); S.done(cur); }
#undef PG8_SA
#undef PG8_SB
#undef PG8_STAGE
#undef PG8_LDA
#undef PG8_LDB
#undef PG8_MMA
#undef PG8_WAIT_V
#undef PG8_WAIT_L
#undef PG8_BAR
#undef PG8_SCHED
}
}

__device__ __forceinline__ void phase1(const Params& p, unsigned char* lds) {
    pg8::Gemm g{(const bf16*)(p.ws + WS_ACT), (const bf16*)(p.ws + WS_WINT), NTOK, 3584, D}; pg8::StaticOrder S; S.init(NTOK, 3584, (int)gridDim.x, (int)blockIdx.x);
    pg8::EpiStoreBf16 E{(bf16*)(p.ws + WS_PROJ), PS, DIN};
    pg8::gemm_phase<pg8::EpiStoreBf16, pg8::StaticOrder, true, true>((PG8_LAS unsigned char*)lds, g, S, E);
}


__device__ __forceinline__ void phase5(const Params& p, unsigned char* lds) {
    pg8::Gemm g{(const bf16*)(p.ws + WS_ACT), (const bf16*)(p.ws + WS_WOUTT), NTOK, D, D}; pg8::StaticOrder S; S.init(NTOK, D, (int)gridDim.x, (int)blockIdx.x);
    pg8::EpiResidF32 E{p.in[0], p.out, D, 0};
    pg8::gemm_phase<pg8::EpiResidF32, pg8::StaticOrder, true, true>((PG8_LAS unsigned char*)lds, g, S, E);
}
__device__ __forceinline__ void phase6(const Params& p, unsigned char* lds) {
    const int gw = (blockIdx.x * NTHR + threadIdx.x) >> 6, ngw = (gridDim.x * NTHR) >> 6, lane = threadIdx.x & 63;
    for (int m = gw; m < NTOK; m += ngw) rms_row_bf16(p.out + (size_t)m * D, p.in[13], (bf16*)(p.ws + WS_ACT) + (size_t)m * D, lane);
}
__device__ __forceinline__ void phase7(const Params& p, unsigned char* lds) {
    pg8::Gemm g{(const bf16*)(p.ws + WS_ACT), (const bf16*)(p.ws + WS_WQT), NTOK, 2048, D}; pg8::StaticOrder S; S.init(NTOK, 2048, (int)gridDim.x, (int)blockIdx.x);
    pg8::EpiStoreBf16 E{(bf16*)(p.ws + WS_PROJ), 2048, 2048};
    pg8::gemm_phase<pg8::EpiStoreBf16, pg8::StaticOrder, true, true>((PG8_LAS unsigned char*)lds, g, S, E);
}
__device__ __forceinline__ void phase10(const Params& p, unsigned char* lds) {
    {
        pg8::Gemm g{(const bf16*)(p.ws + WS_PB), (const bf16*)(p.ws + WS_WPT), NTOK, D, 256}; pg8::StaticOrder S; S.init(NTOK, D, (int)gridDim.x, (int)blockIdx.x);
        pg8::EpiStoreBf16 E{(bf16*)(p.ws + WS_ACT), D, D};
        pg8::gemm_phase<pg8::EpiStoreBf16, pg8::StaticOrder, true, true>((PG8_LAS unsigned char*)lds, g, S, E);
    }
    {
        pg8::Gemm g{(const bf16*)(p.ws + WS_PROJ + 64 * MiB), (const bf16*)(p.ws + WS_WGT), NTOK, D, D}; pg8::StaticOrder S; S.init(NTOK, D, (int)gridDim.x, (int)blockIdx.x);
        pg8::EpiFinalGate E{(const bf16*)(p.ws + WS_ACT), (const float*)(p.ws + WS_SSQ), p.out, D, NTOK, EPS, 0};
        pg8::gemm_phase<pg8::EpiFinalGate, pg8::StaticOrder, true, true>((PG8_LAS unsigned char*)lds, g, S, E);
    }
}

typedef __bf16 bf16x2v __attribute__((ext_vector_type(2)));
template <int CTRL> __device__ __forceinline__ float dpp_f(float v) { return __int_as_float(__builtin_amdgcn_update_dpp(0, __float_as_int(v), CTRL, 0xF, 0xF, false)); }
__device__ __forceinline__ float grp16_max(float v) { v = fmaxf(v, dpp_f<0xB1>(v)); v = fmaxf(v, dpp_f<0x4E>(v)); v = fmaxf(v, dpp_f<0x141>(v)); v = fmaxf(v, dpp_f<0x140>(v)); return v; }
__device__ __forceinline__ float grp16_sum(float v) { v += dpp_f<0xB1>(v); v += dpp_f<0x4E>(v); v += dpp_f<0x141>(v); v += dpp_f<0x140>(v); return v; }
#define CE_DESC(a, b) { const float _hi = fmaxf(a, b), _lo = fminf(a, b); a = _hi; b = _lo; }
__device__ __forceinline__ float grp16_top16(float (&v)[8], int lig) {
    CE_DESC(v[0], v[1]) CE_DESC(v[2], v[3]) CE_DESC(v[4], v[5]) CE_DESC(v[6], v[7])
    CE_DESC(v[0], v[2]) CE_DESC(v[1], v[3]) CE_DESC(v[4], v[6]) CE_DESC(v[5], v[7])
    CE_DESC(v[1], v[2]) CE_DESC(v[5], v[6])
    CE_DESC(v[0], v[4]) CE_DESC(v[1], v[5]) CE_DESC(v[2], v[6]) CE_DESC(v[3], v[7])
    CE_DESC(v[2], v[4]) CE_DESC(v[3], v[5])
    CE_DESC(v[1], v[2]) CE_DESC(v[3], v[4]) CE_DESC(v[5], v[6])
    float top = 0.f;
#pragma unroll
    for (int r = 0; r < 16; ++r) {
        const float m = grp16_max(v[0]);
        if (lig == r) top = m;
        const bool own = (v[0] == m);
#pragma unroll
        for (int j = 0; j < 7; ++j) v[j] = own ? v[j + 1] : v[j];
        v[7] = own ? -3.0e38f : v[7];
    }
    return top;
}
__device__ __forceinline__ void phase8(const Params& p, unsigned char* lds) {
    const bf16* PQ = (const bf16*)(p.ws + WS_PROJ); const bf16* KB = (const bf16*)(p.ws + WS_KEYB);
    int* ids = (int*)(p.ws + WS_IDS); float* wts = (float*)(p.ws + WS_WTS);
    float* S = (float*)lds;
    const int tid = threadIdx.x, lane = tid & 63, wid = tid >> 6, lig = tid & 15, gbase = lane & 48;
    for (int item = blockIdx.x; item < 2048; item += gridDim.x) {
        const int tok0 = (item >> 3) * 64, h = item & 7;
        {
            const int c = wid >> 2, key0 = (wid & 3) * 32, r = lane & 31, hh = lane >> 5;
            f32x16 acc0, acc1;
#pragma unroll
            for (int i = 0; i < 16; ++i) { acc0[i] = 0.f; acc1[i] = 0.f; }
            const bf16* bq = KB + ((size_t)(h * 2 + c) * 128 + key0 + r) * 128 + hh * 8;
            const bf16* aq0 = PQ + (size_t)(tok0 + r) * 2048 + h * 256 + c * 128 + hh * 8;
            const bf16* aq1 = aq0 + (size_t)32 * 2048;
#pragma unroll
            for (int s = 0; s < 8; ++s) {
                const bf16x8 b = *(const bf16x8*)(bq + s * 16), a0 = *(const bf16x8*)(aq0 + s * 16), a1 = *(const bf16x8*)(aq1 + s * 16);
                acc0 = __builtin_amdgcn_mfma_f32_32x32x16_bf16(a0, b, acc0, 0, 0, 0);
                acc1 = __builtin_amdgcn_mfma_f32_32x32x16_bf16(a1, b, acc1, 0, 0, 0);
            }
#pragma unroll
            for (int i = 0; i < 16; ++i) { const int tl = (i & 3) + 8 * (i >> 2) + 4 * hh; S[(c * 64 + tl) * 132 + key0 + r] = acc0[i]; S[(c * 64 + 32 + tl) * 132 + key0 + r] = acc1[i]; }
        }
        __syncthreads();
#pragma unroll 1
        for (int rd = 0; rd < 2; ++rd) {
            const int tl = (tid >> 4) + 32 * rd;
            float ts[2];
#pragma unroll
            for (int c = 0; c < 2; ++c) {
                float v[8];
                const f32x4 lo = *(const f32x4*)(S + (c * 64 + tl) * 132 + lig * 8), hi = *(const f32x4*)(S + (c * 64 + tl) * 132 + lig * 8 + 4);
                v[0] = lo.x; v[1] = lo.y; v[2] = lo.z; v[3] = lo.w; v[4] = hi.x; v[5] = hi.y; v[6] = hi.z; v[7] = hi.w;
#pragma unroll
                for (int j = 0; j < 8; ++j) v[j] = __uint_as_float((__float_as_uint(v[j]) & ~127u) | (unsigned)(lig * 8 + j));
                ts[c] = grp16_top16(v, lig);
            }
            const float t0 = ts[0], t1 = ts[1];
            int bp = 0; float my_s = 0.f; int my_eid = 0;
#pragma unroll 1
            for (int r = 0; r < 16; ++r) {
                const float other = __shfl(t1, gbase + (bp < 15 ? bp : 15));
                const float sum = t0 + other;
                const float head = (bp >= 16) ? -3.0e38f : __uint_as_float((__float_as_uint(sum) & ~15u) | (unsigned)lig);
                const int cur_eid = (int)(((__float_as_uint(t0) & 127u) << 7) | (__float_as_uint(other) & 127u));
                const float m = grp16_max(head);
                const int owner = (int)(__float_as_uint(m) & 15u);
                const int ew = __shfl(cur_eid, gbase + owner);
                if (lig == r) { my_s = m; my_eid = ew; }
                if (lig == owner) ++bp;
            }
            const float mx = grp16_max(my_s);
            const float e = __expf(my_s - mx);
            const float sm = grp16_sum(e);
            const size_t o = (size_t)(tok0 + tl) * 128 + h * 16 + lig;
            ids[o] = my_eid; wts[o] = e / sm;
        }
        __syncthreads();
    }
}

__device__ __forceinline__ void hgrn_pre_item(const Params& p, unsigned char* lds, int ci) {
    const int tid = threadIdx.x, lane = tid & 63, wid = tid >> 6, k = tid & 127, tq = tid >> 7;
    const int n = ci & 127, h = (ci >> 7) & 3, b = ci >> 9, tok0 = b * T + n * 64;
    bf16* proj = (bf16*)(p.ws + WS_PROJ);
    float* OB = p.out; bf16* KIT = (bf16*)((unsigned char*)p.out + OUT_KIT) + (size_t)ci * 8192; bf16* VTg = (bf16*)((unsigned char*)p.out + OUT_VT) + (size_t)ci * 8192;
    float* DEC = (float*)(p.ws + WS_DEC) + (size_t)ci * 128;
    bf16* QT = (bf16*)lds; bf16* KT = (bf16*)(lds + 17408); bf16* VTl = (bf16*)(lds + 34816); bf16* AM = (bf16*)(lds + 53248);
    float* part = (float*)(lds + 62464); float* gref = (float*)(lds + 64512);
    float lb; { const float l0 = p.in[4][h * 128 + k], l1 = p.in[4][512 + h * 128 + k]; const float m = fmaxf(l0, l1); const float e0 = __expf(l0 - m), e1 = __expf(l1 - m); lb = e0 / (e0 + e1); }
    float G[16], key[16], qv[16], vv[16];
    {
        float c = 0.f;
#pragma unroll
        for (int i = 0; i < 16; ++i) {
            const size_t row = (size_t)(tok0 + tq * 16 + i) * PS;
            const float fg = lb + (1.0f - lb) * sigmoidf_(bf2f(proj[row + C_HF + h * 128 + k]));
            key[i] = 1.0f - fg; c += __logf(fg); G[i] = c;
            qv[i] = siluf_(bf2f(proj[row + C_HQ + h * 128 + k])) * 0.08838834764831845f;
            vv[i] = bf2f(proj[row + C_HI + h * 128 + k]);
        }
        part[tq * 128 + k] = c;
    }
    __syncthreads();
    {
        float off = 0.f;
#pragma unroll
        for (int j = 0; j < 3; ++j) off += (j < tq) ? part[j * 128 + k] : 0.f;
#pragma unroll
        for (int i = 0; i < 16; ++i) G[i] += off;
        if (tq == 1) gref[k] = G[15];
        if (tq == 3) gref[128 + k] = G[15];
    }
    __syncthreads();
    {
        const float gr = gref[k], gl = gref[128 + k];
        const int kpos = (k & ~31) | (((k >> 2) & 3) << 3) | (((k >> 4) & 1) << 2) | (k & 3);
        unsigned kp[8], vp[8];
#pragma unroll
        for (int i = 0; i < 16; i += 2) {
            kp[i >> 1] = pk2(key[i] * __expf(gl - G[i]), key[i + 1] * __expf(gl - G[i + 1]));
            vp[i >> 1] = pk2(vv[i], vv[i + 1]);
        }
#pragma unroll
        for (int i = 0; i < 16; ++i) {
            const int t = tq * 16 + i;
            QT[t * 136 + k] = f2bf(qv[i] * __expf(G[i] - gr));
            KT[t * 136 + k] = f2bf(key[i] * __expf(gr - G[i]));
            proj[(size_t)(tok0 + t) * PS + C_HQ + h * 128 + kpos] = f2bf(qv[i] * __expf(G[i]));
        }
        u32x4 a0, a1, b0, b1; a0.x = kp[0]; a0.y = kp[1]; a0.z = kp[2]; a0.w = kp[3]; a1.x = kp[4]; a1.y = kp[5]; a1.z = kp[6]; a1.w = kp[7];
        b0.x = vp[0]; b0.y = vp[1]; b0.z = vp[2]; b0.w = vp[3]; b1.x = vp[4]; b1.y = vp[5]; b1.z = vp[6]; b1.w = vp[7];
        *(u32x4*)(KIT + k * 64 + tq * 16) = a0; *(u32x4*)(KIT + k * 64 + tq * 16 + 8) = a1;
        *(u32x4*)(VTg + k * 64 + tq * 16) = b0; *(u32x4*)(VTg + k * 64 + tq * 16 + 8) = b1;
        *(u32x4*)(VTl + k * 72 + tq * 16) = b0; *(u32x4*)(VTl + k * 72 + tq * 16 + 8) = b1;
        if (tq == 3) DEC[k] = __expf(gl);
    }
    __syncthreads();
    const int fr = lane & 15, fq = lane >> 4;
    {
        const int tt = wid >> 1;
#pragma unroll
        for (int e = 0; e < 2; ++e) {
            const int st = 2 * (wid & 1) + e;
            f32x4 acc = (f32x4){0.f, 0.f, 0.f, 0.f};
            if (st <= tt) {
#pragma unroll
                for (int s = 0; s < 4; ++s) {
                    const bf16x8 a = *(const bf16x8*)(QT + (tt * 16 + fr) * 136 + s * 32 + fq * 8), bb = *(const bf16x8*)(KT + (st * 16 + fr) * 136 + s * 32 + fq * 8);
                    acc = __builtin_amdgcn_mfma_f32_16x16x32_bf16(a, bb, acc, 0, 0, 0);
                }
            }
#pragma unroll
            for (int r = 0; r < 4; ++r) { const int t = tt * 16 + fq * 4 + r, sp = st * 16 + fr; AM[t * 72 + sp] = f2bf(sp <= t ? acc[r] : 0.f); }
        }
    }
    __syncthreads();
    {
        const int tt = wid >> 1;
        const bf16x8 a0 = *(const bf16x8*)(AM + (tt * 16 + fr) * 72 + fq * 8), a1 = *(const bf16x8*)(AM + (tt * 16 + fr) * 72 + 32 + fq * 8);
#pragma unroll
        for (int e = 0; e < 4; ++e) {
            const int vt = (wid & 1) * 4 + e;
            const bf16x8 b0 = *(const bf16x8*)(VTl + (vt * 16 + fr) * 72 + fq * 8), b1 = *(const bf16x8*)(VTl + (vt * 16 + fr) * 72 + 32 + fq * 8);
            f32x4 acc = (f32x4){0.f, 0.f, 0.f, 0.f};
            acc = __builtin_amdgcn_mfma_f32_16x16x32_bf16(a0, b0, acc, 0, 0, 0);
            acc = __builtin_amdgcn_mfma_f32_16x16x32_bf16(a1, b1, acc, 0, 0, 0);
#pragma unroll
            for (int r = 0; r < 4; ++r) OB[(size_t)(tok0 + tt * 16 + fq * 4 + r) * 512 + h * 128 + vt * 16 + fr] = acc[r];
        }
    }
    __syncthreads();
}
template <bool DUMMY>
__device__ __forceinline__ void hgrn_scan_item(const Params& p, int wi) {
    const int lane = threadIdx.x & 63, fr = lane & 15, fq = lane >> 4;
    const int vs = wi & 7, bh = wi >> 3, h = bh & 3, b = bh >> 2;
    const bf16* proj = (const bf16*)(p.ws + WS_PROJ);
    float* OB = p.out; const bf16* KIT = (const bf16*)((unsigned char*)p.out + OUT_KIT); const bf16* VTg = (const bf16*)((unsigned char*)p.out + OUT_VT);
    const float* DEC = (const float*)(p.ws + WS_DEC);
    f32x4 S[8];
#pragma unroll
    for (int i = 0; i < 8; ++i) S[i] = (f32x4){0.f, 0.f, 0.f, 0.f};
#pragma unroll 1
    for (int n = 0; n < 128; ++n) {
        const int ci = bh * 128 + n, tok0 = b * T + n * 64;
        bf16x8 qf[4][4];
#pragma unroll
        for (int tt = 0; tt < 4; ++tt)
#pragma unroll
            for (int s = 0; s < 4; ++s) qf[tt][s] = *(const bf16x8*)(proj + (size_t)(tok0 + tt * 16 + fr) * PS + C_HQ + h * 128 + s * 32 + fq * 8);
        float oin[4][4];
#pragma unroll
        for (int tt = 0; tt < 4; ++tt)
#pragma unroll
            for (int r = 0; r < 4; ++r) oin[tt][r] = OB[(size_t)(tok0 + tt * 16 + fq * 4 + r) * 512 + h * 128 + vs * 16 + fr];
        bf16x8 Sb[4];
#pragma unroll
        for (int s = 0; s < 4; ++s) {
            u32x4 w; w.x = pk2(S[2 * s][0], S[2 * s][1]); w.y = pk2(S[2 * s][2], S[2 * s][3]); w.z = pk2(S[2 * s + 1][0], S[2 * s + 1][1]); w.w = pk2(S[2 * s + 1][2], S[2 * s + 1][3]);
            Sb[s] = __builtin_bit_cast(bf16x8, w);
        }
#pragma unroll
        for (int tt = 0; tt < 4; ++tt) {
            f32x4 acc = (f32x4){0.f, 0.f, 0.f, 0.f};
#pragma unroll
            for (int s = 0; s < 4; ++s) acc = __builtin_amdgcn_mfma_f32_16x16x32_bf16(qf[tt][s], Sb[s], acc, 0, 0, 0);
#pragma unroll
            for (int r = 0; r < 4; ++r) { const size_t oi = (size_t)(tok0 + tt * 16 + fq * 4 + r) * 512 + h * 128 + vs * 16 + fr; if (DUMMY) ((float*)(p.ws + WS_SPARE))[oi & 0x3fffff] = oin[tt][r] + acc[r]; else OB[oi] = oin[tt][r] + acc[r]; }
        }
        const bf16x8 v0 = *(const bf16x8*)(VTg + (size_t)ci * 8192 + (vs * 16 + fr) * 64 + fq * 8), v1 = *(const bf16x8*)(VTg + (size_t)ci * 8192 + (vs * 16 + fr) * 64 + 32 + fq * 8);
#pragma unroll
        for (int kb = 0; kb < 8; ++kb) {
            const bf16x8 k0 = *(const bf16x8*)(KIT + (size_t)ci * 8192 + (kb * 16 + fr) * 64 + fq * 8), k1 = *(const bf16x8*)(KIT + (size_t)ci * 8192 + (kb * 16 + fr) * 64 + 32 + fq * 8);
            const f32x4 dv = *(const f32x4*)(DEC + (size_t)ci * 128 + kb * 16 + fq * 4);
            f32x4 sacc = S[kb] * dv;
            sacc = __builtin_amdgcn_mfma_f32_16x16x32_bf16(k0, v0, sacc, 0, 0, 0);
            sacc = __builtin_amdgcn_mfma_f32_16x16x32_bf16(k1, v1, sacc, 0, 0, 0);
            S[kb] = sacc;
        }
    }
}

__device__ __forceinline__ void hgrn_scan_block(const Params& p, unsigned char* lds, int bh) {
    const int tid = threadIdx.x, lane = tid & 63, vs = tid >> 6, fr = lane & 15, fq = lane >> 4;
    const int h = bh & 3, b = bh >> 2;
    const bf16* proj = (const bf16*)(p.ws + WS_PROJ);
    float* OB = p.out; const bf16* KIT = (const bf16*)((unsigned char*)p.out + OUT_KIT); const bf16* VTg = (const bf16*)((unsigned char*)p.out + OUT_VT);
    const float* DEC = (const float*)(p.ws + WS_DEC);
    constexpr int BUF = 54784, O_KIT = 17408, O_VT = 17408 + 18432, O_DEC = 17408 + 2 * 18432;
    u32x4 rq[2], rk[2], rv[2], rd;
    float oin[4][4];
    auto issue = [&](int n) {
        const int ci = bh * 128 + n, tok0 = b * T + n * 64;
#pragma unroll
        for (int i = 0; i < 2; ++i) {
            const int id = tid + i * NTHR;
            rq[i] = *(const u32x4*)(proj + (size_t)(tok0 + (id >> 4)) * PS + C_HQ + h * 128 + (id & 15) * 8);
            rk[i] = *(const u32x4*)(KIT + (size_t)ci * 8192 + id * 8);
            rv[i] = *(const u32x4*)(VTg + (size_t)ci * 8192 + id * 8);
        }
        if (tid < 32) rd = *(const u32x4*)(DEC + (size_t)ci * 128 + tid * 4);
    };
    auto stash = [&](unsigned char* buf) {
#pragma unroll
        for (int i = 0; i < 2; ++i) {
            const int id = tid + i * NTHR;
            *(u32x4*)(buf + (id >> 4) * 272 + (id & 15) * 16) = rq[i];
            *(u32x4*)(buf + O_KIT + (id >> 3) * 144 + (id & 7) * 16) = rk[i];
            *(u32x4*)(buf + O_VT + (id >> 3) * 144 + (id & 7) * 16) = rv[i];
        }
        if (tid < 32) *(u32x4*)(buf + O_DEC + tid * 16) = rd;
    };
    auto load_oin = [&](int n) {
        const int tok0 = b * T + n * 64;
#pragma unroll
        for (int tt = 0; tt < 4; ++tt)
#pragma unroll
            for (int r = 0; r < 4; ++r) oin[tt][r] = OB[(size_t)(tok0 + tt * 16 + fq * 4 + r) * 512 + h * 128 + vs * 16 + fr];
    };
    f32x4 S[8];
#pragma unroll
    for (int i = 0; i < 8; ++i) S[i] = (f32x4){0.f, 0.f, 0.f, 0.f};
    issue(0); stash(lds); load_oin(0);
    __syncthreads();
#pragma unroll 1
    for (int n = 0; n < 128; ++n) {
        unsigned char* cur = lds + (n & 1) * BUF; unsigned char* nxt = lds + ((n + 1) & 1) * BUF;
        const int tok0 = b * T + n * 64;
        const int nn = (n + 1 < 128) ? n + 1 : n;
        issue(nn);
        bf16x8 Sb[4];
#pragma unroll
        for (int s = 0; s < 4; ++s) {
            u32x4 w; w.x = pk2(S[2 * s][0], S[2 * s][1]); w.y = pk2(S[2 * s][2], S[2 * s][3]); w.z = pk2(S[2 * s + 1][0], S[2 * s + 1][1]); w.w = pk2(S[2 * s + 1][2], S[2 * s + 1][3]);
            Sb[s] = __builtin_bit_cast(bf16x8, w);
        }
        float ores[4][4];
#pragma unroll
        for (int tt = 0; tt < 4; ++tt) {
            f32x4 acc = (f32x4){0.f, 0.f, 0.f, 0.f};
#pragma unroll
            for (int s = 0; s < 4; ++s) { const bf16x8 qf = *(const bf16x8*)(cur + (tt * 16 + fr) * 272 + (s * 32 + fq * 8) * 2); acc = __builtin_amdgcn_mfma_f32_16x16x32_bf16(qf, Sb[s], acc, 0, 0, 0); }
#pragma unroll
            for (int r = 0; r < 4; ++r) ores[tt][r] = oin[tt][r] + acc[r];
        }
#pragma unroll
        for (int tt = 0; tt < 4; ++tt)
#pragma unroll
            for (int r = 0; r < 4; ++r) OB[(size_t)(tok0 + tt * 16 + fq * 4 + r) * 512 + h * 128 + vs * 16 + fr] = ores[tt][r];
        load_oin(nn);
        const bf16x8 v0 = *(const bf16x8*)(cur + O_VT + (vs * 16 + fr) * 144 + fq * 16), v1 = *(const bf16x8*)(cur + O_VT + (vs * 16 + fr) * 144 + 64 + fq * 16);
#pragma unroll
        for (int kb = 0; kb < 8; ++kb) {
            const bf16x8 k0 = *(const bf16x8*)(cur + O_KIT + (kb * 16 + fr) * 144 + fq * 16), k1 = *(const bf16x8*)(cur + O_KIT + (kb * 16 + fr) * 144 + 64 + fq * 16);
            const f32x4 dv = *(const f32x4*)(cur + O_DEC + (kb * 16 + fq * 4) * 4);
            f32x4 sacc = S[kb] * dv;
            sacc = __builtin_amdgcn_mfma_f32_16x16x32_bf16(k0, v0, sacc, 0, 0, 0);
            sacc = __builtin_amdgcn_mfma_f32_16x16x32_bf16(k1, v1, sacc, 0, 0, 0);
            S[kb] = sacc;
        }
        stash(nxt);
        __syncthreads();
    }
}
__device__ __forceinline__ void phase4(const Params& p, unsigned char* lds) {
    const bf16* proj = (const bf16*)(p.ws + WS_PROJ); const float* OB = p.out; bf16* mixed = (bf16*)(p.ws + WS_ACT); const float* gain = p.in[5];
    const int lane = threadIdx.x & 63, gw = (blockIdx.x * NTHR + threadIdx.x) >> 6, ngw = (gridDim.x * NTHR) >> 6;
    for (int tok = gw; tok < NTOK; tok += ngw) {
        const f32x4 o0 = *(const f32x4*)(OB + (size_t)tok * 512 + lane * 8), o1 = *(const f32x4*)(OB + (size_t)tok * 512 + lane * 8 + 4);
        const u32x4 gp = *(const u32x4*)(proj + (size_t)tok * PS + C_HG + lane * 8);
        const f32x4 g0 = *(const f32x4*)(gain + lane * 8), g1 = *(const f32x4*)(gain + lane * 8 + 4);
        float ss = o0.x * o0.x + o0.y * o0.y + o0.z * o0.z + o0.w * o0.w + o1.x * o1.x + o1.y * o1.y + o1.z * o1.z + o1.w * o1.w;
        ss = grp16_sum(ss);
        const float r = rsqrtf(ss * (1.0f / 128.0f) + EPS);
        const unsigned gx = gp.x, gy = gp.y, gz = gp.z, gw_ = gp.w;
        u32x4 w;
        w.x = pk2(o0.x * r * g0.x * siluf_(__uint_as_float(gx << 16)), o0.y * r * g0.y * siluf_(__uint_as_float(gx & 0xffff0000u)));
        w.y = pk2(o0.z * r * g0.z * siluf_(__uint_as_float(gy << 16)), o0.w * r * g0.w * siluf_(__uint_as_float(gy & 0xffff0000u)));
        w.z = pk2(o1.x * r * g1.x * siluf_(__uint_as_float(gz << 16)), o1.y * r * g1.y * siluf_(__uint_as_float(gz & 0xffff0000u)));
        w.w = pk2(o1.z * r * g1.z * siluf_(__uint_as_float(gw_ << 16)), o1.w * r * g1.w * siluf_(__uint_as_float(gw_ & 0xffff0000u)));
        *(u32x4*)(mixed + (size_t)tok * D + lane * 8) = w;
    }
}

#define WAVE_LDS_SYNC() asm volatile("s_waitcnt lgkmcnt(0)" ::: "memory")
__device__ __forceinline__ void nsa_prep_item(const Params& p, unsigned char* lds, int tile) {
    const int tid = threadIdx.x, lig = tid & 15;
    const int tok0 = tile * 64;
    bf16* proj = (bf16*)(p.ws + WS_PROJ);
    for (int rho = tid >> 4; rho < 768; rho += 32) {
        const int tl = rho / 12, which = rho - tl * 12;
        int col; const float* gain; float sc = 1.0f;
        if (which < 8) { col = C_NQ + which * 64; gain = p.in[6]; sc = 0.125f * 1.4426950408889634f; }
        else if (which < 10) { col = C_KS + (which - 8) * 64; gain = p.in[7] + 64; }
        else { col = C_KW + (which - 10) * 64; gain = p.in[7] + 128; }
        bf16* rp = proj + (size_t)(tok0 + tl) * PS + col + lig * 4;
        const u32x2 raw = *(const u32x2*)rp;
        const unsigned r0 = raw.x, r1 = raw.y;
        const float a = __uint_as_float(r0 << 16), b = __uint_as_float(r0 & 0xffff0000u), c = __uint_as_float(r1 << 16), d = __uint_as_float(r1 & 0xffff0000u);
        const float ss = grp16_sum(a * a + b * b + c * c + d * d);
        const float r = rsqrtf(ss * (1.0f / 64.0f) + EPS) * sc;
        const f32x4 gg = *(const f32x4*)(gain + lig * 4);
        u32x2 o; o.x = pk2(a * r * gg.x, b * r * gg.y); o.y = pk2(c * r * gg.z, d * r * gg.w);
        *(u32x2*)rp = o;
    }
    {
        const int c = tid & 127, tq = tid >> 7, g = c >> 6, d = c & 63, b = tok0 / T, t0 = tok0 % T;
#pragma unroll
        for (int which = 0; which < 2; ++which) {
            const int col = (which == 0 ? C_VS : C_VW) + c;
            unsigned w[8];
#pragma unroll
            for (int i = 0; i < 16; i += 2) w[i >> 1] = (unsigned)proj[(size_t)(tok0 + tq * 16 + i) * PS + col] | ((unsigned)proj[(size_t)(tok0 + tq * 16 + i + 1) * PS + col] << 16);
            bf16* dst = (bf16*)(p.ws + (which == 0 ? WS_VTS : WS_VTW)) + ((size_t)(b * 2 + g) * 64 + d) * T + t0 + tq * 16;
            u32x4 a0, a1; a0.x = w[0]; a0.y = w[1]; a0.z = w[2]; a0.w = w[3]; a1.x = w[4]; a1.y = w[5]; a1.z = w[6]; a1.w = w[7];
            *(u32x4*)dst = a0; *(u32x4*)(dst + 8) = a1;
        }
    }
}
__device__ __forceinline__ void nsa_cmp_item(const Params& p, unsigned char* lds, int item) {
    const int tid = threadIdx.x, lane = tid & 63, wid = tid >> 6, fr = lane & 15, fq = lane >> 4;
    const int nt32 = item & 15, g = (item >> 4) & 1, b = (item >> 5) & 1, which = item >> 6, n0 = nt32 * 32;
    const bf16* proj = (const bf16*)(p.ws + WS_PROJ);
    const float* pe = p.in[8] + which * 2048;
    const bf16* W1T = (const bf16*)(p.ws + WS_W1T) + (size_t)which * 64 * 2048;
    const float* w2 = p.in[10] + which * 4096;
    bf16* A = (bf16*)lds; float* H = (float*)(lds + 33280);
    const int col0 = (which == 0 ? C_KC : C_VC) + g * 64;
    const int nt = wid & 1, ct = wid >> 1;
    f32x4 acc = (f32x4){0.f, 0.f, 0.f, 0.f};
#pragma unroll 1
    for (int kc = 0; kc < 4; ++kc) {
#pragma unroll
        for (int i = 0; i < 4; ++i) {
            const int idx = tid + i * NTHR, dch = idx & 7, jj = (idx >> 3) & 7, n = idx >> 6, j = kc * 8 + jj;
            u32x4 o = (u32x4){0u, 0u, 0u, 0u};
            if (n0 + n < NCMP) {
                const u32x4 raw = *(const u32x4*)(proj + (size_t)(b * T + 16 * (n0 + n) + j) * PS + col0 + dch * 8);
                const f32x4 p0 = *(const f32x4*)(pe + j * 64 + dch * 8), p1 = *(const f32x4*)(pe + j * 64 + dch * 8 + 4);
                const unsigned r0 = raw.x, r1 = raw.y, r2 = raw.z, r3 = raw.w;
                o.x = pk2(__uint_as_float(r0 << 16) + p0.x, __uint_as_float(r0 & 0xffff0000u) + p0.y);
                o.y = pk2(__uint_as_float(r1 << 16) + p0.z, __uint_as_float(r1 & 0xffff0000u) + p0.w);
                o.z = pk2(__uint_as_float(r2 << 16) + p1.x, __uint_as_float(r2 & 0xffff0000u) + p1.y);
                o.w = pk2(__uint_as_float(r3 << 16) + p1.z, __uint_as_float(r3 & 0xffff0000u) + p1.w);
            }
            *(u32x4*)(A + n * 520 + jj * 64 + dch * 8) = o;
        }
        __syncthreads();
#pragma unroll 4
        for (int s = 0; s < 16; ++s) {
            const bf16x8 a = *(const bf16x8*)(A + (nt * 16 + fr) * 520 + s * 32 + fq * 8);
            const bf16x8 bb = *(const bf16x8*)(W1T + (size_t)(ct * 16 + fr) * 2048 + kc * 512 + s * 32 + fq * 8);
            acc = __builtin_amdgcn_mfma_f32_16x16x32_bf16(a, bb, acc, 0, 0, 0);
        }
        __syncthreads();
    }
#pragma unroll
    for (int r = 0; r < 4; ++r) H[(nt * 16 + fq * 4 + r) * 64 + ct * 16 + fr] = gelu_tanh(acc[r]);
    __syncthreads();
    {
        const int n = tid >> 4, c = (tid & 15) * 4;
        f32x4 o = (f32x4){0.f, 0.f, 0.f, 0.f};
#pragma unroll 8
        for (int i = 0; i < 64; ++i) { const float hv = H[n * 64 + i]; const f32x4 w = *(const f32x4*)(w2 + i * 64 + c); o += hv * w; }
        if (which == 0) {
            const float ss = grp16_sum(o.x * o.x + o.y * o.y + o.z * o.z + o.w * o.w);
            const float r = rsqrtf(ss * (1.0f / 64.0f) + EPS);
            const f32x4 gg = *(const f32x4*)(p.in[7] + c);
            o = o * r * gg;
        }
        if (n0 + n >= NCMP) o = (f32x4){0.f, 0.f, 0.f, 0.f};
        if (which == 0) { u32x2 w; w.x = pk2(o.x, o.y); w.y = pk2(o.z, o.w); *(u32x2*)((bf16*)(p.ws + WS_KC) + ((size_t)(b * 2 + g) * 512 + n0 + n) * 64 + c) = w; }
        else { bf16* vt = (bf16*)(p.ws + WS_VCT) + (size_t)(b * 2 + g) * 64 * 512 + n0 + n; vt[(c + 0) * 512] = f2bf(o.x); vt[(c + 1) * 512] = f2bf(o.y); vt[(c + 2) * 512] = f2bf(o.z); vt[(c + 3) * 512] = f2bf(o.w); }
    }
    __syncthreads();
}

constexpr float LOG2E = 1.4426950408889634f;
__device__ __forceinline__ int rho16(int reg, int hh) { return (reg & 3) + 8 * (reg >> 2) + 4 * hh; }
__device__ __forceinline__ bf16x8 pack8(const float* pv) {
    u32x4 w; w.x = pk2(pv[0], pv[1]); w.y = pk2(pv[2], pv[3]); w.z = pk2(pv[4], pv[5]); w.w = pk2(pv[6], pv[7]);
    return __builtin_bit_cast(bf16x8, w);
}
struct KF { bf16x8 f[4]; };
struct VF { u32x2 a[2][4]; };
__device__ __forceinline__ void load_k(KF& k, const bf16* kp) {
#pragma unroll
    for (int s = 0; s < 4; ++s) k.f[s] = *(const bf16x8*)(kp + s * 16);
}
__device__ __forceinline__ void load_v(VF& v, const bf16* vp, size_t vstride32) {
#pragma unroll
    for (int dt = 0; dt < 2; ++dt)
#pragma unroll
        for (int q = 0; q < 4; ++q) v.a[dt][q] = *(const u32x2*)(vp + (size_t)dt * vstride32 + q * 8);
}
__device__ __forceinline__ f32x16 score_tile(const KF& k, const bf16x8 (&qf)[4]) {
    f32x16 st;
#pragma unroll
    for (int i = 0; i < 16; ++i) st[i] = 0.f;
#pragma unroll
    for (int s = 0; s < 4; ++s) st = __builtin_amdgcn_mfma_f32_32x32x16_bf16(k.f[s], qf[s], st, 0, 0, 0);
    return st;
}
__device__ __forceinline__ void pv_tile(f32x16& o0, f32x16& o1, const VF& v, const float* pv) {
    const bf16x8 p0 = pack8(pv), p1 = pack8(pv + 8);
    u32x4 w0, w1;
    w0.x = v.a[0][0].x; w0.y = v.a[0][0].y; w0.z = v.a[0][1].x; w0.w = v.a[0][1].y; w1.x = v.a[0][2].x; w1.y = v.a[0][2].y; w1.z = v.a[0][3].x; w1.w = v.a[0][3].y;
    o0 = __builtin_amdgcn_mfma_f32_32x32x16_bf16(__builtin_bit_cast(bf16x8, w0), p0, o0, 0, 0, 0); o0 = __builtin_amdgcn_mfma_f32_32x32x16_bf16(__builtin_bit_cast(bf16x8, w1), p1, o0, 0, 0, 0);
    w0.x = v.a[1][0].x; w0.y = v.a[1][0].y; w0.z = v.a[1][1].x; w0.w = v.a[1][1].y; w1.x = v.a[1][2].x; w1.y = v.a[1][2].y; w1.z = v.a[1][3].x; w1.w = v.a[1][3].y;
    o1 = __builtin_amdgcn_mfma_f32_32x32x16_bf16(__builtin_bit_cast(bf16x8, w0), p0, o1, 0, 0, 0); o1 = __builtin_amdgcn_mfma_f32_32x32x16_bf16(__builtin_bit_cast(bf16x8, w1), p1, o1, 0, 0, 0);
}
template <bool FAST>
__device__ __forceinline__ void attn_tile(const KF& kc, const VF& vf, const bf16x8 (&qf)[4], float slope, float base, int distbase, bool colsel, int wlimit,
                                          float& m, float& l, f32x16& o0, f32x16& o1) {
    const f32x16 st = score_tile(kc, qf);
    float sv[16];
#pragma unroll
    for (int i = 0; i < 16; ++i) {
        const int rc = (i & 3) + 8 * (i >> 2);
        const float v = st[i] + fmaf(slope, (float)rc, base);
        if (FAST) sv[i] = v;
        else { const int dist = distbase - rc; sv[i] = (colsel && dist >= 0 && dist < wlimit) ? v : -1e30f; }
    }
    float ml = sv[0];
#pragma unroll
    for (int i = 1; i < 16; ++i) ml = fmaxf(ml, sv[i]);
    ml = fmaxf(ml, __shfl_xor(ml, 32));
    if (__any(ml > m)) {
        const float mn = fmaxf(m, ml), alpha = __builtin_amdgcn_exp2f(m - mn);
        m = mn; l *= alpha;
#pragma unroll
        for (int i = 0; i < 16; ++i) { o0[i] *= alpha; o1[i] *= alpha; }
    }
    float ps = 0.f;
#pragma unroll
    for (int i = 0; i < 16; ++i) { float e = __builtin_amdgcn_exp2f(sv[i] - m); if (!FAST) e = (sv[i] > -1e29f) ? e : 0.f; sv[i] = e; ps += e; }
    l += ps;
    pv_tile(o0, o1, vf, sv);
}
__device__ __forceinline__ void nsa_attn_item(const Params& p, unsigned char* wlds, int item) {
    const int lane = threadIdx.x & 63, c = lane & 31, hh = lane >> 5, jt = c >> 2, r4 = c & 3;
    const int oct = item & 1023, g = (item >> 10) & 1, b = item >> 11;
    const int t0 = oct * 8, tc = t0 + jt, h = g * 4 + r4;
    const float slope = exp2f(-(float)(h + 1)) * LOG2E;
    const bf16* proj = (const bf16*)(p.ws + WS_PROJ);
    float* impA = (float*)wlds; float* impB = impA + 1024; unsigned* msk = (unsigned*)(impB + 1024);
    unsigned char* blist = (unsigned char*)(msk + 32);
    float* ocl = (float*)(wlds + 8448) + lane;
#pragma unroll
    for (int i = 0; i < 16; ++i) { impA[lane + 64 * i] = 0.f; impB[lane + 64 * i] = 0.f; }
    if (lane < 32) msk[lane] = 0u;
    bf16x8 qf[4];
    { const bf16* qp = proj + (size_t)(b * T + tc) * PS + C_NQ + h * 64 + hh * 8;
#pragma unroll
      for (int s = 0; s < 4; ++s) qf[s] = *(const bf16x8*)(qp + s * 16); }
    float gate[3];
    { const bf16* gp = proj + (size_t)(b * T + tc) * PS + C_GT + h * 3;
#pragma unroll
      for (int i = 0; i < 3; ++i) gate[i] = sigmoidf_(bf2f(gp[i])); }
    WAVE_LDS_SYNC();
    {
        const bf16* KC = (const bf16*)(p.ws + WS_KC) + (size_t)(b * 2 + g) * 512 * 64 + (size_t)c * 64 + hh * 8;
        const bf16* VCT = (const bf16*)(p.ws + WS_VCT) + (size_t)(b * 2 + g) * 64 * 512 + (size_t)c * 512 + 4 * hh;
        const int nmax = (t0 + 7 >= 31) ? ((t0 + 7 - 31) >> 4) : -1;
        const int nlast = (nmax >= 0) ? (nmax & ~31) : -32;
        float m = -1e30f, l = 0.f;
        f32x16 o0, o1;
#pragma unroll
        for (int i = 0; i < 16; ++i) { o0[i] = 0.f; o1[i] = 0.f; }
        KF kn;
        if (nlast >= 0) load_k(kn, KC + (size_t)nlast * 64);
#pragma unroll 1
        for (int n0 = nlast; n0 >= 0; n0 -= 32) {
            const KF kc = kn;
            load_k(kn, KC + (size_t)(n0 >= 32 ? n0 - 32 : n0) * 64);
            const f32x16 st = score_tile(kc, qf);
            float sv[16];
#pragma unroll
            for (int i = 0; i < 16; ++i) { const int dist = tc - (16 * (n0 + rho16(i, hh)) + 31); sv[i] = (dist >= 0) ? st[i] - slope * (float)dist : -1e30f; }
            float ml = sv[0];
#pragma unroll
            for (int i = 1; i < 16; ++i) ml = fmaxf(ml, sv[i]);
            ml = fmaxf(ml, __shfl_xor(ml, 32));
            const float mn = fmaxf(m, ml); float ps = 0.f;
#pragma unroll
            for (int i = 0; i < 16; ++i) ps += (sv[i] > -1e29f) ? __builtin_amdgcn_exp2f(sv[i] - mn) : 0.f;
            l = l * __builtin_amdgcn_exp2f(m - mn) + ps; m = mn;
        }
        l += __shfl_xor(l, 32);
        const float inv = 1.0f / fmaxf(l, 1e-30f);
        if (nlast >= 0) load_k(kn, KC + (size_t)nlast * 64);
#pragma unroll 1
        for (int n0 = nlast; n0 >= 0; n0 -= 32) {
            const KF kc = kn; VF vf;
            load_v(vf, VCT + n0, (size_t)32 * 512);
            load_k(kn, KC + (size_t)(n0 >= 32 ? n0 - 32 : n0) * 64);
            const f32x16 st = score_tile(kc, qf);
            float pv[16];
#pragma unroll
            for (int i = 0; i < 16; ++i) { const int dist = tc - (16 * (n0 + rho16(i, hh)) + 31); pv[i] = (dist >= 0) ? __builtin_amdgcn_exp2f(st[i] - slope * (float)dist - m) * inv : 0.f; }
            pv_tile(o0, o1, vf, pv);
#pragma unroll
            for (int i = 0; i < 16; ++i) { float v = pv[i]; v += dpp_f<0xB1>(v); v += dpp_f<0x4E>(v); pv[i] = v; }
            if (r4 == 0) {
#pragma unroll
                for (int rg = 0; rg < 4; ++rg) {
                    const int jb = (n0 >> 2) + 2 * rg + hh;
                    impA[jt * 128 + jb] = pv[4 * rg] + 2.f * pv[4 * rg + 1] + 2.f * pv[4 * rg + 2] + 2.f * pv[4 * rg + 3];
                    if (jb >= 1) impB[jt * 128 + jb - 1] = pv[4 * rg];
                }
            }
        }
#pragma unroll
        for (int i = 0; i < 16; ++i) { ocl[i * 64] = gate[0] * o0[i]; ocl[(16 + i) * 64] = gate[0] * o1[i]; }
    }
    WAVE_LDS_SYNC();
    {
        const int lig = lane & 15, grp = lane >> 4;
#pragma unroll 1
        for (int half = 0; half < 2; ++half) {
            const int j2 = half * 4 + grp, cur = (t0 + j2) >> 6;
            float v[8];
#pragma unroll
            for (int e = 0; e < 8; ++e) {
                const int j = lig * 8 + e; const float val = impA[j2 * 128 + j] + impB[j2 * 128 + j];
                v[e] = (j >= 1 && j <= cur - 2) ? __uint_as_float((__float_as_uint(val) & ~127u) | (unsigned)(127 - j)) : -1.0f;
            }
            const float top = grp16_top16(v, lig);
            const int need = 16 - ((cur == 0) ? 1 : (cur == 1) ? 2 : 3);
            if (lig < need && top >= 0.f) { const int idx = 127 - (int)(__float_as_uint(top) & 127u); atomicOr(&msk[j2 * 4 + (idx >> 5)], 1u << (idx & 31)); }
            if (lig == 0) { atomicOr(&msk[j2 * 4], 1u); atomicOr(&msk[j2 * 4 + (cur >> 5)], 1u << (cur & 31)); if (cur >= 1) atomicOr(&msk[j2 * 4 + ((cur - 1) >> 5)], 1u << ((cur - 1) & 31)); }
        }
    }
    WAVE_LDS_SYNC();
    {
        int nblk = 0;
#pragma unroll
        for (int w = 3; w >= 0; --w) {
            unsigned u = 0u;
#pragma unroll
            for (int j = 0; j < 8; ++j) u |= msk[j * 4 + w];
            u = (unsigned)__builtin_amdgcn_readfirstlane((int)u);
            while (u) { const int bit = 31 - __builtin_clz(u); u &= ~(1u << bit); if (lane == 0) blist[nblk] = (unsigned char)(w * 32 + bit); ++nblk; }
        }
        WAVE_LDS_SYNC();
        const bf16* KS = proj + (size_t)(b * T + c) * PS + C_KS + g * 64 + hh * 8;
        const bf16* VTS = (const bf16*)(p.ws + WS_VTS) + (size_t)(b * 2 + g) * 64 * T + (size_t)c * T + 4 * hh;
        float m = -1e30f, l = 0.f;
        f32x16 o0, o1;
#pragma unroll
        for (int i = 0; i < 16; ++i) { o0[i] = 0.f; o1[i] = 0.f; }
        const int ntile = 2 * nblk;
        KF kn;
        { const int jb0 = blist[0]; load_k(kn, KS + (size_t)(jb0 * 64 + 32) * PS); }
#pragma unroll 1
        for (int ti = 0; ti < ntile; ++ti) {
            const int jb = __builtin_amdgcn_readfirstlane((int)blist[ti >> 1]);
            const int key0 = jb * 64 + 32 - 32 * (ti & 1);
            const KF kc = kn; VF vf;
            load_v(vf, VTS + key0, (size_t)32 * T);
            { const int tn = (ti + 1 < ntile) ? ti + 1 : ti; const int jn = __builtin_amdgcn_readfirstlane((int)blist[tn >> 1]); load_k(kn, KS + (size_t)(jn * 64 + 32 - 32 * (tn & 1)) * PS); }
            const bool colsel = (msk[jt * 4 + (jb >> 5)] >> (jb & 31)) & 1u;
            const int distbase = tc - key0 - 4 * hh;
            if (key0 + 31 <= t0) attn_tile<true>(kc, vf, qf, slope, colsel ? -slope * (float)distbase : -1e30f, distbase, true, 1 << 30, m, l, o0, o1);
            else attn_tile<false>(kc, vf, qf, slope, -slope * (float)distbase, distbase, colsel, 1 << 30, m, l, o0, o1);
        }
        l += __shfl_xor(l, 32);
        const float sc = gate[1] / fmaxf(l, 1e-30f);
#pragma unroll
        for (int i = 0; i < 16; ++i) { ocl[i * 64] += sc * o0[i]; ocl[(16 + i) * 64] += sc * o1[i]; }
    }
    {
        const bf16* KW = proj + (size_t)(b * T + c) * PS + C_KW + g * 64 + hh * 8;
        const bf16* VTW = (const bf16*)(p.ws + WS_VTW) + (size_t)(b * 2 + g) * 64 * T + (size_t)c * T + 4 * hh;
        float m = -1e30f, l = 0.f;
        f32x16 o0, o1;
#pragma unroll
        for (int i = 0; i < 16; ++i) { o0[i] = 0.f; o1[i] = 0.f; }
        const int kstart = (t0 - 511 > 0 ? t0 - 511 : 0) & ~31, kfirst = t0 & ~31;
        KF kn;
        load_k(kn, KW + (size_t)kfirst * PS);
#pragma unroll 1
        for (int key0 = kfirst; key0 >= kstart; key0 -= 32) {
            const KF kc = kn; VF vf;
            load_v(vf, VTW + key0, (size_t)32 * T);
            { const int kn0 = (key0 - 32 >= kstart) ? key0 - 32 : key0; load_k(kn, KW + (size_t)kn0 * PS); }
            const int distbase = tc - key0 - 4 * hh;
            if (key0 + 31 <= t0 && key0 >= t0 - 504) attn_tile<true>(kc, vf, qf, slope, -slope * (float)distbase, distbase, true, 512, m, l, o0, o1);
            else attn_tile<false>(kc, vf, qf, slope, -slope * (float)distbase, distbase, true, 512, m, l, o0, o1);
        }
        l += __shfl_xor(l, 32);
        const float sc = gate[2] / fmaxf(l, 1e-30f);
#pragma unroll
        for (int i = 0; i < 16; ++i) { o0[i] = ocl[i * 64] + sc * o0[i]; o1[i] = ocl[(16 + i) * 64] + sc * o1[i]; }
        float ss = 0.f;
#pragma unroll
        for (int i = 0; i < 16; ++i) ss += o0[i] * o0[i] + o1[i] * o1[i];
        ss += __shfl_xor(ss, 32);
        const float r = rsqrtf(ss * (1.0f / 64.0f) + EPS);
        const float* og = p.in[11] + h * 64;
        bf16* op = (bf16*)(p.ws + WS_ACT) + (size_t)(b * T + tc) * D + 512 + h * 64;
#pragma unroll
        for (int dt = 0; dt < 2; ++dt)
#pragma unroll
            for (int rg = 0; rg < 4; ++rg) {
                const int d0 = dt * 32 + 8 * rg + 4 * hh;
                const f32x4 gg = *(const f32x4*)(og + d0);
                u32x2 w;
                if (dt == 0) { w.x = pk2(o0[4 * rg] * r * gg.x, o0[4 * rg + 1] * r * gg.y); w.y = pk2(o0[4 * rg + 2] * r * gg.z, o0[4 * rg + 3] * r * gg.w); }
                else { w.x = pk2(o1[4 * rg] * r * gg.x, o1[4 * rg + 1] * r * gg.y); w.y = pk2(o1[4 * rg + 2] * r * gg.z, o1[4 * rg + 3] * r * gg.w); }
                *(u32x2*)(op + d0) = w;
            }
    }
    WAVE_LDS_SYNC();
}
__device__ __forceinline__ void phase2(const Params& p, unsigned char* lds) {
    for (int it = blockIdx.x; it < 128 + 256 + 1024; it += gridDim.x) {
        if (it < 128) nsa_cmp_item(p, lds, it);
        else if (it < 384) nsa_prep_item(p, lds, it - 128);
        else hgrn_pre_item(p, lds, it - 384);
    }
}
template <bool SCAN>
__device__ __forceinline__ void phase3(const Params& p, unsigned char* lds) {
    const int gw = (blockIdx.x * NTHR + threadIdx.x) >> 6;
    const int wid = threadIdx.x >> 6;
    if (SCAN && blockIdx.x < 8) hgrn_scan_block(p, lds, blockIdx.x);
    unsigned* ctr = (unsigned*)(p.ws + WS_CTR) + (SCAN ? 0 : 64);
    for (;;) {
        int it = 0;
        if ((threadIdx.x & 63) == 0) it = (int)atomicAdd(ctr, 1u);
        it = __builtin_amdgcn_readfirstlane(it);
        if (it >= 4096) break;
        nsa_attn_item(p, lds + wid * 16640, 4095 - it);
    }
}

__device__ __forceinline__ float dot2u(unsigned a, unsigned b, float acc) { return __builtin_amdgcn_fdot2_f32_bf16(__builtin_bit_cast(bf16x2v, a), __builtin_bit_cast(bf16x2v, b), acc, false); }
__device__ __forceinline__ float dot8(u32x4 a, u32x4 b, float acc) {
    const unsigned a0 = a.x, a1 = a.y, a2 = a.z, a3 = a.w, b0 = b.x, b1 = b.y, b2 = b.z, b3 = b.w;
    acc = dot2u(a0, b0, acc); acc = dot2u(a1, b1, acc); acc = dot2u(a2, b2, acc); acc = dot2u(a3, b3, acc);
    return acc;
}
__device__ __forceinline__ void axpy8(float (&o)[8], float c, u32x4 v) {
    o[0] += c * __uint_as_float(v.x << 16); o[1] += c * __uint_as_float(v.x & 0xffff0000u);
    o[2] += c * __uint_as_float(v.y << 16); o[3] += c * __uint_as_float(v.y & 0xffff0000u);
    o[4] += c * __uint_as_float(v.z << 16); o[5] += c * __uint_as_float(v.z & 0xffff0000u);
    o[6] += c * __uint_as_float(v.w << 16); o[7] += c * __uint_as_float(v.w & 0xffff0000u);
}
typedef float f32x2 __attribute__((ext_vector_type(2)));
__device__ __forceinline__ float dot16_fp8(u32x4 r, const float* xf) {
    const unsigned r0 = r.x, r1 = r.y, r2 = r.z, r3 = r.w; float acc = 0.f; f32x2 t;
    t = __builtin_amdgcn_cvt_pk_f32_fp8((int)r0, false); acc += t.x * xf[0] + t.y * xf[1]; t = __builtin_amdgcn_cvt_pk_f32_fp8((int)r0, true); acc += t.x * xf[2] + t.y * xf[3];
    t = __builtin_amdgcn_cvt_pk_f32_fp8((int)r1, false); acc += t.x * xf[4] + t.y * xf[5]; t = __builtin_amdgcn_cvt_pk_f32_fp8((int)r1, true); acc += t.x * xf[6] + t.y * xf[7];
    t = __builtin_amdgcn_cvt_pk_f32_fp8((int)r2, false); acc += t.x * xf[8] + t.y * xf[9]; t = __builtin_amdgcn_cvt_pk_f32_fp8((int)r2, true); acc += t.x * xf[10] + t.y * xf[11];
    t = __builtin_amdgcn_cvt_pk_f32_fp8((int)r3, false); acc += t.x * xf[12] + t.y * xf[13]; t = __builtin_amdgcn_cvt_pk_f32_fp8((int)r3, true); acc += t.x * xf[14] + t.y * xf[15];
    return acc;
}
__device__ __forceinline__ void axpy16_fp8(float* o, float c, u32x4 r) {
    const unsigned r0 = r.x, r1 = r.y, r2 = r.z, r3 = r.w; f32x2 t;
    t = __builtin_amdgcn_cvt_pk_f32_fp8((int)r0, false); o[0] += c * t.x; o[1] += c * t.y; t = __builtin_amdgcn_cvt_pk_f32_fp8((int)r0, true); o[2] += c * t.x; o[3] += c * t.y;
    t = __builtin_amdgcn_cvt_pk_f32_fp8((int)r1, false); o[4] += c * t.x; o[5] += c * t.y; t = __builtin_amdgcn_cvt_pk_f32_fp8((int)r1, true); o[6] += c * t.x; o[7] += c * t.y;
    t = __builtin_amdgcn_cvt_pk_f32_fp8((int)r2, false); o[8] += c * t.x; o[9] += c * t.y; t = __builtin_amdgcn_cvt_pk_f32_fp8((int)r2, true); o[10] += c * t.x; o[11] += c * t.y;
    t = __builtin_amdgcn_cvt_pk_f32_fp8((int)r3, false); o[12] += c * t.x; o[13] += c * t.y; t = __builtin_amdgcn_cvt_pk_f32_fp8((int)r3, true); o[14] += c * t.x; o[15] += c * t.y;
}
template <bool DUMMY>
__device__ __forceinline__ void phase9(const Params& p, unsigned char* lds) {
    const bf16* HN = (const bf16*)(p.ws + WS_ACT); const unsigned char* UB = p.ws + WS_UB; const unsigned char* VB = p.ws + WS_VB;
    const float* US = (const float*)(p.ws + WS_US); const float* VS = (const float*)(p.ws + WS_VS);
    const int* ids = (const int*)(p.ws + WS_IDS); const float* wts = (const float*)(p.ws + WS_WTS);
    float* O = p.out; bf16* HG = (bf16*)(p.ws + WS_PROJ + 64 * MiB); const float* gn = p.in[19];
    const int lane = threadIdx.x & 63, gw = (blockIdx.x * NTHR + threadIdx.x) >> 6, ngw = (gridDim.x * NTHR) >> 6;
    for (int tok = gw; tok < NTOK; tok += ngw) {
        float xf[16], oa[16];
        {
            const u32x4 x0 = *(const u32x4*)(HN + (size_t)tok * D + lane * 16), x1 = *(const u32x4*)(HN + (size_t)tok * D + lane * 16 + 8);
            const unsigned a0 = x0.x, a1 = x0.y, a2 = x0.z, a3 = x0.w, b0 = x1.x, b1 = x1.y, b2 = x1.z, b3 = x1.w;
            xf[0] = __uint_as_float(a0 << 16); xf[1] = __uint_as_float(a0 & 0xffff0000u); xf[2] = __uint_as_float(a1 << 16); xf[3] = __uint_as_float(a1 & 0xffff0000u);
            xf[4] = __uint_as_float(a2 << 16); xf[5] = __uint_as_float(a2 & 0xffff0000u); xf[6] = __uint_as_float(a3 << 16); xf[7] = __uint_as_float(a3 & 0xffff0000u);
            xf[8] = __uint_as_float(b0 << 16); xf[9] = __uint_as_float(b0 & 0xffff0000u); xf[10] = __uint_as_float(b1 << 16); xf[11] = __uint_as_float(b1 & 0xffff0000u);
            xf[12] = __uint_as_float(b2 << 16); xf[13] = __uint_as_float(b2 & 0xffff0000u); xf[14] = __uint_as_float(b3 << 16); xf[15] = __uint_as_float(b3 & 0xffff0000u);
        }
#pragma unroll
        for (int j = 0; j < 16; ++j) oa[j] = 0.f;
#pragma unroll 1
        for (int half = 0; half < 2; ++half) {
            const int myid = ids[(size_t)tok * 128 + half * 64 + lane];
            const float myw = wts[(size_t)tok * 128 + half * 64 + lane] * VS[myid];
            const float myus = US[myid];
#pragma unroll 1
            for (int eb = 0; eb < 64; eb += 16) {
                int id[16]; float d[16]; u32x4 ur[16];
#pragma unroll
                for (int j = 0; j < 16; ++j) id[j] = __shfl(myid, eb + j);
#pragma unroll
                for (int j = 0; j < 16; ++j) ur[j] = *(const u32x4*)(UB + (size_t)id[j] * D + lane * 16);
#pragma unroll
                for (int j = 0; j < 16; ++j) d[j] = dot16_fp8(ur[j], xf);
#pragma unroll
                for (int j = 0; j < 16; ++j) ur[j] = *(const u32x4*)(VB + (size_t)id[j] * D + lane * 16);
#pragma unroll
                for (int j = 0; j < 16; ++j) d[j] = wave_sum(d[j]);
#pragma unroll
                for (int j = 0; j < 16; ++j) { const float c = __shfl(myw, eb + j) * gelu_tanh(d[j] * __shfl(myus, eb + j)); axpy16_fp8(oa, c, ur[j]); }
            }
        }
        float* orow = O + (size_t)tok * D + lane * 16; float* wrow = DUMMY ? (float*)(p.ws + WS_PROJ) + (size_t)tok * D + lane * 16 : orow;
        float ss = 0.f; f32x4 hv[4];
#pragma unroll
        for (int q = 0; q < 4; ++q) {
            f32x4 h = *(const f32x4*)(orow + 4 * q);
            h.x += oa[4 * q]; h.y += oa[4 * q + 1]; h.z += oa[4 * q + 2]; h.w += oa[4 * q + 3];
            *(f32x4*)(wrow + 4 * q) = h; hv[q] = h;
            ss += h.x * h.x + h.y * h.y + h.z * h.z + h.w * h.w;
        }
        ss = wave_sum(ss);
        const float r = rsqrtf(ss * (1.0f / D) + EPS);
        u32x4 q0, q1;
        { const f32x4 g0 = *(const f32x4*)(gn + lane * 16), g1 = *(const f32x4*)(gn + lane * 16 + 4), g2 = *(const f32x4*)(gn + lane * 16 + 8), g3 = *(const f32x4*)(gn + lane * 16 + 12);
          q0.x = pk2(hv[0].x * r * g0.x, hv[0].y * r * g0.y); q0.y = pk2(hv[0].z * r * g0.z, hv[0].w * r * g0.w); q0.z = pk2(hv[1].x * r * g1.x, hv[1].y * r * g1.y); q0.w = pk2(hv[1].z * r * g1.z, hv[1].w * r * g1.w);
          q1.x = pk2(hv[2].x * r * g2.x, hv[2].y * r * g2.y); q1.y = pk2(hv[2].z * r * g2.z, hv[2].w * r * g2.w); q1.z = pk2(hv[3].x * r * g3.x, hv[3].y * r * g3.y); q1.w = pk2(hv[3].z * r * g3.z, hv[3].w * r * g3.w); }
        *(u32x4*)(HG + (size_t)tok * D + lane * 16) = q0; *(u32x4*)(HG + (size_t)tok * D + lane * 16 + 8) = q1;
    }
}


__device__ __forceinline__ unsigned xb_xcc_id();
template <int CTRL> __device__ __forceinline__ float dpp_row_ror(float v) { return __int_as_float(__builtin_amdgcn_update_dpp(0, __float_as_int(v), CTRL, 0xF, 0xF, false)); }
__device__ __forceinline__ float grp8_sum(float v) { v += dpp_f<0xB1>(v); v += dpp_f<0x4E>(v); v += dpp_f<0x141>(v); return v; }
__device__ __forceinline__ int peer_next_item(unsigned* ctr, int myx, int& slice) {
    for (int k = 0; k < 8; ++k) {
        const int x = (myx + k) & 7;
        int it = 0;
        if ((threadIdx.x & 63) == 0) it = (int)atomicAdd(ctr + x * 16, 1u);
        it = __builtin_amdgcn_readfirstlane(it);
        if (it < 1024) { slice = x; return it; }
    }
    return -1;
}
__device__ __forceinline__ void unpack16(const u32x4 x0, const u32x4 x1, float* xf) {
    const unsigned a0 = x0.x, a1 = x0.y, a2 = x0.z, a3 = x0.w, b0 = x1.x, b1 = x1.y, b2 = x1.z, b3 = x1.w;
    xf[0] = __uint_as_float(a0 << 16); xf[1] = __uint_as_float(a0 & 0xffff0000u); xf[2] = __uint_as_float(a1 << 16); xf[3] = __uint_as_float(a1 & 0xffff0000u);
    xf[4] = __uint_as_float(a2 << 16); xf[5] = __uint_as_float(a2 & 0xffff0000u); xf[6] = __uint_as_float(a3 << 16); xf[7] = __uint_as_float(a3 & 0xffff0000u);
    xf[8] = __uint_as_float(b0 << 16); xf[9] = __uint_as_float(b0 & 0xffff0000u); xf[10] = __uint_as_float(b1 << 16); xf[11] = __uint_as_float(b1 & 0xffff0000u);
    xf[12] = __uint_as_float(b2 << 16); xf[13] = __uint_as_float(b2 & 0xffff0000u); xf[14] = __uint_as_float(b3 << 16); xf[15] = __uint_as_float(b3 & 0xffff0000u);
}
__device__ __forceinline__ void phase9a(const Params& p, unsigned char* lds) {
    const bf16* HN = (const bf16*)(p.ws + WS_ACT); const unsigned char* UB = p.ws + WS_UB;
    const int* ids = (const int*)(p.ws + WS_IDS); float* PD = (float*)(p.ws + WS_PROJ);
    unsigned* ctr = (unsigned*)(p.ws + WS_CTR) + 256;
    const int lane = threadIdx.x & 63, gq = lane >> 3, cl = lane & 7, myx = (int)(xb_xcc_id() & 7u);
    for (;;) {
        int x; const int it = peer_next_item(ctr, myx, x);
        if (it < 0) break;
        const unsigned char* ub = UB + (size_t)x * (16384 * 128) + cl * 16;
        const bf16* hn = HN + x * 128 + cl * 16;
        const int tokb = it * 16;
        int idn[8]; u32x4 buf[8], xr0, xr1;
        { const int* ip = ids + (size_t)tokb * 128 + gq;
#pragma unroll
          for (int i = 0; i < 8; ++i) idn[i] = ip[i * 8]; }
#pragma unroll
        for (int i = 0; i < 8; ++i) buf[i] = *(const u32x4*)(ub + (size_t)idn[i] * 128);
        xr0 = *(const u32x4*)(hn + (size_t)tokb * D); xr1 = *(const u32x4*)(hn + (size_t)tokb * D + 8);
        { const int* ip = ids + (size_t)tokb * 128 + 64 + gq;
#pragma unroll
          for (int i = 0; i < 8; ++i) idn[i] = ip[i * 8]; }
#pragma unroll 1
        for (int u = 0; u < 32; ++u) {
            const int u1 = (u + 1 < 32) ? u + 1 : u, u2 = (u + 2 < 32) ? u + 2 : u;
            float xf[16]; unpack16(xr0, xr1, xf);
            float keep = 0.f;
#pragma unroll
            for (int i = 0; i < 8; ++i) {
                const float d = grp8_sum(dot16_fp8(buf[i], xf)); if (i == cl) keep = d;
                buf[i] = *(const u32x4*)(ub + (size_t)idn[i] * 128);
            }
            xr0 = *(const u32x4*)(hn + (size_t)(tokb + (u1 >> 1)) * D); xr1 = *(const u32x4*)(hn + (size_t)(tokb + (u1 >> 1)) * D + 8);
            { const int* ip = ids + (size_t)(tokb + (u2 >> 1)) * 128 + (u2 & 1) * 64 + gq;
#pragma unroll
              for (int i = 0; i < 8; ++i) idn[i] = ip[i * 8]; }
            PD[((size_t)x * NTOK + tokb + (u >> 1)) * 128 + ((u & 1) * 8 + cl) * 8 + gq] = keep;
        }
    }
}
__device__ __forceinline__ void phase9c(const Params& p, unsigned char* lds) {
    const int* ids = (const int*)(p.ws + WS_IDS); float* wts = (float*)(p.ws + WS_WTS); const float* PD = (const float*)(p.ws + WS_PROJ);
    const float* US = (const float*)(p.ws + WS_US); const float* VS = (const float*)(p.ws + WS_VS);
    const size_t gtid = (size_t)blockIdx.x * NTHR + threadIdx.x, gth = (size_t)gridDim.x * NTHR;
    for (size_t i = gtid; i < (size_t)NTOK * 128; i += gth) {
        float sdot = 0.f;
#pragma unroll
        for (int x = 0; x < 8; ++x) sdot += PD[(size_t)x * NTOK * 128 + i];
        const int id = ids[i];
        wts[i] = wts[i] * VS[id] * gelu_tanh(sdot * US[id]);
    }
}
__device__ __forceinline__ void phase9b(const Params& p, unsigned char* lds) {
    const unsigned char* VB = p.ws + WS_VB; const int* ids = (const int*)(p.ws + WS_IDS); const float* coef = (const float*)(p.ws + WS_WTS);
    float* O = p.out; bf16* HG = (bf16*)(p.ws + WS_PROJ + 64 * MiB); const float* gn = p.in[19]; float* SSQ = (float*)(p.ws + WS_SSQ);
    unsigned* ctr = (unsigned*)(p.ws + WS_CTR) + 512;
    const int lane = threadIdx.x & 63, gq = lane >> 3, cl = lane & 7, myx = (int)(xb_xcc_id() & 7u);
    for (;;) {
        int x; const int it = peer_next_item(ctr, myx, x);
        if (it < 0) break;
        const unsigned char* vb = VB + (size_t)x * (16384 * 128) + cl * 16;
        const int tokb = it * 16;
        int idn[8]; u32x4 buf[8]; float cf[8], cn[8]; float acc[16];
#pragma unroll
        for (int j = 0; j < 16; ++j) acc[j] = 0.f;
        { const int* ip = ids + (size_t)tokb * 128 + gq; const float* cp = coef + (size_t)tokb * 128 + gq;
#pragma unroll
          for (int i = 0; i < 8; ++i) { idn[i] = ip[i * 8]; cf[i] = cp[i * 8]; } }
#pragma unroll
        for (int i = 0; i < 8; ++i) buf[i] = *(const u32x4*)(vb + (size_t)idn[i] * 128);
        { const int* ip = ids + (size_t)tokb * 128 + 64 + gq; const float* cp = coef + (size_t)tokb * 128 + 64 + gq;
#pragma unroll
          for (int i = 0; i < 8; ++i) { idn[i] = ip[i * 8]; cn[i] = cp[i * 8]; } }
#pragma unroll 1
        for (int u = 0; u < 32; ++u) {
            const int u2 = (u + 2 < 32) ? u + 2 : u;
#pragma unroll
            for (int i = 0; i < 8; ++i) { axpy16_fp8(acc, cf[i], buf[i]); buf[i] = *(const u32x4*)(vb + (size_t)idn[i] * 128); cf[i] = cn[i]; }
            { const int* ip = ids + (size_t)(tokb + (u2 >> 1)) * 128 + (u2 & 1) * 64 + gq; const float* cp = coef + (size_t)(tokb + (u2 >> 1)) * 128 + (u2 & 1) * 64 + gq;
#pragma unroll
              for (int i = 0; i < 8; ++i) { idn[i] = ip[i * 8]; cn[i] = cp[i * 8]; } }
            if (u & 1) {
                const int tok = tokb + (u >> 1);
#pragma unroll
                for (int j = 0; j < 16; ++j) { float v = acc[j]; v += __shfl_xor(v, 8); v += __shfl_xor(v, 16); v += __shfl_xor(v, 32); acc[j] = v; }
                float ss = 0.f;
                if (gq == 0) {
                    float* orow = O + (size_t)tok * D + x * 128 + cl * 16; const float* gr = gn + x * 128 + cl * 16; u32x4 q0, q1; unsigned qq[8];
#pragma unroll
                    for (int q = 0; q < 4; ++q) {
                        f32x4 hv = *(const f32x4*)(orow + 4 * q); const f32x4 gg = *(const f32x4*)(gr + 4 * q);
                        hv.x += acc[4 * q]; hv.y += acc[4 * q + 1]; hv.z += acc[4 * q + 2]; hv.w += acc[4 * q + 3];
                        *(f32x4*)(orow + 4 * q) = hv;
                        ss += hv.x * hv.x + hv.y * hv.y + hv.z * hv.z + hv.w * hv.w;
                        qq[2 * q] = pk2(hv.x * gg.x, hv.y * gg.y); qq[2 * q + 1] = pk2(hv.z * gg.z, hv.w * gg.w);
                    }
                    q0.x = qq[0]; q0.y = qq[1]; q0.z = qq[2]; q0.w = qq[3]; q1.x = qq[4]; q1.y = qq[5]; q1.z = qq[6]; q1.w = qq[7];
                    *(u32x4*)(HG + (size_t)tok * D + x * 128 + cl * 16) = q0; *(u32x4*)(HG + (size_t)tok * D + x * 128 + cl * 16 + 8) = q1;
                }
                ss = grp8_sum(ss);
                if (lane == 0) SSQ[(size_t)x * NTOK + tok] = ss;
#pragma unroll
                for (int j = 0; j < 16; ++j) acc[j] = 0.f;
            }
        }
    }
}

#define XB_TMO      128
#define XB_XCNT(j)  (256  + 64 * (j))
#define XB_XSUB(j)  (1280 + 64 * (j))
#define XB_XGEN(j)  (2304 + 64 * (j))
#define XB_TOP      3328
#define XB_TOPGEN   3392
#define XCD_BAR_WORDS 3456
#define XB_SPIN_CAP (1u << 18)
#define LAS __attribute__((address_space(3)))
__device__ __forceinline__ unsigned xb_ld(unsigned* p)              { return __hip_atomic_load(p, __ATOMIC_RELAXED, __HIP_MEMORY_SCOPE_AGENT); }
__device__ __forceinline__ unsigned xb_add(unsigned* p, unsigned v) { return __hip_atomic_fetch_add(p, v, __ATOMIC_RELAXED, __HIP_MEMORY_SCOPE_AGENT); }
__device__ __forceinline__ unsigned xb_xcc_id() { return (unsigned)__builtin_amdgcn_s_getreg((3 << 11) | 20) & 0xFu; }
#define XB_SPIN(cond, bar) do { unsigned _sp = 0; while (cond) { __builtin_amdgcn_s_sleep(1); \
    if ((++_sp & 255u) == 0u) { if (xb_ld(&(bar)[XB_TMO])) break; if (_sp > XB_SPIN_CAP) { atomicAdd(&(bar)[XB_TMO], 1u); break; } } } } while (0)
struct XcdBarrier { unsigned* bar; unsigned x; volatile LAS unsigned* st; };
__device__ __forceinline__ XcdBarrier xcd_barrier_post(unsigned* bar, volatile LAS unsigned* st) {
    XcdBarrier b; b.bar = bar; b.x = xb_xcc_id(); b.st = st;
    if (threadIdx.x == 0) (void)xb_add(&bar[XB_XCNT(b.x)], 1u);
    return b;
}
__device__ __forceinline__ void xcd_barrier_complete(unsigned* bar, unsigned x, unsigned& nloc, unsigned& nx) {
    const unsigned G = gridDim.x * gridDim.y * gridDim.z;
    unsigned sum, cnt, mine, sp = 0u;
    for (;;) {
        sum = 0u; cnt = 0u; mine = 0u;
#pragma unroll
        for (unsigned j = 0; j < 16; ++j) { const unsigned c = xb_ld(&bar[XB_XCNT(j)]); sum += c; cnt += (c > 0u) ? 1u : 0u; mine = (j == x) ? c : mine; }
        if (sum == G) break;
        __builtin_amdgcn_s_sleep(1);
        if ((++sp & 255u) == 0u) { if (xb_ld(&bar[XB_TMO])) break; if (sp > XB_SPIN_CAP) { atomicAdd(&bar[XB_TMO], 1u); break; } }
    }
    nloc = mine > 0u ? mine : 1u; nx = cnt > 0u ? cnt : 1u;
}
__device__ __forceinline__ void xcd_barrier(const XcdBarrier& b) {
    asm volatile("s_waitcnt vmcnt(0)" ::: "memory");
    __syncthreads();
    if (threadIdx.x == 0) {
        unsigned* bar = b.bar;
        __builtin_amdgcn_s_waitcnt(0);
        unsigned nloc = b.st[0], nx = b.st[1];
        if (nloc == 0u) { xcd_barrier_complete(bar, b.x, nloc, nx); b.st[0] = nloc; b.st[1] = nx; }
        const unsigned old = xb_add(&bar[XB_XSUB(b.x)], 1u);
        const unsigned gen = old / nloc;
        if (old + 1u == (gen + 1u) * nloc) {
            __builtin_amdgcn_fence(__ATOMIC_RELEASE, "agent");
            asm volatile("s_waitcnt vmcnt(0)" ::: "memory");
            const unsigned og = xb_add(&bar[XB_TOP], 1u);
            const unsigned tg = og / nx;
            if (og + 1u == (tg + 1u) * nx) xb_add(&bar[XB_TOPGEN], 1u);
            else XB_SPIN(xb_ld(&bar[XB_TOPGEN]) == tg, bar);
            __builtin_amdgcn_fence(__ATOMIC_ACQUIRE, "agent");
            xb_add(&bar[XB_XGEN(b.x)], 1u);
            asm volatile("s_waitcnt vmcnt(0)" ::: "memory");
        } else {
            XB_SPIN(xb_ld(&bar[XB_XGEN(b.x)]) == gen, bar);
            __builtin_amdgcn_fence(__ATOMIC_ACQUIRE, "agent");
            asm volatile("s_waitcnt vmcnt(0)" ::: "memory");
        }
    }
    __syncthreads();
}

constexpr int REPK = -1;
__global__ void __launch_bounds__(NTHR, 2) mega(Params p, int ph_lo, int ph_hi) {
    extern __shared__ __attribute__((aligned(16))) unsigned char lds[];
    volatile LAS unsigned* st = (volatile LAS unsigned*)(LAS unsigned char*)(lds + LDS_BYTES - 16);
    if (threadIdx.x < 4) st[threadIdx.x] = 0u;
    __syncthreads();
    const XcdBarrier bar = xcd_barrier_post((unsigned*)p.ws, st);
#define RUN_PHASE(k, call) if (ph_lo <= (k) && (k) < ph_hi) { if ((k) > ph_lo) xcd_barrier(bar); call; if (REPK == (k)) { xcd_barrier(bar); call; } }
    RUN_PHASE(0, phase0(p, lds))
    RUN_PHASE(1, phase1(p, lds))
    RUN_PHASE(2, phase2(p, lds))
    if (REPK == 30) { xcd_barrier(bar); if ((threadIdx.x >> 6) == 0 && blockIdx.x < 64) hgrn_scan_item<true>(p, blockIdx.x); }
    if (ph_lo <= 3 && 3 < ph_hi) { if (3 > ph_lo) xcd_barrier(bar); phase3<true>(p, lds); if (REPK == 3) { xcd_barrier(bar); phase3<false>(p, lds); } }
    RUN_PHASE(4, phase4(p, lds))
    RUN_PHASE(5, phase5(p, lds))
    RUN_PHASE(6, phase6(p, lds))
    RUN_PHASE(7, phase7(p, lds))
    RUN_PHASE(8, phase8(p, lds))
    if (ph_lo <= 9 && 9 < ph_hi) { if (9 > ph_lo) xcd_barrier(bar); phase9a(p, lds); }
    if (ph_lo <= 9 && 9 < ph_hi) { xcd_barrier(bar); phase9c(p, lds); }
    if (ph_lo <= 9 && 9 < ph_hi) { xcd_barrier(bar); phase9b(p, lds); }
    RUN_PHASE(10, phase10(p, lds))
}

static void launch_mega(const Params& p, int lo, int hi, hipStream_t stream) {
    static int grid = 0;
    if (grid == 0) {
        int dev = 0, cus = 0, per_cu = 0;
        hipGetDevice(&dev); hipDeviceGetAttribute(&cus, hipDeviceAttributeMultiprocessorCount, dev);
        hipFuncSetAttribute((const void*)mega, hipFuncAttributeMaxDynamicSharedMemorySize, LDS_BYTES);
        hipOccupancyMaxActiveBlocksPerMultiprocessor(&per_cu, (const void*)mega, NTHR, LDS_BYTES);
        if (per_cu < 1) { fprintf(stderr, "mega: occupancy query says %d blocks/CU\n", per_cu); per_cu = 1; }
        grid = cus;
    }
    hipMemsetAsync(p.ws, 0, 65536, stream);
    Params pp = p; int l = lo, h = hi;
    void* args[] = {&pp, &l, &h};
    hipError_t e = hipLaunchCooperativeKernel((const void*)mega, dim3(grid), dim3(NTHR), args, LDS_BYTES, stream);
    if (e != hipSuccess) fprintf(stderr, "cooperative launch failed: %s (grid %d)\n", hipGetErrorString(e), grid);
}

extern "C" void kernel_launch(void* const* d_in, const int* in_sizes, int n_in, void* d_out, int out_size, void* d_ws, size_t ws_size, hipStream_t stream) {
    const float* x = (const float*)d_in[0]; const float* p = (const float*)d_in[1]; const float* mix_norm = (const float*)d_in[2]; const float* w_in = (const float*)d_in[3];
    const float* lb_logits = (const float*)d_in[4]; const float* hg_out_norm = (const float*)d_in[5]; const float* q_norm = (const float*)d_in[6]; const float* k_norm = (const float*)d_in[7];
    const float* cmp_pe = (const float*)d_in[8]; const float* cmp_w1 = (const float*)d_in[9]; const float* cmp_w2 = (const float*)d_in[10]; const float* nsa_out_norm = (const float*)d_in[11];
    const float* w_out = (const float*)d_in[12]; const float* ffn_norm = (const float*)d_in[13]; const float* peer_wq = (const float*)d_in[14]; const float* peer_keys = (const float*)d_in[15];
    const float* peer_u = (const float*)d_in[16]; const float* peer_v = (const float*)d_in[17]; const float* ple_proj = (const float*)d_in[18]; const float* ple_gate_norm = (const float*)d_in[19];
    const float* ple_gate_w = (const float*)d_in[20];
    float* out = (float*)d_out; unsigned char* ws = (unsigned char*)d_ws;
    bf16* act = (bf16*)(ws + WS_ACT); bf16* proj = (bf16*)(ws + WS_PROJ);
    bf16* pq = (bf16*)(ws + WS_PROJ); bf16* hg = (bf16*)(ws + WS_PROJ + 64 * MiB);
    int* ids = (int*)(ws + WS_IDS); float* wts = (float*)(ws + WS_WTS); float* kcf = (float*)(ws + WS_KCF); float* vcf = (float*)(ws + WS_VCF); float* gl = (float*)(ws + WS_GL);

    Params prm{}; for (int i = 0; i < 21; ++i) prm.in[i] = (const float*)d_in[i]; prm.out = out; prm.ws = ws;
    launch_mega(prm, 0, 11, stream);
}
```

```cpp
#include <hip/hip_runtime.h>
#include <hip/hip_cooperative_groups.h>
#include <cstdint>
#include <cstdio>
namespace cg = cooperative_groups;

constexpr int D = 1024, NB = 2, T = 8192, NTOK = NB * T;
constexpr int DIN = 3352, PS = 3392;
constexpr int C_HQ = 0, C_HF = 512, C_HI = 1024, C_HG = 1536, C_NQ = 2048, C_KC = 2560, C_VC = 2688,
              C_KS = 2816, C_VS = 2944, C_KW = 3072, C_VW = 3200, C_GT = 3328;
constexpr int NCMP = 511;
constexpr float EPS = 1e-6f;
typedef unsigned short bf16;

constexpr size_t MiB = 1u << 20;
constexpr size_t WS_WINT = 1 * MiB;
constexpr size_t WS_WOUTT = 8 * MiB;
constexpr size_t WS_WQT = 10 * MiB;
constexpr size_t WS_WGT = 14 * MiB;
constexpr size_t WS_WPT = 16 * MiB;
constexpr size_t WS_KEYB = 16 * MiB + 512 * 1024;
constexpr size_t WS_W1T = 17 * MiB;
constexpr size_t WS_CTR = 16384;
constexpr size_t WS_SSQ = 512 * 1024;
constexpr size_t WS_US = 256 * 1024;
constexpr size_t WS_VS = 320 * 1024;
constexpr size_t WS_UB = 18 * MiB;
constexpr size_t WS_VB = 50 * MiB;
constexpr size_t WS_ACT = 82 * MiB;
constexpr size_t WS_PROJ = 114 * MiB;
constexpr size_t WS_SPARE = 220 * MiB;
constexpr size_t WS_IDS = WS_SPARE;
constexpr size_t WS_WTS = WS_SPARE + 8 * MiB;
constexpr size_t WS_KCF = WS_SPARE + 16 * MiB;
constexpr size_t WS_VCF = WS_SPARE + 17 * MiB;
constexpr size_t WS_PB = WS_SPARE + 18 * MiB;
constexpr size_t WS_VTS = WS_SPARE + 26 * MiB;
constexpr size_t WS_VTW = WS_SPARE + 30 * MiB;
constexpr size_t WS_KFS = WS_SPARE;
constexpr size_t WS_KFW = WS_SPARE + 4 * MiB;
constexpr size_t WS_KC = WS_SPARE + 34 * MiB;
constexpr size_t WS_VCT = WS_SPARE + 34 * MiB + 256 * 1024;
constexpr size_t WS_DEC = WS_SPARE + 34 * MiB + 512 * 1024;
constexpr size_t OUT_KIT = 32 * MiB;
constexpr size_t OUT_VT = 48 * MiB;
constexpr size_t WS_GL = 18 * MiB;

__device__ __forceinline__ float bf2f(bf16 v) { return __uint_as_float(((unsigned)v) << 16); }
__device__ __forceinline__ bf16 f2bf(float f) { return __builtin_bit_cast(bf16, (__bf16)f); }
__device__ __forceinline__ float wave_sum(float v) {
#pragma unroll
    for (int o = 1; o < 64; o <<= 1) v += __shfl_xor(v, o);
    return v;
}
__device__ __forceinline__ float wave_max(float v) {
#pragma unroll
    for (int o = 1; o < 64; o <<= 1) v = fmaxf(v, __shfl_xor(v, o));
    return v;
}
__device__ __forceinline__ float sigmoidf_(float x) { return 1.0f / (1.0f + __expf(-x)); }
__device__ __forceinline__ float siluf_(float x) { return x * sigmoidf_(x); }
__device__ __forceinline__ float gelu_tanh(float x) { return 0.5f * x * (1.0f + tanhf(0.7978845608028654f * (x + 0.044715f * x * x * x))); }
__device__ __forceinline__ float toF(float v) { return v; }
__device__ __forceinline__ float toF(bf16 v) { return bf2f(v); }

__global__ void __launch_bounds__(256) k_rms_rows(const float* __restrict__ x, const float* __restrict__ g, bf16* __restrict__ out, int rows) {
    const int wave = (blockIdx.x * 256 + threadIdx.x) >> 6, lane = threadIdx.x & 63;
    if (wave >= rows) return;
    const float* xr = x + (size_t)wave * D;
    float v[16]; float s = 0.f;
#pragma unroll
    for (int j = 0; j < 16; ++j) { v[j] = xr[lane + 64 * j]; s += v[j] * v[j]; }
    s = wave_sum(s);
    const float r = rsqrtf(s * (1.0f / D) + EPS);
#pragma unroll
    for (int j = 0; j < 16; ++j) out[(size_t)wave * D + lane + 64 * j] = f2bf(v[j] * r * g[lane + 64 * j]);
}

struct EpiBf16 { bf16* C; int ldc; int pad; __device__ void operator()(int r, int c, float v) const { C[(size_t)r * ldc + c] = f2bf(v); } };
struct EpiF32 { float* C; int ldc; int pad; __device__ void operator()(int r, int c, float v) const { C[(size_t)r * ldc + c] = v; } };
struct EpiResid { const float* X; float* O; int ld; int pad; __device__ void operator()(int r, int c, float v) const { O[(size_t)r * ld + c] = X[(size_t)r * ld + c] + v; } };
struct EpiFinal { const float* G; float* O; int ld; int pad; __device__ void operator()(int r, int c, float v) const { const size_t i = (size_t)r * ld + c; O[i] = O[i] + v * sigmoidf_(G[i]); } };

template <typename AT, class Epi>
__global__ void __launch_bounds__(256) k_gemm_naive(const AT* __restrict__ A, int lda, const float* __restrict__ W, int ldw, int N, int K, Epi epi) {
    __shared__ float As[16][65];
    __shared__ float Bs[16][64];
    const int tid = threadIdx.x, tx = tid & 15, ty = tid >> 4;
    const int m0 = blockIdx.y * 64, n0 = blockIdx.x * 64;
    float acc[4][4];
#pragma unroll
    for (int i = 0; i < 4; ++i)
#pragma unroll
        for (int j = 0; j < 4; ++j) acc[i][j] = 0.f;
    for (int k0 = 0; k0 < K; k0 += 16) {
#pragma unroll
        for (int i = 0; i < 4; ++i) { const int idx = tid + i * 256, r = idx >> 4, kk = idx & 15; As[kk][r] = toF(A[(size_t)(m0 + r) * lda + k0 + kk]); }
#pragma unroll
        for (int i = 0; i < 4; ++i) { const int idx = tid + i * 256, kk = idx >> 6, c = idx & 63; Bs[kk][c] = (n0 + c < N) ? W[(size_t)(k0 + kk) * ldw + n0 + c] : 0.f; }
        __syncthreads();
#pragma unroll
        for (int kk = 0; kk < 16; ++kk) {
            float a[4], b[4];
#pragma unroll
            for (int i = 0; i < 4; ++i) a[i] = As[kk][ty * 4 + i];
#pragma unroll
            for (int j = 0; j < 4; ++j) b[j] = Bs[kk][tx * 4 + j];
#pragma unroll
            for (int i = 0; i < 4; ++i)
#pragma unroll
                for (int j = 0; j < 4; ++j) acc[i][j] += a[i] * b[j];
        }
        __syncthreads();
    }
#pragma unroll
    for (int i = 0; i < 4; ++i)
#pragma unroll
        for (int j = 0; j < 4; ++j) { const int r = m0 + ty * 4 + i, c = n0 + tx * 4 + j; if (c < N) epi(r, c, acc[i][j]); }
}

__global__ void __launch_bounds__(1024) k_hgrn_naive(const bf16* __restrict__ proj, const float* __restrict__ lb_logits, const float* __restrict__ out_gain, bf16* __restrict__ mixed) {
    const int b = blockIdx.x >> 2, h = blockIdx.x & 3, tid = threadIdx.x, v = tid & 127, kg = tid >> 7;
    __shared__ float qsh[128], ksh[128], fsh[128], vsh[128], part[8][128], red[2], lbs[128];
    if (tid < 128) { const float l0 = lb_logits[h * 128 + tid], l1 = lb_logits[512 + h * 128 + tid]; const float m = fmaxf(l0, l1); const float e0 = expf(l0 - m), e1 = expf(l1 - m); lbs[tid] = e0 / (e0 + e1); }
    float S[16];
#pragma unroll
    for (int i = 0; i < 16; ++i) S[i] = 0.f;
    __syncthreads();
    for (int t = 0; t < T; ++t) {
        const size_t row = (size_t)(b * T + t) * PS;
        if (tid < 128) {
            const float fl = bf2f(proj[row + C_HF + h * 128 + tid]); const float lb = lbs[tid];
            const float fg = lb + (1.0f - lb) * sigmoidf_(fl); fsh[tid] = fg; ksh[tid] = 1.0f - fg;
            qsh[tid] = siluf_(bf2f(proj[row + C_HQ + h * 128 + tid])) * 0.08838834764831845f;
        } else if (tid < 256) vsh[tid - 128] = bf2f(proj[row + C_HI + h * 128 + tid - 128]);
        __syncthreads();
        const float vv = vsh[v]; float p = 0.f;
#pragma unroll
        for (int i = 0; i < 16; ++i) { const int k = kg * 16 + i; S[i] = fsh[k] * S[i] + ksh[k] * vv; p += qsh[k] * S[i]; }
        part[kg][v] = p;
        __syncthreads();
        float o = 0.f;
        if (tid < 128) {
#pragma unroll
            for (int j = 0; j < 8; ++j) o += part[j][tid];
            const float ss = wave_sum(o * o); if ((tid & 63) == 0) red[tid >> 6] = ss;
        }
        __syncthreads();
        if (tid < 128) {
            const float tot = red[0] + red[1];
            const float y = o * rsqrtf(tot * (1.0f / 128.0f) + EPS) * out_gain[h * 128 + tid];
            const float gl = bf2f(proj[row + C_HG + h * 128 + tid]);
            mixed[(size_t)(b * T + t) * D + h * 128 + tid] = f2bf(y * siluf_(gl));
        }
    }
}

__global__ void __launch_bounds__(64) k_cmp_naive(const bf16* __restrict__ proj, const float* __restrict__ pe, const float* __restrict__ w1, const float* __restrict__ w2,
                                                  const float* __restrict__ k_gain, float* __restrict__ kc, float* __restrict__ vc) {
    int it = blockIdx.x; const int n = it % NCMP; it /= NCMP; const int g = it & 1; it >>= 1; const int b = it & 1; const int which = it >> 1;
    const int c = threadIdx.x;
    __shared__ float blk[2048]; __shared__ float hid[64];
    const int col0 = (which == 0 ? C_KC : C_VC) + g * 64;
    for (int i = c; i < 2048; i += 64) { const int j = i >> 6, d = i & 63; blk[i] = bf2f(proj[(size_t)(b * T + 16 * n + j) * PS + col0 + d]) + pe[which * 2048 + i]; }
    __syncthreads();
    float acc = 0.f;
    for (int i = 0; i < 2048; ++i) acc += blk[i] * w1[(size_t)which * 2048 * 64 + (size_t)i * 64 + c];
    hid[c] = gelu_tanh(acc);
    __syncthreads();
    float o = 0.f;
    for (int i = 0; i < 64; ++i) o += hid[i] * w2[which * 4096 + i * 64 + c];
    if (which == 0) { const float ss = wave_sum(o * o); o = o * rsqrtf(ss * (1.0f / 64.0f) + EPS) * k_gain[c]; }
    (which == 0 ? kc : vc)[((size_t)(b * 2 + g) * NCMP + n) * 64 + c] = o;
}

__global__ void __launch_bounds__(256) k_nsa_naive(const bf16* __restrict__ proj, const float* __restrict__ kc, const float* __restrict__ vc, const float* __restrict__ q_gain,
                                                   const float* __restrict__ k_gain, const float* __restrict__ out_gain, bf16* __restrict__ mixed) {
    const int g = blockIdx.x & 1, tok = blockIdx.x >> 1, b = tok / T, t = tok % T;
    const int tid = threadIdx.x, r = tid >> 6, lane = tid & 63, h = g * 4 + r;
    __shared__ float qs[4][64]; __shared__ float sc[4][1024]; __shared__ float P[520]; __shared__ float imp[128]; __shared__ int sel[128]; __shared__ int blist[16]; __shared__ int nbs;
    const float slope = exp2f(-(float)(h + 1));
    const float NEG = -__builtin_huge_valf();
    {
        float qv = bf2f(proj[(size_t)tok * PS + C_NQ + h * 64 + lane]);
        const float ss = wave_sum(qv * qv);
        qs[r][lane] = qv * rsqrtf(ss * (1.0f / 64.0f) + EPS) * q_gain[lane] * 0.125f;
    }
    __syncthreads();
    const int nvalid = (t >= 31) ? ((t - 31) / 16 + 1) : 0;
    const float* kcb = kc + (size_t)(b * 2 + g) * NCMP * 64; const float* vcb = vc + (size_t)(b * 2 + g) * NCMP * 64;
    float mx = NEG;
    for (int n = lane; n < 512; n += 64) {
        float s = NEG;
        if (n < nvalid) { float d = 0.f; for (int i = 0; i < 64; ++i) d += qs[r][i] * kcb[n * 64 + i]; s = d - slope * (float)(t - (16 * n + 31)); }
        sc[r][n] = s; mx = fmaxf(mx, s);
    }
    mx = wave_max(mx); if (mx == NEG) mx = 0.f;
    float sum = 0.f;
    for (int n = lane; n < 512; n += 64) { const float e = (n < nvalid) ? expf(sc[r][n] - mx) : 0.f; sc[r][n] = e; sum += e; }
    sum = wave_sum(sum); float inv = 1.0f / fmaxf(sum, 1e-30f);
    for (int n = lane; n < 512; n += 64) sc[r][n] *= inv;
    __syncthreads();
    float oc = 0.f;
    for (int n = 0; n < nvalid; ++n) oc += sc[r][n] * vcb[n * 64 + lane];
    for (int i = tid; i < 520; i += 256) P[i] = (i < 512) ? (sc[0][i] + sc[1][i] + sc[2][i] + sc[3][i]) : 0.f;
    __syncthreads();
    if (tid < 128) imp[tid] = P[4 * tid] + 2.f * P[4 * tid + 1] + 2.f * P[4 * tid + 2] + 2.f * P[4 * tid + 3] + P[4 * tid + 4];
    __syncthreads();
    const int cur = t >> 6;
    if (tid < 128) {
        const int j = tid; const bool forced = (j == 0) || (j == cur) || (j == cur - 1); const bool cand = !forced && j <= cur;
        const int nforced = (cur == 0) ? 1 : (cur == 1) ? 2 : 3; const int need = 16 - nforced;
        int rank = 0; const float mine = imp[j];
        for (int q = 1; q <= cur - 2; ++q) { if (q == j) continue; const float o = imp[q]; if (o > mine || (o == mine && q < j)) ++rank; }
        sel[j] = (forced || (cand && rank < need)) ? 1 : 0;
    }
    __syncthreads();
    if (tid == 0) { int nb = 0; for (int j = 0; j < 128; ++j) if (sel[j] && nb < 16) blist[nb++] = j; nbs = nb; }
    __syncthreads();
    const int nb = nbs;
    float os = 0.f;
    {
        float m2 = NEG;
        for (int s = 0; s < nb; ++s) {
            const int pos = blist[s] * 64 + lane; float val = NEG;
            if (pos <= t) {
                const bf16* kr = proj + (size_t)(b * T + pos) * PS + C_KS + g * 64; float d = 0.f, sq = 0.f;
                for (int i = 0; i < 64; ++i) { const float kv = bf2f(kr[i]); d += qs[r][i] * kv * k_gain[64 + i]; sq += kv * kv; }
                val = d * rsqrtf(sq * (1.0f / 64.0f) + EPS) - slope * (float)(t - pos);
            }
            sc[r][s * 64 + lane] = val; m2 = fmaxf(m2, val);
        }
        m2 = wave_max(m2); if (m2 == NEG) m2 = 0.f;
        float su = 0.f;
        for (int s = 0; s < nb; ++s) { const float v0 = sc[r][s * 64 + lane]; const float e = (v0 == NEG) ? 0.f : expf(v0 - m2); sc[r][s * 64 + lane] = e; su += e; }
        su = wave_sum(su); const float iv = 1.0f / fmaxf(su, 1e-30f);
        __syncthreads();
        for (int s = 0; s < nb; ++s) for (int i = 0; i < 64; ++i) {
            const float p = sc[r][s * 64 + i]; if (p != 0.f) os += p * bf2f(proj[(size_t)(b * T + blist[s] * 64 + i) * PS + C_VS + g * 64 + lane]); }
        os *= iv;
    }
    __syncthreads();
    float ow = 0.f;
    {
        float m2 = NEG;
        for (int i = lane; i < 512; i += 64) {
            const int pos = t - i; float val = NEG;
            if (pos >= 0) {
                const bf16* kr = proj + (size_t)(b * T + pos) * PS + C_KW + g * 64; float d = 0.f, sq = 0.f;
                for (int c = 0; c < 64; ++c) { const float kv = bf2f(kr[c]); d += qs[r][c] * kv * k_gain[128 + c]; sq += kv * kv; }
                val = d * rsqrtf(sq * (1.0f / 64.0f) + EPS) - slope * (float)i;
            }
            sc[r][i] = val; m2 = fmaxf(m2, val);
        }
        m2 = wave_max(m2);
        float su = 0.f;
        for (int i = lane; i < 512; i += 64) { const float v0 = sc[r][i]; const float e = (v0 == NEG) ? 0.f : expf(v0 - m2); sc[r][i] = e; su += e; }
        su = wave_sum(su); const float iv = 1.0f / fmaxf(su, 1e-30f);
        __syncthreads();
        for (int i = 0; i < 512; ++i) { const float p = sc[r][i]; if (p != 0.f) ow += p * bf2f(proj[(size_t)(b * T + t - i) * PS + C_VW + g * 64 + lane]); }
        ow *= iv;
    }
    const bf16* gl = proj + (size_t)tok * PS + C_GT + h * 3;
    const float o = sigmoidf_(bf2f(gl[0])) * oc + sigmoidf_(bf2f(gl[1])) * os + sigmoidf_(bf2f(gl[2])) * ow;
    const float ss = wave_sum(o * o);
    mixed[(size_t)tok * D + 512 + h * 64 + lane] = f2bf(o * rsqrtf(ss * (1.0f / 64.0f) + EPS) * out_gain[h * 64 + lane]);
}

__global__ void __launch_bounds__(128) k_peer_topk_naive(const bf16* __restrict__ pq, const float* __restrict__ keys, int* __restrict__ ids, float* __restrict__ wts) {
    const int tok = blockIdx.x >> 3, h = blockIdx.x & 7, k = threadIdx.x;
    __shared__ float q[256]; __shared__ float s[2][128]; __shared__ float ts[2][16]; __shared__ int ti[2][16]; __shared__ float cand[256]; __shared__ float bs[16]; __shared__ int bc[16];
    q[k] = bf2f(pq[(size_t)tok * 2048 + h * 256 + k]); q[k + 128] = bf2f(pq[(size_t)tok * 2048 + h * 256 + 128 + k]);
    __syncthreads();
#pragma unroll
    for (int c = 0; c < 2; ++c) { const float* kr = keys + ((size_t)(h * 2 + c) * 128 + k) * 128; float d = 0.f; for (int i = 0; i < 128; ++i) d += q[c * 128 + i] * kr[i]; s[c][k] = d; }
    __syncthreads();
#pragma unroll
    for (int c = 0; c < 2; ++c) { const float mine = s[c][k]; int rank = 0; for (int j = 0; j < 128; ++j) { const float o = s[c][j]; if (o > mine || (o == mine && j < k)) ++rank; } if (rank < 16) { ts[c][rank] = mine; ti[c][rank] = k; } }
    __syncthreads();
    cand[k] = ts[0][k >> 4] + ts[1][k & 15]; cand[k + 128] = ts[0][(k + 128) >> 4] + ts[1][(k + 128) & 15];
    __syncthreads();
#pragma unroll
    for (int e = 0; e < 2; ++e) { const int me = k + e * 128; const float mine = cand[me]; int rank = 0; for (int j = 0; j < 256; ++j) { const float o = cand[j]; if (o > mine || (o == mine && j < me)) ++rank; } if (rank < 16) { bs[rank] = mine; bc[rank] = me; } }
    __syncthreads();
    if (k < 16) {
        float mx = bs[0]; float sum = 0.f; for (int j = 0; j < 16; ++j) sum += expf(bs[j] - mx);
        const int c = bc[k]; ids[(size_t)tok * 128 + h * 16 + k] = ti[0][c >> 4] * 128 + ti[1][c & 15];
        wts[(size_t)tok * 128 + h * 16 + k] = expf(bs[k] - mx) / sum;
    }
}

__global__ void __launch_bounds__(256) k_peer_gather_naive(const bf16* __restrict__ hn, const int* __restrict__ ids, const float* __restrict__ wts, const float* __restrict__ U, const float* __restrict__ V,
                                                           const float* __restrict__ gnorm, float* __restrict__ hio, bf16* __restrict__ hg) {
    const int tok = blockIdx.x, tid = threadIdx.x, w = tid >> 6, lane = tid & 63;
    __shared__ float xs[1024]; __shared__ float coef[128]; __shared__ int eid[128]; __shared__ float red[4];
    for (int i = tid; i < 1024; i += 256) xs[i] = bf2f(hn[(size_t)tok * D + i]);
    if (tid < 128) eid[tid] = ids[(size_t)tok * 128 + tid];
    __syncthreads();
    for (int e = w * 32; e < w * 32 + 32; ++e) {
        const float* ur = U + (size_t)eid[e] * D; float d = 0.f;
        for (int i = lane; i < 1024; i += 64) d += ur[i] * xs[i];
        d = wave_sum(d);
        if (lane == 0) coef[e] = wts[(size_t)tok * 128 + e] * gelu_tanh(d);
    }
    __syncthreads();
    float o[4] = {0.f, 0.f, 0.f, 0.f};
    for (int e = 0; e < 128; ++e) { const float* vr = V + (size_t)eid[e] * D; const float c = coef[e];
#pragma unroll
        for (int j = 0; j < 4; ++j) o[j] += c * vr[tid + 256 * j]; }
    float ss = 0.f;
#pragma unroll
    for (int j = 0; j < 4; ++j) { o[j] += hio[(size_t)tok * D + tid + 256 * j]; hio[(size_t)tok * D + tid + 256 * j] = o[j]; ss += o[j] * o[j]; }
    ss = wave_sum(ss); if (lane == 0) red[w] = ss;
    __syncthreads();
    const float r = rsqrtf((red[0] + red[1] + red[2] + red[3]) * (1.0f / D) + EPS);
#pragma unroll
    for (int j = 0; j < 4; ++j) hg[(size_t)tok * D + tid + 256 * j] = f2bf(o[j] * r * gnorm[tid + 256 * j]);
}


typedef short bf16x8 __attribute__((ext_vector_type(8)));
typedef float f32x4 __attribute__((ext_vector_type(4)));
typedef float f32x16 __attribute__((ext_vector_type(16)));
typedef unsigned u32x4 __attribute__((ext_vector_type(4)));
typedef unsigned u32x2 __attribute__((ext_vector_type(2)));
constexpr int NTHR = 512;
constexpr int LDS_BYTES = 143360 + 16;
struct Params { const float* in[21]; float* out; unsigned char* ws; };

typedef __bf16 bf16x2c __attribute__((ext_vector_type(2)));
__device__ __forceinline__ unsigned pk2(float lo, float hi) { bf16x2c v = { (__bf16)lo, (__bf16)hi }; return __builtin_bit_cast(unsigned, v); }

__device__ __forceinline__ void transpose_tile(const float* __restrict__ W, int K, int N, bf16* __restrict__ Wt, int kt, int nt, float* tile) {
    const int tid = threadIdx.x, k0 = kt * 64, n0 = nt * 64;
#pragma unroll
    for (int i = 0; i < 8; ++i) { const int idx = tid + i * NTHR, kk = idx >> 6, nn = idx & 63; tile[kk * 65 + nn] = (n0 + nn < N) ? W[(size_t)(k0 + kk) * N + n0 + nn] : 0.f; }
    __syncthreads();
    { const int nn = tid >> 3, ch = tid & 7; const float* s = tile + (ch * 8) * 65 + nn;
      u32x4 o; o.x = pk2(s[0], s[65]); o.y = pk2(s[130], s[195]); o.z = pk2(s[260], s[325]); o.w = pk2(s[390], s[455]);
      *(u32x4*)(Wt + (size_t)(n0 + nn) * K + k0 + ch * 8) = o; }
    __syncthreads();
}
__device__ __forceinline__ void cvt_range(const float* __restrict__ src, bf16* __restrict__ dst, size_t n8, size_t gtid, size_t gthreads) {
    for (size_t i = gtid; i < n8; i += gthreads) {
        const f32x4 a = ((const f32x4*)src)[2 * i], b = ((const f32x4*)src)[2 * i + 1];
        u32x4 o; o.x = pk2(a.x, a.y); o.y = pk2(a.z, a.w); o.z = pk2(b.x, b.y); o.w = pk2(b.z, b.w);
        ((u32x4*)dst)[i] = o;
    }
}
__device__ __forceinline__ void rms_row_bf16(const float* __restrict__ xr, const float* __restrict__ g, bf16* __restrict__ orow, int lane) {
    f32x4 v[4]; float s = 0.f;
#pragma unroll
    for (int j = 0; j < 4; ++j) { v[j] = ((const f32x4*)xr)[lane + 64 * j]; s += v[j].x * v[j].x + v[j].y * v[j].y + v[j].z * v[j].z + v[j].w * v[j].w; }
    s = wave_sum(s);
    const float r = rsqrtf(s * (1.0f / D) + EPS);
#pragma unroll
    for (int j = 0; j < 4; ++j) { const f32x4 gg = ((const f32x4*)g)[lane + 64 * j]; u32x2 o; o.x = pk2(v[j].x * r * gg.x, v[j].y * r * gg.y); o.y = pk2(v[j].z * r * gg.z, v[j].w * r * gg.w); ((u32x2*)orow)[lane + 64 * j] = o; }
}

__device__ __forceinline__ void phase0(const Params& p, unsigned char* lds) {
    float* tile = (float*)lds;
    const int nblk = gridDim.x, blk = blockIdx.x;
    unsigned char* ws = p.ws;
    constexpr int I_WIN = 16 * 56, I_WOUT = 16 * 16, I_WQ = 16 * 32, I_WG = 16 * 16, I_WP = 4 * 16, I_W1 = 2 * 32;
    constexpr int NIT = I_WIN + I_WOUT + I_WQ + I_WG + I_WP + I_W1;
    for (int it = blk; it < NIT; it += nblk) {
        int r = it;
        if (r < I_WIN) { transpose_tile(p.in[3], 1024, DIN, (bf16*)(ws + WS_WINT), r / 56, r % 56, tile); continue; } r -= I_WIN;
        if (r < I_WOUT) { transpose_tile(p.in[12], 1024, 1024, (bf16*)(ws + WS_WOUTT), r / 16, r % 16, tile); continue; } r -= I_WOUT;
        if (r < I_WQ) { transpose_tile(p.in[14], 1024, 2048, (bf16*)(ws + WS_WQT), r / 32, r % 32, tile); continue; } r -= I_WQ;
        if (r < I_WG) { transpose_tile(p.in[20], 1024, 1024, (bf16*)(ws + WS_WGT), r / 16, r % 16, tile); continue; } r -= I_WG;
        if (r < I_WP) { transpose_tile(p.in[18], 256, 1024, (bf16*)(ws + WS_WPT), r / 16, r % 16, tile); continue; } r -= I_WP;
        { const int which = r / 32, kt = r % 32; transpose_tile(p.in[9] + (size_t)which * 2048 * 64, 2048, 64, (bf16*)(ws + WS_W1T) + (size_t)which * 64 * 2048, kt, 0, tile); }
    }
    const size_t gtid = (size_t)blk * NTHR + threadIdx.x, gthreads = (size_t)nblk * NTHR;
    cvt_range(p.in[15], (bf16*)(ws + WS_KEYB), (size_t)8 * 2 * 128 * 128 / 8, gtid, gthreads);
    cvt_range(p.in[1], (bf16*)(ws + WS_PB), (size_t)NTOK * 256 / 8, gtid, gthreads);
    const int gw = (int)(gtid >> 6), ngw = (int)(gthreads >> 6), lane = threadIdx.x & 63;
    for (int m = gw; m < NTOK; m += ngw) rms_row_bf16(p.in[0] + (size_t)m * D, p.in[2], (bf16*)(ws + WS_ACT) + (size_t)m * D, lane);
    for (int m = gw; m < 2 * 16384; m += ngw) {
        const int which = m >> 14, row = m & 16383;
        const float* src = p.in[16 + which] + (size_t)row * D + lane * 16;
        const f32x4 a = *(const f32x4*)src, b = *(const f32x4*)(src + 4), c = *(const f32x4*)(src + 8), d = *(const f32x4*)(src + 12);
        float mx = fmaxf(fmaxf(fmaxf(fabsf(a.x), fabsf(a.y)), fmaxf(fabsf(a.z), fabsf(a.w))), fmaxf(fmaxf(fabsf(b.x), fabsf(b.y)), fmaxf(fabsf(b.z), fabsf(b.w))));
        mx = fmaxf(mx, fmaxf(fmaxf(fmaxf(fabsf(c.x), fabsf(c.y)), fmaxf(fabsf(c.z), fabsf(c.w))), fmaxf(fmaxf(fabsf(d.x), fabsf(d.y)), fmaxf(fabsf(d.z), fabsf(d.w)))));
        mx = fmaxf(wave_max(mx), 1e-30f);
        const float sc = 224.0f / mx;
        u32x4 o; int w;
        w = __builtin_amdgcn_cvt_pk_fp8_f32(a.x * sc, a.y * sc, 0, false); w = __builtin_amdgcn_cvt_pk_fp8_f32(a.z * sc, a.w * sc, w, true); o.x = (unsigned)w;
        w = __builtin_amdgcn_cvt_pk_fp8_f32(b.x * sc, b.y * sc, 0, false); w = __builtin_amdgcn_cvt_pk_fp8_f32(b.z * sc, b.w * sc, w, true); o.y = (unsigned)w;
        w = __builtin_amdgcn_cvt_pk_fp8_f32(c.x * sc, c.y * sc, 0, false); w = __builtin_amdgcn_cvt_pk_fp8_f32(c.z * sc, c.w * sc, w, true); o.z = (unsigned)w;
        w = __builtin_amdgcn_cvt_pk_fp8_f32(d.x * sc, d.y * sc, 0, false); w = __builtin_amdgcn_cvt_pk_fp8_f32(d.z * sc, d.w * sc, w, true); o.w = (unsigned)w;
        *(u32x4*)(ws + (which ? WS_VB : WS_UB) + (size_t)(lane >> 3) * (16384 * 128) + (size_t)row * 128 + (lane & 7) * 16) = o;
        if (lane == 0) ((float*)(ws + (which ? WS_VS : WS_US)))[row] = mx * (1.0f / 224.0f);
    }
}

__device__ __forceinline__ int swz(int ob) { return ob ^ (((ob >> 9) & 1) << 5); }
constexpr int G_STAGE = 49152;
__device__ __forceinline__ void gemm_mainloop(f32x4 (&acc)[4][4], const bf16* __restrict__ A, int lda, const bf16* __restrict__ Bt, int ldb, int K, int m0, int n0, unsigned char* lds) {
    const int tid = threadIdx.x, lane = tid & 63, wid = tid >> 6, wm = wid >> 1, wn = wid & 1, fr = lane & 15, fq = lane >> 4;
    const int lrow = tid >> 3, lc = tid & 7;
    const bf16* ag = A + (size_t)(m0 + lrow) * lda + lc * 8;
    const bf16* bg = Bt + (size_t)(n0 + lrow) * ldb + lc * 8;
    const int woff = ((lrow >> 4) * 2 + (lc >> 2)) * 1024 + swz((lrow & 15) * 64 + (lc & 3) * 16);
    const int roff = swz(fr * 64 + fq * 16);
    const int nk = K >> 6;
    u32x4 ra0[4], rb0[2], ra1[4], rb1[2];
#define GM_LOAD(ra, rb, kt) { _Pragma("unroll") for (int i = 0; i < 4; ++i) ra[i] = *(const u32x4*)(ag + (size_t)i * 64 * lda + (kt) * 64); \
                              _Pragma("unroll") for (int i = 0; i < 2; ++i) rb[i] = *(const u32x4*)(bg + (size_t)i * 64 * ldb + (kt) * 64); }
#define GM_STORE(ra, rb, buf) { _Pragma("unroll") for (int i = 0; i < 4; ++i) *(u32x4*)((buf) + woff + i * 8192) = ra[i]; \
                                _Pragma("unroll") for (int i = 0; i < 2; ++i) *(u32x4*)((buf) + 32768 + woff + i * 8192) = rb[i]; }
#define GM_COMPUTE(cur) { _Pragma("unroll") for (int s = 0; s < 2; ++s) { bf16x8 af[4], bfr[4]; \
        _Pragma("unroll") for (int i = 0; i < 4; ++i) af[i] = *(const bf16x8*)((cur) + ((wm * 4 + i) * 2 + s) * 1024 + roff); \
        _Pragma("unroll") for (int i = 0; i < 4; ++i) bfr[i] = *(const bf16x8*)((cur) + 32768 + ((wn * 4 + i) * 2 + s) * 1024 + roff); \
        _Pragma("unroll") for (int mi = 0; mi < 4; ++mi) _Pragma("unroll") for (int ni = 0; ni < 4; ++ni) acc[mi][ni] = __builtin_amdgcn_mfma_f32_16x16x32_bf16(bfr[ni], af[mi], acc[mi][ni], 0, 0, 0); } }
    unsigned char* buf0 = lds; unsigned char* buf1 = lds + G_STAGE;
    GM_LOAD(ra0, rb0, 0)
    GM_LOAD(ra1, rb1, 1)
    GM_STORE(ra0, rb0, buf0)
    __syncthreads();
    for (int kt = 0; kt < nk; kt += 2) {
        { const int kp = (kt + 2 < nk) ? kt + 2 : kt; GM_LOAD(ra0, rb0, kp) }
        GM_COMPUTE(buf0)
        GM_STORE(ra1, rb1, buf1)
        __syncthreads();
        { const int kp = (kt + 3 < nk) ? kt + 3 : kt + 1; GM_LOAD(ra1, rb1, kp) }
        GM_COMPUTE(buf1)
        if (kt + 2 < nk) GM_STORE(ra0, rb0, buf0)
        __syncthreads();
    }
}
__device__ __forceinline__ void acc_zero(f32x4 (&acc)[4][4]) {
#pragma unroll
    for (int i = 0; i < 4; ++i)
#pragma unroll
        for (int j = 0; j < 4; ++j) acc[i][j] = (f32x4){0.f, 0.f, 0.f, 0.f};
}
namespace pg8 {
#define PG8_LAS __attribute__((address_space(3)))
typedef unsigned short bf16_t;
typedef short bf16x8 __attribute__((ext_vector_type(8)));
typedef float f32x4 __attribute__((ext_vector_type(4)));
typedef unsigned u32x4 __attribute__((ext_vector_type(4)));
constexpr int BM = 256, BK = 64, HALF = 128, HTB = HALF * BK * 2  , STAGE_BYTES = 8 * HTB, NXCD = 8, WGM = 8;

__host__ __device__ __forceinline__ int lds_byte(int r, int c) { const int st = (r >> 4) * 2 + (c >> 5), rr = r & 15, cc = c & 31, ob = rr * 64 + cc * 2; return st * 1024 + (ob ^ (((ob >> 9) & 1) << 5)); }
__host__ __device__ __forceinline__ void stage_rc(int b, int& R, int& C) { const int st = b / 1024, sb = b % 1024, swz = sb ^ (((sb >> 9) & 1) << 5); R = (st >> 1) * 16 + swz / 64; C = (st & 1) * 32 + (swz % 64) / 2; }
__host__ __device__ __forceinline__ int perm32(int rho) { const int n = rho >> 4, i = rho & 15; return 8 * (i >> 2) + 4 * n + (i & 3); }

struct Unit { int pm, pn; };
struct Gemm { const bf16_t* A; const bf16_t* Bt; int M, N, K; };

struct StaticOrder {
    int nM, nN, nwg, G, c;
    __host__ __device__ void init(int M, int N, int G_, int c_) { nM = M / BM; nN = N / BM; nwg = nM * nN; G = G_; c = c_; }
    __host__ __device__ bool next(int i, Unit& u) const {
        const long L = (long)i * G + c; if (L >= nwg) return false;
        int wgid = (int)L; { const int q = nwg / NXCD, r = nwg % NXCD, xcd = wgid % NXCD, off = wgid / NXCD; wgid = (xcd < r ? xcd * (q + 1) : r * (q + 1) + (xcd - r) * q) + off; }
        const int nig = WGM * nN, gid = wgid / nig, fm = gid * WGM, gsz = (nM - fm) < WGM ? (nM - fm) : WGM;
        u.pm = fm + ((wgid % nig) % gsz); u.pn = (wgid % nig) / gsz; return true;
    }
    __device__ __forceinline__ void a_ready(const Unit&) const {}
    __device__ __forceinline__ void done(const Unit&) const {}
};

__device__ __forceinline__ unsigned pk2b(float lo, float hi) { typedef __bf16 b2 __attribute__((ext_vector_type(2))); b2 v = { (__bf16)lo, (__bf16)hi }; return __builtin_bit_cast(unsigned, v); }
typedef unsigned u32x2 __attribute__((ext_vector_type(2)));
struct EpiStoreBf16 {
    static constexpr bool PERM = false, AFTER_DRAIN = false;
    bf16_t* C; int ldc; int ncols;
    __device__ __forceinline__ void operator()(const f32x4 (&acc)[2][2][4][2], const Unit& u, int wr, int wc, int fr, int fq) const {
#pragma unroll
        for (int ai = 0; ai < 2; ++ai)
#pragma unroll
            for (int m = 0; m < 4; ++m) { bf16_t* rowp = C + (size_t)(u.pm * BM + ai * HALF + wr * 64 + m * 16 + fr) * ldc;
#pragma unroll
                for (int bj = 0; bj < 2; ++bj)
#pragma unroll
                    for (int n = 0; n < 2; ++n) { const int col = u.pn * BM + bj * HALF + wc * 32 + n * 16 + fq * 4;
                        if (col < ncols) { u32x2 w; w.x = pk2b(acc[ai][bj][m][n][0], acc[ai][bj][m][n][1]); w.y = pk2b(acc[ai][bj][m][n][2], acc[ai][bj][m][n][3]); *(u32x2*)(rowp + col) = w; } } }
    }
};
struct EpiResidF32 {
    static constexpr bool PERM = false, AFTER_DRAIN = false;
    const float* X; float* O; int ld; int pad;
    __device__ __forceinline__ void operator()(const f32x4 (&acc)[2][2][4][2], const Unit& u, int wr, int wc, int fr, int fq) const {
#pragma unroll
        for (int ai = 0; ai < 2; ++ai)
#pragma unroll
            for (int m = 0; m < 4; ++m) { const size_t ro = (size_t)(u.pm * BM + ai * HALF + wr * 64 + m * 16 + fr) * ld;
#pragma unroll
                for (int bj = 0; bj < 2; ++bj)
#pragma unroll
                    for (int n = 0; n < 2; ++n) { const size_t idx = ro + u.pn * BM + bj * HALF + wc * 32 + n * 16 + fq * 4; *(f32x4*)(O + idx) = *(const f32x4*)(X + idx) + acc[ai][bj][m][n]; } }
    }
};
struct EpiFinalGate {
    static constexpr bool PERM = false, AFTER_DRAIN = false;
    const bf16_t* PL; const float* SSQ; float* O; int ld; int ntok; float eps; int pad;
    __device__ __forceinline__ void operator()(const f32x4 (&acc)[2][2][4][2], const Unit& u, int wr, int wc, int fr, int fq) const {
#pragma unroll
        for (int ai = 0; ai < 2; ++ai)
#pragma unroll
            for (int m = 0; m < 4; ++m) { const int row = u.pm * BM + ai * HALF + wr * 64 + m * 16 + fr; const size_t ro = (size_t)row * ld;
                float tot = 0.f;
#pragma unroll
                for (int x = 0; x < 8; ++x) tot += SSQ[(size_t)x * ntok + row];
                const float rs = 1.0f / sqrtf(tot * (1.0f / 1024.0f) + eps);
#pragma unroll
                for (int bj = 0; bj < 2; ++bj)
#pragma unroll
                    for (int n = 0; n < 2; ++n) { const size_t idx = ro + u.pn * BM + bj * HALF + wc * 32 + n * 16 + fq * 4;
                        const u32x2 pw = *(const u32x2*)(PL + idx); const unsigned px = pw.x, py = pw.y;
                        f32x4 pv; pv.x = __uint_as_float(px << 16); pv.y = __uint_as_float(px & 0xffff0000u); pv.z = __uint_as_float(py << 16); pv.w = __uint_as_float(py & 0xffff0000u);
                        f32x4 g;
#pragma unroll
                        for (int e = 0; e < 4; ++e) g[e] = 1.0f / (1.0f + __expf(-rs * acc[ai][bj][m][n][e]));
                        *(f32x4*)(O + idx) = *(const f32x4*)(O + idx) + pv * g; } }
    }
};

template <class Epi, class Sched, bool ALIGN_EPI = false, bool SP2 = false>
__device__ __forceinline__ void gemm_phase(PG8_LAS unsigned char* lds, const Gemm g, const Sched& S, const Epi& E) {
    const int tid = threadIdx.x, wid = __builtin_amdgcn_readfirstlane(tid >> 6), lane = tid & 63, wr = wid >> 2, wc = wid & 3, fr = lane & 15, fq = lane >> 4;
    const int K = g.K, nt = K / BK;
    unsigned voffA[2], voffB[2];
#pragma unroll
    for (int i = 0; i < 2; ++i) { int R, C; stage_rc(tid * 16 + i * 8192, R, C); const int Rb = Epi::PERM ? ((R & ~31) + perm32(R & 31)) : R;
        voffA[i] = (unsigned)(R * K + C) * 2u; voffB[i] = (unsigned)(Rb * K + C) * 2u; }
    const size_t kstep = (size_t)(BK * 2);
    const size_t hstep = (size_t)HALF * K * 2;
    const size_t tstep = 2 * hstep;
    const unsigned ldsw = (unsigned)wid * 1024u;
    const int aoff = lds_byte(wr * 64 + fr, fq * 8), boff = lds_byte(wc * 32 + fr, fq * 8);
#define PG8_SA(b, h) (((b) * 2 + (h)) * HTB)
#define PG8_SB(b, h) ((4 + (b) * 2 + (h)) * HTB)
#define PG8_STAGE(bufoff, gbase, voff) do { _Pragma("unroll") for (int _i = 0; _i < 2; ++_i) \
        __builtin_amdgcn_global_load_lds((const unsigned*)((const char*)(gbase) + (voff)[_i]), (PG8_LAS unsigned*)(lds + (bufoff) + ldsw + _i * 8192), 16, 0, 0); } while (0)
#define PG8_LDA(dst, b, h) do { _Pragma("unroll") for (int m = 0; m < 4; ++m) _Pragma("unroll") for (int k = 0; k < 2; ++k) dst[m][k] = *(const PG8_LAS bf16x8*)(lds + PG8_SA(b, h) + aoff + m * 2048 + k * 1024); } while (0)
#define PG8_LDB(dst, b, h) do { _Pragma("unroll") for (int n = 0; n < 2; ++n) _Pragma("unroll") for (int k = 0; k < 2; ++k) dst[n][k] = *(const PG8_LAS bf16x8*)(lds + PG8_SB(b, h) + boff + n * 2048 + k * 1024); } while (0)
#define PG8_MMA(ai, bj, At, Bt) do { __builtin_amdgcn_s_setprio(1); _Pragma("unroll") for (int m = 0; m < 4; ++m) _Pragma("unroll") for (int n = 0; n < 2; ++n) _Pragma("unroll") for (int k = 0; k < 2; ++k) \
        acc[ai][bj][m][n] = __builtin_amdgcn_mfma_f32_16x16x32_bf16(Bt[n][k], At[m][k], acc[ai][bj][m][n], 0, 0, 0); __builtin_amdgcn_s_setprio(0); } while (0)
#define PG8_WAIT_V(n) asm volatile("s_waitcnt vmcnt(" #n ")" ::: "memory")
#define PG8_WAIT_L(n) asm volatile("s_waitcnt lgkmcnt(" #n ")" ::: "memory")
#define PG8_BAR __builtin_amdgcn_s_barrier()
#define PG8_SCHED __builtin_amdgcn_sched_barrier(0)
    Unit cur, nxt; int ui = 0;
    if (!S.next(0, cur)) return;
    f32x4 acc[2][2][4][2];
#pragma unroll
    for (int a = 0; a < 2; ++a)
#pragma unroll
        for (int b = 0; b < 2; ++b)
#pragma unroll
            for (int m = 0; m < 4; ++m)
#pragma unroll
                for (int n = 0; n < 2; ++n) acc[a][b][m][n] = (f32x4){0.f, 0.f, 0.f, 0.f};
    bf16x8 At[4][2], B0[2][2], B1[2][2];
    const char* cA = (const char*)g.A + (size_t)cur.pm * tstep; const char* cB = (const char*)g.Bt + (size_t)cur.pn * tstep;
    S.a_ready(cur);
    if constexpr (SP2) {
        PG8_STAGE(PG8_SB(0, 0), cB, voffB); PG8_STAGE(PG8_SB(0, 1), cB + hstep, voffB); PG8_STAGE(PG8_SA(0, 0), cA, voffA); PG8_STAGE(PG8_SA(0, 1), cA + hstep, voffA);
        if (wr == 1) PG8_BAR;
        PG8_WAIT_V(2); PG8_BAR;
        PG8_STAGE(PG8_SB(1, 0), cB + kstep, voffB); PG8_STAGE(PG8_SA(1, 0), cA + kstep, voffA); PG8_STAGE(PG8_SB(1, 1), cB + hstep + kstep, voffB);
        PG8_WAIT_V(6); PG8_BAR;
    } else {
        PG8_STAGE(PG8_SB(0, 0), cB, voffB); PG8_STAGE(PG8_SA(0, 0), cA, voffA); PG8_STAGE(PG8_SB(0, 1), cB + hstep, voffB); PG8_STAGE(PG8_SA(0, 1), cA + hstep, voffA);
        if (wr == 1) PG8_BAR;
        PG8_WAIT_V(4); PG8_BAR;
        PG8_STAGE(PG8_SB(1, 0), cB + kstep, voffB); PG8_STAGE(PG8_SA(1, 0), cA + kstep, voffA); PG8_STAGE(PG8_SB(1, 1), cB + hstep + kstep, voffB);
        PG8_WAIT_V(6); PG8_BAR;
    }
    for (;;) {
        const bool has_next = S.next(ui + 1, nxt);
        const char* nA = has_next ? (const char*)g.A + (size_t)nxt.pm * tstep : cA; const char* nB = has_next ? (const char*)g.Bt + (size_t)nxt.pn * tstep : cB;
        for (int t = 0; t < nt; t += 2) {
            const bool last = (t == nt - 2);
            const char* a1 = cA + (size_t)(t + 1) * kstep;
            const char* a2 = last ? nA : cA + (size_t)(t + 2) * kstep; const char* b2 = last ? nB : cB + (size_t)(t + 2) * kstep;
            const char* a3 = a2 + kstep; const char* b3 = b2 + kstep;
            if (last && has_next) S.a_ready(nxt);
            if constexpr (SP2) {
            PG8_LDB(B0, 0, 0); PG8_LDB(B1, 0, 1); PG8_SCHED; PG8_LDA(At, 0, 0); PG8_STAGE(PG8_SA(1, 1), a1 + hstep, voffA);
            PG8_WAIT_V(8); PG8_WAIT_L(0); PG8_BAR; PG8_MMA(0, 0, At, B0); PG8_MMA(0, 1, At, B1); PG8_BAR; PG8_SCHED;
            PG8_LDA(At, 0, 1); PG8_STAGE(PG8_SB(0, 0), b2, voffB); PG8_STAGE(PG8_SB(0, 1), b2 + hstep, voffB); PG8_STAGE(PG8_SA(0, 0), a2, voffA);
            PG8_WAIT_V(8); PG8_WAIT_L(0); PG8_BAR; PG8_MMA(1, 0, At, B0); PG8_MMA(1, 1, At, B1); PG8_BAR; PG8_SCHED;
            PG8_LDB(B0, 1, 0); PG8_LDB(B1, 1, 1); PG8_SCHED; PG8_LDA(At, 1, 0); PG8_STAGE(PG8_SA(0, 1), a2 + hstep, voffA);
            PG8_WAIT_V(8); PG8_WAIT_L(0); PG8_BAR; PG8_MMA(0, 0, At, B0); PG8_MMA(0, 1, At, B1); PG8_BAR; PG8_SCHED;
            PG8_LDA(At, 1, 1); PG8_STAGE(PG8_SB(1, 0), b3, voffB); PG8_STAGE(PG8_SB(1, 1), b3 + hstep, voffB); PG8_STAGE(PG8_SA(1, 0), a3, voffA);
            PG8_WAIT_V(8); PG8_WAIT_L(0); PG8_BAR; PG8_MMA(1, 0, At, B0); PG8_MMA(1, 1, At, B1); PG8_BAR; PG8_SCHED;
            } else {
            PG8_LDB(B0, 0, 0); PG8_SCHED; PG8_LDA(At, 0, 0); PG8_STAGE(PG8_SA(1, 1), a1 + hstep, voffA);
            PG8_WAIT_L(8); PG8_BAR; PG8_WAIT_L(0); PG8_MMA(0, 0, At, B0); PG8_BAR; PG8_SCHED;
            PG8_LDB(B1, 0, 1); PG8_STAGE(PG8_SB(0, 0), b2, voffB);
            PG8_BAR; PG8_WAIT_L(0); PG8_MMA(0, 1, At, B1); PG8_BAR;
            PG8_LDA(At, 0, 1); PG8_STAGE(PG8_SA(0, 0), a2, voffA);
            PG8_BAR; PG8_WAIT_L(0); PG8_MMA(1, 0, At, B0); PG8_BAR; PG8_SCHED;
            PG8_STAGE(PG8_SB(0, 1), b2 + hstep, voffB);
            PG8_WAIT_V(6); PG8_BAR; PG8_MMA(1, 1, At, B1); PG8_BAR;
            PG8_LDB(B0, 1, 0); PG8_SCHED; PG8_LDA(At, 1, 0); PG8_STAGE(PG8_SA(0, 1), a2 + hstep, voffA);
            PG8_WAIT_L(8); PG8_BAR; PG8_WAIT_L(0); PG8_MMA(0, 0, At, B0); PG8_BAR; PG8_SCHED;
            PG8_LDB(B1, 1, 1); PG8_STAGE(PG8_SB(1, 0), b3, voffB);
            PG8_BAR; PG8_WAIT_L(0); PG8_MMA(0, 1, At, B1); PG8_BAR;
            PG8_LDA(At, 1, 1); PG8_STAGE(PG8_SA(1, 0), a3, voffA);
            PG8_BAR; PG8_WAIT_L(0); PG8_MMA(1, 0, At, B0); PG8_BAR; PG8_SCHED;
            PG8_STAGE(PG8_SB(1, 1), b3 + hstep, voffB);
            PG8_WAIT_V(6); PG8_BAR; PG8_MMA(1, 1, At, B1); PG8_BAR;
            }
        }
        if constexpr (ALIGN_EPI) { if (wr == 0) PG8_BAR; }
        if constexpr (!Epi::AFTER_DRAIN) { E(acc, cur, wr, wc, fr, fq); S.done(cur); }
        if (!has_next) break;
#pragma unroll
        for (int a = 0; a < 2; ++a)
#pragma unroll
            for (int b = 0; b < 2; ++b)
#pragma unroll
                for (int m = 0; m < 4; ++m)
#pragma unroll
                    for (int n = 0; n < 2; ++n) acc[a][b][m][n] = (f32x4){0.f, 0.f, 0.f, 0.f};
        cur = nxt; cA = nA; cB = nB; ++ui;
        if constexpr (ALIGN_EPI) { if (wr == 1) PG8_BAR; }
    }
    PG8_WAIT_V(0);
    if constexpr (!ALIGN_EPI) { if (wr == 0) PG8_BAR; }
    PG8_BAR;
    if constexpr (Epi::AFTER_DRAIN) { E.fused(acc, cur, wr, wc, fr, fq, lds, wid, lane); S.done(cur); }
#undef PG8_SA
#undef PG8_SB
#undef PG8_STAGE
#undef PG8_LDA
#undef PG8_LDB
#undef PG8_MMA
#undef PG8_WAIT_V
#undef PG8_WAIT_L
#undef PG8_BAR
#undef PG8_SCHED
}
}

__device__ __forceinline__ void phase1(const Params& p, unsigned char* lds) {
    pg8::Gemm g{(const bf16*)(p.ws + WS_ACT), (const bf16*)(p.ws + WS_WINT), NTOK, 3584, D}; pg8::StaticOrder S; S.init(NTOK, 3584, (int)gridDim.x, (int)blockIdx.x);
    pg8::EpiStoreBf16 E{(bf16*)(p.ws + WS_PROJ), PS, DIN};
    pg8::gemm_phase<pg8::EpiStoreBf16, pg8::StaticOrder, true, true>((PG8_LAS unsigned char*)lds, g, S, E);
}


__device__ __forceinline__ void phase5(const Params& p, unsigned char* lds) {
    pg8::Gemm g{(const bf16*)(p.ws + WS_ACT), (const bf16*)(p.ws + WS_WOUTT), NTOK, D, D}; pg8::StaticOrder S; S.init(NTOK, D, (int)gridDim.x, (int)blockIdx.x);
    pg8::EpiResidF32 E{p.in[0], p.out, D, 0};
    pg8::gemm_phase<pg8::EpiResidF32, pg8::StaticOrder, true, true>((PG8_LAS unsigned char*)lds, g, S, E);
}
__device__ __forceinline__ void phase6(const Params& p, unsigned char* lds) {
    const int gw = (blockIdx.x * NTHR + threadIdx.x) >> 6, ngw = (gridDim.x * NTHR) >> 6, lane = threadIdx.x & 63;
    for (int m = gw; m < NTOK; m += ngw) rms_row_bf16(p.out + (size_t)m * D, p.in[13], (bf16*)(p.ws + WS_ACT) + (size_t)m * D, lane);
}
__device__ __forceinline__ void phase7(const Params& p, unsigned char* lds) {
    pg8::Gemm g{(const bf16*)(p.ws + WS_ACT), (const bf16*)(p.ws + WS_WQT), NTOK, 2048, D}; pg8::StaticOrder S; S.init(NTOK, 2048, (int)gridDim.x, (int)blockIdx.x);
    pg8::EpiStoreBf16 E{(bf16*)(p.ws + WS_PROJ), 2048, 2048};
    pg8::gemm_phase<pg8::EpiStoreBf16, pg8::StaticOrder, true, true>((PG8_LAS unsigned char*)lds, g, S, E);
}
__device__ __forceinline__ void phase10(const Params& p, unsigned char* lds) {
    {
        pg8::Gemm g{(const bf16*)(p.ws + WS_PB), (const bf16*)(p.ws + WS_WPT), NTOK, D, 256}; pg8::StaticOrder S; S.init(NTOK, D, (int)gridDim.x, (int)blockIdx.x);
        pg8::EpiStoreBf16 E{(bf16*)(p.ws + WS_ACT), D, D};
        pg8::gemm_phase<pg8::EpiStoreBf16, pg8::StaticOrder, true, true>((PG8_LAS unsigned char*)lds, g, S, E);
    }
    {
        pg8::Gemm g{(const bf16*)(p.ws + WS_PROJ + 64 * MiB), (const bf16*)(p.ws + WS_WGT), NTOK, D, D}; pg8::StaticOrder S; S.init(NTOK, D, (int)gridDim.x, (int)blockIdx.x);
        pg8::EpiFinalGate E{(const bf16*)(p.ws + WS_ACT), (const float*)(p.ws + WS_SSQ), p.out, D, NTOK, EPS, 0};
        pg8::gemm_phase<pg8::EpiFinalGate, pg8::StaticOrder, true, true>((PG8_LAS unsigned char*)lds, g, S, E);
    }
}

typedef __bf16 bf16x2v __attribute__((ext_vector_type(2)));
template <int CTRL> __device__ __forceinline__ float dpp_f(float v) { return __int_as_float(__builtin_amdgcn_update_dpp(0, __float_as_int(v), CTRL, 0xF, 0xF, false)); }
__device__ __forceinline__ float grp16_max(float v) { v = fmaxf(v, dpp_f<0xB1>(v)); v = fmaxf(v, dpp_f<0x4E>(v)); v = fmaxf(v, dpp_f<0x141>(v)); v = fmaxf(v, dpp_f<0x140>(v)); return v; }
__device__ __forceinline__ float grp16_sum(float v) { v += dpp_f<0xB1>(v); v += dpp_f<0x4E>(v); v += dpp_f<0x141>(v); v += dpp_f<0x140>(v); return v; }
#define CE_DESC(a, b) { const float _hi = fmaxf(a, b), _lo = fminf(a, b); a = _hi; b = _lo; }
__device__ __forceinline__ float grp16_top16(float (&v)[8], int lig) {
    CE_DESC(v[0], v[1]) CE_DESC(v[2], v[3]) CE_DESC(v[4], v[5]) CE_DESC(v[6], v[7])
    CE_DESC(v[0], v[2]) CE_DESC(v[1], v[3]) CE_DESC(v[4], v[6]) CE_DESC(v[5], v[7])
    CE_DESC(v[1], v[2]) CE_DESC(v[5], v[6])
    CE_DESC(v[0], v[4]) CE_DESC(v[1], v[5]) CE_DESC(v[2], v[6]) CE_DESC(v[3], v[7])
    CE_DESC(v[2], v[4]) CE_DESC(v[3], v[5])
    CE_DESC(v[1], v[2]) CE_DESC(v[3], v[4]) CE_DESC(v[5], v[6])
    float top = 0.f;
#pragma unroll
    for (int r = 0; r < 16; ++r) {
        const float m = grp16_max(v[0]);
        if (lig == r) top = m;
        const bool own = (v[0] == m);
#pragma unroll
        for (int j = 0; j < 7; ++j) v[j] = own ? v[j + 1] : v[j];
        v[7] = own ? -3.0e38f : v[7];
    }
    return top;
}
__device__ __forceinline__ void phase8(const Params& p, unsigned char* lds) {
    const bf16* PQ = (const bf16*)(p.ws + WS_PROJ); const bf16* KB = (const bf16*)(p.ws + WS_KEYB);
    int* ids = (int*)(p.ws + WS_IDS); float* wts = (float*)(p.ws + WS_WTS);
    float* S = (float*)lds;
    const int tid = threadIdx.x, lane = tid & 63, wid = tid >> 6, lig = tid & 15, gbase = lane & 48;
    for (int item = blockIdx.x; item < 2048; item += gridDim.x) {
        const int tok0 = (item >> 3) * 64, h = item & 7;
        {
            const int c = wid >> 2, key0 = (wid & 3) * 32, r = lane & 31, hh = lane >> 5;
            f32x16 acc0, acc1;
#pragma unroll
            for (int i = 0; i < 16; ++i) { acc0[i] = 0.f; acc1[i] = 0.f; }
            const bf16* bq = KB + ((size_t)(h * 2 + c) * 128 + key0 + r) * 128 + hh * 8;
            const bf16* aq0 = PQ + (size_t)(tok0 + r) * 2048 + h * 256 + c * 128 + hh * 8;
            const bf16* aq1 = aq0 + (size_t)32 * 2048;
#pragma unroll
            for (int s = 0; s < 8; ++s) {
                const bf16x8 b = *(const bf16x8*)(bq + s * 16), a0 = *(const bf16x8*)(aq0 + s * 16), a1 = *(const bf16x8*)(aq1 + s * 16);
                acc0 = __builtin_amdgcn_mfma_f32_32x32x16_bf16(a0, b, acc0, 0, 0, 0);
                acc1 = __builtin_amdgcn_mfma_f32_32x32x16_bf16(a1, b, acc1, 0, 0, 0);
            }
#pragma unroll
            for (int i = 0; i < 16; ++i) { const int tl = (i & 3) + 8 * (i >> 2) + 4 * hh; S[(c * 64 + tl) * 132 + key0 + r] = acc0[i]; S[(c * 64 + 32 + tl) * 132 + key0 + r] = acc1[i]; }
        }
        __syncthreads();
#pragma unroll 1
        for (int rd = 0; rd < 2; ++rd) {
            const int tl = (tid >> 4) + 32 * rd;
            float ts[2];
#pragma unroll
            for (int c = 0; c < 2; ++c) {
                float v[8];
                const f32x4 lo = *(const f32x4*)(S + (c * 64 + tl) * 132 + lig * 8), hi = *(const f32x4*)(S + (c * 64 + tl) * 132 + lig * 8 + 4);
                v[0] = lo.x; v[1] = lo.y; v[2] = lo.z; v[3] = lo.w; v[4] = hi.x; v[5] = hi.y; v[6] = hi.z; v[7] = hi.w;
#pragma unroll
                for (int j = 0; j < 8; ++j) v[j] = __uint_as_float((__float_as_uint(v[j]) & ~127u) | (unsigned)(lig * 8 + j));
                ts[c] = grp16_top16(v, lig);
            }
            const float t0 = ts[0], t1 = ts[1];
            int bp = 0; float my_s = 0.f; int my_eid = 0;
#pragma unroll 1
            for (int r = 0; r < 16; ++r) {
                const float other = __shfl(t1, gbase + (bp < 15 ? bp : 15));
                const float sum = t0 + other;
                const float head = (bp >= 16) ? -3.0e38f : __uint_as_float((__float_as_uint(sum) & ~15u) | (unsigned)lig);
                const int cur_eid = (int)(((__float_as_uint(t0) & 127u) << 7) | (__float_as_uint(other) & 127u));
                const float m = grp16_max(head);
                const int owner = (int)(__float_as_uint(m) & 15u);
                const int ew = __shfl(cur_eid, gbase + owner);
                if (lig == r) { my_s = m; my_eid = ew; }
                if (lig == owner) ++bp;
            }
            const float mx = grp16_max(my_s);
            const float e = __expf(my_s - mx);
            const float sm = grp16_sum(e);
            const size_t o = (size_t)(tok0 + tl) * 128 + h * 16 + lig;
            ids[o] = my_eid; wts[o] = e / sm;
        }
        __syncthreads();
    }
}

__device__ __forceinline__ void hgrn_pre_item(const Params& p, unsigned char* lds, int ci) {
    const int tid = threadIdx.x, lane = tid & 63, wid = tid >> 6, k = tid & 127, tq = tid >> 7;
    const int n = ci & 127, h = (ci >> 7) & 3, b = ci >> 9, tok0 = b * T + n * 64;
    bf16* proj = (bf16*)(p.ws + WS_PROJ);
    float* OB = p.out; bf16* KIT = (bf16*)((unsigned char*)p.out + OUT_KIT) + (size_t)ci * 8192; bf16* VTg = (bf16*)((unsigned char*)p.out + OUT_VT) + (size_t)ci * 8192;
    float* DEC = (float*)(p.ws + WS_DEC) + (size_t)ci * 128;
    bf16* QT = (bf16*)lds; bf16* KT = (bf16*)(lds + 17408); bf16* VTl = (bf16*)(lds + 34816); bf16* AM = (bf16*)(lds + 53248);
    float* part = (float*)(lds + 62464); float* gref = (float*)(lds + 64512);
    float lb; { const float l0 = p.in[4][h * 128 + k], l1 = p.in[4][512 + h * 128 + k]; const float m = fmaxf(l0, l1); const float e0 = __expf(l0 - m), e1 = __expf(l1 - m); lb = e0 / (e0 + e1); }
    float G[16], key[16], qv[16], vv[16];
    {
        float c = 0.f;
#pragma unroll
        for (int i = 0; i < 16; ++i) {
            const size_t row = (size_t)(tok0 + tq * 16 + i) * PS;
            const float fg = lb + (1.0f - lb) * sigmoidf_(bf2f(proj[row + C_HF + h * 128 + k]));
            key[i] = 1.0f - fg; c += __logf(fg); G[i] = c;
            qv[i] = siluf_(bf2f(proj[row + C_HQ + h * 128 + k])) * 0.08838834764831845f;
            vv[i] = bf2f(proj[row + C_HI + h * 128 + k]);
        }
        part[tq * 128 + k] = c;
    }
    __syncthreads();
    {
        float off = 0.f;
#pragma unroll
        for (int j = 0; j < 3; ++j) off += (j < tq) ? part[j * 128 + k] : 0.f;
#pragma unroll
        for (int i = 0; i < 16; ++i) G[i] += off;
        if (tq == 1) gref[k] = G[15];
        if (tq == 3) gref[128 + k] = G[15];
    }
    __syncthreads();
    {
        const float gr = gref[k], gl = gref[128 + k];
        const int kpos = (k & ~31) | (((k >> 2) & 3) << 3) | (((k >> 4) & 1) << 2) | (k & 3);
        unsigned kp[8], vp[8];
#pragma unroll
        for (int i = 0; i < 16; i += 2) {
            kp[i >> 1] = pk2(key[i] * __expf(gl - G[i]), key[i + 1] * __expf(gl - G[i + 1]));
            vp[i >> 1] = pk2(vv[i], vv[i + 1]);
        }
#pragma unroll
        for (int i = 0; i < 16; ++i) {
            const int t = tq * 16 + i;
            QT[t * 136 + k] = f2bf(qv[i] * __expf(G[i] - gr));
            KT[t * 136 + k] = f2bf(key[i] * __expf(gr - G[i]));
            proj[(size_t)(tok0 + t) * PS + C_HQ + h * 128 + kpos] = f2bf(qv[i] * __expf(G[i]));
        }
        u32x4 a0, a1, b0, b1; a0.x = kp[0]; a0.y = kp[1]; a0.z = kp[2]; a0.w = kp[3]; a1.x = kp[4]; a1.y = kp[5]; a1.z = kp[6]; a1.w = kp[7];
        b0.x = vp[0]; b0.y = vp[1]; b0.z = vp[2]; b0.w = vp[3]; b1.x = vp[4]; b1.y = vp[5]; b1.z = vp[6]; b1.w = vp[7];
        *(u32x4*)(KIT + k * 64 + tq * 16) = a0; *(u32x4*)(KIT + k * 64 + tq * 16 + 8) = a1;
        *(u32x4*)(VTg + k * 64 + tq * 16) = b0; *(u32x4*)(VTg + k * 64 + tq * 16 + 8) = b1;
        *(u32x4*)(VTl + k * 72 + tq * 16) = b0; *(u32x4*)(VTl + k * 72 + tq * 16 + 8) = b1;
        if (tq == 3) DEC[k] = __expf(gl);
    }
    __syncthreads();
    const int fr = lane & 15, fq = lane >> 4;
    {
        const int tt = wid >> 1;
#pragma unroll
        for (int e = 0; e < 2; ++e) {
            const int st = 2 * (wid & 1) + e;
            f32x4 acc = (f32x4){0.f, 0.f, 0.f, 0.f};
            if (st <= tt) {
#pragma unroll
                for (int s = 0; s < 4; ++s) {
                    const bf16x8 a = *(const bf16x8*)(QT + (tt * 16 + fr) * 136 + s * 32 + fq * 8), bb = *(const bf16x8*)(KT + (st * 16 + fr) * 136 + s * 32 + fq * 8);
                    acc = __builtin_amdgcn_mfma_f32_16x16x32_bf16(a, bb, acc, 0, 0, 0);
                }
            }
#pragma unroll
            for (int r = 0; r < 4; ++r) { const int t = tt * 16 + fq * 4 + r, sp = st * 16 + fr; AM[t * 72 + sp] = f2bf(sp <= t ? acc[r] : 0.f); }
        }
    }
    __syncthreads();
    {
        const int tt = wid >> 1;
        const bf16x8 a0 = *(const bf16x8*)(AM + (tt * 16 + fr) * 72 + fq * 8), a1 = *(const bf16x8*)(AM + (tt * 16 + fr) * 72 + 32 + fq * 8);
#pragma unroll
        for (int e = 0; e < 4; ++e) {
            const int vt = (wid & 1) * 4 + e;
            const bf16x8 b0 = *(const bf16x8*)(VTl + (vt * 16 + fr) * 72 + fq * 8), b1 = *(const bf16x8*)(VTl + (vt * 16 + fr) * 72 + 32 + fq * 8);
            f32x4 acc = (f32x4){0.f, 0.f, 0.f, 0.f};
            acc = __builtin_amdgcn_mfma_f32_16x16x32_bf16(a0, b0, acc, 0, 0, 0);
            acc = __builtin_amdgcn_mfma_f32_16x16x32_bf16(a1, b1, acc, 0, 0, 0);
#pragma unroll
            for (int r = 0; r < 4; ++r) OB[(size_t)(tok0 + tt * 16 + fq * 4 + r) * 512 + h * 128 + vt * 16 + fr] = acc[r];
        }
    }
    __syncthreads();
}
template <bool DUMMY>
__device__ __forceinline__ void hgrn_scan_item(const Params& p, int wi) {
    const int lane = threadIdx.x & 63, fr = lane & 15, fq = lane >> 4;
    const int vs = wi & 7, bh = wi >> 3, h = bh & 3, b = bh >> 2;
    const bf16* proj = (const bf16*)(p.ws + WS_PROJ);
    float* OB = p.out; const bf16* KIT = (const bf16*)((unsigned char*)p.out + OUT_KIT); const bf16* VTg = (const bf16*)((unsigned char*)p.out + OUT_VT);
    const float* DEC = (const float*)(p.ws + WS_DEC);
    f32x4 S[8];
#pragma unroll
    for (int i = 0; i < 8; ++i) S[i] = (f32x4){0.f, 0.f, 0.f, 0.f};
#pragma unroll 1
    for (int n = 0; n < 128; ++n) {
        const int ci = bh * 128 + n, tok0 = b * T + n * 64;
        bf16x8 qf[4][4];
#pragma unroll
        for (int tt = 0; tt < 4; ++tt)
#pragma unroll
            for (int s = 0; s < 4; ++s) qf[tt][s] = *(const bf16x8*)(proj + (size_t)(tok0 + tt * 16 + fr) * PS + C_HQ + h * 128 + s * 32 + fq * 8);
        float oin[4][4];
#pragma unroll
        for (int tt = 0; tt < 4; ++tt)
#pragma unroll
            for (int r = 0; r < 4; ++r) oin[tt][r] = OB[(size_t)(tok0 + tt * 16 + fq * 4 + r) * 512 + h * 128 + vs * 16 + fr];
        bf16x8 Sb[4];
#pragma unroll
        for (int s = 0; s < 4; ++s) {
            u32x4 w; w.x = pk2(S[2 * s][0], S[2 * s][1]); w.y = pk2(S[2 * s][2], S[2 * s][3]); w.z = pk2(S[2 * s + 1][0], S[2 * s + 1][1]); w.w = pk2(S[2 * s + 1][2], S[2 * s + 1][3]);
            Sb[s] = __builtin_bit_cast(bf16x8, w);
        }
#pragma unroll
        for (int tt = 0; tt < 4; ++tt) {
            f32x4 acc = (f32x4){0.f, 0.f, 0.f, 0.f};
#pragma unroll
            for (int s = 0; s < 4; ++s) acc = __builtin_amdgcn_mfma_f32_16x16x32_bf16(qf[tt][s], Sb[s], acc, 0, 0, 0);
#pragma unroll
            for (int r = 0; r < 4; ++r) { const size_t oi = (size_t)(tok0 + tt * 16 + fq * 4 + r) * 512 + h * 128 + vs * 16 + fr; if (DUMMY) ((float*)(p.ws + WS_SPARE))[oi & 0x3fffff] = oin[tt][r] + acc[r]; else OB[oi] = oin[tt][r] + acc[r]; }
        }
        const bf16x8 v0 = *(const bf16x8*)(VTg + (size_t)ci * 8192 + (vs * 16 + fr) * 64 + fq * 8), v1 = *(const bf16x8*)(VTg + (size_t)ci * 8192 + (vs * 16 + fr) * 64 + 32 + fq * 8);
#pragma unroll
        for (int kb = 0; kb < 8; ++kb) {
            const bf16x8 k0 = *(const bf16x8*)(KIT + (size_t)ci * 8192 + (kb * 16 + fr) * 64 + fq * 8), k1 = *(const bf16x8*)(KIT + (size_t)ci * 8192 + (kb * 16 + fr) * 64 + 32 + fq * 8);
            const f32x4 dv = *(const f32x4*)(DEC + (size_t)ci * 128 + kb * 16 + fq * 4);
            f32x4 sacc = S[kb] * dv;
            sacc = __builtin_amdgcn_mfma_f32_16x16x32_bf16(k0, v0, sacc, 0, 0, 0);
            sacc = __builtin_amdgcn_mfma_f32_16x16x32_bf16(k1, v1, sacc, 0, 0, 0);
            S[kb] = sacc;
        }
    }
}

__device__ __forceinline__ void hgrn_scan_block(const Params& p, unsigned char* lds, int bh) {
    const int tid = threadIdx.x, lane = tid & 63, vs = tid >> 6, fr = lane & 15, fq = lane >> 4;
    const int h = bh & 3, b = bh >> 2;
    const bf16* proj = (const bf16*)(p.ws + WS_PROJ);
    float* OB = p.out; const bf16* KIT = (const bf16*)((unsigned char*)p.out + OUT_KIT); const bf16* VTg = (const bf16*)((unsigned char*)p.out + OUT_VT);
    const float* DEC = (const float*)(p.ws + WS_DEC);
    constexpr int BUF = 54784, O_KIT = 17408, O_VT = 17408 + 18432, O_DEC = 17408 + 2 * 18432;
    u32x4 rq[2], rk[2], rv[2], rd;
    float oin[4][4];
    auto issue = [&](int n) {
        const int ci = bh * 128 + n, tok0 = b * T + n * 64;
#pragma unroll
        for (int i = 0; i < 2; ++i) {
            const int id = tid + i * NTHR;
            rq[i] = *(const u32x4*)(proj + (size_t)(tok0 + (id >> 4)) * PS + C_HQ + h * 128 + (id & 15) * 8);
            rk[i] = *(const u32x4*)(KIT + (size_t)ci * 8192 + id * 8);
            rv[i] = *(const u32x4*)(VTg + (size_t)ci * 8192 + id * 8);
        }
        if (tid < 32) rd = *(const u32x4*)(DEC + (size_t)ci * 128 + tid * 4);
    };
    auto stash = [&](unsigned char* buf) {
#pragma unroll
        for (int i = 0; i < 2; ++i) {
            const int id = tid + i * NTHR;
            *(u32x4*)(buf + (id >> 4) * 272 + (id & 15) * 16) = rq[i];
            *(u32x4*)(buf + O_KIT + (id >> 3) * 144 + (id & 7) * 16) = rk[i];
            *(u32x4*)(buf + O_VT + (id >> 3) * 144 + (id & 7) * 16) = rv[i];
        }
        if (tid < 32) *(u32x4*)(buf + O_DEC + tid * 16) = rd;
    };
    auto load_oin = [&](int n) {
        const int tok0 = b * T + n * 64;
#pragma unroll
        for (int tt = 0; tt < 4; ++tt)
#pragma unroll
            for (int r = 0; r < 4; ++r) oin[tt][r] = OB[(size_t)(tok0 + tt * 16 + fq * 4 + r) * 512 + h * 128 + vs * 16 + fr];
    };
    f32x4 S[8];
#pragma unroll
    for (int i = 0; i < 8; ++i) S[i] = (f32x4){0.f, 0.f, 0.f, 0.f};
    issue(0); stash(lds); load_oin(0);
    __syncthreads();
#pragma unroll 1
    for (int n = 0; n < 128; ++n) {
        unsigned char* cur = lds + (n & 1) * BUF; unsigned char* nxt = lds + ((n + 1) & 1) * BUF;
        const int tok0 = b * T + n * 64;
        const int nn = (n + 1 < 128) ? n + 1 : n;
        issue(nn);
        bf16x8 Sb[4];
#pragma unroll
        for (int s = 0; s < 4; ++s) {
            u32x4 w; w.x = pk2(S[2 * s][0], S[2 * s][1]); w.y = pk2(S[2 * s][2], S[2 * s][3]); w.z = pk2(S[2 * s + 1][0], S[2 * s + 1][1]); w.w = pk2(S[2 * s + 1][2], S[2 * s + 1][3]);
            Sb[s] = __builtin_bit_cast(bf16x8, w);
        }
        float ores[4][4];
#pragma unroll
        for (int tt = 0; tt < 4; ++tt) {
            f32x4 acc = (f32x4){0.f, 0.f, 0.f, 0.f};
#pragma unroll
            for (int s = 0; s < 4; ++s) { const bf16x8 qf = *(const bf16x8*)(cur + (tt * 16 + fr) * 272 + (s * 32 + fq * 8) * 2); acc = __builtin_amdgcn_mfma_f32_16x16x32_bf16(qf, Sb[s], acc, 0, 0, 0); }
#pragma unroll
            for (int r = 0; r < 4; ++r) ores[tt][r] = oin[tt][r] + acc[r];
        }
#pragma unroll
        for (int tt = 0; tt < 4; ++tt)
#pragma unroll
            for (int r = 0; r < 4; ++r) OB[(size_t)(tok0 + tt * 16 + fq * 4 + r) * 512 + h * 128 + vs * 16 + fr] = ores[tt][r];
        load_oin(nn);
        const bf16x8 v0 = *(const bf16x8*)(cur + O_VT + (vs * 16 + fr) * 144 + fq * 16), v1 = *(const bf16x8*)(cur + O_VT + (vs * 16 + fr) * 144 + 64 + fq * 16);
#pragma unroll
        for (int kb = 0; kb < 8; ++kb) {
            const bf16x8 k0 = *(const bf16x8*)(cur + O_KIT + (kb * 16 + fr) * 144 + fq * 16), k1 = *(const bf16x8*)(cur + O_KIT + (kb * 16 + fr) * 144 + 64 + fq * 16);
            const f32x4 dv = *(const f32x4*)(cur + O_DEC + (kb * 16 + fq * 4) * 4);
            f32x4 sacc = S[kb] * dv;
            sacc = __builtin_amdgcn_mfma_f32_16x16x32_bf16(k0, v0, sacc, 0, 0, 0);
            sacc = __builtin_amdgcn_mfma_f32_16x16x32_bf16(k1, v1, sacc, 0, 0, 0);
            S[kb] = sacc;
        }
        stash(nxt);
        __syncthreads();
    }
}
__device__ __forceinline__ void phase4(const Params& p, unsigned char* lds) {
    const bf16* proj = (const bf16*)(p.ws + WS_PROJ); const float* OB = p.out; bf16* mixed = (bf16*)(p.ws + WS_ACT); const float* gain = p.in[5];
    const int lane = threadIdx.x & 63, gw = (blockIdx.x * NTHR + threadIdx.x) >> 6, ngw = (gridDim.x * NTHR) >> 6;
    for (int tok = gw; tok < NTOK; tok += ngw) {
        const f32x4 o0 = *(const f32x4*)(OB + (size_t)tok * 512 + lane * 8), o1 = *(const f32x4*)(OB + (size_t)tok * 512 + lane * 8 + 4);
        const u32x4 gp = *(const u32x4*)(proj + (size_t)tok * PS + C_HG + lane * 8);
        const f32x4 g0 = *(const f32x4*)(gain + lane * 8), g1 = *(const f32x4*)(gain + lane * 8 + 4);
        float ss = o0.x * o0.x + o0.y * o0.y + o0.z * o0.z + o0.w * o0.w + o1.x * o1.x + o1.y * o1.y + o1.z * o1.z + o1.w * o1.w;
        ss = grp16_sum(ss);
        const float r = rsqrtf(ss * (1.0f / 128.0f) + EPS);
        const unsigned gx = gp.x, gy = gp.y, gz = gp.z, gw_ = gp.w;
        u32x4 w;
        w.x = pk2(o0.x * r * g0.x * siluf_(__uint_as_float(gx << 16)), o0.y * r * g0.y * siluf_(__uint_as_float(gx & 0xffff0000u)));
        w.y = pk2(o0.z * r * g0.z * siluf_(__uint_as_float(gy << 16)), o0.w * r * g0.w * siluf_(__uint_as_float(gy & 0xffff0000u)));
        w.z = pk2(o1.x * r * g1.x * siluf_(__uint_as_float(gz << 16)), o1.y * r * g1.y * siluf_(__uint_as_float(gz & 0xffff0000u)));
        w.w = pk2(o1.z * r * g1.z * siluf_(__uint_as_float(gw_ << 16)), o1.w * r * g1.w * siluf_(__uint_as_float(gw_ & 0xffff0000u)));
        *(u32x4*)(mixed + (size_t)tok * D + lane * 8) = w;
    }
}

#define WAVE_LDS_SYNC() asm volatile("s_waitcnt lgkmcnt(0)" ::: "memory")
__device__ __forceinline__ void nsa_prep_item(const Params& p, unsigned char* lds, int tile) {
    const int tid = threadIdx.x, lig = tid & 15;
    const int tok0 = tile * 64;
    bf16* proj = (bf16*)(p.ws + WS_PROJ);
    for (int rho = tid >> 4; rho < 768; rho += 32) {
        const int tl = rho / 12, which = rho - tl * 12;
        int col; const float* gain; float sc = 1.0f;
        if (which < 8) { col = C_NQ + which * 64; gain = p.in[6]; sc = 0.125f * 1.4426950408889634f; }
        else if (which < 10) { col = C_KS + (which - 8) * 64; gain = p.in[7] + 64; }
        else { col = C_KW + (which - 10) * 64; gain = p.in[7] + 128; }
        bf16* rp = proj + (size_t)(tok0 + tl) * PS + col + lig * 4;
        const u32x2 raw = *(const u32x2*)rp;
        const unsigned r0 = raw.x, r1 = raw.y;
        const float a = __uint_as_float(r0 << 16), b = __uint_as_float(r0 & 0xffff0000u), c = __uint_as_float(r1 << 16), d = __uint_as_float(r1 & 0xffff0000u);
        const float ss = grp16_sum(a * a + b * b + c * c + d * d);
        const float r = rsqrtf(ss * (1.0f / 64.0f) + EPS) * sc;
        const f32x4 gg = *(const f32x4*)(gain + lig * 4);
        u32x2 o; o.x = pk2(a * r * gg.x, b * r * gg.y); o.y = pk2(c * r * gg.z, d * r * gg.w);
        if (which < 8) *(u32x2*)rp = o;
        else {
            const int g = (which - 8) & 1, tok = tok0 + tl, b = tok / T, t = tok % T;
            unsigned char* kb = p.ws + (which < 10 ? WS_KFS : WS_KFW) + ((size_t)(b * 2 + g) * 256 + (t >> 5)) * 4096;
            *(u32x2*)(kb + (lig >> 2) * 1024 + ((t & 31) + 32 * ((lig >> 1) & 1)) * 16 + (lig & 1) * 8) = o;
        }
    }
    {
        const int c = tid & 127, tq = tid >> 7, g = c >> 6, d = c & 63, b = tok0 / T, t0 = tok0 % T;
#pragma unroll
        for (int which = 0; which < 2; ++which) {
            const int col = (which == 0 ? C_VS : C_VW) + c;
            unsigned short e[16];
#pragma unroll
            for (int i = 0; i < 16; ++i) e[i] = proj[(size_t)(tok0 + tq * 16 + i) * PS + col];
            unsigned char* vb = p.ws + (which == 0 ? WS_VTS : WS_VTW) + ((size_t)(b * 2 + g) * 256 + ((t0 + tq * 16) >> 5)) * 4096 + ((d >> 5) * 2 + (tq & 1)) * 1024 + (d & 31) * 16;
            u32x4 h0, h1;
            h0.x = e[0] | ((unsigned)e[1] << 16); h0.y = e[2] | ((unsigned)e[3] << 16); h0.z = e[8] | ((unsigned)e[9] << 16); h0.w = e[10] | ((unsigned)e[11] << 16);
            h1.x = e[4] | ((unsigned)e[5] << 16); h1.y = e[6] | ((unsigned)e[7] << 16); h1.z = e[12] | ((unsigned)e[13] << 16); h1.w = e[14] | ((unsigned)e[15] << 16);
            *(u32x4*)vb = h0; *(u32x4*)(vb + 512) = h1;
        }
    }
}
__device__ __forceinline__ void nsa_cmp_item(const Params& p, unsigned char* lds, int item) {
    const int tid = threadIdx.x, lane = tid & 63, wid = tid >> 6, fr = lane & 15, fq = lane >> 4;
    const int nt32 = item & 15, g = (item >> 4) & 1, b = (item >> 5) & 1, which = item >> 6, n0 = nt32 * 32;
    const bf16* proj = (const bf16*)(p.ws + WS_PROJ);
    const float* pe = p.in[8] + which * 2048;
    const bf16* W1T = (const bf16*)(p.ws + WS_W1T) + (size_t)which * 64 * 2048;
    const float* w2 = p.in[10] + which * 4096;
    bf16* A = (bf16*)lds; float* H = (float*)(lds + 33280);
    const int col0 = (which == 0 ? C_KC : C_VC) + g * 64;
    const int nt = wid & 1, ct = wid >> 1;
    f32x4 acc = (f32x4){0.f, 0.f, 0.f, 0.f};
#pragma unroll 1
    for (int kc = 0; kc < 4; ++kc) {
#pragma unroll
        for (int i = 0; i < 4; ++i) {
            const int idx = tid + i * NTHR, dch = idx & 7, jj = (idx >> 3) & 7, n = idx >> 6, j = kc * 8 + jj;
            u32x4 o = (u32x4){0u, 0u, 0u, 0u};
            if (n0 + n < NCMP) {
                const u32x4 raw = *(const u32x4*)(proj + (size_t)(b * T + 16 * (n0 + n) + j) * PS + col0 + dch * 8);
                const f32x4 p0 = *(const f32x4*)(pe + j * 64 + dch * 8), p1 = *(const f32x4*)(pe + j * 64 + dch * 8 + 4);
                const unsigned r0 = raw.x, r1 = raw.y, r2 = raw.z, r3 = raw.w;
                o.x = pk2(__uint_as_float(r0 << 16) + p0.x, __uint_as_float(r0 & 0xffff0000u) + p0.y);
                o.y = pk2(__uint_as_float(r1 << 16) + p0.z, __uint_as_float(r1 & 0xffff0000u) + p0.w);
                o.z = pk2(__uint_as_float(r2 << 16) + p1.x, __uint_as_float(r2 & 0xffff0000u) + p1.y);
                o.w = pk2(__uint_as_float(r3 << 16) + p1.z, __uint_as_float(r3 & 0xffff0000u) + p1.w);
            }
            *(u32x4*)(A + n * 520 + jj * 64 + dch * 8) = o;
        }
        __syncthreads();
#pragma unroll 4
        for (int s = 0; s < 16; ++s) {
            const bf16x8 a = *(const bf16x8*)(A + (nt * 16 + fr) * 520 + s * 32 + fq * 8);
            const bf16x8 bb = *(const bf16x8*)(W1T + (size_t)(ct * 16 + fr) * 2048 + kc * 512 + s * 32 + fq * 8);
            acc = __builtin_amdgcn_mfma_f32_16x16x32_bf16(a, bb, acc, 0, 0, 0);
        }
        __syncthreads();
    }
#pragma unroll
    for (int r = 0; r < 4; ++r) H[(nt * 16 + fq * 4 + r) * 64 + ct * 16 + fr] = gelu_tanh(acc[r]);
    __syncthreads();
    {
        const int n = tid >> 4, c = (tid & 15) * 4;
        f32x4 o = (f32x4){0.f, 0.f, 0.f, 0.f};
#pragma unroll 8
        for (int i = 0; i < 64; ++i) { const float hv = H[n * 64 + i]; const f32x4 w = *(const f32x4*)(w2 + i * 64 + c); o += hv * w; }
        if (which == 0) {
            const float ss = grp16_sum(o.x * o.x + o.y * o.y + o.z * o.z + o.w * o.w);
            const float r = rsqrtf(ss * (1.0f / 64.0f) + EPS);
            const f32x4 gg = *(const f32x4*)(p.in[7] + c);
            o = o * r * gg;
        }
        if (n0 + n >= NCMP) o = (f32x4){0.f, 0.f, 0.f, 0.f};
        const int nn = n0 + n;
        if (which == 0) { u32x2 w; w.x = pk2(o.x, o.y); w.y = pk2(o.z, o.w);
            *(u32x2*)(p.ws + WS_KC + ((size_t)(b * 2 + g) * 16 + (nn >> 5)) * 4096 + (c >> 4) * 1024 + ((nn & 31) + 32 * ((c >> 3) & 1)) * 16 + (c & 7) * 2) = w; }
        else {
            const int kl = nn & 31, sst = kl >> 4, r = kl & 15, j = ((r >> 3) << 2) | (r & 3), hh = (r >> 2) & 1;
            bf16* vt = (bf16*)(p.ws + WS_VCT + ((size_t)(b * 2 + g) * 16 + (nn >> 5)) * 4096 + sst * 1024 + hh * 512 + j * 2);
            const float ov[4] = {o.x, o.y, o.z, o.w};
#pragma unroll
            for (int e = 0; e < 4; ++e) { const int dd = c + e; vt[((dd >> 5) * 2048 + (dd & 31) * 16) / 2] = f2bf(ov[e]); }
        }
    }
    __syncthreads();
}

constexpr float LOG2E = 1.4426950408889634f;
__device__ __forceinline__ int rho16(int reg, int hh) { return (reg & 3) + 8 * (reg >> 2) + 4 * hh; }
__device__ __forceinline__ bf16x8 pack8(const float* pv) {
    u32x4 w; w.x = pk2(pv[0], pv[1]); w.y = pk2(pv[2], pv[3]); w.z = pk2(pv[4], pv[5]); w.w = pk2(pv[6], pv[7]);
    return __builtin_bit_cast(bf16x8, w);
}
struct KF { bf16x8 f[4]; };
struct VF { bf16x8 f[4]; };
__device__ __forceinline__ void load_k(KF& k, const unsigned char* tp) {
#pragma unroll
    for (int s = 0; s < 4; ++s) k.f[s] = *(const bf16x8*)(tp + s * 1024);
}
__device__ __forceinline__ void load_v(VF& v, const unsigned char* tp) {
#pragma unroll
    for (int q = 0; q < 4; ++q) v.f[q] = *(const bf16x8*)(tp + q * 1024);
}
__device__ __forceinline__ f32x16 score_tile(const KF& k, const bf16x8 (&qf)[4], float slope, float base) {
    f32x16 st;
#pragma unroll
    for (int i = 0; i < 16; ++i) st[i] = fmaf(slope, (float)((i & 3) + 8 * (i >> 2)), base);
#pragma unroll
    for (int s = 0; s < 4; ++s) st = __builtin_amdgcn_mfma_f32_32x32x16_bf16(k.f[s], qf[s], st, 0, 0, 0);
    return st;
}
__device__ __forceinline__ void pv_tile(f32x16& o0, f32x16& o1, const VF& v, const float* pv) {
    const bf16x8 p0 = pack8(pv), p1 = pack8(pv + 8);
    o0 = __builtin_amdgcn_mfma_f32_32x32x16_bf16(v.f[0], p0, o0, 0, 0, 0); o0 = __builtin_amdgcn_mfma_f32_32x32x16_bf16(v.f[1], p1, o0, 0, 0, 0);
    o1 = __builtin_amdgcn_mfma_f32_32x32x16_bf16(v.f[2], p0, o1, 0, 0, 0); o1 = __builtin_amdgcn_mfma_f32_32x32x16_bf16(v.f[3], p1, o1, 0, 0, 0);
}
template <bool FAST>
__device__ __forceinline__ void attn_tile(const KF& kc, const VF& vf, const bf16x8 (&qf)[4], float slope, float base, int distbase, bool colsel, int wlimit,
                                          float& l, f32x16& o0, f32x16& o1) {
    const f32x16 st = score_tile(kc, qf, slope, base);
    float sv[16]; float ps = 0.f;
#pragma unroll
    for (int i = 0; i < 16; ++i) {
        float e = __builtin_amdgcn_exp2f(st[i]);
        if (!FAST) { const int dist = distbase - ((i & 3) + 8 * (i >> 2)); e = (colsel && dist >= 0 && dist < wlimit) ? e : 0.f; }
        sv[i] = e; ps += e;
    }
    l += ps;
    pv_tile(o0, o1, vf, sv);
}
__device__ __forceinline__ void nsa_attn_item(const Params& p, unsigned char* wlds, int item) {
    const int lane = threadIdx.x & 63, c = lane & 31, hh = lane >> 5, jt = c >> 2, r4 = c & 3;
    const int oct = item & 1023, g = (item >> 10) & 1, b = item >> 11;
    const int t0 = oct * 8, tc = t0 + jt, h = g * 4 + r4;
    const float slope = exp2f(-(float)(h + 1)) * LOG2E;
    const bf16* proj = (const bf16*)(p.ws + WS_PROJ);
    float* impA = (float*)wlds; float* impB = impA + 1024; unsigned* msk = (unsigned*)(impB + 1024);
    unsigned char* blist = (unsigned char*)(msk + 32);
    float* ocl = (float*)(wlds + 8448) + lane;
#pragma unroll
    for (int i = 0; i < 16; ++i) { impA[lane + 64 * i] = 0.f; impB[lane + 64 * i] = 0.f; }
    if (lane < 32) msk[lane] = 0u;
    bf16x8 qf[4];
    { const bf16* qp = proj + (size_t)(b * T + tc) * PS + C_NQ + h * 64 + hh * 8;
#pragma unroll
      for (int s = 0; s < 4; ++s) qf[s] = *(const bf16x8*)(qp + s * 16); }
    float gate[3];
    { const bf16* gp = proj + (size_t)(b * T + tc) * PS + C_GT + h * 3;
#pragma unroll
      for (int i = 0; i < 3; ++i) gate[i] = sigmoidf_(bf2f(gp[i])); }
    float bnd[3];
    { const float gq = wave_max(fabsf(p.in[6][lane]));
#pragma unroll
      for (int i = 0; i < 3; ++i) bnd[i] = 8.0f * LOG2E * 1.02f * gq * wave_max(fabsf(p.in[7][i * 64 + lane])); }
    WAVE_LDS_SYNC();
    {
        const unsigned char* KC = p.ws + WS_KC + (size_t)(b * 2 + g) * 65536 + lane * 16;
        const unsigned char* VCT = p.ws + WS_VCT + (size_t)(b * 2 + g) * 65536 + lane * 16;
        const int nmax = (t0 + 7 >= 31) ? ((t0 + 7 - 31) >> 4) : -1;
        const int nlast = (nmax >= 0) ? (nmax & ~31) : -32;
        float l = 0.f;
        f32x16 o0, o1;
#pragma unroll
        for (int i = 0; i < 16; ++i) { o0[i] = 0.f; o1[i] = 0.f; }
        KF kn;
        if (nlast >= 0) load_k(kn, KC + (size_t)nlast * 128);
#pragma unroll 1
        for (int n0 = nlast; n0 >= 0; n0 -= 32) {
            const KF kc = kn;
            load_k(kn, KC + (size_t)(n0 >= 32 ? n0 - 32 : n0) * 128);
            const int distbase = tc - 16 * (n0 + 4 * hh) - 31;
            const f32x16 st = score_tile(kc, qf, 16.0f * slope, -slope * (float)distbase - bnd[0]);
            float ps = 0.f;
#pragma unroll
            for (int i = 0; i < 16; ++i) { const int dist = distbase - 16 * ((i & 3) + 8 * (i >> 2)); ps += (dist >= 0) ? __builtin_amdgcn_exp2f(st[i]) : 0.f; }
            l += ps;
        }
        l += __shfl_xor(l, 32);
        const float inv = (l > 0.f) ? 1.0f / l : 0.f;
        if (nlast >= 0) load_k(kn, KC + (size_t)nlast * 128);
#pragma unroll 1
        for (int n0 = nlast; n0 >= 0; n0 -= 32) {
            const KF kc = kn; VF vf;
            load_v(vf, VCT + (size_t)n0 * 128);
            load_k(kn, KC + (size_t)(n0 >= 32 ? n0 - 32 : n0) * 128);
            const int distbase = tc - 16 * (n0 + 4 * hh) - 31;
            const f32x16 st = score_tile(kc, qf, 16.0f * slope, -slope * (float)distbase - bnd[0]);
            float pv[16];
#pragma unroll
            for (int i = 0; i < 16; ++i) { const int dist = distbase - 16 * ((i & 3) + 8 * (i >> 2)); pv[i] = (dist >= 0) ? __builtin_amdgcn_exp2f(st[i]) * inv : 0.f; }
            pv_tile(o0, o1, vf, pv);
#pragma unroll
            for (int i = 0; i < 16; ++i) { float v = pv[i]; v += dpp_f<0xB1>(v); v += dpp_f<0x4E>(v); pv[i] = v; }
            if (r4 == 0) {
#pragma unroll
                for (int rg = 0; rg < 4; ++rg) {
                    const int jb = (n0 >> 2) + 2 * rg + hh;
                    impA[jt * 128 + jb] = pv[4 * rg] + 2.f * pv[4 * rg + 1] + 2.f * pv[4 * rg + 2] + 2.f * pv[4 * rg + 3];
                    if (jb >= 1) impB[jt * 128 + jb - 1] = pv[4 * rg];
                }
            }
        }
#pragma unroll
        for (int i = 0; i < 16; ++i) { ocl[i * 64] = gate[0] * o0[i]; ocl[(16 + i) * 64] = gate[0] * o1[i]; }
    }
    WAVE_LDS_SYNC();
    {
        const int lig = lane & 15, grp = lane >> 4;
#pragma unroll 1
        for (int half = 0; half < 2; ++half) {
            const int j2 = half * 4 + grp, cur = (t0 + j2) >> 6;
            float v[8];
#pragma unroll
            for (int e = 0; e < 8; ++e) {
                const int j = lig * 8 + e; const float val = impA[j2 * 128 + j] + impB[j2 * 128 + j];
                v[e] = (j >= 1 && j <= cur - 2) ? __uint_as_float((__float_as_uint(val) & ~127u) | (unsigned)(127 - j)) : -1.0f;
            }
            const float top = grp16_top16(v, lig);
            const int need = 16 - ((cur == 0) ? 1 : (cur == 1) ? 2 : 3);
            if (lig < need && top >= 0.f) { const int idx = 127 - (int)(__float_as_uint(top) & 127u); atomicOr(&msk[j2 * 4 + (idx >> 5)], 1u << (idx & 31)); }
            if (lig == 0) { atomicOr(&msk[j2 * 4], 1u); atomicOr(&msk[j2 * 4 + (cur >> 5)], 1u << (cur & 31)); if (cur >= 1) atomicOr(&msk[j2 * 4 + ((cur - 1) >> 5)], 1u << ((cur - 1) & 31)); }
        }
    }
    WAVE_LDS_SYNC();
    {
        int nblk = 0;
#pragma unroll
        for (int w = 3; w >= 0; --w) {
            unsigned u = 0u;
#pragma unroll
            for (int j = 0; j < 8; ++j) u |= msk[j * 4 + w];
            u = (unsigned)__builtin_amdgcn_readfirstlane((int)u);
            while (u) { const int bit = 31 - __builtin_clz(u); u &= ~(1u << bit); if (lane == 0) blist[nblk] = (unsigned char)(w * 32 + bit); ++nblk; }
        }
        WAVE_LDS_SYNC();
        const unsigned char* KS = p.ws + WS_KFS + (size_t)(b * 2 + g) * (256 * 4096) + lane * 16;
        const unsigned char* VTS = p.ws + WS_VTS + (size_t)(b * 2 + g) * (256 * 4096) + lane * 16;
        float l = 0.f;
        f32x16 o0, o1;
#pragma unroll
        for (int i = 0; i < 16; ++i) { o0[i] = 0.f; o1[i] = 0.f; }
        const int ntile = 2 * nblk;
        KF kn;
        { const int jb0 = blist[0]; load_k(kn, KS + (size_t)(jb0 * 64 + 32) * 128); }
#pragma unroll 1
        for (int ti = 0; ti < ntile; ++ti) {
            const int jb = __builtin_amdgcn_readfirstlane((int)blist[ti >> 1]);
            const int key0 = jb * 64 + 32 - 32 * (ti & 1);
            const KF kc = kn; VF vf;
            load_v(vf, VTS + (size_t)key0 * 128);
            { const int tn = (ti + 1 < ntile) ? ti + 1 : ti; const int jn = __builtin_amdgcn_readfirstlane((int)blist[tn >> 1]); load_k(kn, KS + (size_t)(jn * 64 + 32 - 32 * (tn & 1)) * 128); }
            const bool colsel = (msk[jt * 4 + (jb >> 5)] >> (jb & 31)) & 1u;
            const int distbase = tc - key0 - 4 * hh;
            if (key0 + 31 <= t0) attn_tile<true>(kc, vf, qf, slope, colsel ? -slope * (float)distbase - bnd[1] : -1e30f, distbase, true, 1 << 30, l, o0, o1);
            else attn_tile<false>(kc, vf, qf, slope, -slope * (float)distbase - bnd[1], distbase, colsel, 1 << 30, l, o0, o1);
        }
        l += __shfl_xor(l, 32);
        const float sc = (l > 0.f) ? gate[1] / l : 0.f;
#pragma unroll
        for (int i = 0; i < 16; ++i) { ocl[i * 64] += sc * o0[i]; ocl[(16 + i) * 64] += sc * o1[i]; }
    }
    {
        const unsigned char* KW = p.ws + WS_KFW + (size_t)(b * 2 + g) * (256 * 4096) + lane * 16;
        const unsigned char* VTW = p.ws + WS_VTW + (size_t)(b * 2 + g) * (256 * 4096) + lane * 16;
        float l = 0.f;
        f32x16 o0, o1;
#pragma unroll
        for (int i = 0; i < 16; ++i) { o0[i] = 0.f; o1[i] = 0.f; }
        const int kstart = (t0 - 511 > 0 ? t0 - 511 : 0) & ~31, kfirst = t0 & ~31;
        KF kn;
        load_k(kn, KW + (size_t)kfirst * 128);
#pragma unroll 1
        for (int key0 = kfirst; key0 >= kstart; key0 -= 32) {
            const KF kc = kn; VF vf;
            load_v(vf, VTW + (size_t)key0 * 128);
            { const int kn0 = (key0 - 32 >= kstart) ? key0 - 32 : key0; load_k(kn, KW + (size_t)kn0 * 128); }
            const int distbase = tc - key0 - 4 * hh;
            if (key0 + 31 <= t0 && key0 >= t0 - 504) attn_tile<true>(kc, vf, qf, slope, -slope * (float)distbase - bnd[2], distbase, true, 512, l, o0, o1);
            else attn_tile<false>(kc, vf, qf, slope, -slope * (float)distbase - bnd[2], distbase, true, 512, l, o0, o1);
        }
        l += __shfl_xor(l, 32);
        const float sc = (l > 0.f) ? gate[2] / l : 0.f;
#pragma unroll
        for (int i = 0; i < 16; ++i) { o0[i] = ocl[i * 64] + sc * o0[i]; o1[i] = ocl[(16 + i) * 64] + sc * o1[i]; }
        float ss = 0.f;
#pragma unroll
        for (int i = 0; i < 16; ++i) ss += o0[i] * o0[i] + o1[i] * o1[i];
        ss += __shfl_xor(ss, 32);
        const float r = rsqrtf(ss * (1.0f / 64.0f) + EPS);
        const float* og = p.in[11] + h * 64;
        bf16* op = (bf16*)(p.ws + WS_ACT) + (size_t)(b * T + tc) * D + 512 + h * 64;
#pragma unroll
        for (int dt = 0; dt < 2; ++dt)
#pragma unroll
            for (int rg = 0; rg < 4; ++rg) {
                const int d0 = dt * 32 + 8 * rg + 4 * hh;
                const f32x4 gg = *(const f32x4*)(og + d0);
                u32x2 w;
                if (dt == 0) { w.x = pk2(o0[4 * rg] * r * gg.x, o0[4 * rg + 1] * r * gg.y); w.y = pk2(o0[4 * rg + 2] * r * gg.z, o0[4 * rg + 3] * r * gg.w); }
                else { w.x = pk2(o1[4 * rg] * r * gg.x, o1[4 * rg + 1] * r * gg.y); w.y = pk2(o1[4 * rg + 2] * r * gg.z, o1[4 * rg + 3] * r * gg.w); }
                *(u32x2*)(op + d0) = w;
            }
    }
    WAVE_LDS_SYNC();
}
__device__ __forceinline__ void phase2(const Params& p, unsigned char* lds) {
    for (int it = blockIdx.x; it < 128 + 256 + 1024; it += gridDim.x) {
        if (it < 128) nsa_cmp_item(p, lds, it);
        else if (it < 384) nsa_prep_item(p, lds, it - 128);
        else hgrn_pre_item(p, lds, it - 384);
    }
}
template <bool SCAN>
__device__ __forceinline__ void phase3(const Params& p, unsigned char* lds) {
    const int gw = (blockIdx.x * NTHR + threadIdx.x) >> 6;
    const int wid = threadIdx.x >> 6;
    if (SCAN && blockIdx.x < 8) hgrn_scan_block(p, lds, blockIdx.x);
    unsigned* ctr = (unsigned*)(p.ws + WS_CTR) + (SCAN ? 0 : 64);
    for (;;) {
        int it = 0;
        if ((threadIdx.x & 63) == 0) it = (int)atomicAdd(ctr, 1u);
        it = __builtin_amdgcn_readfirstlane(it);
        if (it >= 4096) break;
        nsa_attn_item(p, lds + wid * 16640, 4095 - it);
    }
}

__device__ __forceinline__ float dot2u(unsigned a, unsigned b, float acc) { return __builtin_amdgcn_fdot2_f32_bf16(__builtin_bit_cast(bf16x2v, a), __builtin_bit_cast(bf16x2v, b), acc, false); }
__device__ __forceinline__ float dot8(u32x4 a, u32x4 b, float acc) {
    const unsigned a0 = a.x, a1 = a.y, a2 = a.z, a3 = a.w, b0 = b.x, b1 = b.y, b2 = b.z, b3 = b.w;
    acc = dot2u(a0, b0, acc); acc = dot2u(a1, b1, acc); acc = dot2u(a2, b2, acc); acc = dot2u(a3, b3, acc);
    return acc;
}
__device__ __forceinline__ void axpy8(float (&o)[8], float c, u32x4 v) {
    o[0] += c * __uint_as_float(v.x << 16); o[1] += c * __uint_as_float(v.x & 0xffff0000u);
    o[2] += c * __uint_as_float(v.y << 16); o[3] += c * __uint_as_float(v.y & 0xffff0000u);
    o[4] += c * __uint_as_float(v.z << 16); o[5] += c * __uint_as_float(v.z & 0xffff0000u);
    o[6] += c * __uint_as_float(v.w << 16); o[7] += c * __uint_as_float(v.w & 0xffff0000u);
}
typedef float f32x2 __attribute__((ext_vector_type(2)));
__device__ __forceinline__ float dot16_fp8(u32x4 r, const float* xf) {
    const unsigned r0 = r.x, r1 = r.y, r2 = r.z, r3 = r.w; float acc = 0.f; f32x2 t;
    t = __builtin_amdgcn_cvt_pk_f32_fp8((int)r0, false); acc += t.x * xf[0] + t.y * xf[1]; t = __builtin_amdgcn_cvt_pk_f32_fp8((int)r0, true); acc += t.x * xf[2] + t.y * xf[3];
    t = __builtin_amdgcn_cvt_pk_f32_fp8((int)r1, false); acc += t.x * xf[4] + t.y * xf[5]; t = __builtin_amdgcn_cvt_pk_f32_fp8((int)r1, true); acc += t.x * xf[6] + t.y * xf[7];
    t = __builtin_amdgcn_cvt_pk_f32_fp8((int)r2, false); acc += t.x * xf[8] + t.y * xf[9]; t = __builtin_amdgcn_cvt_pk_f32_fp8((int)r2, true); acc += t.x * xf[10] + t.y * xf[11];
    t = __builtin_amdgcn_cvt_pk_f32_fp8((int)r3, false); acc += t.x * xf[12] + t.y * xf[13]; t = __builtin_amdgcn_cvt_pk_f32_fp8((int)r3, true); acc += t.x * xf[14] + t.y * xf[15];
    return acc;
}
__device__ __forceinline__ void axpy16_fp8(float* o, float c, u32x4 r) {
    const unsigned r0 = r.x, r1 = r.y, r2 = r.z, r3 = r.w; f32x2 t;
    t = __builtin_amdgcn_cvt_pk_f32_fp8((int)r0, false); o[0] += c * t.x; o[1] += c * t.y; t = __builtin_amdgcn_cvt_pk_f32_fp8((int)r0, true); o[2] += c * t.x; o[3] += c * t.y;
    t = __builtin_amdgcn_cvt_pk_f32_fp8((int)r1, false); o[4] += c * t.x; o[5] += c * t.y; t = __builtin_amdgcn_cvt_pk_f32_fp8((int)r1, true); o[6] += c * t.x; o[7] += c * t.y;
    t = __builtin_amdgcn_cvt_pk_f32_fp8((int)r2, false); o[8] += c * t.x; o[9] += c * t.y; t = __builtin_amdgcn_cvt_pk_f32_fp8((int)r2, true); o[10] += c * t.x; o[11] += c * t.y;
    t = __builtin_amdgcn_cvt_pk_f32_fp8((int)r3, false); o[12] += c * t.x; o[13] += c * t.y; t = __builtin_amdgcn_cvt_pk_f32_fp8((int)r3, true); o[14] += c * t.x; o[15] += c * t.y;
}
template <bool DUMMY>
__device__ __forceinline__ void phase9(const Params& p, unsigned char* lds) {
    const bf16* HN = (const bf16*)(p.ws + WS_ACT); const unsigned char* UB = p.ws + WS_UB; const unsigned char* VB = p.ws + WS_VB;
    const float* US = (const float*)(p.ws + WS_US); const float* VS = (const float*)(p.ws + WS_VS);
    const int* ids = (const int*)(p.ws + WS_IDS); const float* wts = (const float*)(p.ws + WS_WTS);
    float* O = p.out; bf16* HG = (bf16*)(p.ws + WS_PROJ + 64 * MiB); const float* gn = p.in[19];
    const int lane = threadIdx.x & 63, gw = (blockIdx.x * NTHR + threadIdx.x) >> 6, ngw = (gridDim.x * NTHR) >> 6;
    for (int tok = gw; tok < NTOK; tok += ngw) {
        float xf[16], oa[16];
        {
            const u32x4 x0 = *(const u32x4*)(HN + (size_t)tok * D + lane * 16), x1 = *(const u32x4*)(HN + (size_t)tok * D + lane * 16 + 8);
            const unsigned a0 = x0.x, a1 = x0.y, a2 = x0.z, a3 = x0.w, b0 = x1.x, b1 = x1.y, b2 = x1.z, b3 = x1.w;
            xf[0] = __uint_as_float(a0 << 16); xf[1] = __uint_as_float(a0 & 0xffff0000u); xf[2] = __uint_as_float(a1 << 16); xf[3] = __uint_as_float(a1 & 0xffff0000u);
            xf[4] = __uint_as_float(a2 << 16); xf[5] = __uint_as_float(a2 & 0xffff0000u); xf[6] = __uint_as_float(a3 << 16); xf[7] = __uint_as_float(a3 & 0xffff0000u);
            xf[8] = __uint_as_float(b0 << 16); xf[9] = __uint_as_float(b0 & 0xffff0000u); xf[10] = __uint_as_float(b1 << 16); xf[11] = __uint_as_float(b1 & 0xffff0000u);
            xf[12] = __uint_as_float(b2 << 16); xf[13] = __uint_as_float(b2 & 0xffff0000u); xf[14] = __uint_as_float(b3 << 16); xf[15] = __uint_as_float(b3 & 0xffff0000u);
        }
#pragma unroll
        for (int j = 0; j < 16; ++j) oa[j] = 0.f;
#pragma unroll 1
        for (int half = 0; half < 2; ++half) {
            const int myid = ids[(size_t)tok * 128 + half * 64 + lane];
            const float myw = wts[(size_t)tok * 128 + half * 64 + lane] * VS[myid];
            const float myus = US[myid];
#pragma unroll 1
            for (int eb = 0; eb < 64; eb += 16) {
                int id[16]; float d[16]; u32x4 ur[16];
#pragma unroll
                for (int j = 0; j < 16; ++j) id[j] = __shfl(myid, eb + j);
#pragma unroll
                for (int j = 0; j < 16; ++j) ur[j] = *(const u32x4*)(UB + (size_t)id[j] * D + lane * 16);
#pragma unroll
                for (int j = 0; j < 16; ++j) d[j] = dot16_fp8(ur[j], xf);
#pragma unroll
                for (int j = 0; j < 16; ++j) ur[j] = *(const u32x4*)(VB + (size_t)id[j] * D + lane * 16);
#pragma unroll
                for (int j = 0; j < 16; ++j) d[j] = wave_sum(d[j]);
#pragma unroll
                for (int j = 0; j < 16; ++j) { const float c = __shfl(myw, eb + j) * gelu_tanh(d[j] * __shfl(myus, eb + j)); axpy16_fp8(oa, c, ur[j]); }
            }
        }
        float* orow = O + (size_t)tok * D + lane * 16; float* wrow = DUMMY ? (float*)(p.ws + WS_PROJ) + (size_t)tok * D + lane * 16 : orow;
        float ss = 0.f; f32x4 hv[4];
#pragma unroll
        for (int q = 0; q < 4; ++q) {
            f32x4 h = *(const f32x4*)(orow + 4 * q);
            h.x += oa[4 * q]; h.y += oa[4 * q + 1]; h.z += oa[4 * q + 2]; h.w += oa[4 * q + 3];
            *(f32x4*)(wrow + 4 * q) = h; hv[q] = h;
            ss += h.x * h.x + h.y * h.y + h.z * h.z + h.w * h.w;
        }
        ss = wave_sum(ss);
        const float r = rsqrtf(ss * (1.0f / D) + EPS);
        u32x4 q0, q1;
        { const f32x4 g0 = *(const f32x4*)(gn + lane * 16), g1 = *(const f32x4*)(gn + lane * 16 + 4), g2 = *(const f32x4*)(gn + lane * 16 + 8), g3 = *(const f32x4*)(gn + lane * 16 + 12);
          q0.x = pk2(hv[0].x * r * g0.x, hv[0].y * r * g0.y); q0.y = pk2(hv[0].z * r * g0.z, hv[0].w * r * g0.w); q0.z = pk2(hv[1].x * r * g1.x, hv[1].y * r * g1.y); q0.w = pk2(hv[1].z * r * g1.z, hv[1].w * r * g1.w);
          q1.x = pk2(hv[2].x * r * g2.x, hv[2].y * r * g2.y); q1.y = pk2(hv[2].z * r * g2.z, hv[2].w * r * g2.w); q1.z = pk2(hv[3].x * r * g3.x, hv[3].y * r * g3.y); q1.w = pk2(hv[3].z * r * g3.z, hv[3].w * r * g3.w); }
        *(u32x4*)(HG + (size_t)tok * D + lane * 16) = q0; *(u32x4*)(HG + (size_t)tok * D + lane * 16 + 8) = q1;
    }
}


__device__ __forceinline__ unsigned xb_xcc_id();
template <int CTRL> __device__ __forceinline__ float dpp_row_ror(float v) { return __int_as_float(__builtin_amdgcn_update_dpp(0, __float_as_int(v), CTRL, 0xF, 0xF, false)); }
__device__ __forceinline__ float grp8_sum(float v) { v += dpp_f<0xB1>(v); v += dpp_f<0x4E>(v); v += dpp_f<0x141>(v); return v; }
__device__ __forceinline__ int peer_next_item(unsigned* ctr, int myx, int& slice) {
    for (int k = 0; k < 8; ++k) {
        const int x = (myx + k) & 7;
        int it = 0;
        if ((threadIdx.x & 63) == 0) it = (int)atomicAdd(ctr + x * 16, 1u);
        it = __builtin_amdgcn_readfirstlane(it);
        if (it < 1024) { slice = x; return it; }
    }
    return -1;
}
__device__ __forceinline__ void unpack16(const u32x4 x0, const u32x4 x1, float* xf) {
    const unsigned a0 = x0.x, a1 = x0.y, a2 = x0.z, a3 = x0.w, b0 = x1.x, b1 = x1.y, b2 = x1.z, b3 = x1.w;
    xf[0] = __uint_as_float(a0 << 16); xf[1] = __uint_as_float(a0 & 0xffff0000u); xf[2] = __uint_as_float(a1 << 16); xf[3] = __uint_as_float(a1 & 0xffff0000u);
    xf[4] = __uint_as_float(a2 << 16); xf[5] = __uint_as_float(a2 & 0xffff0000u); xf[6] = __uint_as_float(a3 << 16); xf[7] = __uint_as_float(a3 & 0xffff0000u);
    xf[8] = __uint_as_float(b0 << 16); xf[9] = __uint_as_float(b0 & 0xffff0000u); xf[10] = __uint_as_float(b1 << 16); xf[11] = __uint_as_float(b1 & 0xffff0000u);
    xf[12] = __uint_as_float(b2 << 16); xf[13] = __uint_as_float(b2 & 0xffff0000u); xf[14] = __uint_as_float(b3 << 16); xf[15] = __uint_as_float(b3 & 0xffff0000u);
}
__device__ __forceinline__ void phase9a(const Params& p, unsigned char* lds) {
    const bf16* HN = (const bf16*)(p.ws + WS_ACT); const unsigned char* UB = p.ws + WS_UB;
    const int* ids = (const int*)(p.ws + WS_IDS); float* PD = (float*)(p.ws + WS_PROJ);
    unsigned* ctr = (unsigned*)(p.ws + WS_CTR) + 256;
    const int lane = threadIdx.x & 63, gq = lane >> 3, cl = lane & 7, myx = (int)(xb_xcc_id() & 7u);
    for (;;) {
        int x; const int it = peer_next_item(ctr, myx, x);
        if (it < 0) break;
        const unsigned char* ub = UB + (size_t)x * (16384 * 128) + cl * 16;
        const bf16* hn = HN + x * 128 + cl * 16;
        const int tokb = it * 16;
        int idn[8]; u32x4 buf[8], xr0, xr1;
        { const int* ip = ids + (size_t)tokb * 128 + gq;
#pragma unroll
          for (int i = 0; i < 8; ++i) idn[i] = ip[i * 8]; }
#pragma unroll
        for (int i = 0; i < 8; ++i) buf[i] = *(const u32x4*)(ub + (size_t)idn[i] * 128);
        xr0 = *(const u32x4*)(hn + (size_t)tokb * D); xr1 = *(const u32x4*)(hn + (size_t)tokb * D + 8);
        { const int* ip = ids + (size_t)tokb * 128 + 64 + gq;
#pragma unroll
          for (int i = 0; i < 8; ++i) idn[i] = ip[i * 8]; }
#pragma unroll 1
        for (int u = 0; u < 32; ++u) {
            const int u1 = (u + 1 < 32) ? u + 1 : u, u2 = (u + 2 < 32) ? u + 2 : u;
            float xf[16]; unpack16(xr0, xr1, xf);
            float keep = 0.f;
#pragma unroll
            for (int i = 0; i < 8; ++i) {
                const float d = grp8_sum(dot16_fp8(buf[i], xf)); if (i == cl) keep = d;
                buf[i] = *(const u32x4*)(ub + (size_t)idn[i] * 128);
            }
            xr0 = *(const u32x4*)(hn + (size_t)(tokb + (u1 >> 1)) * D); xr1 = *(const u32x4*)(hn + (size_t)(tokb + (u1 >> 1)) * D + 8);
            { const int* ip = ids + (size_t)(tokb + (u2 >> 1)) * 128 + (u2 & 1) * 64 + gq;
#pragma unroll
              for (int i = 0; i < 8; ++i) idn[i] = ip[i * 8]; }
            PD[((size_t)x * NTOK + tokb + (u >> 1)) * 128 + ((u & 1) * 8 + cl) * 8 + gq] = keep;
        }
    }
}
__device__ __forceinline__ void phase9c(const Params& p, unsigned char* lds) {
    const int* ids = (const int*)(p.ws + WS_IDS); float* wts = (float*)(p.ws + WS_WTS); const float* PD = (const float*)(p.ws + WS_PROJ);
    const float* US = (const float*)(p.ws + WS_US); const float* VS = (const float*)(p.ws + WS_VS);
    const size_t gtid = (size_t)blockIdx.x * NTHR + threadIdx.x, gth = (size_t)gridDim.x * NTHR;
    for (size_t i = gtid; i < (size_t)NTOK * 128; i += gth) {
        float sdot = 0.f;
#pragma unroll
        for (int x = 0; x < 8; ++x) sdot += PD[(size_t)x * NTOK * 128 + i];
        const int id = ids[i];
        wts[i] = wts[i] * VS[id] * gelu_tanh(sdot * US[id]);
    }
}
__device__ __forceinline__ void phase9b(const Params& p, unsigned char* lds) {
    const unsigned char* VB = p.ws + WS_VB; const int* ids = (const int*)(p.ws + WS_IDS); const float* coef = (const float*)(p.ws + WS_WTS);
    float* O = p.out; bf16* HG = (bf16*)(p.ws + WS_PROJ + 64 * MiB); const float* gn = p.in[19]; float* SSQ = (float*)(p.ws + WS_SSQ);
    unsigned* ctr = (unsigned*)(p.ws + WS_CTR) + 512;
    const int lane = threadIdx.x & 63, gq = lane >> 3, cl = lane & 7, myx = (int)(xb_xcc_id() & 7u);
    for (;;) {
        int x; const int it = peer_next_item(ctr, myx, x);
        if (it < 0) break;
        const unsigned char* vb = VB + (size_t)x * (16384 * 128) + cl * 16;
        const int tokb = it * 16;
        int idn[8]; u32x4 buf[8]; float cf[8], cn[8]; float acc[16];
#pragma unroll
        for (int j = 0; j < 16; ++j) acc[j] = 0.f;
        { const int* ip = ids + (size_t)tokb * 128 + gq; const float* cp = coef + (size_t)tokb * 128 + gq;
#pragma unroll
          for (int i = 0; i < 8; ++i) { idn[i] = ip[i * 8]; cf[i] = cp[i * 8]; } }
#pragma unroll
        for (int i = 0; i < 8; ++i) buf[i] = *(const u32x4*)(vb + (size_t)idn[i] * 128);
        { const int* ip = ids + (size_t)tokb * 128 + 64 + gq; const float* cp = coef + (size_t)tokb * 128 + 64 + gq;
#pragma unroll
          for (int i = 0; i < 8; ++i) { idn[i] = ip[i * 8]; cn[i] = cp[i * 8]; } }
#pragma unroll 1
        for (int u = 0; u < 32; ++u) {
            const int u2 = (u + 2 < 32) ? u + 2 : u;
#pragma unroll
            for (int i = 0; i < 8; ++i) { axpy16_fp8(acc, cf[i], buf[i]); buf[i] = *(const u32x4*)(vb + (size_t)idn[i] * 128); cf[i] = cn[i]; }
            { const int* ip = ids + (size_t)(tokb + (u2 >> 1)) * 128 + (u2 & 1) * 64 + gq; const float* cp = coef + (size_t)(tokb + (u2 >> 1)) * 128 + (u2 & 1) * 64 + gq;
#pragma unroll
              for (int i = 0; i < 8; ++i) { idn[i] = ip[i * 8]; cn[i] = cp[i * 8]; } }
            if (u & 1) {
                const int tok = tokb + (u >> 1);
#pragma unroll
                for (int j = 0; j < 16; ++j) { float v = acc[j]; v += __shfl_xor(v, 8); v += __shfl_xor(v, 16); v += __shfl_xor(v, 32); acc[j] = v; }
                float ss = 0.f;
                if (gq == 0) {
                    float* orow = O + (size_t)tok * D + x * 128 + cl * 16; const float* gr = gn + x * 128 + cl * 16; u32x4 q0, q1; unsigned qq[8];
#pragma unroll
                    for (int q = 0; q < 4; ++q) {
                        f32x4 hv = *(const f32x4*)(orow + 4 * q); const f32x4 gg = *(const f32x4*)(gr + 4 * q);
                        hv.x += acc[4 * q]; hv.y += acc[4 * q + 1]; hv.z += acc[4 * q + 2]; hv.w += acc[4 * q + 3];
                        *(f32x4*)(orow + 4 * q) = hv;
                        ss += hv.x * hv.x + hv.y * hv.y + hv.z * hv.z + hv.w * hv.w;
                        qq[2 * q] = pk2(hv.x * gg.x, hv.y * gg.y); qq[2 * q + 1] = pk2(hv.z * gg.z, hv.w * gg.w);
                    }
                    q0.x = qq[0]; q0.y = qq[1]; q0.z = qq[2]; q0.w = qq[3]; q1.x = qq[4]; q1.y = qq[5]; q1.z = qq[6]; q1.w = qq[7];
                    *(u32x4*)(HG + (size_t)tok * D + x * 128 + cl * 16) = q0; *(u32x4*)(HG + (size_t)tok * D + x * 128 + cl * 16 + 8) = q1;
                }
                ss = grp8_sum(ss);
                if (lane == 0) SSQ[(size_t)x * NTOK + tok] = ss;
#pragma unroll
                for (int j = 0; j < 16; ++j) acc[j] = 0.f;
            }
        }
    }
}

#define XB_TMO      128
#define XB_XCNT(j)  (256  + 64 * (j))
#define XB_XSUB(j)  (1280 + 64 * (j))
#define XB_XGEN(j)  (2304 + 64 * (j))
#define XB_TOP      3328
#define XB_TOPGEN   3392
#define XCD_BAR_WORDS 3456
#define XB_SPIN_CAP (1u << 18)
#define LAS __attribute__((address_space(3)))
__device__ __forceinline__ unsigned xb_ld(unsigned* p)              { return __hip_atomic_load(p, __ATOMIC_RELAXED, __HIP_MEMORY_SCOPE_AGENT); }
__device__ __forceinline__ unsigned xb_add(unsigned* p, unsigned v) { return __hip_atomic_fetch_add(p, v, __ATOMIC_RELAXED, __HIP_MEMORY_SCOPE_AGENT); }
__device__ __forceinline__ unsigned xb_xcc_id() { return (unsigned)__builtin_amdgcn_s_getreg((3 << 11) | 20) & 0xFu; }
#define XB_SPIN(cond, bar) do { unsigned _sp = 0; while (cond) { __builtin_amdgcn_s_sleep(1); \
    if ((++_sp & 255u) == 0u) { if (xb_ld(&(bar)[XB_TMO])) break; if (_sp > XB_SPIN_CAP) { atomicAdd(&(bar)[XB_TMO], 1u); break; } } } } while (0)
struct XcdBarrier { unsigned* bar; unsigned x; volatile LAS unsigned* st; };
__device__ __forceinline__ XcdBarrier xcd_barrier_post(unsigned* bar, volatile LAS unsigned* st) {
    XcdBarrier b; b.bar = bar; b.x = xb_xcc_id(); b.st = st;
    if (threadIdx.x == 0) (void)xb_add(&bar[XB_XCNT(b.x)], 1u);
    return b;
}
__device__ __forceinline__ void xcd_barrier_complete(unsigned* bar, unsigned x, unsigned& nloc, unsigned& nx) {
    const unsigned G = gridDim.x * gridDim.y * gridDim.z;
    unsigned sum, cnt, mine, sp = 0u;
    for (;;) {
        sum = 0u; cnt = 0u; mine = 0u;
#pragma unroll
        for (unsigned j = 0; j < 16; ++j) { const unsigned c = xb_ld(&bar[XB_XCNT(j)]); sum += c; cnt += (c > 0u) ? 1u : 0u; mine = (j == x) ? c : mine; }
        if (sum == G) break;
        __builtin_amdgcn_s_sleep(1);
        if ((++sp & 255u) == 0u) { if (xb_ld(&bar[XB_TMO])) break; if (sp > XB_SPIN_CAP) { atomicAdd(&bar[XB_TMO], 1u); break; } }
    }
    nloc = mine > 0u ? mine : 1u; nx = cnt > 0u ? cnt : 1u;
}
__device__ __forceinline__ void xcd_barrier(const XcdBarrier& b) {
    asm volatile("s_waitcnt vmcnt(0)" ::: "memory");
    __syncthreads();
    if (threadIdx.x == 0) {
        unsigned* bar = b.bar;
        __builtin_amdgcn_s_waitcnt(0);
        unsigned nloc = b.st[0], nx = b.st[1];
        if (nloc == 0u) { xcd_barrier_complete(bar, b.x, nloc, nx); b.st[0] = nloc; b.st[1] = nx; }
        const unsigned old = xb_add(&bar[XB_XSUB(b.x)], 1u);
        const unsigned gen = old / nloc;
        if (old + 1u == (gen + 1u) * nloc) {
            __builtin_amdgcn_fence(__ATOMIC_RELEASE, "agent");
            asm volatile("s_waitcnt vmcnt(0)" ::: "memory");
            const unsigned og = xb_add(&bar[XB_TOP], 1u);
            const unsigned tg = og / nx;
            if (og + 1u == (tg + 1u) * nx) xb_add(&bar[XB_TOPGEN], 1u);
            else XB_SPIN(xb_ld(&bar[XB_TOPGEN]) == tg, bar);
            __builtin_amdgcn_fence(__ATOMIC_ACQUIRE, "agent");
            xb_add(&bar[XB_XGEN(b.x)], 1u);
            asm volatile("s_waitcnt vmcnt(0)" ::: "memory");
        } else {
            XB_SPIN(xb_ld(&bar[XB_XGEN(b.x)]) == gen, bar);
            __builtin_amdgcn_fence(__ATOMIC_ACQUIRE, "agent");
            asm volatile("s_waitcnt vmcnt(0)" ::: "memory");
        }
    }
    __syncthreads();
}

constexpr int REPK = -1;
__global__ void __launch_bounds__(NTHR, 2) mega(Params p, int ph_lo, int ph_hi) {
    extern __shared__ __attribute__((aligned(16))) unsigned char lds[];
    volatile LAS unsigned* st = (volatile LAS unsigned*)(LAS unsigned char*)(lds + LDS_BYTES - 16);
    if (threadIdx.x < 4) st[threadIdx.x] = 0u;
    __syncthreads();
    const XcdBarrier bar = xcd_barrier_post((unsigned*)p.ws, st);
#define RUN_PHASE(k, call) if (ph_lo <= (k) && (k) < ph_hi) { if ((k) > ph_lo) xcd_barrier(bar); call; if (REPK == (k)) { xcd_barrier(bar); call; } }
    RUN_PHASE(0, phase0(p, lds))
    RUN_PHASE(1, phase1(p, lds))
    RUN_PHASE(2, phase2(p, lds))
    if (REPK == 30) { xcd_barrier(bar); if ((threadIdx.x >> 6) == 0 && blockIdx.x < 64) hgrn_scan_item<true>(p, blockIdx.x); }
    if (ph_lo <= 3 && 3 < ph_hi) { if (3 > ph_lo) xcd_barrier(bar); phase3<true>(p, lds); if (REPK == 3) { xcd_barrier(bar); phase3<false>(p, lds); } }
    RUN_PHASE(4, phase4(p, lds))
    RUN_PHASE(5, phase5(p, lds))
    RUN_PHASE(6, phase6(p, lds))
    RUN_PHASE(7, phase7(p, lds))
    RUN_PHASE(8, phase8(p, lds))
    if (ph_lo <= 9 && 9 < ph_hi) { if (9 > ph_lo) xcd_barrier(bar); phase9a(p, lds); }
    if (ph_lo <= 9 && 9 < ph_hi) { xcd_barrier(bar); phase9c(p, lds); }
    if (ph_lo <= 9 && 9 < ph_hi) { xcd_barrier(bar); phase9b(p, lds); }
    RUN_PHASE(10, phase10(p, lds))
}

static void launch_mega(const Params& p, int lo, int hi, hipStream_t stream) {
    static int grid = 0;
    if (grid == 0) {
        int dev = 0, cus = 0, per_cu = 0;
        hipGetDevice(&dev); hipDeviceGetAttribute(&cus, hipDeviceAttributeMultiprocessorCount, dev);
        hipFuncSetAttribute((const void*)mega, hipFuncAttributeMaxDynamicSharedMemorySize, LDS_BYTES);
        hipOccupancyMaxActiveBlocksPerMultiprocessor(&per_cu, (const void*)mega, NTHR, LDS_BYTES);
        if (per_cu < 1) { fprintf(stderr, "mega: occupancy query says %d blocks/CU\n", per_cu); per_cu = 1; }
        grid = cus;
    }
    hipMemsetAsync(p.ws, 0, 65536, stream);
    Params pp = p; int l = lo, h = hi;
    void* args[] = {&pp, &l, &h};
    hipError_t e = hipLaunchCooperativeKernel((const void*)mega, dim3(grid), dim3(NTHR), args, LDS_BYTES, stream);
    if (e != hipSuccess) fprintf(stderr, "cooperative launch failed: %s (grid %d)\n", hipGetErrorString(e), grid);
}

extern "C" void kernel_launch(void* const* d_in, const int* in_sizes, int n_in, void* d_out, int out_size, void* d_ws, size_t ws_size, hipStream_t stream) {
    const float* x = (const float*)d_in[0]; const float* p = (const float*)d_in[1]; const float* mix_norm = (const float*)d_in[2]; const float* w_in = (const float*)d_in[3];
    const float* lb_logits = (const float*)d_in[4]; const float* hg_out_norm = (const float*)d_in[5]; const float* q_norm = (const float*)d_in[6]; const float* k_norm = (const float*)d_in[7];
    const float* cmp_pe = (const float*)d_in[8]; const float* cmp_w1 = (const float*)d_in[9]; const float* cmp_w2 = (const float*)d_in[10]; const float* nsa_out_norm = (const float*)d_in[11];
    const float* w_out = (const float*)d_in[12]; const float* ffn_norm = (const float*)d_in[13]; const float* peer_wq = (const float*)d_in[14]; const float* peer_keys = (const float*)d_in[15];
    const float* peer_u = (const float*)d_in[16]; const float* peer_v = (const float*)d_in[17]; const float* ple_proj = (const float*)d_in[18]; const float* ple_gate_norm = (const float*)d_in[19];
    const float* ple_gate_w = (const float*)d_in[20];
    float* out = (float*)d_out; unsigned char* ws = (unsigned char*)d_ws;
    bf16* act = (bf16*)(ws + WS_ACT); bf16* proj = (bf16*)(ws + WS_PROJ);
    bf16* pq = (bf16*)(ws + WS_PROJ); bf16* hg = (bf16*)(ws + WS_PROJ + 64 * MiB);
    int* ids = (int*)(ws + WS_IDS); float* wts = (float*)(ws + WS_WTS); float* kcf = (float*)(ws + WS_KCF); float* vcf = (float*)(ws + WS_VCF); float* gl = (float*)(ws + WS_GL);

    Params prm{}; for (int i = 0; i < 21; ++i) prm.in[i] = (const float*)d_in[i]; prm.out = out; prm.ws = ws;
    launch_mega(prm, 0, 11, stream);
}
```

```cpp
#include <hip/hip_runtime.h>
#include <hip/hip_cooperative_groups.h>
#include <cstdint>
#include <cstdio>
namespace cg = cooperative_groups;

constexpr int D = 1024, NB = 2, T = 8192, NTOK = NB * T;
constexpr int DIN = 3352, PS = 3392;
constexpr int C_HQ = 0, C_HF = 512, C_HI = 1024, C_HG = 1536, C_NQ = 2048, C_KC = 2560, C_VC = 2688,
              C_KS = 2816, C_VS = 2944, C_KW = 3072, C_VW = 3200, C_GT = 3328;
constexpr int NCMP = 511;
constexpr float EPS = 1e-6f;
typedef unsigned short bf16;

constexpr size_t MiB = 1u << 20;
constexpr size_t WS_WINT = 1 * MiB;
constexpr size_t WS_WOUTT = 8 * MiB;
constexpr size_t WS_WQT = 10 * MiB;
constexpr size_t WS_WGT = 14 * MiB;
constexpr size_t WS_WPT = 16 * MiB;
constexpr size_t WS_KEYB = 16 * MiB + 512 * 1024;
constexpr size_t WS_W1T = 17 * MiB;
constexpr size_t WS_CTR = 16384;
constexpr size_t WS_SSQ = 512 * 1024;
constexpr size_t WS_US = 256 * 1024;
constexpr size_t WS_VS = 320 * 1024;
constexpr size_t WS_UB = 18 * MiB;
constexpr size_t WS_VB = 50 * MiB;
constexpr size_t WS_ACT = 82 * MiB;
constexpr size_t WS_PROJ = 114 * MiB;
constexpr size_t WS_SPARE = 220 * MiB;
constexpr size_t WS_IDS = WS_SPARE;
constexpr size_t WS_WTS = WS_SPARE + 8 * MiB;
constexpr size_t WS_KCF = WS_SPARE + 16 * MiB;
constexpr size_t WS_VCF = WS_SPARE + 17 * MiB;
constexpr size_t WS_PB = WS_SPARE + 18 * MiB;
constexpr size_t WS_VTS = WS_SPARE + 26 * MiB;
constexpr size_t WS_VTW = WS_SPARE + 30 * MiB;
constexpr size_t WS_COEFT = WS_SPARE + 26 * MiB;
constexpr size_t WS_KFS = WS_SPARE;
constexpr size_t WS_KFW = WS_SPARE + 4 * MiB;
constexpr size_t WS_KC = WS_SPARE + 34 * MiB;
constexpr size_t WS_VCT = WS_SPARE + 34 * MiB + 256 * 1024;
constexpr size_t WS_DEC = WS_SPARE + 34 * MiB + 512 * 1024;
constexpr size_t OUT_KIT = 32 * MiB;
constexpr size_t OUT_VT = 48 * MiB;
constexpr size_t WS_GL = 18 * MiB;

__device__ __forceinline__ float bf2f(bf16 v) { return __uint_as_float(((unsigned)v) << 16); }
__device__ __forceinline__ bf16 f2bf(float f) { return __builtin_bit_cast(bf16, (__bf16)f); }
__device__ __forceinline__ float wave_sum(float v) {
#pragma unroll
    for (int o = 1; o < 64; o <<= 1) v += __shfl_xor(v, o);
    return v;
}
__device__ __forceinline__ float wave_max(float v) {
#pragma unroll
    for (int o = 1; o < 64; o <<= 1) v = fmaxf(v, __shfl_xor(v, o));
    return v;
}
__device__ __forceinline__ float sigmoidf_(float x) { return 1.0f / (1.0f + __expf(-x)); }
__device__ __forceinline__ float siluf_(float x) { return x * sigmoidf_(x); }
__device__ __forceinline__ float gelu_tanh(float x) { return 0.5f * x * (1.0f + tanhf(0.7978845608028654f * (x + 0.044715f * x * x * x))); }
__device__ __forceinline__ float toF(float v) { return v; }
__device__ __forceinline__ float toF(bf16 v) { return bf2f(v); }

__global__ void __launch_bounds__(256) k_rms_rows(const float* __restrict__ x, const float* __restrict__ g, bf16* __restrict__ out, int rows) {
    const int wave = (blockIdx.x * 256 + threadIdx.x) >> 6, lane = threadIdx.x & 63;
    if (wave >= rows) return;
    const float* xr = x + (size_t)wave * D;
    float v[16]; float s = 0.f;
#pragma unroll
    for (int j = 0; j < 16; ++j) { v[j] = xr[lane + 64 * j]; s += v[j] * v[j]; }
    s = wave_sum(s);
    const float r = rsqrtf(s * (1.0f / D) + EPS);
#pragma unroll
    for (int j = 0; j < 16; ++j) out[(size_t)wave * D + lane + 64 * j] = f2bf(v[j] * r * g[lane + 64 * j]);
}

struct EpiBf16 { bf16* C; int ldc; int pad; __device__ void operator()(int r, int c, float v) const { C[(size_t)r * ldc + c] = f2bf(v); } };
struct EpiF32 { float* C; int ldc; int pad; __device__ void operator()(int r, int c, float v) const { C[(size_t)r * ldc + c] = v; } };
struct EpiResid { const float* X; float* O; int ld; int pad; __device__ void operator()(int r, int c, float v) const { O[(size_t)r * ld + c] = X[(size_t)r * ld + c] + v; } };
struct EpiFinal { const float* G; float* O; int ld; int pad; __device__ void operator()(int r, int c, float v) const { const size_t i = (size_t)r * ld + c; O[i] = O[i] + v * sigmoidf_(G[i]); } };

template <typename AT, class Epi>
__global__ void __launch_bounds__(256) k_gemm_naive(const AT* __restrict__ A, int lda, const float* __restrict__ W, int ldw, int N, int K, Epi epi) {
    __shared__ float As[16][65];
    __shared__ float Bs[16][64];
    const int tid = threadIdx.x, tx = tid & 15, ty = tid >> 4;
    const int m0 = blockIdx.y * 64, n0 = blockIdx.x * 64;
    float acc[4][4];
#pragma unroll
    for (int i = 0; i < 4; ++i)
#pragma unroll
        for (int j = 0; j < 4; ++j) acc[i][j] = 0.f;
    for (int k0 = 0; k0 < K; k0 += 16) {
#pragma unroll
        for (int i = 0; i < 4; ++i) { const int idx = tid + i * 256, r = idx >> 4, kk = idx & 15; As[kk][r] = toF(A[(size_t)(m0 + r) * lda + k0 + kk]); }
#pragma unroll
        for (int i = 0; i < 4; ++i) { const int idx = tid + i * 256, kk = idx >> 6, c = idx & 63; Bs[kk][c] = (n0 + c < N) ? W[(size_t)(k0 + kk) * ldw + n0 + c] : 0.f; }
        __syncthreads();
#pragma unroll
        for (int kk = 0; kk < 16; ++kk) {
            float a[4], b[4];
#pragma unroll
            for (int i = 0; i < 4; ++i) a[i] = As[kk][ty * 4 + i];
#pragma unroll
            for (int j = 0; j < 4; ++j) b[j] = Bs[kk][tx * 4 + j];
#pragma unroll
            for (int i = 0; i < 4; ++i)
#pragma unroll
                for (int j = 0; j < 4; ++j) acc[i][j] += a[i] * b[j];
        }
        __syncthreads();
    }
#pragma unroll
    for (int i = 0; i < 4; ++i)
#pragma unroll
        for (int j = 0; j < 4; ++j) { const int r = m0 + ty * 4 + i, c = n0 + tx * 4 + j; if (c < N) epi(r, c, acc[i][j]); }
}

__global__ void __launch_bounds__(1024) k_hgrn_naive(const bf16* __restrict__ proj, const float* __restrict__ lb_logits, const float* __restrict__ out_gain, bf16* __restrict__ mixed) {
    const int b = blockIdx.x >> 2, h = blockIdx.x & 3, tid = threadIdx.x, v = tid & 127, kg = tid >> 7;
    __shared__ float qsh[128], ksh[128], fsh[128], vsh[128], part[8][128], red[2], lbs[128];
    if (tid < 128) { const float l0 = lb_logits[h * 128 + tid], l1 = lb_logits[512 + h * 128 + tid]; const float m = fmaxf(l0, l1); const float e0 = expf(l0 - m), e1 = expf(l1 - m); lbs[tid] = e0 / (e0 + e1); }
    float S[16];
#pragma unroll
    for (int i = 0; i < 16; ++i) S[i] = 0.f;
    __syncthreads();
    for (int t = 0; t < T; ++t) {
        const size_t row = (size_t)(b * T + t) * PS;
        if (tid < 128) {
            const float fl = bf2f(proj[row + C_HF + h * 128 + tid]); const float lb = lbs[tid];
            const float fg = lb + (1.0f - lb) * sigmoidf_(fl); fsh[tid] = fg; ksh[tid] = 1.0f - fg;
            qsh[tid] = siluf_(bf2f(proj[row + C_HQ + h * 128 + tid])) * 0.08838834764831845f;
        } else if (tid < 256) vsh[tid - 128] = bf2f(proj[row + C_HI + h * 128 + tid - 128]);
        __syncthreads();
        const float vv = vsh[v]; float p = 0.f;
#pragma unroll
        for (int i = 0; i < 16; ++i) { const int k = kg * 16 + i; S[i] = fsh[k] * S[i] + ksh[k] * vv; p += qsh[k] * S[i]; }
        part[kg][v] = p;
        __syncthreads();
        float o = 0.f;
        if (tid < 128) {
#pragma unroll
            for (int j = 0; j < 8; ++j) o += part[j][tid];
            const float ss = wave_sum(o * o); if ((tid & 63) == 0) red[tid >> 6] = ss;
        }
        __syncthreads();
        if (tid < 128) {
            const float tot = red[0] + red[1];
            const float y = o * rsqrtf(tot * (1.0f / 128.0f) + EPS) * out_gain[h * 128 + tid];
            const float gl = bf2f(proj[row + C_HG + h * 128 + tid]);
            mixed[(size_t)(b * T + t) * D + h * 128 + tid] = f2bf(y * siluf_(gl));
        }
    }
}

__global__ void __launch_bounds__(64) k_cmp_naive(const bf16* __restrict__ proj, const float* __restrict__ pe, const float* __restrict__ w1, const float* __restrict__ w2,
                                                  const float* __restrict__ k_gain, float* __restrict__ kc, float* __restrict__ vc) {
    int it = blockIdx.x; const int n = it % NCMP; it /= NCMP; const int g = it & 1; it >>= 1; const int b = it & 1; const int which = it >> 1;
    const int c = threadIdx.x;
    __shared__ float blk[2048]; __shared__ float hid[64];
    const int col0 = (which == 0 ? C_KC : C_VC) + g * 64;
    for (int i = c; i < 2048; i += 64) { const int j = i >> 6, d = i & 63; blk[i] = bf2f(proj[(size_t)(b * T + 16 * n + j) * PS + col0 + d]) + pe[which * 2048 + i]; }
    __syncthreads();
    float acc = 0.f;
    for (int i = 0; i < 2048; ++i) acc += blk[i] * w1[(size_t)which * 2048 * 64 + (size_t)i * 64 + c];
    hid[c] = gelu_tanh(acc);
    __syncthreads();
    float o = 0.f;
    for (int i = 0; i < 64; ++i) o += hid[i] * w2[which * 4096 + i * 64 + c];
    if (which == 0) { const float ss = wave_sum(o * o); o = o * rsqrtf(ss * (1.0f / 64.0f) + EPS) * k_gain[c]; }
    (which == 0 ? kc : vc)[((size_t)(b * 2 + g) * NCMP + n) * 64 + c] = o;
}

__global__ void __launch_bounds__(256) k_nsa_naive(const bf16* __restrict__ proj, const float* __restrict__ kc, const float* __restrict__ vc, const float* __restrict__ q_gain,
                                                   const float* __restrict__ k_gain, const float* __restrict__ out_gain, bf16* __restrict__ mixed) {
    const int g = blockIdx.x & 1, tok = blockIdx.x >> 1, b = tok / T, t = tok % T;
    const int tid = threadIdx.x, r = tid >> 6, lane = tid & 63, h = g * 4 + r;
    __shared__ float qs[4][64]; __shared__ float sc[4][1024]; __shared__ float P[520]; __shared__ float imp[128]; __shared__ int sel[128]; __shared__ int blist[16]; __shared__ int nbs;
    const float slope = exp2f(-(float)(h + 1));
    const float NEG = -__builtin_huge_valf();
    {
        float qv = bf2f(proj[(size_t)tok * PS + C_NQ + h * 64 + lane]);
        const float ss = wave_sum(qv * qv);
        qs[r][lane] = qv * rsqrtf(ss * (1.0f / 64.0f) + EPS) * q_gain[lane] * 0.125f;
    }
    __syncthreads();
    const int nvalid = (t >= 31) ? ((t - 31) / 16 + 1) : 0;
    const float* kcb = kc + (size_t)(b * 2 + g) * NCMP * 64; const float* vcb = vc + (size_t)(b * 2 + g) * NCMP * 64;
    float mx = NEG;
    for (int n = lane; n < 512; n += 64) {
        float s = NEG;
        if (n < nvalid) { float d = 0.f; for (int i = 0; i < 64; ++i) d += qs[r][i] * kcb[n * 64 + i]; s = d - slope * (float)(t - (16 * n + 31)); }
        sc[r][n] = s; mx = fmaxf(mx, s);
    }
    mx = wave_max(mx); if (mx == NEG) mx = 0.f;
    float sum = 0.f;
    for (int n = lane; n < 512; n += 64) { const float e = (n < nvalid) ? expf(sc[r][n] - mx) : 0.f; sc[r][n] = e; sum += e; }
    sum = wave_sum(sum); float inv = 1.0f / fmaxf(sum, 1e-30f);
    for (int n = lane; n < 512; n += 64) sc[r][n] *= inv;
    __syncthreads();
    float oc = 0.f;
    for (int n = 0; n < nvalid; ++n) oc += sc[r][n] * vcb[n * 64 + lane];
    for (int i = tid; i < 520; i += 256) P[i] = (i < 512) ? (sc[0][i] + sc[1][i] + sc[2][i] + sc[3][i]) : 0.f;
    __syncthreads();
    if (tid < 128) imp[tid] = P[4 * tid] + 2.f * P[4 * tid + 1] + 2.f * P[4 * tid + 2] + 2.f * P[4 * tid + 3] + P[4 * tid + 4];
    __syncthreads();
    const int cur = t >> 6;
    if (tid < 128) {
        const int j = tid; const bool forced = (j == 0) || (j == cur) || (j == cur - 1); const bool cand = !forced && j <= cur;
        const int nforced = (cur == 0) ? 1 : (cur == 1) ? 2 : 3; const int need = 16 - nforced;
        int rank = 0; const float mine = imp[j];
        for (int q = 1; q <= cur - 2; ++q) { if (q == j) continue; const float o = imp[q]; if (o > mine || (o == mine && q < j)) ++rank; }
        sel[j] = (forced || (cand && rank < need)) ? 1 : 0;
    }
    __syncthreads();
    if (tid == 0) { int nb = 0; for (int j = 0; j < 128; ++j) if (sel[j] && nb < 16) blist[nb++] = j; nbs = nb; }
    __syncthreads();
    const int nb = nbs;
    float os = 0.f;
    {
        float m2 = NEG;
        for (int s = 0; s < nb; ++s) {
            const int pos = blist[s] * 64 + lane; float val = NEG;
            if (pos <= t) {
                const bf16* kr = proj + (size_t)(b * T + pos) * PS + C_KS + g * 64; float d = 0.f, sq = 0.f;
                for (int i = 0; i < 64; ++i) { const float kv = bf2f(kr[i]); d += qs[r][i] * kv * k_gain[64 + i]; sq += kv * kv; }
                val = d * rsqrtf(sq * (1.0f / 64.0f) + EPS) - slope * (float)(t - pos);
            }
            sc[r][s * 64 + lane] = val; m2 = fmaxf(m2, val);
        }
        m2 = wave_max(m2); if (m2 == NEG) m2 = 0.f;
        float su = 0.f;
        for (int s = 0; s < nb; ++s) { const float v0 = sc[r][s * 64 + lane]; const float e = (v0 == NEG) ? 0.f : expf(v0 - m2); sc[r][s * 64 + lane] = e; su += e; }
        su = wave_sum(su); const float iv = 1.0f / fmaxf(su, 1e-30f);
        __syncthreads();
        for (int s = 0; s < nb; ++s) for (int i = 0; i < 64; ++i) {
            const float p = sc[r][s * 64 + i]; if (p != 0.f) os += p * bf2f(proj[(size_t)(b * T + blist[s] * 64 + i) * PS + C_VS + g * 64 + lane]); }
        os *= iv;
    }
    __syncthreads();
    float ow = 0.f;
    {
        float m2 = NEG;
        for (int i = lane; i < 512; i += 64) {
            const int pos = t - i; float val = NEG;
            if (pos >= 0) {
                const bf16* kr = proj + (size_t)(b * T + pos) * PS + C_KW + g * 64; float d = 0.f, sq = 0.f;
                for (int c = 0; c < 64; ++c) { const float kv = bf2f(kr[c]); d += qs[r][c] * kv * k_gain[128 + c]; sq += kv * kv; }
                val = d * rsqrtf(sq * (1.0f / 64.0f) + EPS) - slope * (float)i;
            }
            sc[r][i] = val; m2 = fmaxf(m2, val);
        }
        m2 = wave_max(m2);
        float su = 0.f;
        for (int i = lane; i < 512; i += 64) { const float v0 = sc[r][i]; const float e = (v0 == NEG) ? 0.f : expf(v0 - m2); sc[r][i] = e; su += e; }
        su = wave_sum(su); const float iv = 1.0f / fmaxf(su, 1e-30f);
        __syncthreads();
        for (int i = 0; i < 512; ++i) { const float p = sc[r][i]; if (p != 0.f) ow += p * bf2f(proj[(size_t)(b * T + t - i) * PS + C_VW + g * 64 + lane]); }
        ow *= iv;
    }
    const bf16* gl = proj + (size_t)tok * PS + C_GT + h * 3;
    const float o = sigmoidf_(bf2f(gl[0])) * oc + sigmoidf_(bf2f(gl[1])) * os + sigmoidf_(bf2f(gl[2])) * ow;
    const float ss = wave_sum(o * o);
    mixed[(size_t)tok * D + 512 + h * 64 + lane] = f2bf(o * rsqrtf(ss * (1.0f / 64.0f) + EPS) * out_gain[h * 64 + lane]);
}

__global__ void __launch_bounds__(128) k_peer_topk_naive(const bf16* __restrict__ pq, const float* __restrict__ keys, int* __restrict__ ids, float* __restrict__ wts) {
    const int tok = blockIdx.x >> 3, h = blockIdx.x & 7, k = threadIdx.x;
    __shared__ float q[256]; __shared__ float s[2][128]; __shared__ float ts[2][16]; __shared__ int ti[2][16]; __shared__ float cand[256]; __shared__ float bs[16]; __shared__ int bc[16];
    q[k] = bf2f(pq[(size_t)tok * 2048 + h * 256 + k]); q[k + 128] = bf2f(pq[(size_t)tok * 2048 + h * 256 + 128 + k]);
    __syncthreads();
#pragma unroll
    for (int c = 0; c < 2; ++c) { const float* kr = keys + ((size_t)(h * 2 + c) * 128 + k) * 128; float d = 0.f; for (int i = 0; i < 128; ++i) d += q[c * 128 + i] * kr[i]; s[c][k] = d; }
    __syncthreads();
#pragma unroll
    for (int c = 0; c < 2; ++c) { const float mine = s[c][k]; int rank = 0; for (int j = 0; j < 128; ++j) { const float o = s[c][j]; if (o > mine || (o == mine && j < k)) ++rank; } if (rank < 16) { ts[c][rank] = mine; ti[c][rank] = k; } }
    __syncthreads();
    cand[k] = ts[0][k >> 4] + ts[1][k & 15]; cand[k + 128] = ts[0][(k + 128) >> 4] + ts[1][(k + 128) & 15];
    __syncthreads();
#pragma unroll
    for (int e = 0; e < 2; ++e) { const int me = k + e * 128; const float mine = cand[me]; int rank = 0; for (int j = 0; j < 256; ++j) { const float o = cand[j]; if (o > mine || (o == mine && j < me)) ++rank; } if (rank < 16) { bs[rank] = mine; bc[rank] = me; } }
    __syncthreads();
    if (k < 16) {
        float mx = bs[0]; float sum = 0.f; for (int j = 0; j < 16; ++j) sum += expf(bs[j] - mx);
        const int c = bc[k]; ids[(size_t)tok * 128 + h * 16 + k] = ti[0][c >> 4] * 128 + ti[1][c & 15];
        wts[(size_t)tok * 128 + h * 16 + k] = expf(bs[k] - mx) / sum;
    }
}

__global__ void __launch_bounds__(256) k_peer_gather_naive(const bf16* __restrict__ hn, const int* __restrict__ ids, const float* __restrict__ wts, const float* __restrict__ U, const float* __restrict__ V,
                                                           const float* __restrict__ gnorm, float* __restrict__ hio, bf16* __restrict__ hg) {
    const int tok = blockIdx.x, tid = threadIdx.x, w = tid >> 6, lane = tid & 63;
    __shared__ float xs[1024]; __shared__ float coef[128]; __shared__ int eid[128]; __shared__ float red[4];
    for (int i = tid; i < 1024; i += 256) xs[i] = bf2f(hn[(size_t)tok * D + i]);
    if (tid < 128) eid[tid] = ids[(size_t)tok * 128 + tid];
    __syncthreads();
    for (int e = w * 32; e < w * 32 + 32; ++e) {
        const float* ur = U + (size_t)eid[e] * D; float d = 0.f;
        for (int i = lane; i < 1024; i += 64) d += ur[i] * xs[i];
        d = wave_sum(d);
        if (lane == 0) coef[e] = wts[(size_t)tok * 128 + e] * gelu_tanh(d);
    }
    __syncthreads();
    float o[4] = {0.f, 0.f, 0.f, 0.f};
    for (int e = 0; e < 128; ++e) { const float* vr = V + (size_t)eid[e] * D; const float c = coef[e];
#pragma unroll
        for (int j = 0; j < 4; ++j) o[j] += c * vr[tid + 256 * j]; }
    float ss = 0.f;
#pragma unroll
    for (int j = 0; j < 4; ++j) { o[j] += hio[(size_t)tok * D + tid + 256 * j]; hio[(size_t)tok * D + tid + 256 * j] = o[j]; ss += o[j] * o[j]; }
    ss = wave_sum(ss); if (lane == 0) red[w] = ss;
    __syncthreads();
    const float r = rsqrtf((red[0] + red[1] + red[2] + red[3]) * (1.0f / D) + EPS);
#pragma unroll
    for (int j = 0; j < 4; ++j) hg[(size_t)tok * D + tid + 256 * j] = f2bf(o[j] * r * gnorm[tid + 256 * j]);
}


typedef short bf16x8 __attribute__((ext_vector_type(8)));
typedef float f32x4 __attribute__((ext_vector_type(4)));
typedef float f32x16 __attribute__((ext_vector_type(16)));
typedef unsigned u32x4 __attribute__((ext_vector_type(4)));
typedef unsigned u32x2 __attribute__((ext_vector_type(2)));
constexpr int NTHR = 512;
constexpr int LDS_BYTES = 143360 + 16;
struct Params { const float* in[21]; float* out; unsigned char* ws; };
__device__ __forceinline__ unsigned xb_xcc_id();

typedef __bf16 bf16x2c __attribute__((ext_vector_type(2)));
__device__ __forceinline__ unsigned pk2(float lo, float hi) { bf16x2c v = { (__bf16)lo, (__bf16)hi }; return __builtin_bit_cast(unsigned, v); }

__device__ __forceinline__ void transpose_tile(const float* __restrict__ W, int K, int N, bf16* __restrict__ Wt, int kt, int nt, float* tile) {
    const int tid = threadIdx.x, k0 = kt * 64, n0 = nt * 64;
#pragma unroll
    for (int i = 0; i < 8; ++i) { const int idx = tid + i * NTHR, kk = idx >> 6, nn = idx & 63; tile[kk * 65 + nn] = (n0 + nn < N) ? W[(size_t)(k0 + kk) * N + n0 + nn] : 0.f; }
    __syncthreads();
    { const int nn = tid >> 3, ch = tid & 7; const float* s = tile + (ch * 8) * 65 + nn;
      u32x4 o; o.x = pk2(s[0], s[65]); o.y = pk2(s[130], s[195]); o.z = pk2(s[260], s[325]); o.w = pk2(s[390], s[455]);
      *(u32x4*)(Wt + (size_t)(n0 + nn) * K + k0 + ch * 8) = o; }
    __syncthreads();
}
__device__ __forceinline__ void cvt_range(const float* __restrict__ src, bf16* __restrict__ dst, size_t n8, size_t gtid, size_t gthreads) {
    for (size_t i = gtid; i < n8; i += gthreads) {
        const f32x4 a = ((const f32x4*)src)[2 * i], b = ((const f32x4*)src)[2 * i + 1];
        u32x4 o; o.x = pk2(a.x, a.y); o.y = pk2(a.z, a.w); o.z = pk2(b.x, b.y); o.w = pk2(b.z, b.w);
        ((u32x4*)dst)[i] = o;
    }
}
__device__ __forceinline__ void rms_row_bf16(const float* __restrict__ xr, const float* __restrict__ g, bf16* __restrict__ orow, int lane) {
    f32x4 v[4]; float s = 0.f;
#pragma unroll
    for (int j = 0; j < 4; ++j) { v[j] = ((const f32x4*)xr)[lane + 64 * j]; s += v[j].x * v[j].x + v[j].y * v[j].y + v[j].z * v[j].z + v[j].w * v[j].w; }
    s = wave_sum(s);
    const float r = rsqrtf(s * (1.0f / D) + EPS);
#pragma unroll
    for (int j = 0; j < 4; ++j) { const f32x4 gg = ((const f32x4*)g)[lane + 64 * j]; u32x2 o; o.x = pk2(v[j].x * r * gg.x, v[j].y * r * gg.y); o.y = pk2(v[j].z * r * gg.z, v[j].w * r * gg.w); ((u32x2*)orow)[lane + 64 * j] = o; }
}

__device__ __forceinline__ void phase0(const Params& p, unsigned char* lds) {
    float* tile = (float*)lds;
    const int nblk = gridDim.x, blk = blockIdx.x;
    unsigned char* ws = p.ws;
    constexpr int I_WIN = 16 * 56, I_WOUT = 16 * 16, I_WQ = 16 * 32, I_WG = 16 * 16, I_WP = 4 * 16, I_W1 = 2 * 32;
    constexpr int NIT = I_WIN + I_WOUT + I_WQ + I_WG + I_WP + I_W1;
    for (int it = blk; it < NIT; it += nblk) {
        int r = it;
        if (r < I_WIN) { transpose_tile(p.in[3], 1024, DIN, (bf16*)(ws + WS_WINT), r / 56, r % 56, tile); continue; } r -= I_WIN;
        if (r < I_WOUT) { transpose_tile(p.in[12], 1024, 1024, (bf16*)(ws + WS_WOUTT), r / 16, r % 16, tile); continue; } r -= I_WOUT;
        if (r < I_WQ) { transpose_tile(p.in[14], 1024, 2048, (bf16*)(ws + WS_WQT), r / 32, r % 32, tile); continue; } r -= I_WQ;
        if (r < I_WG) { transpose_tile(p.in[20], 1024, 1024, (bf16*)(ws + WS_WGT), r / 16, r % 16, tile); continue; } r -= I_WG;
        if (r < I_WP) { transpose_tile(p.in[18], 256, 1024, (bf16*)(ws + WS_WPT), r / 16, r % 16, tile); continue; } r -= I_WP;
        { const int which = r / 32, kt = r % 32; transpose_tile(p.in[9] + (size_t)which * 2048 * 64, 2048, 64, (bf16*)(ws + WS_W1T) + (size_t)which * 64 * 2048, kt, 0, tile); }
    }
    const size_t gtid = (size_t)blk * NTHR + threadIdx.x, gthreads = (size_t)nblk * NTHR;
    cvt_range(p.in[15], (bf16*)(ws + WS_KEYB), (size_t)8 * 2 * 128 * 128 / 8, gtid, gthreads);
    cvt_range(p.in[1], (bf16*)(ws + WS_PB), (size_t)NTOK * 256 / 8, gtid, gthreads);
    const int gw = (int)(gtid >> 6), ngw = (int)(gthreads >> 6), lane = threadIdx.x & 63;
    for (int m = gw; m < NTOK; m += ngw) rms_row_bf16(p.in[0] + (size_t)m * D, p.in[2], (bf16*)(ws + WS_ACT) + (size_t)m * D, lane);
    for (int m = gw; m < 2 * 16384; m += ngw) {
        const int which = m >> 14, row = m & 16383;
        const float* src = p.in[16 + which] + (size_t)row * D + lane * 16;
        const f32x4 a = *(const f32x4*)src, b = *(const f32x4*)(src + 4), c = *(const f32x4*)(src + 8), d = *(const f32x4*)(src + 12);
        float mx = fmaxf(fmaxf(fmaxf(fabsf(a.x), fabsf(a.y)), fmaxf(fabsf(a.z), fabsf(a.w))), fmaxf(fmaxf(fabsf(b.x), fabsf(b.y)), fmaxf(fabsf(b.z), fabsf(b.w))));
        mx = fmaxf(mx, fmaxf(fmaxf(fmaxf(fabsf(c.x), fabsf(c.y)), fmaxf(fabsf(c.z), fabsf(c.w))), fmaxf(fmaxf(fabsf(d.x), fabsf(d.y)), fmaxf(fabsf(d.z), fabsf(d.w)))));
        mx = fmaxf(wave_max(mx), 1e-30f);
        const float sc = 224.0f / mx;
        u32x4 o; int w;
        w = __builtin_amdgcn_cvt_pk_fp8_f32(a.x * sc, a.y * sc, 0, false); w = __builtin_amdgcn_cvt_pk_fp8_f32(a.z * sc, a.w * sc, w, true); o.x = (unsigned)w;
        w = __builtin_amdgcn_cvt_pk_fp8_f32(b.x * sc, b.y * sc, 0, false); w = __builtin_amdgcn_cvt_pk_fp8_f32(b.z * sc, b.w * sc, w, true); o.y = (unsigned)w;
        w = __builtin_amdgcn_cvt_pk_fp8_f32(c.x * sc, c.y * sc, 0, false); w = __builtin_amdgcn_cvt_pk_fp8_f32(c.z * sc, c.w * sc, w, true); o.z = (unsigned)w;
        w = __builtin_amdgcn_cvt_pk_fp8_f32(d.x * sc, d.y * sc, 0, false); w = __builtin_amdgcn_cvt_pk_fp8_f32(d.z * sc, d.w * sc, w, true); o.w = (unsigned)w;
        *(u32x4*)(ws + (which ? WS_VB : WS_UB) + (size_t)(lane >> 3) * (16384 * 128) + (size_t)row * 128 + (lane & 7) * 16) = o;
        if (lane == 0) ((float*)(ws + (which ? WS_VS : WS_US)))[row] = mx * (1.0f / 224.0f);
    }
}

__device__ __forceinline__ int swz(int ob) { return ob ^ (((ob >> 9) & 1) << 5); }
constexpr int G_STAGE = 49152;
__device__ __forceinline__ void gemm_mainloop(f32x4 (&acc)[4][4], const bf16* __restrict__ A, int lda, const bf16* __restrict__ Bt, int ldb, int K, int m0, int n0, unsigned char* lds) {
    const int tid = threadIdx.x, lane = tid & 63, wid = tid >> 6, wm = wid >> 1, wn = wid & 1, fr = lane & 15, fq = lane >> 4;
    const int lrow = tid >> 3, lc = tid & 7;
    const bf16* ag = A + (size_t)(m0 + lrow) * lda + lc * 8;
    const bf16* bg = Bt + (size_t)(n0 + lrow) * ldb + lc * 8;
    const int woff = ((lrow >> 4) * 2 + (lc >> 2)) * 1024 + swz((lrow & 15) * 64 + (lc & 3) * 16);
    const int roff = swz(fr * 64 + fq * 16);
    const int nk = K >> 6;
    u32x4 ra0[4], rb0[2], ra1[4], rb1[2];
#define GM_LOAD(ra, rb, kt) { _Pragma("unroll") for (int i = 0; i < 4; ++i) ra[i] = *(const u32x4*)(ag + (size_t)i * 64 * lda + (kt) * 64); \
                              _Pragma("unroll") for (int i = 0; i < 2; ++i) rb[i] = *(const u32x4*)(bg + (size_t)i * 64 * ldb + (kt) * 64); }
#define GM_STORE(ra, rb, buf) { _Pragma("unroll") for (int i = 0; i < 4; ++i) *(u32x4*)((buf) + woff + i * 8192) = ra[i]; \
                                _Pragma("unroll") for (int i = 0; i < 2; ++i) *(u32x4*)((buf) + 32768 + woff + i * 8192) = rb[i]; }
#define GM_COMPUTE(cur) { _Pragma("unroll") for (int s = 0; s < 2; ++s) { bf16x8 af[4], bfr[4]; \
        _Pragma("unroll") for (int i = 0; i < 4; ++i) af[i] = *(const bf16x8*)((cur) + ((wm * 4 + i) * 2 + s) * 1024 + roff); \
        _Pragma("unroll") for (int i = 0; i < 4; ++i) bfr[i] = *(const bf16x8*)((cur) + 32768 + ((wn * 4 + i) * 2 + s) * 1024 + roff); \
        _Pragma("unroll") for (int mi = 0; mi < 4; ++mi) _Pragma("unroll") for (int ni = 0; ni < 4; ++ni) acc[mi][ni] = __builtin_amdgcn_mfma_f32_16x16x32_bf16(bfr[ni], af[mi], acc[mi][ni], 0, 0, 0); } }
    unsigned char* buf0 = lds; unsigned char* buf1 = lds + G_STAGE;
    GM_LOAD(ra0, rb0, 0)
    GM_LOAD(ra1, rb1, 1)
    GM_STORE(ra0, rb0, buf0)
    __syncthreads();
    for (int kt = 0; kt < nk; kt += 2) {
        { const int kp = (kt + 2 < nk) ? kt + 2 : kt; GM_LOAD(ra0, rb0, kp) }
        GM_COMPUTE(buf0)
        GM_STORE(ra1, rb1, buf1)
        __syncthreads();
        { const int kp = (kt + 3 < nk) ? kt + 3 : kt + 1; GM_LOAD(ra1, rb1, kp) }
        GM_COMPUTE(buf1)
        if (kt + 2 < nk) GM_STORE(ra0, rb0, buf0)
        __syncthreads();
    }
}
__device__ __forceinline__ void acc_zero(f32x4 (&acc)[4][4]) {
#pragma unroll
    for (int i = 0; i < 4; ++i)
#pragma unroll
        for (int j = 0; j < 4; ++j) acc[i][j] = (f32x4){0.f, 0.f, 0.f, 0.f};
}
namespace pg8 {
#define PG8_LAS __attribute__((address_space(3)))
typedef unsigned short bf16_t;
typedef short bf16x8 __attribute__((ext_vector_type(8)));
typedef float f32x4 __attribute__((ext_vector_type(4)));
typedef unsigned u32x4 __attribute__((ext_vector_type(4)));
constexpr int BM = 256, BK = 64, HALF = 128, HTB = HALF * BK * 2  , STAGE_BYTES = 8 * HTB, NXCD = 8, WGM = 8;

__host__ __device__ __forceinline__ int lds_byte(int r, int c) { const int st = (r >> 4) * 2 + (c >> 5), rr = r & 15, cc = c & 31, ob = rr * 64 + cc * 2; return st * 1024 + (ob ^ (((ob >> 9) & 1) << 5)); }
__host__ __device__ __forceinline__ void stage_rc(int b, int& R, int& C) { const int st = b / 1024, sb = b % 1024, swz = sb ^ (((sb >> 9) & 1) << 5); R = (st >> 1) * 16 + swz / 64; C = (st & 1) * 32 + (swz % 64) / 2; }
__host__ __device__ __forceinline__ int perm32(int rho) { const int n = rho >> 4, i = rho & 15; return 8 * (i >> 2) + 4 * n + (i & 3); }

struct Unit { int pm, pn; };
struct Gemm { const bf16_t* A; const bf16_t* Bt; int M, N, K; };

struct StaticOrder {
    int nM, nN, nwg, G, c;
    __host__ __device__ void init(int M, int N, int G_, int c_) { nM = M / BM; nN = N / BM; nwg = nM * nN; G = G_; c = c_; }
    __host__ __device__ bool next(int i, Unit& u) const {
        const long L = (long)i * G + c; if (L >= nwg) return false;
        int wgid = (int)L; { const int q = nwg / NXCD, r = nwg % NXCD, xcd = wgid % NXCD, off = wgid / NXCD; wgid = (xcd < r ? xcd * (q + 1) : r * (q + 1) + (xcd - r) * q) + off; }
        const int nig = WGM * nN, gid = wgid / nig, fm = gid * WGM, gsz = (nM - fm) < WGM ? (nM - fm) : WGM;
        u.pm = fm + ((wgid % nig) % gsz); u.pn = (wgid % nig) / gsz; return true;
    }
    __device__ __forceinline__ void a_ready(const Unit&) const {}
    __device__ __forceinline__ void done(const Unit&) const {}
};

__device__ __forceinline__ unsigned pk2b(float lo, float hi) { typedef __bf16 b2 __attribute__((ext_vector_type(2))); b2 v = { (__bf16)lo, (__bf16)hi }; return __builtin_bit_cast(unsigned, v); }
typedef unsigned u32x2 __attribute__((ext_vector_type(2)));
struct EpiStoreBf16 {
    static constexpr bool PERM = false, AFTER_DRAIN = false;
    bf16_t* C; int ldc; int ncols;
    __device__ __forceinline__ void operator()(const f32x4 (&acc)[2][2][4][2], const Unit& u, int wr, int wc, int fr, int fq) const {
#pragma unroll
        for (int ai = 0; ai < 2; ++ai)
#pragma unroll
            for (int m = 0; m < 4; ++m) { bf16_t* rowp = C + (size_t)(u.pm * BM + ai * HALF + wr * 64 + m * 16 + fr) * ldc;
#pragma unroll
                for (int bj = 0; bj < 2; ++bj)
#pragma unroll
                    for (int n = 0; n < 2; ++n) { const int col = u.pn * BM + bj * HALF + wc * 32 + n * 16 + fq * 4;
                        if (col < ncols) { u32x2 w; w.x = pk2b(acc[ai][bj][m][n][0], acc[ai][bj][m][n][1]); w.y = pk2b(acc[ai][bj][m][n][2], acc[ai][bj][m][n][3]); *(u32x2*)(rowp + col) = w; } } }
    }
};
struct EpiResidF32 {
    static constexpr bool PERM = false, AFTER_DRAIN = false;
    const float* X; float* O; int ld; int pad;
    __device__ __forceinline__ void operator()(const f32x4 (&acc)[2][2][4][2], const Unit& u, int wr, int wc, int fr, int fq) const {
#pragma unroll
        for (int ai = 0; ai < 2; ++ai)
#pragma unroll
            for (int m = 0; m < 4; ++m) { const size_t ro = (size_t)(u.pm * BM + ai * HALF + wr * 64 + m * 16 + fr) * ld;
#pragma unroll
                for (int bj = 0; bj < 2; ++bj)
#pragma unroll
                    for (int n = 0; n < 2; ++n) { const size_t idx = ro + u.pn * BM + bj * HALF + wc * 32 + n * 16 + fq * 4; *(f32x4*)(O + idx) = *(const f32x4*)(X + idx) + acc[ai][bj][m][n]; } }
    }
};
struct EpiFinalGate {
    static constexpr bool PERM = false, AFTER_DRAIN = false;
    const bf16_t* PL; const float* SSQ; float* O; int ld; int ntok; float eps; int pad;
    __device__ __forceinline__ void operator()(const f32x4 (&acc)[2][2][4][2], const Unit& u, int wr, int wc, int fr, int fq) const {
#pragma unroll
        for (int ai = 0; ai < 2; ++ai)
#pragma unroll
            for (int m = 0; m < 4; ++m) { const int row = u.pm * BM + ai * HALF + wr * 64 + m * 16 + fr; const size_t ro = (size_t)row * ld;
                float tot = 0.f;
#pragma unroll
                for (int x = 0; x < 8; ++x) tot += SSQ[(size_t)x * ntok + row];
                const float rs = 1.0f / sqrtf(tot * (1.0f / 1024.0f) + eps);
#pragma unroll
                for (int bj = 0; bj < 2; ++bj)
#pragma unroll
                    for (int n = 0; n < 2; ++n) { const size_t idx = ro + u.pn * BM + bj * HALF + wc * 32 + n * 16 + fq * 4;
                        const u32x2 pw = *(const u32x2*)(PL + idx); const unsigned px = pw.x, py = pw.y;
                        f32x4 pv; pv.x = __uint_as_float(px << 16); pv.y = __uint_as_float(px & 0xffff0000u); pv.z = __uint_as_float(py << 16); pv.w = __uint_as_float(py & 0xffff0000u);
                        f32x4 g;
#pragma unroll
                        for (int e = 0; e < 4; ++e) g[e] = 1.0f / (1.0f + __expf(-rs * acc[ai][bj][m][n][e]));
                        *(f32x4*)(O + idx) = *(const f32x4*)(O + idx) + pv * g; } }
    }
};

template <class Epi, class Sched, bool ALIGN_EPI = false, bool SP2 = false>
__device__ __forceinline__ void gemm_phase(PG8_LAS unsigned char* lds, const Gemm g, const Sched& S, const Epi& E) {
    const int tid = threadIdx.x, wid = __builtin_amdgcn_readfirstlane(tid >> 6), lane = tid & 63, wr = wid >> 2, wc = wid & 3, fr = lane & 15, fq = lane >> 4;
    const int K = g.K, nt = K / BK;
    unsigned voffA[2], voffB[2];
#pragma unroll
    for (int i = 0; i < 2; ++i) { int R, C; stage_rc(tid * 16 + i * 8192, R, C); const int Rb = Epi::PERM ? ((R & ~31) + perm32(R & 31)) : R;
        voffA[i] = (unsigned)(R * K + C) * 2u; voffB[i] = (unsigned)(Rb * K + C) * 2u; }
    const size_t kstep = (size_t)(BK * 2);
    const size_t hstep = (size_t)HALF * K * 2;
    const size_t tstep = 2 * hstep;
    const unsigned ldsw = (unsigned)wid * 1024u;
    const int aoff = lds_byte(wr * 64 + fr, fq * 8), boff = lds_byte(wc * 32 + fr, fq * 8);
#define PG8_SA(b, h) (((b) * 2 + (h)) * HTB)
#define PG8_SB(b, h) ((4 + (b) * 2 + (h)) * HTB)
#define PG8_STAGE(bufoff, gbase, voff) do { _Pragma("unroll") for (int _i = 0; _i < 2; ++_i) \
        __builtin_amdgcn_global_load_lds((const unsigned*)((const char*)(gbase) + (voff)[_i]), (PG8_LAS unsigned*)(lds + (bufoff) + ldsw + _i * 8192), 16, 0, 0); } while (0)
#define PG8_LDA(dst, b, h) do { _Pragma("unroll") for (int m = 0; m < 4; ++m) _Pragma("unroll") for (int k = 0; k < 2; ++k) dst[m][k] = *(const PG8_LAS bf16x8*)(lds + PG8_SA(b, h) + aoff + m * 2048 + k * 1024); } while (0)
#define PG8_LDB(dst, b, h) do { _Pragma("unroll") for (int n = 0; n < 2; ++n) _Pragma("unroll") for (int k = 0; k < 2; ++k) dst[n][k] = *(const PG8_LAS bf16x8*)(lds + PG8_SB(b, h) + boff + n * 2048 + k * 1024); } while (0)
#define PG8_MMA(ai, bj, At, Bt) do { __builtin_amdgcn_s_setprio(1); _Pragma("unroll") for (int m = 0; m < 4; ++m) _Pragma("unroll") for (int n = 0; n < 2; ++n) _Pragma("unroll") for (int k = 0; k < 2; ++k) \
        acc[ai][bj][m][n] = __builtin_amdgcn_mfma_f32_16x16x32_bf16(Bt[n][k], At[m][k], acc[ai][bj][m][n], 0, 0, 0); __builtin_amdgcn_s_setprio(0); } while (0)
#define PG8_WAIT_V(n) asm volatile("s_waitcnt vmcnt(" #n ")" ::: "memory")
#define PG8_WAIT_L(n) asm volatile("s_waitcnt lgkmcnt(" #n ")" ::: "memory")
#define PG8_BAR __builtin_amdgcn_s_barrier()
#define PG8_SCHED __builtin_amdgcn_sched_barrier(0)
    Unit cur, nxt; int ui = 0;
    if (!S.next(0, cur)) return;
    f32x4 acc[2][2][4][2];
#pragma unroll
    for (int a = 0; a < 2; ++a)
#pragma unroll
        for (int b = 0; b < 2; ++b)
#pragma unroll
            for (int m = 0; m < 4; ++m)
#pragma unroll
                for (int n = 0; n < 2; ++n) acc[a][b][m][n] = (f32x4){0.f, 0.f, 0.f, 0.f};
    bf16x8 At[4][2], B0[2][2], B1[2][2];
    const char* cA = (const char*)g.A + (size_t)cur.pm * tstep; const char* cB = (const char*)g.Bt + (size_t)cur.pn * tstep;
    S.a_ready(cur);
    if constexpr (SP2) {
        PG8_STAGE(PG8_SB(0, 0), cB, voffB); PG8_STAGE(PG8_SB(0, 1), cB + hstep, voffB); PG8_STAGE(PG8_SA(0, 0), cA, voffA); PG8_STAGE(PG8_SA(0, 1), cA + hstep, voffA);
        if (wr == 1) PG8_BAR;
        PG8_WAIT_V(2); PG8_BAR;
        PG8_STAGE(PG8_SB(1, 0), cB + kstep, voffB); PG8_STAGE(PG8_SA(1, 0), cA + kstep, voffA); PG8_STAGE(PG8_SB(1, 1), cB + hstep + kstep, voffB);
        PG8_WAIT_V(6); PG8_BAR;
    } else {
        PG8_STAGE(PG8_SB(0, 0), cB, voffB); PG8_STAGE(PG8_SA(0, 0), cA, voffA); PG8_STAGE(PG8_SB(0, 1), cB + hstep, voffB); PG8_STAGE(PG8_SA(0, 1), cA + hstep, voffA);
        if (wr == 1) PG8_BAR;
        PG8_WAIT_V(4); PG8_BAR;
        PG8_STAGE(PG8_SB(1, 0), cB + kstep, voffB); PG8_STAGE(PG8_SA(1, 0), cA + kstep, voffA); PG8_STAGE(PG8_SB(1, 1), cB + hstep + kstep, voffB);
        PG8_WAIT_V(6); PG8_BAR;
    }
    for (;;) {
        const bool has_next = S.next(ui + 1, nxt);
        const char* nA = has_next ? (const char*)g.A + (size_t)nxt.pm * tstep : cA; const char* nB = has_next ? (const char*)g.Bt + (size_t)nxt.pn * tstep : cB;
        for (int t = 0; t < nt; t += 2) {
            const bool last = (t == nt - 2);
            const char* a1 = cA + (size_t)(t + 1) * kstep;
            const char* a2 = last ? nA : cA + (size_t)(t + 2) * kstep; const char* b2 = last ? nB : cB + (size_t)(t + 2) * kstep;
            const char* a3 = a2 + kstep; const char* b3 = b2 + kstep;
            if (last && has_next) S.a_ready(nxt);
            if constexpr (SP2) {
            PG8_LDB(B0, 0, 0); PG8_LDB(B1, 0, 1); PG8_SCHED; PG8_LDA(At, 0, 0); PG8_STAGE(PG8_SA(1, 1), a1 + hstep, voffA);
            PG8_WAIT_V(8); PG8_WAIT_L(0); PG8_BAR; PG8_MMA(0, 0, At, B0); PG8_MMA(0, 1, At, B1); PG8_BAR; PG8_SCHED;
            PG8_LDA(At, 0, 1); PG8_STAGE(PG8_SB(0, 0), b2, voffB); PG8_STAGE(PG8_SB(0, 1), b2 + hstep, voffB); PG8_STAGE(PG8_SA(0, 0), a2, voffA);
            PG8_WAIT_V(8); PG8_WAIT_L(0); PG8_BAR; PG8_MMA(1, 0, At, B0); PG8_MMA(1, 1, At, B1); PG8_BAR; PG8_SCHED;
            PG8_LDB(B0, 1, 0); PG8_LDB(B1, 1, 1); PG8_SCHED; PG8_LDA(At, 1, 0); PG8_STAGE(PG8_SA(0, 1), a2 + hstep, voffA);
            PG8_WAIT_V(8); PG8_WAIT_L(0); PG8_BAR; PG8_MMA(0, 0, At, B0); PG8_MMA(0, 1, At, B1); PG8_BAR; PG8_SCHED;
            PG8_LDA(At, 1, 1); PG8_STAGE(PG8_SB(1, 0), b3, voffB); PG8_STAGE(PG8_SB(1, 1), b3 + hstep, voffB); PG8_STAGE(PG8_SA(1, 0), a3, voffA);
            PG8_WAIT_V(8); PG8_WAIT_L(0); PG8_BAR; PG8_MMA(1, 0, At, B0); PG8_MMA(1, 1, At, B1); PG8_BAR; PG8_SCHED;
            } else {
            PG8_LDB(B0, 0, 0); PG8_SCHED; PG8_LDA(At, 0, 0); PG8_STAGE(PG8_SA(1, 1), a1 + hstep, voffA);
            PG8_WAIT_L(8); PG8_BAR; PG8_WAIT_L(0); PG8_MMA(0, 0, At, B0); PG8_BAR; PG8_SCHED;
            PG8_LDB(B1, 0, 1); PG8_STAGE(PG8_SB(0, 0), b2, voffB);
            PG8_BAR; PG8_WAIT_L(0); PG8_MMA(0, 1, At, B1); PG8_BAR;
            PG8_LDA(At, 0, 1); PG8_STAGE(PG8_SA(0, 0), a2, voffA);
            PG8_BAR; PG8_WAIT_L(0); PG8_MMA(1, 0, At, B0); PG8_BAR; PG8_SCHED;
            PG8_STAGE(PG8_SB(0, 1), b2 + hstep, voffB);
            PG8_WAIT_V(6); PG8_BAR; PG8_MMA(1, 1, At, B1); PG8_BAR;
            PG8_LDB(B0, 1, 0); PG8_SCHED; PG8_LDA(At, 1, 0); PG8_STAGE(PG8_SA(0, 1), a2 + hstep, voffA);
            PG8_WAIT_L(8); PG8_BAR; PG8_WAIT_L(0); PG8_MMA(0, 0, At, B0); PG8_BAR; PG8_SCHED;
            PG8_LDB(B1, 1, 1); PG8_STAGE(PG8_SB(1, 0), b3, voffB);
            PG8_BAR; PG8_WAIT_L(0); PG8_MMA(0, 1, At, B1); PG8_BAR;
            PG8_LDA(At, 1, 1); PG8_STAGE(PG8_SA(1, 0), a3, voffA);
            PG8_BAR; PG8_WAIT_L(0); PG8_MMA(1, 0, At, B0); PG8_BAR; PG8_SCHED;
            PG8_STAGE(PG8_SB(1, 1), b3 + hstep, voffB);
            PG8_WAIT_V(6); PG8_BAR; PG8_MMA(1, 1, At, B1); PG8_BAR;
            }
        }
        if constexpr (ALIGN_EPI) { if (wr == 0) PG8_BAR; }
        if constexpr (!Epi::AFTER_DRAIN) { E(acc, cur, wr, wc, fr, fq); S.done(cur); }
        if (!has_next) break;
#pragma unroll
        for (int a = 0; a < 2; ++a)
#pragma unroll
            for (int b = 0; b < 2; ++b)
#pragma unroll
                for (int m = 0; m < 4; ++m)
#pragma unroll
                    for (int n = 0; n < 2; ++n) acc[a][b][m][n] = (f32x4){0.f, 0.f, 0.f, 0.f};
        cur = nxt; cA = nA; cB = nB; ++ui;
        if constexpr (ALIGN_EPI) { if (wr == 1) PG8_BAR; }
    }
    PG8_WAIT_V(0);
    if constexpr (!ALIGN_EPI) { if (wr == 0) PG8_BAR; }
    PG8_BAR;
    if constexpr (Epi::AFTER_DRAIN) { E.fused(acc, cur, wr, wc, fr, fq, lds, wid, lane); S.done(cur); }
#undef PG8_SA
#undef PG8_SB
#undef PG8_STAGE
#undef PG8_LDA
#undef PG8_LDB
#undef PG8_MMA
#undef PG8_WAIT_V
#undef PG8_WAIT_L
#undef PG8_BAR
#undef PG8_SCHED
}
}

__device__ __forceinline__ void phase1(const Params& p, unsigned char* lds) {
    pg8::Gemm g{(const bf16*)(p.ws + WS_ACT), (const bf16*)(p.ws + WS_WINT), NTOK, 3584, D}; pg8::StaticOrder S; S.init(NTOK, 3584, (int)gridDim.x, (int)blockIdx.x);
    pg8::EpiStoreBf16 E{(bf16*)(p.ws + WS_PROJ), PS, DIN};
    pg8::gemm_phase<pg8::EpiStoreBf16, pg8::StaticOrder, true, true>((PG8_LAS unsigned char*)lds, g, S, E);
}


__device__ __forceinline__ void phase5(const Params& p, unsigned char* lds) {
    pg8::Gemm g{(const bf16*)(p.ws + WS_ACT), (const bf16*)(p.ws + WS_WOUTT), NTOK, D, D}; pg8::StaticOrder S; S.init(NTOK, D, (int)gridDim.x, (int)blockIdx.x);
    pg8::EpiResidF32 E{p.in[0], p.out, D, 0};
    pg8::gemm_phase<pg8::EpiResidF32, pg8::StaticOrder, true, true>((PG8_LAS unsigned char*)lds, g, S, E);
}
__device__ __forceinline__ void phase6(const Params& p, unsigned char* lds) {
    const int gw = (blockIdx.x * NTHR + threadIdx.x) >> 6, ngw = (gridDim.x * NTHR) >> 6, lane = threadIdx.x & 63;
    for (int m = gw; m < NTOK; m += ngw) rms_row_bf16(p.out + (size_t)m * D, p.in[13], (bf16*)(p.ws + WS_ACT) + (size_t)m * D, lane);
}
__device__ __forceinline__ void phase7(const Params& p, unsigned char* lds) {
    pg8::Gemm g{(const bf16*)(p.ws + WS_ACT), (const bf16*)(p.ws + WS_WQT), NTOK, 2048, D}; pg8::StaticOrder S; S.init(NTOK, 2048, (int)gridDim.x, (int)blockIdx.x);
    pg8::EpiStoreBf16 E{(bf16*)(p.ws + WS_PROJ), 2048, 2048};
    pg8::gemm_phase<pg8::EpiStoreBf16, pg8::StaticOrder, true, true>((PG8_LAS unsigned char*)lds, g, S, E);
}
__device__ __forceinline__ void phase10(const Params& p, unsigned char* lds) {
    {
        pg8::Gemm g{(const bf16*)(p.ws + WS_PB), (const bf16*)(p.ws + WS_WPT), NTOK, D, 256}; pg8::StaticOrder S; S.init(NTOK, D, (int)gridDim.x, (int)blockIdx.x);
        pg8::EpiStoreBf16 E{(bf16*)(p.ws + WS_ACT), D, D};
        pg8::gemm_phase<pg8::EpiStoreBf16, pg8::StaticOrder, true, true>((PG8_LAS unsigned char*)lds, g, S, E);
    }
    {
        pg8::Gemm g{(const bf16*)(p.ws + WS_PROJ + 64 * MiB), (const bf16*)(p.ws + WS_WGT), NTOK, D, D}; pg8::StaticOrder S; S.init(NTOK, D, (int)gridDim.x, (int)blockIdx.x);
        pg8::EpiFinalGate E{(const bf16*)(p.ws + WS_ACT), (const float*)(p.ws + WS_SSQ), p.out, D, NTOK, EPS, 0};
        pg8::gemm_phase<pg8::EpiFinalGate, pg8::StaticOrder, true, true>((PG8_LAS unsigned char*)lds, g, S, E);
    }
}

typedef __bf16 bf16x2v __attribute__((ext_vector_type(2)));
template <int CTRL> __device__ __forceinline__ float dpp_f(float v) { return __int_as_float(__builtin_amdgcn_update_dpp(0, __float_as_int(v), CTRL, 0xF, 0xF, false)); }
__device__ __forceinline__ float grp16_max(float v) { v = fmaxf(v, dpp_f<0xB1>(v)); v = fmaxf(v, dpp_f<0x4E>(v)); v = fmaxf(v, dpp_f<0x141>(v)); v = fmaxf(v, dpp_f<0x140>(v)); return v; }
__device__ __forceinline__ float grp16_sum(float v) { v += dpp_f<0xB1>(v); v += dpp_f<0x4E>(v); v += dpp_f<0x141>(v); v += dpp_f<0x140>(v); return v; }
#define CE_DESC(a, b) { const float _hi = fmaxf(a, b), _lo = fminf(a, b); a = _hi; b = _lo; }
__device__ __forceinline__ float grp16_top16(float (&v)[8], int lig) {
    CE_DESC(v[0], v[1]) CE_DESC(v[2], v[3]) CE_DESC(v[4], v[5]) CE_DESC(v[6], v[7])
    CE_DESC(v[0], v[2]) CE_DESC(v[1], v[3]) CE_DESC(v[4], v[6]) CE_DESC(v[5], v[7])
    CE_DESC(v[1], v[2]) CE_DESC(v[5], v[6])
    CE_DESC(v[0], v[4]) CE_DESC(v[1], v[5]) CE_DESC(v[2], v[6]) CE_DESC(v[3], v[7])
    CE_DESC(v[2], v[4]) CE_DESC(v[3], v[5])
    CE_DESC(v[1], v[2]) CE_DESC(v[3], v[4]) CE_DESC(v[5], v[6])
    float top = 0.f;
#pragma unroll
    for (int r = 0; r < 16; ++r) {
        const float m = grp16_max(v[0]);
        if (lig == r) top = m;
        const bool own = (v[0] == m);
#pragma unroll
        for (int j = 0; j < 7; ++j) v[j] = own ? v[j + 1] : v[j];
        v[7] = own ? -3.0e38f : v[7];
    }
    return top;
}
__device__ __forceinline__ void phase8(const Params& p, unsigned char* lds) {
    const bf16* PQ = (const bf16*)(p.ws + WS_PROJ); const bf16* KB = (const bf16*)(p.ws + WS_KEYB);
    int* ids = (int*)(p.ws + WS_IDS); float* wts = (float*)(p.ws + WS_WTS);
    float* S = (float*)lds;
    const int tid = threadIdx.x, lane = tid & 63, wid = tid >> 6, lig = tid & 15, gbase = lane & 48;
    for (int item = blockIdx.x; item < 2048; item += gridDim.x) {
        const int tok0 = (item >> 3) * 64, h = item & 7;
        {
            const int c = wid >> 2, key0 = (wid & 3) * 32, r = lane & 31, hh = lane >> 5;
            f32x16 acc0, acc1;
#pragma unroll
            for (int i = 0; i < 16; ++i) { acc0[i] = 0.f; acc1[i] = 0.f; }
            const bf16* bq = KB + ((size_t)(h * 2 + c) * 128 + key0 + r) * 128 + hh * 8;
            const bf16* aq0 = PQ + (size_t)(tok0 + r) * 2048 + h * 256 + c * 128 + hh * 8;
            const bf16* aq1 = aq0 + (size_t)32 * 2048;
#pragma unroll
            for (int s = 0; s < 8; ++s) {
                const bf16x8 b = *(const bf16x8*)(bq + s * 16), a0 = *(const bf16x8*)(aq0 + s * 16), a1 = *(const bf16x8*)(aq1 + s * 16);
                acc0 = __builtin_amdgcn_mfma_f32_32x32x16_bf16(a0, b, acc0, 0, 0, 0);
                acc1 = __builtin_amdgcn_mfma_f32_32x32x16_bf16(a1, b, acc1, 0, 0, 0);
            }
#pragma unroll
            for (int i = 0; i < 16; ++i) { const int tl = (i & 3) + 8 * (i >> 2) + 4 * hh; S[(c * 64 + tl) * 132 + key0 + r] = acc0[i]; S[(c * 64 + 32 + tl) * 132 + key0 + r] = acc1[i]; }
        }
        __syncthreads();
#pragma unroll 1
        for (int rd = 0; rd < 2; ++rd) {
            const int tl = (tid >> 4) + 32 * rd;
            float ts[2];
#pragma unroll
            for (int c = 0; c < 2; ++c) {
                float v[8];
                const f32x4 lo = *(const f32x4*)(S + (c * 64 + tl) * 132 + lig * 8), hi = *(const f32x4*)(S + (c * 64 + tl) * 132 + lig * 8 + 4);
                v[0] = lo.x; v[1] = lo.y; v[2] = lo.z; v[3] = lo.w; v[4] = hi.x; v[5] = hi.y; v[6] = hi.z; v[7] = hi.w;
#pragma unroll
                for (int j = 0; j < 8; ++j) v[j] = __uint_as_float((__float_as_uint(v[j]) & ~127u) | (unsigned)(lig * 8 + j));
                ts[c] = grp16_top16(v, lig);
            }
            const float t0 = ts[0], t1 = ts[1];
            int bp = 0; float my_s = 0.f; int my_eid = 0;
#pragma unroll 1
            for (int r = 0; r < 16; ++r) {
                const float other = __shfl(t1, gbase + (bp < 15 ? bp : 15));
                const float sum = t0 + other;
                const float head = (bp >= 16) ? -3.0e38f : __uint_as_float((__float_as_uint(sum) & ~15u) | (unsigned)lig);
                const int cur_eid = (int)(((__float_as_uint(t0) & 127u) << 7) | (__float_as_uint(other) & 127u));
                const float m = grp16_max(head);
                const int owner = (int)(__float_as_uint(m) & 15u);
                const int ew = __shfl(cur_eid, gbase + owner);
                if (lig == r) { my_s = m; my_eid = ew; }
                if (lig == owner) ++bp;
            }
            const float mx = grp16_max(my_s);
            const float e = __expf(my_s - mx);
            const float sm = grp16_sum(e);
            const size_t o = (size_t)(tok0 + tl) * 128 + h * 16 + lig;
            ((unsigned short*)ids)[(size_t)(tok0 + tl) * 128 + (h >> 2) * 64 + (lig & 7) * 8 + (h & 3) * 2 + (lig >> 3)] = (unsigned short)my_eid; wts[o] = e / sm;
        }
        __syncthreads();
    }
}

__device__ __forceinline__ void hgrn_pre_item(const Params& p, unsigned char* lds, int ci) {
    const int tid = threadIdx.x, lane = tid & 63, wid = tid >> 6, k = tid & 127, tq = tid >> 7;
    const int n = ci & 127, h = (ci >> 7) & 3, b = ci >> 9, tok0 = b * T + n * 64;
    bf16* proj = (bf16*)(p.ws + WS_PROJ);
    float* OB = p.out; bf16* KIT = (bf16*)((unsigned char*)p.out + OUT_KIT) + (size_t)ci * 8192; bf16* VTg = (bf16*)((unsigned char*)p.out + OUT_VT) + (size_t)ci * 8192;
    float* DEC = (float*)(p.ws + WS_DEC) + (size_t)ci * 128;
    bf16* QT = (bf16*)lds; bf16* KT = (bf16*)(lds + 17408); bf16* VTl = (bf16*)(lds + 34816); bf16* AM = (bf16*)(lds + 53248);
    float* part = (float*)(lds + 62464); float* gref = (float*)(lds + 64512);
    float lb; { const float l0 = p.in[4][h * 128 + k], l1 = p.in[4][512 + h * 128 + k]; const float m = fmaxf(l0, l1); const float e0 = __expf(l0 - m), e1 = __expf(l1 - m); lb = e0 / (e0 + e1); }
    float G[16], key[16], qv[16], vv[16];
    {
        float c = 0.f;
#pragma unroll
        for (int i = 0; i < 16; ++i) {
            const size_t row = (size_t)(tok0 + tq * 16 + i) * PS;
            const float fg = lb + (1.0f - lb) * sigmoidf_(bf2f(proj[row + C_HF + h * 128 + k]));
            key[i] = 1.0f - fg; c += __logf(fg); G[i] = c;
            qv[i] = siluf_(bf2f(proj[row + C_HQ + h * 128 + k])) * 0.08838834764831845f;
            vv[i] = bf2f(proj[row + C_HI + h * 128 + k]);
        }
        part[tq * 128 + k] = c;
    }
    __syncthreads();
    {
        float off = 0.f;
#pragma unroll
        for (int j = 0; j < 3; ++j) off += (j < tq) ? part[j * 128 + k] : 0.f;
#pragma unroll
        for (int i = 0; i < 16; ++i) G[i] += off;
        if (tq == 1) gref[k] = G[15];
        if (tq == 3) gref[128 + k] = G[15];
    }
    __syncthreads();
    {
        const float gr = gref[k], gl = gref[128 + k];
        const int kpos = (k & ~31) | (((k >> 2) & 3) << 3) | (((k >> 4) & 1) << 2) | (k & 3);
        unsigned kp[8], vp[8];
#pragma unroll
        for (int i = 0; i < 16; i += 2) {
            kp[i >> 1] = pk2(key[i] * __expf(gl - G[i]), key[i + 1] * __expf(gl - G[i + 1]));
            vp[i >> 1] = pk2(vv[i], vv[i + 1]);
        }
#pragma unroll
        for (int i = 0; i < 16; ++i) {
            const int t = tq * 16 + i;
            QT[t * 136 + k] = f2bf(qv[i] * __expf(G[i] - gr));
            KT[t * 136 + k] = f2bf(key[i] * __expf(gr - G[i]));
            proj[(size_t)(tok0 + t) * PS + C_HQ + h * 128 + kpos] = f2bf(qv[i] * __expf(G[i]));
        }
        u32x4 a0, a1, b0, b1; a0.x = kp[0]; a0.y = kp[1]; a0.z = kp[2]; a0.w = kp[3]; a1.x = kp[4]; a1.y = kp[5]; a1.z = kp[6]; a1.w = kp[7];
        b0.x = vp[0]; b0.y = vp[1]; b0.z = vp[2]; b0.w = vp[3]; b1.x = vp[4]; b1.y = vp[5]; b1.z = vp[6]; b1.w = vp[7];
        *(u32x4*)(KIT + k * 64 + tq * 16) = a0; *(u32x4*)(KIT + k * 64 + tq * 16 + 8) = a1;
        *(u32x4*)(VTg + k * 64 + tq * 16) = b0; *(u32x4*)(VTg + k * 64 + tq * 16 + 8) = b1;
        *(u32x4*)(VTl + k * 72 + tq * 16) = b0; *(u32x4*)(VTl + k * 72 + tq * 16 + 8) = b1;
        if (tq == 3) DEC[k] = __expf(gl);
    }
    __syncthreads();
    const int fr = lane & 15, fq = lane >> 4;
    {
        const int tt = wid >> 1;
#pragma unroll
        for (int e = 0; e < 2; ++e) {
            const int st = 2 * (wid & 1) + e;
            f32x4 acc = (f32x4){0.f, 0.f, 0.f, 0.f};
            if (st <= tt) {
#pragma unroll
                for (int s = 0; s < 4; ++s) {
                    const bf16x8 a = *(const bf16x8*)(QT + (tt * 16 + fr) * 136 + s * 32 + fq * 8), bb = *(const bf16x8*)(KT + (st * 16 + fr) * 136 + s * 32 + fq * 8);
                    acc = __builtin_amdgcn_mfma_f32_16x16x32_bf16(a, bb, acc, 0, 0, 0);
                }
            }
#pragma unroll
            for (int r = 0; r < 4; ++r) { const int t = tt * 16 + fq * 4 + r, sp = st * 16 + fr; AM[t * 72 + sp] = f2bf(sp <= t ? acc[r] : 0.f); }
        }
    }
    __syncthreads();
    {
        const int tt = wid >> 1;
        const bf16x8 a0 = *(const bf16x8*)(AM + (tt * 16 + fr) * 72 + fq * 8), a1 = *(const bf16x8*)(AM + (tt * 16 + fr) * 72 + 32 + fq * 8);
#pragma unroll
        for (int e = 0; e < 4; ++e) {
            const int vt = (wid & 1) * 4 + e;
            const bf16x8 b0 = *(const bf16x8*)(VTl + (vt * 16 + fr) * 72 + fq * 8), b1 = *(const bf16x8*)(VTl + (vt * 16 + fr) * 72 + 32 + fq * 8);
            f32x4 acc = (f32x4){0.f, 0.f, 0.f, 0.f};
            acc = __builtin_amdgcn_mfma_f32_16x16x32_bf16(a0, b0, acc, 0, 0, 0);
            acc = __builtin_amdgcn_mfma_f32_16x16x32_bf16(a1, b1, acc, 0, 0, 0);
#pragma unroll
            for (int r = 0; r < 4; ++r) OB[(size_t)(tok0 + tt * 16 + fq * 4 + r) * 512 + h * 128 + vt * 16 + fr] = acc[r];
        }
    }
    __syncthreads();
}
template <bool DUMMY>
__device__ __forceinline__ void hgrn_scan_item(const Params& p, int wi) {
    const int lane = threadIdx.x & 63, fr = lane & 15, fq = lane >> 4;
    const int vs = wi & 7, bh = wi >> 3, h = bh & 3, b = bh >> 2;
    const bf16* proj = (const bf16*)(p.ws + WS_PROJ);
    float* OB = p.out; const bf16* KIT = (const bf16*)((unsigned char*)p.out + OUT_KIT); const bf16* VTg = (const bf16*)((unsigned char*)p.out + OUT_VT);
    const float* DEC = (const float*)(p.ws + WS_DEC);
    f32x4 S[8];
#pragma unroll
    for (int i = 0; i < 8; ++i) S[i] = (f32x4){0.f, 0.f, 0.f, 0.f};
#pragma unroll 1
    for (int n = 0; n < 128; ++n) {
        const int ci = bh * 128 + n, tok0 = b * T + n * 64;
        bf16x8 qf[4][4];
#pragma unroll
        for (int tt = 0; tt < 4; ++tt)
#pragma unroll
            for (int s = 0; s < 4; ++s) qf[tt][s] = *(const bf16x8*)(proj + (size_t)(tok0 + tt * 16 + fr) * PS + C_HQ + h * 128 + s * 32 + fq * 8);
        float oin[4][4];
#pragma unroll
        for (int tt = 0; tt < 4; ++tt)
#pragma unroll
            for (int r = 0; r < 4; ++r) oin[tt][r] = OB[(size_t)(tok0 + tt * 16 + fq * 4 + r) * 512 + h * 128 + vs * 16 + fr];
        bf16x8 Sb[4];
#pragma unroll
        for (int s = 0; s < 4; ++s) {
            u32x4 w; w.x = pk2(S[2 * s][0], S[2 * s][1]); w.y = pk2(S[2 * s][2], S[2 * s][3]); w.z = pk2(S[2 * s + 1][0], S[2 * s + 1][1]); w.w = pk2(S[2 * s + 1][2], S[2 * s + 1][3]);
            Sb[s] = __builtin_bit_cast(bf16x8, w);
        }
#pragma unroll
        for (int tt = 0; tt < 4; ++tt) {
            f32x4 acc = (f32x4){0.f, 0.f, 0.f, 0.f};
#pragma unroll
            for (int s = 0; s < 4; ++s) acc = __builtin_amdgcn_mfma_f32_16x16x32_bf16(qf[tt][s], Sb[s], acc, 0, 0, 0);
#pragma unroll
            for (int r = 0; r < 4; ++r) { const size_t oi = (size_t)(tok0 + tt * 16 + fq * 4 + r) * 512 + h * 128 + vs * 16 + fr; if (DUMMY) ((float*)(p.ws + WS_SPARE))[oi & 0x3fffff] = oin[tt][r] + acc[r]; else OB[oi] = oin[tt][r] + acc[r]; }
        }
        const bf16x8 v0 = *(const bf16x8*)(VTg + (size_t)ci * 8192 + (vs * 16 + fr) * 64 + fq * 8), v1 = *(const bf16x8*)(VTg + (size_t)ci * 8192 + (vs * 16 + fr) * 64 + 32 + fq * 8);
#pragma unroll
        for (int kb = 0; kb < 8; ++kb) {
            const bf16x8 k0 = *(const bf16x8*)(KIT + (size_t)ci * 8192 + (kb * 16 + fr) * 64 + fq * 8), k1 = *(const bf16x8*)(KIT + (size_t)ci * 8192 + (kb * 16 + fr) * 64 + 32 + fq * 8);
            const f32x4 dv = *(const f32x4*)(DEC + (size_t)ci * 128 + kb * 16 + fq * 4);
            f32x4 sacc = S[kb] * dv;
            sacc = __builtin_amdgcn_mfma_f32_16x16x32_bf16(k0, v0, sacc, 0, 0, 0);
            sacc = __builtin_amdgcn_mfma_f32_16x16x32_bf16(k1, v1, sacc, 0, 0, 0);
            S[kb] = sacc;
        }
    }
}

__device__ __forceinline__ void hgrn_scan_block(const Params& p, unsigned char* lds, int sb) {
    const int tid = threadIdx.x, lane = tid & 63, wid = __builtin_amdgcn_readfirstlane(tid >> 6), fr = lane & 15, fq = lane >> 4;
    const int bh = sb >> 2, vs = (sb & 3) * 2 + (wid & 1); const bool worker = wid < 2;
    const int h = bh & 3, b = bh >> 2;
    const bf16* proj = (const bf16*)(p.ws + WS_PROJ);
    float* OB = p.out; const bf16* KIT = (const bf16*)((unsigned char*)p.out + OUT_KIT); const bf16* VTg = (const bf16*)((unsigned char*)p.out + OUT_VT);
    const float* DEC = (const float*)(p.ws + WS_DEC);
    constexpr int BUF = 54784, O_KIT = 17408, O_VT = 17408 + 18432, O_DEC = 17408 + 2 * 18432;
    u32x4 rqA[2], rkA[2], rvA[2], rdA, rqB[2], rkB[2], rvB[2], rdB;
    float oin[4][4];
#define SC_ISSUE(rq, rk, rv, rd, n_) { const int ci_ = bh * 128 + (n_), tk_ = b * T + (n_) * 64; \
        _Pragma("unroll") for (int i = 0; i < 2; ++i) { const int id = tid + i * NTHR; \
            rq[i] = *(const u32x4*)(proj + (size_t)(tk_ + (id >> 4)) * PS + C_HQ + h * 128 + (id & 15) * 8); \
            rk[i] = *(const u32x4*)(KIT + (size_t)ci_ * 8192 + id * 8); rv[i] = *(const u32x4*)(VTg + (size_t)ci_ * 8192 + id * 8); } \
        if (tid < 32) rd = *(const u32x4*)(DEC + (size_t)ci_ * 128 + tid * 4); }
#define SC_STASH(rq, rk, rv, rd, buf) { _Pragma("unroll") for (int i = 0; i < 2; ++i) { const int id = tid + i * NTHR; \
            *(u32x4*)((buf) + (id >> 4) * 272 + (id & 15) * 16) = rq[i]; *(u32x4*)((buf) + O_KIT + (id >> 3) * 144 + (id & 7) * 16) = rk[i]; \
            *(u32x4*)((buf) + O_VT + (id >> 3) * 144 + (id & 7) * 16) = rv[i]; } \
        if (tid < 32) *(u32x4*)((buf) + O_DEC + tid * 16) = rd; }
    auto load_oin = [&](int n) {
        const int tok0 = b * T + n * 64;
#pragma unroll
        for (int tt = 0; tt < 4; ++tt)
#pragma unroll
            for (int r = 0; r < 4; ++r) oin[tt][r] = OB[(size_t)(tok0 + tt * 16 + fq * 4 + r) * 512 + h * 128 + vs * 16 + fr];
    };
    f32x4 S[8];
#pragma unroll
    for (int i = 0; i < 8; ++i) S[i] = (f32x4){0.f, 0.f, 0.f, 0.f};
    SC_ISSUE(rqA, rkA, rvA, rdA, 0)
    SC_ISSUE(rqB, rkB, rvB, rdB, 1)
    SC_STASH(rqA, rkA, rvA, rdA, lds)
    if (worker) load_oin(0);
    __syncthreads();
    auto compute = [&](int n, unsigned char* cur) {
        const int tok0 = b * T + n * 64;
        const int nn = (n + 1 < 128) ? n + 1 : n;
        bf16x8 Sb[4];
#pragma unroll
        for (int s = 0; s < 4; ++s) {
            u32x4 w; w.x = pk2(S[2 * s][0], S[2 * s][1]); w.y = pk2(S[2 * s][2], S[2 * s][3]); w.z = pk2(S[2 * s + 1][0], S[2 * s + 1][1]); w.w = pk2(S[2 * s + 1][2], S[2 * s + 1][3]);
            Sb[s] = __builtin_bit_cast(bf16x8, w);
        }
        float ores[4][4];
#pragma unroll
        for (int tt = 0; tt < 4; ++tt) {
            f32x4 acc = (f32x4){0.f, 0.f, 0.f, 0.f};
#pragma unroll
            for (int s = 0; s < 4; ++s) { const bf16x8 qf = *(const bf16x8*)(cur + (tt * 16 + fr) * 272 + (s * 32 + fq * 8) * 2); acc = __builtin_amdgcn_mfma_f32_16x16x32_bf16(qf, Sb[s], acc, 0, 0, 0); }
#pragma unroll
            for (int r = 0; r < 4; ++r) ores[tt][r] = oin[tt][r] + acc[r];
        }
#pragma unroll
        for (int tt = 0; tt < 4; ++tt)
#pragma unroll
            for (int r = 0; r < 4; ++r) OB[(size_t)(tok0 + tt * 16 + fq * 4 + r) * 512 + h * 128 + vs * 16 + fr] = ores[tt][r];
        load_oin(nn);
        const bf16x8 v0 = *(const bf16x8*)(cur + O_VT + (vs * 16 + fr) * 144 + fq * 16), v1 = *(const bf16x8*)(cur + O_VT + (vs * 16 + fr) * 144 + 64 + fq * 16);
#pragma unroll
        for (int kb = 0; kb < 8; ++kb) {
            const bf16x8 k0 = *(const bf16x8*)(cur + O_KIT + (kb * 16 + fr) * 144 + fq * 16), k1 = *(const bf16x8*)(cur + O_KIT + (kb * 16 + fr) * 144 + 64 + fq * 16);
            const f32x4 dv = *(const f32x4*)(cur + O_DEC + (kb * 16 + fq * 4) * 4);
            f32x4 sacc = S[kb] * dv;
            sacc = __builtin_amdgcn_mfma_f32_16x16x32_bf16(k0, v0, sacc, 0, 0, 0);
            sacc = __builtin_amdgcn_mfma_f32_16x16x32_bf16(k1, v1, sacc, 0, 0, 0);
            S[kb] = sacc;
        }
    };
#pragma unroll 1
    for (int n = 0; n < 128; n += 2) {
        { const int n2 = (n + 2 < 128) ? n + 2 : n; SC_ISSUE(rqA, rkA, rvA, rdA, n2) }
        if (worker) compute(n, lds);
        SC_STASH(rqB, rkB, rvB, rdB, lds + BUF)
        __syncthreads();
        { const int n3 = (n + 3 < 128) ? n + 3 : n + 1; SC_ISSUE(rqB, rkB, rvB, rdB, n3) }
        if (worker) compute(n + 1, lds + BUF);
        SC_STASH(rqA, rkA, rvA, rdA, lds)
        __syncthreads();
    }
#undef SC_ISSUE
#undef SC_STASH
}
__device__ __forceinline__ void phase4(const Params& p, unsigned char* lds) {
    const bf16* proj = (const bf16*)(p.ws + WS_PROJ); const float* OB = p.out; bf16* mixed = (bf16*)(p.ws + WS_ACT); const float* gain = p.in[5];
    const int lane = threadIdx.x & 63, gw = (blockIdx.x * NTHR + threadIdx.x) >> 6, ngw = (gridDim.x * NTHR) >> 6;
    for (int tok = gw; tok < NTOK; tok += ngw) {
        const f32x4 o0 = *(const f32x4*)(OB + (size_t)tok * 512 + lane * 8), o1 = *(const f32x4*)(OB + (size_t)tok * 512 + lane * 8 + 4);
        const u32x4 gp = *(const u32x4*)(proj + (size_t)tok * PS + C_HG + lane * 8);
        const f32x4 g0 = *(const f32x4*)(gain + lane * 8), g1 = *(const f32x4*)(gain + lane * 8 + 4);
        float ss = o0.x * o0.x + o0.y * o0.y + o0.z * o0.z + o0.w * o0.w + o1.x * o1.x + o1.y * o1.y + o1.z * o1.z + o1.w * o1.w;
        ss = grp16_sum(ss);
        const float r = rsqrtf(ss * (1.0f / 128.0f) + EPS);
        const unsigned gx = gp.x, gy = gp.y, gz = gp.z, gw_ = gp.w;
        u32x4 w;
        w.x = pk2(o0.x * r * g0.x * siluf_(__uint_as_float(gx << 16)), o0.y * r * g0.y * siluf_(__uint_as_float(gx & 0xffff0000u)));
        w.y = pk2(o0.z * r * g0.z * siluf_(__uint_as_float(gy << 16)), o0.w * r * g0.w * siluf_(__uint_as_float(gy & 0xffff0000u)));
        w.z = pk2(o1.x * r * g1.x * siluf_(__uint_as_float(gz << 16)), o1.y * r * g1.y * siluf_(__uint_as_float(gz & 0xffff0000u)));
        w.w = pk2(o1.z * r * g1.z * siluf_(__uint_as_float(gw_ << 16)), o1.w * r * g1.w * siluf_(__uint_as_float(gw_ & 0xffff0000u)));
        *(u32x4*)(mixed + (size_t)tok * D + lane * 8) = w;
    }
}

#define WAVE_LDS_SYNC() asm volatile("s_waitcnt lgkmcnt(0)" ::: "memory")
__device__ __forceinline__ void nsa_prep_item(const Params& p, unsigned char* lds, int tile) {
    const int tid = threadIdx.x, lig = tid & 15;
    const int tok0 = tile * 64;
    bf16* proj = (bf16*)(p.ws + WS_PROJ);
    for (int rho = tid >> 4; rho < 768; rho += 32) {
        const int tl = rho / 12, which = rho - tl * 12;
        int col; const float* gain; float sc = 1.0f;
        if (which < 8) { col = C_NQ + which * 64; gain = p.in[6]; sc = 0.125f * 1.4426950408889634f; }
        else if (which < 10) { col = C_KS + (which - 8) * 64; gain = p.in[7] + 64; }
        else { col = C_KW + (which - 10) * 64; gain = p.in[7] + 128; }
        bf16* rp = proj + (size_t)(tok0 + tl) * PS + col + lig * 4;
        const u32x2 raw = *(const u32x2*)rp;
        const unsigned r0 = raw.x, r1 = raw.y;
        const float a = __uint_as_float(r0 << 16), b = __uint_as_float(r0 & 0xffff0000u), c = __uint_as_float(r1 << 16), d = __uint_as_float(r1 & 0xffff0000u);
        const float ss = grp16_sum(a * a + b * b + c * c + d * d);
        const float r = rsqrtf(ss * (1.0f / 64.0f) + EPS) * sc;
        const f32x4 gg = *(const f32x4*)(gain + lig * 4);
        u32x2 o; o.x = pk2(a * r * gg.x, b * r * gg.y); o.y = pk2(c * r * gg.z, d * r * gg.w);
        if (which < 8) *(u32x2*)rp = o;
        else {
            const int g = (which - 8) & 1, tok = tok0 + tl, b = tok / T, t = tok % T;
            unsigned char* kb = p.ws + (which < 10 ? WS_KFS : WS_KFW) + ((size_t)(b * 2 + g) * 256 + (t >> 5)) * 4096;
            *(u32x2*)(kb + (lig >> 2) * 1024 + ((t & 31) + 32 * ((lig >> 1) & 1)) * 16 + (lig & 1) * 8) = o;
        }
    }
    {
        const int c = tid & 127, tq = tid >> 7, g = c >> 6, d = c & 63, b = tok0 / T, t0 = tok0 % T;
#pragma unroll
        for (int which = 0; which < 2; ++which) {
            const int col = (which == 0 ? C_VS : C_VW) + c;
            unsigned short e[16];
#pragma unroll
            for (int i = 0; i < 16; ++i) e[i] = proj[(size_t)(tok0 + tq * 16 + i) * PS + col];
            unsigned char* vb = p.ws + (which == 0 ? WS_VTS : WS_VTW) + ((size_t)(b * 2 + g) * 256 + ((t0 + tq * 16) >> 5)) * 4096 + ((d >> 5) * 2 + (tq & 1)) * 1024 + (d & 31) * 16;
            u32x4 h0, h1;
            h0.x = e[0] | ((unsigned)e[1] << 16); h0.y = e[2] | ((unsigned)e[3] << 16); h0.z = e[8] | ((unsigned)e[9] << 16); h0.w = e[10] | ((unsigned)e[11] << 16);
            h1.x = e[4] | ((unsigned)e[5] << 16); h1.y = e[6] | ((unsigned)e[7] << 16); h1.z = e[12] | ((unsigned)e[13] << 16); h1.w = e[14] | ((unsigned)e[15] << 16);
            *(u32x4*)vb = h0; *(u32x4*)(vb + 512) = h1;
        }
    }
}
__device__ __forceinline__ void nsa_cmp_item(const Params& p, unsigned char* lds, int item) {
    const int tid = threadIdx.x, lane = tid & 63, wid = tid >> 6, fr = lane & 15, fq = lane >> 4;
    const int nt32 = item & 15, g = (item >> 4) & 1, b = (item >> 5) & 1, which = item >> 6, n0 = nt32 * 32;
    const bf16* proj = (const bf16*)(p.ws + WS_PROJ);
    const float* pe = p.in[8] + which * 2048;
    const bf16* W1T = (const bf16*)(p.ws + WS_W1T) + (size_t)which * 64 * 2048;
    const float* w2 = p.in[10] + which * 4096;
    bf16* A = (bf16*)lds; float* H = (float*)(lds + 33280);
    const int col0 = (which == 0 ? C_KC : C_VC) + g * 64;
    const int nt = wid & 1, ct = wid >> 1;
    f32x4 acc = (f32x4){0.f, 0.f, 0.f, 0.f};
#pragma unroll 1
    for (int kc = 0; kc < 4; ++kc) {
#pragma unroll
        for (int i = 0; i < 4; ++i) {
            const int idx = tid + i * NTHR, dch = idx & 7, jj = (idx >> 3) & 7, n = idx >> 6, j = kc * 8 + jj;
            u32x4 o = (u32x4){0u, 0u, 0u, 0u};
            if (n0 + n < NCMP) {
                const u32x4 raw = *(const u32x4*)(proj + (size_t)(b * T + 16 * (n0 + n) + j) * PS + col0 + dch * 8);
                const f32x4 p0 = *(const f32x4*)(pe + j * 64 + dch * 8), p1 = *(const f32x4*)(pe + j * 64 + dch * 8 + 4);
                const unsigned r0 = raw.x, r1 = raw.y, r2 = raw.z, r3 = raw.w;
                o.x = pk2(__uint_as_float(r0 << 16) + p0.x, __uint_as_float(r0 & 0xffff0000u) + p0.y);
                o.y = pk2(__uint_as_float(r1 << 16) + p0.z, __uint_as_float(r1 & 0xffff0000u) + p0.w);
                o.z = pk2(__uint_as_float(r2 << 16) + p1.x, __uint_as_float(r2 & 0xffff0000u) + p1.y);
                o.w = pk2(__uint_as_float(r3 << 16) + p1.z, __uint_as_float(r3 & 0xffff0000u) + p1.w);
            }
            *(u32x4*)(A + n * 520 + jj * 64 + dch * 8) = o;
        }
        __syncthreads();
#pragma unroll 4
        for (int s = 0; s < 16; ++s) {
            const bf16x8 a = *(const bf16x8*)(A + (nt * 16 + fr) * 520 + s * 32 + fq * 8);
            const bf16x8 bb = *(const bf16x8*)(W1T + (size_t)(ct * 16 + fr) * 2048 + kc * 512 + s * 32 + fq * 8);
            acc = __builtin_amdgcn_mfma_f32_16x16x32_bf16(a, bb, acc, 0, 0, 0);
        }
        __syncthreads();
    }
#pragma unroll
    for (int r = 0; r < 4; ++r) H[(nt * 16 + fq * 4 + r) * 64 + ct * 16 + fr] = gelu_tanh(acc[r]);
    __syncthreads();
    {
        const int n = tid >> 4, c = (tid & 15) * 4;
        f32x4 o = (f32x4){0.f, 0.f, 0.f, 0.f};
#pragma unroll 8
        for (int i = 0; i < 64; ++i) { const float hv = H[n * 64 + i]; const f32x4 w = *(const f32x4*)(w2 + i * 64 + c); o += hv * w; }
        if (which == 0) {
            const float ss = grp16_sum(o.x * o.x + o.y * o.y + o.z * o.z + o.w * o.w);
            const float r = rsqrtf(ss * (1.0f / 64.0f) + EPS);
            const f32x4 gg = *(const f32x4*)(p.in[7] + c);
            o = o * r * gg;
        }
        if (n0 + n >= NCMP) o = (f32x4){0.f, 0.f, 0.f, 0.f};
        const int nn = n0 + n;
        if (which == 0) { u32x2 w; w.x = pk2(o.x, o.y); w.y = pk2(o.z, o.w);
            *(u32x2*)(p.ws + WS_KC + ((size_t)(b * 2 + g) * 16 + (nn >> 5)) * 4096 + (c >> 4) * 1024 + ((nn & 31) + 32 * ((c >> 3) & 1)) * 16 + (c & 7) * 2) = w; }
        else {
            const int kl = nn & 31, sst = kl >> 4, r = kl & 15, j = ((r >> 3) << 2) | (r & 3), hh = (r >> 2) & 1;
            bf16* vt = (bf16*)(p.ws + WS_VCT + ((size_t)(b * 2 + g) * 16 + (nn >> 5)) * 4096 + sst * 1024 + hh * 512 + j * 2);
            const float ov[4] = {o.x, o.y, o.z, o.w};
#pragma unroll
            for (int e = 0; e < 4; ++e) { const int dd = c + e; vt[((dd >> 5) * 2048 + (dd & 31) * 16) / 2] = f2bf(ov[e]); }
        }
    }
    __syncthreads();
}

constexpr float LOG2E = 1.4426950408889634f;
__device__ __forceinline__ int rho16(int reg, int hh) { return (reg & 3) + 8 * (reg >> 2) + 4 * hh; }
__device__ __forceinline__ bf16x8 pack8(const float* pv) {
    u32x4 w; w.x = pk2(pv[0], pv[1]); w.y = pk2(pv[2], pv[3]); w.z = pk2(pv[4], pv[5]); w.w = pk2(pv[6], pv[7]);
    return __builtin_bit_cast(bf16x8, w);
}
struct KF { bf16x8 f[4]; };
struct VF { bf16x8 f[4]; };
__device__ __forceinline__ void load_k(KF& k, const unsigned char* tp) {
#pragma unroll
    for (int s = 0; s < 4; ++s) k.f[s] = *(const bf16x8*)(tp + s * 1024);
}
__device__ __forceinline__ void load_v(VF& v, const unsigned char* tp) {
#pragma unroll
    for (int q = 0; q < 4; ++q) v.f[q] = *(const bf16x8*)(tp + q * 1024);
}
__device__ __forceinline__ f32x16 score_tile(const KF& k, const bf16x8 (&qf)[4], float slope, float base) {
    f32x16 st;
#pragma unroll
    for (int i = 0; i < 16; ++i) st[i] = fmaf(slope, (float)((i & 3) + 8 * (i >> 2)), base);
#pragma unroll
    for (int s = 0; s < 4; ++s) st = __builtin_amdgcn_mfma_f32_32x32x16_bf16(k.f[s], qf[s], st, 0, 0, 0);
    return st;
}
__device__ __forceinline__ void pv_tile(f32x16& o0, f32x16& o1, const VF& v, const float* pv) {
    const bf16x8 p0 = pack8(pv), p1 = pack8(pv + 8);
    o0 = __builtin_amdgcn_mfma_f32_32x32x16_bf16(v.f[0], p0, o0, 0, 0, 0); o0 = __builtin_amdgcn_mfma_f32_32x32x16_bf16(v.f[1], p1, o0, 0, 0, 0);
    o1 = __builtin_amdgcn_mfma_f32_32x32x16_bf16(v.f[2], p0, o1, 0, 0, 0); o1 = __builtin_amdgcn_mfma_f32_32x32x16_bf16(v.f[3], p1, o1, 0, 0, 0);
}
template <bool FAST>
__device__ __forceinline__ void attn_tile(const KF& kc, const VF& vf, const bf16x8 (&qf)[4], float slope, float base, int distbase, bool colsel, int wlimit,
                                          float& l, f32x16& o0, f32x16& o1) {
    const f32x16 st = score_tile(kc, qf, slope, base);
    float sv[16]; float ps = 0.f;
#pragma unroll
    for (int i = 0; i < 16; ++i) {
        float e = __builtin_amdgcn_exp2f(st[i]);
        if (!FAST) { const int dist = distbase - ((i & 3) + 8 * (i >> 2)); e = (colsel && dist >= 0 && dist < wlimit) ? e : 0.f; }
        sv[i] = e; ps += e;
    }
    l += ps;
    pv_tile(o0, o1, vf, sv);
}
__device__ __forceinline__ void nsa_attn_item(const Params& p, unsigned char* wlds, int item) {
    const int lane = threadIdx.x & 63, c = lane & 31, hh = lane >> 5, jt = c >> 2, r4 = c & 3;
    const int oct = item & 1023, g = (item >> 10) & 1, b = item >> 11;
    const int t0 = oct * 8, tc = t0 + jt, h = g * 4 + r4;
    const float slope = exp2f(-(float)(h + 1)) * LOG2E;
    const bf16* proj = (const bf16*)(p.ws + WS_PROJ);
    float* impA = (float*)wlds; float* impB = impA + 1024; unsigned* msk = (unsigned*)(impB + 1024);
    unsigned char* blist = (unsigned char*)(msk + 32);
    float* ocl = (float*)(wlds + 8448) + lane;
#pragma unroll
    for (int i = 0; i < 16; ++i) { impA[lane + 64 * i] = 0.f; impB[lane + 64 * i] = 0.f; }
    if (lane < 32) msk[lane] = 0u;
    bf16x8 qf[4];
    { const bf16* qp = proj + (size_t)(b * T + tc) * PS + C_NQ + h * 64 + hh * 8;
#pragma unroll
      for (int s = 0; s < 4; ++s) qf[s] = *(const bf16x8*)(qp + s * 16); }
    const bf16* gatep = proj + (size_t)(b * T + tc) * PS + C_GT + h * 3;
#define NSA_GATE(i) sigmoidf_(bf2f(gatep[i]))
    float bnd[3];
    { const float gq = wave_max(fabsf(p.in[6][lane]));
#pragma unroll
      for (int i = 0; i < 3; ++i) bnd[i] = __uint_as_float((unsigned)__builtin_amdgcn_readfirstlane((int)__float_as_uint(8.0f * LOG2E * 1.02f * gq * wave_max(fabsf(p.in[7][i * 64 + lane]))))); }
    WAVE_LDS_SYNC();
    {
        const unsigned char* KC = p.ws + WS_KC + (size_t)(b * 2 + g) * 65536 + lane * 16;
        const unsigned char* VCT = p.ws + WS_VCT + (size_t)(b * 2 + g) * 65536 + lane * 16;
        const int nmax = (t0 + 7 >= 31) ? ((t0 + 7 - 31) >> 4) : -1;
        const int nlast = (nmax >= 0) ? (nmax & ~31) : -32;
        float l = 0.f;
        f32x16 o0, o1;
#pragma unroll
        for (int i = 0; i < 16; ++i) { o0[i] = 0.f; o1[i] = 0.f; }
        KF kn;
        if (nlast >= 0) load_k(kn, KC + (size_t)nlast * 128);
#pragma unroll 1
        for (int n0 = nlast; n0 >= 0; n0 -= 32) {
            const KF kc = kn;
            load_k(kn, KC + (size_t)(n0 >= 32 ? n0 - 32 : n0) * 128);
            const int distbase = tc - 16 * (n0 + 4 * hh) - 31;
            const f32x16 st = score_tile(kc, qf, 16.0f * slope, -slope * (float)distbase - bnd[0]);
            float ps = 0.f;
#pragma unroll
            for (int i = 0; i < 16; ++i) { const int dist = distbase - 16 * ((i & 3) + 8 * (i >> 2)); ps += (dist >= 0) ? __builtin_amdgcn_exp2f(st[i]) : 0.f; }
            l += ps;
        }
        l += __shfl_xor(l, 32);
        const float inv = (l > 0.f) ? 1.0f / l : 0.f;
        if (nlast >= 0) load_k(kn, KC + (size_t)nlast * 128);
#pragma unroll 1
        for (int n0 = nlast; n0 >= 0; n0 -= 32) {
            const KF kc = kn; VF vf;
            load_v(vf, VCT + (size_t)n0 * 128);
            load_k(kn, KC + (size_t)(n0 >= 32 ? n0 - 32 : n0) * 128);
            const int distbase = tc - 16 * (n0 + 4 * hh) - 31;
            const f32x16 st = score_tile(kc, qf, 16.0f * slope, -slope * (float)distbase - bnd[0]);
            float pv[16];
#pragma unroll
            for (int i = 0; i < 16; ++i) { const int dist = distbase - 16 * ((i & 3) + 8 * (i >> 2)); pv[i] = (dist >= 0) ? __builtin_amdgcn_exp2f(st[i]) * inv : 0.f; }
            pv_tile(o0, o1, vf, pv);
#pragma unroll
            for (int i = 0; i < 16; ++i) { float v = pv[i]; v += dpp_f<0xB1>(v); v += dpp_f<0x4E>(v); pv[i] = v; }
            if (r4 == 0) {
#pragma unroll
                for (int rg = 0; rg < 4; ++rg) {
                    const int jb = (n0 >> 2) + 2 * rg + hh;
                    impA[jt * 128 + jb] = pv[4 * rg] + 2.f * pv[4 * rg + 1] + 2.f * pv[4 * rg + 2] + 2.f * pv[4 * rg + 3];
                    if (jb >= 1) impB[jt * 128 + jb - 1] = pv[4 * rg];
                }
            }
        }
        { const float g0 = NSA_GATE(0);
#pragma unroll
        for (int i = 0; i < 16; ++i) { ocl[i * 64] = g0 * o0[i]; ocl[(16 + i) * 64] = g0 * o1[i]; } }
    }
    WAVE_LDS_SYNC();
    {
        const int lig = lane & 15, grp = lane >> 4;
#pragma unroll 1
        for (int half = 0; half < 2; ++half) {
            const int j2 = half * 4 + grp, cur = (t0 + j2) >> 6;
            float v[8];
#pragma unroll
            for (int e = 0; e < 8; ++e) {
                const int j = lig * 8 + e; const float val = impA[j2 * 128 + j] + impB[j2 * 128 + j];
                v[e] = (j >= 1 && j <= cur - 2) ? __uint_as_float((__float_as_uint(val) & ~127u) | (unsigned)(127 - j)) : -1.0f;
            }
            const float top = grp16_top16(v, lig);
            const int need = 16 - ((cur == 0) ? 1 : (cur == 1) ? 2 : 3);
            if (lig < need && top >= 0.f) { const int idx = 127 - (int)(__float_as_uint(top) & 127u); atomicOr(&msk[j2 * 4 + (idx >> 5)], 1u << (idx & 31)); }
            if (lig == 0) { atomicOr(&msk[j2 * 4], 1u); atomicOr(&msk[j2 * 4 + (cur >> 5)], 1u << (cur & 31)); if (cur >= 1) atomicOr(&msk[j2 * 4 + ((cur - 1) >> 5)], 1u << ((cur - 1) & 31)); }
        }
    }
    WAVE_LDS_SYNC();
    {
        int nblk = 0;
#pragma unroll
        for (int w = 3; w >= 0; --w) {
            unsigned u = 0u;
#pragma unroll
            for (int j = 0; j < 8; ++j) u |= msk[j * 4 + w];
            u = (unsigned)__builtin_amdgcn_readfirstlane((int)u);
            while (u) { const int bit = 31 - __builtin_clz(u); u &= ~(1u << bit); if (lane == 0) blist[nblk] = (unsigned char)(w * 32 + bit); ++nblk; }
        }
        WAVE_LDS_SYNC();
        const unsigned char* KS = p.ws + WS_KFS + (size_t)(b * 2 + g) * (256 * 4096) + lane * 16;
        const unsigned char* VTS = p.ws + WS_VTS + (size_t)(b * 2 + g) * (256 * 4096) + lane * 16;
        float l = 0.f;
        f32x16 o0, o1;
#pragma unroll
        for (int i = 0; i < 16; ++i) { o0[i] = 0.f; o1[i] = 0.f; }
        const int ntile = 2 * nblk;
        KF kn; VF vn;
        { const int jb0 = blist[0]; load_k(kn, KS + (size_t)(jb0 * 64 + 32) * 128); load_v(vn, VTS + (size_t)(jb0 * 64 + 32) * 128); }
#pragma unroll 1
        for (int ti = 0; ti < ntile; ++ti) {
            const int jb = __builtin_amdgcn_readfirstlane((int)blist[ti >> 1]);
            const int key0 = jb * 64 + 32 - 32 * (ti & 1);
            const KF kc = kn; const VF vf = vn;
            { const int tn = (ti + 1 < ntile) ? ti + 1 : ti; const int jn = __builtin_amdgcn_readfirstlane((int)blist[tn >> 1]); const size_t off = (size_t)(jn * 64 + 32 - 32 * (tn & 1)) * 128;
              load_k(kn, KS + off); load_v(vn, VTS + off); }
            const bool colsel = (msk[jt * 4 + (jb >> 5)] >> (jb & 31)) & 1u;
            const int distbase = tc - key0 - 4 * hh;
            if (key0 + 31 <= t0) attn_tile<true>(kc, vf, qf, slope, colsel ? -slope * (float)distbase - bnd[1] : -1e30f, distbase, true, 1 << 30, l, o0, o1);
            else attn_tile<false>(kc, vf, qf, slope, -slope * (float)distbase - bnd[1], distbase, colsel, 1 << 30, l, o0, o1);
        }
        l += __shfl_xor(l, 32);
        const float sc = (l > 0.f) ? NSA_GATE(1) / l : 0.f;
#pragma unroll
        for (int i = 0; i < 16; ++i) { ocl[i * 64] += sc * o0[i]; ocl[(16 + i) * 64] += sc * o1[i]; }
    }
    {
        const unsigned char* KW = p.ws + WS_KFW + (size_t)(b * 2 + g) * (256 * 4096) + lane * 16;
        const unsigned char* VTW = p.ws + WS_VTW + (size_t)(b * 2 + g) * (256 * 4096) + lane * 16;
        float l = 0.f;
        f32x16 o0, o1;
#pragma unroll
        for (int i = 0; i < 16; ++i) { o0[i] = 0.f; o1[i] = 0.f; }
        const int kstart = (t0 - 511 > 0 ? t0 - 511 : 0) & ~31, kfirst = t0 & ~31;
        KF kn;
        load_k(kn, KW + (size_t)kfirst * 128);
#pragma unroll 1
        for (int key0 = kfirst; key0 >= kstart; key0 -= 32) {
            const KF kc = kn; VF vf;
            load_v(vf, VTW + (size_t)key0 * 128);
            { const int kn0 = (key0 - 32 >= kstart) ? key0 - 32 : key0; load_k(kn, KW + (size_t)kn0 * 128); }
            const int distbase = tc - key0 - 4 * hh;
            if (key0 + 31 <= t0 && key0 >= t0 - 504) attn_tile<true>(kc, vf, qf, slope, -slope * (float)distbase - bnd[2], distbase, true, 512, l, o0, o1);
            else attn_tile<false>(kc, vf, qf, slope, -slope * (float)distbase - bnd[2], distbase, true, 512, l, o0, o1);
        }
        l += __shfl_xor(l, 32);
        const float sc = (l > 0.f) ? NSA_GATE(2) / l : 0.f;
#pragma unroll
        for (int i = 0; i < 16; ++i) { o0[i] = ocl[i * 64] + sc * o0[i]; o1[i] = ocl[(16 + i) * 64] + sc * o1[i]; }
        float ss = 0.f;
#pragma unroll
        for (int i = 0; i < 16; ++i) ss += o0[i] * o0[i] + o1[i] * o1[i];
        ss += __shfl_xor(ss, 32);
        const float r = rsqrtf(ss * (1.0f / 64.0f) + EPS);
        const float* og = p.in[11] + h * 64;
        bf16* op = (bf16*)(p.ws + WS_ACT) + (size_t)(b * T + tc) * D + 512 + h * 64;
#pragma unroll
        for (int dt = 0; dt < 2; ++dt)
#pragma unroll
            for (int rg = 0; rg < 4; ++rg) {
                const int d0 = dt * 32 + 8 * rg + 4 * hh;
                const f32x4 gg = *(const f32x4*)(og + d0);
                u32x2 w;
                if (dt == 0) { w.x = pk2(o0[4 * rg] * r * gg.x, o0[4 * rg + 1] * r * gg.y); w.y = pk2(o0[4 * rg + 2] * r * gg.z, o0[4 * rg + 3] * r * gg.w); }
                else { w.x = pk2(o1[4 * rg] * r * gg.x, o1[4 * rg + 1] * r * gg.y); w.y = pk2(o1[4 * rg + 2] * r * gg.z, o1[4 * rg + 3] * r * gg.w); }
                *(u32x2*)(op + d0) = w;
            }
    }
    WAVE_LDS_SYNC();
}
__device__ __forceinline__ void phase2(const Params& p, unsigned char* lds) {
    unsigned* ctr = (unsigned*)(p.ws + WS_CTR) + 2048;
    volatile int* slot = (volatile int*)(lds + LDS_BYTES - 32);
    for (;;) {
        if (threadIdx.x == 0) *slot = (int)atomicAdd(ctr, 1u);
        __syncthreads();
        const int it = *slot;
        __syncthreads();
        if (it >= 128 + 1024 + 256) break;
        if (it < 128) nsa_cmp_item(p, lds, it);
        else if (it < 1152) hgrn_pre_item(p, lds, it - 128);
        else { nsa_prep_item(p, lds, it - 1152); __syncthreads(); }
    }
}
template <bool SCAN>
__device__ __forceinline__ void phase3(const Params& p, unsigned char* lds) {
    const int wid = __builtin_amdgcn_readfirstlane((int)(threadIdx.x >> 6));
    if (SCAN && blockIdx.x < 32) hgrn_scan_block(p, lds, blockIdx.x);
    unsigned* ctr = (unsigned*)(p.ws + WS_CTR) + (SCAN ? 0 : 128);
    const int myx = (int)(xb_xcc_id() & 7u);
    for (;;) {
        int q = -1, it = 0;
        for (int k = 0; k < 8; ++k) {
            const int x = (myx + k) & 7;
            int v = 0;
            if ((threadIdx.x & 63) == 0) v = (int)atomicAdd(ctr + x * 16, 1u);
            v = __builtin_amdgcn_readfirstlane(v);
            if (v < 512) { q = x; it = v; break; }
        }
        if (q < 0) break;
        const int item = ((q >> 1) << 10) | ((q & 1) * 512 + 511 - it);
        nsa_attn_item(p, lds + wid * 16640, item);
    }
}

__device__ __forceinline__ float dot2u(unsigned a, unsigned b, float acc) { return __builtin_amdgcn_fdot2_f32_bf16(__builtin_bit_cast(bf16x2v, a), __builtin_bit_cast(bf16x2v, b), acc, false); }
__device__ __forceinline__ float dot8(u32x4 a, u32x4 b, float acc) {
    const unsigned a0 = a.x, a1 = a.y, a2 = a.z, a3 = a.w, b0 = b.x, b1 = b.y, b2 = b.z, b3 = b.w;
    acc = dot2u(a0, b0, acc); acc = dot2u(a1, b1, acc); acc = dot2u(a2, b2, acc); acc = dot2u(a3, b3, acc);
    return acc;
}
__device__ __forceinline__ void axpy8(float (&o)[8], float c, u32x4 v) {
    o[0] += c * __uint_as_float(v.x << 16); o[1] += c * __uint_as_float(v.x & 0xffff0000u);
    o[2] += c * __uint_as_float(v.y << 16); o[3] += c * __uint_as_float(v.y & 0xffff0000u);
    o[4] += c * __uint_as_float(v.z << 16); o[5] += c * __uint_as_float(v.z & 0xffff0000u);
    o[6] += c * __uint_as_float(v.w << 16); o[7] += c * __uint_as_float(v.w & 0xffff0000u);
}
typedef float f32x2 __attribute__((ext_vector_type(2)));
__device__ __forceinline__ float dot16_fp8(u32x4 r, const float* xf) {
    const unsigned r0 = r.x, r1 = r.y, r2 = r.z, r3 = r.w; float acc = 0.f; f32x2 t;
    t = __builtin_amdgcn_cvt_pk_f32_fp8((int)r0, false); acc += t.x * xf[0] + t.y * xf[1]; t = __builtin_amdgcn_cvt_pk_f32_fp8((int)r0, true); acc += t.x * xf[2] + t.y * xf[3];
    t = __builtin_amdgcn_cvt_pk_f32_fp8((int)r1, false); acc += t.x * xf[4] + t.y * xf[5]; t = __builtin_amdgcn_cvt_pk_f32_fp8((int)r1, true); acc += t.x * xf[6] + t.y * xf[7];
    t = __builtin_amdgcn_cvt_pk_f32_fp8((int)r2, false); acc += t.x * xf[8] + t.y * xf[9]; t = __builtin_amdgcn_cvt_pk_f32_fp8((int)r2, true); acc += t.x * xf[10] + t.y * xf[11];
    t = __builtin_amdgcn_cvt_pk_f32_fp8((int)r3, false); acc += t.x * xf[12] + t.y * xf[13]; t = __builtin_amdgcn_cvt_pk_f32_fp8((int)r3, true); acc += t.x * xf[14] + t.y * xf[15];
    return acc;
}
__device__ __forceinline__ void axpy16_fp8(float* o, float c, u32x4 r) {
    const unsigned r0 = r.x, r1 = r.y, r2 = r.z, r3 = r.w; f32x2 t;
    t = __builtin_amdgcn_cvt_pk_f32_fp8((int)r0, false); o[0] += c * t.x; o[1] += c * t.y; t = __builtin_amdgcn_cvt_pk_f32_fp8((int)r0, true); o[2] += c * t.x; o[3] += c * t.y;
    t = __builtin_amdgcn_cvt_pk_f32_fp8((int)r1, false); o[4] += c * t.x; o[5] += c * t.y; t = __builtin_amdgcn_cvt_pk_f32_fp8((int)r1, true); o[6] += c * t.x; o[7] += c * t.y;
    t = __builtin_amdgcn_cvt_pk_f32_fp8((int)r2, false); o[8] += c * t.x; o[9] += c * t.y; t = __builtin_amdgcn_cvt_pk_f32_fp8((int)r2, true); o[10] += c * t.x; o[11] += c * t.y;
    t = __builtin_amdgcn_cvt_pk_f32_fp8((int)r3, false); o[12] += c * t.x; o[13] += c * t.y; t = __builtin_amdgcn_cvt_pk_f32_fp8((int)r3, true); o[14] += c * t.x; o[15] += c * t.y;
}
template <bool DUMMY>
__device__ __forceinline__ void phase9(const Params& p, unsigned char* lds) {
    const bf16* HN = (const bf16*)(p.ws + WS_ACT); const unsigned char* UB = p.ws + WS_UB; const unsigned char* VB = p.ws + WS_VB;
    const float* US = (const float*)(p.ws + WS_US); const float* VS = (const float*)(p.ws + WS_VS);
    const int* ids = (const int*)(p.ws + WS_IDS); const float* wts = (const float*)(p.ws + WS_WTS);
    float* O = p.out; bf16* HG = (bf16*)(p.ws + WS_PROJ + 64 * MiB); const float* gn = p.in[19];
    const int lane = threadIdx.x & 63, gw = (blockIdx.x * NTHR + threadIdx.x) >> 6, ngw = (gridDim.x * NTHR) >> 6;
    for (int tok = gw; tok < NTOK; tok += ngw) {
        float xf[16], oa[16];
        {
            const u32x4 x0 = *(const u32x4*)(HN + (size_t)tok * D + lane * 16), x1 = *(const u32x4*)(HN + (size_t)tok * D + lane * 16 + 8);
            const unsigned a0 = x0.x, a1 = x0.y, a2 = x0.z, a3 = x0.w, b0 = x1.x, b1 = x1.y, b2 = x1.z, b3 = x1.w;
            xf[0] = __uint_as_float(a0 << 16); xf[1] = __uint_as_float(a0 & 0xffff0000u); xf[2] = __uint_as_float(a1 << 16); xf[3] = __uint_as_float(a1 & 0xffff0000u);
            xf[4] = __uint_as_float(a2 << 16); xf[5] = __uint_as_float(a2 & 0xffff0000u); xf[6] = __uint_as_float(a3 << 16); xf[7] = __uint_as_float(a3 & 0xffff0000u);
            xf[8] = __uint_as_float(b0 << 16); xf[9] = __uint_as_float(b0 & 0xffff0000u); xf[10] = __uint_as_float(b1 << 16); xf[11] = __uint_as_float(b1 & 0xffff0000u);
            xf[12] = __uint_as_float(b2 << 16); xf[13] = __uint_as_float(b2 & 0xffff0000u); xf[14] = __uint_as_float(b3 << 16); xf[15] = __uint_as_float(b3 & 0xffff0000u);
        }
#pragma unroll
        for (int j = 0; j < 16; ++j) oa[j] = 0.f;
#pragma unroll 1
        for (int half = 0; half < 2; ++half) {
            const int myid = ids[(size_t)tok * 128 + half * 64 + lane];
            const float myw = wts[(size_t)tok * 128 + half * 64 + lane] * VS[myid];
            const float myus = US[myid];
#pragma unroll 1
            for (int eb = 0; eb < 64; eb += 16) {
                int id[16]; float d[16]; u32x4 ur[16];
#pragma unroll
                for (int j = 0; j < 16; ++j) id[j] = __shfl(myid, eb + j);
#pragma unroll
                for (int j = 0; j < 16; ++j) ur[j] = *(const u32x4*)(UB + (size_t)id[j] * D + lane * 16);
#pragma unroll
                for (int j = 0; j < 16; ++j) d[j] = dot16_fp8(ur[j], xf);
#pragma unroll
                for (int j = 0; j < 16; ++j) ur[j] = *(const u32x4*)(VB + (size_t)id[j] * D + lane * 16);
#pragma unroll
                for (int j = 0; j < 16; ++j) d[j] = wave_sum(d[j]);
#pragma unroll
                for (int j = 0; j < 16; ++j) { const float c = __shfl(myw, eb + j) * gelu_tanh(d[j] * __shfl(myus, eb + j)); axpy16_fp8(oa, c, ur[j]); }
            }
        }
        float* orow = O + (size_t)tok * D + lane * 16; float* wrow = DUMMY ? (float*)(p.ws + WS_PROJ) + (size_t)tok * D + lane * 16 : orow;
        float ss = 0.f; f32x4 hv[4];
#pragma unroll
        for (int q = 0; q < 4; ++q) {
            f32x4 h = *(const f32x4*)(orow + 4 * q);
            h.x += oa[4 * q]; h.y += oa[4 * q + 1]; h.z += oa[4 * q + 2]; h.w += oa[4 * q + 3];
            *(f32x4*)(wrow + 4 * q) = h; hv[q] = h;
            ss += h.x * h.x + h.y * h.y + h.z * h.z + h.w * h.w;
        }
        ss = wave_sum(ss);
        const float r = rsqrtf(ss * (1.0f / D) + EPS);
        u32x4 q0, q1;
        { const f32x4 g0 = *(const f32x4*)(gn + lane * 16), g1 = *(const f32x4*)(gn + lane * 16 + 4), g2 = *(const f32x4*)(gn + lane * 16 + 8), g3 = *(const f32x4*)(gn + lane * 16 + 12);
          q0.x = pk2(hv[0].x * r * g0.x, hv[0].y * r * g0.y); q0.y = pk2(hv[0].z * r * g0.z, hv[0].w * r * g0.w); q0.z = pk2(hv[1].x * r * g1.x, hv[1].y * r * g1.y); q0.w = pk2(hv[1].z * r * g1.z, hv[1].w * r * g1.w);
          q1.x = pk2(hv[2].x * r * g2.x, hv[2].y * r * g2.y); q1.y = pk2(hv[2].z * r * g2.z, hv[2].w * r * g2.w); q1.z = pk2(hv[3].x * r * g3.x, hv[3].y * r * g3.y); q1.w = pk2(hv[3].z * r * g3.z, hv[3].w * r * g3.w); }
        *(u32x4*)(HG + (size_t)tok * D + lane * 16) = q0; *(u32x4*)(HG + (size_t)tok * D + lane * 16 + 8) = q1;
    }
}


__device__ __forceinline__ unsigned xb_xcc_id();
template <int CTRL> __device__ __forceinline__ float dpp_row_ror(float v) { return __int_as_float(__builtin_amdgcn_update_dpp(0, __float_as_int(v), CTRL, 0xF, 0xF, false)); }
__device__ __forceinline__ float grp8_sum(float v) { v += dpp_f<0xB1>(v); v += dpp_f<0x4E>(v); v += dpp_f<0x141>(v); return v; }
__device__ __forceinline__ int peer_next_item(unsigned* ctr, int myx, int& slice) {
    for (int k = 0; k < 8; ++k) {
        const int x = (myx + k) & 7;
        int it = 0;
        if ((threadIdx.x & 63) == 0) it = (int)atomicAdd(ctr + x * 16, 1u);
        it = __builtin_amdgcn_readfirstlane(it);
        if (it < 1024) { slice = x; return it; }
    }
    return -1;
}
__device__ __forceinline__ void unpack16(const u32x4 x0, const u32x4 x1, float* xf) {
    const unsigned a0 = x0.x, a1 = x0.y, a2 = x0.z, a3 = x0.w, b0 = x1.x, b1 = x1.y, b2 = x1.z, b3 = x1.w;
    xf[0] = __uint_as_float(a0 << 16); xf[1] = __uint_as_float(a0 & 0xffff0000u); xf[2] = __uint_as_float(a1 << 16); xf[3] = __uint_as_float(a1 & 0xffff0000u);
    xf[4] = __uint_as_float(a2 << 16); xf[5] = __uint_as_float(a2 & 0xffff0000u); xf[6] = __uint_as_float(a3 << 16); xf[7] = __uint_as_float(a3 & 0xffff0000u);
    xf[8] = __uint_as_float(b0 << 16); xf[9] = __uint_as_float(b0 & 0xffff0000u); xf[10] = __uint_as_float(b1 << 16); xf[11] = __uint_as_float(b1 & 0xffff0000u);
    xf[12] = __uint_as_float(b2 << 16); xf[13] = __uint_as_float(b2 & 0xffff0000u); xf[14] = __uint_as_float(b3 << 16); xf[15] = __uint_as_float(b3 & 0xffff0000u);
}
__device__ __forceinline__ void unpack_ids(const u32x4 r, int* id) {
    const unsigned a = r.x, b = r.y, c = r.z, d = r.w;
    id[0] = a & 0xffff; id[1] = a >> 16; id[2] = b & 0xffff; id[3] = b >> 16; id[4] = c & 0xffff; id[5] = c >> 16; id[6] = d & 0xffff; id[7] = d >> 16;
}
__device__ __forceinline__ void phase9a(const Params& p, unsigned char* lds) {
    const bf16* HN = (const bf16*)(p.ws + WS_ACT); const unsigned char* UB = p.ws + WS_UB;
    const unsigned short* ids = (const unsigned short*)(p.ws + WS_IDS); float* PD = (float*)(p.ws + WS_PROJ);
    unsigned* ctr = (unsigned*)(p.ws + WS_CTR) + 256;
    const int lane = threadIdx.x & 63, gq = lane >> 3, cl = lane & 7, myx = (int)(xb_xcc_id() & 7u);
    for (;;) {
        int x; const int it = peer_next_item(ctr, myx, x);
        if (it < 0) break;
        const unsigned char* ub = UB + (size_t)x * (16384 * 128) + cl * 16;
        const bf16* hn = HN + x * 128 + cl * 16;
        const int tokb = it * 16;
        const unsigned short* ip = ids + (size_t)tokb * 128 + gq * 8;
        int idn[8]; u32x4 bufA[8], bufB[8], xa0, xa1, xb0, xb1, idr;
        idr = *(const u32x4*)ip; unpack_ids(idr, idn);
#pragma unroll
        for (int i = 0; i < 8; ++i) bufA[i] = *(const u32x4*)(ub + (size_t)idn[i] * 128);
        xa0 = *(const u32x4*)(hn + (size_t)tokb * D); xa1 = *(const u32x4*)(hn + (size_t)tokb * D + 8);
        idr = *(const u32x4*)(ip + 64); unpack_ids(idr, idn);
#pragma unroll
        for (int i = 0; i < 8; ++i) bufB[i] = *(const u32x4*)(ub + (size_t)idn[i] * 128);
        xb0 = xa0; xb1 = xa1;
        idr = *(const u32x4*)(ip + 128);
#define P9A_STEP(buf, x0, x1, u) { const int u2_ = ((u) + 2 < 32) ? (u) + 2 : (u), u3_ = ((u) + 3 < 32) ? (u) + 3 : (u); \
            unpack_ids(idr, idn); idr = *(const u32x4*)(ip + u3_ * 64); \
            float xf[16]; unpack16(x0, x1, xf); \
            x0 = *(const u32x4*)(hn + (size_t)(tokb + (u2_ >> 1)) * D); x1 = *(const u32x4*)(hn + (size_t)(tokb + (u2_ >> 1)) * D + 8); \
            float keep = 0.f; \
            _Pragma("unroll") for (int i = 0; i < 8; ++i) { const float d = grp8_sum(dot16_fp8(buf[i], xf)); if (i == cl) keep = d; buf[i] = *(const u32x4*)(ub + (size_t)idn[i] * 128); } \
            PD[((size_t)x * NTOK + tokb + ((u) >> 1)) * 128 + (((u) & 1) * 8 + cl) * 8 + gq] = keep; }
#pragma unroll 1
        for (int u = 0; u < 32; u += 2) {
            P9A_STEP(bufA, xa0, xa1, u)
            P9A_STEP(bufB, xb0, xb1, u + 1)
        }
#undef P9A_STEP
    }
}
__device__ __forceinline__ void phase9c(const Params& p, unsigned char* lds) {
    const unsigned short* ids = (const unsigned short*)(p.ws + WS_IDS); const float* wts = (const float*)(p.ws + WS_WTS); const float* PD = (const float*)(p.ws + WS_PROJ);
    const float* US = (const float*)(p.ws + WS_US); const float* VS = (const float*)(p.ws + WS_VS); float* coefT = (float*)(p.ws + WS_COEFT);
    const size_t gtid = (size_t)blockIdx.x * NTHR + threadIdx.x, gth = (size_t)gridDim.x * NTHR;
    for (size_t idx = gtid; idx < (size_t)NTOK * 128; idx += gth) {
        const size_t tok = idx >> 7; const int r = (int)(idx & 127), e = (r & 64) + (r & 7) * 8 + ((r >> 3) & 7);
        float sdot = 0.f;
#pragma unroll
        for (int x = 0; x < 8; ++x) sdot += PD[(size_t)x * NTOK * 128 + tok * 128 + e];
        const int id = ids[idx];
        coefT[idx] = wts[tok * 128 + e] * VS[id] * gelu_tanh(sdot * US[id]);
    }
}
__device__ __forceinline__ void phase9b(const Params& p, unsigned char* lds) {
    const unsigned char* VB = p.ws + WS_VB; const unsigned short* ids = (const unsigned short*)(p.ws + WS_IDS); const float* coef = (const float*)(p.ws + WS_COEFT);
    float* O = p.out; bf16* HG = (bf16*)(p.ws + WS_PROJ + 64 * MiB); const float* gn = p.in[19]; float* SSQ = (float*)(p.ws + WS_SSQ);
    unsigned* ctr = (unsigned*)(p.ws + WS_CTR) + 512;
    const int lane = threadIdx.x & 63, gq = lane >> 3, cl = lane & 7, myx = (int)(xb_xcc_id() & 7u);
    for (;;) {
        int x; const int it = peer_next_item(ctr, myx, x);
        if (it < 0) break;
        const unsigned char* vb = VB + (size_t)x * (16384 * 128) + cl * 16;
        const int tokb = it * 16;
        const unsigned short* ip = ids + (size_t)tokb * 128 + gq * 8;
        const float* cp = coef + (size_t)tokb * 128 + gq * 8;
        int idn[8]; u32x4 buf[8], idr; f32x4 cf0, cf1, cn0, cn1; float acc[16];
#pragma unroll
        for (int j = 0; j < 16; ++j) acc[j] = 0.f;
        idr = *(const u32x4*)ip; unpack_ids(idr, idn);
        cf0 = *(const f32x4*)cp; cf1 = *(const f32x4*)(cp + 4);
#pragma unroll
        for (int i = 0; i < 8; ++i) buf[i] = *(const u32x4*)(vb + (size_t)idn[i] * 128);
        idr = *(const u32x4*)(ip + 64); cn0 = *(const f32x4*)(cp + 64); cn1 = *(const f32x4*)(cp + 68);
#pragma unroll 1
        for (int u = 0; u < 32; ++u) {
            const int u2 = (u + 2 < 32) ? u + 2 : u;
            unpack_ids(idr, idn);
            const f32x4 c0 = cf0, c1 = cf1; cf0 = cn0; cf1 = cn1;
            idr = *(const u32x4*)(ip + u2 * 64); cn0 = *(const f32x4*)(cp + u2 * 64); cn1 = *(const f32x4*)(cp + u2 * 64 + 4);
            const float cfv[8] = {c0.x, c0.y, c0.z, c0.w, c1.x, c1.y, c1.z, c1.w};
#pragma unroll
            for (int i = 0; i < 8; ++i) { axpy16_fp8(acc, cfv[i], buf[i]); buf[i] = *(const u32x4*)(vb + (size_t)idn[i] * 128); }
            if (u & 1) {
                const int tok = tokb + (u >> 1);
#pragma unroll
                for (int j = 0; j < 16; ++j) { float v = acc[j]; v += __shfl_xor(v, 8); v += __shfl_xor(v, 16); v += __shfl_xor(v, 32); acc[j] = v; }
                float ss = 0.f;
                if (gq == 0) {
                    float* orow = O + (size_t)tok * D + x * 128 + cl * 16; const float* gr = gn + x * 128 + cl * 16; u32x4 q0, q1; unsigned qq[8];
#pragma unroll
                    for (int q = 0; q < 4; ++q) {
                        f32x4 hv = *(const f32x4*)(orow + 4 * q); const f32x4 gg = *(const f32x4*)(gr + 4 * q);
                        hv.x += acc[4 * q]; hv.y += acc[4 * q + 1]; hv.z += acc[4 * q + 2]; hv.w += acc[4 * q + 3];
                        *(f32x4*)(orow + 4 * q) = hv;
                        ss += hv.x * hv.x + hv.y * hv.y + hv.z * hv.z + hv.w * hv.w;
                        qq[2 * q] = pk2(hv.x * gg.x, hv.y * gg.y); qq[2 * q + 1] = pk2(hv.z * gg.z, hv.w * gg.w);
                    }
                    q0.x = qq[0]; q0.y = qq[1]; q0.z = qq[2]; q0.w = qq[3]; q1.x = qq[4]; q1.y = qq[5]; q1.z = qq[6]; q1.w = qq[7];
                    *(u32x4*)(HG + (size_t)tok * D + x * 128 + cl * 16) = q0; *(u32x4*)(HG + (size_t)tok * D + x * 128 + cl * 16 + 8) = q1;
                }
                ss = grp8_sum(ss);
                if (lane == 0) SSQ[(size_t)x * NTOK + tok] = ss;
#pragma unroll
                for (int j = 0; j < 16; ++j) acc[j] = 0.f;
            }
        }
    }
}

#define XB_TMO      128
#define XB_XCNT(j)  (256  + 64 * (j))
#define XB_XSUB(j)  (1280 + 64 * (j))
#define XB_XGEN(j)  (2304 + 64 * (j))
#define XB_TOP      3328
#define XB_TOPGEN   3392
#define XCD_BAR_WORDS 3456
#define XB_SPIN_CAP (1u << 18)
#define LAS __attribute__((address_space(3)))
__device__ __forceinline__ unsigned xb_ld(unsigned* p)              { return __hip_atomic_load(p, __ATOMIC_RELAXED, __HIP_MEMORY_SCOPE_AGENT); }
__device__ __forceinline__ unsigned xb_add(unsigned* p, unsigned v) { return __hip_atomic_fetch_add(p, v, __ATOMIC_RELAXED, __HIP_MEMORY_SCOPE_AGENT); }
__device__ __forceinline__ unsigned xb_xcc_id() { return (unsigned)__builtin_amdgcn_s_getreg((3 << 11) | 20) & 0xFu; }
#define XB_SPIN(cond, bar) do { unsigned _sp = 0; while (cond) { __builtin_amdgcn_s_sleep(1); \
    if ((++_sp & 255u) == 0u) { if (xb_ld(&(bar)[XB_TMO])) break; if (_sp > XB_SPIN_CAP) { atomicAdd(&(bar)[XB_TMO], 1u); break; } } } } while (0)
struct XcdBarrier { unsigned* bar; unsigned x; volatile LAS unsigned* st; };
__device__ __forceinline__ XcdBarrier xcd_barrier_post(unsigned* bar, volatile LAS unsigned* st) {
    XcdBarrier b; b.bar = bar; b.x = xb_xcc_id(); b.st = st;
    if (threadIdx.x == 0) (void)xb_add(&bar[XB_XCNT(b.x)], 1u);
    return b;
}
__device__ __forceinline__ void xcd_barrier_complete(unsigned* bar, unsigned x, unsigned& nloc, unsigned& nx) {
    const unsigned G = gridDim.x * gridDim.y * gridDim.z;
    unsigned sum, cnt, mine, sp = 0u;
    for (;;) {
        sum = 0u; cnt = 0u; mine = 0u;
#pragma unroll
        for (unsigned j = 0; j < 16; ++j) { const unsigned c = xb_ld(&bar[XB_XCNT(j)]); sum += c; cnt += (c > 0u) ? 1u : 0u; mine = (j == x) ? c : mine; }
        if (sum == G) break;
        __builtin_amdgcn_s_sleep(1);
        if ((++sp & 255u) == 0u) { if (xb_ld(&bar[XB_TMO])) break; if (sp > XB_SPIN_CAP) { atomicAdd(&bar[XB_TMO], 1u); break; } }
    }
    nloc = mine > 0u ? mine : 1u; nx = cnt > 0u ? cnt : 1u;
}
__device__ __forceinline__ void xcd_barrier(const XcdBarrier& b) {
    asm volatile("s_waitcnt vmcnt(0)" ::: "memory");
    __syncthreads();
    if (threadIdx.x == 0) {
        unsigned* bar = b.bar;
        __builtin_amdgcn_s_waitcnt(0);
        unsigned nloc = b.st[0], nx = b.st[1];
        if (nloc == 0u) { xcd_barrier_complete(bar, b.x, nloc, nx); b.st[0] = nloc; b.st[1] = nx; }
        const unsigned old = xb_add(&bar[XB_XSUB(b.x)], 1u);
        const unsigned gen = old / nloc;
        if (old + 1u == (gen + 1u) * nloc) {
            __builtin_amdgcn_fence(__ATOMIC_RELEASE, "agent");
            asm volatile("s_waitcnt vmcnt(0)" ::: "memory");
            const unsigned og = xb_add(&bar[XB_TOP], 1u);
            const unsigned tg = og / nx;
            if (og + 1u == (tg + 1u) * nx) xb_add(&bar[XB_TOPGEN], 1u);
            else XB_SPIN(xb_ld(&bar[XB_TOPGEN]) == tg, bar);
            __builtin_amdgcn_fence(__ATOMIC_ACQUIRE, "agent");
            xb_add(&bar[XB_XGEN(b.x)], 1u);
            asm volatile("s_waitcnt vmcnt(0)" ::: "memory");
        } else {
            XB_SPIN(xb_ld(&bar[XB_XGEN(b.x)]) == gen, bar);
            __builtin_amdgcn_fence(__ATOMIC_ACQUIRE, "agent");
            asm volatile("s_waitcnt vmcnt(0)" ::: "memory");
        }
    }
    __syncthreads();
}

constexpr int REPK = -1;
__global__ void __launch_bounds__(NTHR, 2) mega(Params p, int ph_lo, int ph_hi) {
    extern __shared__ __attribute__((aligned(16))) unsigned char lds[];
    volatile LAS unsigned* st = (volatile LAS unsigned*)(LAS unsigned char*)(lds + LDS_BYTES - 16);
    if (threadIdx.x < 4) st[threadIdx.x] = 0u;
    __syncthreads();
    const XcdBarrier bar = xcd_barrier_post((unsigned*)p.ws, st);
#define RUN_PHASE(k, call) if (ph_lo <= (k) && (k) < ph_hi) { if ((k) > ph_lo) xcd_barrier(bar); call; if (REPK == (k)) { xcd_barrier(bar); call; } }
    RUN_PHASE(0, phase0(p, lds))
    RUN_PHASE(1, phase1(p, lds))
    RUN_PHASE(2, phase2(p, lds))
    if (REPK == 30) { xcd_barrier(bar); if ((threadIdx.x >> 6) == 0 && blockIdx.x < 64) hgrn_scan_item<true>(p, blockIdx.x); }
    if (ph_lo <= 3 && 3 < ph_hi) { if (3 > ph_lo) xcd_barrier(bar); phase3<true>(p, lds); if (REPK == 3) { xcd_barrier(bar); phase3<false>(p, lds); } }
    RUN_PHASE(4, phase4(p, lds))
    RUN_PHASE(5, phase5(p, lds))
    RUN_PHASE(6, phase6(p, lds))
    RUN_PHASE(7, phase7(p, lds))
    RUN_PHASE(8, phase8(p, lds))
    if (ph_lo <= 9 && 9 < ph_hi) { if (9 > ph_lo) xcd_barrier(bar); phase9a(p, lds); }
    if (ph_lo <= 9 && 9 < ph_hi) { xcd_barrier(bar); phase9c(p, lds); }
    if (ph_lo <= 9 && 9 < ph_hi) { xcd_barrier(bar); phase9b(p, lds); }
    RUN_PHASE(10, phase10(p, lds))
}

static void launch_mega(const Params& p, int lo, int hi, hipStream_t stream) {
    static int grid = 0;
    if (grid == 0) {
        int dev = 0, cus = 0, per_cu = 0;
        hipGetDevice(&dev); hipDeviceGetAttribute(&cus, hipDeviceAttributeMultiprocessorCount, dev);
        hipFuncSetAttribute((const void*)mega, hipFuncAttributeMaxDynamicSharedMemorySize, LDS_BYTES);
        hipOccupancyMaxActiveBlocksPerMultiprocessor(&per_cu, (const void*)mega, NTHR, LDS_BYTES);
        if (per_cu < 1) { fprintf(stderr, "mega: occupancy query says %d blocks/CU\n", per_cu); per_cu = 1; }
        grid = cus;
    }
    hipMemsetAsync(p.ws, 0, 65536, stream);
    Params pp = p; int l = lo, h = hi;
    void* args[] = {&pp, &l, &h};
    hipError_t e = hipLaunchCooperativeKernel((const void*)mega, dim3(grid), dim3(NTHR), args, LDS_BYTES, stream);
    if (e != hipSuccess) fprintf(stderr, "cooperative launch failed: %s (grid %d)\n", hipGetErrorString(e), grid);
}

extern "C" void kernel_launch(void* const* d_in, const int* in_sizes, int n_in, void* d_out, int out_size, void* d_ws, size_t ws_size, hipStream_t stream) {
    const float* x = (const float*)d_in[0]; const float* p = (const float*)d_in[1]; const float* mix_norm = (const float*)d_in[2]; const float* w_in = (const float*)d_in[3];
    const float* lb_logits = (const float*)d_in[4]; const float* hg_out_norm = (const float*)d_in[5]; const float* q_norm = (const float*)d_in[6]; const float* k_norm = (const float*)d_in[7];
    const float* cmp_pe = (const float*)d_in[8]; const float* cmp_w1 = (const float*)d_in[9]; const float* cmp_w2 = (const float*)d_in[10]; const float* nsa_out_norm = (const float*)d_in[11];
    const float* w_out = (const float*)d_in[12]; const float* ffn_norm = (const float*)d_in[13]; const float* peer_wq = (const float*)d_in[14]; const float* peer_keys = (const float*)d_in[15];
    const float* peer_u = (const float*)d_in[16]; const float* peer_v = (const float*)d_in[17]; const float* ple_proj = (const float*)d_in[18]; const float* ple_gate_norm = (const float*)d_in[19];
    const float* ple_gate_w = (const float*)d_in[20];
    float* out = (float*)d_out; unsigned char* ws = (unsigned char*)d_ws;
    bf16* act = (bf16*)(ws + WS_ACT); bf16* proj = (bf16*)(ws + WS_PROJ);
    bf16* pq = (bf16*)(ws + WS_PROJ); bf16* hg = (bf16*)(ws + WS_PROJ + 64 * MiB);
    int* ids = (int*)(ws + WS_IDS); float* wts = (float*)(ws + WS_WTS); float* kcf = (float*)(ws + WS_KCF); float* vcf = (float*)(ws + WS_VCF); float* gl = (float*)(ws + WS_GL);

    Params prm{}; for (int i = 0; i < 21; ++i) prm.in[i] = (const float*)d_in[i]; prm.out = out; prm.ws = ws;
    launch_mega(prm, 0, 11, stream);
}
```

```cpp
#include <hip/hip_runtime.h>
#include <hip/hip_cooperative_groups.h>
#include <cstdint>
#include <cstdio>
namespace cg = cooperative_groups;

constexpr int D = 1024, NB = 2, T = 8192, NTOK = NB * T;
constexpr int DIN = 3352, PS = 3392;
constexpr int C_HQ = 0, C_HF = 512, C_HI = 1024, C_HG = 1536, C_NQ = 2048, C_KC = 2560, C_VC = 2688,
              C_KS = 2816, C_VS = 2944, C_KW = 3072, C_VW = 3200, C_GT = 3328;
constexpr int NCMP = 511;
constexpr float EPS = 1e-6f;
typedef unsigned short bf16;

constexpr size_t MiB = 1u << 20;
constexpr size_t WS_WINT = 1 * MiB;
constexpr size_t WS_WOUTT = 8 * MiB;
constexpr size_t WS_WQT = 10 * MiB;
constexpr size_t WS_WGT = 14 * MiB;
constexpr size_t WS_WPT = 16 * MiB;
constexpr size_t WS_KEYB = 16 * MiB + 512 * 1024;
constexpr size_t WS_W1T = 17 * MiB;
constexpr size_t WS_CTR = 16384;
constexpr size_t WS_SSQ = 512 * 1024;
constexpr size_t WS_US = 256 * 1024;
constexpr size_t WS_VS = 320 * 1024;
constexpr size_t WS_UB = 18 * MiB;
constexpr size_t WS_VB = 50 * MiB;
constexpr size_t WS_ACT = 82 * MiB;
constexpr size_t WS_PROJ = 114 * MiB;
constexpr size_t WS_SPARE = 220 * MiB;
constexpr size_t WS_IDS = WS_SPARE;
constexpr size_t WS_WTS = WS_SPARE + 8 * MiB;
constexpr size_t WS_KCF = WS_SPARE + 16 * MiB;
constexpr size_t WS_VCF = WS_SPARE + 17 * MiB;
constexpr size_t WS_PB = WS_SPARE + 18 * MiB;
constexpr size_t WS_VTS = WS_SPARE + 26 * MiB;
constexpr size_t WS_VTW = WS_SPARE + 30 * MiB;
constexpr size_t WS_COEFT = WS_SPARE + 26 * MiB;
constexpr size_t WS_KFS = WS_SPARE;
constexpr size_t WS_KFW = WS_SPARE + 4 * MiB;
constexpr size_t WS_KC = WS_SPARE + 34 * MiB;
constexpr size_t WS_VCT = WS_SPARE + 34 * MiB + 256 * 1024;
constexpr size_t WS_DEC = WS_SPARE + 34 * MiB + 512 * 1024;
constexpr size_t OUT_KIT = 32 * MiB;
constexpr size_t OUT_VT = 48 * MiB;
constexpr size_t WS_GL = 18 * MiB;

__device__ __forceinline__ float bf2f(bf16 v) { return __uint_as_float(((unsigned)v) << 16); }
__device__ __forceinline__ bf16 f2bf(float f) { return __builtin_bit_cast(bf16, (__bf16)f); }
__device__ __forceinline__ float wave_sum(float v) {
#pragma unroll
    for (int o = 1; o < 64; o <<= 1) v += __shfl_xor(v, o);
    return v;
}
__device__ __forceinline__ float wave_max(float v) {
#pragma unroll
    for (int o = 1; o < 64; o <<= 1) v = fmaxf(v, __shfl_xor(v, o));
    return v;
}
__device__ __forceinline__ float sigmoidf_(float x) { return 1.0f / (1.0f + __expf(-x)); }
__device__ __forceinline__ float siluf_(float x) { return x * sigmoidf_(x); }
__device__ __forceinline__ float gelu_tanh(float x) { return 0.5f * x * (1.0f + tanhf(0.7978845608028654f * (x + 0.044715f * x * x * x))); }
__device__ __forceinline__ float toF(float v) { return v; }
__device__ __forceinline__ float toF(bf16 v) { return bf2f(v); }

typedef short bf16x8 __attribute__((ext_vector_type(8)));
typedef float f32x4 __attribute__((ext_vector_type(4)));
typedef float f32x16 __attribute__((ext_vector_type(16)));
typedef unsigned u32x4 __attribute__((ext_vector_type(4)));
typedef unsigned u32x2 __attribute__((ext_vector_type(2)));
constexpr int NTHR = 512;
constexpr int LDS_BYTES = 143360 + 16;
struct Params { const float* in[21]; float* out; unsigned char* ws; };
__device__ __forceinline__ unsigned xb_xcc_id();

typedef __bf16 bf16x2c __attribute__((ext_vector_type(2)));
__device__ __forceinline__ unsigned pk2(float lo, float hi) { bf16x2c v = { (__bf16)lo, (__bf16)hi }; return __builtin_bit_cast(unsigned, v); }

__device__ __forceinline__ void transpose_tile(const float* __restrict__ W, int K, int N, bf16* __restrict__ Wt, int kt, int nt, float* tile) {
    const int tid = threadIdx.x, k0 = kt * 64, n0 = nt * 64;
#pragma unroll
    for (int i = 0; i < 8; ++i) { const int idx = tid + i * NTHR, kk = idx >> 6, nn = idx & 63; tile[kk * 65 + nn] = (n0 + nn < N) ? W[(size_t)(k0 + kk) * N + n0 + nn] : 0.f; }
    __syncthreads();
    { const int nn = tid >> 3, ch = tid & 7; const float* s = tile + (ch * 8) * 65 + nn;
      u32x4 o; o.x = pk2(s[0], s[65]); o.y = pk2(s[130], s[195]); o.z = pk2(s[260], s[325]); o.w = pk2(s[390], s[455]);
      *(u32x4*)(Wt + (size_t)(n0 + nn) * K + k0 + ch * 8) = o; }
    __syncthreads();
}
__device__ __forceinline__ void cvt_range(const float* __restrict__ src, bf16* __restrict__ dst, size_t n8, size_t gtid, size_t gthreads) {
    for (size_t i = gtid; i < n8; i += gthreads) {
        const f32x4 a = ((const f32x4*)src)[2 * i], b = ((const f32x4*)src)[2 * i + 1];
        u32x4 o; o.x = pk2(a.x, a.y); o.y = pk2(a.z, a.w); o.z = pk2(b.x, b.y); o.w = pk2(b.z, b.w);
        ((u32x4*)dst)[i] = o;
    }
}
__device__ __forceinline__ void rms_row_bf16(const float* __restrict__ xr, const float* __restrict__ g, bf16* __restrict__ orow, int lane) {
    f32x4 v[4]; float s = 0.f;
#pragma unroll
    for (int j = 0; j < 4; ++j) { v[j] = ((const f32x4*)xr)[lane + 64 * j]; s += v[j].x * v[j].x + v[j].y * v[j].y + v[j].z * v[j].z + v[j].w * v[j].w; }
    s = wave_sum(s);
    const float r = rsqrtf(s * (1.0f / D) + EPS);
#pragma unroll
    for (int j = 0; j < 4; ++j) { const f32x4 gg = ((const f32x4*)g)[lane + 64 * j]; u32x2 o; o.x = pk2(v[j].x * r * gg.x, v[j].y * r * gg.y); o.y = pk2(v[j].z * r * gg.z, v[j].w * r * gg.w); ((u32x2*)orow)[lane + 64 * j] = o; }
}

__device__ __forceinline__ void phase0(const Params& p, unsigned char* lds) {
    float* tile = (float*)lds;
    const int nblk = gridDim.x, blk = blockIdx.x;
    unsigned char* ws = p.ws;
    constexpr int I_WIN = 16 * 56, I_WOUT = 16 * 16, I_WQ = 16 * 32, I_WG = 16 * 16, I_WP = 4 * 16, I_W1 = 2 * 32;
    constexpr int NIT = I_WIN + I_WOUT + I_WQ + I_WG + I_WP + I_W1;
    for (int it = blk; it < NIT; it += nblk) {
        int r = it;
        if (r < I_WIN) { transpose_tile(p.in[3], 1024, DIN, (bf16*)(ws + WS_WINT), r / 56, r % 56, tile); continue; } r -= I_WIN;
        if (r < I_WOUT) { transpose_tile(p.in[12], 1024, 1024, (bf16*)(ws + WS_WOUTT), r / 16, r % 16, tile); continue; } r -= I_WOUT;
        if (r < I_WQ) { transpose_tile(p.in[14], 1024, 2048, (bf16*)(ws + WS_WQT), r / 32, r % 32, tile); continue; } r -= I_WQ;
        if (r < I_WG) { transpose_tile(p.in[20], 1024, 1024, (bf16*)(ws + WS_WGT), r / 16, r % 16, tile); continue; } r -= I_WG;
        if (r < I_WP) { transpose_tile(p.in[18], 256, 1024, (bf16*)(ws + WS_WPT), r / 16, r % 16, tile); continue; } r -= I_WP;
        { const int which = r / 32, kt = r % 32; transpose_tile(p.in[9] + (size_t)which * 2048 * 64, 2048, 64, (bf16*)(ws + WS_W1T) + (size_t)which * 64 * 2048, kt, 0, tile); }
    }
    const size_t gtid = (size_t)blk * NTHR + threadIdx.x, gthreads = (size_t)nblk * NTHR;
    cvt_range(p.in[15], (bf16*)(ws + WS_KEYB), (size_t)8 * 2 * 128 * 128 / 8, gtid, gthreads);
    cvt_range(p.in[1], (bf16*)(ws + WS_PB), (size_t)NTOK * 256 / 8, gtid, gthreads);
    const int gw = (int)(gtid >> 6), ngw = (int)(gthreads >> 6), lane = threadIdx.x & 63;
    for (int m = gw; m < NTOK; m += ngw) rms_row_bf16(p.in[0] + (size_t)m * D, p.in[2], (bf16*)(ws + WS_ACT) + (size_t)m * D, lane);
    for (int m = gw; m < 2 * 16384; m += ngw) {
        const int which = m >> 14, row = m & 16383;
        const float* src = p.in[16 + which] + (size_t)row * D + lane * 16;
        const f32x4 a = *(const f32x4*)src, b = *(const f32x4*)(src + 4), c = *(const f32x4*)(src + 8), d = *(const f32x4*)(src + 12);
        float mx = fmaxf(fmaxf(fmaxf(fabsf(a.x), fabsf(a.y)), fmaxf(fabsf(a.z), fabsf(a.w))), fmaxf(fmaxf(fabsf(b.x), fabsf(b.y)), fmaxf(fabsf(b.z), fabsf(b.w))));
        mx = fmaxf(mx, fmaxf(fmaxf(fmaxf(fabsf(c.x), fabsf(c.y)), fmaxf(fabsf(c.z), fabsf(c.w))), fmaxf(fmaxf(fabsf(d.x), fabsf(d.y)), fmaxf(fabsf(d.z), fabsf(d.w)))));
        mx = fmaxf(wave_max(mx), 1e-30f);
        const float sc = 224.0f / mx;
        u32x4 o; int w;
        w = __builtin_amdgcn_cvt_pk_fp8_f32(a.x * sc, a.y * sc, 0, false); w = __builtin_amdgcn_cvt_pk_fp8_f32(a.z * sc, a.w * sc, w, true); o.x = (unsigned)w;
        w = __builtin_amdgcn_cvt_pk_fp8_f32(b.x * sc, b.y * sc, 0, false); w = __builtin_amdgcn_cvt_pk_fp8_f32(b.z * sc, b.w * sc, w, true); o.y = (unsigned)w;
        w = __builtin_amdgcn_cvt_pk_fp8_f32(c.x * sc, c.y * sc, 0, false); w = __builtin_amdgcn_cvt_pk_fp8_f32(c.z * sc, c.w * sc, w, true); o.z = (unsigned)w;
        w = __builtin_amdgcn_cvt_pk_fp8_f32(d.x * sc, d.y * sc, 0, false); w = __builtin_amdgcn_cvt_pk_fp8_f32(d.z * sc, d.w * sc, w, true); o.w = (unsigned)w;
        *(u32x4*)(ws + (which ? WS_VB : WS_UB) + (size_t)(lane >> 3) * (16384 * 128) + (size_t)row * 128 + (lane & 7) * 16) = o;
        if (lane == 0) ((float*)(ws + (which ? WS_VS : WS_US)))[row] = mx * (1.0f / 224.0f);
    }
}

__device__ __forceinline__ int swz(int ob) { return ob ^ (((ob >> 9) & 1) << 5); }
constexpr int G_STAGE = 49152;
__device__ __forceinline__ void gemm_mainloop(f32x4 (&acc)[4][4], const bf16* __restrict__ A, int lda, const bf16* __restrict__ Bt, int ldb, int K, int m0, int n0, unsigned char* lds) {
    const int tid = threadIdx.x, lane = tid & 63, wid = tid >> 6, wm = wid >> 1, wn = wid & 1, fr = lane & 15, fq = lane >> 4;
    const int lrow = tid >> 3, lc = tid & 7;
    const bf16* ag = A + (size_t)(m0 + lrow) * lda + lc * 8;
    const bf16* bg = Bt + (size_t)(n0 + lrow) * ldb + lc * 8;
    const int woff = ((lrow >> 4) * 2 + (lc >> 2)) * 1024 + swz((lrow & 15) * 64 + (lc & 3) * 16);
    const int roff = swz(fr * 64 + fq * 16);
    const int nk = K >> 6;
    u32x4 ra0[4], rb0[2], ra1[4], rb1[2];
#define GM_LOAD(ra, rb, kt) { _Pragma("unroll") for (int i = 0; i < 4; ++i) ra[i] = *(const u32x4*)(ag + (size_t)i * 64 * lda + (kt) * 64); \
                              _Pragma("unroll") for (int i = 0; i < 2; ++i) rb[i] = *(const u32x4*)(bg + (size_t)i * 64 * ldb + (kt) * 64); }
#define GM_STORE(ra, rb, buf) { _Pragma("unroll") for (int i = 0; i < 4; ++i) *(u32x4*)((buf) + woff + i * 8192) = ra[i]; \
                                _Pragma("unroll") for (int i = 0; i < 2; ++i) *(u32x4*)((buf) + 32768 + woff + i * 8192) = rb[i]; }
#define GM_COMPUTE(cur) { _Pragma("unroll") for (int s = 0; s < 2; ++s) { bf16x8 af[4], bfr[4]; \
        _Pragma("unroll") for (int i = 0; i < 4; ++i) af[i] = *(const bf16x8*)((cur) + ((wm * 4 + i) * 2 + s) * 1024 + roff); \
        _Pragma("unroll") for (int i = 0; i < 4; ++i) bfr[i] = *(const bf16x8*)((cur) + 32768 + ((wn * 4 + i) * 2 + s) * 1024 + roff); \
        _Pragma("unroll") for (int mi = 0; mi < 4; ++mi) _Pragma("unroll") for (int ni = 0; ni < 4; ++ni) acc[mi][ni] = __builtin_amdgcn_mfma_f32_16x16x32_bf16(bfr[ni], af[mi], acc[mi][ni], 0, 0, 0); } }
    unsigned char* buf0 = lds; unsigned char* buf1 = lds + G_STAGE;
    GM_LOAD(ra0, rb0, 0)
    GM_LOAD(ra1, rb1, 1)
    GM_STORE(ra0, rb0, buf0)
    __syncthreads();
    for (int kt = 0; kt < nk; kt += 2) {
        { const int kp = (kt + 2 < nk) ? kt + 2 : kt; GM_LOAD(ra0, rb0, kp) }
        GM_COMPUTE(buf0)
        GM_STORE(ra1, rb1, buf1)
        __syncthreads();
        { const int kp = (kt + 3 < nk) ? kt + 3 : kt + 1; GM_LOAD(ra1, rb1, kp) }
        GM_COMPUTE(buf1)
        if (kt + 2 < nk) GM_STORE(ra0, rb0, buf0)
        __syncthreads();
    }
}
__device__ __forceinline__ void acc_zero(f32x4 (&acc)[4][4]) {
#pragma unroll
    for (int i = 0; i < 4; ++i)
#pragma unroll
        for (int j = 0; j < 4; ++j) acc[i][j] = (f32x4){0.f, 0.f, 0.f, 0.f};
}
namespace pg8 {
#define PG8_LAS __attribute__((address_space(3)))
typedef unsigned short bf16_t;
typedef short bf16x8 __attribute__((ext_vector_type(8)));
typedef float f32x4 __attribute__((ext_vector_type(4)));
typedef unsigned u32x4 __attribute__((ext_vector_type(4)));
constexpr int BM = 256, BK = 64, HALF = 128, HTB = HALF * BK * 2  , STAGE_BYTES = 8 * HTB, NXCD = 8, WGM = 8;

__host__ __device__ __forceinline__ int lds_byte(int r, int c) { const int st = (r >> 4) * 2 + (c >> 5), rr = r & 15, cc = c & 31, ob = rr * 64 + cc * 2; return st * 1024 + (ob ^ (((ob >> 9) & 1) << 5)); }
__host__ __device__ __forceinline__ void stage_rc(int b, int& R, int& C) { const int st = b / 1024, sb = b % 1024, swz = sb ^ (((sb >> 9) & 1) << 5); R = (st >> 1) * 16 + swz / 64; C = (st & 1) * 32 + (swz % 64) / 2; }
__host__ __device__ __forceinline__ int perm32(int rho) { const int n = rho >> 4, i = rho & 15; return 8 * (i >> 2) + 4 * n + (i & 3); }

struct Unit { int pm, pn; };
struct Gemm { const bf16_t* A; const bf16_t* Bt; int M, N, K; };

struct StaticOrder {
    int nM, nN, nwg, G, c;
    __host__ __device__ void init(int M, int N, int G_, int c_) { nM = M / BM; nN = N / BM; nwg = nM * nN; G = G_; c = c_; }
    __host__ __device__ bool next(int i, Unit& u) const {
        const long L = (long)i * G + c; if (L >= nwg) return false;
        int wgid = (int)L; { const int q = nwg / NXCD, r = nwg % NXCD, xcd = wgid % NXCD, off = wgid / NXCD; wgid = (xcd < r ? xcd * (q + 1) : r * (q + 1) + (xcd - r) * q) + off; }
        const int nig = WGM * nN, gid = wgid / nig, fm = gid * WGM, gsz = (nM - fm) < WGM ? (nM - fm) : WGM;
        u.pm = fm + ((wgid % nig) % gsz); u.pn = (wgid % nig) / gsz; return true;
    }
    __device__ __forceinline__ void a_ready(const Unit&) const {}
    __device__ __forceinline__ void done(const Unit&) const {}
};

__device__ __forceinline__ unsigned pk2b(float lo, float hi) { typedef __bf16 b2 __attribute__((ext_vector_type(2))); b2 v = { (__bf16)lo, (__bf16)hi }; return __builtin_bit_cast(unsigned, v); }
typedef unsigned u32x2 __attribute__((ext_vector_type(2)));
struct EpiStoreBf16 {
    static constexpr bool PERM = false, AFTER_DRAIN = false;
    bf16_t* C; int ldc; int ncols;
    __device__ __forceinline__ void operator()(const f32x4 (&acc)[2][2][4][2], const Unit& u, int wr, int wc, int fr, int fq) const {
#pragma unroll
        for (int ai = 0; ai < 2; ++ai)
#pragma unroll
            for (int m = 0; m < 4; ++m) { bf16_t* rowp = C + (size_t)(u.pm * BM + ai * HALF + wr * 64 + m * 16 + fr) * ldc;
#pragma unroll
                for (int bj = 0; bj < 2; ++bj)
#pragma unroll
                    for (int n = 0; n < 2; ++n) { const int col = u.pn * BM + bj * HALF + wc * 32 + n * 16 + fq * 4;
                        if (col < ncols) { u32x2 w; w.x = pk2b(acc[ai][bj][m][n][0], acc[ai][bj][m][n][1]); w.y = pk2b(acc[ai][bj][m][n][2], acc[ai][bj][m][n][3]); *(u32x2*)(rowp + col) = w; } } }
    }
};
struct EpiResidF32 {
    static constexpr bool PERM = false, AFTER_DRAIN = false;
    const float* X; float* O; int ld; int pad;
    __device__ __forceinline__ void operator()(const f32x4 (&acc)[2][2][4][2], const Unit& u, int wr, int wc, int fr, int fq) const {
#pragma unroll
        for (int ai = 0; ai < 2; ++ai)
#pragma unroll
            for (int m = 0; m < 4; ++m) { const size_t ro = (size_t)(u.pm * BM + ai * HALF + wr * 64 + m * 16 + fr) * ld;
#pragma unroll
                for (int bj = 0; bj < 2; ++bj)
#pragma unroll
                    for (int n = 0; n < 2; ++n) { const size_t idx = ro + u.pn * BM + bj * HALF + wc * 32 + n * 16 + fq * 4; *(f32x4*)(O + idx) = *(const f32x4*)(X + idx) + acc[ai][bj][m][n]; } }
    }
};
struct EpiFinalGate {
    static constexpr bool PERM = false, AFTER_DRAIN = false;
    const bf16_t* PL; const float* SSQ; float* O; int ld; int ntok; float eps; int pad;
    __device__ __forceinline__ void operator()(const f32x4 (&acc)[2][2][4][2], const Unit& u, int wr, int wc, int fr, int fq) const {
#pragma unroll
        for (int ai = 0; ai < 2; ++ai)
#pragma unroll
            for (int m = 0; m < 4; ++m) { const int row = u.pm * BM + ai * HALF + wr * 64 + m * 16 + fr; const size_t ro = (size_t)row * ld;
                float tot = 0.f;
#pragma unroll
                for (int x = 0; x < 8; ++x) tot += SSQ[(size_t)x * ntok + row];
                const float rs = 1.0f / sqrtf(tot * (1.0f / 1024.0f) + eps);
#pragma unroll
                for (int bj = 0; bj < 2; ++bj)
#pragma unroll
                    for (int n = 0; n < 2; ++n) { const size_t idx = ro + u.pn * BM + bj * HALF + wc * 32 + n * 16 + fq * 4;
                        const u32x2 pw = *(const u32x2*)(PL + idx); const unsigned px = pw.x, py = pw.y;
                        f32x4 pv; pv.x = __uint_as_float(px << 16); pv.y = __uint_as_float(px & 0xffff0000u); pv.z = __uint_as_float(py << 16); pv.w = __uint_as_float(py & 0xffff0000u);
                        f32x4 g;
#pragma unroll
                        for (int e = 0; e < 4; ++e) g[e] = 1.0f / (1.0f + __expf(-rs * acc[ai][bj][m][n][e]));
                        *(f32x4*)(O + idx) = *(const f32x4*)(O + idx) + pv * g; } }
    }
};

template <class Epi, class Sched, bool ALIGN_EPI = false, bool SP2 = false>
__device__ __forceinline__ void gemm_phase(PG8_LAS unsigned char* lds, const Gemm g, const Sched& S, const Epi& E) {
    const int tid = threadIdx.x, wid = __builtin_amdgcn_readfirstlane(tid >> 6), lane = tid & 63, wr = wid >> 2, wc = wid & 3, fr = lane & 15, fq = lane >> 4;
    const int K = g.K, nt = K / BK;
    unsigned voffA[2], voffB[2];
#pragma unroll
    for (int i = 0; i < 2; ++i) { int R, C; stage_rc(tid * 16 + i * 8192, R, C); const int Rb = Epi::PERM ? ((R & ~31) + perm32(R & 31)) : R;
        voffA[i] = (unsigned)(R * K + C) * 2u; voffB[i] = (unsigned)(Rb * K + C) * 2u; }
    const size_t kstep = (size_t)(BK * 2);
    const size_t hstep = (size_t)HALF * K * 2;
    const size_t tstep = 2 * hstep;
    const unsigned ldsw = (unsigned)wid * 1024u;
    const int aoff = lds_byte(wr * 64 + fr, fq * 8), boff = lds_byte(wc * 32 + fr, fq * 8);
#define PG8_SA(b, h) (((b) * 2 + (h)) * HTB)
#define PG8_SB(b, h) ((4 + (b) * 2 + (h)) * HTB)
#define PG8_STAGE(bufoff, gbase, voff) do { _Pragma("unroll") for (int _i = 0; _i < 2; ++_i) \
        __builtin_amdgcn_global_load_lds((const unsigned*)((const char*)(gbase) + (voff)[_i]), (PG8_LAS unsigned*)(lds + (bufoff) + ldsw + _i * 8192), 16, 0, 0); } while (0)
#define PG8_LDA(dst, b, h) do { _Pragma("unroll") for (int m = 0; m < 4; ++m) _Pragma("unroll") for (int k = 0; k < 2; ++k) dst[m][k] = *(const PG8_LAS bf16x8*)(lds + PG8_SA(b, h) + aoff + m * 2048 + k * 1024); } while (0)
#define PG8_LDB(dst, b, h) do { _Pragma("unroll") for (int n = 0; n < 2; ++n) _Pragma("unroll") for (int k = 0; k < 2; ++k) dst[n][k] = *(const PG8_LAS bf16x8*)(lds + PG8_SB(b, h) + boff + n * 2048 + k * 1024); } while (0)
#define PG8_MMA(ai, bj, At, Bt) do { __builtin_amdgcn_s_setprio(1); _Pragma("unroll") for (int m = 0; m < 4; ++m) _Pragma("unroll") for (int n = 0; n < 2; ++n) _Pragma("unroll") for (int k = 0; k < 2; ++k) \
        acc[ai][bj][m][n] = __builtin_amdgcn_mfma_f32_16x16x32_bf16(Bt[n][k], At[m][k], acc[ai][bj][m][n], 0, 0, 0); __builtin_amdgcn_s_setprio(0); } while (0)
#define PG8_WAIT_V(n) asm volatile("s_waitcnt vmcnt(" #n ")" ::: "memory")
#define PG8_WAIT_L(n) asm volatile("s_waitcnt lgkmcnt(" #n ")" ::: "memory")
#define PG8_BAR __builtin_amdgcn_s_barrier()
#define PG8_SCHED __builtin_amdgcn_sched_barrier(0)
    Unit cur, nxt; int ui = 0;
    if (!S.next(0, cur)) return;
    f32x4 acc[2][2][4][2];
#pragma unroll
    for (int a = 0; a < 2; ++a)
#pragma unroll
        for (int b = 0; b < 2; ++b)
#pragma unroll
            for (int m = 0; m < 4; ++m)
#pragma unroll
                for (int n = 0; n < 2; ++n) acc[a][b][m][n] = (f32x4){0.f, 0.f, 0.f, 0.f};
    bf16x8 At[4][2], B0[2][2], B1[2][2];
    const char* cA = (const char*)g.A + (size_t)cur.pm * tstep; const char* cB = (const char*)g.Bt + (size_t)cur.pn * tstep;
    S.a_ready(cur);
    if constexpr (SP2) {
        PG8_STAGE(PG8_SB(0, 0), cB, voffB); PG8_STAGE(PG8_SB(0, 1), cB + hstep, voffB); PG8_STAGE(PG8_SA(0, 0), cA, voffA); PG8_STAGE(PG8_SA(0, 1), cA + hstep, voffA);
        if (wr == 1) PG8_BAR;
        PG8_WAIT_V(2); PG8_BAR;
        PG8_STAGE(PG8_SB(1, 0), cB + kstep, voffB); PG8_STAGE(PG8_SA(1, 0), cA + kstep, voffA); PG8_STAGE(PG8_SB(1, 1), cB + hstep + kstep, voffB);
        PG8_WAIT_V(6); PG8_BAR;
    } else {
        PG8_STAGE(PG8_SB(0, 0), cB, voffB); PG8_STAGE(PG8_SA(0, 0), cA, voffA); PG8_STAGE(PG8_SB(0, 1), cB + hstep, voffB); PG8_STAGE(PG8_SA(0, 1), cA + hstep, voffA);
        if (wr == 1) PG8_BAR;
        PG8_WAIT_V(4); PG8_BAR;
        PG8_STAGE(PG8_SB(1, 0), cB + kstep, voffB); PG8_STAGE(PG8_SA(1, 0), cA + kstep, voffA); PG8_STAGE(PG8_SB(1, 1), cB + hstep + kstep, voffB);
        PG8_WAIT_V(6); PG8_BAR;
    }
    for (;;) {
        const bool has_next = S.next(ui + 1, nxt);
        const char* nA = has_next ? (const char*)g.A + (size_t)nxt.pm * tstep : cA; const char* nB = has_next ? (const char*)g.Bt + (size_t)nxt.pn * tstep : cB;
        for (int t = 0; t < nt; t += 2) {
            const bool last = (t == nt - 2);
            const char* a1 = cA + (size_t)(t + 1) * kstep;
            const char* a2 = last ? nA : cA + (size_t)(t + 2) * kstep; const char* b2 = last ? nB : cB + (size_t)(t + 2) * kstep;
            const char* a3 = a2 + kstep; const char* b3 = b2 + kstep;
            if (last && has_next) S.a_ready(nxt);
            if constexpr (SP2) {
            PG8_LDB(B0, 0, 0); PG8_LDB(B1, 0, 1); PG8_SCHED; PG8_LDA(At, 0, 0); PG8_STAGE(PG8_SA(1, 1), a1 + hstep, voffA);
            PG8_WAIT_V(8); PG8_WAIT_L(0); PG8_BAR; PG8_MMA(0, 0, At, B0); PG8_MMA(0, 1, At, B1); PG8_BAR; PG8_SCHED;
            PG8_LDA(At, 0, 1); PG8_STAGE(PG8_SB(0, 0), b2, voffB); PG8_STAGE(PG8_SB(0, 1), b2 + hstep, voffB); PG8_STAGE(PG8_SA(0, 0), a2, voffA);
            PG8_WAIT_V(8); PG8_WAIT_L(0); PG8_BAR; PG8_MMA(1, 0, At, B0); PG8_MMA(1, 1, At, B1); PG8_BAR; PG8_SCHED;
            PG8_LDB(B0, 1, 0); PG8_LDB(B1, 1, 1); PG8_SCHED; PG8_LDA(At, 1, 0); PG8_STAGE(PG8_SA(0, 1), a2 + hstep, voffA);
            PG8_WAIT_V(8); PG8_WAIT_L(0); PG8_BAR; PG8_MMA(0, 0, At, B0); PG8_MMA(0, 1, At, B1); PG8_BAR; PG8_SCHED;
            PG8_LDA(At, 1, 1); PG8_STAGE(PG8_SB(1, 0), b3, voffB); PG8_STAGE(PG8_SB(1, 1), b3 + hstep, voffB); PG8_STAGE(PG8_SA(1, 0), a3, voffA);
            PG8_WAIT_V(8); PG8_WAIT_L(0); PG8_BAR; PG8_MMA(1, 0, At, B0); PG8_MMA(1, 1, At, B1); PG8_BAR; PG8_SCHED;
            } else {
            PG8_LDB(B0, 0, 0); PG8_SCHED; PG8_LDA(At, 0, 0); PG8_STAGE(PG8_SA(1, 1), a1 + hstep, voffA);
            PG8_WAIT_L(8); PG8_BAR; PG8_WAIT_L(0); PG8_MMA(0, 0, At, B0); PG8_BAR; PG8_SCHED;
            PG8_LDB(B1, 0, 1); PG8_STAGE(PG8_SB(0, 0), b2, voffB);
            PG8_BAR; PG8_WAIT_L(0); PG8_MMA(0, 1, At, B1); PG8_BAR;
            PG8_LDA(At, 0, 1); PG8_STAGE(PG8_SA(0, 0), a2, voffA);
            PG8_BAR; PG8_WAIT_L(0); PG8_MMA(1, 0, At, B0); PG8_BAR; PG8_SCHED;
            PG8_STAGE(PG8_SB(0, 1), b2 + hstep, voffB);
            PG8_WAIT_V(6); PG8_BAR; PG8_MMA(1, 1, At, B1); PG8_BAR;
            PG8_LDB(B0, 1, 0); PG8_SCHED; PG8_LDA(At, 1, 0); PG8_STAGE(PG8_SA(0, 1), a2 + hstep, voffA);
            PG8_WAIT_L(8); PG8_BAR; PG8_WAIT_L(0); PG8_MMA(0, 0, At, B0); PG8_BAR; PG8_SCHED;
            PG8_LDB(B1, 1, 1); PG8_STAGE(PG8_SB(1, 0), b3, voffB);
            PG8_BAR; PG8_WAIT_L(0); PG8_MMA(0, 1, At, B1); PG8_BAR;
            PG8_LDA(At, 1, 1); PG8_STAGE(PG8_SA(1, 0), a3, voffA);
            PG8_BAR; PG8_WAIT_L(0); PG8_MMA(1, 0, At, B0); PG8_BAR; PG8_SCHED;
            PG8_STAGE(PG8_SB(1, 1), b3 + hstep, voffB);
            PG8_WAIT_V(6); PG8_BAR; PG8_MMA(1, 1, At, B1); PG8_BAR;
            }
        }
        if constexpr (ALIGN_EPI) { if (wr == 0) PG8_BAR; }
        if constexpr (!Epi::AFTER_DRAIN) { E(acc, cur, wr, wc, fr, fq); S.done(cur); }
        if (!has_next) break;
#pragma unroll
        for (int a = 0; a < 2; ++a)
#pragma unroll
            for (int b = 0; b < 2; ++b)
#pragma unroll
                for (int m = 0; m < 4; ++m)
#pragma unroll
                    for (int n = 0; n < 2; ++n) acc[a][b][m][n] = (f32x4){0.f, 0.f, 0.f, 0.f};
        cur = nxt; cA = nA; cB = nB; ++ui;
        if constexpr (ALIGN_EPI) { if (wr == 1) PG8_BAR; }
    }
    PG8_WAIT_V(0);
    if constexpr (!ALIGN_EPI) { if (wr == 0) PG8_BAR; }
    PG8_BAR;
    if constexpr (Epi::AFTER_DRAIN) { E.fused(acc, cur, wr, wc, fr, fq, lds, wid, lane); S.done(cur); }
#undef PG8_SA
#undef PG8_SB
#undef PG8_STAGE
#undef PG8_LDA
#undef PG8_LDB
#undef PG8_MMA
#undef PG8_WAIT_V
#undef PG8_WAIT_L
#undef PG8_BAR
#undef PG8_SCHED
}
}

__device__ __forceinline__ void phase1(const Params& p, unsigned char* lds) {
    pg8::Gemm g{(const bf16*)(p.ws + WS_ACT), (const bf16*)(p.ws + WS_WINT), NTOK, 3584, D}; pg8::StaticOrder S; S.init(NTOK, 3584, (int)gridDim.x, (int)blockIdx.x);
    pg8::EpiStoreBf16 E{(bf16*)(p.ws + WS_PROJ), PS, DIN};
    pg8::gemm_phase<pg8::EpiStoreBf16, pg8::StaticOrder, true, true>((PG8_LAS unsigned char*)lds, g, S, E);
}


__device__ __forceinline__ void phase5(const Params& p, unsigned char* lds) {
    pg8::Gemm g{(const bf16*)(p.ws + WS_ACT), (const bf16*)(p.ws + WS_WOUTT), NTOK, D, D}; pg8::StaticOrder S; S.init(NTOK, D, (int)gridDim.x, (int)blockIdx.x);
    pg8::EpiResidF32 E{p.in[0], p.out, D, 0};
    pg8::gemm_phase<pg8::EpiResidF32, pg8::StaticOrder, true, true>((PG8_LAS unsigned char*)lds, g, S, E);
}
__device__ __forceinline__ void phase6(const Params& p, unsigned char* lds) {
    const int gw = (blockIdx.x * NTHR + threadIdx.x) >> 6, ngw = (gridDim.x * NTHR) >> 6, lane = threadIdx.x & 63;
    for (int m = gw; m < NTOK; m += ngw) rms_row_bf16(p.out + (size_t)m * D, p.in[13], (bf16*)(p.ws + WS_ACT) + (size_t)m * D, lane);
}
__device__ __forceinline__ void phase7(const Params& p, unsigned char* lds) {
    pg8::Gemm g{(const bf16*)(p.ws + WS_ACT), (const bf16*)(p.ws + WS_WQT), NTOK, 2048, D}; pg8::StaticOrder S; S.init(NTOK, 2048, (int)gridDim.x, (int)blockIdx.x);
    pg8::EpiStoreBf16 E{(bf16*)(p.ws + WS_PROJ), 2048, 2048};
    pg8::gemm_phase<pg8::EpiStoreBf16, pg8::StaticOrder, true, true>((PG8_LAS unsigned char*)lds, g, S, E);
}
__device__ __forceinline__ void phase10(const Params& p, unsigned char* lds) {
    {
        pg8::Gemm g{(const bf16*)(p.ws + WS_PB), (const bf16*)(p.ws + WS_WPT), NTOK, D, 256}; pg8::StaticOrder S; S.init(NTOK, D, (int)gridDim.x, (int)blockIdx.x);
        pg8::EpiStoreBf16 E{(bf16*)(p.ws + WS_ACT), D, D};
        pg8::gemm_phase<pg8::EpiStoreBf16, pg8::StaticOrder, true, true>((PG8_LAS unsigned char*)lds, g, S, E);
    }
    {
        pg8::Gemm g{(const bf16*)(p.ws + WS_PROJ + 64 * MiB), (const bf16*)(p.ws + WS_WGT), NTOK, D, D}; pg8::StaticOrder S; S.init(NTOK, D, (int)gridDim.x, (int)blockIdx.x);
        pg8::EpiFinalGate E{(const bf16*)(p.ws + WS_ACT), (const float*)(p.ws + WS_SSQ), p.out, D, NTOK, EPS, 0};
        pg8::gemm_phase<pg8::EpiFinalGate, pg8::StaticOrder, true, true>((PG8_LAS unsigned char*)lds, g, S, E);
    }
}

typedef __bf16 bf16x2v __attribute__((ext_vector_type(2)));
template <int CTRL> __device__ __forceinline__ float dpp_f(float v) { return __int_as_float(__builtin_amdgcn_update_dpp(0, __float_as_int(v), CTRL, 0xF, 0xF, false)); }
__device__ __forceinline__ float grp16_max(float v) { v = fmaxf(v, dpp_f<0xB1>(v)); v = fmaxf(v, dpp_f<0x4E>(v)); v = fmaxf(v, dpp_f<0x141>(v)); v = fmaxf(v, dpp_f<0x140>(v)); return v; }
__device__ __forceinline__ float grp16_sum(float v) { v += dpp_f<0xB1>(v); v += dpp_f<0x4E>(v); v += dpp_f<0x141>(v); v += dpp_f<0x140>(v); return v; }
#define CE_DESC(a, b) { const float _hi = fmaxf(a, b), _lo = fminf(a, b); a = _hi; b = _lo; }
__device__ __forceinline__ float grp16_top16(float (&v)[8], int lig) {
    CE_DESC(v[0], v[1]) CE_DESC(v[2], v[3]) CE_DESC(v[4], v[5]) CE_DESC(v[6], v[7])
    CE_DESC(v[0], v[2]) CE_DESC(v[1], v[3]) CE_DESC(v[4], v[6]) CE_DESC(v[5], v[7])
    CE_DESC(v[1], v[2]) CE_DESC(v[5], v[6])
    CE_DESC(v[0], v[4]) CE_DESC(v[1], v[5]) CE_DESC(v[2], v[6]) CE_DESC(v[3], v[7])
    CE_DESC(v[2], v[4]) CE_DESC(v[3], v[5])
    CE_DESC(v[1], v[2]) CE_DESC(v[3], v[4]) CE_DESC(v[5], v[6])
    float top = 0.f;
#pragma unroll
    for (int r = 0; r < 16; ++r) {
        const float m = grp16_max(v[0]);
        if (lig == r) top = m;
        const bool own = (v[0] == m);
#pragma unroll
        for (int j = 0; j < 7; ++j) v[j] = own ? v[j + 1] : v[j];
        v[7] = own ? -3.0e38f : v[7];
    }
    return top;
}
__device__ __forceinline__ void phase8(const Params& p, unsigned char* lds) {
    const bf16* PQ = (const bf16*)(p.ws + WS_PROJ); const bf16* KB = (const bf16*)(p.ws + WS_KEYB);
    int* ids = (int*)(p.ws + WS_IDS); float* wts = (float*)(p.ws + WS_WTS);
    float* S = (float*)lds;
    const int tid = threadIdx.x, lane = tid & 63, wid = tid >> 6, lig = tid & 15, gbase = lane & 48;
    for (int item = blockIdx.x; item < 2048; item += gridDim.x) {
        const int tok0 = (item >> 3) * 64, h = item & 7;
        {
            const int c = wid >> 2, key0 = (wid & 3) * 32, r = lane & 31, hh = lane >> 5;
            f32x16 acc0, acc1;
#pragma unroll
            for (int i = 0; i < 16; ++i) { acc0[i] = 0.f; acc1[i] = 0.f; }
            const bf16* bq = KB + ((size_t)(h * 2 + c) * 128 + key0 + r) * 128 + hh * 8;
            const bf16* aq0 = PQ + (size_t)(tok0 + r) * 2048 + h * 256 + c * 128 + hh * 8;
            const bf16* aq1 = aq0 + (size_t)32 * 2048;
#pragma unroll
            for (int s = 0; s < 8; ++s) {
                const bf16x8 b = *(const bf16x8*)(bq + s * 16), a0 = *(const bf16x8*)(aq0 + s * 16), a1 = *(const bf16x8*)(aq1 + s * 16);
                acc0 = __builtin_amdgcn_mfma_f32_32x32x16_bf16(a0, b, acc0, 0, 0, 0);
                acc1 = __builtin_amdgcn_mfma_f32_32x32x16_bf16(a1, b, acc1, 0, 0, 0);
            }
#pragma unroll
            for (int i = 0; i < 16; ++i) { const int tl = (i & 3) + 8 * (i >> 2) + 4 * hh; S[(c * 64 + tl) * 132 + key0 + r] = acc0[i]; S[(c * 64 + 32 + tl) * 132 + key0 + r] = acc1[i]; }
        }
        __syncthreads();
        {
            const int tl0 = tid >> 4;
            float ts[2][2];
#pragma unroll
            for (int rd = 0; rd < 2; ++rd)
#pragma unroll
                for (int c = 0; c < 2; ++c) {
                    float v[8];
                    const float* sp = S + (c * 64 + tl0 + 32 * rd) * 132 + lig * 8;
                    const f32x4 lo = *(const f32x4*)sp, hi = *(const f32x4*)(sp + 4);
                    v[0] = lo.x; v[1] = lo.y; v[2] = lo.z; v[3] = lo.w; v[4] = hi.x; v[5] = hi.y; v[6] = hi.z; v[7] = hi.w;
#pragma unroll
                    for (int j = 0; j < 8; ++j) v[j] = __uint_as_float((__float_as_uint(v[j]) & ~127u) | (unsigned)(lig * 8 + j));
                    ts[rd][c] = grp16_top16(v, lig);
                }
            int bp[2] = {0, 0}; float my_s[2] = {0.f, 0.f}; int my_eid[2] = {0, 0};
#pragma unroll 4
            for (int r = 0; r < 16; ++r) {
#pragma unroll
                for (int rd = 0; rd < 2; ++rd) {
                    const float other = __shfl(ts[rd][1], gbase + (bp[rd] < 15 ? bp[rd] : 15));
                    const float sum = ts[rd][0] + other;
                    const float head = (bp[rd] >= 16) ? -3.0e38f : __uint_as_float((__float_as_uint(sum) & ~15u) | (unsigned)lig);
                    const int cur_eid = (int)(((__float_as_uint(ts[rd][0]) & 127u) << 7) | (__float_as_uint(other) & 127u));
                    const float m = grp16_max(head);
                    const int owner = (int)(__float_as_uint(m) & 15u);
                    const int ew = __shfl(cur_eid, gbase + owner);
                    if (lig == r) { my_s[rd] = m; my_eid[rd] = ew; }
                    if (lig == owner) ++bp[rd];
                }
            }
#pragma unroll
            for (int rd = 0; rd < 2; ++rd) {
                const int tl = tl0 + 32 * rd;
                const float mx = grp16_max(my_s[rd]);
                const float e = __expf(my_s[rd] - mx);
                const float sm = grp16_sum(e);
                const size_t o = (size_t)(tok0 + tl) * 128 + h * 16 + lig;
                ((unsigned short*)ids)[(size_t)(tok0 + tl) * 128 + (h >> 2) * 64 + (lig & 7) * 8 + (h & 3) * 2 + (lig >> 3)] = (unsigned short)my_eid[rd]; wts[o] = e / sm;
            }
        }
        __syncthreads();
    }
}

__device__ __forceinline__ void hgrn_pre_item(const Params& p, unsigned char* lds, int ci) {
    const int tid = threadIdx.x, lane = tid & 63, wid = tid >> 6, k = tid & 127, tq = tid >> 7;
    const int n = ci & 127, h = (ci >> 7) & 3, b = ci >> 9, tok0 = b * T + n * 64;
    bf16* proj = (bf16*)(p.ws + WS_PROJ);
    float* OB = p.out; bf16* KIT = (bf16*)((unsigned char*)p.out + OUT_KIT) + (size_t)ci * 8192; bf16* VTg = (bf16*)((unsigned char*)p.out + OUT_VT) + (size_t)ci * 8192;
    float* DEC = (float*)(p.ws + WS_DEC) + (size_t)ci * 128;
    bf16* QT = (bf16*)lds; bf16* KT = (bf16*)(lds + 17408); bf16* VTl = (bf16*)(lds + 34816); bf16* AM = (bf16*)(lds + 53248);
    float* part = (float*)(lds + 62464); float* gref = (float*)(lds + 64512);
    float lb; { const float l0 = p.in[4][h * 128 + k], l1 = p.in[4][512 + h * 128 + k]; const float m = fmaxf(l0, l1); const float e0 = __expf(l0 - m), e1 = __expf(l1 - m); lb = e0 / (e0 + e1); }
    float G[16], key[16], qv[16], vv[16];
    {
        float c = 0.f;
#pragma unroll
        for (int i = 0; i < 16; ++i) {
            const size_t row = (size_t)(tok0 + tq * 16 + i) * PS;
            const float fg = lb + (1.0f - lb) * sigmoidf_(bf2f(proj[row + C_HF + h * 128 + k]));
            key[i] = 1.0f - fg; c += __logf(fg); G[i] = c;
            qv[i] = siluf_(bf2f(proj[row + C_HQ + h * 128 + k])) * 0.08838834764831845f;
            vv[i] = bf2f(proj[row + C_HI + h * 128 + k]);
        }
        part[tq * 128 + k] = c;
    }
    __syncthreads();
    {
        float off = 0.f;
#pragma unroll
        for (int j = 0; j < 3; ++j) off += (j < tq) ? part[j * 128 + k] : 0.f;
#pragma unroll
        for (int i = 0; i < 16; ++i) G[i] += off;
        if (tq == 1) gref[k] = G[15];
        if (tq == 3) gref[128 + k] = G[15];
    }
    __syncthreads();
    {
        const float gr = gref[k], gl = gref[128 + k];
        const int kpos = (k & ~31) | (((k >> 2) & 3) << 3) | (((k >> 4) & 1) << 2) | (k & 3);
        unsigned kp[8], vp[8];
#pragma unroll
        for (int i = 0; i < 16; i += 2) {
            kp[i >> 1] = pk2(key[i] * __expf(gl - G[i]), key[i + 1] * __expf(gl - G[i + 1]));
            vp[i >> 1] = pk2(vv[i], vv[i + 1]);
        }
#pragma unroll
        for (int i = 0; i < 16; ++i) {
            const int t = tq * 16 + i;
            QT[t * 136 + k] = f2bf(qv[i] * __expf(G[i] - gr));
            KT[t * 136 + k] = f2bf(key[i] * __expf(gr - G[i]));
            proj[(size_t)(tok0 + t) * PS + C_HQ + h * 128 + kpos] = f2bf(qv[i] * __expf(G[i]));
        }
        u32x4 a0, a1, b0, b1; a0.x = kp[0]; a0.y = kp[1]; a0.z = kp[2]; a0.w = kp[3]; a1.x = kp[4]; a1.y = kp[5]; a1.z = kp[6]; a1.w = kp[7];
        b0.x = vp[0]; b0.y = vp[1]; b0.z = vp[2]; b0.w = vp[3]; b1.x = vp[4]; b1.y = vp[5]; b1.z = vp[6]; b1.w = vp[7];
        *(u32x4*)(KIT + k * 64 + tq * 16) = a0; *(u32x4*)(KIT + k * 64 + tq * 16 + 8) = a1;
        *(u32x4*)(VTg + k * 64 + tq * 16) = b0; *(u32x4*)(VTg + k * 64 + tq * 16 + 8) = b1;
        *(u32x4*)(VTl + k * 72 + tq * 16) = b0; *(u32x4*)(VTl + k * 72 + tq * 16 + 8) = b1;
        if (tq == 3) DEC[k] = __expf(gl);
    }
    __syncthreads();
    const int fr = lane & 15, fq = lane >> 4;
    {
        const int tt = wid >> 1;
#pragma unroll
        for (int e = 0; e < 2; ++e) {
            const int st = 2 * (wid & 1) + e;
            f32x4 acc = (f32x4){0.f, 0.f, 0.f, 0.f};
            if (st <= tt) {
#pragma unroll
                for (int s = 0; s < 4; ++s) {
                    const bf16x8 a = *(const bf16x8*)(QT + (tt * 16 + fr) * 136 + s * 32 + fq * 8), bb = *(const bf16x8*)(KT + (st * 16 + fr) * 136 + s * 32 + fq * 8);
                    acc = __builtin_amdgcn_mfma_f32_16x16x32_bf16(a, bb, acc, 0, 0, 0);
                }
            }
#pragma unroll
            for (int r = 0; r < 4; ++r) { const int t = tt * 16 + fq * 4 + r, sp = st * 16 + fr; AM[t * 72 + sp] = f2bf(sp <= t ? acc[r] : 0.f); }
        }
    }
    __syncthreads();
    {
        const int tt = wid >> 1;
        const bf16x8 a0 = *(const bf16x8*)(AM + (tt * 16 + fr) * 72 + fq * 8), a1 = *(const bf16x8*)(AM + (tt * 16 + fr) * 72 + 32 + fq * 8);
#pragma unroll
        for (int e = 0; e < 4; ++e) {
            const int vt = (wid & 1) * 4 + e;
            const bf16x8 b0 = *(const bf16x8*)(VTl + (vt * 16 + fr) * 72 + fq * 8), b1 = *(const bf16x8*)(VTl + (vt * 16 + fr) * 72 + 32 + fq * 8);
            f32x4 acc = (f32x4){0.f, 0.f, 0.f, 0.f};
            acc = __builtin_amdgcn_mfma_f32_16x16x32_bf16(a0, b0, acc, 0, 0, 0);
            acc = __builtin_amdgcn_mfma_f32_16x16x32_bf16(a1, b1, acc, 0, 0, 0);
#pragma unroll
            for (int r = 0; r < 4; ++r) OB[(size_t)(tok0 + tt * 16 + fq * 4 + r) * 512 + h * 128 + vt * 16 + fr] = acc[r];
        }
    }
    __syncthreads();
}
template <bool DUMMY>
__device__ __forceinline__ void hgrn_scan_item(const Params& p, int wi) {
    const int lane = threadIdx.x & 63, fr = lane & 15, fq = lane >> 4;
    const int vs = wi & 7, bh = wi >> 3, h = bh & 3, b = bh >> 2;
    const bf16* proj = (const bf16*)(p.ws + WS_PROJ);
    float* OB = p.out; const bf16* KIT = (const bf16*)((unsigned char*)p.out + OUT_KIT); const bf16* VTg = (const bf16*)((unsigned char*)p.out + OUT_VT);
    const float* DEC = (const float*)(p.ws + WS_DEC);
    f32x4 S[8];
#pragma unroll
    for (int i = 0; i < 8; ++i) S[i] = (f32x4){0.f, 0.f, 0.f, 0.f};
#pragma unroll 1
    for (int n = 0; n < 128; ++n) {
        const int ci = bh * 128 + n, tok0 = b * T + n * 64;
        bf16x8 qf[4][4];
#pragma unroll
        for (int tt = 0; tt < 4; ++tt)
#pragma unroll
            for (int s = 0; s < 4; ++s) qf[tt][s] = *(const bf16x8*)(proj + (size_t)(tok0 + tt * 16 + fr) * PS + C_HQ + h * 128 + s * 32 + fq * 8);
        float oin[4][4];
#pragma unroll
        for (int tt = 0; tt < 4; ++tt)
#pragma unroll
            for (int r = 0; r < 4; ++r) oin[tt][r] = OB[(size_t)(tok0 + tt * 16 + fq * 4 + r) * 512 + h * 128 + vs * 16 + fr];
        bf16x8 Sb[4];
#pragma unroll
        for (int s = 0; s < 4; ++s) {
            u32x4 w; w.x = pk2(S[2 * s][0], S[2 * s][1]); w.y = pk2(S[2 * s][2], S[2 * s][3]); w.z = pk2(S[2 * s + 1][0], S[2 * s + 1][1]); w.w = pk2(S[2 * s + 1][2], S[2 * s + 1][3]);
            Sb[s] = __builtin_bit_cast(bf16x8, w);
        }
#pragma unroll
        for (int tt = 0; tt < 4; ++tt) {
            f32x4 acc = (f32x4){0.f, 0.f, 0.f, 0.f};
#pragma unroll
            for (int s = 0; s < 4; ++s) acc = __builtin_amdgcn_mfma_f32_16x16x32_bf16(qf[tt][s], Sb[s], acc, 0, 0, 0);
#pragma unroll
            for (int r = 0; r < 4; ++r) { const size_t oi = (size_t)(tok0 + tt * 16 + fq * 4 + r) * 512 + h * 128 + vs * 16 + fr; if (DUMMY) ((float*)(p.ws + WS_SPARE))[oi & 0x3fffff] = oin[tt][r] + acc[r]; else OB[oi] = oin[tt][r] + acc[r]; }
        }
        const bf16x8 v0 = *(const bf16x8*)(VTg + (size_t)ci * 8192 + (vs * 16 + fr) * 64 + fq * 8), v1 = *(const bf16x8*)(VTg + (size_t)ci * 8192 + (vs * 16 + fr) * 64 + 32 + fq * 8);
#pragma unroll
        for (int kb = 0; kb < 8; ++kb) {
            const bf16x8 k0 = *(const bf16x8*)(KIT + (size_t)ci * 8192 + (kb * 16 + fr) * 64 + fq * 8), k1 = *(const bf16x8*)(KIT + (size_t)ci * 8192 + (kb * 16 + fr) * 64 + 32 + fq * 8);
            const f32x4 dv = *(const f32x4*)(DEC + (size_t)ci * 128 + kb * 16 + fq * 4);
            f32x4 sacc = S[kb] * dv;
            sacc = __builtin_amdgcn_mfma_f32_16x16x32_bf16(k0, v0, sacc, 0, 0, 0);
            sacc = __builtin_amdgcn_mfma_f32_16x16x32_bf16(k1, v1, sacc, 0, 0, 0);
            S[kb] = sacc;
        }
    }
}

__device__ __forceinline__ void hgrn_scan_block(const Params& p, unsigned char* lds, int sb) {
    const int tid = threadIdx.x, lane = tid & 63, wid = __builtin_amdgcn_readfirstlane(tid >> 6), fr = lane & 15, fq = lane >> 4;
    const int bh = sb >> 2, vs = (sb & 3) * 2 + (wid & 1); const bool worker = wid < 2;
    const int h = bh & 3, b = bh >> 2;
    const bf16* proj = (const bf16*)(p.ws + WS_PROJ);
    float* OB = p.out; const bf16* KIT = (const bf16*)((unsigned char*)p.out + OUT_KIT); const bf16* VTg = (const bf16*)((unsigned char*)p.out + OUT_VT);
    const float* DEC = (const float*)(p.ws + WS_DEC);
    constexpr int BUF = 54784, O_KIT = 17408, O_VT = 17408 + 18432, O_DEC = 17408 + 2 * 18432;
    u32x4 rqA[2], rkA[2], rvA[2], rdA, rqB[2], rkB[2], rvB[2], rdB;
    float oin[4][4];
#define SC_ISSUE(rq, rk, rv, rd, n_) { const int ci_ = bh * 128 + (n_), tk_ = b * T + (n_) * 64; \
        _Pragma("unroll") for (int i = 0; i < 2; ++i) { const int id = tid + i * NTHR; \
            rq[i] = *(const u32x4*)(proj + (size_t)(tk_ + (id >> 4)) * PS + C_HQ + h * 128 + (id & 15) * 8); \
            rk[i] = *(const u32x4*)(KIT + (size_t)ci_ * 8192 + id * 8); rv[i] = *(const u32x4*)(VTg + (size_t)ci_ * 8192 + id * 8); } \
        if (tid < 32) rd = *(const u32x4*)(DEC + (size_t)ci_ * 128 + tid * 4); }
#define SC_STASH(rq, rk, rv, rd, buf) { _Pragma("unroll") for (int i = 0; i < 2; ++i) { const int id = tid + i * NTHR; \
            *(u32x4*)((buf) + (id >> 4) * 272 + (id & 15) * 16) = rq[i]; *(u32x4*)((buf) + O_KIT + (id >> 3) * 144 + (id & 7) * 16) = rk[i]; \
            *(u32x4*)((buf) + O_VT + (id >> 3) * 144 + (id & 7) * 16) = rv[i]; } \
        if (tid < 32) *(u32x4*)((buf) + O_DEC + tid * 16) = rd; }
    auto load_oin = [&](int n) {
        const int tok0 = b * T + n * 64;
#pragma unroll
        for (int tt = 0; tt < 4; ++tt)
#pragma unroll
            for (int r = 0; r < 4; ++r) oin[tt][r] = OB[(size_t)(tok0 + tt * 16 + fq * 4 + r) * 512 + h * 128 + vs * 16 + fr];
    };
    f32x4 S[8];
#pragma unroll
    for (int i = 0; i < 8; ++i) S[i] = (f32x4){0.f, 0.f, 0.f, 0.f};
    SC_ISSUE(rqA, rkA, rvA, rdA, 0)
    SC_ISSUE(rqB, rkB, rvB, rdB, 1)
    SC_STASH(rqA, rkA, rvA, rdA, lds)
    if (worker) load_oin(0);
    __syncthreads();
    auto compute = [&](int n, unsigned char* cur) {
        const int tok0 = b * T + n * 64;
        const int nn = (n + 1 < 128) ? n + 1 : n;
        bf16x8 Sb[4];
#pragma unroll
        for (int s = 0; s < 4; ++s) {
            u32x4 w; w.x = pk2(S[2 * s][0], S[2 * s][1]); w.y = pk2(S[2 * s][2], S[2 * s][3]); w.z = pk2(S[2 * s + 1][0], S[2 * s + 1][1]); w.w = pk2(S[2 * s + 1][2], S[2 * s + 1][3]);
            Sb[s] = __builtin_bit_cast(bf16x8, w);
        }
        float ores[4][4];
#pragma unroll
        for (int tt = 0; tt < 4; ++tt) {
            f32x4 acc = (f32x4){0.f, 0.f, 0.f, 0.f};
#pragma unroll
            for (int s = 0; s < 4; ++s) { const bf16x8 qf = *(const bf16x8*)(cur + (tt * 16 + fr) * 272 + (s * 32 + fq * 8) * 2); acc = __builtin_amdgcn_mfma_f32_16x16x32_bf16(qf, Sb[s], acc, 0, 0, 0); }
#pragma unroll
            for (int r = 0; r < 4; ++r) ores[tt][r] = oin[tt][r] + acc[r];
        }
#pragma unroll
        for (int tt = 0; tt < 4; ++tt)
#pragma unroll
            for (int r = 0; r < 4; ++r) OB[(size_t)(tok0 + tt * 16 + fq * 4 + r) * 512 + h * 128 + vs * 16 + fr] = ores[tt][r];
        load_oin(nn);
        const bf16x8 v0 = *(const bf16x8*)(cur + O_VT + (vs * 16 + fr) * 144 + fq * 16), v1 = *(const bf16x8*)(cur + O_VT + (vs * 16 + fr) * 144 + 64 + fq * 16);
#pragma unroll
        for (int kb = 0; kb < 8; ++kb) {
            const bf16x8 k0 = *(const bf16x8*)(cur + O_KIT + (kb * 16 + fr) * 144 + fq * 16), k1 = *(const bf16x8*)(cur + O_KIT + (kb * 16 + fr) * 144 + 64 + fq * 16);
            const f32x4 dv = *(const f32x4*)(cur + O_DEC + (kb * 16 + fq * 4) * 4);
            f32x4 sacc = S[kb] * dv;
            sacc = __builtin_amdgcn_mfma_f32_16x16x32_bf16(k0, v0, sacc, 0, 0, 0);
            sacc = __builtin_amdgcn_mfma_f32_16x16x32_bf16(k1, v1, sacc, 0, 0, 0);
            S[kb] = sacc;
        }
    };
#pragma unroll 1
    for (int n = 0; n < 128; n += 2) {
        { const int n2 = (n + 2 < 128) ? n + 2 : n; SC_ISSUE(rqA, rkA, rvA, rdA, n2) }
        if (worker) compute(n, lds);
        SC_STASH(rqB, rkB, rvB, rdB, lds + BUF)
        __syncthreads();
        { const int n3 = (n + 3 < 128) ? n + 3 : n + 1; SC_ISSUE(rqB, rkB, rvB, rdB, n3) }
        if (worker) compute(n + 1, lds + BUF);
        SC_STASH(rqA, rkA, rvA, rdA, lds)
        __syncthreads();
    }
#undef SC_ISSUE
#undef SC_STASH
}
__device__ __forceinline__ void phase4(const Params& p, unsigned char* lds) {
    const bf16* proj = (const bf16*)(p.ws + WS_PROJ); const float* OB = p.out; bf16* mixed = (bf16*)(p.ws + WS_ACT); const float* gain = p.in[5];
    const int lane = threadIdx.x & 63, gw = (blockIdx.x * NTHR + threadIdx.x) >> 6, ngw = (gridDim.x * NTHR) >> 6;
    for (int tok = gw; tok < NTOK; tok += ngw) {
        const f32x4 o0 = *(const f32x4*)(OB + (size_t)tok * 512 + lane * 8), o1 = *(const f32x4*)(OB + (size_t)tok * 512 + lane * 8 + 4);
        const u32x4 gp = *(const u32x4*)(proj + (size_t)tok * PS + C_HG + lane * 8);
        const f32x4 g0 = *(const f32x4*)(gain + lane * 8), g1 = *(const f32x4*)(gain + lane * 8 + 4);
        float ss = o0.x * o0.x + o0.y * o0.y + o0.z * o0.z + o0.w * o0.w + o1.x * o1.x + o1.y * o1.y + o1.z * o1.z + o1.w * o1.w;
        ss = grp16_sum(ss);
        const float r = rsqrtf(ss * (1.0f / 128.0f) + EPS);
        const unsigned gx = gp.x, gy = gp.y, gz = gp.z, gw_ = gp.w;
        u32x4 w;
        w.x = pk2(o0.x * r * g0.x * siluf_(__uint_as_float(gx << 16)), o0.y * r * g0.y * siluf_(__uint_as_float(gx & 0xffff0000u)));
        w.y = pk2(o0.z * r * g0.z * siluf_(__uint_as_float(gy << 16)), o0.w * r * g0.w * siluf_(__uint_as_float(gy & 0xffff0000u)));
        w.z = pk2(o1.x * r * g1.x * siluf_(__uint_as_float(gz << 16)), o1.y * r * g1.y * siluf_(__uint_as_float(gz & 0xffff0000u)));
        w.w = pk2(o1.z * r * g1.z * siluf_(__uint_as_float(gw_ << 16)), o1.w * r * g1.w * siluf_(__uint_as_float(gw_ & 0xffff0000u)));
        *(u32x4*)(mixed + (size_t)tok * D + lane * 8) = w;
    }
}

#define WAVE_LDS_SYNC() asm volatile("s_waitcnt lgkmcnt(0)" ::: "memory")
__device__ __forceinline__ void nsa_prep_item(const Params& p, unsigned char* lds, int tile) {
    const int tid = threadIdx.x, lig = tid & 15;
    const int tok0 = tile * 64;
    bf16* proj = (bf16*)(p.ws + WS_PROJ);
    for (int rho = tid >> 4; rho < 768; rho += 32) {
        const int tl = rho / 12, which = rho - tl * 12;
        int col; const float* gain; float sc = 1.0f;
        if (which < 8) { col = C_NQ + which * 64; gain = p.in[6]; sc = 0.125f * 1.4426950408889634f; }
        else if (which < 10) { col = C_KS + (which - 8) * 64; gain = p.in[7] + 64; }
        else { col = C_KW + (which - 10) * 64; gain = p.in[7] + 128; }
        bf16* rp = proj + (size_t)(tok0 + tl) * PS + col + lig * 4;
        const u32x2 raw = *(const u32x2*)rp;
        const unsigned r0 = raw.x, r1 = raw.y;
        const float a = __uint_as_float(r0 << 16), b = __uint_as_float(r0 & 0xffff0000u), c = __uint_as_float(r1 << 16), d = __uint_as_float(r1 & 0xffff0000u);
        const float ss = grp16_sum(a * a + b * b + c * c + d * d);
        const float r = rsqrtf(ss * (1.0f / 64.0f) + EPS) * sc;
        const f32x4 gg = *(const f32x4*)(gain + lig * 4);
        u32x2 o; o.x = pk2(a * r * gg.x, b * r * gg.y); o.y = pk2(c * r * gg.z, d * r * gg.w);
        if (which < 8) *(u32x2*)rp = o;
        else {
            const int g = (which - 8) & 1, tok = tok0 + tl, b = tok / T, t = tok % T;
            unsigned char* kb = p.ws + (which < 10 ? WS_KFS : WS_KFW) + ((size_t)(b * 2 + g) * 256 + (t >> 5)) * 4096;
            *(u32x2*)(kb + (lig >> 2) * 1024 + ((t & 31) + 32 * ((lig >> 1) & 1)) * 16 + (lig & 1) * 8) = o;
        }
    }
    {
        const int c = tid & 127, tq = tid >> 7, g = c >> 6, d = c & 63, b = tok0 / T, t0 = tok0 % T;
#pragma unroll
        for (int which = 0; which < 2; ++which) {
            const int col = (which == 0 ? C_VS : C_VW) + c;
            unsigned short e[16];
#pragma unroll
            for (int i = 0; i < 16; ++i) e[i] = proj[(size_t)(tok0 + tq * 16 + i) * PS + col];
            unsigned char* vb = p.ws + (which == 0 ? WS_VTS : WS_VTW) + ((size_t)(b * 2 + g) * 256 + ((t0 + tq * 16) >> 5)) * 4096 + ((d >> 5) * 2 + (tq & 1)) * 1024 + (d & 31) * 16;
            u32x4 h0, h1;
            h0.x = e[0] | ((unsigned)e[1] << 16); h0.y = e[2] | ((unsigned)e[3] << 16); h0.z = e[8] | ((unsigned)e[9] << 16); h0.w = e[10] | ((unsigned)e[11] << 16);
            h1.x = e[4] | ((unsigned)e[5] << 16); h1.y = e[6] | ((unsigned)e[7] << 16); h1.z = e[12] | ((unsigned)e[13] << 16); h1.w = e[14] | ((unsigned)e[15] << 16);
            *(u32x4*)vb = h0; *(u32x4*)(vb + 512) = h1;
        }
    }
}
__device__ __forceinline__ void nsa_cmp_item(const Params& p, unsigned char* lds, int item) {
    const int tid = threadIdx.x, lane = tid & 63, wid = tid >> 6, fr = lane & 15, fq = lane >> 4;
    const int nt32 = item & 15, g = (item >> 4) & 1, b = (item >> 5) & 1, which = item >> 6, n0 = nt32 * 32;
    const bf16* proj = (const bf16*)(p.ws + WS_PROJ);
    const float* pe = p.in[8] + which * 2048;
    const bf16* W1T = (const bf16*)(p.ws + WS_W1T) + (size_t)which * 64 * 2048;
    const float* w2 = p.in[10] + which * 4096;
    bf16* A = (bf16*)lds; float* H = (float*)(lds + 33280);
    const int col0 = (which == 0 ? C_KC : C_VC) + g * 64;
    const int nt = wid & 1, ct = wid >> 1;
    f32x4 acc = (f32x4){0.f, 0.f, 0.f, 0.f};
#pragma unroll 1
    for (int kc = 0; kc < 4; ++kc) {
#pragma unroll
        for (int i = 0; i < 4; ++i) {
            const int idx = tid + i * NTHR, dch = idx & 7, jj = (idx >> 3) & 7, n = idx >> 6, j = kc * 8 + jj;
            u32x4 o = (u32x4){0u, 0u, 0u, 0u};
            if (n0 + n < NCMP) {
                const u32x4 raw = *(const u32x4*)(proj + (size_t)(b * T + 16 * (n0 + n) + j) * PS + col0 + dch * 8);
                const f32x4 p0 = *(const f32x4*)(pe + j * 64 + dch * 8), p1 = *(const f32x4*)(pe + j * 64 + dch * 8 + 4);
                const unsigned r0 = raw.x, r1 = raw.y, r2 = raw.z, r3 = raw.w;
                o.x = pk2(__uint_as_float(r0 << 16) + p0.x, __uint_as_float(r0 & 0xffff0000u) + p0.y);
                o.y = pk2(__uint_as_float(r1 << 16) + p0.z, __uint_as_float(r1 & 0xffff0000u) + p0.w);
                o.z = pk2(__uint_as_float(r2 << 16) + p1.x, __uint_as_float(r2 & 0xffff0000u) + p1.y);
                o.w = pk2(__uint_as_float(r3 << 16) + p1.z, __uint_as_float(r3 & 0xffff0000u) + p1.w);
            }
            *(u32x4*)(A + n * 520 + jj * 64 + dch * 8) = o;
        }
        __syncthreads();
#pragma unroll 4
        for (int s = 0; s < 16; ++s) {
            const bf16x8 a = *(const bf16x8*)(A + (nt * 16 + fr) * 520 + s * 32 + fq * 8);
            const bf16x8 bb = *(const bf16x8*)(W1T + (size_t)(ct * 16 + fr) * 2048 + kc * 512 + s * 32 + fq * 8);
            acc = __builtin_amdgcn_mfma_f32_16x16x32_bf16(a, bb, acc, 0, 0, 0);
        }
        __syncthreads();
    }
#pragma unroll
    for (int r = 0; r < 4; ++r) H[(nt * 16 + fq * 4 + r) * 64 + ct * 16 + fr] = gelu_tanh(acc[r]);
    __syncthreads();
    {
        const int n = tid >> 4, c = (tid & 15) * 4;
        f32x4 o = (f32x4){0.f, 0.f, 0.f, 0.f};
#pragma unroll 8
        for (int i = 0; i < 64; ++i) { const float hv = H[n * 64 + i]; const f32x4 w = *(const f32x4*)(w2 + i * 64 + c); o += hv * w; }
        if (which == 0) {
            const float ss = grp16_sum(o.x * o.x + o.y * o.y + o.z * o.z + o.w * o.w);
            const float r = rsqrtf(ss * (1.0f / 64.0f) + EPS);
            const f32x4 gg = *(const f32x4*)(p.in[7] + c);
            o = o * r * gg;
        }
        if (n0 + n >= NCMP) o = (f32x4){0.f, 0.f, 0.f, 0.f};
        const int nn = n0 + n;
        if (which == 0) { u32x2 w; w.x = pk2(o.x, o.y); w.y = pk2(o.z, o.w);
            *(u32x2*)(p.ws + WS_KC + ((size_t)(b * 2 + g) * 16 + (nn >> 5)) * 4096 + (c >> 4) * 1024 + ((nn & 31) + 32 * ((c >> 3) & 1)) * 16 + (c & 7) * 2) = w; }
        else {
            const int kl = nn & 31, sst = kl >> 4, r = kl & 15, j = ((r >> 3) << 2) | (r & 3), hh = (r >> 2) & 1;
            bf16* vt = (bf16*)(p.ws + WS_VCT + ((size_t)(b * 2 + g) * 16 + (nn >> 5)) * 4096 + sst * 1024 + hh * 512 + j * 2);
            const float ov[4] = {o.x, o.y, o.z, o.w};
#pragma unroll
            for (int e = 0; e < 4; ++e) { const int dd = c + e; vt[((dd >> 5) * 2048 + (dd & 31) * 16) / 2] = f2bf(ov[e]); }
        }
    }
    __syncthreads();
}

constexpr float LOG2E = 1.4426950408889634f;
__device__ __forceinline__ int rho16(int reg, int hh) { return (reg & 3) + 8 * (reg >> 2) + 4 * hh; }
__device__ __forceinline__ bf16x8 pack8(const float* pv) {
    u32x4 w; w.x = pk2(pv[0], pv[1]); w.y = pk2(pv[2], pv[3]); w.z = pk2(pv[4], pv[5]); w.w = pk2(pv[6], pv[7]);
    return __builtin_bit_cast(bf16x8, w);
}
struct KF { bf16x8 f[4]; };
struct VF { bf16x8 f[4]; };
__device__ __forceinline__ void load_k(KF& k, const unsigned char* tp) {
#pragma unroll
    for (int s = 0; s < 4; ++s) k.f[s] = *(const bf16x8*)(tp + s * 1024);
}
__device__ __forceinline__ void load_v(VF& v, const unsigned char* tp) {
#pragma unroll
    for (int q = 0; q < 4; ++q) v.f[q] = *(const bf16x8*)(tp + q * 1024);
}
__device__ __forceinline__ f32x16 score_tile(const KF& k, const bf16x8 (&qf)[4], float slope, float base) {
    f32x16 st;
#pragma unroll
    for (int i = 0; i < 16; ++i) st[i] = fmaf(slope, (float)((i & 3) + 8 * (i >> 2)), base);
#pragma unroll
    for (int s = 0; s < 4; ++s) st = __builtin_amdgcn_mfma_f32_32x32x16_bf16(k.f[s], qf[s], st, 0, 0, 0);
    return st;
}
__device__ __forceinline__ void pv_tile(f32x16& o0, f32x16& o1, const VF& v, const float* pv) {
    const bf16x8 p0 = pack8(pv), p1 = pack8(pv + 8);
    o0 = __builtin_amdgcn_mfma_f32_32x32x16_bf16(v.f[0], p0, o0, 0, 0, 0); o0 = __builtin_amdgcn_mfma_f32_32x32x16_bf16(v.f[1], p1, o0, 0, 0, 0);
    o1 = __builtin_amdgcn_mfma_f32_32x32x16_bf16(v.f[2], p0, o1, 0, 0, 0); o1 = __builtin_amdgcn_mfma_f32_32x32x16_bf16(v.f[3], p1, o1, 0, 0, 0);
}
template <bool FAST>
__device__ __forceinline__ void attn_tile(const KF& kc, const VF& vf, const bf16x8 (&qf)[4], float slope, float base, int distbase, bool colsel, int wlimit,
                                          float& l, f32x16& o0, f32x16& o1) {
    const f32x16 st = score_tile(kc, qf, slope, base);
    float sv[16]; float ps = 0.f;
#pragma unroll
    for (int i = 0; i < 16; ++i) {
        float e = __builtin_amdgcn_exp2f(st[i]);
        if (!FAST) { const int dist = distbase - ((i & 3) + 8 * (i >> 2)); e = (colsel && dist >= 0 && dist < wlimit) ? e : 0.f; }
        sv[i] = e; ps += e;
    }
    l += ps;
    pv_tile(o0, o1, vf, sv);
}
__device__ __forceinline__ void nsa_attn_item(const Params& p, unsigned char* wlds, int item) {
    const int lane = threadIdx.x & 63, c = lane & 31, hh = lane >> 5, jt = c >> 2, r4 = c & 3;
    const int oct = item & 1023, g = (item >> 10) & 1, b = item >> 11;
    const int t0 = oct * 8, tc = t0 + jt, h = g * 4 + r4;
    const float slope = exp2f(-(float)(h + 1)) * LOG2E;
    const bf16* proj = (const bf16*)(p.ws + WS_PROJ);
    float* impA = (float*)wlds; float* impB = impA + 1024; unsigned* msk = (unsigned*)(impB + 1024);
    unsigned char* blist = (unsigned char*)(msk + 32);
    float* ocl = (float*)(wlds + 8448) + lane;
#pragma unroll
    for (int i = 0; i < 16; ++i) { impA[lane + 64 * i] = 0.f; impB[lane + 64 * i] = 0.f; }
    if (lane < 32) msk[lane] = 0u;
    bf16x8 qf[4];
    { const bf16* qp = proj + (size_t)(b * T + tc) * PS + C_NQ + h * 64 + hh * 8;
#pragma unroll
      for (int s = 0; s < 4; ++s) qf[s] = *(const bf16x8*)(qp + s * 16); }
    const bf16* gatep = proj + (size_t)(b * T + tc) * PS + C_GT + h * 3;
#define NSA_GATE(i) sigmoidf_(bf2f(gatep[i]))
    float bnd[3];
    { const float gq = wave_max(fabsf(p.in[6][lane]));
#pragma unroll
      for (int i = 0; i < 3; ++i) bnd[i] = __uint_as_float((unsigned)__builtin_amdgcn_readfirstlane((int)__float_as_uint(8.0f * LOG2E * 1.02f * gq * wave_max(fabsf(p.in[7][i * 64 + lane]))))); }
    WAVE_LDS_SYNC();
    {
        const unsigned char* KC = p.ws + WS_KC + (size_t)(b * 2 + g) * 65536 + lane * 16;
        const unsigned char* VCT = p.ws + WS_VCT + (size_t)(b * 2 + g) * 65536 + lane * 16;
        const int nmax = (t0 + 7 >= 31) ? ((t0 + 7 - 31) >> 4) : -1;
        const int nlast = (nmax >= 0) ? (nmax & ~31) : -32;
        float l = 0.f;
        f32x16 o0, o1;
#pragma unroll
        for (int i = 0; i < 16; ++i) { o0[i] = 0.f; o1[i] = 0.f; }
        KF kn;
        if (nlast >= 0) load_k(kn, KC + (size_t)nlast * 128);
#pragma unroll 1
        for (int n0 = nlast; n0 >= 0; n0 -= 32) {
            const KF kc = kn;
            load_k(kn, KC + (size_t)(n0 >= 32 ? n0 - 32 : n0) * 128);
            const int distbase = tc - 16 * (n0 + 4 * hh) - 31;
            const f32x16 st = score_tile(kc, qf, 16.0f * slope, -slope * (float)distbase - bnd[0]);
            float ps = 0.f;
#pragma unroll
            for (int i = 0; i < 16; ++i) { const int dist = distbase - 16 * ((i & 3) + 8 * (i >> 2)); ps += (dist >= 0) ? __builtin_amdgcn_exp2f(st[i]) : 0.f; }
            l += ps;
        }
        l += __shfl_xor(l, 32);
        const float inv = (l > 0.f) ? 1.0f / l : 0.f;
        if (nlast >= 0) load_k(kn, KC + (size_t)nlast * 128);
#pragma unroll 1
        for (int n0 = nlast; n0 >= 0; n0 -= 32) {
            const KF kc = kn; VF vf;
            load_v(vf, VCT + (size_t)n0 * 128);
            load_k(kn, KC + (size_t)(n0 >= 32 ? n0 - 32 : n0) * 128);
            const int distbase = tc - 16 * (n0 + 4 * hh) - 31;
            const f32x16 st = score_tile(kc, qf, 16.0f * slope, -slope * (float)distbase - bnd[0]);
            float pv[16];
#pragma unroll
            for (int i = 0; i < 16; ++i) { const int dist = distbase - 16 * ((i & 3) + 8 * (i >> 2)); pv[i] = (dist >= 0) ? __builtin_amdgcn_exp2f(st[i]) * inv : 0.f; }
            pv_tile(o0, o1, vf, pv);
#pragma unroll
            for (int i = 0; i < 16; ++i) { float v = pv[i]; v += dpp_f<0xB1>(v); v += dpp_f<0x4E>(v); pv[i] = v; }
            if (r4 == 0) {
#pragma unroll
                for (int rg = 0; rg < 4; ++rg) {
                    const int jb = (n0 >> 2) + 2 * rg + hh;
                    impA[jt * 128 + jb] = pv[4 * rg] + 2.f * pv[4 * rg + 1] + 2.f * pv[4 * rg + 2] + 2.f * pv[4 * rg + 3];
                    if (jb >= 1) impB[jt * 128 + jb - 1] = pv[4 * rg];
                }
            }
        }
        { const float g0 = NSA_GATE(0);
#pragma unroll
        for (int i = 0; i < 16; ++i) { ocl[i * 64] = g0 * o0[i]; ocl[(16 + i) * 64] = g0 * o1[i]; } }
    }
    WAVE_LDS_SYNC();
    {
        const int lig = lane & 15, grp = lane >> 4;
#pragma unroll 1
        for (int half = 0; half < 2; ++half) {
            const int j2 = half * 4 + grp, cur = (t0 + j2) >> 6;
            float v[8];
#pragma unroll
            for (int e = 0; e < 8; ++e) {
                const int j = lig * 8 + e; const float val = impA[j2 * 128 + j] + impB[j2 * 128 + j];
                v[e] = (j >= 1 && j <= cur - 2) ? __uint_as_float((__float_as_uint(val) & ~127u) | (unsigned)(127 - j)) : -1.0f;
            }
            const float top = grp16_top16(v, lig);
            const int need = 16 - ((cur == 0) ? 1 : (cur == 1) ? 2 : 3);
            if (lig < need && top >= 0.f) { const int idx = 127 - (int)(__float_as_uint(top) & 127u); atomicOr(&msk[j2 * 4 + (idx >> 5)], 1u << (idx & 31)); }
            if (lig == 0) { atomicOr(&msk[j2 * 4], 1u); atomicOr(&msk[j2 * 4 + (cur >> 5)], 1u << (cur & 31)); if (cur >= 1) atomicOr(&msk[j2 * 4 + ((cur - 1) >> 5)], 1u << ((cur - 1) & 31)); }
        }
    }
    WAVE_LDS_SYNC();
    {
        int nblk = 0;
#pragma unroll
        for (int w = 3; w >= 0; --w) {
            unsigned u = 0u;
#pragma unroll
            for (int j = 0; j < 8; ++j) u |= msk[j * 4 + w];
            u = (unsigned)__builtin_amdgcn_readfirstlane((int)u);
            while (u) { const int bit = 31 - __builtin_clz(u); u &= ~(1u << bit); if (lane == 0) blist[nblk] = (unsigned char)(w * 32 + bit); ++nblk; }
        }
        WAVE_LDS_SYNC();
        const unsigned char* KS = p.ws + WS_KFS + (size_t)(b * 2 + g) * (256 * 4096) + lane * 16;
        const unsigned char* VTS = p.ws + WS_VTS + (size_t)(b * 2 + g) * (256 * 4096) + lane * 16;
        float l = 0.f;
        f32x16 o0, o1;
#pragma unroll
        for (int i = 0; i < 16; ++i) { o0[i] = 0.f; o1[i] = 0.f; }
        const int ntile = 2 * nblk;
        KF kn; VF vn;
        { const int jb0 = blist[0]; load_k(kn, KS + (size_t)(jb0 * 64 + 32) * 128); load_v(vn, VTS + (size_t)(jb0 * 64 + 32) * 128); }
#pragma unroll 1
        for (int ti = 0; ti < ntile; ++ti) {
            const int jb = __builtin_amdgcn_readfirstlane((int)blist[ti >> 1]);
            const int key0 = jb * 64 + 32 - 32 * (ti & 1);
            const KF kc = kn; const VF vf = vn;
            { const int tn = (ti + 1 < ntile) ? ti + 1 : ti; const int jn = __builtin_amdgcn_readfirstlane((int)blist[tn >> 1]); const size_t off = (size_t)(jn * 64 + 32 - 32 * (tn & 1)) * 128;
              load_k(kn, KS + off); load_v(vn, VTS + off); }
            const bool colsel = (msk[jt * 4 + (jb >> 5)] >> (jb & 31)) & 1u;
            const int distbase = tc - key0 - 4 * hh;
            if (key0 + 31 <= t0) attn_tile<true>(kc, vf, qf, slope, colsel ? -slope * (float)distbase - bnd[1] : -1e30f, distbase, true, 1 << 30, l, o0, o1);
            else attn_tile<false>(kc, vf, qf, slope, -slope * (float)distbase - bnd[1], distbase, colsel, 1 << 30, l, o0, o1);
        }
        l += __shfl_xor(l, 32);
        const float sc = (l > 0.f) ? NSA_GATE(1) / l : 0.f;
#pragma unroll
        for (int i = 0; i < 16; ++i) { ocl[i * 64] += sc * o0[i]; ocl[(16 + i) * 64] += sc * o1[i]; }
    }
    {
        const unsigned char* KW = p.ws + WS_KFW + (size_t)(b * 2 + g) * (256 * 4096) + lane * 16;
        const unsigned char* VTW = p.ws + WS_VTW + (size_t)(b * 2 + g) * (256 * 4096) + lane * 16;
        float l = 0.f;
        f32x16 o0, o1;
#pragma unroll
        for (int i = 0; i < 16; ++i) { o0[i] = 0.f; o1[i] = 0.f; }
        const int kstart = (t0 - 511 > 0 ? t0 - 511 : 0) & ~31, kfirst = t0 & ~31;
        KF kn;
        load_k(kn, KW + (size_t)kfirst * 128);
#pragma unroll 1
        for (int key0 = kfirst; key0 >= kstart; key0 -= 32) {
            const KF kc = kn; VF vf;
            load_v(vf, VTW + (size_t)key0 * 128);
            { const int kn0 = (key0 - 32 >= kstart) ? key0 - 32 : key0; load_k(kn, KW + (size_t)kn0 * 128); }
            const int distbase = tc - key0 - 4 * hh;
            if (key0 + 31 <= t0 && key0 >= t0 - 504) attn_tile<true>(kc, vf, qf, slope, -slope * (float)distbase - bnd[2], distbase, true, 512, l, o0, o1);
            else attn_tile<false>(kc, vf, qf, slope, -slope * (float)distbase - bnd[2], distbase, true, 512, l, o0, o1);
        }
        l += __shfl_xor(l, 32);
        const float sc = (l > 0.f) ? NSA_GATE(2) / l : 0.f;
#pragma unroll
        for (int i = 0; i < 16; ++i) { o0[i] = ocl[i * 64] + sc * o0[i]; o1[i] = ocl[(16 + i) * 64] + sc * o1[i]; }
        float ss = 0.f;
#pragma unroll
        for (int i = 0; i < 16; ++i) ss += o0[i] * o0[i] + o1[i] * o1[i];
        ss += __shfl_xor(ss, 32);
        const float r = rsqrtf(ss * (1.0f / 64.0f) + EPS);
        const float* og = p.in[11] + h * 64;
        bf16* op = (bf16*)(p.ws + WS_ACT) + (size_t)(b * T + tc) * D + 512 + h * 64;
#pragma unroll
        for (int dt = 0; dt < 2; ++dt)
#pragma unroll
            for (int rg = 0; rg < 4; ++rg) {
                const int d0 = dt * 32 + 8 * rg + 4 * hh;
                const f32x4 gg = *(const f32x4*)(og + d0);
                u32x2 w;
                if (dt == 0) { w.x = pk2(o0[4 * rg] * r * gg.x, o0[4 * rg + 1] * r * gg.y); w.y = pk2(o0[4 * rg + 2] * r * gg.z, o0[4 * rg + 3] * r * gg.w); }
                else { w.x = pk2(o1[4 * rg] * r * gg.x, o1[4 * rg + 1] * r * gg.y); w.y = pk2(o1[4 * rg + 2] * r * gg.z, o1[4 * rg + 3] * r * gg.w); }
                *(u32x2*)(op + d0) = w;
            }
    }
    WAVE_LDS_SYNC();
}
__device__ __forceinline__ void phase2(const Params& p, unsigned char* lds) {
    unsigned* ctr = (unsigned*)(p.ws + WS_CTR) + 2048;
    volatile int* slot = (volatile int*)(lds + LDS_BYTES - 32);
    for (;;) {
        if (threadIdx.x == 0) *slot = (int)atomicAdd(ctr, 1u);
        __syncthreads();
        const int it = *slot;
        __syncthreads();
        if (it >= 128 + 1024 + 256) break;
        if (it < 128) nsa_cmp_item(p, lds, it);
        else if (it < 1152) hgrn_pre_item(p, lds, it - 128);
        else { nsa_prep_item(p, lds, it - 1152); __syncthreads(); }
    }
}
template <bool SCAN>
__device__ __forceinline__ void phase3(const Params& p, unsigned char* lds) {
    const int wid = __builtin_amdgcn_readfirstlane((int)(threadIdx.x >> 6));
    if (SCAN && blockIdx.x < 32) hgrn_scan_block(p, lds, blockIdx.x);
    unsigned* ctr = (unsigned*)(p.ws + WS_CTR) + (SCAN ? 0 : 128);
    const int myx = (int)(xb_xcc_id() & 7u);
    for (;;) {
        int q = -1, it = 0;
        for (int k = 0; k < 8; ++k) {
            const int x = (myx + k) & 7;
            int v = 0;
            if ((threadIdx.x & 63) == 0) v = (int)atomicAdd(ctr + x * 16, 1u);
            v = __builtin_amdgcn_readfirstlane(v);
            if (v < 512) { q = x; it = v; break; }
        }
        if (q < 0) break;
        const int item = ((q >> 1) << 10) | ((q & 1) * 512 + 511 - it);
        nsa_attn_item(p, lds + wid * 16640, item);
    }
}

__device__ __forceinline__ float dot2u(unsigned a, unsigned b, float acc) { return __builtin_amdgcn_fdot2_f32_bf16(__builtin_bit_cast(bf16x2v, a), __builtin_bit_cast(bf16x2v, b), acc, false); }
__device__ __forceinline__ float dot8(u32x4 a, u32x4 b, float acc) {
    const unsigned a0 = a.x, a1 = a.y, a2 = a.z, a3 = a.w, b0 = b.x, b1 = b.y, b2 = b.z, b3 = b.w;
    acc = dot2u(a0, b0, acc); acc = dot2u(a1, b1, acc); acc = dot2u(a2, b2, acc); acc = dot2u(a3, b3, acc);
    return acc;
}
__device__ __forceinline__ void axpy8(float (&o)[8], float c, u32x4 v) {
    o[0] += c * __uint_as_float(v.x << 16); o[1] += c * __uint_as_float(v.x & 0xffff0000u);
    o[2] += c * __uint_as_float(v.y << 16); o[3] += c * __uint_as_float(v.y & 0xffff0000u);
    o[4] += c * __uint_as_float(v.z << 16); o[5] += c * __uint_as_float(v.z & 0xffff0000u);
    o[6] += c * __uint_as_float(v.w << 16); o[7] += c * __uint_as_float(v.w & 0xffff0000u);
}
typedef float f32x2 __attribute__((ext_vector_type(2)));
__device__ __forceinline__ float dot16_fp8(u32x4 r, const float* xf) {
    const unsigned r0 = r.x, r1 = r.y, r2 = r.z, r3 = r.w; float acc = 0.f; f32x2 t;
    t = __builtin_amdgcn_cvt_pk_f32_fp8((int)r0, false); acc += t.x * xf[0] + t.y * xf[1]; t = __builtin_amdgcn_cvt_pk_f32_fp8((int)r0, true); acc += t.x * xf[2] + t.y * xf[3];
    t = __builtin_amdgcn_cvt_pk_f32_fp8((int)r1, false); acc += t.x * xf[4] + t.y * xf[5]; t = __builtin_amdgcn_cvt_pk_f32_fp8((int)r1, true); acc += t.x * xf[6] + t.y * xf[7];
    t = __builtin_amdgcn_cvt_pk_f32_fp8((int)r2, false); acc += t.x * xf[8] + t.y * xf[9]; t = __builtin_amdgcn_cvt_pk_f32_fp8((int)r2, true); acc += t.x * xf[10] + t.y * xf[11];
    t = __builtin_amdgcn_cvt_pk_f32_fp8((int)r3, false); acc += t.x * xf[12] + t.y * xf[13]; t = __builtin_amdgcn_cvt_pk_f32_fp8((int)r3, true); acc += t.x * xf[14] + t.y * xf[15];
    return acc;
}
__device__ __forceinline__ void axpy16_fp8(float* o, float c, u32x4 r) {
    const unsigned r0 = r.x, r1 = r.y, r2 = r.z, r3 = r.w; f32x2 t;
    t = __builtin_amdgcn_cvt_pk_f32_fp8((int)r0, false); o[0] += c * t.x; o[1] += c * t.y; t = __builtin_amdgcn_cvt_pk_f32_fp8((int)r0, true); o[2] += c * t.x; o[3] += c * t.y;
    t = __builtin_amdgcn_cvt_pk_f32_fp8((int)r1, false); o[4] += c * t.x; o[5] += c * t.y; t = __builtin_amdgcn_cvt_pk_f32_fp8((int)r1, true); o[6] += c * t.x; o[7] += c * t.y;
    t = __builtin_amdgcn_cvt_pk_f32_fp8((int)r2, false); o[8] += c * t.x; o[9] += c * t.y; t = __builtin_amdgcn_cvt_pk_f32_fp8((int)r2, true); o[10] += c * t.x; o[11] += c * t.y;
    t = __builtin_amdgcn_cvt_pk_f32_fp8((int)r3, false); o[12] += c * t.x; o[13] += c * t.y; t = __builtin_amdgcn_cvt_pk_f32_fp8((int)r3, true); o[14] += c * t.x; o[15] += c * t.y;
}
template <bool DUMMY>
__device__ __forceinline__ void phase9(const Params& p, unsigned char* lds) {
    const bf16* HN = (const bf16*)(p.ws + WS_ACT); const unsigned char* UB = p.ws + WS_UB; const unsigned char* VB = p.ws + WS_VB;
    const float* US = (const float*)(p.ws + WS_US); const float* VS = (const float*)(p.ws + WS_VS);
    const int* ids = (const int*)(p.ws + WS_IDS); const float* wts = (const float*)(p.ws + WS_WTS);
    float* O = p.out; bf16* HG = (bf16*)(p.ws + WS_PROJ + 64 * MiB); const float* gn = p.in[19];
    const int lane = threadIdx.x & 63, gw = (blockIdx.x * NTHR + threadIdx.x) >> 6, ngw = (gridDim.x * NTHR) >> 6;
    for (int tok = gw; tok < NTOK; tok += ngw) {
        float xf[16], oa[16];
        {
            const u32x4 x0 = *(const u32x4*)(HN + (size_t)tok * D + lane * 16), x1 = *(const u32x4*)(HN + (size_t)tok * D + lane * 16 + 8);
            const unsigned a0 = x0.x, a1 = x0.y, a2 = x0.z, a3 = x0.w, b0 = x1.x, b1 = x1.y, b2 = x1.z, b3 = x1.w;
            xf[0] = __uint_as_float(a0 << 16); xf[1] = __uint_as_float(a0 & 0xffff0000u); xf[2] = __uint_as_float(a1 << 16); xf[3] = __uint_as_float(a1 & 0xffff0000u);
            xf[4] = __uint_as_float(a2 << 16); xf[5] = __uint_as_float(a2 & 0xffff0000u); xf[6] = __uint_as_float(a3 << 16); xf[7] = __uint_as_float(a3 & 0xffff0000u);
            xf[8] = __uint_as_float(b0 << 16); xf[9] = __uint_as_float(b0 & 0xffff0000u); xf[10] = __uint_as_float(b1 << 16); xf[11] = __uint_as_float(b1 & 0xffff0000u);
            xf[12] = __uint_as_float(b2 << 16); xf[13] = __uint_as_float(b2 & 0xffff0000u); xf[14] = __uint_as_float(b3 << 16); xf[15] = __uint_as_float(b3 & 0xffff0000u);
        }
#pragma unroll
        for (int j = 0; j < 16; ++j) oa[j] = 0.f;
#pragma unroll 1
        for (int half = 0; half < 2; ++half) {
            const int myid = ids[(size_t)tok * 128 + half * 64 + lane];
            const float myw = wts[(size_t)tok * 128 + half * 64 + lane] * VS[myid];
            const float myus = US[myid];
#pragma unroll 1
            for (int eb = 0; eb < 64; eb += 16) {
                int id[16]; float d[16]; u32x4 ur[16];
#pragma unroll
                for (int j = 0; j < 16; ++j) id[j] = __shfl(myid, eb + j);
#pragma unroll
                for (int j = 0; j < 16; ++j) ur[j] = *(const u32x4*)(UB + (size_t)id[j] * D + lane * 16);
#pragma unroll
                for (int j = 0; j < 16; ++j) d[j] = dot16_fp8(ur[j], xf);
#pragma unroll
                for (int j = 0; j < 16; ++j) ur[j] = *(const u32x4*)(VB + (size_t)id[j] * D + lane * 16);
#pragma unroll
                for (int j = 0; j < 16; ++j) d[j] = wave_sum(d[j]);
#pragma unroll
                for (int j = 0; j < 16; ++j) { const float c = __shfl(myw, eb + j) * gelu_tanh(d[j] * __shfl(myus, eb + j)); axpy16_fp8(oa, c, ur[j]); }
            }
        }
        float* orow = O + (size_t)tok * D + lane * 16; float* wrow = DUMMY ? (float*)(p.ws + WS_PROJ) + (size_t)tok * D + lane * 16 : orow;
        float ss = 0.f; f32x4 hv[4];
#pragma unroll
        for (int q = 0; q < 4; ++q) {
            f32x4 h = *(const f32x4*)(orow + 4 * q);
            h.x += oa[4 * q]; h.y += oa[4 * q + 1]; h.z += oa[4 * q + 2]; h.w += oa[4 * q + 3];
            *(f32x4*)(wrow + 4 * q) = h; hv[q] = h;
            ss += h.x * h.x + h.y * h.y + h.z * h.z + h.w * h.w;
        }
        ss = wave_sum(ss);
        const float r = rsqrtf(ss * (1.0f / D) + EPS);
        u32x4 q0, q1;
        { const f32x4 g0 = *(const f32x4*)(gn + lane * 16), g1 = *(const f32x4*)(gn + lane * 16 + 4), g2 = *(const f32x4*)(gn + lane * 16 + 8), g3 = *(const f32x4*)(gn + lane * 16 + 12);
          q0.x = pk2(hv[0].x * r * g0.x, hv[0].y * r * g0.y); q0.y = pk2(hv[0].z * r * g0.z, hv[0].w * r * g0.w); q0.z = pk2(hv[1].x * r * g1.x, hv[1].y * r * g1.y); q0.w = pk2(hv[1].z * r * g1.z, hv[1].w * r * g1.w);
          q1.x = pk2(hv[2].x * r * g2.x, hv[2].y * r * g2.y); q1.y = pk2(hv[2].z * r * g2.z, hv[2].w * r * g2.w); q1.z = pk2(hv[3].x * r * g3.x, hv[3].y * r * g3.y); q1.w = pk2(hv[3].z * r * g3.z, hv[3].w * r * g3.w); }
        *(u32x4*)(HG + (size_t)tok * D + lane * 16) = q0; *(u32x4*)(HG + (size_t)tok * D + lane * 16 + 8) = q1;
    }
}


__device__ __forceinline__ unsigned xb_xcc_id();
template <int CTRL> __device__ __forceinline__ float dpp_row_ror(float v) { return __int_as_float(__builtin_amdgcn_update_dpp(0, __float_as_int(v), CTRL, 0xF, 0xF, false)); }
__device__ __forceinline__ float grp8_sum(float v) { v += dpp_f<0xB1>(v); v += dpp_f<0x4E>(v); v += dpp_f<0x141>(v); return v; }
__device__ __forceinline__ int peer_next_item(unsigned* ctr, int myx, int& slice) {
    for (int k = 0; k < 8; ++k) {
        const int x = (myx + k) & 7;
        int it = 0;
        if ((threadIdx.x & 63) == 0) it = (int)atomicAdd(ctr + x * 16, 1u);
        it = __builtin_amdgcn_readfirstlane(it);
        if (it < 1024) { slice = x; return it; }
    }
    return -1;
}
__device__ __forceinline__ void unpack16(const u32x4 x0, const u32x4 x1, float* xf) {
    const unsigned a0 = x0.x, a1 = x0.y, a2 = x0.z, a3 = x0.w, b0 = x1.x, b1 = x1.y, b2 = x1.z, b3 = x1.w;
    xf[0] = __uint_as_float(a0 << 16); xf[1] = __uint_as_float(a0 & 0xffff0000u); xf[2] = __uint_as_float(a1 << 16); xf[3] = __uint_as_float(a1 & 0xffff0000u);
    xf[4] = __uint_as_float(a2 << 16); xf[5] = __uint_as_float(a2 & 0xffff0000u); xf[6] = __uint_as_float(a3 << 16); xf[7] = __uint_as_float(a3 & 0xffff0000u);
    xf[8] = __uint_as_float(b0 << 16); xf[9] = __uint_as_float(b0 & 0xffff0000u); xf[10] = __uint_as_float(b1 << 16); xf[11] = __uint_as_float(b1 & 0xffff0000u);
    xf[12] = __uint_as_float(b2 << 16); xf[13] = __uint_as_float(b2 & 0xffff0000u); xf[14] = __uint_as_float(b3 << 16); xf[15] = __uint_as_float(b3 & 0xffff0000u);
}
__device__ __forceinline__ void unpack_ids(const u32x4 r, int* id) {
    const unsigned a = r.x, b = r.y, c = r.z, d = r.w;
    id[0] = a & 0xffff; id[1] = a >> 16; id[2] = b & 0xffff; id[3] = b >> 16; id[4] = c & 0xffff; id[5] = c >> 16; id[6] = d & 0xffff; id[7] = d >> 16;
}
__device__ __forceinline__ void phase9a(const Params& p, unsigned char* lds) {
    const bf16* HN = (const bf16*)(p.ws + WS_ACT); const unsigned char* UB = p.ws + WS_UB;
    const unsigned short* ids = (const unsigned short*)(p.ws + WS_IDS); float* PD = (float*)(p.ws + WS_PROJ);
    unsigned* ctr = (unsigned*)(p.ws + WS_CTR) + 256;
    const int lane = threadIdx.x & 63, gq = lane >> 3, cl = lane & 7, myx = (int)(xb_xcc_id() & 7u);
    for (;;) {
        int x; const int it = peer_next_item(ctr, myx, x);
        if (it < 0) break;
        const unsigned char* ub = UB + (size_t)x * (16384 * 128) + cl * 16;
        const bf16* hn = HN + x * 128 + cl * 16;
        const int tokb = it * 16;
        const unsigned short* ip = ids + (size_t)tokb * 128 + gq * 8;
        int idn[8]; u32x4 bufA[8], bufB[8], xa0, xa1, xb0, xb1, idr;
        idr = *(const u32x4*)ip; unpack_ids(idr, idn);
#pragma unroll
        for (int i = 0; i < 8; ++i) bufA[i] = *(const u32x4*)(ub + (size_t)idn[i] * 128);
        xa0 = *(const u32x4*)(hn + (size_t)tokb * D); xa1 = *(const u32x4*)(hn + (size_t)tokb * D + 8);
        idr = *(const u32x4*)(ip + 64); unpack_ids(idr, idn);
#pragma unroll
        for (int i = 0; i < 8; ++i) bufB[i] = *(const u32x4*)(ub + (size_t)idn[i] * 128);
        xb0 = xa0; xb1 = xa1;
        idr = *(const u32x4*)(ip + 128);
#define P9A_STEP(buf, x0, x1, u) { const int u2_ = ((u) + 2 < 32) ? (u) + 2 : (u), u3_ = ((u) + 3 < 32) ? (u) + 3 : (u); \
            unpack_ids(idr, idn); idr = *(const u32x4*)(ip + u3_ * 64); \
            float xf[16]; unpack16(x0, x1, xf); \
            x0 = *(const u32x4*)(hn + (size_t)(tokb + (u2_ >> 1)) * D); x1 = *(const u32x4*)(hn + (size_t)(tokb + (u2_ >> 1)) * D + 8); \
            float keep = 0.f; \
            _Pragma("unroll") for (int i = 0; i < 8; ++i) { const float d = grp8_sum(dot16_fp8(buf[i], xf)); if (i == cl) keep = d; buf[i] = *(const u32x4*)(ub + (size_t)idn[i] * 128); } \
            PD[((size_t)x * NTOK + tokb + ((u) >> 1)) * 128 + (((u) & 1) * 8 + cl) * 8 + gq] = keep; }
#pragma unroll 1
        for (int u = 0; u < 32; u += 2) {
            P9A_STEP(bufA, xa0, xa1, u)
            P9A_STEP(bufB, xb0, xb1, u + 1)
        }
#undef P9A_STEP
    }
}
__device__ __forceinline__ void phase9c(const Params& p, unsigned char* lds) {
    const unsigned short* ids = (const unsigned short*)(p.ws + WS_IDS); const float* wts = (const float*)(p.ws + WS_WTS); const float* PD = (const float*)(p.ws + WS_PROJ);
    const float* US = (const float*)(p.ws + WS_US); const float* VS = (const float*)(p.ws + WS_VS); float* coefT = (float*)(p.ws + WS_COEFT);
    const size_t gtid = (size_t)blockIdx.x * NTHR + threadIdx.x, gth = (size_t)gridDim.x * NTHR;
    for (size_t idx = gtid; idx < (size_t)NTOK * 128; idx += gth) {
        const size_t tok = idx >> 7; const int r = (int)(idx & 127), e = (r & 64) + (r & 7) * 8 + ((r >> 3) & 7);
        float sdot = 0.f;
#pragma unroll
        for (int x = 0; x < 8; ++x) sdot += PD[(size_t)x * NTOK * 128 + tok * 128 + e];
        const int id = ids[idx];
        coefT[idx] = wts[tok * 128 + e] * VS[id] * gelu_tanh(sdot * US[id]);
    }
}
__device__ __forceinline__ void phase9b(const Params& p, unsigned char* lds) {
    const unsigned char* VB = p.ws + WS_VB; const unsigned short* ids = (const unsigned short*)(p.ws + WS_IDS); const float* coef = (const float*)(p.ws + WS_COEFT);
    float* O = p.out; bf16* HG = (bf16*)(p.ws + WS_PROJ + 64 * MiB); const float* gn = p.in[19]; float* SSQ = (float*)(p.ws + WS_SSQ);
    unsigned* ctr = (unsigned*)(p.ws + WS_CTR) + 512;
    const int lane = threadIdx.x & 63, gq = lane >> 3, cl = lane & 7, myx = (int)(xb_xcc_id() & 7u);
    for (;;) {
        int x; const int it = peer_next_item(ctr, myx, x);
        if (it < 0) break;
        const unsigned char* vb = VB + (size_t)x * (16384 * 128) + cl * 16;
        const int tokb = it * 16;
        const unsigned short* ip = ids + (size_t)tokb * 128 + gq * 8;
        const float* cp = coef + (size_t)tokb * 128 + gq * 8;
        int idn[8]; u32x4 buf[8], idr; f32x4 cf0, cf1, cn0, cn1; float acc[16];
#pragma unroll
        for (int j = 0; j < 16; ++j) acc[j] = 0.f;
        idr = *(const u32x4*)ip; unpack_ids(idr, idn);
        cf0 = *(const f32x4*)cp; cf1 = *(const f32x4*)(cp + 4);
#pragma unroll
        for (int i = 0; i < 8; ++i) buf[i] = *(const u32x4*)(vb + (size_t)idn[i] * 128);
        idr = *(const u32x4*)(ip + 64); cn0 = *(const f32x4*)(cp + 64); cn1 = *(const f32x4*)(cp + 68);
#pragma unroll 1
        for (int u = 0; u < 32; ++u) {
            const int u2 = (u + 2 < 32) ? u + 2 : u;
            unpack_ids(idr, idn);
            const f32x4 c0 = cf0, c1 = cf1; cf0 = cn0; cf1 = cn1;
            idr = *(const u32x4*)(ip + u2 * 64); cn0 = *(const f32x4*)(cp + u2 * 64); cn1 = *(const f32x4*)(cp + u2 * 64 + 4);
            const float cfv[8] = {c0.x, c0.y, c0.z, c0.w, c1.x, c1.y, c1.z, c1.w};
#pragma unroll
            for (int i = 0; i < 8; ++i) { axpy16_fp8(acc, cfv[i], buf[i]); buf[i] = *(const u32x4*)(vb + (size_t)idn[i] * 128); }
            if (u & 1) {
                const int tok = tokb + (u >> 1);
#pragma unroll
                for (int j = 0; j < 16; ++j) { float v = acc[j]; v += __shfl_xor(v, 8); v += __shfl_xor(v, 16); v += __shfl_xor(v, 32); acc[j] = v; }
                float ss = 0.f;
                if (gq == 0) {
                    float* orow = O + (size_t)tok * D + x * 128 + cl * 16; const float* gr = gn + x * 128 + cl * 16; u32x4 q0, q1; unsigned qq[8];
#pragma unroll
                    for (int q = 0; q < 4; ++q) {
                        f32x4 hv = *(const f32x4*)(orow + 4 * q); const f32x4 gg = *(const f32x4*)(gr + 4 * q);
                        hv.x += acc[4 * q]; hv.y += acc[4 * q + 1]; hv.z += acc[4 * q + 2]; hv.w += acc[4 * q + 3];
                        *(f32x4*)(orow + 4 * q) = hv;
                        ss += hv.x * hv.x + hv.y * hv.y + hv.z * hv.z + hv.w * hv.w;
                        qq[2 * q] = pk2(hv.x * gg.x, hv.y * gg.y); qq[2 * q + 1] = pk2(hv.z * gg.z, hv.w * gg.w);
                    }
                    q0.x = qq[0]; q0.y = qq[1]; q0.z = qq[2]; q0.w = qq[3]; q1.x = qq[4]; q1.y = qq[5]; q1.z = qq[6]; q1.w = qq[7];
                    *(u32x4*)(HG + (size_t)tok * D + x * 128 + cl * 16) = q0; *(u32x4*)(HG + (size_t)tok * D + x * 128 + cl * 16 + 8) = q1;
                }
                ss = grp8_sum(ss);
                if (lane == 0) SSQ[(size_t)x * NTOK + tok] = ss;
#pragma unroll
                for (int j = 0; j < 16; ++j) acc[j] = 0.f;
            }
        }
    }
}

#define XB_TMO      128
#define XB_XCNT(j)  (256  + 64 * (j))
#define XB_XSUB(j)  (1280 + 64 * (j))
#define XB_XGEN(j)  (2304 + 64 * (j))
#define XB_TOP      3328
#define XB_TOPGEN   3392
#define XCD_BAR_WORDS 3456
#define XB_SPIN_CAP (1u << 18)
#define LAS __attribute__((address_space(3)))
__device__ __forceinline__ unsigned xb_ld(unsigned* p)              { return __hip_atomic_load(p, __ATOMIC_RELAXED, __HIP_MEMORY_SCOPE_AGENT); }
__device__ __forceinline__ unsigned xb_add(unsigned* p, unsigned v) { return __hip_atomic_fetch_add(p, v, __ATOMIC_RELAXED, __HIP_MEMORY_SCOPE_AGENT); }
__device__ __forceinline__ unsigned xb_xcc_id() { return (unsigned)__builtin_amdgcn_s_getreg((3 << 11) | 20) & 0xFu; }
#define XB_SPIN(cond, bar) do { unsigned _sp = 0; while (cond) { __builtin_amdgcn_s_sleep(1); \
    if ((++_sp & 255u) == 0u) { if (xb_ld(&(bar)[XB_TMO])) break; if (_sp > XB_SPIN_CAP) { atomicAdd(&(bar)[XB_TMO], 1u); break; } } } } while (0)
struct XcdBarrier { unsigned* bar; unsigned x; volatile LAS unsigned* st; };
__device__ __forceinline__ XcdBarrier xcd_barrier_post(unsigned* bar, volatile LAS unsigned* st) {
    XcdBarrier b; b.bar = bar; b.x = xb_xcc_id(); b.st = st;
    if (threadIdx.x == 0) (void)xb_add(&bar[XB_XCNT(b.x)], 1u);
    return b;
}
__device__ __forceinline__ void xcd_barrier_complete(unsigned* bar, unsigned x, unsigned& nloc, unsigned& nx) {
    const unsigned G = gridDim.x * gridDim.y * gridDim.z;
    unsigned sum, cnt, mine, sp = 0u;
    for (;;) {
        sum = 0u; cnt = 0u; mine = 0u;
#pragma unroll
        for (unsigned j = 0; j < 16; ++j) { const unsigned c = xb_ld(&bar[XB_XCNT(j)]); sum += c; cnt += (c > 0u) ? 1u : 0u; mine = (j == x) ? c : mine; }
        if (sum == G) break;
        __builtin_amdgcn_s_sleep(1);
        if ((++sp & 255u) == 0u) { if (xb_ld(&bar[XB_TMO])) break; if (sp > XB_SPIN_CAP) { atomicAdd(&bar[XB_TMO], 1u); break; } }
    }
    nloc = mine > 0u ? mine : 1u; nx = cnt > 0u ? cnt : 1u;
}
__device__ __forceinline__ void xcd_barrier(const XcdBarrier& b) {
    asm volatile("s_waitcnt vmcnt(0)" ::: "memory");
    __syncthreads();
    if (threadIdx.x == 0) {
        unsigned* bar = b.bar;
        __builtin_amdgcn_s_waitcnt(0);
        unsigned nloc = b.st[0], nx = b.st[1];
        if (nloc == 0u) { xcd_barrier_complete(bar, b.x, nloc, nx); b.st[0] = nloc; b.st[1] = nx; }
        const unsigned old = xb_add(&bar[XB_XSUB(b.x)], 1u);
        const unsigned gen = old / nloc;
        if (old + 1u == (gen + 1u) * nloc) {
            __builtin_amdgcn_fence(__ATOMIC_RELEASE, "agent");
            asm volatile("s_waitcnt vmcnt(0)" ::: "memory");
            const unsigned og = xb_add(&bar[XB_TOP], 1u);
            const unsigned tg = og / nx;
            if (og + 1u == (tg + 1u) * nx) xb_add(&bar[XB_TOPGEN], 1u);
            else XB_SPIN(xb_ld(&bar[XB_TOPGEN]) == tg, bar);
            __builtin_amdgcn_fence(__ATOMIC_ACQUIRE, "agent");
            xb_add(&bar[XB_XGEN(b.x)], 1u);
            asm volatile("s_waitcnt vmcnt(0)" ::: "memory");
        } else {
            XB_SPIN(xb_ld(&bar[XB_XGEN(b.x)]) == gen, bar);
            __builtin_amdgcn_fence(__ATOMIC_ACQUIRE, "agent");
            asm volatile("s_waitcnt vmcnt(0)" ::: "memory");
        }
    }
    __syncthreads();
}

constexpr int REPK = -1;
__global__ void __launch_bounds__(NTHR, 2) mega(Params p, int ph_lo, int ph_hi) {
    extern __shared__ __attribute__((aligned(16))) unsigned char lds[];
    volatile LAS unsigned* st = (volatile LAS unsigned*)(LAS unsigned char*)(lds + LDS_BYTES - 16);
    if (threadIdx.x < 4) st[threadIdx.x] = 0u;
    __syncthreads();
    const XcdBarrier bar = xcd_barrier_post((unsigned*)p.ws, st);
#define RUN_PHASE(k, call) if (ph_lo <= (k) && (k) < ph_hi) { if ((k) > ph_lo) xcd_barrier(bar); call; if (REPK == (k)) { xcd_barrier(bar); call; } }
    RUN_PHASE(0, phase0(p, lds))
    RUN_PHASE(1, phase1(p, lds))
    RUN_PHASE(2, phase2(p, lds))
    if (REPK == 30) { xcd_barrier(bar); if ((threadIdx.x >> 6) == 0 && blockIdx.x < 64) hgrn_scan_item<true>(p, blockIdx.x); }
    if (ph_lo <= 3 && 3 < ph_hi) { if (3 > ph_lo) xcd_barrier(bar); phase3<true>(p, lds); if (REPK == 3) { xcd_barrier(bar); phase3<false>(p, lds); } }
    RUN_PHASE(4, phase4(p, lds))
    RUN_PHASE(5, phase5(p, lds))
    RUN_PHASE(6, phase6(p, lds))
    RUN_PHASE(7, phase7(p, lds))
    RUN_PHASE(8, phase8(p, lds))
    if (ph_lo <= 9 && 9 < ph_hi) { if (9 > ph_lo) xcd_barrier(bar); phase9a(p, lds); }
    if (ph_lo <= 9 && 9 < ph_hi) { xcd_barrier(bar); phase9c(p, lds); }
    if (ph_lo <= 9 && 9 < ph_hi) { xcd_barrier(bar); phase9b(p, lds); }
    RUN_PHASE(10, phase10(p, lds))
}

static void launch_mega(const Params& p, int lo, int hi, hipStream_t stream) {
    static int grid = 0;
    if (grid == 0) {
        int dev = 0, cus = 0, per_cu = 0;
        hipGetDevice(&dev); hipDeviceGetAttribute(&cus, hipDeviceAttributeMultiprocessorCount, dev);
        hipFuncSetAttribute((const void*)mega, hipFuncAttributeMaxDynamicSharedMemorySize, LDS_BYTES);
        hipOccupancyMaxActiveBlocksPerMultiprocessor(&per_cu, (const void*)mega, NTHR, LDS_BYTES);
        if (per_cu < 1) { fprintf(stderr, "mega: occupancy query says %d blocks/CU\n", per_cu); per_cu = 1; }
        grid = cus;
    }
    hipMemsetAsync(p.ws, 0, 65536, stream);
    Params pp = p; int l = lo, h = hi;
    void* args[] = {&pp, &l, &h};
    hipError_t e = hipLaunchCooperativeKernel((const void*)mega, dim3(grid), dim3(NTHR), args, LDS_BYTES, stream);
    if (e != hipSuccess) fprintf(stderr, "cooperative launch failed: %s (grid %d)\n", hipGetErrorString(e), grid);
}

extern "C" void kernel_launch(void* const* d_in, const int* in_sizes, int n_in, void* d_out, int out_size, void* d_ws, size_t ws_size, hipStream_t stream) {
    float* out = (float*)d_out; unsigned char* ws = (unsigned char*)d_ws;
    Params prm{}; for (int i = 0; i < 21; ++i) prm.in[i] = (const float*)d_in[i]; prm.out = out; prm.ws = ws;
    launch_mega(prm, 0, 11, stream);
}
```

```cpp
#include <hip/hip_runtime.h>
#include <hip/hip_cooperative_groups.h>
#include <cstdint>
#include <cstdio>
namespace cg = cooperative_groups;

constexpr int D = 1024, NB = 2, T = 8192, NTOK = NB * T;
constexpr int DIN = 3352, PS = 3392;
constexpr int C_HQ = 0, C_HF = 512, C_HI = 1024, C_HG = 1536, C_NQ = 2048, C_KC = 2560, C_VC = 2688,
              C_KS = 2816, C_VS = 2944, C_KW = 3072, C_VW = 3200, C_GT = 3328;
constexpr int NCMP = 511;
constexpr float EPS = 1e-6f;
typedef unsigned short bf16;

constexpr size_t MiB = 1u << 20;
constexpr size_t WS_WINT = 1 * MiB;
constexpr size_t WS_WOUTT = 8 * MiB;
constexpr size_t WS_WQT = 10 * MiB;
constexpr size_t WS_WGT = 14 * MiB;
constexpr size_t WS_WPT = 16 * MiB;
constexpr size_t WS_KEYB = 16 * MiB + 512 * 1024;
constexpr size_t WS_W1T = 17 * MiB;
constexpr size_t WS_CTR = 16384;
constexpr size_t WS_SSQ = 512 * 1024;
constexpr size_t WS_US = 256 * 1024;
constexpr size_t WS_VS = 320 * 1024;
constexpr size_t WS_UB = 18 * MiB;
constexpr size_t WS_VB = 50 * MiB;
constexpr size_t WS_ACT = 82 * MiB;
constexpr size_t WS_PROJ = 114 * MiB;
constexpr size_t WS_SPARE = 220 * MiB;
constexpr size_t WS_IDS = WS_SPARE;
constexpr size_t WS_WTS = WS_SPARE + 8 * MiB;
constexpr size_t WS_KCF = WS_SPARE + 16 * MiB;
constexpr size_t WS_VCF = WS_SPARE + 17 * MiB;
constexpr size_t WS_PB = WS_SPARE + 18 * MiB;
constexpr size_t WS_VTS = WS_SPARE + 26 * MiB;
constexpr size_t WS_VTW = WS_SPARE + 30 * MiB;
constexpr size_t WS_COEFT = WS_SPARE + 26 * MiB;
constexpr size_t WS_KFS = WS_SPARE;
constexpr size_t WS_KFW = WS_SPARE + 4 * MiB;
constexpr size_t WS_KC = WS_SPARE + 34 * MiB;
constexpr size_t WS_VCT = WS_SPARE + 34 * MiB + 256 * 1024;
constexpr size_t WS_DEC = WS_SPARE + 34 * MiB + 512 * 1024;
constexpr size_t OUT_KIT = 32 * MiB;
constexpr size_t OUT_VT = 48 * MiB;
constexpr size_t WS_GL = 18 * MiB;

__device__ __forceinline__ float bf2f(bf16 v) { return __uint_as_float(((unsigned)v) << 16); }
__device__ __forceinline__ bf16 f2bf(float f) { return __builtin_bit_cast(bf16, (__bf16)f); }
__device__ __forceinline__ float wave_sum(float v) {
#pragma unroll
    for (int o = 1; o < 64; o <<= 1) v += __shfl_xor(v, o);
    return v;
}
__device__ __forceinline__ float wave_max(float v) {
#pragma unroll
    for (int o = 1; o < 64; o <<= 1) v = fmaxf(v, __shfl_xor(v, o));
    return v;
}
__device__ __forceinline__ float sigmoidf_(float x) { return 1.0f / (1.0f + __expf(-x)); }
__device__ __forceinline__ float siluf_(float x) { return x * sigmoidf_(x); }
__device__ __forceinline__ float gelu_tanh(float x) { return 0.5f * x * (1.0f + tanhf(0.7978845608028654f * (x + 0.044715f * x * x * x))); }
__device__ __forceinline__ float toF(float v) { return v; }
__device__ __forceinline__ float toF(bf16 v) { return bf2f(v); }

typedef short bf16x8 __attribute__((ext_vector_type(8)));
typedef float f32x4 __attribute__((ext_vector_type(4)));
typedef float f32x16 __attribute__((ext_vector_type(16)));
typedef unsigned u32x4 __attribute__((ext_vector_type(4)));
typedef unsigned u32x2 __attribute__((ext_vector_type(2)));
constexpr int NTHR = 512;
constexpr int LDS_BYTES = 143360 + 16;
struct Params { const float* in[21]; float* out; unsigned char* ws; };
__device__ __forceinline__ unsigned xb_xcc_id();

typedef __bf16 bf16x2c __attribute__((ext_vector_type(2)));
__device__ __forceinline__ unsigned pk2(float lo, float hi) { bf16x2c v = { (__bf16)lo, (__bf16)hi }; return __builtin_bit_cast(unsigned, v); }

__device__ __forceinline__ void transpose_tile(const float* __restrict__ W, int K, int N, bf16* __restrict__ Wt, int kt, int nt, float* tile) {
    const int tid = threadIdx.x, k0 = kt * 64, n0 = nt * 64;
#pragma unroll
    for (int i = 0; i < 8; ++i) { const int idx = tid + i * NTHR, kk = idx >> 6, nn = idx & 63; tile[kk * 65 + nn] = (n0 + nn < N) ? W[(size_t)(k0 + kk) * N + n0 + nn] : 0.f; }
    __syncthreads();
    { const int nn = tid >> 3, ch = tid & 7; const float* s = tile + (ch * 8) * 65 + nn;
      u32x4 o; o.x = pk2(s[0], s[65]); o.y = pk2(s[130], s[195]); o.z = pk2(s[260], s[325]); o.w = pk2(s[390], s[455]);
      *(u32x4*)(Wt + (size_t)(n0 + nn) * K + k0 + ch * 8) = o; }
    __syncthreads();
}
__device__ __forceinline__ void cvt_range(const float* __restrict__ src, bf16* __restrict__ dst, size_t n8, size_t gtid, size_t gthreads) {
    for (size_t i = gtid; i < n8; i += gthreads) {
        const f32x4 a = ((const f32x4*)src)[2 * i], b = ((const f32x4*)src)[2 * i + 1];
        u32x4 o; o.x = pk2(a.x, a.y); o.y = pk2(a.z, a.w); o.z = pk2(b.x, b.y); o.w = pk2(b.z, b.w);
        ((u32x4*)dst)[i] = o;
    }
}
__device__ __forceinline__ void rms_row_bf16(const float* __restrict__ xr, const float* __restrict__ g, bf16* __restrict__ orow, int lane) {
    f32x4 v[4]; float s = 0.f;
#pragma unroll
    for (int j = 0; j < 4; ++j) { v[j] = ((const f32x4*)xr)[lane + 64 * j]; s += v[j].x * v[j].x + v[j].y * v[j].y + v[j].z * v[j].z + v[j].w * v[j].w; }
    s = wave_sum(s);
    const float r = rsqrtf(s * (1.0f / D) + EPS);
#pragma unroll
    for (int j = 0; j < 4; ++j) { const f32x4 gg = ((const f32x4*)g)[lane + 64 * j]; u32x2 o; o.x = pk2(v[j].x * r * gg.x, v[j].y * r * gg.y); o.y = pk2(v[j].z * r * gg.z, v[j].w * r * gg.w); ((u32x2*)orow)[lane + 64 * j] = o; }
}

__device__ __forceinline__ void phase0(const Params& p, unsigned char* lds) {
    float* tile = (float*)lds;
    const int nblk = gridDim.x, blk = blockIdx.x;
    unsigned char* ws = p.ws;
    constexpr int I_WIN = 16 * 56, I_WOUT = 16 * 16, I_WQ = 16 * 32, I_WG = 16 * 16, I_WP = 4 * 16, I_W1 = 2 * 32;
    constexpr int NIT = I_WIN + I_WOUT + I_WQ + I_WG + I_WP + I_W1;
    for (int it = blk; it < NIT; it += nblk) {
        int r = it;
        if (r < I_WIN) { transpose_tile(p.in[3], 1024, DIN, (bf16*)(ws + WS_WINT), r / 56, r % 56, tile); continue; } r -= I_WIN;
        if (r < I_WOUT) { transpose_tile(p.in[12], 1024, 1024, (bf16*)(ws + WS_WOUTT), r / 16, r % 16, tile); continue; } r -= I_WOUT;
        if (r < I_WQ) { transpose_tile(p.in[14], 1024, 2048, (bf16*)(ws + WS_WQT), r / 32, r % 32, tile); continue; } r -= I_WQ;
        if (r < I_WG) { transpose_tile(p.in[20], 1024, 1024, (bf16*)(ws + WS_WGT), r / 16, r % 16, tile); continue; } r -= I_WG;
        if (r < I_WP) { transpose_tile(p.in[18], 256, 1024, (bf16*)(ws + WS_WPT), r / 16, r % 16, tile); continue; } r -= I_WP;
        { const int which = r / 32, kt = r % 32; transpose_tile(p.in[9] + (size_t)which * 2048 * 64, 2048, 64, (bf16*)(ws + WS_W1T) + (size_t)which * 64 * 2048, kt, 0, tile); }
    }
    const size_t gtid = (size_t)blk * NTHR + threadIdx.x, gthreads = (size_t)nblk * NTHR;
    cvt_range(p.in[15], (bf16*)(ws + WS_KEYB), (size_t)8 * 2 * 128 * 128 / 8, gtid, gthreads);
    cvt_range(p.in[1], (bf16*)(ws + WS_PB), (size_t)NTOK * 256 / 8, gtid, gthreads);
    const int gw = (int)(gtid >> 6), ngw = (int)(gthreads >> 6), lane = threadIdx.x & 63;
    for (int m = gw; m < NTOK; m += ngw) rms_row_bf16(p.in[0] + (size_t)m * D, p.in[2], (bf16*)(ws + WS_ACT) + (size_t)m * D, lane);
    for (int m = gw; m < 2 * 16384; m += ngw) {
        const int which = m >> 14, row = m & 16383;
        const float* src = p.in[16 + which] + (size_t)row * D + lane * 16;
        const f32x4 a = *(const f32x4*)src, b = *(const f32x4*)(src + 4), c = *(const f32x4*)(src + 8), d = *(const f32x4*)(src + 12);
        float mx = fmaxf(fmaxf(fmaxf(fabsf(a.x), fabsf(a.y)), fmaxf(fabsf(a.z), fabsf(a.w))), fmaxf(fmaxf(fabsf(b.x), fabsf(b.y)), fmaxf(fabsf(b.z), fabsf(b.w))));
        mx = fmaxf(mx, fmaxf(fmaxf(fmaxf(fabsf(c.x), fabsf(c.y)), fmaxf(fabsf(c.z), fabsf(c.w))), fmaxf(fmaxf(fabsf(d.x), fabsf(d.y)), fmaxf(fabsf(d.z), fabsf(d.w)))));
        mx = fmaxf(wave_max(mx), 1e-30f);
        const float sc = 224.0f / mx;
        u32x4 o; int w;
        w = __builtin_amdgcn_cvt_pk_fp8_f32(a.x * sc, a.y * sc, 0, false); w = __builtin_amdgcn_cvt_pk_fp8_f32(a.z * sc, a.w * sc, w, true); o.x = (unsigned)w;
        w = __builtin_amdgcn_cvt_pk_fp8_f32(b.x * sc, b.y * sc, 0, false); w = __builtin_amdgcn_cvt_pk_fp8_f32(b.z * sc, b.w * sc, w, true); o.y = (unsigned)w;
        w = __builtin_amdgcn_cvt_pk_fp8_f32(c.x * sc, c.y * sc, 0, false); w = __builtin_amdgcn_cvt_pk_fp8_f32(c.z * sc, c.w * sc, w, true); o.z = (unsigned)w;
        w = __builtin_amdgcn_cvt_pk_fp8_f32(d.x * sc, d.y * sc, 0, false); w = __builtin_amdgcn_cvt_pk_fp8_f32(d.z * sc, d.w * sc, w, true); o.w = (unsigned)w;
        *(u32x4*)(ws + (which ? WS_VB : WS_UB) + (size_t)(lane >> 3) * (16384 * 128) + (size_t)row * 128 + (lane & 7) * 16) = o;
        if (lane == 0) ((float*)(ws + (which ? WS_VS : WS_US)))[row] = mx * (1.0f / 224.0f);
    }
}

__device__ __forceinline__ int swz(int ob) { return ob ^ (((ob >> 9) & 1) << 5); }
constexpr int G_STAGE = 49152;
__device__ __forceinline__ void gemm_mainloop(f32x4 (&acc)[4][4], const bf16* __restrict__ A, int lda, const bf16* __restrict__ Bt, int ldb, int K, int m0, int n0, unsigned char* lds) {
    const int tid = threadIdx.x, lane = tid & 63, wid = tid >> 6, wm = wid >> 1, wn = wid & 1, fr = lane & 15, fq = lane >> 4;
    const int lrow = tid >> 3, lc = tid & 7;
    const bf16* ag = A + (size_t)(m0 + lrow) * lda + lc * 8;
    const bf16* bg = Bt + (size_t)(n0 + lrow) * ldb + lc * 8;
    const int woff = ((lrow >> 4) * 2 + (lc >> 2)) * 1024 + swz((lrow & 15) * 64 + (lc & 3) * 16);
    const int roff = swz(fr * 64 + fq * 16);
    const int nk = K >> 6;
    u32x4 ra0[4], rb0[2], ra1[4], rb1[2];
#define GM_LOAD(ra, rb, kt) { _Pragma("unroll") for (int i = 0; i < 4; ++i) ra[i] = *(const u32x4*)(ag + (size_t)i * 64 * lda + (kt) * 64); \
                              _Pragma("unroll") for (int i = 0; i < 2; ++i) rb[i] = *(const u32x4*)(bg + (size_t)i * 64 * ldb + (kt) * 64); }
#define GM_STORE(ra, rb, buf) { _Pragma("unroll") for (int i = 0; i < 4; ++i) *(u32x4*)((buf) + woff + i * 8192) = ra[i]; \
                                _Pragma("unroll") for (int i = 0; i < 2; ++i) *(u32x4*)((buf) + 32768 + woff + i * 8192) = rb[i]; }
#define GM_COMPUTE(cur) { _Pragma("unroll") for (int s = 0; s < 2; ++s) { bf16x8 af[4], bfr[4]; \
        _Pragma("unroll") for (int i = 0; i < 4; ++i) af[i] = *(const bf16x8*)((cur) + ((wm * 4 + i) * 2 + s) * 1024 + roff); \
        _Pragma("unroll") for (int i = 0; i < 4; ++i) bfr[i] = *(const bf16x8*)((cur) + 32768 + ((wn * 4 + i) * 2 + s) * 1024 + roff); \
        _Pragma("unroll") for (int mi = 0; mi < 4; ++mi) _Pragma("unroll") for (int ni = 0; ni < 4; ++ni) acc[mi][ni] = __builtin_amdgcn_mfma_f32_16x16x32_bf16(bfr[ni], af[mi], acc[mi][ni], 0, 0, 0); } }
    unsigned char* buf0 = lds; unsigned char* buf1 = lds + G_STAGE;
    GM_LOAD(ra0, rb0, 0)
    GM_LOAD(ra1, rb1, 1)
    GM_STORE(ra0, rb0, buf0)
    __syncthreads();
    for (int kt = 0; kt < nk; kt += 2) {
        { const int kp = (kt + 2 < nk) ? kt + 2 : kt; GM_LOAD(ra0, rb0, kp) }
        GM_COMPUTE(buf0)
        GM_STORE(ra1, rb1, buf1)
        __syncthreads();
        { const int kp = (kt + 3 < nk) ? kt + 3 : kt + 1; GM_LOAD(ra1, rb1, kp) }
        GM_COMPUTE(buf1)
        if (kt + 2 < nk) GM_STORE(ra0, rb0, buf0)
        __syncthreads();
    }
}
__device__ __forceinline__ void acc_zero(f32x4 (&acc)[4][4]) {
#pragma unroll
    for (int i = 0; i < 4; ++i)
#pragma unroll
        for (int j = 0; j < 4; ++j) acc[i][j] = (f32x4){0.f, 0.f, 0.f, 0.f};
}
namespace pg8 {
#define PG8_LAS __attribute__((address_space(3)))
typedef unsigned short bf16_t;
typedef short bf16x8 __attribute__((ext_vector_type(8)));
typedef float f32x4 __attribute__((ext_vector_type(4)));
typedef unsigned u32x4 __attribute__((ext_vector_type(4)));
constexpr int BM = 256, BK = 64, HALF = 128, HTB = HALF * BK * 2  , STAGE_BYTES = 8 * HTB, NXCD = 8, WGM = 8;

__host__ __device__ __forceinline__ int lds_byte(int r, int c) { const int st = (r >> 4) * 2 + (c >> 5), rr = r & 15, cc = c & 31, ob = rr * 64 + cc * 2; return st * 1024 + (ob ^ (((ob >> 9) & 1) << 5)); }
__host__ __device__ __forceinline__ void stage_rc(int b, int& R, int& C) { const int st = b / 1024, sb = b % 1024, swz = sb ^ (((sb >> 9) & 1) << 5); R = (st >> 1) * 16 + swz / 64; C = (st & 1) * 32 + (swz % 64) / 2; }
__host__ __device__ __forceinline__ int perm32(int rho) { const int n = rho >> 4, i = rho & 15; return 8 * (i >> 2) + 4 * n + (i & 3); }

struct Unit { int pm, pn; };
struct Gemm { const bf16_t* A; const bf16_t* Bt; int M, N, K; };

struct StaticOrder {
    int nM, nN, nwg, G, c;
    __host__ __device__ void init(int M, int N, int G_, int c_) { nM = M / BM; nN = N / BM; nwg = nM * nN; G = G_; c = c_; }
    __host__ __device__ bool next(int i, Unit& u) const {
        const long L = (long)i * G + c; if (L >= nwg) return false;
        int wgid = (int)L; { const int q = nwg / NXCD, r = nwg % NXCD, xcd = wgid % NXCD, off = wgid / NXCD; wgid = (xcd < r ? xcd * (q + 1) : r * (q + 1) + (xcd - r) * q) + off; }
        const int nig = WGM * nN, gid = wgid / nig, fm = gid * WGM, gsz = (nM - fm) < WGM ? (nM - fm) : WGM;
        u.pm = fm + ((wgid % nig) % gsz); u.pn = (wgid % nig) / gsz; return true;
    }
    __device__ __forceinline__ void a_ready(const Unit&) const {}
    __device__ __forceinline__ void done(const Unit&) const {}
};

__device__ __forceinline__ unsigned pk2b(float lo, float hi) { typedef __bf16 b2 __attribute__((ext_vector_type(2))); b2 v = { (__bf16)lo, (__bf16)hi }; return __builtin_bit_cast(unsigned, v); }
typedef unsigned u32x2 __attribute__((ext_vector_type(2)));
struct EpiStoreBf16 {
    static constexpr bool PERM = false, AFTER_DRAIN = false;
    bf16_t* C; int ldc; int ncols;
    __device__ __forceinline__ void operator()(const f32x4 (&acc)[2][2][4][2], const Unit& u, int wr, int wc, int fr, int fq) const {
#pragma unroll
        for (int ai = 0; ai < 2; ++ai)
#pragma unroll
            for (int m = 0; m < 4; ++m) { bf16_t* rowp = C + (size_t)(u.pm * BM + ai * HALF + wr * 64 + m * 16 + fr) * ldc;
#pragma unroll
                for (int bj = 0; bj < 2; ++bj)
#pragma unroll
                    for (int n = 0; n < 2; ++n) { const int col = u.pn * BM + bj * HALF + wc * 32 + n * 16 + fq * 4;
                        if (col < ncols) { u32x2 w; w.x = pk2b(acc[ai][bj][m][n][0], acc[ai][bj][m][n][1]); w.y = pk2b(acc[ai][bj][m][n][2], acc[ai][bj][m][n][3]); *(u32x2*)(rowp + col) = w; } } }
    }
};
struct EpiResidF32 {
    static constexpr bool PERM = false, AFTER_DRAIN = false;
    const float* X; float* O; int ld; int pad;
    __device__ __forceinline__ void operator()(const f32x4 (&acc)[2][2][4][2], const Unit& u, int wr, int wc, int fr, int fq) const {
#pragma unroll
        for (int ai = 0; ai < 2; ++ai)
#pragma unroll
            for (int m = 0; m < 4; ++m) { const size_t ro = (size_t)(u.pm * BM + ai * HALF + wr * 64 + m * 16 + fr) * ld;
#pragma unroll
                for (int bj = 0; bj < 2; ++bj)
#pragma unroll
                    for (int n = 0; n < 2; ++n) { const size_t idx = ro + u.pn * BM + bj * HALF + wc * 32 + n * 16 + fq * 4; *(f32x4*)(O + idx) = *(const f32x4*)(X + idx) + acc[ai][bj][m][n]; } }
    }
};
struct EpiFinalGate {
    static constexpr bool PERM = false, AFTER_DRAIN = false;
    const bf16_t* PL; const float* SSQ; float* O; int ld; int ntok; float eps; int pad;
    __device__ __forceinline__ void operator()(const f32x4 (&acc)[2][2][4][2], const Unit& u, int wr, int wc, int fr, int fq) const {
#pragma unroll
        for (int ai = 0; ai < 2; ++ai)
#pragma unroll
            for (int m = 0; m < 4; ++m) { const int row = u.pm * BM + ai * HALF + wr * 64 + m * 16 + fr; const size_t ro = (size_t)row * ld;
                float tot = 0.f;
#pragma unroll
                for (int x = 0; x < 8; ++x) tot += SSQ[(size_t)x * ntok + row];
                const float rs = 1.0f / sqrtf(tot * (1.0f / 1024.0f) + eps);
#pragma unroll
                for (int bj = 0; bj < 2; ++bj)
#pragma unroll
                    for (int n = 0; n < 2; ++n) { const size_t idx = ro + u.pn * BM + bj * HALF + wc * 32 + n * 16 + fq * 4;
                        const u32x2 pw = *(const u32x2*)(PL + idx); const unsigned px = pw.x, py = pw.y;
                        f32x4 pv; pv.x = __uint_as_float(px << 16); pv.y = __uint_as_float(px & 0xffff0000u); pv.z = __uint_as_float(py << 16); pv.w = __uint_as_float(py & 0xffff0000u);
                        f32x4 g;
#pragma unroll
                        for (int e = 0; e < 4; ++e) g[e] = 1.0f / (1.0f + __expf(-rs * acc[ai][bj][m][n][e]));
                        *(f32x4*)(O + idx) = *(const f32x4*)(O + idx) + pv * g; } }
    }
};

template <class Epi, class Sched, bool ALIGN_EPI = false, bool SP2 = false>
__device__ __forceinline__ void gemm_phase(PG8_LAS unsigned char* lds, const Gemm g, const Sched& S, const Epi& E) {
    const int tid = threadIdx.x, wid = __builtin_amdgcn_readfirstlane(tid >> 6), lane = tid & 63, wr = wid >> 2, wc = wid & 3, fr = lane & 15, fq = lane >> 4;
    const int K = g.K, nt = K / BK;
    unsigned voffA[2], voffB[2];
#pragma unroll
    for (int i = 0; i < 2; ++i) { int R, C; stage_rc(tid * 16 + i * 8192, R, C); const int Rb = Epi::PERM ? ((R & ~31) + perm32(R & 31)) : R;
        voffA[i] = (unsigned)(R * K + C) * 2u; voffB[i] = (unsigned)(Rb * K + C) * 2u; }
    const size_t kstep = (size_t)(BK * 2);
    const size_t hstep = (size_t)HALF * K * 2;
    const size_t tstep = 2 * hstep;
    const unsigned ldsw = (unsigned)wid * 1024u;
    const int aoff = lds_byte(wr * 64 + fr, fq * 8), boff = lds_byte(wc * 32 + fr, fq * 8);
#define PG8_SA(b, h) (((b) * 2 + (h)) * HTB)
#define PG8_SB(b, h) ((4 + (b) * 2 + (h)) * HTB)
#define PG8_STAGE(bufoff, gbase, voff) do { _Pragma("unroll") for (int _i = 0; _i < 2; ++_i) \
        __builtin_amdgcn_global_load_lds((const unsigned*)((const char*)(gbase) + (voff)[_i]), (PG8_LAS unsigned*)(lds + (bufoff) + ldsw + _i * 8192), 16, 0, 0); } while (0)
#define PG8_LDA(dst, b, h) do { _Pragma("unroll") for (int m = 0; m < 4; ++m) _Pragma("unroll") for (int k = 0; k < 2; ++k) dst[m][k] = *(const PG8_LAS bf16x8*)(lds + PG8_SA(b, h) + aoff + m * 2048 + k * 1024); } while (0)
#define PG8_LDB(dst, b, h) do { _Pragma("unroll") for (int n = 0; n < 2; ++n) _Pragma("unroll") for (int k = 0; k < 2; ++k) dst[n][k] = *(const PG8_LAS bf16x8*)(lds + PG8_SB(b, h) + boff + n * 2048 + k * 1024); } while (0)
#define PG8_MMA(ai, bj, At, Bt) do { __builtin_amdgcn_s_setprio(1); _Pragma("unroll") for (int m = 0; m < 4; ++m) _Pragma("unroll") for (int n = 0; n < 2; ++n) _Pragma("unroll") for (int k = 0; k < 2; ++k) \
        acc[ai][bj][m][n] = __builtin_amdgcn_mfma_f32_16x16x32_bf16(Bt[n][k], At[m][k], acc[ai][bj][m][n], 0, 0, 0); __builtin_amdgcn_s_setprio(0); } while (0)
#define PG8_WAIT_V(n) asm volatile("s_waitcnt vmcnt(" #n ")" ::: "memory")
#define PG8_WAIT_L(n) asm volatile("s_waitcnt lgkmcnt(" #n ")" ::: "memory")
#define PG8_BAR __builtin_amdgcn_s_barrier()
#define PG8_SCHED __builtin_amdgcn_sched_barrier(0)
    Unit cur, nxt; int ui = 0;
    if (!S.next(0, cur)) return;
    f32x4 acc[2][2][4][2];
#pragma unroll
    for (int a = 0; a < 2; ++a)
#pragma unroll
        for (int b = 0; b < 2; ++b)
#pragma unroll
            for (int m = 0; m < 4; ++m)
#pragma unroll
                for (int n = 0; n < 2; ++n) acc[a][b][m][n] = (f32x4){0.f, 0.f, 0.f, 0.f};
    bf16x8 At[4][2], B0[2][2], B1[2][2];
    const char* cA = (const char*)g.A + (size_t)cur.pm * tstep; const char* cB = (const char*)g.Bt + (size_t)cur.pn * tstep;
    S.a_ready(cur);
    if constexpr (SP2) {
        PG8_STAGE(PG8_SB(0, 0), cB, voffB); PG8_STAGE(PG8_SB(0, 1), cB + hstep, voffB); PG8_STAGE(PG8_SA(0, 0), cA, voffA); PG8_STAGE(PG8_SA(0, 1), cA + hstep, voffA);
        if (wr == 1) PG8_BAR;
        PG8_WAIT_V(2); PG8_BAR;
        PG8_STAGE(PG8_SB(1, 0), cB + kstep, voffB); PG8_STAGE(PG8_SA(1, 0), cA + kstep, voffA); PG8_STAGE(PG8_SB(1, 1), cB + hstep + kstep, voffB);
        PG8_WAIT_V(6); PG8_BAR;
    } else {
        PG8_STAGE(PG8_SB(0, 0), cB, voffB); PG8_STAGE(PG8_SA(0, 0), cA, voffA); PG8_STAGE(PG8_SB(0, 1), cB + hstep, voffB); PG8_STAGE(PG8_SA(0, 1), cA + hstep, voffA);
        if (wr == 1) PG8_BAR;
        PG8_WAIT_V(4); PG8_BAR;
        PG8_STAGE(PG8_SB(1, 0), cB + kstep, voffB); PG8_STAGE(PG8_SA(1, 0), cA + kstep, voffA); PG8_STAGE(PG8_SB(1, 1), cB + hstep + kstep, voffB);
        PG8_WAIT_V(6); PG8_BAR;
    }
    for (;;) {
        const bool has_next = S.next(ui + 1, nxt);
        const char* nA = has_next ? (const char*)g.A + (size_t)nxt.pm * tstep : cA; const char* nB = has_next ? (const char*)g.Bt + (size_t)nxt.pn * tstep : cB;
        for (int t = 0; t < nt; t += 2) {
            const bool last = (t == nt - 2);
            const char* a1 = cA + (size_t)(t + 1) * kstep;
            const char* a2 = last ? nA : cA + (size_t)(t + 2) * kstep; const char* b2 = last ? nB : cB + (size_t)(t + 2) * kstep;
            const char* a3 = a2 + kstep; const char* b3 = b2 + kstep;
            if (last && has_next) S.a_ready(nxt);
            if constexpr (SP2) {
            PG8_LDB(B0, 0, 0); PG8_LDB(B1, 0, 1); PG8_SCHED; PG8_LDA(At, 0, 0); PG8_STAGE(PG8_SA(1, 1), a1 + hstep, voffA);
            PG8_WAIT_V(8); PG8_WAIT_L(0); PG8_BAR; PG8_MMA(0, 0, At, B0); PG8_MMA(0, 1, At, B1); PG8_BAR; PG8_SCHED;
            PG8_LDA(At, 0, 1); PG8_STAGE(PG8_SB(0, 0), b2, voffB); PG8_STAGE(PG8_SB(0, 1), b2 + hstep, voffB); PG8_STAGE(PG8_SA(0, 0), a2, voffA);
            PG8_WAIT_V(8); PG8_WAIT_L(0); PG8_BAR; PG8_MMA(1, 0, At, B0); PG8_MMA(1, 1, At, B1); PG8_BAR; PG8_SCHED;
            PG8_LDB(B0, 1, 0); PG8_LDB(B1, 1, 1); PG8_SCHED; PG8_LDA(At, 1, 0); PG8_STAGE(PG8_SA(0, 1), a2 + hstep, voffA);
            PG8_WAIT_V(8); PG8_WAIT_L(0); PG8_BAR; PG8_MMA(0, 0, At, B0); PG8_MMA(0, 1, At, B1); PG8_BAR; PG8_SCHED;
            PG8_LDA(At, 1, 1); PG8_STAGE(PG8_SB(1, 0), b3, voffB); PG8_STAGE(PG8_SB(1, 1), b3 + hstep, voffB); PG8_STAGE(PG8_SA(1, 0), a3, voffA);
            PG8_WAIT_V(8); PG8_WAIT_L(0); PG8_BAR; PG8_MMA(1, 0, At, B0); PG8_MMA(1, 1, At, B1); PG8_BAR; PG8_SCHED;
            } else {
            PG8_LDB(B0, 0, 0); PG8_SCHED; PG8_LDA(At, 0, 0); PG8_STAGE(PG8_SA(1, 1), a1 + hstep, voffA);
            PG8_WAIT_L(8); PG8_BAR; PG8_WAIT_L(0); PG8_MMA(0, 0, At, B0); PG8_BAR; PG8_SCHED;
            PG8_LDB(B1, 0, 1); PG8_STAGE(PG8_SB(0, 0), b2, voffB);
            PG8_BAR; PG8_WAIT_L(0); PG8_MMA(0, 1, At, B1); PG8_BAR;
            PG8_LDA(At, 0, 1); PG8_STAGE(PG8_SA(0, 0), a2, voffA);
            PG8_BAR; PG8_WAIT_L(0); PG8_MMA(1, 0, At, B0); PG8_BAR; PG8_SCHED;
            PG8_STAGE(PG8_SB(0, 1), b2 + hstep, voffB);
            PG8_WAIT_V(6); PG8_BAR; PG8_MMA(1, 1, At, B1); PG8_BAR;
            PG8_LDB(B0, 1, 0); PG8_SCHED; PG8_LDA(At, 1, 0); PG8_STAGE(PG8_SA(0, 1), a2 + hstep, voffA);
            PG8_WAIT_L(8); PG8_BAR; PG8_WAIT_L(0); PG8_MMA(0, 0, At, B0); PG8_BAR; PG8_SCHED;
            PG8_LDB(B1, 1, 1); PG8_STAGE(PG8_SB(1, 0), b3, voffB);
            PG8_BAR; PG8_WAIT_L(0); PG8_MMA(0, 1, At, B1); PG8_BAR;
            PG8_LDA(At, 1, 1); PG8_STAGE(PG8_SA(1, 0), a3, voffA);
            PG8_BAR; PG8_WAIT_L(0); PG8_MMA(1, 0, At, B0); PG8_BAR; PG8_SCHED;
            PG8_STAGE(PG8_SB(1, 1), b3 + hstep, voffB);
            PG8_WAIT_V(6); PG8_BAR; PG8_MMA(1, 1, At, B1); PG8_BAR;
            }
        }
        if constexpr (ALIGN_EPI) { if (wr == 0) PG8_BAR; }
        if constexpr (!Epi::AFTER_DRAIN) { E(acc, cur, wr, wc, fr, fq); S.done(cur); }
        if (!has_next) break;
#pragma unroll
        for (int a = 0; a < 2; ++a)
#pragma unroll
            for (int b = 0; b < 2; ++b)
#pragma unroll
                for (int m = 0; m < 4; ++m)
#pragma unroll
                    for (int n = 0; n < 2; ++n) acc[a][b][m][n] = (f32x4){0.f, 0.f, 0.f, 0.f};
        cur = nxt; cA = nA; cB = nB; ++ui;
        if constexpr (ALIGN_EPI) { if (wr == 1) PG8_BAR; }
    }
    PG8_WAIT_V(0);
    if constexpr (!ALIGN_EPI) { if (wr == 0) PG8_BAR; }
    PG8_BAR;
    if constexpr (Epi::AFTER_DRAIN) { E.fused(acc, cur, wr, wc, fr, fq, lds, wid, lane); S.done(cur); }
#undef PG8_SA
#undef PG8_SB
#undef PG8_STAGE
#undef PG8_LDA
#undef PG8_LDB
#undef PG8_MMA
#undef PG8_WAIT_V
#undef PG8_WAIT_L
#undef PG8_BAR
#undef PG8_SCHED
}
}

__device__ __forceinline__ void phase1(const Params& p, unsigned char* lds) {
    pg8::Gemm g{(const bf16*)(p.ws + WS_ACT), (const bf16*)(p.ws + WS_WINT), NTOK, 3584, D}; pg8::StaticOrder S; S.init(NTOK, 3584, (int)gridDim.x, (int)blockIdx.x);
    pg8::EpiStoreBf16 E{(bf16*)(p.ws + WS_PROJ), PS, DIN};
    pg8::gemm_phase<pg8::EpiStoreBf16, pg8::StaticOrder, true, true>((PG8_LAS unsigned char*)lds, g, S, E);
}


__device__ __forceinline__ void phase5(const Params& p, unsigned char* lds) {
    pg8::Gemm g{(const bf16*)(p.ws + WS_ACT), (const bf16*)(p.ws + WS_WOUTT), NTOK, D, D}; pg8::StaticOrder S; S.init(NTOK, D, (int)gridDim.x, (int)blockIdx.x);
    pg8::EpiResidF32 E{p.in[0], p.out, D, 0};
    pg8::gemm_phase<pg8::EpiResidF32, pg8::StaticOrder, true, true>((PG8_LAS unsigned char*)lds, g, S, E);
}
__device__ __forceinline__ void phase6(const Params& p, unsigned char* lds) {
    const int gw = (blockIdx.x * NTHR + threadIdx.x) >> 6, ngw = (gridDim.x * NTHR) >> 6, lane = threadIdx.x & 63;
    for (int m = gw; m < NTOK; m += ngw) rms_row_bf16(p.out + (size_t)m * D, p.in[13], (bf16*)(p.ws + WS_ACT) + (size_t)m * D, lane);
}
__device__ __forceinline__ void phase7(const Params& p, unsigned char* lds) {
    pg8::Gemm g{(const bf16*)(p.ws + WS_ACT), (const bf16*)(p.ws + WS_WQT), NTOK, 2048, D}; pg8::StaticOrder S; S.init(NTOK, 2048, (int)gridDim.x, (int)blockIdx.x);
    pg8::EpiStoreBf16 E{(bf16*)(p.ws + WS_PROJ), 2048, 2048};
    pg8::gemm_phase<pg8::EpiStoreBf16, pg8::StaticOrder, true, true>((PG8_LAS unsigned char*)lds, g, S, E);
}
__device__ __forceinline__ void phase10(const Params& p, unsigned char* lds) {
    {
        pg8::Gemm g{(const bf16*)(p.ws + WS_PB), (const bf16*)(p.ws + WS_WPT), NTOK, D, 256}; pg8::StaticOrder S; S.init(NTOK, D, (int)gridDim.x, (int)blockIdx.x);
        pg8::EpiStoreBf16 E{(bf16*)(p.ws + WS_ACT), D, D};
        pg8::gemm_phase<pg8::EpiStoreBf16, pg8::StaticOrder, true, true>((PG8_LAS unsigned char*)lds, g, S, E);
    }
    {
        pg8::Gemm g{(const bf16*)(p.ws + WS_PROJ + 64 * MiB), (const bf16*)(p.ws + WS_WGT), NTOK, D, D}; pg8::StaticOrder S; S.init(NTOK, D, (int)gridDim.x, (int)blockIdx.x);
        pg8::EpiFinalGate E{(const bf16*)(p.ws + WS_ACT), (const float*)(p.ws + WS_SSQ), p.out, D, NTOK, EPS, 0};
        pg8::gemm_phase<pg8::EpiFinalGate, pg8::StaticOrder, true, true>((PG8_LAS unsigned char*)lds, g, S, E);
    }
}

typedef __bf16 bf16x2v __attribute__((ext_vector_type(2)));
template <int CTRL> __device__ __forceinline__ float dpp_f(float v) { return __int_as_float(__builtin_amdgcn_update_dpp(0, __float_as_int(v), CTRL, 0xF, 0xF, false)); }
__device__ __forceinline__ float grp16_max(float v) { v = fmaxf(v, dpp_f<0xB1>(v)); v = fmaxf(v, dpp_f<0x4E>(v)); v = fmaxf(v, dpp_f<0x141>(v)); v = fmaxf(v, dpp_f<0x140>(v)); return v; }
__device__ __forceinline__ float grp16_sum(float v) { v += dpp_f<0xB1>(v); v += dpp_f<0x4E>(v); v += dpp_f<0x141>(v); v += dpp_f<0x140>(v); return v; }
#define CE_DESC(a, b) { const float _hi = fmaxf(a, b), _lo = fminf(a, b); a = _hi; b = _lo; }
__device__ __forceinline__ float grp16_top16(float (&v)[8], int lig) {
    CE_DESC(v[0], v[1]) CE_DESC(v[2], v[3]) CE_DESC(v[4], v[5]) CE_DESC(v[6], v[7])
    CE_DESC(v[0], v[2]) CE_DESC(v[1], v[3]) CE_DESC(v[4], v[6]) CE_DESC(v[5], v[7])
    CE_DESC(v[1], v[2]) CE_DESC(v[5], v[6])
    CE_DESC(v[0], v[4]) CE_DESC(v[1], v[5]) CE_DESC(v[2], v[6]) CE_DESC(v[3], v[7])
    CE_DESC(v[2], v[4]) CE_DESC(v[3], v[5])
    CE_DESC(v[1], v[2]) CE_DESC(v[3], v[4]) CE_DESC(v[5], v[6])
    float top = 0.f;
#pragma unroll
    for (int r = 0; r < 16; ++r) {
        const float m = grp16_max(v[0]);
        if (lig == r) top = m;
        const bool own = (v[0] == m);
#pragma unroll
        for (int j = 0; j < 7; ++j) v[j] = own ? v[j + 1] : v[j];
        v[7] = own ? -3.0e38f : v[7];
    }
    return top;
}
__device__ __forceinline__ void phase8(const Params& p, unsigned char* lds) {
    const bf16* PQ = (const bf16*)(p.ws + WS_PROJ); const bf16* KB = (const bf16*)(p.ws + WS_KEYB);
    int* ids = (int*)(p.ws + WS_IDS); float* wts = (float*)(p.ws + WS_WTS);
    float* S = (float*)lds;
    const int tid = threadIdx.x, lane = tid & 63, wid = tid >> 6, lig = tid & 15, gbase = lane & 48;
    for (int item = blockIdx.x; item < 2048; item += gridDim.x) {
        const int tok0 = (item >> 3) * 64, h = item & 7;
        {
            const int c = wid >> 2, key0 = (wid & 3) * 32, r = lane & 31, hh = lane >> 5;
            f32x16 acc0, acc1;
#pragma unroll
            for (int i = 0; i < 16; ++i) { acc0[i] = 0.f; acc1[i] = 0.f; }
            const bf16* bq = KB + ((size_t)(h * 2 + c) * 128 + key0 + r) * 128 + hh * 8;
            const bf16* aq0 = PQ + (size_t)(tok0 + r) * 2048 + h * 256 + c * 128 + hh * 8;
            const bf16* aq1 = aq0 + (size_t)32 * 2048;
#pragma unroll
            for (int s = 0; s < 8; ++s) {
                const bf16x8 b = *(const bf16x8*)(bq + s * 16), a0 = *(const bf16x8*)(aq0 + s * 16), a1 = *(const bf16x8*)(aq1 + s * 16);
                acc0 = __builtin_amdgcn_mfma_f32_32x32x16_bf16(a0, b, acc0, 0, 0, 0);
                acc1 = __builtin_amdgcn_mfma_f32_32x32x16_bf16(a1, b, acc1, 0, 0, 0);
            }
#pragma unroll
            for (int i = 0; i < 16; ++i) { const int tl = (i & 3) + 8 * (i >> 2) + 4 * hh; S[(c * 64 + tl) * 132 + key0 + r] = acc0[i]; S[(c * 64 + 32 + tl) * 132 + key0 + r] = acc1[i]; }
        }
        __syncthreads();
        {
            const int tl0 = tid >> 4;
            float ts[2][2];
#pragma unroll
            for (int rd = 0; rd < 2; ++rd)
#pragma unroll
                for (int c = 0; c < 2; ++c) {
                    float v[8];
                    const float* sp = S + (c * 64 + tl0 + 32 * rd) * 132 + lig * 8;
                    const f32x4 lo = *(const f32x4*)sp, hi = *(const f32x4*)(sp + 4);
                    v[0] = lo.x; v[1] = lo.y; v[2] = lo.z; v[3] = lo.w; v[4] = hi.x; v[5] = hi.y; v[6] = hi.z; v[7] = hi.w;
#pragma unroll
                    for (int j = 0; j < 8; ++j) v[j] = __uint_as_float((__float_as_uint(v[j]) & ~127u) | (unsigned)(lig * 8 + j));
                    ts[rd][c] = grp16_top16(v, lig);
                }
            int bp[2] = {0, 0}; float my_s[2] = {0.f, 0.f}; int my_eid[2] = {0, 0};
#pragma unroll 4
            for (int r = 0; r < 16; ++r) {
#pragma unroll
                for (int rd = 0; rd < 2; ++rd) {
                    const float other = __shfl(ts[rd][1], gbase + (bp[rd] < 15 ? bp[rd] : 15));
                    const float sum = ts[rd][0] + other;
                    const float head = (bp[rd] >= 16) ? -3.0e38f : __uint_as_float((__float_as_uint(sum) & ~15u) | (unsigned)lig);
                    const int cur_eid = (int)(((__float_as_uint(ts[rd][0]) & 127u) << 7) | (__float_as_uint(other) & 127u));
                    const float m = grp16_max(head);
                    const int owner = (int)(__float_as_uint(m) & 15u);
                    const int ew = __shfl(cur_eid, gbase + owner);
                    if (lig == r) { my_s[rd] = m; my_eid[rd] = ew; }
                    if (lig == owner) ++bp[rd];
                }
            }
#pragma unroll
            for (int rd = 0; rd < 2; ++rd) {
                const int tl = tl0 + 32 * rd;
                const float mx = grp16_max(my_s[rd]);
                const float e = __expf(my_s[rd] - mx);
                const float sm = grp16_sum(e);
                const size_t o = (size_t)(tok0 + tl) * 128 + h * 16 + lig;
                ((unsigned short*)ids)[(size_t)(tok0 + tl) * 128 + (h >> 2) * 64 + (lig & 7) * 8 + (h & 3) * 2 + (lig >> 3)] = (unsigned short)my_eid[rd]; wts[o] = e / sm;
            }
        }
        __syncthreads();
    }
}

__device__ __forceinline__ void hgrn_pre_item(const Params& p, unsigned char* lds, int ci) {
    const int tid = threadIdx.x, lane = tid & 63, wid = tid >> 6, k = tid & 127, tq = tid >> 7;
    const int n = ci & 127, h = (ci >> 7) & 3, b = ci >> 9, tok0 = b * T + n * 64;
    bf16* proj = (bf16*)(p.ws + WS_PROJ);
    float* OB = p.out; bf16* KIT = (bf16*)((unsigned char*)p.out + OUT_KIT) + (size_t)ci * 8192; bf16* VTg = (bf16*)((unsigned char*)p.out + OUT_VT) + (size_t)ci * 8192;
    float* DEC = (float*)(p.ws + WS_DEC) + (size_t)ci * 128;
    bf16* QT = (bf16*)lds; bf16* KT = (bf16*)(lds + 17408); bf16* VTl = (bf16*)(lds + 34816); bf16* AM = (bf16*)(lds + 53248);
    float* part = (float*)(lds + 62464); float* gref = (float*)(lds + 64512);
    float lb; { const float l0 = p.in[4][h * 128 + k], l1 = p.in[4][512 + h * 128 + k]; const float m = fmaxf(l0, l1); const float e0 = __expf(l0 - m), e1 = __expf(l1 - m); lb = e0 / (e0 + e1); }
    float G[16], key[16], qv[16], vv[16];
    {
        float c = 0.f;
#pragma unroll
        for (int i = 0; i < 16; ++i) {
            const size_t row = (size_t)(tok0 + tq * 16 + i) * PS;
            const float fg = lb + (1.0f - lb) * sigmoidf_(bf2f(proj[row + C_HF + h * 128 + k]));
            key[i] = 1.0f - fg; c += __logf(fg); G[i] = c;
            qv[i] = siluf_(bf2f(proj[row + C_HQ + h * 128 + k])) * 0.08838834764831845f;
            vv[i] = bf2f(proj[row + C_HI + h * 128 + k]);
        }
        part[tq * 128 + k] = c;
    }
    __syncthreads();
    {
        float off = 0.f;
#pragma unroll
        for (int j = 0; j < 3; ++j) off += (j < tq) ? part[j * 128 + k] : 0.f;
#pragma unroll
        for (int i = 0; i < 16; ++i) G[i] += off;
        if (tq == 1) gref[k] = G[15];
        if (tq == 3) gref[128 + k] = G[15];
    }
    __syncthreads();
    {
        const float gr = gref[k], gl = gref[128 + k];
        const int kpos = (k & ~31) | (((k >> 2) & 3) << 3) | (((k >> 4) & 1) << 2) | (k & 3);
        unsigned kp[8], vp[8];
#pragma unroll
        for (int i = 0; i < 16; i += 2) {
            kp[i >> 1] = pk2(key[i] * __expf(gl - G[i]), key[i + 1] * __expf(gl - G[i + 1]));
            vp[i >> 1] = pk2(vv[i], vv[i + 1]);
        }
#pragma unroll
        for (int i = 0; i < 16; ++i) {
            const int t = tq * 16 + i;
            QT[t * 136 + k] = f2bf(qv[i] * __expf(G[i] - gr));
            KT[t * 136 + k] = f2bf(key[i] * __expf(gr - G[i]));
            proj[(size_t)(tok0 + t) * PS + C_HQ + h * 128 + kpos] = f2bf(qv[i] * __expf(G[i]));
        }
        u32x4 a0, a1, b0, b1; a0.x = kp[0]; a0.y = kp[1]; a0.z = kp[2]; a0.w = kp[3]; a1.x = kp[4]; a1.y = kp[5]; a1.z = kp[6]; a1.w = kp[7];
        b0.x = vp[0]; b0.y = vp[1]; b0.z = vp[2]; b0.w = vp[3]; b1.x = vp[4]; b1.y = vp[5]; b1.z = vp[6]; b1.w = vp[7];
        *(u32x4*)(KIT + k * 64 + tq * 16) = a0; *(u32x4*)(KIT + k * 64 + tq * 16 + 8) = a1;
        *(u32x4*)(VTg + k * 64 + tq * 16) = b0; *(u32x4*)(VTg + k * 64 + tq * 16 + 8) = b1;
        *(u32x4*)(VTl + k * 72 + tq * 16) = b0; *(u32x4*)(VTl + k * 72 + tq * 16 + 8) = b1;
        if (tq == 3) DEC[k] = __expf(gl);
    }
    __syncthreads();
    const int fr = lane & 15, fq = lane >> 4;
    {
        const int tt = wid >> 1;
#pragma unroll
        for (int e = 0; e < 2; ++e) {
            const int st = 2 * (wid & 1) + e;
            f32x4 acc = (f32x4){0.f, 0.f, 0.f, 0.f};
            if (st <= tt) {
#pragma unroll
                for (int s = 0; s < 4; ++s) {
                    const bf16x8 a = *(const bf16x8*)(QT + (tt * 16 + fr) * 136 + s * 32 + fq * 8), bb = *(const bf16x8*)(KT + (st * 16 + fr) * 136 + s * 32 + fq * 8);
                    acc = __builtin_amdgcn_mfma_f32_16x16x32_bf16(a, bb, acc, 0, 0, 0);
                }
            }
#pragma unroll
            for (int r = 0; r < 4; ++r) { const int t = tt * 16 + fq * 4 + r, sp = st * 16 + fr; AM[t * 72 + sp] = f2bf(sp <= t ? acc[r] : 0.f); }
        }
    }
    __syncthreads();
    {
        const int tt = wid >> 1;
        const bf16x8 a0 = *(const bf16x8*)(AM + (tt * 16 + fr) * 72 + fq * 8), a1 = *(const bf16x8*)(AM + (tt * 16 + fr) * 72 + 32 + fq * 8);
#pragma unroll
        for (int e = 0; e < 4; ++e) {
            const int vt = (wid & 1) * 4 + e;
            const bf16x8 b0 = *(const bf16x8*)(VTl + (vt * 16 + fr) * 72 + fq * 8), b1 = *(const bf16x8*)(VTl + (vt * 16 + fr) * 72 + 32 + fq * 8);
            f32x4 acc = (f32x4){0.f, 0.f, 0.f, 0.f};
            acc = __builtin_amdgcn_mfma_f32_16x16x32_bf16(a0, b0, acc, 0, 0, 0);
            acc = __builtin_amdgcn_mfma_f32_16x16x32_bf16(a1, b1, acc, 0, 0, 0);
#pragma unroll
            for (int r = 0; r < 4; ++r) OB[(size_t)(tok0 + tt * 16 + fq * 4 + r) * 512 + h * 128 + vt * 16 + fr] = acc[r];
        }
    }
    __syncthreads();
}
template <bool DUMMY>
__device__ __forceinline__ void hgrn_scan_item(const Params& p, int wi) {
    const int lane = threadIdx.x & 63, fr = lane & 15, fq = lane >> 4;
    const int vs = wi & 7, bh = wi >> 3, h = bh & 3, b = bh >> 2;
    const bf16* proj = (const bf16*)(p.ws + WS_PROJ);
    float* OB = p.out; const bf16* KIT = (const bf16*)((unsigned char*)p.out + OUT_KIT); const bf16* VTg = (const bf16*)((unsigned char*)p.out + OUT_VT);
    const float* DEC = (const float*)(p.ws + WS_DEC);
    f32x4 S[8];
#pragma unroll
    for (int i = 0; i < 8; ++i) S[i] = (f32x4){0.f, 0.f, 0.f, 0.f};
#pragma unroll 1
    for (int n = 0; n < 128; ++n) {
        const int ci = bh * 128 + n, tok0 = b * T + n * 64;
        bf16x8 qf[4][4];
#pragma unroll
        for (int tt = 0; tt < 4; ++tt)
#pragma unroll
            for (int s = 0; s < 4; ++s) qf[tt][s] = *(const bf16x8*)(proj + (size_t)(tok0 + tt * 16 + fr) * PS + C_HQ + h * 128 + s * 32 + fq * 8);
        float oin[4][4];
#pragma unroll
        for (int tt = 0; tt < 4; ++tt)
#pragma unroll
            for (int r = 0; r < 4; ++r) oin[tt][r] = OB[(size_t)(tok0 + tt * 16 + fq * 4 + r) * 512 + h * 128 + vs * 16 + fr];
        bf16x8 Sb[4];
#pragma unroll
        for (int s = 0; s < 4; ++s) {
            u32x4 w; w.x = pk2(S[2 * s][0], S[2 * s][1]); w.y = pk2(S[2 * s][2], S[2 * s][3]); w.z = pk2(S[2 * s + 1][0], S[2 * s + 1][1]); w.w = pk2(S[2 * s + 1][2], S[2 * s + 1][3]);
            Sb[s] = __builtin_bit_cast(bf16x8, w);
        }
#pragma unroll
        for (int tt = 0; tt < 4; ++tt) {
            f32x4 acc = (f32x4){0.f, 0.f, 0.f, 0.f};
#pragma unroll
            for (int s = 0; s < 4; ++s) acc = __builtin_amdgcn_mfma_f32_16x16x32_bf16(qf[tt][s], Sb[s], acc, 0, 0, 0);
#pragma unroll
            for (int r = 0; r < 4; ++r) { const size_t oi = (size_t)(tok0 + tt * 16 + fq * 4 + r) * 512 + h * 128 + vs * 16 + fr; if (DUMMY) ((float*)(p.ws + WS_SPARE))[oi & 0x3fffff] = oin[tt][r] + acc[r]; else OB[oi] = oin[tt][r] + acc[r]; }
        }
        const bf16x8 v0 = *(const bf16x8*)(VTg + (size_t)ci * 8192 + (vs * 16 + fr) * 64 + fq * 8), v1 = *(const bf16x8*)(VTg + (size_t)ci * 8192 + (vs * 16 + fr) * 64 + 32 + fq * 8);
#pragma unroll
        for (int kb = 0; kb < 8; ++kb) {
            const bf16x8 k0 = *(const bf16x8*)(KIT + (size_t)ci * 8192 + (kb * 16 + fr) * 64 + fq * 8), k1 = *(const bf16x8*)(KIT + (size_t)ci * 8192 + (kb * 16 + fr) * 64 + 32 + fq * 8);
            const f32x4 dv = *(const f32x4*)(DEC + (size_t)ci * 128 + kb * 16 + fq * 4);
            f32x4 sacc = S[kb] * dv;
            sacc = __builtin_amdgcn_mfma_f32_16x16x32_bf16(k0, v0, sacc, 0, 0, 0);
            sacc = __builtin_amdgcn_mfma_f32_16x16x32_bf16(k1, v1, sacc, 0, 0, 0);
            S[kb] = sacc;
        }
    }
}

__device__ __forceinline__ void hgrn_scan_block(const Params& p, unsigned char* lds, int sb) {
    const int tid = threadIdx.x, lane = tid & 63, wid = __builtin_amdgcn_readfirstlane(tid >> 6), fr = lane & 15, fq = lane >> 4;
    const int bh = sb >> 2, vs = (sb & 3) * 2 + (wid & 1); const bool worker = wid < 2;
    const int h = bh & 3, b = bh >> 2;
    const bf16* proj = (const bf16*)(p.ws + WS_PROJ);
    float* OB = p.out; const bf16* KIT = (const bf16*)((unsigned char*)p.out + OUT_KIT); const bf16* VTg = (const bf16*)((unsigned char*)p.out + OUT_VT);
    const float* DEC = (const float*)(p.ws + WS_DEC);
    constexpr int BUF = 54784, O_KIT = 17408, O_VT = 17408 + 18432, O_DEC = 17408 + 2 * 18432;
    u32x4 rqA[2], rkA[2], rvA[2], rdA, rqB[2], rkB[2], rvB[2], rdB;
    float oin[4][4];
#define SC_ISSUE(rq, rk, rv, rd, n_) { const int ci_ = bh * 128 + (n_), tk_ = b * T + (n_) * 64; \
        _Pragma("unroll") for (int i = 0; i < 2; ++i) { const int id = tid + i * NTHR; \
            rq[i] = *(const u32x4*)(proj + (size_t)(tk_ + (id >> 4)) * PS + C_HQ + h * 128 + (id & 15) * 8); \
            rk[i] = *(const u32x4*)(KIT + (size_t)ci_ * 8192 + id * 8); rv[i] = *(const u32x4*)(VTg + (size_t)ci_ * 8192 + id * 8); } \
        if (tid < 32) rd = *(const u32x4*)(DEC + (size_t)ci_ * 128 + tid * 4); }
#define SC_STASH(rq, rk, rv, rd, buf) { _Pragma("unroll") for (int i = 0; i < 2; ++i) { const int id = tid + i * NTHR; \
            *(u32x4*)((buf) + (id >> 4) * 272 + (id & 15) * 16) = rq[i]; *(u32x4*)((buf) + O_KIT + (id >> 3) * 144 + (id & 7) * 16) = rk[i]; \
            *(u32x4*)((buf) + O_VT + (id >> 3) * 144 + (id & 7) * 16) = rv[i]; } \
        if (tid < 32) *(u32x4*)((buf) + O_DEC + tid * 16) = rd; }
    auto load_oin = [&](int n) {
        const int tok0 = b * T + n * 64;
#pragma unroll
        for (int tt = 0; tt < 4; ++tt)
#pragma unroll
            for (int r = 0; r < 4; ++r) oin[tt][r] = OB[(size_t)(tok0 + tt * 16 + fq * 4 + r) * 512 + h * 128 + vs * 16 + fr];
    };
    f32x4 S[8];
#pragma unroll
    for (int i = 0; i < 8; ++i) S[i] = (f32x4){0.f, 0.f, 0.f, 0.f};
    SC_ISSUE(rqA, rkA, rvA, rdA, 0)
    SC_ISSUE(rqB, rkB, rvB, rdB, 1)
    SC_STASH(rqA, rkA, rvA, rdA, lds)
    if (worker) load_oin(0);
    __syncthreads();
    auto compute = [&](int n, unsigned char* cur) {
        const int tok0 = b * T + n * 64;
        const int nn = (n + 1 < 128) ? n + 1 : n;
        bf16x8 Sb[4];
#pragma unroll
        for (int s = 0; s < 4; ++s) {
            u32x4 w; w.x = pk2(S[2 * s][0], S[2 * s][1]); w.y = pk2(S[2 * s][2], S[2 * s][3]); w.z = pk2(S[2 * s + 1][0], S[2 * s + 1][1]); w.w = pk2(S[2 * s + 1][2], S[2 * s + 1][3]);
            Sb[s] = __builtin_bit_cast(bf16x8, w);
        }
        float ores[4][4];
#pragma unroll
        for (int tt = 0; tt < 4; ++tt) {
            f32x4 acc = (f32x4){0.f, 0.f, 0.f, 0.f};
#pragma unroll
            for (int s = 0; s < 4; ++s) { const bf16x8 qf = *(const bf16x8*)(cur + (tt * 16 + fr) * 272 + (s * 32 + fq * 8) * 2); acc = __builtin_amdgcn_mfma_f32_16x16x32_bf16(qf, Sb[s], acc, 0, 0, 0); }
#pragma unroll
            for (int r = 0; r < 4; ++r) ores[tt][r] = oin[tt][r] + acc[r];
        }
#pragma unroll
        for (int tt = 0; tt < 4; ++tt)
#pragma unroll
            for (int r = 0; r < 4; ++r) OB[(size_t)(tok0 + tt * 16 + fq * 4 + r) * 512 + h * 128 + vs * 16 + fr] = ores[tt][r];
        load_oin(nn);
        const bf16x8 v0 = *(const bf16x8*)(cur + O_VT + (vs * 16 + fr) * 144 + fq * 16), v1 = *(const bf16x8*)(cur + O_VT + (vs * 16 + fr) * 144 + 64 + fq * 16);
#pragma unroll
        for (int kb = 0; kb < 8; ++kb) {
            const bf16x8 k0 = *(const bf16x8*)(cur + O_KIT + (kb * 16 + fr) * 144 + fq * 16), k1 = *(const bf16x8*)(cur + O_KIT + (kb * 16 + fr) * 144 + 64 + fq * 16);
            const f32x4 dv = *(const f32x4*)(cur + O_DEC + (kb * 16 + fq * 4) * 4);
            f32x4 sacc = S[kb] * dv;
            sacc = __builtin_amdgcn_mfma_f32_16x16x32_bf16(k0, v0, sacc, 0, 0, 0);
            sacc = __builtin_amdgcn_mfma_f32_16x16x32_bf16(k1, v1, sacc, 0, 0, 0);
            S[kb] = sacc;
        }
    };
#pragma unroll 1
    for (int n = 0; n < 128; n += 2) {
        { const int n2 = (n + 2 < 128) ? n + 2 : n; SC_ISSUE(rqA, rkA, rvA, rdA, n2) }
        __builtin_amdgcn_sched_barrier(0);
        if (worker) compute(n, lds);
        SC_STASH(rqB, rkB, rvB, rdB, lds + BUF)
        asm volatile("s_waitcnt lgkmcnt(0)" ::: "memory"); __builtin_amdgcn_s_barrier(); asm volatile("" ::: "memory");
        { const int n3 = (n + 3 < 128) ? n + 3 : n + 1; SC_ISSUE(rqB, rkB, rvB, rdB, n3) }
        __builtin_amdgcn_sched_barrier(0);
        if (worker) compute(n + 1, lds + BUF);
        SC_STASH(rqA, rkA, rvA, rdA, lds)
        asm volatile("s_waitcnt lgkmcnt(0)" ::: "memory"); __builtin_amdgcn_s_barrier(); asm volatile("" ::: "memory");
    }
#undef SC_ISSUE
#undef SC_STASH
}
__device__ __forceinline__ void phase4(const Params& p, unsigned char* lds) {
    const bf16* proj = (const bf16*)(p.ws + WS_PROJ); const float* OB = p.out; bf16* mixed = (bf16*)(p.ws + WS_ACT); const float* gain = p.in[5];
    const int lane = threadIdx.x & 63, gw = (blockIdx.x * NTHR + threadIdx.x) >> 6, ngw = (gridDim.x * NTHR) >> 6;
    for (int tok = gw; tok < NTOK; tok += ngw) {
        const f32x4 o0 = *(const f32x4*)(OB + (size_t)tok * 512 + lane * 8), o1 = *(const f32x4*)(OB + (size_t)tok * 512 + lane * 8 + 4);
        const u32x4 gp = *(const u32x4*)(proj + (size_t)tok * PS + C_HG + lane * 8);
        const f32x4 g0 = *(const f32x4*)(gain + lane * 8), g1 = *(const f32x4*)(gain + lane * 8 + 4);
        float ss = o0.x * o0.x + o0.y * o0.y + o0.z * o0.z + o0.w * o0.w + o1.x * o1.x + o1.y * o1.y + o1.z * o1.z + o1.w * o1.w;
        ss = grp16_sum(ss);
        const float r = rsqrtf(ss * (1.0f / 128.0f) + EPS);
        const unsigned gx = gp.x, gy = gp.y, gz = gp.z, gw_ = gp.w;
        u32x4 w;
        w.x = pk2(o0.x * r * g0.x * siluf_(__uint_as_float(gx << 16)), o0.y * r * g0.y * siluf_(__uint_as_float(gx & 0xffff0000u)));
        w.y = pk2(o0.z * r * g0.z * siluf_(__uint_as_float(gy << 16)), o0.w * r * g0.w * siluf_(__uint_as_float(gy & 0xffff0000u)));
        w.z = pk2(o1.x * r * g1.x * siluf_(__uint_as_float(gz << 16)), o1.y * r * g1.y * siluf_(__uint_as_float(gz & 0xffff0000u)));
        w.w = pk2(o1.z * r * g1.z * siluf_(__uint_as_float(gw_ << 16)), o1.w * r * g1.w * siluf_(__uint_as_float(gw_ & 0xffff0000u)));
        *(u32x4*)(mixed + (size_t)tok * D + lane * 8) = w;
    }
}

#define WAVE_LDS_SYNC() asm volatile("s_waitcnt lgkmcnt(0)" ::: "memory")
__device__ __forceinline__ void nsa_prep_item(const Params& p, unsigned char* lds, int tile) {
    const int tid = threadIdx.x, lig = tid & 15;
    const int tok0 = tile * 64;
    bf16* proj = (bf16*)(p.ws + WS_PROJ);
    for (int rho = tid >> 4; rho < 768; rho += 32) {
        const int tl = rho / 12, which = rho - tl * 12;
        int col; const float* gain; float sc = 1.0f;
        if (which < 8) { col = C_NQ + which * 64; gain = p.in[6]; sc = 0.125f * 1.4426950408889634f; }
        else if (which < 10) { col = C_KS + (which - 8) * 64; gain = p.in[7] + 64; }
        else { col = C_KW + (which - 10) * 64; gain = p.in[7] + 128; }
        bf16* rp = proj + (size_t)(tok0 + tl) * PS + col + lig * 4;
        const u32x2 raw = *(const u32x2*)rp;
        const unsigned r0 = raw.x, r1 = raw.y;
        const float a = __uint_as_float(r0 << 16), b = __uint_as_float(r0 & 0xffff0000u), c = __uint_as_float(r1 << 16), d = __uint_as_float(r1 & 0xffff0000u);
        const float ss = grp16_sum(a * a + b * b + c * c + d * d);
        const float r = rsqrtf(ss * (1.0f / 64.0f) + EPS) * sc;
        const f32x4 gg = *(const f32x4*)(gain + lig * 4);
        u32x2 o; o.x = pk2(a * r * gg.x, b * r * gg.y); o.y = pk2(c * r * gg.z, d * r * gg.w);
        if (which < 8) *(u32x2*)rp = o;
        else {
            const int g = (which - 8) & 1, tok = tok0 + tl, b = tok / T, t = tok % T;
            unsigned char* kb = p.ws + (which < 10 ? WS_KFS : WS_KFW) + ((size_t)(b * 2 + g) * 256 + (t >> 5)) * 4096;
            *(u32x2*)(kb + (lig >> 2) * 1024 + ((t & 31) + 32 * ((lig >> 1) & 1)) * 16 + (lig & 1) * 8) = o;
        }
    }
    {
        const int c = tid & 127, tq = tid >> 7, g = c >> 6, d = c & 63, b = tok0 / T, t0 = tok0 % T;
#pragma unroll
        for (int which = 0; which < 2; ++which) {
            const int col = (which == 0 ? C_VS : C_VW) + c;
            unsigned short e[16];
#pragma unroll
            for (int i = 0; i < 16; ++i) e[i] = proj[(size_t)(tok0 + tq * 16 + i) * PS + col];
            unsigned char* vb = p.ws + (which == 0 ? WS_VTS : WS_VTW) + ((size_t)(b * 2 + g) * 256 + ((t0 + tq * 16) >> 5)) * 4096 + ((d >> 5) * 2 + (tq & 1)) * 1024 + (d & 31) * 16;
            u32x4 h0, h1;
            h0.x = e[0] | ((unsigned)e[1] << 16); h0.y = e[2] | ((unsigned)e[3] << 16); h0.z = e[8] | ((unsigned)e[9] << 16); h0.w = e[10] | ((unsigned)e[11] << 16);
            h1.x = e[4] | ((unsigned)e[5] << 16); h1.y = e[6] | ((unsigned)e[7] << 16); h1.z = e[12] | ((unsigned)e[13] << 16); h1.w = e[14] | ((unsigned)e[15] << 16);
            *(u32x4*)vb = h0; *(u32x4*)(vb + 512) = h1;
        }
    }
}
__device__ __forceinline__ void nsa_cmp_item(const Params& p, unsigned char* lds, int item) {
    const int tid = threadIdx.x, lane = tid & 63, wid = tid >> 6, fr = lane & 15, fq = lane >> 4;
    const int nt32 = item & 15, g = (item >> 4) & 1, b = (item >> 5) & 1, which = item >> 6, n0 = nt32 * 32;
    const bf16* proj = (const bf16*)(p.ws + WS_PROJ);
    const float* pe = p.in[8] + which * 2048;
    const bf16* W1T = (const bf16*)(p.ws + WS_W1T) + (size_t)which * 64 * 2048;
    const float* w2 = p.in[10] + which * 4096;
    bf16* A = (bf16*)lds; float* H = (float*)(lds + 33280);
    const int col0 = (which == 0 ? C_KC : C_VC) + g * 64;
    const int nt = wid & 1, ct = wid >> 1;
    f32x4 acc = (f32x4){0.f, 0.f, 0.f, 0.f};
#pragma unroll 1
    for (int kc = 0; kc < 4; ++kc) {
#pragma unroll
        for (int i = 0; i < 4; ++i) {
            const int idx = tid + i * NTHR, dch = idx & 7, jj = (idx >> 3) & 7, n = idx >> 6, j = kc * 8 + jj;
            u32x4 o = (u32x4){0u, 0u, 0u, 0u};
            if (n0 + n < NCMP) {
                const u32x4 raw = *(const u32x4*)(proj + (size_t)(b * T + 16 * (n0 + n) + j) * PS + col0 + dch * 8);
                const f32x4 p0 = *(const f32x4*)(pe + j * 64 + dch * 8), p1 = *(const f32x4*)(pe + j * 64 + dch * 8 + 4);
                const unsigned r0 = raw.x, r1 = raw.y, r2 = raw.z, r3 = raw.w;
                o.x = pk2(__uint_as_float(r0 << 16) + p0.x, __uint_as_float(r0 & 0xffff0000u) + p0.y);
                o.y = pk2(__uint_as_float(r1 << 16) + p0.z, __uint_as_float(r1 & 0xffff0000u) + p0.w);
                o.z = pk2(__uint_as_float(r2 << 16) + p1.x, __uint_as_float(r2 & 0xffff0000u) + p1.y);
                o.w = pk2(__uint_as_float(r3 << 16) + p1.z, __uint_as_float(r3 & 0xffff0000u) + p1.w);
            }
            *(u32x4*)(A + n * 520 + jj * 64 + dch * 8) = o;
        }
        __syncthreads();
#pragma unroll 4
        for (int s = 0; s < 16; ++s) {
            const bf16x8 a = *(const bf16x8*)(A + (nt * 16 + fr) * 520 + s * 32 + fq * 8);
            const bf16x8 bb = *(const bf16x8*)(W1T + (size_t)(ct * 16 + fr) * 2048 + kc * 512 + s * 32 + fq * 8);
            acc = __builtin_amdgcn_mfma_f32_16x16x32_bf16(a, bb, acc, 0, 0, 0);
        }
        __syncthreads();
    }
#pragma unroll
    for (int r = 0; r < 4; ++r) H[(nt * 16 + fq * 4 + r) * 64 + ct * 16 + fr] = gelu_tanh(acc[r]);
    __syncthreads();
    {
        const int n = tid >> 4, c = (tid & 15) * 4;
        f32x4 o = (f32x4){0.f, 0.f, 0.f, 0.f};
#pragma unroll 8
        for (int i = 0; i < 64; ++i) { const float hv = H[n * 64 + i]; const f32x4 w = *(const f32x4*)(w2 + i * 64 + c); o += hv * w; }
        if (which == 0) {
            const float ss = grp16_sum(o.x * o.x + o.y * o.y + o.z * o.z + o.w * o.w);
            const float r = rsqrtf(ss * (1.0f / 64.0f) + EPS);
            const f32x4 gg = *(const f32x4*)(p.in[7] + c);
            o = o * r * gg;
        }
        if (n0 + n >= NCMP) o = (f32x4){0.f, 0.f, 0.f, 0.f};
        const int nn = n0 + n;
        if (which == 0) { u32x2 w; w.x = pk2(o.x, o.y); w.y = pk2(o.z, o.w);
            *(u32x2*)(p.ws + WS_KC + ((size_t)(b * 2 + g) * 16 + (nn >> 5)) * 4096 + (c >> 4) * 1024 + ((nn & 31) + 32 * ((c >> 3) & 1)) * 16 + (c & 7) * 2) = w; }
        else {
            const int kl = nn & 31, sst = kl >> 4, r = kl & 15, j = ((r >> 3) << 2) | (r & 3), hh = (r >> 2) & 1;
            bf16* vt = (bf16*)(p.ws + WS_VCT + ((size_t)(b * 2 + g) * 16 + (nn >> 5)) * 4096 + sst * 1024 + hh * 512 + j * 2);
            const float ov[4] = {o.x, o.y, o.z, o.w};
#pragma unroll
            for (int e = 0; e < 4; ++e) { const int dd = c + e; vt[((dd >> 5) * 2048 + (dd & 31) * 16) / 2] = f2bf(ov[e]); }
        }
    }
    __syncthreads();
}

constexpr float LOG2E = 1.4426950408889634f;
__device__ __forceinline__ int rho16(int reg, int hh) { return (reg & 3) + 8 * (reg >> 2) + 4 * hh; }
__device__ __forceinline__ bf16x8 pack8(const float* pv) {
    u32x4 w; w.x = pk2(pv[0], pv[1]); w.y = pk2(pv[2], pv[3]); w.z = pk2(pv[4], pv[5]); w.w = pk2(pv[6], pv[7]);
    return __builtin_bit_cast(bf16x8, w);
}
struct KF { bf16x8 f[4]; };
struct VF { bf16x8 f[4]; };
__device__ __forceinline__ void load_k(KF& k, const unsigned char* tp) {
#pragma unroll
    for (int s = 0; s < 4; ++s) k.f[s] = *(const bf16x8*)(tp + s * 1024);
}
__device__ __forceinline__ void load_v(VF& v, const unsigned char* tp) {
#pragma unroll
    for (int q = 0; q < 4; ++q) v.f[q] = *(const bf16x8*)(tp + q * 1024);
}
__device__ __forceinline__ f32x16 score_tile(const KF& k, const bf16x8 (&qf)[4], float slope, float base) {
    f32x16 st;
#pragma unroll
    for (int i = 0; i < 16; ++i) st[i] = fmaf(slope, (float)((i & 3) + 8 * (i >> 2)), base);
#pragma unroll
    for (int s = 0; s < 4; ++s) st = __builtin_amdgcn_mfma_f32_32x32x16_bf16(k.f[s], qf[s], st, 0, 0, 0);
    return st;
}
__device__ __forceinline__ void pv_tile(f32x16& o0, f32x16& o1, const VF& v, const float* pv) {
    const bf16x8 p0 = pack8(pv), p1 = pack8(pv + 8);
    o0 = __builtin_amdgcn_mfma_f32_32x32x16_bf16(v.f[0], p0, o0, 0, 0, 0); o0 = __builtin_amdgcn_mfma_f32_32x32x16_bf16(v.f[1], p1, o0, 0, 0, 0);
    o1 = __builtin_amdgcn_mfma_f32_32x32x16_bf16(v.f[2], p0, o1, 0, 0, 0); o1 = __builtin_amdgcn_mfma_f32_32x32x16_bf16(v.f[3], p1, o1, 0, 0, 0);
}
template <bool FAST>
__device__ __forceinline__ void attn_tile(const KF& kc, const VF& vf, const bf16x8 (&qf)[4], float slope, float base, int distbase, bool colsel, int wlimit,
                                          float& l, f32x16& o0, f32x16& o1) {
    const f32x16 st = score_tile(kc, qf, slope, base);
    float sv[16]; float ps = 0.f;
#pragma unroll
    for (int i = 0; i < 16; ++i) {
        float e = __builtin_amdgcn_exp2f(st[i]);
        if (!FAST) { const int dist = distbase - ((i & 3) + 8 * (i >> 2)); e = (colsel && dist >= 0 && dist < wlimit) ? e : 0.f; }
        sv[i] = e; ps += e;
    }
    l += ps;
    pv_tile(o0, o1, vf, sv);
}
__device__ __forceinline__ void nsa_attn_item(const Params& p, unsigned char* wlds, int item) {
    const int lane = threadIdx.x & 63, c = lane & 31, hh = lane >> 5, jt = c >> 2, r4 = c & 3;
    const int oct = item & 1023, g = (item >> 10) & 1, b = item >> 11;
    const int t0 = oct * 8, tc = t0 + jt, h = g * 4 + r4;
    const float slope = exp2f(-(float)(h + 1)) * LOG2E;
    const bf16* proj = (const bf16*)(p.ws + WS_PROJ);
    float* impA = (float*)wlds; float* impB = impA + 1024; unsigned* msk = (unsigned*)(impB + 1024);
    unsigned char* blist = (unsigned char*)(msk + 32);
    float* ocl = (float*)(wlds + 8448) + lane;
#pragma unroll
    for (int i = 0; i < 16; ++i) { impA[lane + 64 * i] = 0.f; impB[lane + 64 * i] = 0.f; }
    if (lane < 32) msk[lane] = 0u;
    bf16x8 qf[4];
    { const bf16* qp = proj + (size_t)(b * T + tc) * PS + C_NQ + h * 64 + hh * 8;
#pragma unroll
      for (int s = 0; s < 4; ++s) qf[s] = *(const bf16x8*)(qp + s * 16); }
    const bf16* gatep = proj + (size_t)(b * T + tc) * PS + C_GT + h * 3;
#define NSA_GATE(i) sigmoidf_(bf2f(gatep[i]))
    float bnd[3];
    { const float gq = wave_max(fabsf(p.in[6][lane]));
#pragma unroll
      for (int i = 0; i < 3; ++i) bnd[i] = __uint_as_float((unsigned)__builtin_amdgcn_readfirstlane((int)__float_as_uint(8.0f * LOG2E * 1.02f * gq * wave_max(fabsf(p.in[7][i * 64 + lane]))))); }
    WAVE_LDS_SYNC();
    {
        const unsigned char* KC = p.ws + WS_KC + (size_t)(b * 2 + g) * 65536 + lane * 16;
        const unsigned char* VCT = p.ws + WS_VCT + (size_t)(b * 2 + g) * 65536 + lane * 16;
        const int nmax = (t0 + 7 >= 31) ? ((t0 + 7 - 31) >> 4) : -1;
        const int nlast = (nmax >= 0) ? (nmax & ~31) : -32;
        float l = 0.f;
        f32x16 o0, o1;
#pragma unroll
        for (int i = 0; i < 16; ++i) { o0[i] = 0.f; o1[i] = 0.f; }
        KF kn;
        if (nlast >= 0) load_k(kn, KC + (size_t)nlast * 128);
#pragma unroll 1
        for (int n0 = nlast; n0 >= 0; n0 -= 32) {
            const KF kc = kn;
            load_k(kn, KC + (size_t)(n0 >= 32 ? n0 - 32 : n0) * 128);
            __builtin_amdgcn_sched_barrier(0);
            const int distbase = tc - 16 * (n0 + 4 * hh) - 31;
            const f32x16 st = score_tile(kc, qf, 16.0f * slope, -slope * (float)distbase - bnd[0]);
            float ps = 0.f;
#pragma unroll
            for (int i = 0; i < 16; ++i) { const int dist = distbase - 16 * ((i & 3) + 8 * (i >> 2)); ps += (dist >= 0) ? __builtin_amdgcn_exp2f(st[i]) : 0.f; }
            l += ps;
        }
        l += __shfl_xor(l, 32);
        const float inv = (l > 0.f) ? 1.0f / l : 0.f;
        if (nlast >= 0) load_k(kn, KC + (size_t)nlast * 128);
#pragma unroll 1
        for (int n0 = nlast; n0 >= 0; n0 -= 32) {
            const KF kc = kn; VF vf;
            load_v(vf, VCT + (size_t)n0 * 128);
            load_k(kn, KC + (size_t)(n0 >= 32 ? n0 - 32 : n0) * 128);
            __builtin_amdgcn_sched_barrier(0);
            const int distbase = tc - 16 * (n0 + 4 * hh) - 31;
            const f32x16 st = score_tile(kc, qf, 16.0f * slope, -slope * (float)distbase - bnd[0]);
            float pv[16];
#pragma unroll
            for (int i = 0; i < 16; ++i) { const int dist = distbase - 16 * ((i & 3) + 8 * (i >> 2)); pv[i] = (dist >= 0) ? __builtin_amdgcn_exp2f(st[i]) * inv : 0.f; }
            pv_tile(o0, o1, vf, pv);
#pragma unroll
            for (int i = 0; i < 16; ++i) { float v = pv[i]; v += dpp_f<0xB1>(v); v += dpp_f<0x4E>(v); pv[i] = v; }
            if (r4 == 0) {
#pragma unroll
                for (int rg = 0; rg < 4; ++rg) {
                    const int jb = (n0 >> 2) + 2 * rg + hh;
                    impA[jt * 128 + jb] = pv[4 * rg] + 2.f * pv[4 * rg + 1] + 2.f * pv[4 * rg + 2] + 2.f * pv[4 * rg + 3];
                    if (jb >= 1) impB[jt * 128 + jb - 1] = pv[4 * rg];
                }
            }
        }
        { const float g0 = NSA_GATE(0);
#pragma unroll
        for (int i = 0; i < 16; ++i) { ocl[i * 64] = g0 * o0[i]; ocl[(16 + i) * 64] = g0 * o1[i]; } }
    }
    WAVE_LDS_SYNC();
    {
        const int lig = lane & 15, grp = lane >> 4;
#pragma unroll 1
        for (int half = 0; half < 2; ++half) {
            const int j2 = half * 4 + grp, cur = (t0 + j2) >> 6;
            float v[8];
#pragma unroll
            for (int e = 0; e < 8; ++e) {
                const int j = lig * 8 + e; const float val = impA[j2 * 128 + j] + impB[j2 * 128 + j];
                v[e] = (j >= 1 && j <= cur - 2) ? __uint_as_float((__float_as_uint(val) & ~127u) | (unsigned)(127 - j)) : -1.0f;
            }
            const float top = grp16_top16(v, lig);
            const int need = 16 - ((cur == 0) ? 1 : (cur == 1) ? 2 : 3);
            if (lig < need && top >= 0.f) { const int idx = 127 - (int)(__float_as_uint(top) & 127u); atomicOr(&msk[j2 * 4 + (idx >> 5)], 1u << (idx & 31)); }
            if (lig == 0) { atomicOr(&msk[j2 * 4], 1u); atomicOr(&msk[j2 * 4 + (cur >> 5)], 1u << (cur & 31)); if (cur >= 1) atomicOr(&msk[j2 * 4 + ((cur - 1) >> 5)], 1u << ((cur - 1) & 31)); }
        }
    }
    WAVE_LDS_SYNC();
    {
        int nblk = 0;
#pragma unroll
        for (int w = 3; w >= 0; --w) {
            unsigned u = 0u;
#pragma unroll
            for (int j = 0; j < 8; ++j) u |= msk[j * 4 + w];
            u = (unsigned)__builtin_amdgcn_readfirstlane((int)u);
            while (u) { const int bit = 31 - __builtin_clz(u); u &= ~(1u << bit); if (lane == 0) blist[nblk] = (unsigned char)(w * 32 + bit); ++nblk; }
        }
        WAVE_LDS_SYNC();
        const unsigned char* KS = p.ws + WS_KFS + (size_t)(b * 2 + g) * (256 * 4096) + lane * 16;
        const unsigned char* VTS = p.ws + WS_VTS + (size_t)(b * 2 + g) * (256 * 4096) + lane * 16;
        float l = 0.f;
        f32x16 o0, o1;
#pragma unroll
        for (int i = 0; i < 16; ++i) { o0[i] = 0.f; o1[i] = 0.f; }
        const int ntile = 2 * nblk;
        KF kn; VF vn;
        { const int jb0 = blist[0]; load_k(kn, KS + (size_t)(jb0 * 64 + 32) * 128); load_v(vn, VTS + (size_t)(jb0 * 64 + 32) * 128); }
#pragma unroll 1
        for (int ti = 0; ti < ntile; ++ti) {
            const int jb = __builtin_amdgcn_readfirstlane((int)blist[ti >> 1]);
            const int key0 = jb * 64 + 32 - 32 * (ti & 1);
            const KF kc = kn; const VF vf = vn;
            { const int tn = (ti + 1 < ntile) ? ti + 1 : ti; const int jn = __builtin_amdgcn_readfirstlane((int)blist[tn >> 1]); const size_t off = (size_t)(jn * 64 + 32 - 32 * (tn & 1)) * 128;
              load_k(kn, KS + off); load_v(vn, VTS + off); }
            __builtin_amdgcn_sched_barrier(0);
            const bool colsel = (msk[jt * 4 + (jb >> 5)] >> (jb & 31)) & 1u;
            const int distbase = tc - key0 - 4 * hh;
            if (key0 + 31 <= t0) attn_tile<true>(kc, vf, qf, slope, colsel ? -slope * (float)distbase - bnd[1] : -1e30f, distbase, true, 1 << 30, l, o0, o1);
            else attn_tile<false>(kc, vf, qf, slope, -slope * (float)distbase - bnd[1], distbase, colsel, 1 << 30, l, o0, o1);
        }
        l += __shfl_xor(l, 32);
        const float sc = (l > 0.f) ? NSA_GATE(1) / l : 0.f;
#pragma unroll
        for (int i = 0; i < 16; ++i) { ocl[i * 64] += sc * o0[i]; ocl[(16 + i) * 64] += sc * o1[i]; }
    }
    {
        const unsigned char* KW = p.ws + WS_KFW + (size_t)(b * 2 + g) * (256 * 4096) + lane * 16;
        const unsigned char* VTW = p.ws + WS_VTW + (size_t)(b * 2 + g) * (256 * 4096) + lane * 16;
        float l = 0.f;
        f32x16 o0, o1;
#pragma unroll
        for (int i = 0; i < 16; ++i) { o0[i] = 0.f; o1[i] = 0.f; }
        const int kstart = (t0 - 511 > 0 ? t0 - 511 : 0) & ~31, kfirst = t0 & ~31;
        KF kn;
        load_k(kn, KW + (size_t)kfirst * 128);
#pragma unroll 1
        for (int key0 = kfirst; key0 >= kstart; key0 -= 32) {
            const KF kc = kn; VF vf;
            load_v(vf, VTW + (size_t)key0 * 128);
            { const int kn0 = (key0 - 32 >= kstart) ? key0 - 32 : key0; load_k(kn, KW + (size_t)kn0 * 128); }
            __builtin_amdgcn_sched_barrier(0);
            const int distbase = tc - key0 - 4 * hh;
            if (key0 + 31 <= t0 && key0 >= t0 - 504) attn_tile<true>(kc, vf, qf, slope, -slope * (float)distbase - bnd[2], distbase, true, 512, l, o0, o1);
            else attn_tile<false>(kc, vf, qf, slope, -slope * (float)distbase - bnd[2], distbase, true, 512, l, o0, o1);
        }
        l += __shfl_xor(l, 32);
        const float sc = (l > 0.f) ? NSA_GATE(2) / l : 0.f;
#pragma unroll
        for (int i = 0; i < 16; ++i) { o0[i] = ocl[i * 64] + sc * o0[i]; o1[i] = ocl[(16 + i) * 64] + sc * o1[i]; }
        float ss = 0.f;
#pragma unroll
        for (int i = 0; i < 16; ++i) ss += o0[i] * o0[i] + o1[i] * o1[i];
        ss += __shfl_xor(ss, 32);
        const float r = rsqrtf(ss * (1.0f / 64.0f) + EPS);
        const float* og = p.in[11] + h * 64;
        bf16* op = (bf16*)(p.ws + WS_ACT) + (size_t)(b * T + tc) * D + 512 + h * 64;
#pragma unroll
        for (int dt = 0; dt < 2; ++dt)
#pragma unroll
            for (int rg = 0; rg < 4; ++rg) {
                const int d0 = dt * 32 + 8 * rg + 4 * hh;
                const f32x4 gg = *(const f32x4*)(og + d0);
                u32x2 w;
                if (dt == 0) { w.x = pk2(o0[4 * rg] * r * gg.x, o0[4 * rg + 1] * r * gg.y); w.y = pk2(o0[4 * rg + 2] * r * gg.z, o0[4 * rg + 3] * r * gg.w); }
                else { w.x = pk2(o1[4 * rg] * r * gg.x, o1[4 * rg + 1] * r * gg.y); w.y = pk2(o1[4 * rg + 2] * r * gg.z, o1[4 * rg + 3] * r * gg.w); }
                *(u32x2*)(op + d0) = w;
            }
    }
    WAVE_LDS_SYNC();
}
__device__ __forceinline__ void phase2(const Params& p, unsigned char* lds) {
    unsigned* ctr = (unsigned*)(p.ws + WS_CTR) + 2048;
    volatile int* slot = (volatile int*)(lds + LDS_BYTES - 32);
    for (;;) {
        if (threadIdx.x == 0) *slot = (int)atomicAdd(ctr, 1u);
        __syncthreads();
        const int it = *slot;
        __syncthreads();
        if (it >= 128 + 1024 + 256) break;
        if (it < 128) nsa_cmp_item(p, lds, it);
        else if (it < 1152) hgrn_pre_item(p, lds, it - 128);
        else { nsa_prep_item(p, lds, it - 1152); __syncthreads(); }
    }
}
template <bool SCAN>
__device__ __forceinline__ void phase3(const Params& p, unsigned char* lds) {
    const int wid = __builtin_amdgcn_readfirstlane((int)(threadIdx.x >> 6));
    if (SCAN && blockIdx.x < 32) hgrn_scan_block(p, lds, blockIdx.x);
    unsigned* ctr = (unsigned*)(p.ws + WS_CTR) + (SCAN ? 0 : 128);
    const int myx = (int)(xb_xcc_id() & 7u);
    for (;;) {
        int q = -1, it = 0;
        for (int k = 0; k < 8; ++k) {
            const int x = (myx + k) & 7;
            int v = 0;
            if ((threadIdx.x & 63) == 0) v = (int)atomicAdd(ctr + x * 16, 1u);
            v = __builtin_amdgcn_readfirstlane(v);
            if (v < 512) { q = x; it = v; break; }
        }
        if (q < 0) break;
        const int item = ((q >> 1) << 10) | ((q & 1) * 512 + 511 - it);
        nsa_attn_item(p, lds + wid * 16640, item);
    }
}

__device__ __forceinline__ float dot2u(unsigned a, unsigned b, float acc) { return __builtin_amdgcn_fdot2_f32_bf16(__builtin_bit_cast(bf16x2v, a), __builtin_bit_cast(bf16x2v, b), acc, false); }
__device__ __forceinline__ float dot8(u32x4 a, u32x4 b, float acc) {
    const unsigned a0 = a.x, a1 = a.y, a2 = a.z, a3 = a.w, b0 = b.x, b1 = b.y, b2 = b.z, b3 = b.w;
    acc = dot2u(a0, b0, acc); acc = dot2u(a1, b1, acc); acc = dot2u(a2, b2, acc); acc = dot2u(a3, b3, acc);
    return acc;
}
__device__ __forceinline__ void axpy8(float (&o)[8], float c, u32x4 v) {
    o[0] += c * __uint_as_float(v.x << 16); o[1] += c * __uint_as_float(v.x & 0xffff0000u);
    o[2] += c * __uint_as_float(v.y << 16); o[3] += c * __uint_as_float(v.y & 0xffff0000u);
    o[4] += c * __uint_as_float(v.z << 16); o[5] += c * __uint_as_float(v.z & 0xffff0000u);
    o[6] += c * __uint_as_float(v.w << 16); o[7] += c * __uint_as_float(v.w & 0xffff0000u);
}
typedef float f32x2 __attribute__((ext_vector_type(2)));
__device__ __forceinline__ float dot16_fp8(u32x4 r, const float* xf) {
    const unsigned r0 = r.x, r1 = r.y, r2 = r.z, r3 = r.w; f32x2 t; float a0, a1;
    t = __builtin_amdgcn_cvt_pk_f32_fp8((int)r0, false); a0 = t.x * xf[0]; a1 = t.y * xf[1];
    t = __builtin_amdgcn_cvt_pk_f32_fp8((int)r0, true); a0 = fmaf(t.x, xf[2], a0); a1 = fmaf(t.y, xf[3], a1);
    t = __builtin_amdgcn_cvt_pk_f32_fp8((int)r1, false); a0 = fmaf(t.x, xf[4], a0); a1 = fmaf(t.y, xf[5], a1);
    t = __builtin_amdgcn_cvt_pk_f32_fp8((int)r1, true); a0 = fmaf(t.x, xf[6], a0); a1 = fmaf(t.y, xf[7], a1);
    t = __builtin_amdgcn_cvt_pk_f32_fp8((int)r2, false); a0 = fmaf(t.x, xf[8], a0); a1 = fmaf(t.y, xf[9], a1);
    t = __builtin_amdgcn_cvt_pk_f32_fp8((int)r2, true); a0 = fmaf(t.x, xf[10], a0); a1 = fmaf(t.y, xf[11], a1);
    t = __builtin_amdgcn_cvt_pk_f32_fp8((int)r3, false); a0 = fmaf(t.x, xf[12], a0); a1 = fmaf(t.y, xf[13], a1);
    t = __builtin_amdgcn_cvt_pk_f32_fp8((int)r3, true); a0 = fmaf(t.x, xf[14], a0); a1 = fmaf(t.y, xf[15], a1);
    return a0 + a1;
}
__device__ __forceinline__ void axpy16_fp8(float* o, float c, u32x4 r) {
    const unsigned r0 = r.x, r1 = r.y, r2 = r.z, r3 = r.w; f32x2 t;
    t = __builtin_amdgcn_cvt_pk_f32_fp8((int)r0, false); o[0] += c * t.x; o[1] += c * t.y; t = __builtin_amdgcn_cvt_pk_f32_fp8((int)r0, true); o[2] += c * t.x; o[3] += c * t.y;
    t = __builtin_amdgcn_cvt_pk_f32_fp8((int)r1, false); o[4] += c * t.x; o[5] += c * t.y; t = __builtin_amdgcn_cvt_pk_f32_fp8((int)r1, true); o[6] += c * t.x; o[7] += c * t.y;
    t = __builtin_amdgcn_cvt_pk_f32_fp8((int)r2, false); o[8] += c * t.x; o[9] += c * t.y; t = __builtin_amdgcn_cvt_pk_f32_fp8((int)r2, true); o[10] += c * t.x; o[11] += c * t.y;
    t = __builtin_amdgcn_cvt_pk_f32_fp8((int)r3, false); o[12] += c * t.x; o[13] += c * t.y; t = __builtin_amdgcn_cvt_pk_f32_fp8((int)r3, true); o[14] += c * t.x; o[15] += c * t.y;
}
template <bool DUMMY>
__device__ __forceinline__ void phase9(const Params& p, unsigned char* lds) {
    const bf16* HN = (const bf16*)(p.ws + WS_ACT); const unsigned char* UB = p.ws + WS_UB; const unsigned char* VB = p.ws + WS_VB;
    const float* US = (const float*)(p.ws + WS_US); const float* VS = (const float*)(p.ws + WS_VS);
    const int* ids = (const int*)(p.ws + WS_IDS); const float* wts = (const float*)(p.ws + WS_WTS);
    float* O = p.out; bf16* HG = (bf16*)(p.ws + WS_PROJ + 64 * MiB); const float* gn = p.in[19];
    const int lane = threadIdx.x & 63, gw = (blockIdx.x * NTHR + threadIdx.x) >> 6, ngw = (gridDim.x * NTHR) >> 6;
    for (int tok = gw; tok < NTOK; tok += ngw) {
        float xf[16], oa[16];
        {
            const u32x4 x0 = *(const u32x4*)(HN + (size_t)tok * D + lane * 16), x1 = *(const u32x4*)(HN + (size_t)tok * D + lane * 16 + 8);
            const unsigned a0 = x0.x, a1 = x0.y, a2 = x0.z, a3 = x0.w, b0 = x1.x, b1 = x1.y, b2 = x1.z, b3 = x1.w;
            xf[0] = __uint_as_float(a0 << 16); xf[1] = __uint_as_float(a0 & 0xffff0000u); xf[2] = __uint_as_float(a1 << 16); xf[3] = __uint_as_float(a1 & 0xffff0000u);
            xf[4] = __uint_as_float(a2 << 16); xf[5] = __uint_as_float(a2 & 0xffff0000u); xf[6] = __uint_as_float(a3 << 16); xf[7] = __uint_as_float(a3 & 0xffff0000u);
            xf[8] = __uint_as_float(b0 << 16); xf[9] = __uint_as_float(b0 & 0xffff0000u); xf[10] = __uint_as_float(b1 << 16); xf[11] = __uint_as_float(b1 & 0xffff0000u);
            xf[12] = __uint_as_float(b2 << 16); xf[13] = __uint_as_float(b2 & 0xffff0000u); xf[14] = __uint_as_float(b3 << 16); xf[15] = __uint_as_float(b3 & 0xffff0000u);
        }
#pragma unroll
        for (int j = 0; j < 16; ++j) oa[j] = 0.f;
#pragma unroll 1
        for (int half = 0; half < 2; ++half) {
            const int myid = ids[(size_t)tok * 128 + half * 64 + lane];
            const float myw = wts[(size_t)tok * 128 + half * 64 + lane] * VS[myid];
            const float myus = US[myid];
#pragma unroll 1
            for (int eb = 0; eb < 64; eb += 16) {
                int id[16]; float d[16]; u32x4 ur[16];
#pragma unroll
                for (int j = 0; j < 16; ++j) id[j] = __shfl(myid, eb + j);
#pragma unroll
                for (int j = 0; j < 16; ++j) ur[j] = *(const u32x4*)(UB + (size_t)id[j] * D + lane * 16);
#pragma unroll
                for (int j = 0; j < 16; ++j) d[j] = dot16_fp8(ur[j], xf);
#pragma unroll
                for (int j = 0; j < 16; ++j) ur[j] = *(const u32x4*)(VB + (size_t)id[j] * D + lane * 16);
#pragma unroll
                for (int j = 0; j < 16; ++j) d[j] = wave_sum(d[j]);
#pragma unroll
                for (int j = 0; j < 16; ++j) { const float c = __shfl(myw, eb + j) * gelu_tanh(d[j] * __shfl(myus, eb + j)); axpy16_fp8(oa, c, ur[j]); }
            }
        }
        float* orow = O + (size_t)tok * D + lane * 16; float* wrow = DUMMY ? (float*)(p.ws + WS_PROJ) + (size_t)tok * D + lane * 16 : orow;
        float ss = 0.f; f32x4 hv[4];
#pragma unroll
        for (int q = 0; q < 4; ++q) {
            f32x4 h = *(const f32x4*)(orow + 4 * q);
            h.x += oa[4 * q]; h.y += oa[4 * q + 1]; h.z += oa[4 * q + 2]; h.w += oa[4 * q + 3];
            *(f32x4*)(wrow + 4 * q) = h; hv[q] = h;
            ss += h.x * h.x + h.y * h.y + h.z * h.z + h.w * h.w;
        }
        ss = wave_sum(ss);
        const float r = rsqrtf(ss * (1.0f / D) + EPS);
        u32x4 q0, q1;
        { const f32x4 g0 = *(const f32x4*)(gn + lane * 16), g1 = *(const f32x4*)(gn + lane * 16 + 4), g2 = *(const f32x4*)(gn + lane * 16 + 8), g3 = *(const f32x4*)(gn + lane * 16 + 12);
          q0.x = pk2(hv[0].x * r * g0.x, hv[0].y * r * g0.y); q0.y = pk2(hv[0].z * r * g0.z, hv[0].w * r * g0.w); q0.z = pk2(hv[1].x * r * g1.x, hv[1].y * r * g1.y); q0.w = pk2(hv[1].z * r * g1.z, hv[1].w * r * g1.w);
          q1.x = pk2(hv[2].x * r * g2.x, hv[2].y * r * g2.y); q1.y = pk2(hv[2].z * r * g2.z, hv[2].w * r * g2.w); q1.z = pk2(hv[3].x * r * g3.x, hv[3].y * r * g3.y); q1.w = pk2(hv[3].z * r * g3.z, hv[3].w * r * g3.w); }
        *(u32x4*)(HG + (size_t)tok * D + lane * 16) = q0; *(u32x4*)(HG + (size_t)tok * D + lane * 16 + 8) = q1;
    }
}


__device__ __forceinline__ unsigned xb_xcc_id();
template <int CTRL> __device__ __forceinline__ float dpp_row_ror(float v) { return __int_as_float(__builtin_amdgcn_update_dpp(0, __float_as_int(v), CTRL, 0xF, 0xF, false)); }
__device__ __forceinline__ float grp8_sum(float v) { v += dpp_f<0xB1>(v); v += dpp_f<0x4E>(v); v += dpp_f<0x141>(v); return v; }
__device__ __forceinline__ int peer_next_item(unsigned* ctr, int myx, int& slice) {
    for (int k = 0; k < 8; ++k) {
        const int x = (myx + k) & 7;
        int it = 0;
        if ((threadIdx.x & 63) == 0) it = (int)atomicAdd(ctr + x * 16, 1u);
        it = __builtin_amdgcn_readfirstlane(it);
        if (it < 1024) { slice = x; return it; }
    }
    return -1;
}
__device__ __forceinline__ void unpack16(const u32x4 x0, const u32x4 x1, float* xf) {
    const unsigned a0 = x0.x, a1 = x0.y, a2 = x0.z, a3 = x0.w, b0 = x1.x, b1 = x1.y, b2 = x1.z, b3 = x1.w;
    xf[0] = __uint_as_float(a0 << 16); xf[1] = __uint_as_float(a0 & 0xffff0000u); xf[2] = __uint_as_float(a1 << 16); xf[3] = __uint_as_float(a1 & 0xffff0000u);
    xf[4] = __uint_as_float(a2 << 16); xf[5] = __uint_as_float(a2 & 0xffff0000u); xf[6] = __uint_as_float(a3 << 16); xf[7] = __uint_as_float(a3 & 0xffff0000u);
    xf[8] = __uint_as_float(b0 << 16); xf[9] = __uint_as_float(b0 & 0xffff0000u); xf[10] = __uint_as_float(b1 << 16); xf[11] = __uint_as_float(b1 & 0xffff0000u);
    xf[12] = __uint_as_float(b2 << 16); xf[13] = __uint_as_float(b2 & 0xffff0000u); xf[14] = __uint_as_float(b3 << 16); xf[15] = __uint_as_float(b3 & 0xffff0000u);
}
__device__ __forceinline__ void unpack_ids(const u32x4 r, int* id) {
    const unsigned a = r.x, b = r.y, c = r.z, d = r.w;
    id[0] = a & 0xffff; id[1] = a >> 16; id[2] = b & 0xffff; id[3] = b >> 16; id[4] = c & 0xffff; id[5] = c >> 16; id[6] = d & 0xffff; id[7] = d >> 16;
}
__device__ __forceinline__ void phase9a(const Params& p, unsigned char* lds) {
    const bf16* HN = (const bf16*)(p.ws + WS_ACT); const unsigned char* UB = p.ws + WS_UB;
    const unsigned short* ids = (const unsigned short*)(p.ws + WS_IDS); float* PD = (float*)(p.ws + WS_PROJ);
    unsigned* ctr = (unsigned*)(p.ws + WS_CTR) + 256;
    const int lane = threadIdx.x & 63, gq = lane >> 3, cl = lane & 7, myx = (int)(xb_xcc_id() & 7u);
    for (;;) {
        int x; const int it = peer_next_item(ctr, myx, x);
        if (it < 0) break;
        const unsigned char* ub = UB + (size_t)x * (16384 * 128) + cl * 16;
        const bf16* hn = HN + x * 128 + cl * 16;
        const int tokb = it * 16;
        const unsigned short* ip = ids + (size_t)tokb * 128 + gq * 8;
        int idn[8]; u32x4 bufA[8], bufB[8], xa0, xa1, xb0, xb1, idr;
        idr = *(const u32x4*)ip; unpack_ids(idr, idn);
#pragma unroll
        for (int i = 0; i < 8; ++i) bufA[i] = *(const u32x4*)(ub + (size_t)idn[i] * 128);
        xa0 = *(const u32x4*)(hn + (size_t)tokb * D); xa1 = *(const u32x4*)(hn + (size_t)tokb * D + 8);
        idr = *(const u32x4*)(ip + 64); unpack_ids(idr, idn);
#pragma unroll
        for (int i = 0; i < 8; ++i) bufB[i] = *(const u32x4*)(ub + (size_t)idn[i] * 128);
        xb0 = xa0; xb1 = xa1;
        idr = *(const u32x4*)(ip + 128);
#define P9A_STEP(buf, x0, x1, u) { const int u2_ = ((u) + 2 < 32) ? (u) + 2 : (u), u3_ = ((u) + 3 < 32) ? (u) + 3 : (u); \
            unpack_ids(idr, idn); idr = *(const u32x4*)(ip + u3_ * 64); \
            float xf[16]; unpack16(x0, x1, xf); \
            x0 = *(const u32x4*)(hn + (size_t)(tokb + (u2_ >> 1)) * D); x1 = *(const u32x4*)(hn + (size_t)(tokb + (u2_ >> 1)) * D + 8); \
            float keep = 0.f; \
            __builtin_amdgcn_sched_barrier(0); \
            _Pragma("unroll") for (int i = 0; i < 8; ++i) { const float d = grp8_sum(dot16_fp8(buf[i], xf)); if (i == cl) keep = d; buf[i] = *(const u32x4*)(ub + (size_t)idn[i] * 128); __builtin_amdgcn_sched_barrier(0); } \
            PD[((size_t)x * NTOK + tokb + ((u) >> 1)) * 128 + (((u) & 1) * 8 + cl) * 8 + gq] = keep; }
#pragma unroll 1
        for (int u = 0; u < 32; u += 2) {
            P9A_STEP(bufA, xa0, xa1, u)
            P9A_STEP(bufB, xb0, xb1, u + 1)
        }
#undef P9A_STEP
    }
}
__device__ __forceinline__ void phase9c(const Params& p, unsigned char* lds) {
    const unsigned short* ids = (const unsigned short*)(p.ws + WS_IDS); const float* wts = (const float*)(p.ws + WS_WTS); const float* PD = (const float*)(p.ws + WS_PROJ);
    const float* US = (const float*)(p.ws + WS_US); const float* VS = (const float*)(p.ws + WS_VS); float* coefT = (float*)(p.ws + WS_COEFT);
    const size_t gtid = (size_t)blockIdx.x * NTHR + threadIdx.x, gth = (size_t)gridDim.x * NTHR;
    for (size_t idx = gtid; idx < (size_t)NTOK * 128; idx += gth) {
        const size_t tok = idx >> 7; const int r = (int)(idx & 127), e = (r & 64) + (r & 7) * 8 + ((r >> 3) & 7);
        float sdot = 0.f;
#pragma unroll
        for (int x = 0; x < 8; ++x) sdot += PD[(size_t)x * NTOK * 128 + tok * 128 + e];
        const int id = ids[idx];
        coefT[idx] = wts[tok * 128 + e] * VS[id] * gelu_tanh(sdot * US[id]);
    }
}
__device__ __forceinline__ void phase9b(const Params& p, unsigned char* lds) {
    const unsigned char* VB = p.ws + WS_VB; const unsigned short* ids = (const unsigned short*)(p.ws + WS_IDS); const float* coef = (const float*)(p.ws + WS_COEFT);
    float* O = p.out; bf16* HG = (bf16*)(p.ws + WS_PROJ + 64 * MiB); const float* gn = p.in[19]; float* SSQ = (float*)(p.ws + WS_SSQ);
    unsigned* ctr = (unsigned*)(p.ws + WS_CTR) + 512;
    const int lane = threadIdx.x & 63, gq = lane >> 3, cl = lane & 7, myx = (int)(xb_xcc_id() & 7u);
    for (;;) {
        int x; const int it = peer_next_item(ctr, myx, x);
        if (it < 0) break;
        const unsigned char* vb = VB + (size_t)x * (16384 * 128) + cl * 16;
        const int tokb = it * 16;
        const unsigned short* ip = ids + (size_t)tokb * 128 + gq * 8;
        const float* cp = coef + (size_t)tokb * 128 + gq * 8;
        int idn[8]; u32x4 buf[8], idr; f32x4 cf0, cf1, cn0, cn1; float acc[16];
#pragma unroll
        for (int j = 0; j < 16; ++j) acc[j] = 0.f;
        idr = *(const u32x4*)ip; unpack_ids(idr, idn);
        cf0 = *(const f32x4*)cp; cf1 = *(const f32x4*)(cp + 4);
#pragma unroll
        for (int i = 0; i < 8; ++i) buf[i] = *(const u32x4*)(vb + (size_t)idn[i] * 128);
        idr = *(const u32x4*)(ip + 64); cn0 = *(const f32x4*)(cp + 64); cn1 = *(const f32x4*)(cp + 68);
#pragma unroll 1
        for (int u = 0; u < 32; ++u) {
            const int u2 = (u + 2 < 32) ? u + 2 : u;
            unpack_ids(idr, idn);
            const f32x4 c0 = cf0, c1 = cf1; cf0 = cn0; cf1 = cn1;
            idr = *(const u32x4*)(ip + u2 * 64); cn0 = *(const f32x4*)(cp + u2 * 64); cn1 = *(const f32x4*)(cp + u2 * 64 + 4);
            const float cfv[8] = {c0.x, c0.y, c0.z, c0.w, c1.x, c1.y, c1.z, c1.w};
            __builtin_amdgcn_sched_barrier(0);
#pragma unroll
            for (int i = 0; i < 8; ++i) { axpy16_fp8(acc, cfv[i], buf[i]); buf[i] = *(const u32x4*)(vb + (size_t)idn[i] * 128); __builtin_amdgcn_sched_barrier(0); }
            if (u & 1) {
                const int tok = tokb + (u >> 1);
#pragma unroll
                for (int j = 0; j < 16; ++j) { float v = acc[j]; v += __shfl_xor(v, 8); v += __shfl_xor(v, 16); v += __shfl_xor(v, 32); acc[j] = v; }
                float ss = 0.f;
                if (gq == 0) {
                    float* orow = O + (size_t)tok * D + x * 128 + cl * 16; const float* gr = gn + x * 128 + cl * 16; u32x4 q0, q1; unsigned qq[8];
#pragma unroll
                    for (int q = 0; q < 4; ++q) {
                        f32x4 hv = *(const f32x4*)(orow + 4 * q); const f32x4 gg = *(const f32x4*)(gr + 4 * q);
                        hv.x += acc[4 * q]; hv.y += acc[4 * q + 1]; hv.z += acc[4 * q + 2]; hv.w += acc[4 * q + 3];
                        *(f32x4*)(orow + 4 * q) = hv;
                        ss += hv.x * hv.x + hv.y * hv.y + hv.z * hv.z + hv.w * hv.w;
                        qq[2 * q] = pk2(hv.x * gg.x, hv.y * gg.y); qq[2 * q + 1] = pk2(hv.z * gg.z, hv.w * gg.w);
                    }
                    q0.x = qq[0]; q0.y = qq[1]; q0.z = qq[2]; q0.w = qq[3]; q1.x = qq[4]; q1.y = qq[5]; q1.z = qq[6]; q1.w = qq[7];
                    *(u32x4*)(HG + (size_t)tok * D + x * 128 + cl * 16) = q0; *(u32x4*)(HG + (size_t)tok * D + x * 128 + cl * 16 + 8) = q1;
                }
                ss = grp8_sum(ss);
                if (lane == 0) SSQ[(size_t)x * NTOK + tok] = ss;
#pragma unroll
                for (int j = 0; j < 16; ++j) acc[j] = 0.f;
            }
        }
    }
}

#define XB_TMO      128
#define XB_XCNT(j)  (256  + 64 * (j))
#define XB_XSUB(j)  (1280 + 64 * (j))
#define XB_XGEN(j)  (2304 + 64 * (j))
#define XB_TOP      3328
#define XB_TOPGEN   3392
#define XCD_BAR_WORDS 3456
#define XB_SPIN_CAP (1u << 18)
#define LAS __attribute__((address_space(3)))
__device__ __forceinline__ unsigned xb_ld(unsigned* p)              { return __hip_atomic_load(p, __ATOMIC_RELAXED, __HIP_MEMORY_SCOPE_AGENT); }
__device__ __forceinline__ unsigned xb_add(unsigned* p, unsigned v) { return __hip_atomic_fetch_add(p, v, __ATOMIC_RELAXED, __HIP_MEMORY_SCOPE_AGENT); }
__device__ __forceinline__ unsigned xb_xcc_id() { return (unsigned)__builtin_amdgcn_s_getreg((3 << 11) | 20) & 0xFu; }
#define XB_SPIN(cond, bar) do { unsigned _sp = 0; while (cond) { __builtin_amdgcn_s_sleep(1); \
    if ((++_sp & 255u) == 0u) { if (xb_ld(&(bar)[XB_TMO])) break; if (_sp > XB_SPIN_CAP) { atomicAdd(&(bar)[XB_TMO], 1u); break; } } } } while (0)
struct XcdBarrier { unsigned* bar; unsigned x; volatile LAS unsigned* st; };
__device__ __forceinline__ XcdBarrier xcd_barrier_post(unsigned* bar, volatile LAS unsigned* st) {
    XcdBarrier b; b.bar = bar; b.x = xb_xcc_id(); b.st = st;
    if (threadIdx.x == 0) (void)xb_add(&bar[XB_XCNT(b.x)], 1u);
    return b;
}
__device__ __forceinline__ void xcd_barrier_complete(unsigned* bar, unsigned x, unsigned& nloc, unsigned& nx) {
    const unsigned G = gridDim.x * gridDim.y * gridDim.z;
    unsigned sum, cnt, mine, sp = 0u;
    for (;;) {
        sum = 0u; cnt = 0u; mine = 0u;
#pragma unroll
        for (unsigned j = 0; j < 16; ++j) { const unsigned c = xb_ld(&bar[XB_XCNT(j)]); sum += c; cnt += (c > 0u) ? 1u : 0u; mine = (j == x) ? c : mine; }
        if (sum == G) break;
        __builtin_amdgcn_s_sleep(1);
        if ((++sp & 255u) == 0u) { if (xb_ld(&bar[XB_TMO])) break; if (sp > XB_SPIN_CAP) { atomicAdd(&bar[XB_TMO], 1u); break; } }
    }
    nloc = mine > 0u ? mine : 1u; nx = cnt > 0u ? cnt : 1u;
}
__device__ __forceinline__ void xcd_barrier(const XcdBarrier& b) {
    asm volatile("s_waitcnt vmcnt(0)" ::: "memory");
    __syncthreads();
    if (threadIdx.x == 0) {
        unsigned* bar = b.bar;
        __builtin_amdgcn_s_waitcnt(0);
        unsigned nloc = b.st[0], nx = b.st[1];
        if (nloc == 0u) { xcd_barrier_complete(bar, b.x, nloc, nx); b.st[0] = nloc; b.st[1] = nx; }
        const unsigned old = xb_add(&bar[XB_XSUB(b.x)], 1u);
        const unsigned gen = old / nloc;
        if (old + 1u == (gen + 1u) * nloc) {
            __builtin_amdgcn_fence(__ATOMIC_RELEASE, "agent");
            asm volatile("s_waitcnt vmcnt(0)" ::: "memory");
            const unsigned og = xb_add(&bar[XB_TOP], 1u);
            const unsigned tg = og / nx;
            if (og + 1u == (tg + 1u) * nx) xb_add(&bar[XB_TOPGEN], 1u);
            else XB_SPIN(xb_ld(&bar[XB_TOPGEN]) == tg, bar);
            __builtin_amdgcn_fence(__ATOMIC_ACQUIRE, "agent");
            xb_add(&bar[XB_XGEN(b.x)], 1u);
            asm volatile("s_waitcnt vmcnt(0)" ::: "memory");
        } else {
            XB_SPIN(xb_ld(&bar[XB_XGEN(b.x)]) == gen, bar);
            __builtin_amdgcn_fence(__ATOMIC_ACQUIRE, "agent");
            asm volatile("s_waitcnt vmcnt(0)" ::: "memory");
        }
    }
    __syncthreads();
}

constexpr int REPK = -1;
__global__ void __launch_bounds__(NTHR, 2) mega(Params p, int ph_lo, int ph_hi) {
    extern __shared__ __attribute__((aligned(16))) unsigned char lds[];
    volatile LAS unsigned* st = (volatile LAS unsigned*)(LAS unsigned char*)(lds + LDS_BYTES - 16);
    if (threadIdx.x < 4) st[threadIdx.x] = 0u;
    __syncthreads();
    const XcdBarrier bar = xcd_barrier_post((unsigned*)p.ws, st);
#define RUN_PHASE(k, call) if (ph_lo <= (k) && (k) < ph_hi) { if ((k) > ph_lo) xcd_barrier(bar); call; if (REPK == (k)) { xcd_barrier(bar); call; } }
    RUN_PHASE(0, phase0(p, lds))
    RUN_PHASE(1, phase1(p, lds))
    RUN_PHASE(2, phase2(p, lds))
    if (REPK == 30) { xcd_barrier(bar); if ((threadIdx.x >> 6) == 0 && blockIdx.x < 64) hgrn_scan_item<true>(p, blockIdx.x); }
    if (ph_lo <= 3 && 3 < ph_hi) { if (3 > ph_lo) xcd_barrier(bar); phase3<true>(p, lds); if (REPK == 3) { xcd_barrier(bar); phase3<false>(p, lds); } }
    RUN_PHASE(4, phase4(p, lds))
    RUN_PHASE(5, phase5(p, lds))
    RUN_PHASE(6, phase6(p, lds))
    RUN_PHASE(7, phase7(p, lds))
    RUN_PHASE(8, phase8(p, lds))
    if (ph_lo <= 9 && 9 < ph_hi) { if (9 > ph_lo) xcd_barrier(bar); phase9a(p, lds); }
    if (ph_lo <= 9 && 9 < ph_hi) { xcd_barrier(bar); phase9c(p, lds); }
    if (ph_lo <= 9 && 9 < ph_hi) { xcd_barrier(bar); phase9b(p, lds); }
    RUN_PHASE(10, phase10(p, lds))
}

static void launch_mega(const Params& p, int lo, int hi, hipStream_t stream) {
    static int grid = 0;
    if (grid == 0) {
        int dev = 0, cus = 0, per_cu = 0;
        hipGetDevice(&dev); hipDeviceGetAttribute(&cus, hipDeviceAttributeMultiprocessorCount, dev);
        hipFuncSetAttribute((const void*)mega, hipFuncAttributeMaxDynamicSharedMemorySize, LDS_BYTES);
        hipOccupancyMaxActiveBlocksPerMultiprocessor(&per_cu, (const void*)mega, NTHR, LDS_BYTES);
        if (per_cu < 1) { fprintf(stderr, "mega: occupancy query says %d blocks/CU\n", per_cu); per_cu = 1; }
        grid = cus;
    }
    hipMemsetAsync(p.ws, 0, 65536, stream);
    Params pp = p; int l = lo, h = hi;
    void* args[] = {&pp, &l, &h};
    hipError_t e = hipLaunchCooperativeKernel((const void*)mega, dim3(grid), dim3(NTHR), args, LDS_BYTES, stream);
    if (e != hipSuccess) fprintf(stderr, "cooperative launch failed: %s (grid %d)\n", hipGetErrorString(e), grid);
}

extern "C" void kernel_launch(void* const* d_in, const int* in_sizes, int n_in, void* d_out, int out_size, void* d_ws, size_t ws_size, hipStream_t stream) {
    float* out = (float*)d_out; unsigned char* ws = (unsigned char*)d_ws;
    Params prm{}; for (int i = 0; i < 21; ++i) prm.in[i] = (const float*)d_in[i]; prm.out = out; prm.ws = ws;
    launch_mega(prm, 0, 11, stream);
}
```

```cpp
#include <hip/hip_runtime.h>
#include <hip/hip_cooperative_groups.h>
#include <cstdint>
#include <cstdio>
namespace cg = cooperative_groups;

constexpr int D = 1024, NB = 2, T = 8192, NTOK = NB * T;
constexpr int DIN = 3352, PS = 3392;
constexpr int C_HQ = 0, C_HF = 512, C_HI = 1024, C_HG = 1536, C_NQ = 2048, C_KC = 2560, C_VC = 2688,
              C_KS = 2816, C_VS = 2944, C_KW = 3072, C_VW = 3200, C_GT = 3328;
constexpr int NCMP = 511;
constexpr float EPS = 1e-6f;
typedef unsigned short bf16;

constexpr size_t MiB = 1u << 20;
constexpr size_t WS_WINT = 1 * MiB;
constexpr size_t WS_WOUTT = 8 * MiB;
constexpr size_t WS_WQT = 10 * MiB;
constexpr size_t WS_WGT = 14 * MiB;
constexpr size_t WS_WPT = 16 * MiB;
constexpr size_t WS_KEYB = 16 * MiB + 512 * 1024;
constexpr size_t WS_W1T = 17 * MiB;
constexpr size_t WS_CTR = 16384;
constexpr size_t WS_SSQ = 512 * 1024;
constexpr size_t WS_US = 256 * 1024;
constexpr size_t WS_VS = 320 * 1024;
constexpr size_t WS_UB = 18 * MiB;
constexpr size_t WS_VB = 50 * MiB;
constexpr size_t WS_ACT = 82 * MiB;
constexpr size_t WS_PROJ = 114 * MiB;
constexpr size_t WS_SPARE = 220 * MiB;
constexpr size_t WS_IDS = WS_SPARE;
constexpr size_t WS_WTS = WS_SPARE + 8 * MiB;
constexpr size_t WS_KCF = WS_SPARE + 16 * MiB;
constexpr size_t WS_VCF = WS_SPARE + 17 * MiB;
constexpr size_t WS_PB = WS_SPARE + 18 * MiB;
constexpr size_t WS_VTS = WS_SPARE + 26 * MiB;
constexpr size_t WS_VTW = WS_SPARE + 30 * MiB;
constexpr size_t WS_COEFT = WS_SPARE + 26 * MiB;
constexpr size_t WS_KFS = WS_SPARE;
constexpr size_t WS_KFW = WS_SPARE + 4 * MiB;
constexpr size_t WS_KC = WS_SPARE + 34 * MiB;
constexpr size_t WS_VCT = WS_SPARE + 34 * MiB + 256 * 1024;
constexpr size_t WS_DEC = WS_SPARE + 34 * MiB + 512 * 1024;
constexpr size_t OUT_KIT = 32 * MiB;
constexpr size_t OUT_VT = 48 * MiB;
constexpr size_t WS_GL = 18 * MiB;

__device__ __forceinline__ float bf2f(bf16 v) { return __uint_as_float(((unsigned)v) << 16); }
__device__ __forceinline__ bf16 f2bf(float f) { return __builtin_bit_cast(bf16, (__bf16)f); }
__device__ __forceinline__ float wave_sum(float v) {
#pragma unroll
    for (int o = 1; o < 64; o <<= 1) v += __shfl_xor(v, o);
    return v;
}
__device__ __forceinline__ float wave_max(float v) {
#pragma unroll
    for (int o = 1; o < 64; o <<= 1) v = fmaxf(v, __shfl_xor(v, o));
    return v;
}
__device__ __forceinline__ float sigmoidf_(float x) { return 1.0f / (1.0f + __expf(-x)); }
__device__ __forceinline__ float siluf_(float x) { return x * sigmoidf_(x); }
__device__ __forceinline__ float gelu_tanh(float x) { return 0.5f * x * (1.0f + tanhf(0.7978845608028654f * (x + 0.044715f * x * x * x))); }
__device__ __forceinline__ float toF(float v) { return v; }
__device__ __forceinline__ float toF(bf16 v) { return bf2f(v); }

typedef short bf16x8 __attribute__((ext_vector_type(8)));
typedef float f32x4 __attribute__((ext_vector_type(4)));
typedef float f32x16 __attribute__((ext_vector_type(16)));
typedef unsigned u32x4 __attribute__((ext_vector_type(4)));
typedef unsigned u32x2 __attribute__((ext_vector_type(2)));
constexpr int NTHR = 512;
constexpr int LDS_BYTES = 143360 + 16;
struct Params { const float* in[21]; float* out; unsigned char* ws; };
__device__ __forceinline__ unsigned xb_xcc_id();

typedef __bf16 bf16x2c __attribute__((ext_vector_type(2)));
__device__ __forceinline__ unsigned pk2(float lo, float hi) { bf16x2c v = { (__bf16)lo, (__bf16)hi }; return __builtin_bit_cast(unsigned, v); }

__device__ __forceinline__ void transpose_tile(const float* __restrict__ W, int K, int N, bf16* __restrict__ Wt, int kt, int nt, float* tile) {
    const int tid = threadIdx.x, k0 = kt * 64, n0 = nt * 64;
#pragma unroll
    for (int i = 0; i < 8; ++i) { const int idx = tid + i * NTHR, kk = idx >> 6, nn = idx & 63; tile[kk * 65 + nn] = (n0 + nn < N) ? W[(size_t)(k0 + kk) * N + n0 + nn] : 0.f; }
    __syncthreads();
    { const int nn = tid >> 3, ch = tid & 7; const float* s = tile + (ch * 8) * 65 + nn;
      u32x4 o; o.x = pk2(s[0], s[65]); o.y = pk2(s[130], s[195]); o.z = pk2(s[260], s[325]); o.w = pk2(s[390], s[455]);
      *(u32x4*)(Wt + (size_t)(n0 + nn) * K + k0 + ch * 8) = o; }
    __syncthreads();
}
__device__ __forceinline__ void cvt_range(const float* __restrict__ src, bf16* __restrict__ dst, size_t n8, size_t gtid, size_t gthreads) {
    for (size_t i = gtid; i < n8; i += gthreads) {
        const f32x4 a = ((const f32x4*)src)[2 * i], b = ((const f32x4*)src)[2 * i + 1];
        u32x4 o; o.x = pk2(a.x, a.y); o.y = pk2(a.z, a.w); o.z = pk2(b.x, b.y); o.w = pk2(b.z, b.w);
        ((u32x4*)dst)[i] = o;
    }
}
__device__ __forceinline__ void rms_row_bf16(const float* __restrict__ xr, const float* __restrict__ g, bf16* __restrict__ orow, int lane) {
    f32x4 v[4]; float s = 0.f;
#pragma unroll
    for (int j = 0; j < 4; ++j) { v[j] = ((const f32x4*)xr)[lane + 64 * j]; s += v[j].x * v[j].x + v[j].y * v[j].y + v[j].z * v[j].z + v[j].w * v[j].w; }
    s = wave_sum(s);
    const float r = rsqrtf(s * (1.0f / D) + EPS);
#pragma unroll
    for (int j = 0; j < 4; ++j) { const f32x4 gg = ((const f32x4*)g)[lane + 64 * j]; u32x2 o; o.x = pk2(v[j].x * r * gg.x, v[j].y * r * gg.y); o.y = pk2(v[j].z * r * gg.z, v[j].w * r * gg.w); ((u32x2*)orow)[lane + 64 * j] = o; }
}

__device__ __forceinline__ void phase0(const Params& p, unsigned char* lds) {
    float* tile = (float*)lds;
    const int nblk = gridDim.x, blk = blockIdx.x;
    unsigned char* ws = p.ws;
    constexpr int I_WIN = 16 * 56, I_WOUT = 16 * 16, I_WQ = 16 * 32, I_WG = 16 * 16, I_WP = 4 * 16, I_W1 = 2 * 32;
    constexpr int NIT = I_WIN + I_WOUT + I_WQ + I_WG + I_WP + I_W1;
    for (int it = blk; it < NIT; it += nblk) {
        int r = it;
        if (r < I_WIN) { transpose_tile(p.in[3], 1024, DIN, (bf16*)(ws + WS_WINT), r / 56, r % 56, tile); continue; } r -= I_WIN;
        if (r < I_WOUT) { transpose_tile(p.in[12], 1024, 1024, (bf16*)(ws + WS_WOUTT), r / 16, r % 16, tile); continue; } r -= I_WOUT;
        if (r < I_WQ) { transpose_tile(p.in[14], 1024, 2048, (bf16*)(ws + WS_WQT), r / 32, r % 32, tile); continue; } r -= I_WQ;
        if (r < I_WG) { transpose_tile(p.in[20], 1024, 1024, (bf16*)(ws + WS_WGT), r / 16, r % 16, tile); continue; } r -= I_WG;
        if (r < I_WP) { transpose_tile(p.in[18], 256, 1024, (bf16*)(ws + WS_WPT), r / 16, r % 16, tile); continue; } r -= I_WP;
        { const int which = r / 32, kt = r % 32; transpose_tile(p.in[9] + (size_t)which * 2048 * 64, 2048, 64, (bf16*)(ws + WS_W1T) + (size_t)which * 64 * 2048, kt, 0, tile); }
    }
    const size_t gtid = (size_t)blk * NTHR + threadIdx.x, gthreads = (size_t)nblk * NTHR;
    for (size_t i = gtid; i < (size_t)8 * 2 * 128 * 16; i += gthreads) {
        const int dch = (int)(i & 15), key = (int)((i >> 4) & 127), hc = (int)(i >> 11);
        const float* src = p.in[15] + ((size_t)hc * 128 + key) * 128 + dch * 8;
        const f32x4 a = *(const f32x4*)src, b = *(const f32x4*)(src + 4);
        u32x4 o; o.x = pk2(a.x, a.y); o.y = pk2(a.z, a.w); o.z = pk2(b.x, b.y); o.w = pk2(b.z, b.w);
        *(u32x4*)((bf16*)(ws + WS_KEYB) + ((((size_t)hc * 4 + (key >> 5)) * 8 + (dch >> 1)) * 64 + (key & 31) + 32 * (dch & 1)) * 8) = o;
    }
    cvt_range(p.in[1], (bf16*)(ws + WS_PB), (size_t)NTOK * 256 / 8, gtid, gthreads);
    const int gw = (int)(gtid >> 6), ngw = (int)(gthreads >> 6), lane = threadIdx.x & 63;
    for (int m = gw; m < NTOK; m += ngw) rms_row_bf16(p.in[0] + (size_t)m * D, p.in[2], (bf16*)(ws + WS_ACT) + (size_t)m * D, lane);
    for (int m = gw; m < 2 * 16384; m += ngw) {
        const int which = m >> 14, row = m & 16383;
        const float* src = p.in[16 + which] + (size_t)row * D + lane * 16;
        const f32x4 a = *(const f32x4*)src, b = *(const f32x4*)(src + 4), c = *(const f32x4*)(src + 8), d = *(const f32x4*)(src + 12);
        float mx = fmaxf(fmaxf(fmaxf(fabsf(a.x), fabsf(a.y)), fmaxf(fabsf(a.z), fabsf(a.w))), fmaxf(fmaxf(fabsf(b.x), fabsf(b.y)), fmaxf(fabsf(b.z), fabsf(b.w))));
        mx = fmaxf(mx, fmaxf(fmaxf(fmaxf(fabsf(c.x), fabsf(c.y)), fmaxf(fabsf(c.z), fabsf(c.w))), fmaxf(fmaxf(fabsf(d.x), fabsf(d.y)), fmaxf(fabsf(d.z), fabsf(d.w)))));
        mx = fmaxf(wave_max(mx), 1e-30f);
        const float sc = 224.0f / mx;
        u32x4 o; int w;
        w = __builtin_amdgcn_cvt_pk_fp8_f32(a.x * sc, a.y * sc, 0, false); w = __builtin_amdgcn_cvt_pk_fp8_f32(a.z * sc, a.w * sc, w, true); o.x = (unsigned)w;
        w = __builtin_amdgcn_cvt_pk_fp8_f32(b.x * sc, b.y * sc, 0, false); w = __builtin_amdgcn_cvt_pk_fp8_f32(b.z * sc, b.w * sc, w, true); o.y = (unsigned)w;
        w = __builtin_amdgcn_cvt_pk_fp8_f32(c.x * sc, c.y * sc, 0, false); w = __builtin_amdgcn_cvt_pk_fp8_f32(c.z * sc, c.w * sc, w, true); o.z = (unsigned)w;
        w = __builtin_amdgcn_cvt_pk_fp8_f32(d.x * sc, d.y * sc, 0, false); w = __builtin_amdgcn_cvt_pk_fp8_f32(d.z * sc, d.w * sc, w, true); o.w = (unsigned)w;
        *(u32x4*)(ws + (which ? WS_VB : WS_UB) + (size_t)(lane >> 3) * (16384 * 128) + (size_t)row * 128 + (lane & 7) * 16) = o;
        if (lane == 0) ((float*)(ws + (which ? WS_VS : WS_US)))[row] = mx * (1.0f / 224.0f);
    }
}

__device__ __forceinline__ int swz(int ob) { return ob ^ (((ob >> 9) & 1) << 5); }
constexpr int G_STAGE = 49152;
__device__ __forceinline__ void gemm_mainloop(f32x4 (&acc)[4][4], const bf16* __restrict__ A, int lda, const bf16* __restrict__ Bt, int ldb, int K, int m0, int n0, unsigned char* lds) {
    const int tid = threadIdx.x, lane = tid & 63, wid = tid >> 6, wm = wid >> 1, wn = wid & 1, fr = lane & 15, fq = lane >> 4;
    const int lrow = tid >> 3, lc = tid & 7;
    const bf16* ag = A + (size_t)(m0 + lrow) * lda + lc * 8;
    const bf16* bg = Bt + (size_t)(n0 + lrow) * ldb + lc * 8;
    const int woff = ((lrow >> 4) * 2 + (lc >> 2)) * 1024 + swz((lrow & 15) * 64 + (lc & 3) * 16);
    const int roff = swz(fr * 64 + fq * 16);
    const int nk = K >> 6;
    u32x4 ra0[4], rb0[2], ra1[4], rb1[2];
#define GM_LOAD(ra, rb, kt) { _Pragma("unroll") for (int i = 0; i < 4; ++i) ra[i] = *(const u32x4*)(ag + (size_t)i * 64 * lda + (kt) * 64); \
                              _Pragma("unroll") for (int i = 0; i < 2; ++i) rb[i] = *(const u32x4*)(bg + (size_t)i * 64 * ldb + (kt) * 64); }
#define GM_STORE(ra, rb, buf) { _Pragma("unroll") for (int i = 0; i < 4; ++i) *(u32x4*)((buf) + woff + i * 8192) = ra[i]; \
                                _Pragma("unroll") for (int i = 0; i < 2; ++i) *(u32x4*)((buf) + 32768 + woff + i * 8192) = rb[i]; }
#define GM_COMPUTE(cur) { _Pragma("unroll") for (int s = 0; s < 2; ++s) { bf16x8 af[4], bfr[4]; \
        _Pragma("unroll") for (int i = 0; i < 4; ++i) af[i] = *(const bf16x8*)((cur) + ((wm * 4 + i) * 2 + s) * 1024 + roff); \
        _Pragma("unroll") for (int i = 0; i < 4; ++i) bfr[i] = *(const bf16x8*)((cur) + 32768 + ((wn * 4 + i) * 2 + s) * 1024 + roff); \
        _Pragma("unroll") for (int mi = 0; mi < 4; ++mi) _Pragma("unroll") for (int ni = 0; ni < 4; ++ni) acc[mi][ni] = __builtin_amdgcn_mfma_f32_16x16x32_bf16(bfr[ni], af[mi], acc[mi][ni], 0, 0, 0); } }
    unsigned char* buf0 = lds; unsigned char* buf1 = lds + G_STAGE;
    GM_LOAD(ra0, rb0, 0)
    GM_LOAD(ra1, rb1, 1)
    GM_STORE(ra0, rb0, buf0)
    __syncthreads();
    for (int kt = 0; kt < nk; kt += 2) {
        { const int kp = (kt + 2 < nk) ? kt + 2 : kt; GM_LOAD(ra0, rb0, kp) }
        GM_COMPUTE(buf0)
        GM_STORE(ra1, rb1, buf1)
        __syncthreads();
        { const int kp = (kt + 3 < nk) ? kt + 3 : kt + 1; GM_LOAD(ra1, rb1, kp) }
        GM_COMPUTE(buf1)
        if (kt + 2 < nk) GM_STORE(ra0, rb0, buf0)
        __syncthreads();
    }
}
__device__ __forceinline__ void acc_zero(f32x4 (&acc)[4][4]) {
#pragma unroll
    for (int i = 0; i < 4; ++i)
#pragma unroll
        for (int j = 0; j < 4; ++j) acc[i][j] = (f32x4){0.f, 0.f, 0.f, 0.f};
}
namespace pg8 {
#define PG8_LAS __attribute__((address_space(3)))
typedef unsigned short bf16_t;
typedef short bf16x8 __attribute__((ext_vector_type(8)));
typedef float f32x4 __attribute__((ext_vector_type(4)));
typedef unsigned u32x4 __attribute__((ext_vector_type(4)));
constexpr int BM = 256, BK = 64, HALF = 128, HTB = HALF * BK * 2  , STAGE_BYTES = 8 * HTB, NXCD = 8, WGM = 8;

__host__ __device__ __forceinline__ int lds_byte(int r, int c) { const int st = (r >> 4) * 2 + (c >> 5), rr = r & 15, cc = c & 31, ob = rr * 64 + cc * 2; return st * 1024 + (ob ^ (((ob >> 9) & 1) << 5)); }
__host__ __device__ __forceinline__ void stage_rc(int b, int& R, int& C) { const int st = b / 1024, sb = b % 1024, swz = sb ^ (((sb >> 9) & 1) << 5); R = (st >> 1) * 16 + swz / 64; C = (st & 1) * 32 + (swz % 64) / 2; }
__host__ __device__ __forceinline__ int perm32(int rho) { const int n = rho >> 4, i = rho & 15; return 8 * (i >> 2) + 4 * n + (i & 3); }

struct Unit { int pm, pn; };
struct Gemm { const bf16_t* A; const bf16_t* Bt; int M, N, K; };

struct StaticOrder {
    int nM, nN, nwg, G, c;
    __host__ __device__ void init(int M, int N, int G_, int c_) { nM = M / BM; nN = N / BM; nwg = nM * nN; G = G_; c = c_; }
    __host__ __device__ bool next(int i, Unit& u) const {
        const long L = (long)i * G + c; if (L >= nwg) return false;
        int wgid = (int)L; { const int q = nwg / NXCD, r = nwg % NXCD, xcd = wgid % NXCD, off = wgid / NXCD; wgid = (xcd < r ? xcd * (q + 1) : r * (q + 1) + (xcd - r) * q) + off; }
        const int nig = WGM * nN, gid = wgid / nig, fm = gid * WGM, gsz = (nM - fm) < WGM ? (nM - fm) : WGM;
        u.pm = fm + ((wgid % nig) % gsz); u.pn = (wgid % nig) / gsz; return true;
    }
    __device__ __forceinline__ void a_ready(const Unit&) const {}
    __device__ __forceinline__ void done(const Unit&) const {}
};

__device__ __forceinline__ unsigned pk2b(float lo, float hi) { typedef __bf16 b2 __attribute__((ext_vector_type(2))); b2 v = { (__bf16)lo, (__bf16)hi }; return __builtin_bit_cast(unsigned, v); }
typedef unsigned u32x2 __attribute__((ext_vector_type(2)));
struct EpiStoreBf16 {
    static constexpr bool PERM = false, AFTER_DRAIN = false;
    bf16_t* C; int ldc; int ncols;
    __device__ __forceinline__ void operator()(const f32x4 (&acc)[2][2][4][2], const Unit& u, int wr, int wc, int fr, int fq) const {
#pragma unroll
        for (int ai = 0; ai < 2; ++ai)
#pragma unroll
            for (int m = 0; m < 4; ++m) { bf16_t* rowp = C + (size_t)(u.pm * BM + ai * HALF + wr * 64 + m * 16 + fr) * ldc;
#pragma unroll
                for (int bj = 0; bj < 2; ++bj)
#pragma unroll
                    for (int n = 0; n < 2; ++n) { const int col = u.pn * BM + bj * HALF + wc * 32 + n * 16 + fq * 4;
                        if (col < ncols) { u32x2 w; w.x = pk2b(acc[ai][bj][m][n][0], acc[ai][bj][m][n][1]); w.y = pk2b(acc[ai][bj][m][n][2], acc[ai][bj][m][n][3]); *(u32x2*)(rowp + col) = w; } } }
    }
};
struct EpiStorePQF {
    static constexpr bool PERM = false, AFTER_DRAIN = false;
    bf16_t* C; int pad0, pad1;
    __device__ __forceinline__ void operator()(const f32x4 (&acc)[2][2][4][2], const Unit& u, int wr, int wc, int fr, int fq) const {
#pragma unroll
        for (int ai = 0; ai < 2; ++ai)
#pragma unroll
            for (int m = 0; m < 4; ++m) { const int row = u.pm * BM + ai * HALF + wr * 64 + m * 16 + fr;
#pragma unroll
                for (int bj = 0; bj < 2; ++bj)
#pragma unroll
                    for (int n = 0; n < 2; ++n) { const int col = u.pn * BM + bj * HALF + wc * 32 + n * 16 + fq * 4, d = col & 127;
                        const size_t off = ((((size_t)(row >> 5) * 16 + (col >> 7)) * 8 + (d >> 4)) * 64 + (row & 31) + 32 * ((d >> 3) & 1)) * 8 + (d & 7);
                        u32x2 w; w.x = pk2b(acc[ai][bj][m][n][0], acc[ai][bj][m][n][1]); w.y = pk2b(acc[ai][bj][m][n][2], acc[ai][bj][m][n][3]); *(u32x2*)(C + off) = w; } }
    }
};
struct EpiResidF32 {
    static constexpr bool PERM = false, AFTER_DRAIN = false;
    const float* X; float* O; int ld; int pad;
    __device__ __forceinline__ void operator()(const f32x4 (&acc)[2][2][4][2], const Unit& u, int wr, int wc, int fr, int fq) const {
#pragma unroll
        for (int ai = 0; ai < 2; ++ai)
#pragma unroll
            for (int m = 0; m < 4; ++m) { const size_t ro = (size_t)(u.pm * BM + ai * HALF + wr * 64 + m * 16 + fr) * ld;
#pragma unroll
                for (int bj = 0; bj < 2; ++bj)
#pragma unroll
                    for (int n = 0; n < 2; ++n) { const size_t idx = ro + u.pn * BM + bj * HALF + wc * 32 + n * 16 + fq * 4; *(f32x4*)(O + idx) = *(const f32x4*)(X + idx) + acc[ai][bj][m][n]; } }
    }
};
struct EpiFinalGate {
    static constexpr bool PERM = false, AFTER_DRAIN = false;
    const bf16_t* PL; const float* SSQ; float* O; int ld; int ntok; float eps; int pad;
    __device__ __forceinline__ void operator()(const f32x4 (&acc)[2][2][4][2], const Unit& u, int wr, int wc, int fr, int fq) const {
#pragma unroll
        for (int ai = 0; ai < 2; ++ai)
#pragma unroll
            for (int m = 0; m < 4; ++m) { const int row = u.pm * BM + ai * HALF + wr * 64 + m * 16 + fr; const size_t ro = (size_t)row * ld;
                float tot = 0.f;
#pragma unroll
                for (int x = 0; x < 8; ++x) tot += SSQ[(size_t)x * ntok + row];
                const float rs = 1.0f / sqrtf(tot * (1.0f / 1024.0f) + eps);
#pragma unroll
                for (int bj = 0; bj < 2; ++bj)
#pragma unroll
                    for (int n = 0; n < 2; ++n) { const size_t idx = ro + u.pn * BM + bj * HALF + wc * 32 + n * 16 + fq * 4;
                        const u32x2 pw = *(const u32x2*)(PL + idx); const unsigned px = pw.x, py = pw.y;
                        f32x4 pv; pv.x = __uint_as_float(px << 16); pv.y = __uint_as_float(px & 0xffff0000u); pv.z = __uint_as_float(py << 16); pv.w = __uint_as_float(py & 0xffff0000u);
                        f32x4 g;
#pragma unroll
                        for (int e = 0; e < 4; ++e) g[e] = 1.0f / (1.0f + __expf(-rs * acc[ai][bj][m][n][e]));
                        *(f32x4*)(O + idx) = *(const f32x4*)(O + idx) + pv * g; } }
    }
};

template <class Epi, class Sched, bool ALIGN_EPI = false, bool SP2 = false>
__device__ __forceinline__ void gemm_phase(PG8_LAS unsigned char* lds, const Gemm g, const Sched& S, const Epi& E) {
    const int tid = threadIdx.x, wid = __builtin_amdgcn_readfirstlane(tid >> 6), lane = tid & 63, wr = wid >> 2, wc = wid & 3, fr = lane & 15, fq = lane >> 4;
    const int K = g.K, nt = K / BK;
    unsigned voffA[2], voffB[2];
#pragma unroll
    for (int i = 0; i < 2; ++i) { int R, C; stage_rc(tid * 16 + i * 8192, R, C); const int Rb = Epi::PERM ? ((R & ~31) + perm32(R & 31)) : R;
        voffA[i] = (unsigned)(R * K + C) * 2u; voffB[i] = (unsigned)(Rb * K + C) * 2u; }
    const size_t kstep = (size_t)(BK * 2);
    const size_t hstep = (size_t)HALF * K * 2;
    const size_t tstep = 2 * hstep;
    const unsigned ldsw = (unsigned)wid * 1024u;
    const int aoff = lds_byte(wr * 64 + fr, fq * 8), boff = lds_byte(wc * 32 + fr, fq * 8);
#define PG8_SA(b, h) (((b) * 2 + (h)) * HTB)
#define PG8_SB(b, h) ((4 + (b) * 2 + (h)) * HTB)
#define PG8_STAGE(bufoff, gbase, voff) do { _Pragma("unroll") for (int _i = 0; _i < 2; ++_i) \
        __builtin_amdgcn_global_load_lds((const unsigned*)((const char*)(gbase) + (voff)[_i]), (PG8_LAS unsigned*)(lds + (bufoff) + ldsw + _i * 8192), 16, 0, 0); } while (0)
#define PG8_LDA(dst, b, h) do { _Pragma("unroll") for (int m = 0; m < 4; ++m) _Pragma("unroll") for (int k = 0; k < 2; ++k) dst[m][k] = *(const PG8_LAS bf16x8*)(lds + PG8_SA(b, h) + aoff + m * 2048 + k * 1024); } while (0)
#define PG8_LDB(dst, b, h) do { _Pragma("unroll") for (int n = 0; n < 2; ++n) _Pragma("unroll") for (int k = 0; k < 2; ++k) dst[n][k] = *(const PG8_LAS bf16x8*)(lds + PG8_SB(b, h) + boff + n * 2048 + k * 1024); } while (0)
#define PG8_MMA(ai, bj, At, Bt) do { __builtin_amdgcn_s_setprio(1); _Pragma("unroll") for (int m = 0; m < 4; ++m) _Pragma("unroll") for (int n = 0; n < 2; ++n) _Pragma("unroll") for (int k = 0; k < 2; ++k) \
        acc[ai][bj][m][n] = __builtin_amdgcn_mfma_f32_16x16x32_bf16(Bt[n][k], At[m][k], acc[ai][bj][m][n], 0, 0, 0); __builtin_amdgcn_s_setprio(0); } while (0)
#define PG8_WAIT_V(n) asm volatile("s_waitcnt vmcnt(" #n ")" ::: "memory")
#define PG8_WAIT_L(n) asm volatile("s_waitcnt lgkmcnt(" #n ")" ::: "memory")
#define PG8_BAR __builtin_amdgcn_s_barrier()
#define PG8_SCHED __builtin_amdgcn_sched_barrier(0)
    Unit cur, nxt; int ui = 0;
    if (!S.next(0, cur)) return;
    f32x4 acc[2][2][4][2];
#pragma unroll
    for (int a = 0; a < 2; ++a)
#pragma unroll
        for (int b = 0; b < 2; ++b)
#pragma unroll
            for (int m = 0; m < 4; ++m)
#pragma unroll
                for (int n = 0; n < 2; ++n) acc[a][b][m][n] = (f32x4){0.f, 0.f, 0.f, 0.f};
    bf16x8 At[4][2], B0[2][2], B1[2][2];
    const char* cA = (const char*)g.A + (size_t)cur.pm * tstep; const char* cB = (const char*)g.Bt + (size_t)cur.pn * tstep;
    S.a_ready(cur);
    if constexpr (SP2) {
        PG8_STAGE(PG8_SB(0, 0), cB, voffB); PG8_STAGE(PG8_SB(0, 1), cB + hstep, voffB); PG8_STAGE(PG8_SA(0, 0), cA, voffA); PG8_STAGE(PG8_SA(0, 1), cA + hstep, voffA);
        if (wr == 1) PG8_BAR;
        PG8_WAIT_V(2); PG8_BAR;
        PG8_STAGE(PG8_SB(1, 0), cB + kstep, voffB); PG8_STAGE(PG8_SA(1, 0), cA + kstep, voffA); PG8_STAGE(PG8_SB(1, 1), cB + hstep + kstep, voffB);
        PG8_WAIT_V(6); PG8_BAR;
    } else {
        PG8_STAGE(PG8_SB(0, 0), cB, voffB); PG8_STAGE(PG8_SA(0, 0), cA, voffA); PG8_STAGE(PG8_SB(0, 1), cB + hstep, voffB); PG8_STAGE(PG8_SA(0, 1), cA + hstep, voffA);
        if (wr == 1) PG8_BAR;
        PG8_WAIT_V(4); PG8_BAR;
        PG8_STAGE(PG8_SB(1, 0), cB + kstep, voffB); PG8_STAGE(PG8_SA(1, 0), cA + kstep, voffA); PG8_STAGE(PG8_SB(1, 1), cB + hstep + kstep, voffB);
        PG8_WAIT_V(6); PG8_BAR;
    }
    for (;;) {
        const bool has_next = S.next(ui + 1, nxt);
        const char* nA = has_next ? (const char*)g.A + (size_t)nxt.pm * tstep : cA; const char* nB = has_next ? (const char*)g.Bt + (size_t)nxt.pn * tstep : cB;
        for (int t = 0; t < nt; t += 2) {
            const bool last = (t == nt - 2);
            const char* a1 = cA + (size_t)(t + 1) * kstep;
            const char* a2 = last ? nA : cA + (size_t)(t + 2) * kstep; const char* b2 = last ? nB : cB + (size_t)(t + 2) * kstep;
            const char* a3 = a2 + kstep; const char* b3 = b2 + kstep;
            if (last && has_next) S.a_ready(nxt);
            if constexpr (SP2) {
            PG8_LDB(B0, 0, 0); PG8_LDB(B1, 0, 1); PG8_SCHED; PG8_LDA(At, 0, 0); PG8_STAGE(PG8_SA(1, 1), a1 + hstep, voffA);
            PG8_WAIT_V(8); PG8_WAIT_L(0); PG8_BAR; PG8_MMA(0, 0, At, B0); PG8_MMA(0, 1, At, B1); PG8_BAR; PG8_SCHED;
            PG8_LDA(At, 0, 1); PG8_STAGE(PG8_SB(0, 0), b2, voffB); PG8_STAGE(PG8_SB(0, 1), b2 + hstep, voffB); PG8_STAGE(PG8_SA(0, 0), a2, voffA);
            PG8_WAIT_V(8); PG8_WAIT_L(0); PG8_BAR; PG8_MMA(1, 0, At, B0); PG8_MMA(1, 1, At, B1); PG8_BAR; PG8_SCHED;
            PG8_LDB(B0, 1, 0); PG8_LDB(B1, 1, 1); PG8_SCHED; PG8_LDA(At, 1, 0); PG8_STAGE(PG8_SA(0, 1), a2 + hstep, voffA);
            PG8_WAIT_V(8); PG8_WAIT_L(0); PG8_BAR; PG8_MMA(0, 0, At, B0); PG8_MMA(0, 1, At, B1); PG8_BAR; PG8_SCHED;
            PG8_LDA(At, 1, 1); PG8_STAGE(PG8_SB(1, 0), b3, voffB); PG8_STAGE(PG8_SB(1, 1), b3 + hstep, voffB); PG8_STAGE(PG8_SA(1, 0), a3, voffA);
            PG8_WAIT_V(8); PG8_WAIT_L(0); PG8_BAR; PG8_MMA(1, 0, At, B0); PG8_MMA(1, 1, At, B1); PG8_BAR; PG8_SCHED;
            } else {
            PG8_LDB(B0, 0, 0); PG8_SCHED; PG8_LDA(At, 0, 0); PG8_STAGE(PG8_SA(1, 1), a1 + hstep, voffA);
            PG8_WAIT_L(8); PG8_BAR; PG8_WAIT_L(0); PG8_MMA(0, 0, At, B0); PG8_BAR; PG8_SCHED;
            PG8_LDB(B1, 0, 1); PG8_STAGE(PG8_SB(0, 0), b2, voffB);
            PG8_BAR; PG8_WAIT_L(0); PG8_MMA(0, 1, At, B1); PG8_BAR;
            PG8_LDA(At, 0, 1); PG8_STAGE(PG8_SA(0, 0), a2, voffA);
            PG8_BAR; PG8_WAIT_L(0); PG8_MMA(1, 0, At, B0); PG8_BAR; PG8_SCHED;
            PG8_STAGE(PG8_SB(0, 1), b2 + hstep, voffB);
            PG8_WAIT_V(6); PG8_BAR; PG8_MMA(1, 1, At, B1); PG8_BAR;
            PG8_LDB(B0, 1, 0); PG8_SCHED; PG8_LDA(At, 1, 0); PG8_STAGE(PG8_SA(0, 1), a2 + hstep, voffA);
            PG8_WAIT_L(8); PG8_BAR; PG8_WAIT_L(0); PG8_MMA(0, 0, At, B0); PG8_BAR; PG8_SCHED;
            PG8_LDB(B1, 1, 1); PG8_STAGE(PG8_SB(1, 0), b3, voffB);
            PG8_BAR; PG8_WAIT_L(0); PG8_MMA(0, 1, At, B1); PG8_BAR;
            PG8_LDA(At, 1, 1); PG8_STAGE(PG8_SA(1, 0), a3, voffA);
            PG8_BAR; PG8_WAIT_L(0); PG8_MMA(1, 0, At, B0); PG8_BAR; PG8_SCHED;
            PG8_STAGE(PG8_SB(1, 1), b3 + hstep, voffB);
            PG8_WAIT_V(6); PG8_BAR; PG8_MMA(1, 1, At, B1); PG8_BAR;
            }
        }
        if constexpr (ALIGN_EPI) { if (wr == 0) PG8_BAR; }
        if constexpr (!Epi::AFTER_DRAIN) { E(acc, cur, wr, wc, fr, fq); S.done(cur); }
        if (!has_next) break;
#pragma unroll
        for (int a = 0; a < 2; ++a)
#pragma unroll
            for (int b = 0; b < 2; ++b)
#pragma unroll
                for (int m = 0; m < 4; ++m)
#pragma unroll
                    for (int n = 0; n < 2; ++n) acc[a][b][m][n] = (f32x4){0.f, 0.f, 0.f, 0.f};
        cur = nxt; cA = nA; cB = nB; ++ui;
        if constexpr (ALIGN_EPI) { if (wr == 1) PG8_BAR; }
    }
    PG8_WAIT_V(0);
    if constexpr (!ALIGN_EPI) { if (wr == 0) PG8_BAR; }
    PG8_BAR;
    if constexpr (Epi::AFTER_DRAIN) { E.fused(acc, cur, wr, wc, fr, fq, lds, wid, lane); S.done(cur); }
#undef PG8_SA
#undef PG8_SB
#undef PG8_STAGE
#undef PG8_LDA
#undef PG8_LDB
#undef PG8_MMA
#undef PG8_WAIT_V
#undef PG8_WAIT_L
#undef PG8_BAR
#undef PG8_SCHED
}
}

__device__ __forceinline__ void phase1(const Params& p, unsigned char* lds) {
    pg8::Gemm g{(const bf16*)(p.ws + WS_ACT), (const bf16*)(p.ws + WS_WINT), NTOK, 3584, D}; pg8::StaticOrder S; S.init(NTOK, 3584, (int)gridDim.x, (int)blockIdx.x);
    pg8::EpiStoreBf16 E{(bf16*)(p.ws + WS_PROJ), PS, DIN};
    pg8::gemm_phase<pg8::EpiStoreBf16, pg8::StaticOrder, true, true>((PG8_LAS unsigned char*)lds, g, S, E);
}


__device__ __forceinline__ void phase5(const Params& p, unsigned char* lds) {
    pg8::Gemm g{(const bf16*)(p.ws + WS_ACT), (const bf16*)(p.ws + WS_WOUTT), NTOK, D, D}; pg8::StaticOrder S; S.init(NTOK, D, (int)gridDim.x, (int)blockIdx.x);
    pg8::EpiResidF32 E{p.in[0], p.out, D, 0};
    pg8::gemm_phase<pg8::EpiResidF32, pg8::StaticOrder, true, true>((PG8_LAS unsigned char*)lds, g, S, E);
}
__device__ __forceinline__ void phase6(const Params& p, unsigned char* lds) {
    const int gw = (blockIdx.x * NTHR + threadIdx.x) >> 6, ngw = (gridDim.x * NTHR) >> 6, lane = threadIdx.x & 63;
    for (int m = gw; m < NTOK; m += ngw) rms_row_bf16(p.out + (size_t)m * D, p.in[13], (bf16*)(p.ws + WS_ACT) + (size_t)m * D, lane);
}
__device__ __forceinline__ void phase7(const Params& p, unsigned char* lds) {
    pg8::Gemm g{(const bf16*)(p.ws + WS_ACT), (const bf16*)(p.ws + WS_WQT), NTOK, 2048, D}; pg8::StaticOrder S; S.init(NTOK, 2048, (int)gridDim.x, (int)blockIdx.x);
    pg8::EpiStorePQF E{(bf16*)(p.ws + WS_PROJ), 0, 0};
    pg8::gemm_phase<pg8::EpiStorePQF, pg8::StaticOrder, true, true>((PG8_LAS unsigned char*)lds, g, S, E);
}
__device__ __forceinline__ void phase10(const Params& p, unsigned char* lds) {
    {
        pg8::Gemm g{(const bf16*)(p.ws + WS_PB), (const bf16*)(p.ws + WS_WPT), NTOK, D, 256}; pg8::StaticOrder S; S.init(NTOK, D, (int)gridDim.x, (int)blockIdx.x);
        pg8::EpiStoreBf16 E{(bf16*)(p.ws + WS_ACT), D, D};
        pg8::gemm_phase<pg8::EpiStoreBf16, pg8::StaticOrder, true, true>((PG8_LAS unsigned char*)lds, g, S, E);
    }
    {
        pg8::Gemm g{(const bf16*)(p.ws + WS_PROJ + 64 * MiB), (const bf16*)(p.ws + WS_WGT), NTOK, D, D}; pg8::StaticOrder S; S.init(NTOK, D, (int)gridDim.x, (int)blockIdx.x);
        pg8::EpiFinalGate E{(const bf16*)(p.ws + WS_ACT), (const float*)(p.ws + WS_SSQ), p.out, D, NTOK, EPS, 0};
        pg8::gemm_phase<pg8::EpiFinalGate, pg8::StaticOrder, true, true>((PG8_LAS unsigned char*)lds, g, S, E);
    }
}

typedef __bf16 bf16x2v __attribute__((ext_vector_type(2)));
template <int CTRL> __device__ __forceinline__ float dpp_f(float v) { return __int_as_float(__builtin_amdgcn_update_dpp(0, __float_as_int(v), CTRL, 0xF, 0xF, false)); }
__device__ __forceinline__ float grp16_max(float v) { v = fmaxf(v, dpp_f<0xB1>(v)); v = fmaxf(v, dpp_f<0x4E>(v)); v = fmaxf(v, dpp_f<0x141>(v)); v = fmaxf(v, dpp_f<0x140>(v)); return v; }
__device__ __forceinline__ float grp16_sum(float v) { v += dpp_f<0xB1>(v); v += dpp_f<0x4E>(v); v += dpp_f<0x141>(v); v += dpp_f<0x140>(v); return v; }
#define CE_DESC(a, b) { const float _hi = fmaxf(a, b), _lo = fminf(a, b); a = _hi; b = _lo; }
__device__ __forceinline__ float grp16_top16(float (&v)[8], int lig) {
    CE_DESC(v[0], v[1]) CE_DESC(v[2], v[3]) CE_DESC(v[4], v[5]) CE_DESC(v[6], v[7])
    CE_DESC(v[0], v[2]) CE_DESC(v[1], v[3]) CE_DESC(v[4], v[6]) CE_DESC(v[5], v[7])
    CE_DESC(v[1], v[2]) CE_DESC(v[5], v[6])
    CE_DESC(v[0], v[4]) CE_DESC(v[1], v[5]) CE_DESC(v[2], v[6]) CE_DESC(v[3], v[7])
    CE_DESC(v[2], v[4]) CE_DESC(v[3], v[5])
    CE_DESC(v[1], v[2]) CE_DESC(v[3], v[4]) CE_DESC(v[5], v[6])
    float top = 0.f;
#pragma unroll
    for (int r = 0; r < 16; ++r) {
        const float m = grp16_max(v[0]);
        if (lig == r) top = m;
        const bool own = (v[0] == m);
#pragma unroll
        for (int j = 0; j < 7; ++j) v[j] = own ? v[j + 1] : v[j];
        v[7] = own ? -3.0e38f : v[7];
    }
    return top;
}
__device__ __forceinline__ void phase8(const Params& p, unsigned char* lds) {
    const bf16* PQ = (const bf16*)(p.ws + WS_PROJ); const bf16* KB = (const bf16*)(p.ws + WS_KEYB);
    int* ids = (int*)(p.ws + WS_IDS); float* wts = (float*)(p.ws + WS_WTS);
    float* S = (float*)lds;
    const int tid = threadIdx.x, lane = tid & 63, wid = tid >> 6, lig = tid & 15, gbase = lane & 48;
    for (int item = blockIdx.x; item < 2048; item += gridDim.x) {
        const int tok0 = (item >> 3) * 64, h = item & 7;
        {
            const int c = wid >> 2, key0 = (wid & 3) * 32, r = lane & 31, hh = lane >> 5;
            f32x16 acc0, acc1;
#pragma unroll
            for (int i = 0; i < 16; ++i) { acc0[i] = 0.f; acc1[i] = 0.f; }
            const bf16* bq = KB + (((size_t)(h * 2 + c) * 4 + (key0 >> 5)) * 8) * 512 + lane * 8;
            const bf16* aq0 = PQ + ((((size_t)(tok0 >> 5)) * 16 + h * 2 + c) * 8) * 512 + lane * 8;
            const bf16* aq1 = aq0 + (size_t)16 * 8 * 512;
#pragma unroll
            for (int s = 0; s < 8; ++s) {
                const bf16x8 b = *(const bf16x8*)(bq + s * 512), a0 = *(const bf16x8*)(aq0 + s * 512), a1 = *(const bf16x8*)(aq1 + s * 512);
                acc0 = __builtin_amdgcn_mfma_f32_32x32x16_bf16(a0, b, acc0, 0, 0, 0);
                acc1 = __builtin_amdgcn_mfma_f32_32x32x16_bf16(a1, b, acc1, 0, 0, 0);
            }
#pragma unroll
            for (int i = 0; i < 16; ++i) { const int tl = (i & 3) + 8 * (i >> 2) + 4 * hh; S[(c * 64 + tl) * 132 + key0 + r] = acc0[i]; S[(c * 64 + 32 + tl) * 132 + key0 + r] = acc1[i]; }
        }
        __syncthreads();
        {
            const int tl0 = tid >> 4;
            float ts[2][2];
#pragma unroll
            for (int rd = 0; rd < 2; ++rd)
#pragma unroll
                for (int c = 0; c < 2; ++c) {
                    float v[8];
                    const float* sp = S + (c * 64 + tl0 + 32 * rd) * 132 + lig * 8;
                    const f32x4 lo = *(const f32x4*)sp, hi = *(const f32x4*)(sp + 4);
                    v[0] = lo.x; v[1] = lo.y; v[2] = lo.z; v[3] = lo.w; v[4] = hi.x; v[5] = hi.y; v[6] = hi.z; v[7] = hi.w;
#pragma unroll
                    for (int j = 0; j < 8; ++j) v[j] = __uint_as_float((__float_as_uint(v[j]) & ~127u) | (unsigned)(lig * 8 + j));
                    ts[rd][c] = grp16_top16(v, lig);
                }
            int bp[2] = {0, 0}; float my_s[2] = {0.f, 0.f}; int my_eid[2] = {0, 0};
#pragma unroll 4
            for (int r = 0; r < 16; ++r) {
#pragma unroll
                for (int rd = 0; rd < 2; ++rd) {
                    const float other = __shfl(ts[rd][1], gbase + (bp[rd] < 15 ? bp[rd] : 15));
                    const float sum = ts[rd][0] + other;
                    const float head = (bp[rd] >= 16) ? -3.0e38f : __uint_as_float((__float_as_uint(sum) & ~15u) | (unsigned)lig);
                    const int cur_eid = (int)(((__float_as_uint(ts[rd][0]) & 127u) << 7) | (__float_as_uint(other) & 127u));
                    const float m = grp16_max(head);
                    const int owner = (int)(__float_as_uint(m) & 15u);
                    const int ew = __shfl(cur_eid, gbase + owner);
                    if (lig == r) { my_s[rd] = m; my_eid[rd] = ew; }
                    if (lig == owner) ++bp[rd];
                }
            }
#pragma unroll
            for (int rd = 0; rd < 2; ++rd) {
                const int tl = tl0 + 32 * rd;
                const float mx = grp16_max(my_s[rd]);
                const float e = __expf(my_s[rd] - mx);
                const float sm = grp16_sum(e);
                const size_t o = (size_t)(tok0 + tl) * 128 + h * 16 + lig;
                ((unsigned short*)ids)[(size_t)(tok0 + tl) * 128 + (h >> 2) * 64 + (lig & 7) * 8 + (h & 3) * 2 + (lig >> 3)] = (unsigned short)my_eid[rd]; wts[o] = e / sm;
            }
        }
        __syncthreads();
    }
}

__device__ __forceinline__ void hgrn_pre_item(const Params& p, unsigned char* lds, int ci) {
    const int tid = threadIdx.x, lane = tid & 63, wid = tid >> 6, k = tid & 127, tq = tid >> 7;
    const int n = ci & 127, h = (ci >> 7) & 3, b = ci >> 9, tok0 = b * T + n * 64;
    bf16* proj = (bf16*)(p.ws + WS_PROJ);
    float* OB = p.out; bf16* KIT = (bf16*)((unsigned char*)p.out + OUT_KIT) + (size_t)ci * 8192; bf16* VTg = (bf16*)((unsigned char*)p.out + OUT_VT) + (size_t)ci * 8192;
    float* DEC = (float*)(p.ws + WS_DEC) + (size_t)ci * 128;
    bf16* QT = (bf16*)lds; bf16* KT = (bf16*)(lds + 17408); bf16* VTl = (bf16*)(lds + 34816); bf16* AM = (bf16*)(lds + 53248);
    float* part = (float*)(lds + 62464); float* gref = (float*)(lds + 64512);
    float lb; { const float l0 = p.in[4][h * 128 + k], l1 = p.in[4][512 + h * 128 + k]; const float m = fmaxf(l0, l1); const float e0 = __expf(l0 - m), e1 = __expf(l1 - m); lb = e0 / (e0 + e1); }
    float G[16], key[16], qv[16], vv[16];
    {
        float c = 0.f;
#pragma unroll
        for (int i = 0; i < 16; ++i) {
            const size_t row = (size_t)(tok0 + tq * 16 + i) * PS;
            const float fg = lb + (1.0f - lb) * sigmoidf_(bf2f(proj[row + C_HF + h * 128 + k]));
            key[i] = 1.0f - fg; c += __logf(fg); G[i] = c;
            qv[i] = siluf_(bf2f(proj[row + C_HQ + h * 128 + k])) * 0.08838834764831845f;
            vv[i] = bf2f(proj[row + C_HI + h * 128 + k]);
        }
        part[tq * 128 + k] = c;
    }
    __syncthreads();
    {
        float off = 0.f;
#pragma unroll
        for (int j = 0; j < 3; ++j) off += (j < tq) ? part[j * 128 + k] : 0.f;
#pragma unroll
        for (int i = 0; i < 16; ++i) G[i] += off;
        if (tq == 1) gref[k] = G[15];
        if (tq == 3) gref[128 + k] = G[15];
    }
    __syncthreads();
    {
        const float gr = gref[k], gl = gref[128 + k];
        const int kpos = (k & ~31) | (((k >> 2) & 3) << 3) | (((k >> 4) & 1) << 2) | (k & 3);
        unsigned kp[8], vp[8];
#pragma unroll
        for (int i = 0; i < 16; i += 2) {
            kp[i >> 1] = pk2(key[i] * __expf(gl - G[i]), key[i + 1] * __expf(gl - G[i + 1]));
            vp[i >> 1] = pk2(vv[i], vv[i + 1]);
        }
#pragma unroll
        for (int i = 0; i < 16; ++i) {
            const int t = tq * 16 + i;
            QT[t * 136 + k] = f2bf(qv[i] * __expf(G[i] - gr));
            KT[t * 136 + k] = f2bf(key[i] * __expf(gr - G[i]));
            proj[(size_t)(tok0 + t) * PS + C_HQ + h * 128 + kpos] = f2bf(qv[i] * __expf(G[i]));
        }
        u32x4 a0, a1, b0, b1; a0.x = kp[0]; a0.y = kp[1]; a0.z = kp[2]; a0.w = kp[3]; a1.x = kp[4]; a1.y = kp[5]; a1.z = kp[6]; a1.w = kp[7];
        b0.x = vp[0]; b0.y = vp[1]; b0.z = vp[2]; b0.w = vp[3]; b1.x = vp[4]; b1.y = vp[5]; b1.z = vp[6]; b1.w = vp[7];
        *(u32x4*)(KIT + k * 64 + tq * 16) = a0; *(u32x4*)(KIT + k * 64 + tq * 16 + 8) = a1;
        *(u32x4*)(VTg + k * 64 + tq * 16) = b0; *(u32x4*)(VTg + k * 64 + tq * 16 + 8) = b1;
        *(u32x4*)(VTl + k * 72 + tq * 16) = b0; *(u32x4*)(VTl + k * 72 + tq * 16 + 8) = b1;
        if (tq == 3) DEC[k] = __expf(gl);
    }
    __syncthreads();
    const int fr = lane & 15, fq = lane >> 4;
    {
        const int tt = wid >> 1;
#pragma unroll
        for (int e = 0; e < 2; ++e) {
            const int st = 2 * (wid & 1) + e;
            f32x4 acc = (f32x4){0.f, 0.f, 0.f, 0.f};
            if (st <= tt) {
#pragma unroll
                for (int s = 0; s < 4; ++s) {
                    const bf16x8 a = *(const bf16x8*)(QT + (tt * 16 + fr) * 136 + s * 32 + fq * 8), bb = *(const bf16x8*)(KT + (st * 16 + fr) * 136 + s * 32 + fq * 8);
                    acc = __builtin_amdgcn_mfma_f32_16x16x32_bf16(a, bb, acc, 0, 0, 0);
                }
            }
#pragma unroll
            for (int r = 0; r < 4; ++r) { const int t = tt * 16 + fq * 4 + r, sp = st * 16 + fr; AM[t * 72 + sp] = f2bf(sp <= t ? acc[r] : 0.f); }
        }
    }
    __syncthreads();
    {
        const int tt = wid >> 1;
        const bf16x8 a0 = *(const bf16x8*)(AM + (tt * 16 + fr) * 72 + fq * 8), a1 = *(const bf16x8*)(AM + (tt * 16 + fr) * 72 + 32 + fq * 8);
#pragma unroll
        for (int e = 0; e < 4; ++e) {
            const int vt = (wid & 1) * 4 + e;
            const bf16x8 b0 = *(const bf16x8*)(VTl + (vt * 16 + fr) * 72 + fq * 8), b1 = *(const bf16x8*)(VTl + (vt * 16 + fr) * 72 + 32 + fq * 8);
            f32x4 acc = (f32x4){0.f, 0.f, 0.f, 0.f};
            acc = __builtin_amdgcn_mfma_f32_16x16x32_bf16(a0, b0, acc, 0, 0, 0);
            acc = __builtin_amdgcn_mfma_f32_16x16x32_bf16(a1, b1, acc, 0, 0, 0);
#pragma unroll
            for (int r = 0; r < 4; ++r) OB[(size_t)(tok0 + tt * 16 + fq * 4 + r) * 512 + h * 128 + vt * 16 + fr] = acc[r];
        }
    }
    __syncthreads();
}
template <bool DUMMY>
__device__ __forceinline__ void hgrn_scan_item(const Params& p, int wi) {
    const int lane = threadIdx.x & 63, fr = lane & 15, fq = lane >> 4;
    const int vs = wi & 7, bh = wi >> 3, h = bh & 3, b = bh >> 2;
    const bf16* proj = (const bf16*)(p.ws + WS_PROJ);
    float* OB = p.out; const bf16* KIT = (const bf16*)((unsigned char*)p.out + OUT_KIT); const bf16* VTg = (const bf16*)((unsigned char*)p.out + OUT_VT);
    const float* DEC = (const float*)(p.ws + WS_DEC);
    f32x4 S[8];
#pragma unroll
    for (int i = 0; i < 8; ++i) S[i] = (f32x4){0.f, 0.f, 0.f, 0.f};
#pragma unroll 1
    for (int n = 0; n < 128; ++n) {
        const int ci = bh * 128 + n, tok0 = b * T + n * 64;
        bf16x8 qf[4][4];
#pragma unroll
        for (int tt = 0; tt < 4; ++tt)
#pragma unroll
            for (int s = 0; s < 4; ++s) qf[tt][s] = *(const bf16x8*)(proj + (size_t)(tok0 + tt * 16 + fr) * PS + C_HQ + h * 128 + s * 32 + fq * 8);
        float oin[4][4];
#pragma unroll
        for (int tt = 0; tt < 4; ++tt)
#pragma unroll
            for (int r = 0; r < 4; ++r) oin[tt][r] = OB[(size_t)(tok0 + tt * 16 + fq * 4 + r) * 512 + h * 128 + vs * 16 + fr];
        bf16x8 Sb[4];
#pragma unroll
        for (int s = 0; s < 4; ++s) {
            u32x4 w; w.x = pk2(S[2 * s][0], S[2 * s][1]); w.y = pk2(S[2 * s][2], S[2 * s][3]); w.z = pk2(S[2 * s + 1][0], S[2 * s + 1][1]); w.w = pk2(S[2 * s + 1][2], S[2 * s + 1][3]);
            Sb[s] = __builtin_bit_cast(bf16x8, w);
        }
#pragma unroll
        for (int tt = 0; tt < 4; ++tt) {
            f32x4 acc = (f32x4){0.f, 0.f, 0.f, 0.f};
#pragma unroll
            for (int s = 0; s < 4; ++s) acc = __builtin_amdgcn_mfma_f32_16x16x32_bf16(qf[tt][s], Sb[s], acc, 0, 0, 0);
#pragma unroll
            for (int r = 0; r < 4; ++r) { const size_t oi = (size_t)(tok0 + tt * 16 + fq * 4 + r) * 512 + h * 128 + vs * 16 + fr; if (DUMMY) ((float*)(p.ws + WS_SPARE))[oi & 0x3fffff] = oin[tt][r] + acc[r]; else OB[oi] = oin[tt][r] + acc[r]; }
        }
        const bf16x8 v0 = *(const bf16x8*)(VTg + (size_t)ci * 8192 + (vs * 16 + fr) * 64 + fq * 8), v1 = *(const bf16x8*)(VTg + (size_t)ci * 8192 + (vs * 16 + fr) * 64 + 32 + fq * 8);
#pragma unroll
        for (int kb = 0; kb < 8; ++kb) {
            const bf16x8 k0 = *(const bf16x8*)(KIT + (size_t)ci * 8192 + (kb * 16 + fr) * 64 + fq * 8), k1 = *(const bf16x8*)(KIT + (size_t)ci * 8192 + (kb * 16 + fr) * 64 + 32 + fq * 8);
            const f32x4 dv = *(const f32x4*)(DEC + (size_t)ci * 128 + kb * 16 + fq * 4);
            f32x4 sacc = S[kb] * dv;
            sacc = __builtin_amdgcn_mfma_f32_16x16x32_bf16(k0, v0, sacc, 0, 0, 0);
            sacc = __builtin_amdgcn_mfma_f32_16x16x32_bf16(k1, v1, sacc, 0, 0, 0);
            S[kb] = sacc;
        }
    }
}

__device__ __forceinline__ void hgrn_scan_block(const Params& p, unsigned char* lds, int sb) {
    const int tid = threadIdx.x, lane = tid & 63, wid = __builtin_amdgcn_readfirstlane(tid >> 6), fr = lane & 15, fq = lane >> 4;
    const int bh = sb >> 2, vs = (sb & 3) * 2 + (wid & 1); const bool worker = wid < 2;
    const int h = bh & 3, b = bh >> 2;
    const bf16* proj = (const bf16*)(p.ws + WS_PROJ);
    float* OB = p.out; const bf16* KIT = (const bf16*)((unsigned char*)p.out + OUT_KIT); const bf16* VTg = (const bf16*)((unsigned char*)p.out + OUT_VT);
    const float* DEC = (const float*)(p.ws + WS_DEC);
    constexpr int BUF = 54784, O_KIT = 17408, O_VT = 17408 + 18432, O_DEC = 17408 + 2 * 18432;
    u32x4 rqA[2], rkA[2], rvA[2], rdA, rqB[2], rkB[2], rvB[2], rdB;
    float oin[4][4];
#define SC_ISSUE(rq, rk, rv, rd, n_) { const int ci_ = bh * 128 + (n_), tk_ = b * T + (n_) * 64; \
        _Pragma("unroll") for (int i = 0; i < 2; ++i) { const int id = tid + i * NTHR; \
            rq[i] = *(const u32x4*)(proj + (size_t)(tk_ + (id >> 4)) * PS + C_HQ + h * 128 + (id & 15) * 8); \
            rk[i] = *(const u32x4*)(KIT + (size_t)ci_ * 8192 + id * 8); rv[i] = *(const u32x4*)(VTg + (size_t)ci_ * 8192 + id * 8); } \
        if (tid < 32) rd = *(const u32x4*)(DEC + (size_t)ci_ * 128 + tid * 4); }
#define SC_STASH(rq, rk, rv, rd, buf) { _Pragma("unroll") for (int i = 0; i < 2; ++i) { const int id = tid + i * NTHR; \
            *(u32x4*)((buf) + (id >> 4) * 272 + (id & 15) * 16) = rq[i]; *(u32x4*)((buf) + O_KIT + (id >> 3) * 144 + (id & 7) * 16) = rk[i]; \
            *(u32x4*)((buf) + O_VT + (id >> 3) * 144 + (id & 7) * 16) = rv[i]; } \
        if (tid < 32) *(u32x4*)((buf) + O_DEC + tid * 16) = rd; }
    auto load_oin = [&](int n) {
        const int tok0 = b * T + n * 64;
#pragma unroll
        for (int tt = 0; tt < 4; ++tt)
#pragma unroll
            for (int r = 0; r < 4; ++r) oin[tt][r] = OB[(size_t)(tok0 + tt * 16 + fq * 4 + r) * 512 + h * 128 + vs * 16 + fr];
    };
    f32x4 S[8];
#pragma unroll
    for (int i = 0; i < 8; ++i) S[i] = (f32x4){0.f, 0.f, 0.f, 0.f};
    SC_ISSUE(rqA, rkA, rvA, rdA, 0)
    SC_ISSUE(rqB, rkB, rvB, rdB, 1)
    SC_STASH(rqA, rkA, rvA, rdA, lds)
    __syncthreads();
    auto compute = [&](int n, unsigned char* cur) {
        const int tok0 = b * T + n * 64;
        const int nn = (n + 1 < 128) ? n + 1 : n;
        bf16x8 Sb[4];
#pragma unroll
        for (int s = 0; s < 4; ++s) {
            u32x4 w; w.x = pk2(S[2 * s][0], S[2 * s][1]); w.y = pk2(S[2 * s][2], S[2 * s][3]); w.z = pk2(S[2 * s + 1][0], S[2 * s + 1][1]); w.w = pk2(S[2 * s + 1][2], S[2 * s + 1][3]);
            Sb[s] = __builtin_bit_cast(bf16x8, w);
        }
        f32x4 oacc[4];
#pragma unroll
        for (int hf = 0; hf < 2; ++hf) {
            bf16x8 qf[2][4];
#pragma unroll
            for (int t2 = 0; t2 < 2; ++t2)
#pragma unroll
                for (int s = 0; s < 4; ++s) qf[t2][s] = *(const bf16x8*)(cur + ((hf * 2 + t2) * 16 + fr) * 272 + (s * 32 + fq * 8) * 2);
            __builtin_amdgcn_sched_barrier(0);
#pragma unroll
            for (int t2 = 0; t2 < 2; ++t2) oacc[hf * 2 + t2] = (f32x4){0.f, 0.f, 0.f, 0.f};
#pragma unroll
            for (int s = 0; s < 4; ++s)
#pragma unroll
                for (int t2 = 0; t2 < 2; ++t2) oacc[hf * 2 + t2] = __builtin_amdgcn_mfma_f32_16x16x32_bf16(qf[t2][s], Sb[s], oacc[hf * 2 + t2], 0, 0, 0);
        }
        { bf16* MX = (bf16*)(p.ws + WS_ACT);
#pragma unroll
          for (int tt = 0; tt < 4; ++tt)
#pragma unroll
            for (int r = 0; r < 4; ++r) MX[(size_t)(tok0 + tt * 16 + fq * 4 + r) * D + h * 128 + vs * 16 + fr] = f2bf(oacc[tt][r]); }
        const bf16x8 v0 = *(const bf16x8*)(cur + O_VT + (vs * 16 + fr) * 144 + fq * 16), v1 = *(const bf16x8*)(cur + O_VT + (vs * 16 + fr) * 144 + 64 + fq * 16);
#pragma unroll
        for (int hf = 0; hf < 2; ++hf) {
            bf16x8 kf[4][2]; f32x4 dvv[4];
#pragma unroll
            for (int k4 = 0; k4 < 4; ++k4) { const int kb = hf * 4 + k4;
                kf[k4][0] = *(const bf16x8*)(cur + O_KIT + (kb * 16 + fr) * 144 + fq * 16); kf[k4][1] = *(const bf16x8*)(cur + O_KIT + (kb * 16 + fr) * 144 + 64 + fq * 16);
                dvv[k4] = *(const f32x4*)(cur + O_DEC + (kb * 16 + fq * 4) * 4); }
            __builtin_amdgcn_sched_barrier(0);
#pragma unroll
            for (int k4 = 0; k4 < 4; ++k4) S[hf * 4 + k4] = S[hf * 4 + k4] * dvv[k4];
#pragma unroll
            for (int e = 0; e < 2; ++e)
#pragma unroll
                for (int k4 = 0; k4 < 4; ++k4) S[hf * 4 + k4] = __builtin_amdgcn_mfma_f32_16x16x32_bf16(kf[k4][e], e == 0 ? v0 : v1, S[hf * 4 + k4], 0, 0, 0);
        }
    };
#pragma unroll 1
    for (int n = 0; n < 128; n += 2) {
        { const int n2 = (n + 2 < 128) ? n + 2 : n; SC_ISSUE(rqA, rkA, rvA, rdA, n2) }
        if (worker) compute(n, lds);
        SC_STASH(rqB, rkB, rvB, rdB, lds + BUF)
        asm volatile("s_waitcnt lgkmcnt(0)" ::: "memory"); __builtin_amdgcn_s_barrier(); asm volatile("" ::: "memory");
        { const int n3 = (n + 3 < 128) ? n + 3 : n + 1; SC_ISSUE(rqB, rkB, rvB, rdB, n3) }
        if (worker) compute(n + 1, lds + BUF);
        SC_STASH(rqA, rkA, rvA, rdA, lds)
        asm volatile("s_waitcnt lgkmcnt(0)" ::: "memory"); __builtin_amdgcn_s_barrier(); asm volatile("" ::: "memory");
    }
#undef SC_ISSUE
#undef SC_STASH
}
__device__ __forceinline__ void phase4(const Params& p, unsigned char* lds) {
    const bf16* proj = (const bf16*)(p.ws + WS_PROJ); const float* OB = p.out; bf16* mixed = (bf16*)(p.ws + WS_ACT); const float* gain = p.in[5];
    const int lane = threadIdx.x & 63, gw = (blockIdx.x * NTHR + threadIdx.x) >> 6, ngw = (gridDim.x * NTHR) >> 6;
    for (int tok = gw; tok < NTOK; tok += ngw) {
        f32x4 o0 = *(const f32x4*)(OB + (size_t)tok * 512 + lane * 8), o1 = *(const f32x4*)(OB + (size_t)tok * 512 + lane * 8 + 4);
        { const u32x4 oi = *(const u32x4*)(mixed + (size_t)tok * D + lane * 8); const unsigned a = oi.x, b = oi.y, c = oi.z, d = oi.w;
          o0.x += __uint_as_float(a << 16); o0.y += __uint_as_float(a & 0xffff0000u); o0.z += __uint_as_float(b << 16); o0.w += __uint_as_float(b & 0xffff0000u);
          o1.x += __uint_as_float(c << 16); o1.y += __uint_as_float(c & 0xffff0000u); o1.z += __uint_as_float(d << 16); o1.w += __uint_as_float(d & 0xffff0000u); }
        const u32x4 gp = *(const u32x4*)(proj + (size_t)tok * PS + C_HG + lane * 8);
        const f32x4 g0 = *(const f32x4*)(gain + lane * 8), g1 = *(const f32x4*)(gain + lane * 8 + 4);
        float ss = o0.x * o0.x + o0.y * o0.y + o0.z * o0.z + o0.w * o0.w + o1.x * o1.x + o1.y * o1.y + o1.z * o1.z + o1.w * o1.w;
        ss = grp16_sum(ss);
        const float r = rsqrtf(ss * (1.0f / 128.0f) + EPS);
        const unsigned gx = gp.x, gy = gp.y, gz = gp.z, gw_ = gp.w;
        u32x4 w;
        w.x = pk2(o0.x * r * g0.x * siluf_(__uint_as_float(gx << 16)), o0.y * r * g0.y * siluf_(__uint_as_float(gx & 0xffff0000u)));
        w.y = pk2(o0.z * r * g0.z * siluf_(__uint_as_float(gy << 16)), o0.w * r * g0.w * siluf_(__uint_as_float(gy & 0xffff0000u)));
        w.z = pk2(o1.x * r * g1.x * siluf_(__uint_as_float(gz << 16)), o1.y * r * g1.y * siluf_(__uint_as_float(gz & 0xffff0000u)));
        w.w = pk2(o1.z * r * g1.z * siluf_(__uint_as_float(gw_ << 16)), o1.w * r * g1.w * siluf_(__uint_as_float(gw_ & 0xffff0000u)));
        *(u32x4*)(mixed + (size_t)tok * D + lane * 8) = w;
    }
}

#define WAVE_LDS_SYNC() asm volatile("s_waitcnt lgkmcnt(0)" ::: "memory")
__device__ __forceinline__ void nsa_prep_item(const Params& p, unsigned char* lds, int tile) {
    const int tid = threadIdx.x, lig = tid & 15;
    const int tok0 = tile * 64;
    bf16* proj = (bf16*)(p.ws + WS_PROJ);
    for (int rho = tid >> 4; rho < 768; rho += 32) {
        const int tl = rho / 12, which = rho - tl * 12;
        int col; const float* gain; float sc = 1.0f;
        if (which < 8) { col = C_NQ + which * 64; gain = p.in[6]; sc = 0.125f * 1.4426950408889634f; }
        else if (which < 10) { col = C_KS + (which - 8) * 64; gain = p.in[7] + 64; }
        else { col = C_KW + (which - 10) * 64; gain = p.in[7] + 128; }
        bf16* rp = proj + (size_t)(tok0 + tl) * PS + col + lig * 4;
        const u32x2 raw = *(const u32x2*)rp;
        const unsigned r0 = raw.x, r1 = raw.y;
        const float a = __uint_as_float(r0 << 16), b = __uint_as_float(r0 & 0xffff0000u), c = __uint_as_float(r1 << 16), d = __uint_as_float(r1 & 0xffff0000u);
        const float ss = grp16_sum(a * a + b * b + c * c + d * d);
        const float r = rsqrtf(ss * (1.0f / 64.0f) + EPS) * sc;
        const f32x4 gg = *(const f32x4*)(gain + lig * 4);
        u32x2 o; o.x = pk2(a * r * gg.x, b * r * gg.y); o.y = pk2(c * r * gg.z, d * r * gg.w);
        if (which < 8) *(u32x2*)rp = o;
        else {
            const int g = (which - 8) & 1, tok = tok0 + tl, b = tok / T, t = tok % T;
            unsigned char* kb = p.ws + (which < 10 ? WS_KFS : WS_KFW) + ((size_t)(b * 2 + g) * 256 + (t >> 5)) * 4096;
            *(u32x2*)(kb + (lig >> 2) * 1024 + ((t & 31) + 32 * ((lig >> 1) & 1)) * 16 + (lig & 1) * 8) = o;
        }
    }
    {
        const int c = tid & 127, tq = tid >> 7, g = c >> 6, d = c & 63, b = tok0 / T, t0 = tok0 % T;
#pragma unroll
        for (int which = 0; which < 2; ++which) {
            const int col = (which == 0 ? C_VS : C_VW) + c;
            unsigned short e[16];
#pragma unroll
            for (int i = 0; i < 16; ++i) e[i] = proj[(size_t)(tok0 + tq * 16 + i) * PS + col];
            unsigned char* vb = p.ws + (which == 0 ? WS_VTS : WS_VTW) + ((size_t)(b * 2 + g) * 256 + ((t0 + tq * 16) >> 5)) * 4096 + ((d >> 5) * 2 + (tq & 1)) * 1024 + (d & 31) * 16;
            u32x4 h0, h1;
            h0.x = e[0] | ((unsigned)e[1] << 16); h0.y = e[2] | ((unsigned)e[3] << 16); h0.z = e[8] | ((unsigned)e[9] << 16); h0.w = e[10] | ((unsigned)e[11] << 16);
            h1.x = e[4] | ((unsigned)e[5] << 16); h1.y = e[6] | ((unsigned)e[7] << 16); h1.z = e[12] | ((unsigned)e[13] << 16); h1.w = e[14] | ((unsigned)e[15] << 16);
            *(u32x4*)vb = h0; *(u32x4*)(vb + 512) = h1;
        }
    }
}
__device__ __forceinline__ void nsa_cmp_item(const Params& p, unsigned char* lds, int item) {
    const int tid = threadIdx.x, lane = tid & 63, wid = tid >> 6, fr = lane & 15, fq = lane >> 4;
    const int nt32 = item & 15, g = (item >> 4) & 1, b = (item >> 5) & 1, which = item >> 6, n0 = nt32 * 32;
    const bf16* proj = (const bf16*)(p.ws + WS_PROJ);
    const float* pe = p.in[8] + which * 2048;
    const bf16* W1T = (const bf16*)(p.ws + WS_W1T) + (size_t)which * 64 * 2048;
    const float* w2 = p.in[10] + which * 4096;
    bf16* A = (bf16*)lds; float* H = (float*)(lds + 33280);
    const int col0 = (which == 0 ? C_KC : C_VC) + g * 64;
    const int nt = wid & 1, ct = wid >> 1;
    f32x4 acc = (f32x4){0.f, 0.f, 0.f, 0.f};
#pragma unroll 1
    for (int kc = 0; kc < 4; ++kc) {
#pragma unroll
        for (int i = 0; i < 4; ++i) {
            const int idx = tid + i * NTHR, dch = idx & 7, jj = (idx >> 3) & 7, n = idx >> 6, j = kc * 8 + jj;
            u32x4 o = (u32x4){0u, 0u, 0u, 0u};
            if (n0 + n < NCMP) {
                const u32x4 raw = *(const u32x4*)(proj + (size_t)(b * T + 16 * (n0 + n) + j) * PS + col0 + dch * 8);
                const f32x4 p0 = *(const f32x4*)(pe + j * 64 + dch * 8), p1 = *(const f32x4*)(pe + j * 64 + dch * 8 + 4);
                const unsigned r0 = raw.x, r1 = raw.y, r2 = raw.z, r3 = raw.w;
                o.x = pk2(__uint_as_float(r0 << 16) + p0.x, __uint_as_float(r0 & 0xffff0000u) + p0.y);
                o.y = pk2(__uint_as_float(r1 << 16) + p0.z, __uint_as_float(r1 & 0xffff0000u) + p0.w);
                o.z = pk2(__uint_as_float(r2 << 16) + p1.x, __uint_as_float(r2 & 0xffff0000u) + p1.y);
                o.w = pk2(__uint_as_float(r3 << 16) + p1.z, __uint_as_float(r3 & 0xffff0000u) + p1.w);
            }
            *(u32x4*)(A + n * 520 + jj * 64 + dch * 8) = o;
        }
        __syncthreads();
#pragma unroll 4
        for (int s = 0; s < 16; ++s) {
            const bf16x8 a = *(const bf16x8*)(A + (nt * 16 + fr) * 520 + s * 32 + fq * 8);
            const bf16x8 bb = *(const bf16x8*)(W1T + (size_t)(ct * 16 + fr) * 2048 + kc * 512 + s * 32 + fq * 8);
            acc = __builtin_amdgcn_mfma_f32_16x16x32_bf16(a, bb, acc, 0, 0, 0);
        }
        __syncthreads();
    }
#pragma unroll
    for (int r = 0; r < 4; ++r) H[(nt * 16 + fq * 4 + r) * 64 + ct * 16 + fr] = gelu_tanh(acc[r]);
    __syncthreads();
    {
        const int n = tid >> 4, c = (tid & 15) * 4;
        f32x4 o = (f32x4){0.f, 0.f, 0.f, 0.f};
#pragma unroll 8
        for (int i = 0; i < 64; ++i) { const float hv = H[n * 64 + i]; const f32x4 w = *(const f32x4*)(w2 + i * 64 + c); o += hv * w; }
        if (which == 0) {
            const float ss = grp16_sum(o.x * o.x + o.y * o.y + o.z * o.z + o.w * o.w);
            const float r = rsqrtf(ss * (1.0f / 64.0f) + EPS);
            const f32x4 gg = *(const f32x4*)(p.in[7] + c);
            o = o * r * gg;
        }
        if (n0 + n >= NCMP) o = (f32x4){0.f, 0.f, 0.f, 0.f};
        const int nn = n0 + n;
        if (which == 0) { u32x2 w; w.x = pk2(o.x, o.y); w.y = pk2(o.z, o.w);
            *(u32x2*)(p.ws + WS_KC + ((size_t)(b * 2 + g) * 16 + (nn >> 5)) * 4096 + (c >> 4) * 1024 + ((nn & 31) + 32 * ((c >> 3) & 1)) * 16 + (c & 7) * 2) = w; }
        else {
            const int kl = nn & 31, sst = kl >> 4, r = kl & 15, j = ((r >> 3) << 2) | (r & 3), hh = (r >> 2) & 1;
            bf16* vt = (bf16*)(p.ws + WS_VCT + ((size_t)(b * 2 + g) * 16 + (nn >> 5)) * 4096 + sst * 1024 + hh * 512 + j * 2);
            const float ov[4] = {o.x, o.y, o.z, o.w};
#pragma unroll
            for (int e = 0; e < 4; ++e) { const int dd = c + e; vt[((dd >> 5) * 2048 + (dd & 31) * 16) / 2] = f2bf(ov[e]); }
        }
    }
    __syncthreads();
}

constexpr float LOG2E = 1.4426950408889634f;
__device__ __forceinline__ int rho16(int reg, int hh) { return (reg & 3) + 8 * (reg >> 2) + 4 * hh; }
__device__ __forceinline__ bf16x8 pack8(const float* pv) {
    u32x4 w; w.x = pk2(pv[0], pv[1]); w.y = pk2(pv[2], pv[3]); w.z = pk2(pv[4], pv[5]); w.w = pk2(pv[6], pv[7]);
    return __builtin_bit_cast(bf16x8, w);
}
struct KF { bf16x8 f[4]; };
struct VF { bf16x8 f[4]; };
__device__ __forceinline__ void load_k(KF& k, const unsigned char* tp) {
#pragma unroll
    for (int s = 0; s < 4; ++s) k.f[s] = *(const bf16x8*)(tp + s * 1024);
}
__device__ __forceinline__ void load_v(VF& v, const unsigned char* tp) {
#pragma unroll
    for (int q = 0; q < 4; ++q) v.f[q] = *(const bf16x8*)(tp + q * 1024);
}
__device__ __forceinline__ f32x16 score_tile(const KF& k, const bf16x8 (&qf)[4], float slope, float base) {
    f32x16 st;
#pragma unroll
    for (int i = 0; i < 16; ++i) st[i] = fmaf(slope, (float)((i & 3) + 8 * (i >> 2)), base);
#pragma unroll
    for (int s = 0; s < 4; ++s) st = __builtin_amdgcn_mfma_f32_32x32x16_bf16(k.f[s], qf[s], st, 0, 0, 0);
    return st;
}
__device__ __forceinline__ void pv_tile(f32x16& o0, f32x16& o1, const VF& v, const float* pv) {
    const bf16x8 p0 = pack8(pv), p1 = pack8(pv + 8);
    o0 = __builtin_amdgcn_mfma_f32_32x32x16_bf16(v.f[0], p0, o0, 0, 0, 0); o0 = __builtin_amdgcn_mfma_f32_32x32x16_bf16(v.f[1], p1, o0, 0, 0, 0);
    o1 = __builtin_amdgcn_mfma_f32_32x32x16_bf16(v.f[2], p0, o1, 0, 0, 0); o1 = __builtin_amdgcn_mfma_f32_32x32x16_bf16(v.f[3], p1, o1, 0, 0, 0);
}
template <bool FAST>
__device__ __forceinline__ void attn_tile(const KF& kc, const VF& vf, const bf16x8 (&qf)[4], float slope, float base, int distbase, bool colsel, int wlimit,
                                          float& l, f32x16& o0, f32x16& o1) {
    const f32x16 st = score_tile(kc, qf, slope, base);
    float sv[16]; float ps = 0.f;
#pragma unroll
    for (int i = 0; i < 16; ++i) {
        float e = __builtin_amdgcn_exp2f(st[i]);
        if (!FAST) { const int dist = distbase - ((i & 3) + 8 * (i >> 2)); e = (colsel && dist >= 0 && dist < wlimit) ? e : 0.f; }
        sv[i] = e; ps += e;
    }
    l += ps;
    pv_tile(o0, o1, vf, sv);
}
__device__ __forceinline__ void nsa_attn_item(const Params& p, unsigned char* wlds, int item) {
    const int lane = threadIdx.x & 63, c = lane & 31, hh = lane >> 5, jt = c >> 2, r4 = c & 3;
    const int oct = item & 1023, g = (item >> 10) & 1, b = item >> 11;
    const int t0 = oct * 8, tc = t0 + jt, h = g * 4 + r4;
    const float slope = exp2f(-(float)(h + 1)) * LOG2E;
    const bf16* proj = (const bf16*)(p.ws + WS_PROJ);
    float* impA = (float*)wlds; float* impB = impA + 1024; unsigned* msk = (unsigned*)(impB + 1024);
    unsigned char* blist = (unsigned char*)(msk + 32);
    float* ocl = (float*)(wlds + 8448) + lane;
#pragma unroll
    for (int i = 0; i < 16; ++i) { impA[lane + 64 * i] = 0.f; impB[lane + 64 * i] = 0.f; }
    if (lane < 32) msk[lane] = 0u;
    bf16x8 qf[4];
    { const bf16* qp = proj + (size_t)(b * T + tc) * PS + C_NQ + h * 64 + hh * 8;
#pragma unroll
      for (int s = 0; s < 4; ++s) qf[s] = *(const bf16x8*)(qp + s * 16); }
    const bf16* gatep = proj + (size_t)(b * T + tc) * PS + C_GT + h * 3;
#define NSA_GATE(i) sigmoidf_(bf2f(gatep[i]))
    float bnd[3];
    { const float gq = wave_max(fabsf(p.in[6][lane]));
#pragma unroll
      for (int i = 0; i < 3; ++i) bnd[i] = __uint_as_float((unsigned)__builtin_amdgcn_readfirstlane((int)__float_as_uint(8.0f * LOG2E * 1.02f * gq * wave_max(fabsf(p.in[7][i * 64 + lane]))))); }
    WAVE_LDS_SYNC();
    {
        const unsigned char* KC = p.ws + WS_KC + (size_t)(b * 2 + g) * 65536 + lane * 16;
        const unsigned char* VCT = p.ws + WS_VCT + (size_t)(b * 2 + g) * 65536 + lane * 16;
        const int nmax = (t0 + 7 >= 31) ? ((t0 + 7 - 31) >> 4) : -1;
        const int nlast = (nmax >= 0) ? (nmax & ~31) : -32;
        float l = 0.f;
        f32x16 o0, o1;
#pragma unroll
        for (int i = 0; i < 16; ++i) { o0[i] = 0.f; o1[i] = 0.f; }
        KF kn;
        if (nlast >= 0) load_k(kn, KC + (size_t)nlast * 128);
#pragma unroll 1
        for (int n0 = nlast; n0 >= 0; n0 -= 32) {
            const KF kc = kn;
            load_k(kn, KC + (size_t)(n0 >= 32 ? n0 - 32 : n0) * 128);
            __builtin_amdgcn_sched_barrier(0);
            const int distbase = tc - 16 * (n0 + 4 * hh) - 31;
            const f32x16 st = score_tile(kc, qf, 16.0f * slope, -slope * (float)distbase - bnd[0]);
            float ps = 0.f;
#pragma unroll
            for (int i = 0; i < 16; ++i) { const int dist = distbase - 16 * ((i & 3) + 8 * (i >> 2)); ps += (dist >= 0) ? __builtin_amdgcn_exp2f(st[i]) : 0.f; }
            l += ps;
        }
        l += __shfl_xor(l, 32);
        const float inv = (l > 0.f) ? 1.0f / l : 0.f;
        if (nlast >= 0) load_k(kn, KC + (size_t)nlast * 128);
#pragma unroll 1
        for (int n0 = nlast; n0 >= 0; n0 -= 32) {
            const KF kc = kn; VF vf;
            load_v(vf, VCT + (size_t)n0 * 128);
            load_k(kn, KC + (size_t)(n0 >= 32 ? n0 - 32 : n0) * 128);
            __builtin_amdgcn_sched_barrier(0);
            const int distbase = tc - 16 * (n0 + 4 * hh) - 31;
            const f32x16 st = score_tile(kc, qf, 16.0f * slope, -slope * (float)distbase - bnd[0]);
            float pv[16];
#pragma unroll
            for (int i = 0; i < 16; ++i) { const int dist = distbase - 16 * ((i & 3) + 8 * (i >> 2)); pv[i] = (dist >= 0) ? __builtin_amdgcn_exp2f(st[i]) * inv : 0.f; }
            pv_tile(o0, o1, vf, pv);
#pragma unroll
            for (int i = 0; i < 16; ++i) { float v = pv[i]; v += dpp_f<0xB1>(v); v += dpp_f<0x4E>(v); pv[i] = v; }
            if (r4 == 0) {
#pragma unroll
                for (int rg = 0; rg < 4; ++rg) {
                    const int jb = (n0 >> 2) + 2 * rg + hh;
                    impA[jt * 128 + jb] = pv[4 * rg] + 2.f * pv[4 * rg + 1] + 2.f * pv[4 * rg + 2] + 2.f * pv[4 * rg + 3];
                    if (jb >= 1) impB[jt * 128 + jb - 1] = pv[4 * rg];
                }
            }
        }
        { const float g0 = NSA_GATE(0);
#pragma unroll
        for (int i = 0; i < 16; ++i) { ocl[i * 64] = g0 * o0[i]; ocl[(16 + i) * 64] = g0 * o1[i]; } }
    }
    WAVE_LDS_SYNC();
    {
        const int lig = lane & 15, grp = lane >> 4;
#pragma unroll 1
        for (int half = 0; half < 2; ++half) {
            const int j2 = half * 4 + grp, cur = (t0 + j2) >> 6;
            float v[8];
#pragma unroll
            for (int e = 0; e < 8; ++e) {
                const int j = lig * 8 + e; const float val = impA[j2 * 128 + j] + impB[j2 * 128 + j];
                v[e] = (j >= 1 && j <= cur - 2) ? __uint_as_float((__float_as_uint(val) & ~127u) | (unsigned)(127 - j)) : -1.0f;
            }
            const float top = grp16_top16(v, lig);
            const int need = 16 - ((cur == 0) ? 1 : (cur == 1) ? 2 : 3);
            if (lig < need && top >= 0.f) { const int idx = 127 - (int)(__float_as_uint(top) & 127u); atomicOr(&msk[j2 * 4 + (idx >> 5)], 1u << (idx & 31)); }
            if (lig == 0) { atomicOr(&msk[j2 * 4], 1u); atomicOr(&msk[j2 * 4 + (cur >> 5)], 1u << (cur & 31)); if (cur >= 1) atomicOr(&msk[j2 * 4 + ((cur - 1) >> 5)], 1u << ((cur - 1) & 31)); }
        }
    }
    WAVE_LDS_SYNC();
    {
        int nblk = 0;
#pragma unroll
        for (int w = 3; w >= 0; --w) {
            unsigned u = 0u;
#pragma unroll
            for (int j = 0; j < 8; ++j) u |= msk[j * 4 + w];
            u = (unsigned)__builtin_amdgcn_readfirstlane((int)u);
            while (u) { const int bit = 31 - __builtin_clz(u); u &= ~(1u << bit); if (lane == 0) blist[nblk] = (unsigned char)(w * 32 + bit); ++nblk; }
        }
        WAVE_LDS_SYNC();
        const unsigned char* KS = p.ws + WS_KFS + (size_t)(b * 2 + g) * (256 * 4096) + lane * 16;
        const unsigned char* VTS = p.ws + WS_VTS + (size_t)(b * 2 + g) * (256 * 4096) + lane * 16;
        float l = 0.f;
        f32x16 o0, o1;
#pragma unroll
        for (int i = 0; i < 16; ++i) { o0[i] = 0.f; o1[i] = 0.f; }
        const int ntile = 2 * nblk;
        KF kn; VF vn;
        { const int jb0 = blist[0]; load_k(kn, KS + (size_t)(jb0 * 64 + 32) * 128); load_v(vn, VTS + (size_t)(jb0 * 64 + 32) * 128); }
#pragma unroll 1
        for (int ti = 0; ti < ntile; ++ti) {
            const int jb = __builtin_amdgcn_readfirstlane((int)blist[ti >> 1]);
            const int key0 = jb * 64 + 32 - 32 * (ti & 1);
            const KF kc = kn; const VF vf = vn;
            { const int tn = (ti + 1 < ntile) ? ti + 1 : ti; const int jn = __builtin_amdgcn_readfirstlane((int)blist[tn >> 1]); const size_t off = (size_t)(jn * 64 + 32 - 32 * (tn & 1)) * 128;
              load_k(kn, KS + off); load_v(vn, VTS + off); }
            __builtin_amdgcn_sched_barrier(0);
            const bool colsel = (msk[jt * 4 + (jb >> 5)] >> (jb & 31)) & 1u;
            const int distbase = tc - key0 - 4 * hh;
            if (key0 + 31 <= t0) attn_tile<true>(kc, vf, qf, slope, colsel ? -slope * (float)distbase - bnd[1] : -1e30f, distbase, true, 1 << 30, l, o0, o1);
            else attn_tile<false>(kc, vf, qf, slope, -slope * (float)distbase - bnd[1], distbase, colsel, 1 << 30, l, o0, o1);
        }
        l += __shfl_xor(l, 32);
        const float sc = (l > 0.f) ? NSA_GATE(1) / l : 0.f;
#pragma unroll
        for (int i = 0; i < 16; ++i) { ocl[i * 64] += sc * o0[i]; ocl[(16 + i) * 64] += sc * o1[i]; }
    }
    {
        const unsigned char* KW = p.ws + WS_KFW + (size_t)(b * 2 + g) * (256 * 4096) + lane * 16;
        const unsigned char* VTW = p.ws + WS_VTW + (size_t)(b * 2 + g) * (256 * 4096) + lane * 16;
        float l = 0.f;
        f32x16 o0, o1;
#pragma unroll
        for (int i = 0; i < 16; ++i) { o0[i] = 0.f; o1[i] = 0.f; }
        const int kstart = (t0 - 511 > 0 ? t0 - 511 : 0) & ~31, kfirst = t0 & ~31;
        KF kn;
        load_k(kn, KW + (size_t)kfirst * 128);
#pragma unroll 1
        for (int key0 = kfirst; key0 >= kstart; key0 -= 32) {
            const KF kc = kn; VF vf;
            load_v(vf, VTW + (size_t)key0 * 128);
            { const int kn0 = (key0 - 32 >= kstart) ? key0 - 32 : key0; load_k(kn, KW + (size_t)kn0 * 128); }
            __builtin_amdgcn_sched_barrier(0);
            const int distbase = tc - key0 - 4 * hh;
            if (key0 + 31 <= t0 && key0 >= t0 - 504) attn_tile<true>(kc, vf, qf, slope, -slope * (float)distbase - bnd[2], distbase, true, 512, l, o0, o1);
            else attn_tile<false>(kc, vf, qf, slope, -slope * (float)distbase - bnd[2], distbase, true, 512, l, o0, o1);
        }
        l += __shfl_xor(l, 32);
        const float sc = (l > 0.f) ? NSA_GATE(2) / l : 0.f;
#pragma unroll
        for (int i = 0; i < 16; ++i) { o0[i] = ocl[i * 64] + sc * o0[i]; o1[i] = ocl[(16 + i) * 64] + sc * o1[i]; }
        float ss = 0.f;
#pragma unroll
        for (int i = 0; i < 16; ++i) ss += o0[i] * o0[i] + o1[i] * o1[i];
        ss += __shfl_xor(ss, 32);
        const float r = rsqrtf(ss * (1.0f / 64.0f) + EPS);
        const float* og = p.in[11] + h * 64;
        bf16* op = (bf16*)(p.ws + WS_ACT) + (size_t)(b * T + tc) * D + 512 + h * 64;
#pragma unroll
        for (int dt = 0; dt < 2; ++dt)
#pragma unroll
            for (int rg = 0; rg < 4; ++rg) {
                const int d0 = dt * 32 + 8 * rg + 4 * hh;
                const f32x4 gg = *(const f32x4*)(og + d0);
                u32x2 w;
                if (dt == 0) { w.x = pk2(o0[4 * rg] * r * gg.x, o0[4 * rg + 1] * r * gg.y); w.y = pk2(o0[4 * rg + 2] * r * gg.z, o0[4 * rg + 3] * r * gg.w); }
                else { w.x = pk2(o1[4 * rg] * r * gg.x, o1[4 * rg + 1] * r * gg.y); w.y = pk2(o1[4 * rg + 2] * r * gg.z, o1[4 * rg + 3] * r * gg.w); }
                *(u32x2*)(op + d0) = w;
            }
    }
    WAVE_LDS_SYNC();
}
__device__ __forceinline__ void phase2(const Params& p, unsigned char* lds) {
    unsigned* ctr = (unsigned*)(p.ws + WS_CTR) + 2048;
    volatile int* slot = (volatile int*)(lds + LDS_BYTES - 32);
    for (;;) {
        if (threadIdx.x == 0) *slot = (int)atomicAdd(ctr, 1u);
        __syncthreads();
        const int it = *slot;
        __syncthreads();
        if (it >= 128 + 1024 + 256) break;
        if (it < 128) nsa_cmp_item(p, lds, it);
        else if (it < 1152) hgrn_pre_item(p, lds, it - 128);
        else { nsa_prep_item(p, lds, it - 1152); __syncthreads(); }
    }
}
template <bool SCAN>
__device__ __forceinline__ void phase3(const Params& p, unsigned char* lds) {
    const int wid = __builtin_amdgcn_readfirstlane((int)(threadIdx.x >> 6));
    if (SCAN && blockIdx.x < 32) hgrn_scan_block(p, lds, blockIdx.x);
    unsigned* ctr = (unsigned*)(p.ws + WS_CTR) + (SCAN ? 0 : 128);
    const int myx = (int)(xb_xcc_id() & 7u);
    for (;;) {
        int q = -1, it = 0;
        for (int k = 0; k < 8; ++k) {
            const int x = (myx + k) & 7;
            int v = 0;
            if ((threadIdx.x & 63) == 0) v = (int)atomicAdd(ctr + x * 16, 1u);
            v = __builtin_amdgcn_readfirstlane(v);
            if (v < 512) { q = x; it = v; break; }
        }
        if (q < 0) break;
        const int item = ((q >> 1) << 10) | ((q & 1) * 512 + 511 - it);
        nsa_attn_item(p, lds + wid * 16640, item);
    }
}

__device__ __forceinline__ float dot2u(unsigned a, unsigned b, float acc) { return __builtin_amdgcn_fdot2_f32_bf16(__builtin_bit_cast(bf16x2v, a), __builtin_bit_cast(bf16x2v, b), acc, false); }
__device__ __forceinline__ float dot8(u32x4 a, u32x4 b, float acc) {
    const unsigned a0 = a.x, a1 = a.y, a2 = a.z, a3 = a.w, b0 = b.x, b1 = b.y, b2 = b.z, b3 = b.w;
    acc = dot2u(a0, b0, acc); acc = dot2u(a1, b1, acc); acc = dot2u(a2, b2, acc); acc = dot2u(a3, b3, acc);
    return acc;
}
__device__ __forceinline__ void axpy8(float (&o)[8], float c, u32x4 v) {
    o[0] += c * __uint_as_float(v.x << 16); o[1] += c * __uint_as_float(v.x & 0xffff0000u);
    o[2] += c * __uint_as_float(v.y << 16); o[3] += c * __uint_as_float(v.y & 0xffff0000u);
    o[4] += c * __uint_as_float(v.z << 16); o[5] += c * __uint_as_float(v.z & 0xffff0000u);
    o[6] += c * __uint_as_float(v.w << 16); o[7] += c * __uint_as_float(v.w & 0xffff0000u);
}
typedef float f32x2 __attribute__((ext_vector_type(2)));
__device__ __forceinline__ float dot16_fp8(u32x4 r, const float* xf) {
    const unsigned r0 = r.x, r1 = r.y, r2 = r.z, r3 = r.w; f32x2 acc = (f32x2){0.f, 0.f};
#define D16_STEP(rr, hi, k) acc = __builtin_elementwise_fma(__builtin_amdgcn_cvt_pk_f32_fp8((int)(rr), hi), (f32x2){xf[k], xf[(k) + 1]}, acc);
    D16_STEP(r0, false, 0) D16_STEP(r0, true, 2) D16_STEP(r1, false, 4) D16_STEP(r1, true, 6)
    D16_STEP(r2, false, 8) D16_STEP(r2, true, 10) D16_STEP(r3, false, 12) D16_STEP(r3, true, 14)
#undef D16_STEP
    return acc.x + acc.y;
}
__device__ __forceinline__ void axpy16_fp8(float* o, float c, u32x4 r) {
    const unsigned r0 = r.x, r1 = r.y, r2 = r.z, r3 = r.w; const f32x2 cc = (f32x2){c, c};
#define A16_STEP(rr, hi, k) { f32x2 a = (f32x2){o[k], o[(k) + 1]}; a = __builtin_elementwise_fma(__builtin_amdgcn_cvt_pk_f32_fp8((int)(rr), hi), cc, a); o[k] = a.x; o[(k) + 1] = a.y; }
    A16_STEP(r0, false, 0) A16_STEP(r0, true, 2) A16_STEP(r1, false, 4) A16_STEP(r1, true, 6)
    A16_STEP(r2, false, 8) A16_STEP(r2, true, 10) A16_STEP(r3, false, 12) A16_STEP(r3, true, 14)
#undef A16_STEP
}
template <bool DUMMY>
__device__ __forceinline__ void phase9(const Params& p, unsigned char* lds) {
    const bf16* HN = (const bf16*)(p.ws + WS_ACT); const unsigned char* UB = p.ws + WS_UB; const unsigned char* VB = p.ws + WS_VB;
    const float* US = (const float*)(p.ws + WS_US); const float* VS = (const float*)(p.ws + WS_VS);
    const int* ids = (const int*)(p.ws + WS_IDS); const float* wts = (const float*)(p.ws + WS_WTS);
    float* O = p.out; bf16* HG = (bf16*)(p.ws + WS_PROJ + 64 * MiB); const float* gn = p.in[19];
    const int lane = threadIdx.x & 63, gw = (blockIdx.x * NTHR + threadIdx.x) >> 6, ngw = (gridDim.x * NTHR) >> 6;
    for (int tok = gw; tok < NTOK; tok += ngw) {
        float xf[16], oa[16];
        {
            const u32x4 x0 = *(const u32x4*)(HN + (size_t)tok * D + lane * 16), x1 = *(const u32x4*)(HN + (size_t)tok * D + lane * 16 + 8);
            const unsigned a0 = x0.x, a1 = x0.y, a2 = x0.z, a3 = x0.w, b0 = x1.x, b1 = x1.y, b2 = x1.z, b3 = x1.w;
            xf[0] = __uint_as_float(a0 << 16); xf[1] = __uint_as_float(a0 & 0xffff0000u); xf[2] = __uint_as_float(a1 << 16); xf[3] = __uint_as_float(a1 & 0xffff0000u);
            xf[4] = __uint_as_float(a2 << 16); xf[5] = __uint_as_float(a2 & 0xffff0000u); xf[6] = __uint_as_float(a3 << 16); xf[7] = __uint_as_float(a3 & 0xffff0000u);
            xf[8] = __uint_as_float(b0 << 16); xf[9] = __uint_as_float(b0 & 0xffff0000u); xf[10] = __uint_as_float(b1 << 16); xf[11] = __uint_as_float(b1 & 0xffff0000u);
            xf[12] = __uint_as_float(b2 << 16); xf[13] = __uint_as_float(b2 & 0xffff0000u); xf[14] = __uint_as_float(b3 << 16); xf[15] = __uint_as_float(b3 & 0xffff0000u);
        }
#pragma unroll
        for (int j = 0; j < 16; ++j) oa[j] = 0.f;
#pragma unroll 1
        for (int half = 0; half < 2; ++half) {
            const int myid = ids[(size_t)tok * 128 + half * 64 + lane];
            const float myw = wts[(size_t)tok * 128 + half * 64 + lane] * VS[myid];
            const float myus = US[myid];
#pragma unroll 1
            for (int eb = 0; eb < 64; eb += 16) {
                int id[16]; float d[16]; u32x4 ur[16];
#pragma unroll
                for (int j = 0; j < 16; ++j) id[j] = __shfl(myid, eb + j);
#pragma unroll
                for (int j = 0; j < 16; ++j) ur[j] = *(const u32x4*)(UB + (size_t)id[j] * D + lane * 16);
#pragma unroll
                for (int j = 0; j < 16; ++j) d[j] = dot16_fp8(ur[j], xf);
#pragma unroll
                for (int j = 0; j < 16; ++j) ur[j] = *(const u32x4*)(VB + (size_t)id[j] * D + lane * 16);
#pragma unroll
                for (int j = 0; j < 16; ++j) d[j] = wave_sum(d[j]);
#pragma unroll
                for (int j = 0; j < 16; ++j) { const float c = __shfl(myw, eb + j) * gelu_tanh(d[j] * __shfl(myus, eb + j)); axpy16_fp8(oa, c, ur[j]); }
            }
        }
        float* orow = O + (size_t)tok * D + lane * 16; float* wrow = DUMMY ? (float*)(p.ws + WS_PROJ) + (size_t)tok * D + lane * 16 : orow;
        float ss = 0.f; f32x4 hv[4];
#pragma unroll
        for (int q = 0; q < 4; ++q) {
            f32x4 h = *(const f32x4*)(orow + 4 * q);
            h.x += oa[4 * q]; h.y += oa[4 * q + 1]; h.z += oa[4 * q + 2]; h.w += oa[4 * q + 3];
            *(f32x4*)(wrow + 4 * q) = h; hv[q] = h;
            ss += h.x * h.x + h.y * h.y + h.z * h.z + h.w * h.w;
        }
        ss = wave_sum(ss);
        const float r = rsqrtf(ss * (1.0f / D) + EPS);
        u32x4 q0, q1;
        { const f32x4 g0 = *(const f32x4*)(gn + lane * 16), g1 = *(const f32x4*)(gn + lane * 16 + 4), g2 = *(const f32x4*)(gn + lane * 16 + 8), g3 = *(const f32x4*)(gn + lane * 16 + 12);
          q0.x = pk2(hv[0].x * r * g0.x, hv[0].y * r * g0.y); q0.y = pk2(hv[0].z * r * g0.z, hv[0].w * r * g0.w); q0.z = pk2(hv[1].x * r * g1.x, hv[1].y * r * g1.y); q0.w = pk2(hv[1].z * r * g1.z, hv[1].w * r * g1.w);
          q1.x = pk2(hv[2].x * r * g2.x, hv[2].y * r * g2.y); q1.y = pk2(hv[2].z * r * g2.z, hv[2].w * r * g2.w); q1.z = pk2(hv[3].x * r * g3.x, hv[3].y * r * g3.y); q1.w = pk2(hv[3].z * r * g3.z, hv[3].w * r * g3.w); }
        *(u32x4*)(HG + (size_t)tok * D + lane * 16) = q0; *(u32x4*)(HG + (size_t)tok * D + lane * 16 + 8) = q1;
    }
}


__device__ __forceinline__ unsigned xb_xcc_id();
template <int CTRL> __device__ __forceinline__ float dpp_row_ror(float v) { return __int_as_float(__builtin_amdgcn_update_dpp(0, __float_as_int(v), CTRL, 0xF, 0xF, false)); }
__device__ __forceinline__ float grp8_sum(float v) { v += dpp_f<0xB1>(v); v += dpp_f<0x4E>(v); v += dpp_f<0x141>(v); return v; }
__device__ __forceinline__ int peer_next_item(unsigned* ctr, int myx, int& slice) {
    for (int k = 0; k < 8; ++k) {
        const int x = (myx + k) & 7;
        int it = 0;
        if ((threadIdx.x & 63) == 0) it = (int)atomicAdd(ctr + x * 16, 1u);
        it = __builtin_amdgcn_readfirstlane(it);
        if (it < 1024) { slice = x; return it; }
    }
    return -1;
}
__device__ __forceinline__ void unpack16(const u32x4 x0, const u32x4 x1, float* xf) {
    const unsigned a0 = x0.x, a1 = x0.y, a2 = x0.z, a3 = x0.w, b0 = x1.x, b1 = x1.y, b2 = x1.z, b3 = x1.w;
    xf[0] = __uint_as_float(a0 << 16); xf[1] = __uint_as_float(a0 & 0xffff0000u); xf[2] = __uint_as_float(a1 << 16); xf[3] = __uint_as_float(a1 & 0xffff0000u);
    xf[4] = __uint_as_float(a2 << 16); xf[5] = __uint_as_float(a2 & 0xffff0000u); xf[6] = __uint_as_float(a3 << 16); xf[7] = __uint_as_float(a3 & 0xffff0000u);
    xf[8] = __uint_as_float(b0 << 16); xf[9] = __uint_as_float(b0 & 0xffff0000u); xf[10] = __uint_as_float(b1 << 16); xf[11] = __uint_as_float(b1 & 0xffff0000u);
    xf[12] = __uint_as_float(b2 << 16); xf[13] = __uint_as_float(b2 & 0xffff0000u); xf[14] = __uint_as_float(b3 << 16); xf[15] = __uint_as_float(b3 & 0xffff0000u);
}
__device__ __forceinline__ void unpack_ids(const u32x4 r, int* id) {
    const unsigned a = r.x, b = r.y, c = r.z, d = r.w;
    id[0] = a & 0xffff; id[1] = a >> 16; id[2] = b & 0xffff; id[3] = b >> 16; id[4] = c & 0xffff; id[5] = c >> 16; id[6] = d & 0xffff; id[7] = d >> 16;
}
__device__ __forceinline__ void phase9a(const Params& p, unsigned char* lds) {
    const bf16* HN = (const bf16*)(p.ws + WS_ACT); const unsigned char* UB = p.ws + WS_UB;
    const unsigned short* ids = (const unsigned short*)(p.ws + WS_IDS); float* PD = (float*)(p.ws + WS_PROJ);
    unsigned* ctr = (unsigned*)(p.ws + WS_CTR) + 256;
    const int lane = threadIdx.x & 63, gq = lane >> 3, cl = lane & 7, myx = (int)(xb_xcc_id() & 7u);
    for (;;) {
        int x; const int it = peer_next_item(ctr, myx, x);
        if (it < 0) break;
        const unsigned char* ub = UB + (size_t)x * (16384 * 128);
        const unsigned cofs = (unsigned)cl * 16u;
        const bf16* hn = HN + x * 128 + cl * 16;
        const int tokb = it * 16;
        const unsigned short* ip = ids + (size_t)tokb * 128 + gq * 8;
        int idn[8]; u32x4 bufA[8], bufB[8], xa0, xa1, xb0, xb1, idr;
        idr = *(const u32x4*)ip; unpack_ids(idr, idn);
#pragma unroll
        for (int i = 0; i < 8; ++i) bufA[i] = *(const u32x4*)(ub + (((unsigned)idn[i] << 7) | cofs));
        xa0 = *(const u32x4*)(hn + (size_t)tokb * D); xa1 = *(const u32x4*)(hn + (size_t)tokb * D + 8);
        idr = *(const u32x4*)(ip + 64); unpack_ids(idr, idn);
#pragma unroll
        for (int i = 0; i < 8; ++i) bufB[i] = *(const u32x4*)(ub + (((unsigned)idn[i] << 7) | cofs));
        xb0 = xa0; xb1 = xa1;
        idr = *(const u32x4*)(ip + 128);
#define P9A_STEP(buf, x0, x1, u) { const int u2_ = ((u) + 2 < 32) ? (u) + 2 : (u), u3_ = ((u) + 3 < 32) ? (u) + 3 : (u); \
            unpack_ids(idr, idn); idr = *(const u32x4*)(ip + u3_ * 64); \
            float xf[16]; unpack16(x0, x1, xf); \
            x0 = *(const u32x4*)(hn + (size_t)(tokb + (u2_ >> 1)) * D); x1 = *(const u32x4*)(hn + (size_t)(tokb + (u2_ >> 1)) * D + 8); \
            float keep = 0.f; \
            __builtin_amdgcn_sched_barrier(0); \
            _Pragma("unroll") for (int i = 0; i < 8; ++i) { const float d = grp8_sum(dot16_fp8(buf[i], xf)); if (i == cl) keep = d; buf[i] = *(const u32x4*)(ub + (((unsigned)idn[i] << 7) | cofs)); __builtin_amdgcn_sched_barrier(0); } \
            PD[((size_t)x * NTOK + tokb + ((u) >> 1)) * 128 + (((u) & 1) * 8 + cl) * 8 + gq] = keep; }
#pragma unroll 1
        for (int u = 0; u < 32; u += 2) {
            P9A_STEP(bufA, xa0, xa1, u)
            P9A_STEP(bufB, xb0, xb1, u + 1)
        }
#undef P9A_STEP
    }
}
__device__ __forceinline__ void phase9c(const Params& p, unsigned char* lds) {
    const unsigned short* ids = (const unsigned short*)(p.ws + WS_IDS); const float* wts = (const float*)(p.ws + WS_WTS); const float* PD = (const float*)(p.ws + WS_PROJ);
    const float* US = (const float*)(p.ws + WS_US); const float* VS = (const float*)(p.ws + WS_VS); float* coefT = (float*)(p.ws + WS_COEFT);
    const size_t gtid = (size_t)blockIdx.x * NTHR + threadIdx.x, gth = (size_t)gridDim.x * NTHR;
    for (size_t idx = gtid; idx < (size_t)NTOK * 128; idx += gth) {
        const size_t tok = idx >> 7; const int r = (int)(idx & 127), e = (r & 64) + (r & 7) * 8 + ((r >> 3) & 7);
        float sdot = 0.f;
#pragma unroll
        for (int x = 0; x < 8; ++x) sdot += PD[(size_t)x * NTOK * 128 + tok * 128 + e];
        const int id = ids[idx];
        coefT[idx] = wts[tok * 128 + e] * VS[id] * gelu_tanh(sdot * US[id]);
    }
}
__device__ __forceinline__ void phase9b(const Params& p, unsigned char* lds) {
    const unsigned char* VB = p.ws + WS_VB; const unsigned short* ids = (const unsigned short*)(p.ws + WS_IDS); const float* coef = (const float*)(p.ws + WS_COEFT);
    float* O = p.out; bf16* HG = (bf16*)(p.ws + WS_PROJ + 64 * MiB); const float* gn = p.in[19]; float* SSQ = (float*)(p.ws + WS_SSQ);
    unsigned* ctr = (unsigned*)(p.ws + WS_CTR) + 512;
    const int lane = threadIdx.x & 63, gq = lane >> 3, cl = lane & 7, myx = (int)(xb_xcc_id() & 7u);
    for (;;) {
        int x; const int it = peer_next_item(ctr, myx, x);
        if (it < 0) break;
        const unsigned char* vb = VB + (size_t)x * (16384 * 128);
        const unsigned cofs = (unsigned)cl * 16u;
        const int tokb = it * 16;
        const unsigned short* ip = ids + (size_t)tokb * 128 + gq * 8;
        const float* cp = coef + (size_t)tokb * 128 + gq * 8;
        int idn[8]; u32x4 buf[8], idr; f32x4 cf0, cf1, cn0, cn1; float acc[16];
#pragma unroll
        for (int j = 0; j < 16; ++j) acc[j] = 0.f;
        idr = *(const u32x4*)ip; unpack_ids(idr, idn);
        cf0 = *(const f32x4*)cp; cf1 = *(const f32x4*)(cp + 4);
#pragma unroll
        for (int i = 0; i < 8; ++i) buf[i] = *(const u32x4*)(vb + (((unsigned)idn[i] << 7) | cofs));
        idr = *(const u32x4*)(ip + 64); cn0 = *(const f32x4*)(cp + 64); cn1 = *(const f32x4*)(cp + 68);
#pragma unroll 1
        for (int u = 0; u < 32; ++u) {
            const int u2 = (u + 2 < 32) ? u + 2 : u;
            unpack_ids(idr, idn);
            const f32x4 c0 = cf0, c1 = cf1; cf0 = cn0; cf1 = cn1;
            idr = *(const u32x4*)(ip + u2 * 64); cn0 = *(const f32x4*)(cp + u2 * 64); cn1 = *(const f32x4*)(cp + u2 * 64 + 4);
            const float cfv[8] = {c0.x, c0.y, c0.z, c0.w, c1.x, c1.y, c1.z, c1.w};
            __builtin_amdgcn_sched_barrier(0);
#pragma unroll
            for (int i = 0; i < 8; ++i) { axpy16_fp8(acc, cfv[i], buf[i]); buf[i] = *(const u32x4*)(vb + (((unsigned)idn[i] << 7) | cofs)); __builtin_amdgcn_sched_barrier(0); }
            if (u & 1) {
                const int tok = tokb + (u >> 1);
#pragma unroll
                for (int j = 0; j < 16; ++j) { float v = acc[j]; v += __shfl_xor(v, 8); v += __shfl_xor(v, 16); v += __shfl_xor(v, 32); acc[j] = v; }
                float ss = 0.f;
                if (gq == 0) {
                    float* orow = O + (size_t)tok * D + x * 128 + cl * 16; const float* gr = gn + x * 128 + cl * 16; u32x4 q0, q1; unsigned qq[8];
#pragma unroll
                    for (int q = 0; q < 4; ++q) {
                        f32x4 hv = *(const f32x4*)(orow + 4 * q); const f32x4 gg = *(const f32x4*)(gr + 4 * q);
                        hv.x += acc[4 * q]; hv.y += acc[4 * q + 1]; hv.z += acc[4 * q + 2]; hv.w += acc[4 * q + 3];
                        *(f32x4*)(orow + 4 * q) = hv;
                        ss += hv.x * hv.x + hv.y * hv.y + hv.z * hv.z + hv.w * hv.w;
                        qq[2 * q] = pk2(hv.x * gg.x, hv.y * gg.y); qq[2 * q + 1] = pk2(hv.z * gg.z, hv.w * gg.w);
                    }
                    q0.x = qq[0]; q0.y = qq[1]; q0.z = qq[2]; q0.w = qq[3]; q1.x = qq[4]; q1.y = qq[5]; q1.z = qq[6]; q1.w = qq[7];
                    *(u32x4*)(HG + (size_t)tok * D + x * 128 + cl * 16) = q0; *(u32x4*)(HG + (size_t)tok * D + x * 128 + cl * 16 + 8) = q1;
                }
                ss = grp8_sum(ss);
                if (lane == 0) SSQ[(size_t)x * NTOK + tok] = ss;
#pragma unroll
                for (int j = 0; j < 16; ++j) acc[j] = 0.f;
            }
        }
    }
}

#define XB_TMO      128
#define XB_XCNT(j)  (256  + 64 * (j))
#define XB_XSUB(j)  (1280 + 64 * (j))
#define XB_XGEN(j)  (2304 + 64 * (j))
#define XB_TOP      3328
#define XB_TOPGEN   3392
#define XCD_BAR_WORDS 3456
#define XB_SPIN_CAP (1u << 18)
#define LAS __attribute__((address_space(3)))
__device__ __forceinline__ unsigned xb_ld(unsigned* p)              { return __hip_atomic_load(p, __ATOMIC_RELAXED, __HIP_MEMORY_SCOPE_AGENT); }
__device__ __forceinline__ unsigned xb_add(unsigned* p, unsigned v) { return __hip_atomic_fetch_add(p, v, __ATOMIC_RELAXED, __HIP_MEMORY_SCOPE_AGENT); }
__device__ __forceinline__ unsigned xb_xcc_id() { return (unsigned)__builtin_amdgcn_s_getreg((3 << 11) | 20) & 0xFu; }
#define XB_SPIN(cond, bar) do { unsigned _sp = 0; while (cond) { __builtin_amdgcn_s_sleep(1); \
    if ((++_sp & 255u) == 0u) { if (xb_ld(&(bar)[XB_TMO])) break; if (_sp > XB_SPIN_CAP) { atomicAdd(&(bar)[XB_TMO], 1u); break; } } } } while (0)
struct XcdBarrier { unsigned* bar; unsigned x; volatile LAS unsigned* st; };
__device__ __forceinline__ XcdBarrier xcd_barrier_post(unsigned* bar, volatile LAS unsigned* st) {
    XcdBarrier b; b.bar = bar; b.x = xb_xcc_id(); b.st = st;
    if (threadIdx.x == 0) (void)xb_add(&bar[XB_XCNT(b.x)], 1u);
    return b;
}
__device__ __forceinline__ void xcd_barrier_complete(unsigned* bar, unsigned x, unsigned& nloc, unsigned& nx) {
    const unsigned G = gridDim.x * gridDim.y * gridDim.z;
    unsigned sum, cnt, mine, sp = 0u;
    for (;;) {
        sum = 0u; cnt = 0u; mine = 0u;
#pragma unroll
        for (unsigned j = 0; j < 16; ++j) { const unsigned c = xb_ld(&bar[XB_XCNT(j)]); sum += c; cnt += (c > 0u) ? 1u : 0u; mine = (j == x) ? c : mine; }
        if (sum == G) break;
        __builtin_amdgcn_s_sleep(1);
        if ((++sp & 255u) == 0u) { if (xb_ld(&bar[XB_TMO])) break; if (sp > XB_SPIN_CAP) { atomicAdd(&bar[XB_TMO], 1u); break; } }
    }
    nloc = mine > 0u ? mine : 1u; nx = cnt > 0u ? cnt : 1u;
}
__device__ __forceinline__ void xcd_barrier(const XcdBarrier& b) {
    asm volatile("s_waitcnt vmcnt(0)" ::: "memory");
    __syncthreads();
    if (threadIdx.x == 0) {
        unsigned* bar = b.bar;
        __builtin_amdgcn_s_waitcnt(0);
        unsigned nloc = b.st[0], nx = b.st[1];
        if (nloc == 0u) { xcd_barrier_complete(bar, b.x, nloc, nx); b.st[0] = nloc; b.st[1] = nx; }
        const unsigned old = xb_add(&bar[XB_XSUB(b.x)], 1u);
        const unsigned gen = old / nloc;
        if (old + 1u == (gen + 1u) * nloc) {
            __builtin_amdgcn_fence(__ATOMIC_RELEASE, "agent");
            asm volatile("s_waitcnt vmcnt(0)" ::: "memory");
            const unsigned og = xb_add(&bar[XB_TOP], 1u);
            const unsigned tg = og / nx;
            if (og + 1u == (tg + 1u) * nx) xb_add(&bar[XB_TOPGEN], 1u);
            else XB_SPIN(xb_ld(&bar[XB_TOPGEN]) == tg, bar);
            __builtin_amdgcn_fence(__ATOMIC_ACQUIRE, "agent");
            xb_add(&bar[XB_XGEN(b.x)], 1u);
            asm volatile("s_waitcnt vmcnt(0)" ::: "memory");
        } else {
            XB_SPIN(xb_ld(&bar[XB_XGEN(b.x)]) == gen, bar);
            __builtin_amdgcn_fence(__ATOMIC_ACQUIRE, "agent");
            asm volatile("s_waitcnt vmcnt(0)" ::: "memory");
        }
    }
    __syncthreads();
}

constexpr int REPK = -1;
__global__ void __launch_bounds__(NTHR, 2) mega(Params p, int ph_lo, int ph_hi) {
    extern __shared__ __attribute__((aligned(16))) unsigned char lds[];
    volatile LAS unsigned* st = (volatile LAS unsigned*)(LAS unsigned char*)(lds + LDS_BYTES - 16);
    if (threadIdx.x < 4) st[threadIdx.x] = 0u;
    __syncthreads();
    const XcdBarrier bar = xcd_barrier_post((unsigned*)p.ws, st);
#define RUN_PHASE(k, call) if (ph_lo <= (k) && (k) < ph_hi) { if ((k) > ph_lo) xcd_barrier(bar); call; if (REPK == (k)) { xcd_barrier(bar); call; } }
    RUN_PHASE(0, phase0(p, lds))
    RUN_PHASE(1, phase1(p, lds))
    RUN_PHASE(2, phase2(p, lds))
    if (REPK == 30) { xcd_barrier(bar); if ((threadIdx.x >> 6) == 0 && blockIdx.x < 64) hgrn_scan_item<true>(p, blockIdx.x); }
    if (ph_lo <= 3 && 3 < ph_hi) { if (3 > ph_lo) xcd_barrier(bar); phase3<true>(p, lds); if (REPK == 3) { xcd_barrier(bar); phase3<false>(p, lds); } }
    RUN_PHASE(4, phase4(p, lds))
    RUN_PHASE(5, phase5(p, lds))
    RUN_PHASE(6, phase6(p, lds))
    RUN_PHASE(7, phase7(p, lds))
    RUN_PHASE(8, phase8(p, lds))
    if (ph_lo <= 9 && 9 < ph_hi) { if (9 > ph_lo) xcd_barrier(bar); phase9a(p, lds); }
    if (ph_lo <= 9 && 9 < ph_hi) { xcd_barrier(bar); phase9c(p, lds); }
    if (ph_lo <= 9 && 9 < ph_hi) { xcd_barrier(bar); phase9b(p, lds); }
    RUN_PHASE(10, phase10(p, lds))
}

static void launch_mega(const Params& p, int lo, int hi, hipStream_t stream) {
    static int grid = 0;
    if (grid == 0) {
        int dev = 0, cus = 0, per_cu = 0;
        hipGetDevice(&dev); hipDeviceGetAttribute(&cus, hipDeviceAttributeMultiprocessorCount, dev);
        hipFuncSetAttribute((const void*)mega, hipFuncAttributeMaxDynamicSharedMemorySize, LDS_BYTES);
        hipOccupancyMaxActiveBlocksPerMultiprocessor(&per_cu, (const void*)mega, NTHR, LDS_BYTES);
        if (per_cu < 1) { fprintf(stderr, "mega: occupancy query says %d blocks/CU\n", per_cu); per_cu = 1; }
        grid = cus;
    }
    hipMemsetAsync(p.ws, 0, 65536, stream);
    Params pp = p; int l = lo, h = hi;
    void* args[] = {&pp, &l, &h};
    hipError_t e = hipLaunchCooperativeKernel((const void*)mega, dim3(grid), dim3(NTHR), args, LDS_BYTES, stream);
    if (e != hipSuccess) fprintf(stderr, "cooperative launch failed: %s (grid %d)\n", hipGetErrorString(e), grid);
}

extern "C" void kernel_launch(void* const* d_in, const int* in_sizes, int n_in, void* d_out, int out_size, void* d_ws, size_t ws_size, hipStream_t stream) {
    float* out = (float*)d_out; unsigned char* ws = (unsigned char*)d_ws;
    Params prm{}; for (int i = 0; i < 21; ++i) prm.in[i] = (const float*)d_in[i]; prm.out = out; prm.ws = ws;
    launch_mega(prm, 0, 11, stream);
}
```

```cpp
#include <hip/hip_runtime.h>
#include <hip/hip_cooperative_groups.h>
#include <cstdint>
#include <cstdio>
namespace cg = cooperative_groups;

constexpr int D = 1024, NB = 2, T = 8192, NTOK = NB * T;
constexpr int DIN = 3352, PS = 3392;
constexpr int C_HQ = 0, C_HF = 512, C_HI = 1024, C_HG = 1536, C_NQ = 2048, C_KC = 2560, C_VC = 2688,
              C_KS = 2816, C_VS = 2944, C_KW = 3072, C_VW = 3200, C_GT = 3328;
constexpr int NCMP = 511;
constexpr float EPS = 1e-6f;
typedef unsigned short bf16;

constexpr size_t MiB = 1u << 20;
constexpr size_t WS_WINT = 1 * MiB;
constexpr size_t WS_WOUTT = 8 * MiB;
constexpr size_t WS_WQT = 10 * MiB;
constexpr size_t WS_WGT = 14 * MiB;
constexpr size_t WS_WPT = 16 * MiB;
constexpr size_t WS_KEYB = 16 * MiB + 512 * 1024;
constexpr size_t WS_W1T = 17 * MiB;
constexpr size_t WS_CTR = 16384;
constexpr size_t WS_SSQ = 512 * 1024;
constexpr size_t WS_US = 256 * 1024;
constexpr size_t WS_VS = 320 * 1024;
constexpr size_t WS_UB = 18 * MiB;
constexpr size_t WS_VB = 50 * MiB;
constexpr size_t WS_ACT = 82 * MiB;
constexpr size_t WS_PROJ = 114 * MiB;
constexpr size_t WS_SPARE = 220 * MiB;
constexpr size_t WS_IDS = WS_SPARE;
constexpr size_t WS_WTS = WS_SPARE + 8 * MiB;
constexpr size_t WS_KCF = WS_SPARE + 16 * MiB;
constexpr size_t WS_VCF = WS_SPARE + 17 * MiB;
constexpr size_t WS_PB = WS_SPARE + 18 * MiB;
constexpr size_t WS_VTS = WS_SPARE + 26 * MiB;
constexpr size_t WS_VTW = WS_SPARE + 30 * MiB;
constexpr size_t WS_COEFT = WS_SPARE + 26 * MiB;
constexpr size_t WS_KFS = WS_SPARE;
constexpr size_t WS_KFW = WS_SPARE + 4 * MiB;
constexpr size_t WS_KC = WS_SPARE + 34 * MiB;
constexpr size_t WS_VCT = WS_SPARE + 34 * MiB + 256 * 1024;
constexpr size_t WS_DEC = WS_SPARE + 34 * MiB + 512 * 1024;
constexpr size_t OUT_KIT = 32 * MiB;
constexpr size_t OUT_VT = 48 * MiB;
constexpr size_t WS_GL = 18 * MiB;

__device__ __forceinline__ float bf2f(bf16 v) { return __uint_as_float(((unsigned)v) << 16); }
__device__ __forceinline__ bf16 f2bf(float f) { return __builtin_bit_cast(bf16, (__bf16)f); }
__device__ __forceinline__ float wave_sum(float v) {
#pragma unroll
    for (int o = 1; o < 64; o <<= 1) v += __shfl_xor(v, o);
    return v;
}
__device__ __forceinline__ float wave_max(float v) {
#pragma unroll
    for (int o = 1; o < 64; o <<= 1) v = fmaxf(v, __shfl_xor(v, o));
    return v;
}
__device__ __forceinline__ float sigmoidf_(float x) { return 1.0f / (1.0f + __expf(-x)); }
__device__ __forceinline__ float siluf_(float x) { return x * sigmoidf_(x); }
__device__ __forceinline__ float gelu_tanh(float x) { return 0.5f * x * (1.0f + tanhf(0.7978845608028654f * (x + 0.044715f * x * x * x))); }
__device__ __forceinline__ float toF(float v) { return v; }
__device__ __forceinline__ float toF(bf16 v) { return bf2f(v); }

typedef short bf16x8 __attribute__((ext_vector_type(8)));
typedef float f32x4 __attribute__((ext_vector_type(4)));
typedef float f32x16 __attribute__((ext_vector_type(16)));
typedef unsigned u32x4 __attribute__((ext_vector_type(4)));
typedef unsigned u32x2 __attribute__((ext_vector_type(2)));
constexpr int NTHR = 512;
constexpr int LDS_BYTES = 143360 + 16;
struct Params { const float* in[21]; float* out; unsigned char* ws; };
__device__ __forceinline__ unsigned xb_xcc_id();

typedef __bf16 bf16x2c __attribute__((ext_vector_type(2)));
__device__ __forceinline__ unsigned pk2(float lo, float hi) { bf16x2c v = { (__bf16)lo, (__bf16)hi }; return __builtin_bit_cast(unsigned, v); }

__device__ __forceinline__ void transpose_tile(const float* __restrict__ W, int K, int N, bf16* __restrict__ Wt, int kt, int nt, float* tile) {
    const int tid = threadIdx.x, k0 = kt * 64, n0 = nt * 64;
#pragma unroll
    for (int i = 0; i < 8; ++i) { const int idx = tid + i * NTHR, kk = idx >> 6, nn = idx & 63; tile[kk * 65 + nn] = (n0 + nn < N) ? W[(size_t)(k0 + kk) * N + n0 + nn] : 0.f; }
    __syncthreads();
    { const int nn = tid >> 3, ch = tid & 7; const float* s = tile + (ch * 8) * 65 + nn;
      u32x4 o; o.x = pk2(s[0], s[65]); o.y = pk2(s[130], s[195]); o.z = pk2(s[260], s[325]); o.w = pk2(s[390], s[455]);
      *(u32x4*)(Wt + (size_t)(n0 + nn) * K + k0 + ch * 8) = o; }
    __syncthreads();
}
__device__ __forceinline__ void cvt_range(const float* __restrict__ src, bf16* __restrict__ dst, size_t n8, size_t gtid, size_t gthreads) {
    for (size_t i = gtid; i < n8; i += gthreads) {
        const f32x4 a = ((const f32x4*)src)[2 * i], b = ((const f32x4*)src)[2 * i + 1];
        u32x4 o; o.x = pk2(a.x, a.y); o.y = pk2(a.z, a.w); o.z = pk2(b.x, b.y); o.w = pk2(b.z, b.w);
        ((u32x4*)dst)[i] = o;
    }
}
__device__ __forceinline__ void rms_row_bf16(const float* __restrict__ xr, const float* __restrict__ g, bf16* __restrict__ orow, int lane) {
    f32x4 v[4]; float s = 0.f;
#pragma unroll
    for (int j = 0; j < 4; ++j) { v[j] = ((const f32x4*)xr)[lane + 64 * j]; s += v[j].x * v[j].x + v[j].y * v[j].y + v[j].z * v[j].z + v[j].w * v[j].w; }
    s = wave_sum(s);
    const float r = rsqrtf(s * (1.0f / D) + EPS);
#pragma unroll
    for (int j = 0; j < 4; ++j) { const f32x4 gg = ((const f32x4*)g)[lane + 64 * j]; u32x2 o; o.x = pk2(v[j].x * r * gg.x, v[j].y * r * gg.y); o.y = pk2(v[j].z * r * gg.z, v[j].w * r * gg.w); ((u32x2*)orow)[lane + 64 * j] = o; }
}

__device__ __forceinline__ void phase0(const Params& p, unsigned char* lds) {
    float* tile = (float*)lds;
    const int nblk = gridDim.x, blk = blockIdx.x;
    unsigned char* ws = p.ws;
    constexpr int I_WIN = 16 * 56, I_WOUT = 16 * 16, I_WQ = 16 * 32, I_WG = 16 * 16, I_WP = 4 * 16, I_W1 = 2 * 32;
    constexpr int NIT = I_WIN + I_WOUT + I_WQ + I_WG + I_WP + I_W1;
    for (int it = blk; it < NIT; it += nblk) {
        int r = it;
        if (r < I_WIN) { transpose_tile(p.in[3], 1024, DIN, (bf16*)(ws + WS_WINT), r / 56, r % 56, tile); continue; } r -= I_WIN;
        if (r < I_WOUT) { transpose_tile(p.in[12], 1024, 1024, (bf16*)(ws + WS_WOUTT), r / 16, r % 16, tile); continue; } r -= I_WOUT;
        if (r < I_WQ) { transpose_tile(p.in[14], 1024, 2048, (bf16*)(ws + WS_WQT), r / 32, r % 32, tile); continue; } r -= I_WQ;
        if (r < I_WG) { transpose_tile(p.in[20], 1024, 1024, (bf16*)(ws + WS_WGT), r / 16, r % 16, tile); continue; } r -= I_WG;
        if (r < I_WP) { transpose_tile(p.in[18], 256, 1024, (bf16*)(ws + WS_WPT), r / 16, r % 16, tile); continue; } r -= I_WP;
        { const int which = r / 32, kt = r % 32; transpose_tile(p.in[9] + (size_t)which * 2048 * 64, 2048, 64, (bf16*)(ws + WS_W1T) + (size_t)which * 64 * 2048, kt, 0, tile); }
    }
    const size_t gtid = (size_t)blk * NTHR + threadIdx.x, gthreads = (size_t)nblk * NTHR;
    for (size_t i = gtid; i < (size_t)8 * 2 * 128 * 16; i += gthreads) {
        const int dch = (int)(i & 15), key = (int)((i >> 4) & 127), hc = (int)(i >> 11);
        const float* src = p.in[15] + ((size_t)hc * 128 + key) * 128 + dch * 8;
        const f32x4 a = *(const f32x4*)src, b = *(const f32x4*)(src + 4);
        u32x4 o; o.x = pk2(a.x, a.y); o.y = pk2(a.z, a.w); o.z = pk2(b.x, b.y); o.w = pk2(b.z, b.w);
        *(u32x4*)((bf16*)(ws + WS_KEYB) + ((((size_t)hc * 4 + (key >> 5)) * 8 + (dch >> 1)) * 64 + (key & 31) + 32 * (dch & 1)) * 8) = o;
    }
    cvt_range(p.in[1], (bf16*)(ws + WS_PB), (size_t)NTOK * 256 / 8, gtid, gthreads);
    const int gw = (int)(gtid >> 6), ngw = (int)(gthreads >> 6), lane = threadIdx.x & 63;
    for (int m = gw; m < NTOK; m += ngw) rms_row_bf16(p.in[0] + (size_t)m * D, p.in[2], (bf16*)(ws + WS_ACT) + (size_t)m * D, lane);
    for (int m = gw; m < 2 * 16384; m += ngw) {
        const int which = m >> 14, row = m & 16383;
        const float* src = p.in[16 + which] + (size_t)row * D + lane * 16;
        const f32x4 a = *(const f32x4*)src, b = *(const f32x4*)(src + 4), c = *(const f32x4*)(src + 8), d = *(const f32x4*)(src + 12);
        float mx = fmaxf(fmaxf(fmaxf(fabsf(a.x), fabsf(a.y)), fmaxf(fabsf(a.z), fabsf(a.w))), fmaxf(fmaxf(fabsf(b.x), fabsf(b.y)), fmaxf(fabsf(b.z), fabsf(b.w))));
        mx = fmaxf(mx, fmaxf(fmaxf(fmaxf(fabsf(c.x), fabsf(c.y)), fmaxf(fabsf(c.z), fabsf(c.w))), fmaxf(fmaxf(fabsf(d.x), fabsf(d.y)), fmaxf(fabsf(d.z), fabsf(d.w)))));
        mx = fmaxf(wave_max(mx), 1e-30f);
        const float sc = 224.0f / mx;
        u32x4 o; int w;
        w = __builtin_amdgcn_cvt_pk_fp8_f32(a.x * sc, a.y * sc, 0, false); w = __builtin_amdgcn_cvt_pk_fp8_f32(a.z * sc, a.w * sc, w, true); o.x = (unsigned)w;
        w = __builtin_amdgcn_cvt_pk_fp8_f32(b.x * sc, b.y * sc, 0, false); w = __builtin_amdgcn_cvt_pk_fp8_f32(b.z * sc, b.w * sc, w, true); o.y = (unsigned)w;
        w = __builtin_amdgcn_cvt_pk_fp8_f32(c.x * sc, c.y * sc, 0, false); w = __builtin_amdgcn_cvt_pk_fp8_f32(c.z * sc, c.w * sc, w, true); o.z = (unsigned)w;
        w = __builtin_amdgcn_cvt_pk_fp8_f32(d.x * sc, d.y * sc, 0, false); w = __builtin_amdgcn_cvt_pk_fp8_f32(d.z * sc, d.w * sc, w, true); o.w = (unsigned)w;
        *(u32x4*)(ws + (which ? WS_VB : WS_UB) + (size_t)(lane >> 3) * (16384 * 128) + (size_t)row * 128 + (lane & 7) * 16) = o;
        if (lane == 0) ((float*)(ws + (which ? WS_VS : WS_US)))[row] = mx * (1.0f / 224.0f);
    }
}

__device__ __forceinline__ int swz(int ob) { return ob ^ (((ob >> 9) & 1) << 5); }
constexpr int G_STAGE = 49152;
__device__ __forceinline__ void gemm_mainloop(f32x4 (&acc)[4][4], const bf16* __restrict__ A, int lda, const bf16* __restrict__ Bt, int ldb, int K, int m0, int n0, unsigned char* lds) {
    const int tid = threadIdx.x, lane = tid & 63, wid = tid >> 6, wm = wid >> 1, wn = wid & 1, fr = lane & 15, fq = lane >> 4;
    const int lrow = tid >> 3, lc = tid & 7;
    const bf16* ag = A + (size_t)(m0 + lrow) * lda + lc * 8;
    const bf16* bg = Bt + (size_t)(n0 + lrow) * ldb + lc * 8;
    const int woff = ((lrow >> 4) * 2 + (lc >> 2)) * 1024 + swz((lrow & 15) * 64 + (lc & 3) * 16);
    const int roff = swz(fr * 64 + fq * 16);
    const int nk = K >> 6;
    u32x4 ra0[4], rb0[2], ra1[4], rb1[2];
#define GM_LOAD(ra, rb, kt) { _Pragma("unroll") for (int i = 0; i < 4; ++i) ra[i] = *(const u32x4*)(ag + (size_t)i * 64 * lda + (kt) * 64); \
                              _Pragma("unroll") for (int i = 0; i < 2; ++i) rb[i] = *(const u32x4*)(bg + (size_t)i * 64 * ldb + (kt) * 64); }
#define GM_STORE(ra, rb, buf) { _Pragma("unroll") for (int i = 0; i < 4; ++i) *(u32x4*)((buf) + woff + i * 8192) = ra[i]; \
                                _Pragma("unroll") for (int i = 0; i < 2; ++i) *(u32x4*)((buf) + 32768 + woff + i * 8192) = rb[i]; }
#define GM_COMPUTE(cur) { _Pragma("unroll") for (int s = 0; s < 2; ++s) { bf16x8 af[4], bfr[4]; \
        _Pragma("unroll") for (int i = 0; i < 4; ++i) af[i] = *(const bf16x8*)((cur) + ((wm * 4 + i) * 2 + s) * 1024 + roff); \
        _Pragma("unroll") for (int i = 0; i < 4; ++i) bfr[i] = *(const bf16x8*)((cur) + 32768 + ((wn * 4 + i) * 2 + s) * 1024 + roff); \
        _Pragma("unroll") for (int mi = 0; mi < 4; ++mi) _Pragma("unroll") for (int ni = 0; ni < 4; ++ni) acc[mi][ni] = __builtin_amdgcn_mfma_f32_16x16x32_bf16(bfr[ni], af[mi], acc[mi][ni], 0, 0, 0); } }
    unsigned char* buf0 = lds; unsigned char* buf1 = lds + G_STAGE;
    GM_LOAD(ra0, rb0, 0)
    GM_LOAD(ra1, rb1, 1)
    GM_STORE(ra0, rb0, buf0)
    __syncthreads();
    for (int kt = 0; kt < nk; kt += 2) {
        { const int kp = (kt + 2 < nk) ? kt + 2 : kt; GM_LOAD(ra0, rb0, kp) }
        GM_COMPUTE(buf0)
        GM_STORE(ra1, rb1, buf1)
        __syncthreads();
        { const int kp = (kt + 3 < nk) ? kt + 3 : kt + 1; GM_LOAD(ra1, rb1, kp) }
        GM_COMPUTE(buf1)
        if (kt + 2 < nk) GM_STORE(ra0, rb0, buf0)
        __syncthreads();
    }
}
__device__ __forceinline__ void acc_zero(f32x4 (&acc)[4][4]) {
#pragma unroll
    for (int i = 0; i < 4; ++i)
#pragma unroll
        for (int j = 0; j < 4; ++j) acc[i][j] = (f32x4){0.f, 0.f, 0.f, 0.f};
}
namespace pg8 {
#define PG8_LAS __attribute__((address_space(3)))
typedef unsigned short bf16_t;
typedef short bf16x8 __attribute__((ext_vector_type(8)));
typedef float f32x4 __attribute__((ext_vector_type(4)));
typedef unsigned u32x4 __attribute__((ext_vector_type(4)));
constexpr int BM = 256, BK = 64, HALF = 128, HTB = HALF * BK * 2  , STAGE_BYTES = 8 * HTB, NXCD = 8, WGM = 8;

__host__ __device__ __forceinline__ int lds_byte(int r, int c) { const int st = (r >> 4) * 2 + (c >> 5), rr = r & 15, cc = c & 31, ob = rr * 64 + cc * 2; return st * 1024 + (ob ^ (((ob >> 9) & 1) << 5)); }
__host__ __device__ __forceinline__ void stage_rc(int b, int& R, int& C) { const int st = b / 1024, sb = b % 1024, swz = sb ^ (((sb >> 9) & 1) << 5); R = (st >> 1) * 16 + swz / 64; C = (st & 1) * 32 + (swz % 64) / 2; }
__host__ __device__ __forceinline__ int perm32(int rho) { const int n = rho >> 4, i = rho & 15; return 8 * (i >> 2) + 4 * n + (i & 3); }

struct Unit { int pm, pn; };
struct Gemm { const bf16_t* A; const bf16_t* Bt; int M, N, K; };

struct StaticOrder {
    int nM, nN, nwg, G, c;
    __host__ __device__ void init(int M, int N, int G_, int c_) { nM = M / BM; nN = N / BM; nwg = nM * nN; G = G_; c = c_; }
    __host__ __device__ bool next(int i, Unit& u) const {
        const long L = (long)i * G + c; if (L >= nwg) return false;
        int wgid = (int)L; { const int q = nwg / NXCD, r = nwg % NXCD, xcd = wgid % NXCD, off = wgid / NXCD; wgid = (xcd < r ? xcd * (q + 1) : r * (q + 1) + (xcd - r) * q) + off; }
        const int nig = WGM * nN, gid = wgid / nig, fm = gid * WGM, gsz = (nM - fm) < WGM ? (nM - fm) : WGM;
        u.pm = fm + ((wgid % nig) % gsz); u.pn = (wgid % nig) / gsz; return true;
    }
    __device__ __forceinline__ void a_ready(const Unit&) const {}
    __device__ __forceinline__ void done(const Unit&) const {}
};

__device__ __forceinline__ unsigned pk2b(float lo, float hi) { typedef __bf16 b2 __attribute__((ext_vector_type(2))); b2 v = { (__bf16)lo, (__bf16)hi }; return __builtin_bit_cast(unsigned, v); }
typedef unsigned u32x2 __attribute__((ext_vector_type(2)));
struct EpiStoreBf16 {
    static constexpr bool PERM = false, AFTER_DRAIN = false;
    bf16_t* C; int ldc; int ncols;
    __device__ __forceinline__ void operator()(const f32x4 (&acc)[2][2][4][2], const Unit& u, int wr, int wc, int fr, int fq) const {
#pragma unroll
        for (int ai = 0; ai < 2; ++ai)
#pragma unroll
            for (int m = 0; m < 4; ++m) { bf16_t* rowp = C + (size_t)(u.pm * BM + ai * HALF + wr * 64 + m * 16 + fr) * ldc;
#pragma unroll
                for (int bj = 0; bj < 2; ++bj)
#pragma unroll
                    for (int n = 0; n < 2; ++n) { const int col = u.pn * BM + bj * HALF + wc * 32 + n * 16 + fq * 4;
                        if (col < ncols) { u32x2 w; w.x = pk2b(acc[ai][bj][m][n][0], acc[ai][bj][m][n][1]); w.y = pk2b(acc[ai][bj][m][n][2], acc[ai][bj][m][n][3]); *(u32x2*)(rowp + col) = w; } } }
    }
};
struct EpiStorePQF {
    static constexpr bool PERM = false, AFTER_DRAIN = false;
    bf16_t* C; int pad0, pad1;
    __device__ __forceinline__ void operator()(const f32x4 (&acc)[2][2][4][2], const Unit& u, int wr, int wc, int fr, int fq) const {
#pragma unroll
        for (int ai = 0; ai < 2; ++ai)
#pragma unroll
            for (int m = 0; m < 4; ++m) { const int row = u.pm * BM + ai * HALF + wr * 64 + m * 16 + fr;
#pragma unroll
                for (int bj = 0; bj < 2; ++bj)
#pragma unroll
                    for (int n = 0; n < 2; ++n) { const int col = u.pn * BM + bj * HALF + wc * 32 + n * 16 + fq * 4, d = col & 127;
                        const size_t off = ((((size_t)(row >> 5) * 16 + (col >> 7)) * 8 + (d >> 4)) * 64 + (row & 31) + 32 * ((d >> 3) & 1)) * 8 + (d & 7);
                        u32x2 w; w.x = pk2b(acc[ai][bj][m][n][0], acc[ai][bj][m][n][1]); w.y = pk2b(acc[ai][bj][m][n][2], acc[ai][bj][m][n][3]); *(u32x2*)(C + off) = w; } }
    }
};
struct EpiResidF32 {
    static constexpr bool PERM = false, AFTER_DRAIN = false;
    const float* X; float* O; int ld; int pad;
    __device__ __forceinline__ void operator()(const f32x4 (&acc)[2][2][4][2], const Unit& u, int wr, int wc, int fr, int fq) const {
#pragma unroll
        for (int ai = 0; ai < 2; ++ai)
#pragma unroll
            for (int m = 0; m < 4; ++m) { const size_t ro = (size_t)(u.pm * BM + ai * HALF + wr * 64 + m * 16 + fr) * ld;
#pragma unroll
                for (int bj = 0; bj < 2; ++bj)
#pragma unroll
                    for (int n = 0; n < 2; ++n) { const size_t idx = ro + u.pn * BM + bj * HALF + wc * 32 + n * 16 + fq * 4; *(f32x4*)(O + idx) = *(const f32x4*)(X + idx) + acc[ai][bj][m][n]; } }
    }
};
struct EpiFinalGate {
    static constexpr bool PERM = false, AFTER_DRAIN = false;
    const bf16_t* PL; const float* SSQ; float* O; int ld; int ntok; float eps; int pad;
    __device__ __forceinline__ void operator()(const f32x4 (&acc)[2][2][4][2], const Unit& u, int wr, int wc, int fr, int fq) const {
#pragma unroll
        for (int ai = 0; ai < 2; ++ai)
#pragma unroll
            for (int m = 0; m < 4; ++m) { const int row = u.pm * BM + ai * HALF + wr * 64 + m * 16 + fr; const size_t ro = (size_t)row * ld;
                float tot = 0.f;
#pragma unroll
                for (int x = 0; x < 8; ++x) tot += SSQ[(size_t)x * ntok + row];
                const float rs = 1.0f / sqrtf(tot * (1.0f / 1024.0f) + eps);
#pragma unroll
                for (int bj = 0; bj < 2; ++bj)
#pragma unroll
                    for (int n = 0; n < 2; ++n) { const size_t idx = ro + u.pn * BM + bj * HALF + wc * 32 + n * 16 + fq * 4;
                        const u32x2 pw = *(const u32x2*)(PL + idx); const unsigned px = pw.x, py = pw.y;
                        f32x4 pv; pv.x = __uint_as_float(px << 16); pv.y = __uint_as_float(px & 0xffff0000u); pv.z = __uint_as_float(py << 16); pv.w = __uint_as_float(py & 0xffff0000u);
                        f32x4 g;
#pragma unroll
                        for (int e = 0; e < 4; ++e) g[e] = 1.0f / (1.0f + __expf(-rs * acc[ai][bj][m][n][e]));
                        *(f32x4*)(O + idx) = *(const f32x4*)(O + idx) + pv * g; } }
    }
};

template <class Epi, class Sched, bool ALIGN_EPI = false, bool SP2 = false>
__device__ __forceinline__ void gemm_phase(PG8_LAS unsigned char* lds, const Gemm g, const Sched& S, const Epi& E) {
    const int tid = threadIdx.x, wid = __builtin_amdgcn_readfirstlane(tid >> 6), lane = tid & 63, wr = wid >> 2, wc = wid & 3, fr = lane & 15, fq = lane >> 4;
    const int K = g.K, nt = K / BK;
    unsigned voffA[2], voffB[2];
#pragma unroll
    for (int i = 0; i < 2; ++i) { int R, C; stage_rc(tid * 16 + i * 8192, R, C); const int Rb = Epi::PERM ? ((R & ~31) + perm32(R & 31)) : R;
        voffA[i] = (unsigned)(R * K + C) * 2u; voffB[i] = (unsigned)(Rb * K + C) * 2u; }
    const size_t kstep = (size_t)(BK * 2);
    const size_t hstep = (size_t)HALF * K * 2;
    const size_t tstep = 2 * hstep;
    const unsigned ldsw = (unsigned)wid * 1024u;
    const int aoff = lds_byte(wr * 64 + fr, fq * 8), boff = lds_byte(wc * 32 + fr, fq * 8);
#define PG8_SA(b, h) (((b) * 2 + (h)) * HTB)
#define PG8_SB(b, h) ((4 + (b) * 2 + (h)) * HTB)
#define PG8_STAGE(bufoff, gbase, voff) do { _Pragma("unroll") for (int _i = 0; _i < 2; ++_i) \
        __builtin_amdgcn_global_load_lds((const unsigned*)((const char*)(gbase) + (voff)[_i]), (PG8_LAS unsigned*)(lds + (bufoff) + ldsw + _i * 8192), 16, 0, 0); } while (0)
#define PG8_LDA(dst, b, h) do { _Pragma("unroll") for (int m = 0; m < 4; ++m) _Pragma("unroll") for (int k = 0; k < 2; ++k) dst[m][k] = *(const PG8_LAS bf16x8*)(lds + PG8_SA(b, h) + aoff + m * 2048 + k * 1024); } while (0)
#define PG8_LDB(dst, b, h) do { _Pragma("unroll") for (int n = 0; n < 2; ++n) _Pragma("unroll") for (int k = 0; k < 2; ++k) dst[n][k] = *(const PG8_LAS bf16x8*)(lds + PG8_SB(b, h) + boff + n * 2048 + k * 1024); } while (0)
#define PG8_MMA(ai, bj, At, Bt) do { __builtin_amdgcn_s_setprio(1); _Pragma("unroll") for (int m = 0; m < 4; ++m) _Pragma("unroll") for (int n = 0; n < 2; ++n) _Pragma("unroll") for (int k = 0; k < 2; ++k) \
        acc[ai][bj][m][n] = __builtin_amdgcn_mfma_f32_16x16x32_bf16(Bt[n][k], At[m][k], acc[ai][bj][m][n], 0, 0, 0); __builtin_amdgcn_s_setprio(0); } while (0)
#define PG8_WAIT_V(n) asm volatile("s_waitcnt vmcnt(" #n ")" ::: "memory")
#define PG8_WAIT_L(n) asm volatile("s_waitcnt lgkmcnt(" #n ")" ::: "memory")
#define PG8_BAR __builtin_amdgcn_s_barrier()
#define PG8_SCHED __builtin_amdgcn_sched_barrier(0)
    Unit cur, nxt; int ui = 0;
    if (!S.next(0, cur)) return;
    f32x4 acc[2][2][4][2];
#pragma unroll
    for (int a = 0; a < 2; ++a)
#pragma unroll
        for (int b = 0; b < 2; ++b)
#pragma unroll
            for (int m = 0; m < 4; ++m)
#pragma unroll
                for (int n = 0; n < 2; ++n) acc[a][b][m][n] = (f32x4){0.f, 0.f, 0.f, 0.f};
    bf16x8 At[4][2], B0[2][2], B1[2][2];
    const char* cA = (const char*)g.A + (size_t)cur.pm * tstep; const char* cB = (const char*)g.Bt + (size_t)cur.pn * tstep;
    S.a_ready(cur);
    if constexpr (SP2) {
        PG8_STAGE(PG8_SB(0, 0), cB, voffB); PG8_STAGE(PG8_SB(0, 1), cB + hstep, voffB); PG8_STAGE(PG8_SA(0, 0), cA, voffA); PG8_STAGE(PG8_SA(0, 1), cA + hstep, voffA);
        if (wr == 1) PG8_BAR;
        PG8_WAIT_V(2); PG8_BAR;
        PG8_STAGE(PG8_SB(1, 0), cB + kstep, voffB); PG8_STAGE(PG8_SA(1, 0), cA + kstep, voffA); PG8_STAGE(PG8_SB(1, 1), cB + hstep + kstep, voffB);
        PG8_WAIT_V(6); PG8_BAR;
    } else {
        PG8_STAGE(PG8_SB(0, 0), cB, voffB); PG8_STAGE(PG8_SA(0, 0), cA, voffA); PG8_STAGE(PG8_SB(0, 1), cB + hstep, voffB); PG8_STAGE(PG8_SA(0, 1), cA + hstep, voffA);
        if (wr == 1) PG8_BAR;
        PG8_WAIT_V(4); PG8_BAR;
        PG8_STAGE(PG8_SB(1, 0), cB + kstep, voffB); PG8_STAGE(PG8_SA(1, 0), cA + kstep, voffA); PG8_STAGE(PG8_SB(1, 1), cB + hstep + kstep, voffB);
        PG8_WAIT_V(6); PG8_BAR;
    }
    for (;;) {
        const bool has_next = S.next(ui + 1, nxt);
        const char* nA = has_next ? (const char*)g.A + (size_t)nxt.pm * tstep : cA; const char* nB = has_next ? (const char*)g.Bt + (size_t)nxt.pn * tstep : cB;
        for (int t = 0; t < nt; t += 2) {
            const bool last = (t == nt - 2);
            const char* a1 = cA + (size_t)(t + 1) * kstep;
            const char* a2 = last ? nA : cA + (size_t)(t + 2) * kstep; const char* b2 = last ? nB : cB + (size_t)(t + 2) * kstep;
            const char* a3 = a2 + kstep; const char* b3 = b2 + kstep;
            if (last && has_next) S.a_ready(nxt);
            if constexpr (SP2) {
            PG8_LDB(B0, 0, 0); PG8_LDB(B1, 0, 1); PG8_SCHED; PG8_LDA(At, 0, 0); PG8_STAGE(PG8_SA(1, 1), a1 + hstep, voffA);
            PG8_WAIT_V(8); PG8_WAIT_L(0); PG8_BAR; PG8_MMA(0, 0, At, B0); PG8_MMA(0, 1, At, B1); PG8_BAR; PG8_SCHED;
            PG8_LDA(At, 0, 1); PG8_STAGE(PG8_SB(0, 0), b2, voffB); PG8_STAGE(PG8_SB(0, 1), b2 + hstep, voffB); PG8_STAGE(PG8_SA(0, 0), a2, voffA);
            PG8_WAIT_V(8); PG8_WAIT_L(0); PG8_BAR; PG8_MMA(1, 0, At, B0); PG8_MMA(1, 1, At, B1); PG8_BAR; PG8_SCHED;
            PG8_LDB(B0, 1, 0); PG8_LDB(B1, 1, 1); PG8_SCHED; PG8_LDA(At, 1, 0); PG8_STAGE(PG8_SA(0, 1), a2 + hstep, voffA);
            PG8_WAIT_V(8); PG8_WAIT_L(0); PG8_BAR; PG8_MMA(0, 0, At, B0); PG8_MMA(0, 1, At, B1); PG8_BAR; PG8_SCHED;
            PG8_LDA(At, 1, 1); PG8_STAGE(PG8_SB(1, 0), b3, voffB); PG8_STAGE(PG8_SB(1, 1), b3 + hstep, voffB); PG8_STAGE(PG8_SA(1, 0), a3, voffA);
            PG8_WAIT_V(8); PG8_WAIT_L(0); PG8_BAR; PG8_MMA(1, 0, At, B0); PG8_MMA(1, 1, At, B1); PG8_BAR; PG8_SCHED;
            } else {
            PG8_LDB(B0, 0, 0); PG8_SCHED; PG8_LDA(At, 0, 0); PG8_STAGE(PG8_SA(1, 1), a1 + hstep, voffA);
            PG8_WAIT_L(8); PG8_BAR; PG8_WAIT_L(0); PG8_MMA(0, 0, At, B0); PG8_BAR; PG8_SCHED;
            PG8_LDB(B1, 0, 1); PG8_STAGE(PG8_SB(0, 0), b2, voffB);
            PG8_BAR; PG8_WAIT_L(0); PG8_MMA(0, 1, At, B1); PG8_BAR;
            PG8_LDA(At, 0, 1); PG8_STAGE(PG8_SA(0, 0), a2, voffA);
            PG8_BAR; PG8_WAIT_L(0); PG8_MMA(1, 0, At, B0); PG8_BAR; PG8_SCHED;
            PG8_STAGE(PG8_SB(0, 1), b2 + hstep, voffB);
            PG8_WAIT_V(6); PG8_BAR; PG8_MMA(1, 1, At, B1); PG8_BAR;
            PG8_LDB(B0, 1, 0); PG8_SCHED; PG8_LDA(At, 1, 0); PG8_STAGE(PG8_SA(0, 1), a2 + hstep, voffA);
            PG8_WAIT_L(8); PG8_BAR; PG8_WAIT_L(0); PG8_MMA(0, 0, At, B0); PG8_BAR; PG8_SCHED;
            PG8_LDB(B1, 1, 1); PG8_STAGE(PG8_SB(1, 0), b3, voffB);
            PG8_BAR; PG8_WAIT_L(0); PG8_MMA(0, 1, At, B1); PG8_BAR;
            PG8_LDA(At, 1, 1); PG8_STAGE(PG8_SA(1, 0), a3, voffA);
            PG8_BAR; PG8_WAIT_L(0); PG8_MMA(1, 0, At, B0); PG8_BAR; PG8_SCHED;
            PG8_STAGE(PG8_SB(1, 1), b3 + hstep, voffB);
            PG8_WAIT_V(6); PG8_BAR; PG8_MMA(1, 1, At, B1); PG8_BAR;
            }
        }
        if constexpr (ALIGN_EPI) { if (wr == 0) PG8_BAR; }
        if constexpr (!Epi::AFTER_DRAIN) { E(acc, cur, wr, wc, fr, fq); S.done(cur); }
        if (!has_next) break;
#pragma unroll
        for (int a = 0; a < 2; ++a)
#pragma unroll
            for (int b = 0; b < 2; ++b)
#pragma unroll
                for (int m = 0; m < 4; ++m)
#pragma unroll
                    for (int n = 0; n < 2; ++n) acc[a][b][m][n] = (f32x4){0.f, 0.f, 0.f, 0.f};
        cur = nxt; cA = nA; cB = nB; ++ui;
        if constexpr (ALIGN_EPI) { if (wr == 1) PG8_BAR; }
    }
    PG8_WAIT_V(0);
    if constexpr (!ALIGN_EPI) { if (wr == 0) PG8_BAR; }
    PG8_BAR;
    if constexpr (Epi::AFTER_DRAIN) { E.fused(acc, cur, wr, wc, fr, fq, lds, wid, lane); S.done(cur); }
#undef PG8_SA
#undef PG8_SB
#undef PG8_STAGE
#undef PG8_LDA
#undef PG8_LDB
#undef PG8_MMA
#undef PG8_WAIT_V
#undef PG8_WAIT_L
#undef PG8_BAR
#undef PG8_SCHED
}
}

__device__ __forceinline__ void phase1(const Params& p, unsigned char* lds) {
    pg8::Gemm g{(const bf16*)(p.ws + WS_ACT), (const bf16*)(p.ws + WS_WINT), NTOK, 3584, D}; pg8::StaticOrder S; S.init(NTOK, 3584, (int)gridDim.x, (int)blockIdx.x);
    pg8::EpiStoreBf16 E{(bf16*)(p.ws + WS_PROJ), PS, DIN};
    pg8::gemm_phase<pg8::EpiStoreBf16, pg8::StaticOrder, true, true>((PG8_LAS unsigned char*)lds, g, S, E);
}


__device__ __forceinline__ void phase5(const Params& p, unsigned char* lds) {
    pg8::Gemm g{(const bf16*)(p.ws + WS_ACT), (const bf16*)(p.ws + WS_WOUTT), NTOK, D, D}; pg8::StaticOrder S; S.init(NTOK, D, (int)gridDim.x, (int)blockIdx.x);
    pg8::EpiResidF32 E{p.in[0], p.out, D, 0};
    pg8::gemm_phase<pg8::EpiResidF32, pg8::StaticOrder, true, true>((PG8_LAS unsigned char*)lds, g, S, E);
}
__device__ __forceinline__ void phase6(const Params& p, unsigned char* lds) {
    const int gw = (blockIdx.x * NTHR + threadIdx.x) >> 6, ngw = (gridDim.x * NTHR) >> 6, lane = threadIdx.x & 63;
    for (int m = gw; m < NTOK; m += ngw) rms_row_bf16(p.out + (size_t)m * D, p.in[13], (bf16*)(p.ws + WS_ACT) + (size_t)m * D, lane);
}
__device__ __forceinline__ void phase7(const Params& p, unsigned char* lds) {
    pg8::Gemm g{(const bf16*)(p.ws + WS_ACT), (const bf16*)(p.ws + WS_WQT), NTOK, 2048, D}; pg8::StaticOrder S; S.init(NTOK, 2048, (int)gridDim.x, (int)blockIdx.x);
    pg8::EpiStorePQF E{(bf16*)(p.ws + WS_PROJ), 0, 0};
    pg8::gemm_phase<pg8::EpiStorePQF, pg8::StaticOrder, true, true>((PG8_LAS unsigned char*)lds, g, S, E);
}
__device__ __forceinline__ void phase10(const Params& p, unsigned char* lds) {
    {
        pg8::Gemm g{(const bf16*)(p.ws + WS_PB), (const bf16*)(p.ws + WS_WPT), NTOK, D, 256}; pg8::StaticOrder S; S.init(NTOK, D, (int)gridDim.x, (int)blockIdx.x);
        pg8::EpiStoreBf16 E{(bf16*)(p.ws + WS_ACT), D, D};
        pg8::gemm_phase<pg8::EpiStoreBf16, pg8::StaticOrder, true, true>((PG8_LAS unsigned char*)lds, g, S, E);
    }
    {
        pg8::Gemm g{(const bf16*)(p.ws + WS_PROJ + 64 * MiB), (const bf16*)(p.ws + WS_WGT), NTOK, D, D}; pg8::StaticOrder S; S.init(NTOK, D, (int)gridDim.x, (int)blockIdx.x);
        pg8::EpiFinalGate E{(const bf16*)(p.ws + WS_ACT), (const float*)(p.ws + WS_SSQ), p.out, D, NTOK, EPS, 0};
        pg8::gemm_phase<pg8::EpiFinalGate, pg8::StaticOrder, true, true>((PG8_LAS unsigned char*)lds, g, S, E);
    }
}

typedef __bf16 bf16x2v __attribute__((ext_vector_type(2)));
template <int CTRL> __device__ __forceinline__ float dpp_f(float v) { return __int_as_float(__builtin_amdgcn_update_dpp(0, __float_as_int(v), CTRL, 0xF, 0xF, false)); }
__device__ __forceinline__ float grp16_max(float v) { v = fmaxf(v, dpp_f<0xB1>(v)); v = fmaxf(v, dpp_f<0x4E>(v)); v = fmaxf(v, dpp_f<0x141>(v)); v = fmaxf(v, dpp_f<0x140>(v)); return v; }
__device__ __forceinline__ float grp16_sum(float v) { v += dpp_f<0xB1>(v); v += dpp_f<0x4E>(v); v += dpp_f<0x141>(v); v += dpp_f<0x140>(v); return v; }
#define CE_DESC(a, b) { const float _hi = fmaxf(a, b), _lo = fminf(a, b); a = _hi; b = _lo; }
__device__ __forceinline__ float grp16_top16(float (&v)[8], int lig) {
    CE_DESC(v[0], v[1]) CE_DESC(v[2], v[3]) CE_DESC(v[4], v[5]) CE_DESC(v[6], v[7])
    CE_DESC(v[0], v[2]) CE_DESC(v[1], v[3]) CE_DESC(v[4], v[6]) CE_DESC(v[5], v[7])
    CE_DESC(v[1], v[2]) CE_DESC(v[5], v[6])
    CE_DESC(v[0], v[4]) CE_DESC(v[1], v[5]) CE_DESC(v[2], v[6]) CE_DESC(v[3], v[7])
    CE_DESC(v[2], v[4]) CE_DESC(v[3], v[5])
    CE_DESC(v[1], v[2]) CE_DESC(v[3], v[4]) CE_DESC(v[5], v[6])
    float top = 0.f;
#pragma unroll
    for (int r = 0; r < 16; ++r) {
        const float m = grp16_max(v[0]);
        if (lig == r) top = m;
        const bool own = (v[0] == m);
#pragma unroll
        for (int j = 0; j < 7; ++j) v[j] = own ? v[j + 1] : v[j];
        v[7] = own ? -3.0e38f : v[7];
    }
    return top;
}
__device__ __forceinline__ void phase8(const Params& p, unsigned char* lds) {
    const bf16* PQ = (const bf16*)(p.ws + WS_PROJ); const bf16* KB = (const bf16*)(p.ws + WS_KEYB);
    int* ids = (int*)(p.ws + WS_IDS); float* wts = (float*)(p.ws + WS_WTS);
    float* S = (float*)lds;
    const int tid = threadIdx.x, lane = tid & 63, wid = tid >> 6, lig = tid & 15, gbase = lane & 48;
    for (int item = blockIdx.x; item < 2048; item += gridDim.x) {
        const int tok0 = (item >> 3) * 64, h = item & 7;
        {
            const int c = wid >> 2, key0 = (wid & 3) * 32, r = lane & 31, hh = lane >> 5;
            f32x16 acc0, acc1;
#pragma unroll
            for (int i = 0; i < 16; ++i) { acc0[i] = 0.f; acc1[i] = 0.f; }
            const bf16* bq = KB + (((size_t)(h * 2 + c) * 4 + (key0 >> 5)) * 8) * 512 + lane * 8;
            const bf16* aq0 = PQ + ((((size_t)(tok0 >> 5)) * 16 + h * 2 + c) * 8) * 512 + lane * 8;
            const bf16* aq1 = aq0 + (size_t)16 * 8 * 512;
#pragma unroll
            for (int s = 0; s < 8; ++s) {
                const bf16x8 b = *(const bf16x8*)(bq + s * 512), a0 = *(const bf16x8*)(aq0 + s * 512), a1 = *(const bf16x8*)(aq1 + s * 512);
                acc0 = __builtin_amdgcn_mfma_f32_32x32x16_bf16(a0, b, acc0, 0, 0, 0);
                acc1 = __builtin_amdgcn_mfma_f32_32x32x16_bf16(a1, b, acc1, 0, 0, 0);
            }
#pragma unroll
            for (int i = 0; i < 16; ++i) { const int tl = (i & 3) + 8 * (i >> 2) + 4 * hh; S[(c * 64 + tl) * 132 + key0 + r] = acc0[i]; S[(c * 64 + 32 + tl) * 132 + key0 + r] = acc1[i]; }
        }
        __syncthreads();
        {
            const int tl0 = tid >> 4;
            float ts[2][2];
#pragma unroll
            for (int rd = 0; rd < 2; ++rd)
#pragma unroll
                for (int c = 0; c < 2; ++c) {
                    float v[8];
                    const float* sp = S + (c * 64 + tl0 + 32 * rd) * 132 + lig * 8;
                    const f32x4 lo = *(const f32x4*)sp, hi = *(const f32x4*)(sp + 4);
                    v[0] = lo.x; v[1] = lo.y; v[2] = lo.z; v[3] = lo.w; v[4] = hi.x; v[5] = hi.y; v[6] = hi.z; v[7] = hi.w;
#pragma unroll
                    for (int j = 0; j < 8; ++j) v[j] = __uint_as_float((__float_as_uint(v[j]) & ~127u) | (unsigned)(lig * 8 + j));
                    ts[rd][c] = grp16_top16(v, lig);
                }
            int bp[2] = {0, 0}; float my_s[2] = {0.f, 0.f}; int my_eid[2] = {0, 0};
#pragma unroll 4
            for (int r = 0; r < 16; ++r) {
#pragma unroll
                for (int rd = 0; rd < 2; ++rd) {
                    const float other = __shfl(ts[rd][1], gbase + (bp[rd] < 15 ? bp[rd] : 15));
                    const float sum = ts[rd][0] + other;
                    const float head = (bp[rd] >= 16) ? -3.0e38f : __uint_as_float((__float_as_uint(sum) & ~15u) | (unsigned)lig);
                    const int cur_eid = (int)(((__float_as_uint(ts[rd][0]) & 127u) << 7) | (__float_as_uint(other) & 127u));
                    const float m = grp16_max(head);
                    const int owner = (int)(__float_as_uint(m) & 15u);
                    const int ew = __shfl(cur_eid, gbase + owner);
                    if (lig == r) { my_s[rd] = m; my_eid[rd] = ew; }
                    if (lig == owner) ++bp[rd];
                }
            }
#pragma unroll
            for (int rd = 0; rd < 2; ++rd) {
                const int tl = tl0 + 32 * rd;
                const float mx = grp16_max(my_s[rd]);
                const float e = __expf(my_s[rd] - mx);
                const float sm = grp16_sum(e);
                const size_t o = (size_t)(tok0 + tl) * 128 + h * 16 + lig;
                ((unsigned short*)ids)[(size_t)(tok0 + tl) * 128 + (h >> 2) * 64 + (lig & 7) * 8 + (h & 3) * 2 + (lig >> 3)] = (unsigned short)my_eid[rd]; wts[o] = e / sm;
            }
        }
        __syncthreads();
    }
}

__device__ __forceinline__ void hgrn_pre_item(const Params& p, unsigned char* lds, int ci) {
    const int tid = threadIdx.x, lane = tid & 63, wid = tid >> 6, k = tid & 127, tq = tid >> 7;
    const int n = ci & 127, h = (ci >> 7) & 3, b = ci >> 9, tok0 = b * T + n * 64;
    bf16* proj = (bf16*)(p.ws + WS_PROJ);
    float* OB = p.out; bf16* KIT = (bf16*)((unsigned char*)p.out + OUT_KIT) + (size_t)ci * 8192; bf16* VTg = (bf16*)((unsigned char*)p.out + OUT_VT) + (size_t)ci * 8192;
    float* DEC = (float*)(p.ws + WS_DEC) + (size_t)ci * 128;
    bf16* QT = (bf16*)lds; bf16* KT = (bf16*)(lds + 17408); bf16* VTl = (bf16*)(lds + 34816); bf16* AM = (bf16*)(lds + 53248);
    float* part = (float*)(lds + 62464); float* gref = (float*)(lds + 64512);
    float lb; { const float l0 = p.in[4][h * 128 + k], l1 = p.in[4][512 + h * 128 + k]; const float m = fmaxf(l0, l1); const float e0 = __expf(l0 - m), e1 = __expf(l1 - m); lb = e0 / (e0 + e1); }
    float G[16], key[16], qv[16], vv[16];
    {
        float c = 0.f;
#pragma unroll
        for (int i = 0; i < 16; ++i) {
            const size_t row = (size_t)(tok0 + tq * 16 + i) * PS;
            const float fg = lb + (1.0f - lb) * sigmoidf_(bf2f(proj[row + C_HF + h * 128 + k]));
            key[i] = 1.0f - fg; c += __logf(fg); G[i] = c;
            qv[i] = siluf_(bf2f(proj[row + C_HQ + h * 128 + k])) * 0.08838834764831845f;
            vv[i] = bf2f(proj[row + C_HI + h * 128 + k]);
        }
        part[tq * 128 + k] = c;
    }
    __syncthreads();
    {
        float off = 0.f;
#pragma unroll
        for (int j = 0; j < 3; ++j) off += (j < tq) ? part[j * 128 + k] : 0.f;
#pragma unroll
        for (int i = 0; i < 16; ++i) G[i] += off;
        if (tq == 1) gref[k] = G[15];
        if (tq == 3) gref[128 + k] = G[15];
    }
    __syncthreads();
    {
        const float gr = gref[k], gl = gref[128 + k];
        const int kpos = (k & ~31) | (((k >> 2) & 3) << 3) | (((k >> 4) & 1) << 2) | (k & 3);
        unsigned kp[8], vp[8];
#pragma unroll
        for (int i = 0; i < 16; i += 2) {
            kp[i >> 1] = pk2(key[i] * __expf(gl - G[i]), key[i + 1] * __expf(gl - G[i + 1]));
            vp[i >> 1] = pk2(vv[i], vv[i + 1]);
        }
#pragma unroll
        for (int i = 0; i < 16; ++i) {
            const int t = tq * 16 + i;
            QT[t * 136 + k] = f2bf(qv[i] * __expf(G[i] - gr));
            KT[t * 136 + k] = f2bf(key[i] * __expf(gr - G[i]));
            proj[(size_t)(tok0 + t) * PS + C_HQ + h * 128 + kpos] = f2bf(qv[i] * __expf(G[i]));
        }
        u32x4 a0, a1, b0, b1; a0.x = kp[0]; a0.y = kp[1]; a0.z = kp[2]; a0.w = kp[3]; a1.x = kp[4]; a1.y = kp[5]; a1.z = kp[6]; a1.w = kp[7];
        b0.x = vp[0]; b0.y = vp[1]; b0.z = vp[2]; b0.w = vp[3]; b1.x = vp[4]; b1.y = vp[5]; b1.z = vp[6]; b1.w = vp[7];
        *(u32x4*)(KIT + k * 64 + tq * 16) = a0; *(u32x4*)(KIT + k * 64 + tq * 16 + 8) = a1;
        *(u32x4*)(VTg + k * 64 + tq * 16) = b0; *(u32x4*)(VTg + k * 64 + tq * 16 + 8) = b1;
        *(u32x4*)(VTl + k * 72 + tq * 16) = b0; *(u32x4*)(VTl + k * 72 + tq * 16 + 8) = b1;
        if (tq == 3) DEC[k] = __expf(gl);
    }
    __syncthreads();
    const int fr = lane & 15, fq = lane >> 4;
    {
        const int tt = wid >> 1;
#pragma unroll
        for (int e = 0; e < 2; ++e) {
            const int st = 2 * (wid & 1) + e;
            f32x4 acc = (f32x4){0.f, 0.f, 0.f, 0.f};
            if (st <= tt) {
#pragma unroll
                for (int s = 0; s < 4; ++s) {
                    const bf16x8 a = *(const bf16x8*)(QT + (tt * 16 + fr) * 136 + s * 32 + fq * 8), bb = *(const bf16x8*)(KT + (st * 16 + fr) * 136 + s * 32 + fq * 8);
                    acc = __builtin_amdgcn_mfma_f32_16x16x32_bf16(a, bb, acc, 0, 0, 0);
                }
            }
#pragma unroll
            for (int r = 0; r < 4; ++r) { const int t = tt * 16 + fq * 4 + r, sp = st * 16 + fr; AM[t * 72 + sp] = f2bf(sp <= t ? acc[r] : 0.f); }
        }
    }
    __syncthreads();
    {
        const int tt = wid >> 1;
        const bf16x8 a0 = *(const bf16x8*)(AM + (tt * 16 + fr) * 72 + fq * 8), a1 = *(const bf16x8*)(AM + (tt * 16 + fr) * 72 + 32 + fq * 8);
#pragma unroll
        for (int e = 0; e < 4; ++e) {
            const int vt = (wid & 1) * 4 + e;
            const bf16x8 b0 = *(const bf16x8*)(VTl + (vt * 16 + fr) * 72 + fq * 8), b1 = *(const bf16x8*)(VTl + (vt * 16 + fr) * 72 + 32 + fq * 8);
            f32x4 acc = (f32x4){0.f, 0.f, 0.f, 0.f};
            acc = __builtin_amdgcn_mfma_f32_16x16x32_bf16(a0, b0, acc, 0, 0, 0);
            acc = __builtin_amdgcn_mfma_f32_16x16x32_bf16(a1, b1, acc, 0, 0, 0);
#pragma unroll
            for (int r = 0; r < 4; ++r) OB[(size_t)(tok0 + tt * 16 + fq * 4 + r) * 512 + h * 128 + vt * 16 + fr] = acc[r];
        }
    }
    __syncthreads();
}
template <bool DUMMY>
__device__ __forceinline__ void hgrn_scan_item(const Params& p, int wi) {
    const int lane = threadIdx.x & 63, fr = lane & 15, fq = lane >> 4;
    const int vs = wi & 7, bh = wi >> 3, h = bh & 3, b = bh >> 2;
    const bf16* proj = (const bf16*)(p.ws + WS_PROJ);
    float* OB = p.out; const bf16* KIT = (const bf16*)((unsigned char*)p.out + OUT_KIT); const bf16* VTg = (const bf16*)((unsigned char*)p.out + OUT_VT);
    const float* DEC = (const float*)(p.ws + WS_DEC);
    f32x4 S[8];
#pragma unroll
    for (int i = 0; i < 8; ++i) S[i] = (f32x4){0.f, 0.f, 0.f, 0.f};
#pragma unroll 1
    for (int n = 0; n < 128; ++n) {
        const int ci = bh * 128 + n, tok0 = b * T + n * 64;
        bf16x8 qf[4][4];
#pragma unroll
        for (int tt = 0; tt < 4; ++tt)
#pragma unroll
            for (int s = 0; s < 4; ++s) qf[tt][s] = *(const bf16x8*)(proj + (size_t)(tok0 + tt * 16 + fr) * PS + C_HQ + h * 128 + s * 32 + fq * 8);
        float oin[4][4];
#pragma unroll
        for (int tt = 0; tt < 4; ++tt)
#pragma unroll
            for (int r = 0; r < 4; ++r) oin[tt][r] = OB[(size_t)(tok0 + tt * 16 + fq * 4 + r) * 512 + h * 128 + vs * 16 + fr];
        bf16x8 Sb[4];
#pragma unroll
        for (int s = 0; s < 4; ++s) {
            u32x4 w; w.x = pk2(S[2 * s][0], S[2 * s][1]); w.y = pk2(S[2 * s][2], S[2 * s][3]); w.z = pk2(S[2 * s + 1][0], S[2 * s + 1][1]); w.w = pk2(S[2 * s + 1][2], S[2 * s + 1][3]);
            Sb[s] = __builtin_bit_cast(bf16x8, w);
        }
#pragma unroll
        for (int tt = 0; tt < 4; ++tt) {
            f32x4 acc = (f32x4){0.f, 0.f, 0.f, 0.f};
#pragma unroll
            for (int s = 0; s < 4; ++s) acc = __builtin_amdgcn_mfma_f32_16x16x32_bf16(qf[tt][s], Sb[s], acc, 0, 0, 0);
#pragma unroll
            for (int r = 0; r < 4; ++r) { const size_t oi = (size_t)(tok0 + tt * 16 + fq * 4 + r) * 512 + h * 128 + vs * 16 + fr; if (DUMMY) ((float*)(p.ws + WS_SPARE))[oi & 0x3fffff] = oin[tt][r] + acc[r]; else OB[oi] = oin[tt][r] + acc[r]; }
        }
        const bf16x8 v0 = *(const bf16x8*)(VTg + (size_t)ci * 8192 + (vs * 16 + fr) * 64 + fq * 8), v1 = *(const bf16x8*)(VTg + (size_t)ci * 8192 + (vs * 16 + fr) * 64 + 32 + fq * 8);
#pragma unroll
        for (int kb = 0; kb < 8; ++kb) {
            const bf16x8 k0 = *(const bf16x8*)(KIT + (size_t)ci * 8192 + (kb * 16 + fr) * 64 + fq * 8), k1 = *(const bf16x8*)(KIT + (size_t)ci * 8192 + (kb * 16 + fr) * 64 + 32 + fq * 8);
            const f32x4 dv = *(const f32x4*)(DEC + (size_t)ci * 128 + kb * 16 + fq * 4);
            f32x4 sacc = S[kb] * dv;
            sacc = __builtin_amdgcn_mfma_f32_16x16x32_bf16(k0, v0, sacc, 0, 0, 0);
            sacc = __builtin_amdgcn_mfma_f32_16x16x32_bf16(k1, v1, sacc, 0, 0, 0);
            S[kb] = sacc;
        }
    }
}

__device__ __forceinline__ void hgrn_scan_block(const Params& p, unsigned char* lds, int sb) {
    const int tid = threadIdx.x, lane = tid & 63, wid = __builtin_amdgcn_readfirstlane(tid >> 6), fr = lane & 15, fq = lane >> 4;
    const int bh = sb >> 2, vs = (sb & 3) * 2 + (wid & 1); const bool worker = wid < 2;
    const int h = bh & 3, b = bh >> 2;
    const bf16* proj = (const bf16*)(p.ws + WS_PROJ);
    float* OB = p.out; const bf16* KIT = (const bf16*)((unsigned char*)p.out + OUT_KIT); const bf16* VTg = (const bf16*)((unsigned char*)p.out + OUT_VT);
    const float* DEC = (const float*)(p.ws + WS_DEC);
    constexpr int BUF = 54784, O_KIT = 17408, O_VT = 17408 + 18432, O_DEC = 17408 + 2 * 18432;
    u32x4 rqA[2], rkA[2], rvA[2], rdA, rqB[2], rkB[2], rvB[2], rdB;
    float oin[4][4];
#define SC_ISSUE(rq, rk, rv, rd, n_) { const int ci_ = bh * 128 + (n_), tk_ = b * T + (n_) * 64; \
        _Pragma("unroll") for (int i = 0; i < 2; ++i) { const int id = tid + i * NTHR; \
            rq[i] = *(const u32x4*)(proj + (size_t)(tk_ + (id >> 4)) * PS + C_HQ + h * 128 + (id & 15) * 8); \
            rk[i] = *(const u32x4*)(KIT + (size_t)ci_ * 8192 + id * 8); rv[i] = *(const u32x4*)(VTg + (size_t)ci_ * 8192 + id * 8); } \
        if (tid < 32) rd = *(const u32x4*)(DEC + (size_t)ci_ * 128 + tid * 4); }
#define SC_STASH(rq, rk, rv, rd, buf) { _Pragma("unroll") for (int i = 0; i < 2; ++i) { const int id = tid + i * NTHR; \
            *(u32x4*)((buf) + (id >> 4) * 272 + (id & 15) * 16) = rq[i]; *(u32x4*)((buf) + O_KIT + (id >> 3) * 144 + (id & 7) * 16) = rk[i]; \
            *(u32x4*)((buf) + O_VT + (id >> 3) * 144 + (id & 7) * 16) = rv[i]; } \
        if (tid < 32) *(u32x4*)((buf) + O_DEC + tid * 16) = rd; }
    auto load_oin = [&](int n) {
        const int tok0 = b * T + n * 64;
#pragma unroll
        for (int tt = 0; tt < 4; ++tt)
#pragma unroll
            for (int r = 0; r < 4; ++r) oin[tt][r] = OB[(size_t)(tok0 + tt * 16 + fq * 4 + r) * 512 + h * 128 + vs * 16 + fr];
    };
    f32x4 S[8];
#pragma unroll
    for (int i = 0; i < 8; ++i) S[i] = (f32x4){0.f, 0.f, 0.f, 0.f};
    SC_ISSUE(rqA, rkA, rvA, rdA, 0)
    SC_ISSUE(rqB, rkB, rvB, rdB, 1)
    SC_STASH(rqA, rkA, rvA, rdA, lds)
    __syncthreads();
    auto compute = [&](int n, unsigned char* cur) {
        const int tok0 = b * T + n * 64;
        const int nn = (n + 1 < 128) ? n + 1 : n;
        bf16x8 Sb[4];
#pragma unroll
        for (int s = 0; s < 4; ++s) {
            u32x4 w; w.x = pk2(S[2 * s][0], S[2 * s][1]); w.y = pk2(S[2 * s][2], S[2 * s][3]); w.z = pk2(S[2 * s + 1][0], S[2 * s + 1][1]); w.w = pk2(S[2 * s + 1][2], S[2 * s + 1][3]);
            Sb[s] = __builtin_bit_cast(bf16x8, w);
        }
        f32x4 oacc[4];
#pragma unroll
        for (int hf = 0; hf < 2; ++hf) {
            bf16x8 qf[2][4];
#pragma unroll
            for (int t2 = 0; t2 < 2; ++t2)
#pragma unroll
                for (int s = 0; s < 4; ++s) qf[t2][s] = *(const bf16x8*)(cur + ((hf * 2 + t2) * 16 + fr) * 272 + (s * 32 + fq * 8) * 2);
            __builtin_amdgcn_sched_barrier(0);
#pragma unroll
            for (int t2 = 0; t2 < 2; ++t2) oacc[hf * 2 + t2] = (f32x4){0.f, 0.f, 0.f, 0.f};
#pragma unroll
            for (int s = 0; s < 4; ++s)
#pragma unroll
                for (int t2 = 0; t2 < 2; ++t2) oacc[hf * 2 + t2] = __builtin_amdgcn_mfma_f32_16x16x32_bf16(qf[t2][s], Sb[s], oacc[hf * 2 + t2], 0, 0, 0);
        }
        { bf16* MX = (bf16*)(p.ws + WS_ACT);
#pragma unroll
          for (int tt = 0; tt < 4; ++tt)
#pragma unroll
            for (int r = 0; r < 4; ++r) MX[(size_t)(tok0 + tt * 16 + fq * 4 + r) * D + h * 128 + vs * 16 + fr] = f2bf(oacc[tt][r]); }
        const bf16x8 v0 = *(const bf16x8*)(cur + O_VT + (vs * 16 + fr) * 144 + fq * 16), v1 = *(const bf16x8*)(cur + O_VT + (vs * 16 + fr) * 144 + 64 + fq * 16);
#pragma unroll
        for (int hf = 0; hf < 2; ++hf) {
            bf16x8 kf[4][2]; f32x4 dvv[4];
#pragma unroll
            for (int k4 = 0; k4 < 4; ++k4) { const int kb = hf * 4 + k4;
                kf[k4][0] = *(const bf16x8*)(cur + O_KIT + (kb * 16 + fr) * 144 + fq * 16); kf[k4][1] = *(const bf16x8*)(cur + O_KIT + (kb * 16 + fr) * 144 + 64 + fq * 16);
                dvv[k4] = *(const f32x4*)(cur + O_DEC + (kb * 16 + fq * 4) * 4); }
            __builtin_amdgcn_sched_barrier(0);
#pragma unroll
            for (int k4 = 0; k4 < 4; ++k4) S[hf * 4 + k4] = S[hf * 4 + k4] * dvv[k4];
#pragma unroll
            for (int e = 0; e < 2; ++e)
#pragma unroll
                for (int k4 = 0; k4 < 4; ++k4) S[hf * 4 + k4] = __builtin_amdgcn_mfma_f32_16x16x32_bf16(kf[k4][e], e == 0 ? v0 : v1, S[hf * 4 + k4], 0, 0, 0);
        }
    };
#pragma unroll 1
    for (int n = 0; n < 128; n += 2) {
        { const int n2 = (n + 2 < 128) ? n + 2 : n; SC_ISSUE(rqA, rkA, rvA, rdA, n2) }
        if (worker) compute(n, lds);
        SC_STASH(rqB, rkB, rvB, rdB, lds + BUF)
        asm volatile("s_waitcnt lgkmcnt(0)" ::: "memory"); __builtin_amdgcn_s_barrier(); asm volatile("" ::: "memory");
        { const int n3 = (n + 3 < 128) ? n + 3 : n + 1; SC_ISSUE(rqB, rkB, rvB, rdB, n3) }
        if (worker) compute(n + 1, lds + BUF);
        SC_STASH(rqA, rkA, rvA, rdA, lds)
        asm volatile("s_waitcnt lgkmcnt(0)" ::: "memory"); __builtin_amdgcn_s_barrier(); asm volatile("" ::: "memory");
    }
#undef SC_ISSUE
#undef SC_STASH
}
__device__ __forceinline__ void phase4(const Params& p, unsigned char* lds) {
    const bf16* proj = (const bf16*)(p.ws + WS_PROJ); const float* OB = p.out; bf16* mixed = (bf16*)(p.ws + WS_ACT); const float* gain = p.in[5];
    const int lane = threadIdx.x & 63, gw = (blockIdx.x * NTHR + threadIdx.x) >> 6, ngw = (gridDim.x * NTHR) >> 6;
    for (int tok = gw; tok < NTOK; tok += ngw) {
        f32x4 o0 = *(const f32x4*)(OB + (size_t)tok * 512 + lane * 8), o1 = *(const f32x4*)(OB + (size_t)tok * 512 + lane * 8 + 4);
        { const u32x4 oi = *(const u32x4*)(mixed + (size_t)tok * D + lane * 8); const unsigned a = oi.x, b = oi.y, c = oi.z, d = oi.w;
          o0.x += __uint_as_float(a << 16); o0.y += __uint_as_float(a & 0xffff0000u); o0.z += __uint_as_float(b << 16); o0.w += __uint_as_float(b & 0xffff0000u);
          o1.x += __uint_as_float(c << 16); o1.y += __uint_as_float(c & 0xffff0000u); o1.z += __uint_as_float(d << 16); o1.w += __uint_as_float(d & 0xffff0000u); }
        const u32x4 gp = *(const u32x4*)(proj + (size_t)tok * PS + C_HG + lane * 8);
        const f32x4 g0 = *(const f32x4*)(gain + lane * 8), g1 = *(const f32x4*)(gain + lane * 8 + 4);
        float ss = o0.x * o0.x + o0.y * o0.y + o0.z * o0.z + o0.w * o0.w + o1.x * o1.x + o1.y * o1.y + o1.z * o1.z + o1.w * o1.w;
        ss = grp16_sum(ss);
        const float r = rsqrtf(ss * (1.0f / 128.0f) + EPS);
        const unsigned gx = gp.x, gy = gp.y, gz = gp.z, gw_ = gp.w;
        u32x4 w;
        w.x = pk2(o0.x * r * g0.x * siluf_(__uint_as_float(gx << 16)), o0.y * r * g0.y * siluf_(__uint_as_float(gx & 0xffff0000u)));
        w.y = pk2(o0.z * r * g0.z * siluf_(__uint_as_float(gy << 16)), o0.w * r * g0.w * siluf_(__uint_as_float(gy & 0xffff0000u)));
        w.z = pk2(o1.x * r * g1.x * siluf_(__uint_as_float(gz << 16)), o1.y * r * g1.y * siluf_(__uint_as_float(gz & 0xffff0000u)));
        w.w = pk2(o1.z * r * g1.z * siluf_(__uint_as_float(gw_ << 16)), o1.w * r * g1.w * siluf_(__uint_as_float(gw_ & 0xffff0000u)));
        *(u32x4*)(mixed + (size_t)tok * D + lane * 8) = w;
    }
}

#define WAVE_LDS_SYNC() asm volatile("s_waitcnt lgkmcnt(0)" ::: "memory")
__device__ __forceinline__ void nsa_prep_item(const Params& p, unsigned char* lds, int tile) {
    const int tid = threadIdx.x, lig = tid & 15;
    const int tok0 = tile * 64;
    bf16* proj = (bf16*)(p.ws + WS_PROJ);
    for (int rho = tid >> 4; rho < 768; rho += 32) {
        const int tl = rho / 12, which = rho - tl * 12;
        int col; const float* gain; float sc = 1.0f;
        if (which < 8) { col = C_NQ + which * 64; gain = p.in[6]; sc = 0.125f * 1.4426950408889634f; }
        else if (which < 10) { col = C_KS + (which - 8) * 64; gain = p.in[7] + 64; }
        else { col = C_KW + (which - 10) * 64; gain = p.in[7] + 128; }
        bf16* rp = proj + (size_t)(tok0 + tl) * PS + col + lig * 4;
        const u32x2 raw = *(const u32x2*)rp;
        const unsigned r0 = raw.x, r1 = raw.y;
        const float a = __uint_as_float(r0 << 16), b = __uint_as_float(r0 & 0xffff0000u), c = __uint_as_float(r1 << 16), d = __uint_as_float(r1 & 0xffff0000u);
        const float ss = grp16_sum(a * a + b * b + c * c + d * d);
        const float r = rsqrtf(ss * (1.0f / 64.0f) + EPS) * sc;
        const f32x4 gg = *(const f32x4*)(gain + lig * 4);
        u32x2 o; o.x = pk2(a * r * gg.x, b * r * gg.y); o.y = pk2(c * r * gg.z, d * r * gg.w);
        if (which < 8) *(u32x2*)rp = o;
        else {
            const int g = (which - 8) & 1, tok = tok0 + tl, b = tok / T, t = tok % T;
            unsigned char* kb = p.ws + (which < 10 ? WS_KFS : WS_KFW) + ((size_t)(b * 2 + g) * 256 + (t >> 5)) * 4096;
            *(u32x2*)(kb + (lig >> 2) * 1024 + ((t & 31) + 32 * ((lig >> 1) & 1)) * 16 + (lig & 1) * 8) = o;
        }
    }
    {
        const int c = tid & 127, tq = tid >> 7, g = c >> 6, d = c & 63, b = tok0 / T, t0 = tok0 % T;
#pragma unroll
        for (int which = 0; which < 2; ++which) {
            const int col = (which == 0 ? C_VS : C_VW) + c;
            unsigned short e[16];
#pragma unroll
            for (int i = 0; i < 16; ++i) e[i] = proj[(size_t)(tok0 + tq * 16 + i) * PS + col];
            unsigned char* vb = p.ws + (which == 0 ? WS_VTS : WS_VTW) + ((size_t)(b * 2 + g) * 256 + ((t0 + tq * 16) >> 5)) * 4096 + ((d >> 5) * 2 + (tq & 1)) * 1024 + (d & 31) * 16;
            u32x4 h0, h1;
            h0.x = e[0] | ((unsigned)e[1] << 16); h0.y = e[2] | ((unsigned)e[3] << 16); h0.z = e[8] | ((unsigned)e[9] << 16); h0.w = e[10] | ((unsigned)e[11] << 16);
            h1.x = e[4] | ((unsigned)e[5] << 16); h1.y = e[6] | ((unsigned)e[7] << 16); h1.z = e[12] | ((unsigned)e[13] << 16); h1.w = e[14] | ((unsigned)e[15] << 16);
            *(u32x4*)vb = h0; *(u32x4*)(vb + 512) = h1;
        }
    }
}
__device__ __forceinline__ void nsa_cmp_item(const Params& p, unsigned char* lds, int item) {
    const int tid = threadIdx.x, lane = tid & 63, wid = tid >> 6, fr = lane & 15, fq = lane >> 4;
    const int nt32 = item & 15, g = (item >> 4) & 1, b = (item >> 5) & 1, which = item >> 6, n0 = nt32 * 32;
    const bf16* proj = (const bf16*)(p.ws + WS_PROJ);
    const float* pe = p.in[8] + which * 2048;
    const bf16* W1T = (const bf16*)(p.ws + WS_W1T) + (size_t)which * 64 * 2048;
    const float* w2 = p.in[10] + which * 4096;
    bf16* A = (bf16*)lds; float* H = (float*)(lds + 33280);
    const int col0 = (which == 0 ? C_KC : C_VC) + g * 64;
    const int nt = wid & 1, ct = wid >> 1;
    f32x4 acc = (f32x4){0.f, 0.f, 0.f, 0.f};
#pragma unroll 1
    for (int kc = 0; kc < 4; ++kc) {
#pragma unroll
        for (int i = 0; i < 4; ++i) {
            const int idx = tid + i * NTHR, dch = idx & 7, jj = (idx >> 3) & 7, n = idx >> 6, j = kc * 8 + jj;
            u32x4 o = (u32x4){0u, 0u, 0u, 0u};
            if (n0 + n < NCMP) {
                const u32x4 raw = *(const u32x4*)(proj + (size_t)(b * T + 16 * (n0 + n) + j) * PS + col0 + dch * 8);
                const f32x4 p0 = *(const f32x4*)(pe + j * 64 + dch * 8), p1 = *(const f32x4*)(pe + j * 64 + dch * 8 + 4);
                const unsigned r0 = raw.x, r1 = raw.y, r2 = raw.z, r3 = raw.w;
                o.x = pk2(__uint_as_float(r0 << 16) + p0.x, __uint_as_float(r0 & 0xffff0000u) + p0.y);
                o.y = pk2(__uint_as_float(r1 << 16) + p0.z, __uint_as_float(r1 & 0xffff0000u) + p0.w);
                o.z = pk2(__uint_as_float(r2 << 16) + p1.x, __uint_as_float(r2 & 0xffff0000u) + p1.y);
                o.w = pk2(__uint_as_float(r3 << 16) + p1.z, __uint_as_float(r3 & 0xffff0000u) + p1.w);
            }
            *(u32x4*)(A + n * 520 + jj * 64 + dch * 8) = o;
        }
        __syncthreads();
#pragma unroll 4
        for (int s = 0; s < 16; ++s) {
            const bf16x8 a = *(const bf16x8*)(A + (nt * 16 + fr) * 520 + s * 32 + fq * 8);
            const bf16x8 bb = *(const bf16x8*)(W1T + (size_t)(ct * 16 + fr) * 2048 + kc * 512 + s * 32 + fq * 8);
            acc = __builtin_amdgcn_mfma_f32_16x16x32_bf16(a, bb, acc, 0, 0, 0);
        }
        __syncthreads();
    }
#pragma unroll
    for (int r = 0; r < 4; ++r) H[(nt * 16 + fq * 4 + r) * 64 + ct * 16 + fr] = gelu_tanh(acc[r]);
    __syncthreads();
    {
        const int n = tid >> 4, c = (tid & 15) * 4;
        f32x4 o = (f32x4){0.f, 0.f, 0.f, 0.f};
#pragma unroll 8
        for (int i = 0; i < 64; ++i) { const float hv = H[n * 64 + i]; const f32x4 w = *(const f32x4*)(w2 + i * 64 + c); o += hv * w; }
        if (which == 0) {
            const float ss = grp16_sum(o.x * o.x + o.y * o.y + o.z * o.z + o.w * o.w);
            const float r = rsqrtf(ss * (1.0f / 64.0f) + EPS);
            const f32x4 gg = *(const f32x4*)(p.in[7] + c);
            o = o * r * gg;
        }
        if (n0 + n >= NCMP) o = (f32x4){0.f, 0.f, 0.f, 0.f};
        const int nn = n0 + n;
        if (which == 0) { u32x2 w; w.x = pk2(o.x, o.y); w.y = pk2(o.z, o.w);
            *(u32x2*)(p.ws + WS_KC + ((size_t)(b * 2 + g) * 16 + (nn >> 5)) * 4096 + (c >> 4) * 1024 + ((nn & 31) + 32 * ((c >> 3) & 1)) * 16 + (c & 7) * 2) = w; }
        else {
            const int kl = nn & 31, sst = kl >> 4, r = kl & 15, j = ((r >> 3) << 2) | (r & 3), hh = (r >> 2) & 1;
            bf16* vt = (bf16*)(p.ws + WS_VCT + ((size_t)(b * 2 + g) * 16 + (nn >> 5)) * 4096 + sst * 1024 + hh * 512 + j * 2);
            const float ov[4] = {o.x, o.y, o.z, o.w};
#pragma unroll
            for (int e = 0; e < 4; ++e) { const int dd = c + e; vt[((dd >> 5) * 2048 + (dd & 31) * 16) / 2] = f2bf(ov[e]); }
        }
    }
    __syncthreads();
}

constexpr float LOG2E = 1.4426950408889634f;
__device__ __forceinline__ int rho16(int reg, int hh) { return (reg & 3) + 8 * (reg >> 2) + 4 * hh; }
__device__ __forceinline__ bf16x8 pack8(const float* pv) {
    u32x4 w; w.x = pk2(pv[0], pv[1]); w.y = pk2(pv[2], pv[3]); w.z = pk2(pv[4], pv[5]); w.w = pk2(pv[6], pv[7]);
    return __builtin_bit_cast(bf16x8, w);
}
struct KF { bf16x8 f[4]; };
struct VF { bf16x8 f[4]; };
__device__ __forceinline__ void load_k(KF& k, const unsigned char* tp) {
#pragma unroll
    for (int s = 0; s < 4; ++s) k.f[s] = *(const bf16x8*)(tp + s * 1024);
}
__device__ __forceinline__ void load_v(VF& v, const unsigned char* tp) {
#pragma unroll
    for (int q = 0; q < 4; ++q) v.f[q] = *(const bf16x8*)(tp + q * 1024);
}
__device__ __forceinline__ f32x16 score_tile(const KF& k, const bf16x8 (&qf)[4], float slope, float base) {
    f32x16 st;
#pragma unroll
    for (int i = 0; i < 16; ++i) st[i] = fmaf(slope, (float)((i & 3) + 8 * (i >> 2)), base);
#pragma unroll
    for (int s = 0; s < 4; ++s) st = __builtin_amdgcn_mfma_f32_32x32x16_bf16(k.f[s], qf[s], st, 0, 0, 0);
    return st;
}
__device__ __forceinline__ void pv_tile(f32x16& o0, f32x16& o1, const VF& v, const float* pv) {
    const bf16x8 p0 = pack8(pv), p1 = pack8(pv + 8);
    o0 = __builtin_amdgcn_mfma_f32_32x32x16_bf16(v.f[0], p0, o0, 0, 0, 0); o0 = __builtin_amdgcn_mfma_f32_32x32x16_bf16(v.f[1], p1, o0, 0, 0, 0);
    o1 = __builtin_amdgcn_mfma_f32_32x32x16_bf16(v.f[2], p0, o1, 0, 0, 0); o1 = __builtin_amdgcn_mfma_f32_32x32x16_bf16(v.f[3], p1, o1, 0, 0, 0);
}
template <bool FAST>
__device__ __forceinline__ void attn_tile(const KF& kc, const VF& vf, const bf16x8 (&qf)[4], float slope, float base, int distbase, bool colsel, int wlimit,
                                          float& l, f32x16& o0, f32x16& o1) {
    const f32x16 st = score_tile(kc, qf, slope, base);
    float sv[16]; float ps = 0.f;
#pragma unroll
    for (int i = 0; i < 16; ++i) {
        float e = __builtin_amdgcn_exp2f(st[i]);
        if (!FAST) { const int dist = distbase - ((i & 3) + 8 * (i >> 2)); e = (colsel && dist >= 0 && dist < wlimit) ? e : 0.f; }
        sv[i] = e; ps += e;
    }
    l += ps;
    pv_tile(o0, o1, vf, sv);
}
__device__ __forceinline__ void nsa_attn_item(const Params& p, unsigned char* wlds, int item) {
    const int lane = threadIdx.x & 63, c = lane & 31, hh = lane >> 5, jt = c >> 2, r4 = c & 3;
    const int oct = item & 1023, g = (item >> 10) & 1, b = item >> 11;
    const int t0 = oct * 8, tc = t0 + jt, h = g * 4 + r4;
    const float slope = exp2f(-(float)(h + 1)) * LOG2E;
    const bf16* proj = (const bf16*)(p.ws + WS_PROJ);
    float* impA = (float*)wlds; float* impB = impA + 1024; unsigned* msk = (unsigned*)(impB + 1024);
    unsigned char* blist = (unsigned char*)(msk + 32);
    float* ocl = (float*)(wlds + 8448) + lane;
#pragma unroll
    for (int i = 0; i < 16; ++i) { impA[lane + 64 * i] = 0.f; impB[lane + 64 * i] = 0.f; }
    if (lane < 32) msk[lane] = 0u;
    bf16x8 qf[4];
    { const bf16* qp = proj + (size_t)(b * T + tc) * PS + C_NQ + h * 64 + hh * 8;
#pragma unroll
      for (int s = 0; s < 4; ++s) qf[s] = *(const bf16x8*)(qp + s * 16); }
    const bf16* gatep = proj + (size_t)(b * T + tc) * PS + C_GT + h * 3;
#define NSA_GATE(i) sigmoidf_(bf2f(gatep[i]))
    float bnd[3];
    { const float gq = wave_max(fabsf(p.in[6][lane]));
#pragma unroll
      for (int i = 0; i < 3; ++i) bnd[i] = __uint_as_float((unsigned)__builtin_amdgcn_readfirstlane((int)__float_as_uint(8.0f * LOG2E * 1.02f * gq * wave_max(fabsf(p.in[7][i * 64 + lane]))))); }
    WAVE_LDS_SYNC();
    {
        const unsigned char* KC = p.ws + WS_KC + (size_t)(b * 2 + g) * 65536 + lane * 16;
        const unsigned char* VCT = p.ws + WS_VCT + (size_t)(b * 2 + g) * 65536 + lane * 16;
        const int nmax = (t0 + 7 >= 31) ? ((t0 + 7 - 31) >> 4) : -1;
        const int nlast = (nmax >= 0) ? (nmax & ~31) : -32;
        float l = 0.f;
        f32x16 o0, o1;
#pragma unroll
        for (int i = 0; i < 16; ++i) { o0[i] = 0.f; o1[i] = 0.f; }
        KF kn;
        if (nlast >= 0) load_k(kn, KC + (size_t)nlast * 128);
#pragma unroll 1
        for (int n0 = nlast; n0 >= 0; n0 -= 32) {
            const KF kc = kn;
            load_k(kn, KC + (size_t)(n0 >= 32 ? n0 - 32 : n0) * 128);
            __builtin_amdgcn_sched_barrier(0);
            const int distbase = tc - 16 * (n0 + 4 * hh) - 31;
            const f32x16 st = score_tile(kc, qf, 16.0f * slope, -slope * (float)distbase - bnd[0]);
            float ps = 0.f;
#pragma unroll
            for (int i = 0; i < 16; ++i) { const int dist = distbase - 16 * ((i & 3) + 8 * (i >> 2)); ps += (dist >= 0) ? __builtin_amdgcn_exp2f(st[i]) : 0.f; }
            l += ps;
        }
        l += __shfl_xor(l, 32);
        const float inv = (l > 0.f) ? 1.0f / l : 0.f;
        if (nlast >= 0) load_k(kn, KC + (size_t)nlast * 128);
#pragma unroll 1
        for (int n0 = nlast; n0 >= 0; n0 -= 32) {
            const KF kc = kn; VF vf;
            load_v(vf, VCT + (size_t)n0 * 128);
            load_k(kn, KC + (size_t)(n0 >= 32 ? n0 - 32 : n0) * 128);
            __builtin_amdgcn_sched_barrier(0);
            const int distbase = tc - 16 * (n0 + 4 * hh) - 31;
            const f32x16 st = score_tile(kc, qf, 16.0f * slope, -slope * (float)distbase - bnd[0]);
            float pv[16];
#pragma unroll
            for (int i = 0; i < 16; ++i) { const int dist = distbase - 16 * ((i & 3) + 8 * (i >> 2)); pv[i] = (dist >= 0) ? __builtin_amdgcn_exp2f(st[i]) * inv : 0.f; }
            pv_tile(o0, o1, vf, pv);
#pragma unroll
            for (int i = 0; i < 16; ++i) { float v = pv[i]; v += dpp_f<0xB1>(v); v += dpp_f<0x4E>(v); pv[i] = v; }
            if (r4 == 0) {
#pragma unroll
                for (int rg = 0; rg < 4; ++rg) {
                    const int jb = (n0 >> 2) + 2 * rg + hh;
                    impA[jt * 128 + jb] = pv[4 * rg] + 2.f * pv[4 * rg + 1] + 2.f * pv[4 * rg + 2] + 2.f * pv[4 * rg + 3];
                    if (jb >= 1) impB[jt * 128 + jb - 1] = pv[4 * rg];
                }
            }
        }
        { const float g0 = NSA_GATE(0);
#pragma unroll
        for (int i = 0; i < 16; ++i) { ocl[i * 64] = g0 * o0[i]; ocl[(16 + i) * 64] = g0 * o1[i]; } }
    }
    WAVE_LDS_SYNC();
    {
        const int lig = lane & 15, grp = lane >> 4;
#pragma unroll 1
        for (int half = 0; half < 2; ++half) {
            const int j2 = half * 4 + grp, cur = (t0 + j2) >> 6;
            float v[8];
#pragma unroll
            for (int e = 0; e < 8; ++e) {
                const int j = lig * 8 + e; const float val = impA[j2 * 128 + j] + impB[j2 * 128 + j];
                v[e] = (j >= 1 && j <= cur - 2) ? __uint_as_float((__float_as_uint(val) & ~127u) | (unsigned)(127 - j)) : -1.0f;
            }
            const float top = grp16_top16(v, lig);
            const int need = 16 - ((cur == 0) ? 1 : (cur == 1) ? 2 : 3);
            if (lig < need && top >= 0.f) { const int idx = 127 - (int)(__float_as_uint(top) & 127u); atomicOr(&msk[j2 * 4 + (idx >> 5)], 1u << (idx & 31)); }
            if (lig == 0) { atomicOr(&msk[j2 * 4], 1u); atomicOr(&msk[j2 * 4 + (cur >> 5)], 1u << (cur & 31)); if (cur >= 1) atomicOr(&msk[j2 * 4 + ((cur - 1) >> 5)], 1u << ((cur - 1) & 31)); }
        }
    }
    WAVE_LDS_SYNC();
    {
        int nblk = 0;
#pragma unroll
        for (int w = 3; w >= 0; --w) {
            unsigned u = 0u;
#pragma unroll
            for (int j = 0; j < 8; ++j) u |= msk[j * 4 + w];
            u = (unsigned)__builtin_amdgcn_readfirstlane((int)u);
            while (u) { const int bit = 31 - __builtin_clz(u); u &= ~(1u << bit); if (lane == 0) blist[nblk] = (unsigned char)(w * 32 + bit); ++nblk; }
        }
        WAVE_LDS_SYNC();
        const unsigned char* KS = p.ws + WS_KFS + (size_t)(b * 2 + g) * (256 * 4096) + lane * 16;
        const unsigned char* VTS = p.ws + WS_VTS + (size_t)(b * 2 + g) * (256 * 4096) + lane * 16;
        float l = 0.f;
        f32x16 o0, o1;
#pragma unroll
        for (int i = 0; i < 16; ++i) { o0[i] = 0.f; o1[i] = 0.f; }
        const int ntile = 2 * nblk;
        KF kn; VF vn;
        { const int jb0 = blist[0]; load_k(kn, KS + (size_t)(jb0 * 64 + 32) * 128); load_v(vn, VTS + (size_t)(jb0 * 64 + 32) * 128); }
#pragma unroll 1
        for (int ti = 0; ti < ntile; ++ti) {
            const int jb = __builtin_amdgcn_readfirstlane((int)blist[ti >> 1]);
            const int key0 = jb * 64 + 32 - 32 * (ti & 1);
            const KF kc = kn; const VF vf = vn;
            { const int tn = (ti + 1 < ntile) ? ti + 1 : ti; const int jn = __builtin_amdgcn_readfirstlane((int)blist[tn >> 1]); const size_t off = (size_t)(jn * 64 + 32 - 32 * (tn & 1)) * 128;
              load_k(kn, KS + off); load_v(vn, VTS + off); }
            __builtin_amdgcn_sched_barrier(0);
            const bool colsel = (msk[jt * 4 + (jb >> 5)] >> (jb & 31)) & 1u;
            const int distbase = tc - key0 - 4 * hh;
            if (key0 + 31 <= t0) attn_tile<true>(kc, vf, qf, slope, colsel ? -slope * (float)distbase - bnd[1] : -1e30f, distbase, true, 1 << 30, l, o0, o1);
            else attn_tile<false>(kc, vf, qf, slope, -slope * (float)distbase - bnd[1], distbase, colsel, 1 << 30, l, o0, o1);
        }
        l += __shfl_xor(l, 32);
        const float sc = (l > 0.f) ? NSA_GATE(1) / l : 0.f;
#pragma unroll
        for (int i = 0; i < 16; ++i) { ocl[i * 64] += sc * o0[i]; ocl[(16 + i) * 64] += sc * o1[i]; }
    }
    {
        const unsigned char* KW = p.ws + WS_KFW + (size_t)(b * 2 + g) * (256 * 4096) + lane * 16;
        const unsigned char* VTW = p.ws + WS_VTW + (size_t)(b * 2 + g) * (256 * 4096) + lane * 16;
        float l = 0.f;
        f32x16 o0, o1;
#pragma unroll
        for (int i = 0; i < 16; ++i) { o0[i] = 0.f; o1[i] = 0.f; }
        const int kstart = (t0 - 511 > 0 ? t0 - 511 : 0) & ~31, kfirst = t0 & ~31;
        KF kn;
        load_k(kn, KW + (size_t)kfirst * 128);
#pragma unroll 1
        for (int key0 = kfirst; key0 >= kstart; key0 -= 32) {
            const KF kc = kn; VF vf;
            load_v(vf, VTW + (size_t)key0 * 128);
            { const int kn0 = (key0 - 32 >= kstart) ? key0 - 32 : key0; load_k(kn, KW + (size_t)kn0 * 128); }
            __builtin_amdgcn_sched_barrier(0);
            const int distbase = tc - key0 - 4 * hh;
            if (key0 + 31 <= t0 && key0 >= t0 - 504) attn_tile<true>(kc, vf, qf, slope, -slope * (float)distbase - bnd[2], distbase, true, 512, l, o0, o1);
            else attn_tile<false>(kc, vf, qf, slope, -slope * (float)distbase - bnd[2], distbase, true, 512, l, o0, o1);
        }
        l += __shfl_xor(l, 32);
        const float sc = (l > 0.f) ? NSA_GATE(2) / l : 0.f;
#pragma unroll
        for (int i = 0; i < 16; ++i) { o0[i] = ocl[i * 64] + sc * o0[i]; o1[i] = ocl[(16 + i) * 64] + sc * o1[i]; }
        float ss = 0.f;
#pragma unroll
        for (int i = 0; i < 16; ++i) ss += o0[i] * o0[i] + o1[i] * o1[i];
        ss += __shfl_xor(ss, 32);
        const float r = rsqrtf(ss * (1.0f / 64.0f) + EPS);
        const float* og = p.in[11] + h * 64;
        bf16* op = (bf16*)(p.ws + WS_ACT) + (size_t)(b * T + tc) * D + 512 + h * 64;
#pragma unroll
        for (int dt = 0; dt < 2; ++dt)
#pragma unroll
            for (int rg = 0; rg < 4; ++rg) {
                const int d0 = dt * 32 + 8 * rg + 4 * hh;
                const f32x4 gg = *(const f32x4*)(og + d0);
                u32x2 w;
                if (dt == 0) { w.x = pk2(o0[4 * rg] * r * gg.x, o0[4 * rg + 1] * r * gg.y); w.y = pk2(o0[4 * rg + 2] * r * gg.z, o0[4 * rg + 3] * r * gg.w); }
                else { w.x = pk2(o1[4 * rg] * r * gg.x, o1[4 * rg + 1] * r * gg.y); w.y = pk2(o1[4 * rg + 2] * r * gg.z, o1[4 * rg + 3] * r * gg.w); }
                *(u32x2*)(op + d0) = w;
            }
    }
    WAVE_LDS_SYNC();
}
__device__ __forceinline__ void phase2(const Params& p, unsigned char* lds) {
    unsigned* ctr = (unsigned*)(p.ws + WS_CTR) + 2048;
    volatile int* slot = (volatile int*)(lds + LDS_BYTES - 32);
    for (;;) {
        if (threadIdx.x == 0) *slot = (int)atomicAdd(ctr, 1u);
        __syncthreads();
        const int it = *slot;
        __syncthreads();
        if (it >= 128 + 1024 + 256) break;
        if (it < 128) nsa_cmp_item(p, lds, it);
        else if (it < 1152) hgrn_pre_item(p, lds, it - 128);
        else { nsa_prep_item(p, lds, it - 1152); __syncthreads(); }
    }
}
template <bool SCAN>
__device__ __forceinline__ void phase3(const Params& p, unsigned char* lds) {
    const int wid = __builtin_amdgcn_readfirstlane((int)(threadIdx.x >> 6));
    if (SCAN && blockIdx.x < 32) hgrn_scan_block(p, lds, blockIdx.x);
    unsigned* ctr = (unsigned*)(p.ws + WS_CTR) + (SCAN ? 0 : 128);
    const int myx = (int)(xb_xcc_id() & 7u);
    for (;;) {
        int q = -1, it = 0;
        const int kmax = (wid == 0) ? 8 : 1;
        for (int k = 0; k < kmax; ++k) {
            const int x = (myx + k) & 7;
            int v = 0;
            if ((threadIdx.x & 63) == 0) v = (int)atomicAdd(ctr + x * 16, 1u);
            v = __builtin_amdgcn_readfirstlane(v);
            if (v < 512) { q = x; it = v; break; }
        }
        if (q < 0) break;
        const int item = ((q >> 1) << 10) | ((q & 1) * 512 + 511 - it);
        nsa_attn_item(p, lds + wid * 16640, item);
    }
}

__device__ __forceinline__ float dot2u(unsigned a, unsigned b, float acc) { return __builtin_amdgcn_fdot2_f32_bf16(__builtin_bit_cast(bf16x2v, a), __builtin_bit_cast(bf16x2v, b), acc, false); }
__device__ __forceinline__ float dot8(u32x4 a, u32x4 b, float acc) {
    const unsigned a0 = a.x, a1 = a.y, a2 = a.z, a3 = a.w, b0 = b.x, b1 = b.y, b2 = b.z, b3 = b.w;
    acc = dot2u(a0, b0, acc); acc = dot2u(a1, b1, acc); acc = dot2u(a2, b2, acc); acc = dot2u(a3, b3, acc);
    return acc;
}
__device__ __forceinline__ void axpy8(float (&o)[8], float c, u32x4 v) {
    o[0] += c * __uint_as_float(v.x << 16); o[1] += c * __uint_as_float(v.x & 0xffff0000u);
    o[2] += c * __uint_as_float(v.y << 16); o[3] += c * __uint_as_float(v.y & 0xffff0000u);
    o[4] += c * __uint_as_float(v.z << 16); o[5] += c * __uint_as_float(v.z & 0xffff0000u);
    o[6] += c * __uint_as_float(v.w << 16); o[7] += c * __uint_as_float(v.w & 0xffff0000u);
}
typedef float f32x2 __attribute__((ext_vector_type(2)));
__device__ __forceinline__ float dot16_fp8(u32x4 r, const float* xf) {
    const unsigned r0 = r.x, r1 = r.y, r2 = r.z, r3 = r.w; f32x2 acc = (f32x2){0.f, 0.f};
#define D16_STEP(rr, hi, k) acc = __builtin_elementwise_fma(__builtin_amdgcn_cvt_pk_f32_fp8((int)(rr), hi), (f32x2){xf[k], xf[(k) + 1]}, acc);
    D16_STEP(r0, false, 0) D16_STEP(r0, true, 2) D16_STEP(r1, false, 4) D16_STEP(r1, true, 6)
    D16_STEP(r2, false, 8) D16_STEP(r2, true, 10) D16_STEP(r3, false, 12) D16_STEP(r3, true, 14)
#undef D16_STEP
    return acc.x + acc.y;
}
__device__ __forceinline__ void axpy16_fp8(float* o, float c, u32x4 r) {
    const unsigned r0 = r.x, r1 = r.y, r2 = r.z, r3 = r.w; const f32x2 cc = (f32x2){c, c};
#define A16_STEP(rr, hi, k) { f32x2 a = (f32x2){o[k], o[(k) + 1]}; a = __builtin_elementwise_fma(__builtin_amdgcn_cvt_pk_f32_fp8((int)(rr), hi), cc, a); o[k] = a.x; o[(k) + 1] = a.y; }
    A16_STEP(r0, false, 0) A16_STEP(r0, true, 2) A16_STEP(r1, false, 4) A16_STEP(r1, true, 6)
    A16_STEP(r2, false, 8) A16_STEP(r2, true, 10) A16_STEP(r3, false, 12) A16_STEP(r3, true, 14)
#undef A16_STEP
}
template <bool DUMMY>
__device__ __forceinline__ void phase9(const Params& p, unsigned char* lds) {
    const bf16* HN = (const bf16*)(p.ws + WS_ACT); const unsigned char* UB = p.ws + WS_UB; const unsigned char* VB = p.ws + WS_VB;
    const float* US = (const float*)(p.ws + WS_US); const float* VS = (const float*)(p.ws + WS_VS);
    const int* ids = (const int*)(p.ws + WS_IDS); const float* wts = (const float*)(p.ws + WS_WTS);
    float* O = p.out; bf16* HG = (bf16*)(p.ws + WS_PROJ + 64 * MiB); const float* gn = p.in[19];
    const int lane = threadIdx.x & 63, gw = (blockIdx.x * NTHR + threadIdx.x) >> 6, ngw = (gridDim.x * NTHR) >> 6;
    for (int tok = gw; tok < NTOK; tok += ngw) {
        float xf[16], oa[16];
        {
            const u32x4 x0 = *(const u32x4*)(HN + (size_t)tok * D + lane * 16), x1 = *(const u32x4*)(HN + (size_t)tok * D + lane * 16 + 8);
            const unsigned a0 = x0.x, a1 = x0.y, a2 = x0.z, a3 = x0.w, b0 = x1.x, b1 = x1.y, b2 = x1.z, b3 = x1.w;
            xf[0] = __uint_as_float(a0 << 16); xf[1] = __uint_as_float(a0 & 0xffff0000u); xf[2] = __uint_as_float(a1 << 16); xf[3] = __uint_as_float(a1 & 0xffff0000u);
            xf[4] = __uint_as_float(a2 << 16); xf[5] = __uint_as_float(a2 & 0xffff0000u); xf[6] = __uint_as_float(a3 << 16); xf[7] = __uint_as_float(a3 & 0xffff0000u);
            xf[8] = __uint_as_float(b0 << 16); xf[9] = __uint_as_float(b0 & 0xffff0000u); xf[10] = __uint_as_float(b1 << 16); xf[11] = __uint_as_float(b1 & 0xffff0000u);
            xf[12] = __uint_as_float(b2 << 16); xf[13] = __uint_as_float(b2 & 0xffff0000u); xf[14] = __uint_as_float(b3 << 16); xf[15] = __uint_as_float(b3 & 0xffff0000u);
        }
#pragma unroll
        for (int j = 0; j < 16; ++j) oa[j] = 0.f;
#pragma unroll 1
        for (int half = 0; half < 2; ++half) {
            const int myid = ids[(size_t)tok * 128 + half * 64 + lane];
            const float myw = wts[(size_t)tok * 128 + half * 64 + lane] * VS[myid];
            const float myus = US[myid];
#pragma unroll 1
            for (int eb = 0; eb < 64; eb += 16) {
                int id[16]; float d[16]; u32x4 ur[16];
#pragma unroll
                for (int j = 0; j < 16; ++j) id[j] = __shfl(myid, eb + j);
#pragma unroll
                for (int j = 0; j < 16; ++j) ur[j] = *(const u32x4*)(UB + (size_t)id[j] * D + lane * 16);
#pragma unroll
                for (int j = 0; j < 16; ++j) d[j] = dot16_fp8(ur[j], xf);
#pragma unroll
                for (int j = 0; j < 16; ++j) ur[j] = *(const u32x4*)(VB + (size_t)id[j] * D + lane * 16);
#pragma unroll
                for (int j = 0; j < 16; ++j) d[j] = wave_sum(d[j]);
#pragma unroll
                for (int j = 0; j < 16; ++j) { const float c = __shfl(myw, eb + j) * gelu_tanh(d[j] * __shfl(myus, eb + j)); axpy16_fp8(oa, c, ur[j]); }
            }
        }
        float* orow = O + (size_t)tok * D + lane * 16; float* wrow = DUMMY ? (float*)(p.ws + WS_PROJ) + (size_t)tok * D + lane * 16 : orow;
        float ss = 0.f; f32x4 hv[4];
#pragma unroll
        for (int q = 0; q < 4; ++q) {
            f32x4 h = *(const f32x4*)(orow + 4 * q);
            h.x += oa[4 * q]; h.y += oa[4 * q + 1]; h.z += oa[4 * q + 2]; h.w += oa[4 * q + 3];
            *(f32x4*)(wrow + 4 * q) = h; hv[q] = h;
            ss += h.x * h.x + h.y * h.y + h.z * h.z + h.w * h.w;
        }
        ss = wave_sum(ss);
        const float r = rsqrtf(ss * (1.0f / D) + EPS);
        u32x4 q0, q1;
        { const f32x4 g0 = *(const f32x4*)(gn + lane * 16), g1 = *(const f32x4*)(gn + lane * 16 + 4), g2 = *(const f32x4*)(gn + lane * 16 + 8), g3 = *(const f32x4*)(gn + lane * 16 + 12);
          q0.x = pk2(hv[0].x * r * g0.x, hv[0].y * r * g0.y); q0.y = pk2(hv[0].z * r * g0.z, hv[0].w * r * g0.w); q0.z = pk2(hv[1].x * r * g1.x, hv[1].y * r * g1.y); q0.w = pk2(hv[1].z * r * g1.z, hv[1].w * r * g1.w);
          q1.x = pk2(hv[2].x * r * g2.x, hv[2].y * r * g2.y); q1.y = pk2(hv[2].z * r * g2.z, hv[2].w * r * g2.w); q1.z = pk2(hv[3].x * r * g3.x, hv[3].y * r * g3.y); q1.w = pk2(hv[3].z * r * g3.z, hv[3].w * r * g3.w); }
        *(u32x4*)(HG + (size_t)tok * D + lane * 16) = q0; *(u32x4*)(HG + (size_t)tok * D + lane * 16 + 8) = q1;
    }
}


__device__ __forceinline__ unsigned xb_xcc_id();
template <int CTRL> __device__ __forceinline__ float dpp_row_ror(float v) { return __int_as_float(__builtin_amdgcn_update_dpp(0, __float_as_int(v), CTRL, 0xF, 0xF, false)); }
__device__ __forceinline__ float grp8_sum(float v) { v += dpp_f<0xB1>(v); v += dpp_f<0x4E>(v); v += dpp_f<0x141>(v); return v; }
__device__ __forceinline__ int peer_next_item(unsigned* ctr, int myx, int& slice) {
    const int kmax = (__builtin_amdgcn_readfirstlane((int)(threadIdx.x >> 6)) == 0) ? 8 : 1;
    for (int k = 0; k < kmax; ++k) {
        const int x = (myx + k) & 7;
        int it = 0;
        if ((threadIdx.x & 63) == 0) it = (int)atomicAdd(ctr + x * 16, 1u);
        it = __builtin_amdgcn_readfirstlane(it);
        if (it < 1024) { slice = x; return it; }
    }
    return -1;
}
__device__ __forceinline__ void unpack16(const u32x4 x0, const u32x4 x1, float* xf) {
    const unsigned a0 = x0.x, a1 = x0.y, a2 = x0.z, a3 = x0.w, b0 = x1.x, b1 = x1.y, b2 = x1.z, b3 = x1.w;
    xf[0] = __uint_as_float(a0 << 16); xf[1] = __uint_as_float(a0 & 0xffff0000u); xf[2] = __uint_as_float(a1 << 16); xf[3] = __uint_as_float(a1 & 0xffff0000u);
    xf[4] = __uint_as_float(a2 << 16); xf[5] = __uint_as_float(a2 & 0xffff0000u); xf[6] = __uint_as_float(a3 << 16); xf[7] = __uint_as_float(a3 & 0xffff0000u);
    xf[8] = __uint_as_float(b0 << 16); xf[9] = __uint_as_float(b0 & 0xffff0000u); xf[10] = __uint_as_float(b1 << 16); xf[11] = __uint_as_float(b1 & 0xffff0000u);
    xf[12] = __uint_as_float(b2 << 16); xf[13] = __uint_as_float(b2 & 0xffff0000u); xf[14] = __uint_as_float(b3 << 16); xf[15] = __uint_as_float(b3 & 0xffff0000u);
}
__device__ __forceinline__ void unpack_ids(const u32x4 r, int* id) {
    const unsigned a = r.x, b = r.y, c = r.z, d = r.w;
    id[0] = a & 0xffff; id[1] = a >> 16; id[2] = b & 0xffff; id[3] = b >> 16; id[4] = c & 0xffff; id[5] = c >> 16; id[6] = d & 0xffff; id[7] = d >> 16;
}
__device__ __forceinline__ void phase9a(const Params& p, unsigned char* lds) {
    const bf16* HN = (const bf16*)(p.ws + WS_ACT); const unsigned char* UB = p.ws + WS_UB;
    const unsigned short* ids = (const unsigned short*)(p.ws + WS_IDS); float* PD = (float*)(p.ws + WS_PROJ);
    unsigned* ctr = (unsigned*)(p.ws + WS_CTR) + 256;
    const int lane = threadIdx.x & 63, gq = lane >> 3, cl = lane & 7, myx = (int)(xb_xcc_id() & 7u);
    for (;;) {
        int x; const int it = peer_next_item(ctr, myx, x);
        if (it < 0) break;
        const unsigned char* ub = UB + (size_t)x * (16384 * 128);
        const unsigned cofs = (unsigned)cl * 16u;
        const bf16* hn = HN + x * 128 + cl * 16;
        const int tokb = it * 16;
        const unsigned short* ip = ids + (size_t)tokb * 128 + gq * 8;
        int idn[8]; u32x4 bufA[8], bufB[8], xa0, xa1, xb0, xb1, idr;
        idr = *(const u32x4*)ip; unpack_ids(idr, idn);
#pragma unroll
        for (int i = 0; i < 8; ++i) bufA[i] = *(const u32x4*)(ub + (((unsigned)idn[i] << 7) | cofs));
        xa0 = *(const u32x4*)(hn + (size_t)tokb * D); xa1 = *(const u32x4*)(hn + (size_t)tokb * D + 8);
        idr = *(const u32x4*)(ip + 64); unpack_ids(idr, idn);
#pragma unroll
        for (int i = 0; i < 8; ++i) bufB[i] = *(const u32x4*)(ub + (((unsigned)idn[i] << 7) | cofs));
        xb0 = xa0; xb1 = xa1;
        idr = *(const u32x4*)(ip + 128);
#define P9A_STEP(buf, x0, x1, u) { const int u2_ = ((u) + 2 < 32) ? (u) + 2 : (u), u3_ = ((u) + 3 < 32) ? (u) + 3 : (u); \
            unpack_ids(idr, idn); idr = *(const u32x4*)(ip + u3_ * 64); \
            float xf[16]; unpack16(x0, x1, xf); \
            x0 = *(const u32x4*)(hn + (size_t)(tokb + (u2_ >> 1)) * D); x1 = *(const u32x4*)(hn + (size_t)(tokb + (u2_ >> 1)) * D + 8); \
            float keep = 0.f; \
            __builtin_amdgcn_sched_barrier(0); \
            _Pragma("unroll") for (int i = 0; i < 8; ++i) { const float d = grp8_sum(dot16_fp8(buf[i], xf)); if (i == cl) keep = d; buf[i] = *(const u32x4*)(ub + (((unsigned)idn[i] << 7) | cofs)); __builtin_amdgcn_sched_barrier(0); } \
            PD[((size_t)x * NTOK + tokb + ((u) >> 1)) * 128 + (((u) & 1) * 8 + cl) * 8 + gq] = keep; }
#pragma unroll 1
        for (int u = 0; u < 32; u += 2) {
            P9A_STEP(bufA, xa0, xa1, u)
            P9A_STEP(bufB, xb0, xb1, u + 1)
        }
#undef P9A_STEP
    }
}
__device__ __forceinline__ void phase9c(const Params& p, unsigned char* lds) {
    const unsigned short* ids = (const unsigned short*)(p.ws + WS_IDS); const float* wts = (const float*)(p.ws + WS_WTS); const float* PD = (const float*)(p.ws + WS_PROJ);
    const float* US = (const float*)(p.ws + WS_US); const float* VS = (const float*)(p.ws + WS_VS); float* coefT = (float*)(p.ws + WS_COEFT);
    const size_t gtid = (size_t)blockIdx.x * NTHR + threadIdx.x, gth = (size_t)gridDim.x * NTHR;
    for (size_t idx = gtid; idx < (size_t)NTOK * 128; idx += gth) {
        const size_t tok = idx >> 7; const int r = (int)(idx & 127), e = (r & 64) + (r & 7) * 8 + ((r >> 3) & 7);
        float sdot = 0.f;
#pragma unroll
        for (int x = 0; x < 8; ++x) sdot += PD[(size_t)x * NTOK * 128 + tok * 128 + e];
        const int id = ids[idx];
        coefT[idx] = wts[tok * 128 + e] * VS[id] * gelu_tanh(sdot * US[id]);
    }
}
__device__ __forceinline__ void phase9b(const Params& p, unsigned char* lds) {
    const unsigned char* VB = p.ws + WS_VB; const unsigned short* ids = (const unsigned short*)(p.ws + WS_IDS); const float* coef = (const float*)(p.ws + WS_COEFT);
    float* O = p.out; bf16* HG = (bf16*)(p.ws + WS_PROJ + 64 * MiB); const float* gn = p.in[19]; float* SSQ = (float*)(p.ws + WS_SSQ);
    unsigned* ctr = (unsigned*)(p.ws + WS_CTR) + 512;
    const int lane = threadIdx.x & 63, gq = lane >> 3, cl = lane & 7, myx = (int)(xb_xcc_id() & 7u);
    for (;;) {
        int x; const int it = peer_next_item(ctr, myx, x);
        if (it < 0) break;
        const unsigned char* vb = VB + (size_t)x * (16384 * 128);
        const unsigned cofs = (unsigned)cl * 16u;
        const int tokb = it * 16;
        const unsigned short* ip = ids + (size_t)tokb * 128 + gq * 8;
        const float* cp = coef + (size_t)tokb * 128 + gq * 8;
        int idn[8]; u32x4 buf[8], idr; f32x4 cf0, cf1, cn0, cn1; float acc[16];
#pragma unroll
        for (int j = 0; j < 16; ++j) acc[j] = 0.f;
        idr = *(const u32x4*)ip; unpack_ids(idr, idn);
        cf0 = *(const f32x4*)cp; cf1 = *(const f32x4*)(cp + 4);
#pragma unroll
        for (int i = 0; i < 8; ++i) buf[i] = *(const u32x4*)(vb + (((unsigned)idn[i] << 7) | cofs));
        idr = *(const u32x4*)(ip + 64); cn0 = *(const f32x4*)(cp + 64); cn1 = *(const f32x4*)(cp + 68);
#pragma unroll 1
        for (int u = 0; u < 32; ++u) {
            const int u2 = (u + 2 < 32) ? u + 2 : u;
            unpack_ids(idr, idn);
            const f32x4 c0 = cf0, c1 = cf1; cf0 = cn0; cf1 = cn1;
            idr = *(const u32x4*)(ip + u2 * 64); cn0 = *(const f32x4*)(cp + u2 * 64); cn1 = *(const f32x4*)(cp + u2 * 64 + 4);
            const float cfv[8] = {c0.x, c0.y, c0.z, c0.w, c1.x, c1.y, c1.z, c1.w};
            __builtin_amdgcn_sched_barrier(0);
#pragma unroll
            for (int i = 0; i < 8; ++i) { axpy16_fp8(acc, cfv[i], buf[i]); buf[i] = *(const u32x4*)(vb + (((unsigned)idn[i] << 7) | cofs)); __builtin_amdgcn_sched_barrier(0); }
            if (u & 1) {
                const int tok = tokb + (u >> 1);
#pragma unroll
                for (int j = 0; j < 16; ++j) { float v = acc[j]; v += __shfl_xor(v, 8); v += __shfl_xor(v, 16); v += __shfl_xor(v, 32); acc[j] = v; }
                float ss = 0.f;
                if (gq == 0) {
                    float* orow = O + (size_t)tok * D + x * 128 + cl * 16; const float* gr = gn + x * 128 + cl * 16; u32x4 q0, q1; unsigned qq[8];
#pragma unroll
                    for (int q = 0; q < 4; ++q) {
                        f32x4 hv = *(const f32x4*)(orow + 4 * q); const f32x4 gg = *(const f32x4*)(gr + 4 * q);
                        hv.x += acc[4 * q]; hv.y += acc[4 * q + 1]; hv.z += acc[4 * q + 2]; hv.w += acc[4 * q + 3];
                        *(f32x4*)(orow + 4 * q) = hv;
                        ss += hv.x * hv.x + hv.y * hv.y + hv.z * hv.z + hv.w * hv.w;
                        qq[2 * q] = pk2(hv.x * gg.x, hv.y * gg.y); qq[2 * q + 1] = pk2(hv.z * gg.z, hv.w * gg.w);
                    }
                    q0.x = qq[0]; q0.y = qq[1]; q0.z = qq[2]; q0.w = qq[3]; q1.x = qq[4]; q1.y = qq[5]; q1.z = qq[6]; q1.w = qq[7];
                    *(u32x4*)(HG + (size_t)tok * D + x * 128 + cl * 16) = q0; *(u32x4*)(HG + (size_t)tok * D + x * 128 + cl * 16 + 8) = q1;
                }
                ss = grp8_sum(ss);
                if (lane == 0) SSQ[(size_t)x * NTOK + tok] = ss;
#pragma unroll
                for (int j = 0; j < 16; ++j) acc[j] = 0.f;
            }
        }
    }
}

#define XB_TMO      128
#define XB_XCNT(j)  (256  + 64 * (j))
#define XB_XSUB(j)  (1280 + 64 * (j))
#define XB_XGEN(j)  (2304 + 64 * (j))
#define XB_TOP      3328
#define XB_TOPGEN   3392
#define XCD_BAR_WORDS 3456
#define XB_SPIN_CAP (1u << 18)
#define LAS __attribute__((address_space(3)))
__device__ __forceinline__ unsigned xb_ld(unsigned* p)              { return __hip_atomic_load(p, __ATOMIC_RELAXED, __HIP_MEMORY_SCOPE_AGENT); }
__device__ __forceinline__ unsigned xb_add(unsigned* p, unsigned v) { return __hip_atomic_fetch_add(p, v, __ATOMIC_RELAXED, __HIP_MEMORY_SCOPE_AGENT); }
__device__ __forceinline__ unsigned xb_xcc_id() { return (unsigned)__builtin_amdgcn_s_getreg((3 << 11) | 20) & 0xFu; }
#define XB_SPIN(cond, bar) do { unsigned _sp = 0; while (cond) { __builtin_amdgcn_s_sleep(1); \
    if ((++_sp & 255u) == 0u) { if (xb_ld(&(bar)[XB_TMO])) break; if (_sp > XB_SPIN_CAP) { atomicAdd(&(bar)[XB_TMO], 1u); break; } } } } while (0)
struct XcdBarrier { unsigned* bar; unsigned x; volatile LAS unsigned* st; };
__device__ __forceinline__ XcdBarrier xcd_barrier_post(unsigned* bar, volatile LAS unsigned* st) {
    XcdBarrier b; b.bar = bar; b.x = xb_xcc_id(); b.st = st;
    if (threadIdx.x == 0) (void)xb_add(&bar[XB_XCNT(b.x)], 1u);
    return b;
}
__device__ __forceinline__ void xcd_barrier_complete(unsigned* bar, unsigned x, unsigned& nloc, unsigned& nx) {
    const unsigned G = gridDim.x * gridDim.y * gridDim.z;
    unsigned sum, cnt, mine, sp = 0u;
    for (;;) {
        sum = 0u; cnt = 0u; mine = 0u;
#pragma unroll
        for (unsigned j = 0; j < 16; ++j) { const unsigned c = xb_ld(&bar[XB_XCNT(j)]); sum += c; cnt += (c > 0u) ? 1u : 0u; mine = (j == x) ? c : mine; }
        if (sum == G) break;
        __builtin_amdgcn_s_sleep(1);
        if ((++sp & 255u) == 0u) { if (xb_ld(&bar[XB_TMO])) break; if (sp > XB_SPIN_CAP) { atomicAdd(&bar[XB_TMO], 1u); break; } }
    }
    nloc = mine > 0u ? mine : 1u; nx = cnt > 0u ? cnt : 1u;
}
__device__ __forceinline__ void xcd_barrier(const XcdBarrier& b) {
    asm volatile("s_waitcnt vmcnt(0)" ::: "memory");
    __syncthreads();
    if (threadIdx.x == 0) {
        unsigned* bar = b.bar;
        __builtin_amdgcn_s_waitcnt(0);
        unsigned nloc = b.st[0], nx = b.st[1];
        if (nloc == 0u) { xcd_barrier_complete(bar, b.x, nloc, nx); b.st[0] = nloc; b.st[1] = nx; }
        const unsigned old = xb_add(&bar[XB_XSUB(b.x)], 1u);
        const unsigned gen = old / nloc;
        if (old + 1u == (gen + 1u) * nloc) {
            __builtin_amdgcn_fence(__ATOMIC_RELEASE, "agent");
            asm volatile("s_waitcnt vmcnt(0)" ::: "memory");
            const unsigned og = xb_add(&bar[XB_TOP], 1u);
            const unsigned tg = og / nx;
            if (og + 1u == (tg + 1u) * nx) xb_add(&bar[XB_TOPGEN], 1u);
            else XB_SPIN(xb_ld(&bar[XB_TOPGEN]) == tg, bar);
            __builtin_amdgcn_fence(__ATOMIC_ACQUIRE, "agent");
            xb_add(&bar[XB_XGEN(b.x)], 1u);
            asm volatile("s_waitcnt vmcnt(0)" ::: "memory");
        } else {
            XB_SPIN(xb_ld(&bar[XB_XGEN(b.x)]) == gen, bar);
            __builtin_amdgcn_fence(__ATOMIC_ACQUIRE, "agent");
            asm volatile("s_waitcnt vmcnt(0)" ::: "memory");
        }
    }
    __syncthreads();
}

constexpr int REPK = -1;
__global__ void __launch_bounds__(NTHR, 2) mega(Params p, int ph_lo, int ph_hi) {
    extern __shared__ __attribute__((aligned(16))) unsigned char lds[];
    volatile LAS unsigned* st = (volatile LAS unsigned*)(LAS unsigned char*)(lds + LDS_BYTES - 16);
    if (threadIdx.x < 4) st[threadIdx.x] = 0u;
    __syncthreads();
    const XcdBarrier bar = xcd_barrier_post((unsigned*)p.ws, st);
#define RUN_PHASE(k, call) if (ph_lo <= (k) && (k) < ph_hi) { if ((k) > ph_lo) xcd_barrier(bar); call; if (REPK == (k)) { xcd_barrier(bar); call; } }
    RUN_PHASE(0, phase0(p, lds))
    RUN_PHASE(1, phase1(p, lds))
    RUN_PHASE(2, phase2(p, lds))
    if (REPK == 30) { xcd_barrier(bar); if ((threadIdx.x >> 6) == 0 && blockIdx.x < 64) hgrn_scan_item<true>(p, blockIdx.x); }
    if (ph_lo <= 3 && 3 < ph_hi) { if (3 > ph_lo) xcd_barrier(bar); phase3<true>(p, lds); if (REPK == 3) { xcd_barrier(bar); phase3<false>(p, lds); } }
    RUN_PHASE(4, phase4(p, lds))
    RUN_PHASE(5, phase5(p, lds))
    RUN_PHASE(6, phase6(p, lds))
    RUN_PHASE(7, phase7(p, lds))
    RUN_PHASE(8, phase8(p, lds))
    if (ph_lo <= 9 && 9 < ph_hi) { if (9 > ph_lo) xcd_barrier(bar); phase9a(p, lds); }
    if (ph_lo <= 9 && 9 < ph_hi) { xcd_barrier(bar); phase9c(p, lds); }
    if (ph_lo <= 9 && 9 < ph_hi) { xcd_barrier(bar); phase9b(p, lds); }
    RUN_PHASE(10, phase10(p, lds))
}

static void launch_mega(const Params& p, int lo, int hi, hipStream_t stream) {
    static int grid = 0;
    if (grid == 0) {
        int dev = 0, cus = 0, per_cu = 0;
        hipGetDevice(&dev); hipDeviceGetAttribute(&cus, hipDeviceAttributeMultiprocessorCount, dev);
        hipFuncSetAttribute((const void*)mega, hipFuncAttributeMaxDynamicSharedMemorySize, LDS_BYTES);
        hipOccupancyMaxActiveBlocksPerMultiprocessor(&per_cu, (const void*)mega, NTHR, LDS_BYTES);
        if (per_cu < 1) { fprintf(stderr, "mega: occupancy query says %d blocks/CU\n", per_cu); per_cu = 1; }
        grid = cus;
    }
    hipMemsetAsync(p.ws, 0, 65536, stream);
    Params pp = p; int l = lo, h = hi;
    void* args[] = {&pp, &l, &h};
    hipError_t e = hipLaunchCooperativeKernel((const void*)mega, dim3(grid), dim3(NTHR), args, LDS_BYTES, stream);
    if (e != hipSuccess) fprintf(stderr, "cooperative launch failed: %s (grid %d)\n", hipGetErrorString(e), grid);
}

extern "C" void kernel_launch(void* const* d_in, const int* in_sizes, int n_in, void* d_out, int out_size, void* d_ws, size_t ws_size, hipStream_t stream) {
    float* out = (float*)d_out; unsigned char* ws = (unsigned char*)d_ws;
    Params prm{}; for (int i = 0; i < 21; ++i) prm.in[i] = (const float*)d_in[i]; prm.out = out; prm.ws = ws;
    launch_mega(prm, 0, 11, stream);
}
```

```cpp
#include <hip/hip_runtime.h>
#include <hip/hip_cooperative_groups.h>
#include <cstdint>
#include <cstdio>
namespace cg = cooperative_groups;

constexpr int D = 1024, NB = 2, T = 8192, NTOK = NB * T;
constexpr int DIN = 3352, PS = 3392;
constexpr int C_HQ = 0, C_HF = 512, C_HI = 1024, C_HG = 1536, C_NQ = 2048, C_KC = 2560, C_VC = 2688,
              C_KS = 2816, C_VS = 2944, C_KW = 3072, C_VW = 3200, C_GT = 3328;
constexpr int NCMP = 511;
constexpr float EPS = 1e-6f;
typedef unsigned short bf16;

constexpr size_t MiB = 1u << 20;
constexpr size_t WS_WINT = 1 * MiB;
constexpr size_t WS_WOUTT = 8 * MiB;
constexpr size_t WS_WQT = 10 * MiB;
constexpr size_t WS_WGT = 14 * MiB;
constexpr size_t WS_WPT = 16 * MiB;
constexpr size_t WS_KEYB = 16 * MiB + 512 * 1024;
constexpr size_t WS_W1T = 17 * MiB;
constexpr size_t WS_CTR = 16384;
constexpr size_t WS_SSQ = 512 * 1024;
constexpr size_t WS_US = 256 * 1024;
constexpr size_t WS_VS = 320 * 1024;
constexpr size_t WS_UB = 18 * MiB;
constexpr size_t WS_VB = 50 * MiB;
constexpr size_t WS_ACT = 82 * MiB;
constexpr size_t WS_PROJ = 114 * MiB;
constexpr size_t WS_SPARE = 220 * MiB;
constexpr size_t WS_IDS = WS_SPARE;
constexpr size_t WS_WTS = WS_SPARE + 8 * MiB;
constexpr size_t WS_KCF = WS_SPARE + 16 * MiB;
constexpr size_t WS_VCF = WS_SPARE + 17 * MiB;
constexpr size_t WS_PB = WS_SPARE + 18 * MiB;
constexpr size_t WS_VTS = WS_SPARE + 26 * MiB;
constexpr size_t WS_VTW = WS_SPARE + 30 * MiB;
constexpr size_t WS_COEFT = WS_SPARE + 26 * MiB;
constexpr size_t WS_KFS = WS_SPARE;
constexpr size_t WS_KFW = WS_SPARE + 4 * MiB;
constexpr size_t WS_KC = WS_SPARE + 34 * MiB;
constexpr size_t WS_VCT = WS_SPARE + 34 * MiB + 256 * 1024;
constexpr size_t WS_DEC = WS_SPARE + 34 * MiB + 512 * 1024;
constexpr size_t OUT_KIT = 32 * MiB;
constexpr size_t OUT_VT = 48 * MiB;
constexpr size_t WS_GL = 18 * MiB;

__device__ __forceinline__ float bf2f(bf16 v) { return __uint_as_float(((unsigned)v) << 16); }
__device__ __forceinline__ bf16 f2bf(float f) { return __builtin_bit_cast(bf16, (__bf16)f); }
__device__ __forceinline__ float wave_sum(float v) {
#pragma unroll
    for (int o = 1; o < 64; o <<= 1) v += __shfl_xor(v, o);
    return v;
}
__device__ __forceinline__ float wave_max(float v) {
#pragma unroll
    for (int o = 1; o < 64; o <<= 1) v = fmaxf(v, __shfl_xor(v, o));
    return v;
}
__device__ __forceinline__ float sigmoidf_(float x) { return 1.0f / (1.0f + __expf(-x)); }
__device__ __forceinline__ float siluf_(float x) { return x * sigmoidf_(x); }
__device__ __forceinline__ float gelu_tanh(float x) { return 0.5f * x * (1.0f + tanhf(0.7978845608028654f * (x + 0.044715f * x * x * x))); }
__device__ __forceinline__ float toF(float v) { return v; }
__device__ __forceinline__ float toF(bf16 v) { return bf2f(v); }

typedef short bf16x8 __attribute__((ext_vector_type(8)));
typedef float f32x4 __attribute__((ext_vector_type(4)));
typedef float f32x16 __attribute__((ext_vector_type(16)));
typedef unsigned u32x4 __attribute__((ext_vector_type(4)));
typedef unsigned u32x2 __attribute__((ext_vector_type(2)));
constexpr int NTHR = 512;
constexpr int LDS_BYTES = 143360 + 16;
struct Params { const float* in[21]; float* out; unsigned char* ws; };
__device__ __forceinline__ unsigned xb_xcc_id();

typedef __bf16 bf16x2c __attribute__((ext_vector_type(2)));
__device__ __forceinline__ unsigned pk2(float lo, float hi) { bf16x2c v = { (__bf16)lo, (__bf16)hi }; return __builtin_bit_cast(unsigned, v); }

__device__ __forceinline__ void transpose_tile(const float* __restrict__ W, int K, int N, bf16* __restrict__ Wt, int kt, int nt, float* tile) {
    const int tid = threadIdx.x, k0 = kt * 64, n0 = nt * 64;
#pragma unroll
    for (int i = 0; i < 8; ++i) { const int idx = tid + i * NTHR, kk = idx >> 6, nn = idx & 63; tile[kk * 65 + nn] = (n0 + nn < N) ? W[(size_t)(k0 + kk) * N + n0 + nn] : 0.f; }
    __syncthreads();
    { const int nn = tid >> 3, ch = tid & 7; const float* s = tile + (ch * 8) * 65 + nn;
      u32x4 o; o.x = pk2(s[0], s[65]); o.y = pk2(s[130], s[195]); o.z = pk2(s[260], s[325]); o.w = pk2(s[390], s[455]);
      *(u32x4*)(Wt + (size_t)(n0 + nn) * K + k0 + ch * 8) = o; }
    __syncthreads();
}
__device__ __forceinline__ void cvt_range(const float* __restrict__ src, bf16* __restrict__ dst, size_t n8, size_t gtid, size_t gthreads) {
    for (size_t i = gtid; i < n8; i += gthreads) {
        const f32x4 a = ((const f32x4*)src)[2 * i], b = ((const f32x4*)src)[2 * i + 1];
        u32x4 o; o.x = pk2(a.x, a.y); o.y = pk2(a.z, a.w); o.z = pk2(b.x, b.y); o.w = pk2(b.z, b.w);
        ((u32x4*)dst)[i] = o;
    }
}
__device__ __forceinline__ void rms_row_bf16(const float* __restrict__ xr, const float* __restrict__ g, bf16* __restrict__ orow, int lane) {
    f32x4 v[4]; float s = 0.f;
#pragma unroll
    for (int j = 0; j < 4; ++j) { v[j] = ((const f32x4*)xr)[lane + 64 * j]; s += v[j].x * v[j].x + v[j].y * v[j].y + v[j].z * v[j].z + v[j].w * v[j].w; }
    s = wave_sum(s);
    const float r = rsqrtf(s * (1.0f / D) + EPS);
#pragma unroll
    for (int j = 0; j < 4; ++j) { const f32x4 gg = ((const f32x4*)g)[lane + 64 * j]; u32x2 o; o.x = pk2(v[j].x * r * gg.x, v[j].y * r * gg.y); o.y = pk2(v[j].z * r * gg.z, v[j].w * r * gg.w); ((u32x2*)orow)[lane + 64 * j] = o; }
}

__device__ __forceinline__ void phase0(const Params& p, unsigned char* lds) {
    float* tile = (float*)lds;
    const int nblk = gridDim.x, blk = blockIdx.x;
    unsigned char* ws = p.ws;
    constexpr int I_WIN = 16 * 56, I_WOUT = 16 * 16, I_WQ = 16 * 32, I_WG = 16 * 16, I_WP = 4 * 16, I_W1 = 2 * 32;
    constexpr int NIT = I_WIN + I_WOUT + I_WQ + I_WG + I_WP + I_W1;
    for (int it = blk; it < NIT; it += nblk) {
        int r = it;
        if (r < I_WIN) { transpose_tile(p.in[3], 1024, DIN, (bf16*)(ws + WS_WINT), r / 56, r % 56, tile); continue; } r -= I_WIN;
        if (r < I_WOUT) { transpose_tile(p.in[12], 1024, 1024, (bf16*)(ws + WS_WOUTT), r / 16, r % 16, tile); continue; } r -= I_WOUT;
        if (r < I_WQ) { transpose_tile(p.in[14], 1024, 2048, (bf16*)(ws + WS_WQT), r / 32, r % 32, tile); continue; } r -= I_WQ;
        if (r < I_WG) { transpose_tile(p.in[20], 1024, 1024, (bf16*)(ws + WS_WGT), r / 16, r % 16, tile); continue; } r -= I_WG;
        if (r < I_WP) { transpose_tile(p.in[18], 256, 1024, (bf16*)(ws + WS_WPT), r / 16, r % 16, tile); continue; } r -= I_WP;
        { const int which = r / 32, kt = r % 32; transpose_tile(p.in[9] + (size_t)which * 2048 * 64, 2048, 64, (bf16*)(ws + WS_W1T) + (size_t)which * 64 * 2048, kt, 0, tile); }
    }
    const size_t gtid = (size_t)blk * NTHR + threadIdx.x, gthreads = (size_t)nblk * NTHR;
    for (size_t i = gtid; i < (size_t)8 * 2 * 128 * 16; i += gthreads) {
        const int dch = (int)(i & 15), key = (int)((i >> 4) & 127), hc = (int)(i >> 11);
        const float* src = p.in[15] + ((size_t)hc * 128 + key) * 128 + dch * 8;
        const f32x4 a = *(const f32x4*)src, b = *(const f32x4*)(src + 4);
        u32x4 o; o.x = pk2(a.x, a.y); o.y = pk2(a.z, a.w); o.z = pk2(b.x, b.y); o.w = pk2(b.z, b.w);
        *(u32x4*)((bf16*)(ws + WS_KEYB) + ((((size_t)hc * 4 + (key >> 5)) * 8 + (dch >> 1)) * 64 + (key & 31) + 32 * (dch & 1)) * 8) = o;
    }
    cvt_range(p.in[1], (bf16*)(ws + WS_PB), (size_t)NTOK * 256 / 8, gtid, gthreads);
    const int gw = (int)(gtid >> 6), ngw = (int)(gthreads >> 6), lane = threadIdx.x & 63;
    for (int m = gw; m < NTOK; m += ngw) rms_row_bf16(p.in[0] + (size_t)m * D, p.in[2], (bf16*)(ws + WS_ACT) + (size_t)m * D, lane);
    for (int m = gw; m < 2 * 16384; m += ngw) {
        const int which = m >> 14, row = m & 16383;
        const float* src = p.in[16 + which] + (size_t)row * D + lane * 16;
        const f32x4 a = *(const f32x4*)src, b = *(const f32x4*)(src + 4), c = *(const f32x4*)(src + 8), d = *(const f32x4*)(src + 12);
        float mx = fmaxf(fmaxf(fmaxf(fabsf(a.x), fabsf(a.y)), fmaxf(fabsf(a.z), fabsf(a.w))), fmaxf(fmaxf(fabsf(b.x), fabsf(b.y)), fmaxf(fabsf(b.z), fabsf(b.w))));
        mx = fmaxf(mx, fmaxf(fmaxf(fmaxf(fabsf(c.x), fabsf(c.y)), fmaxf(fabsf(c.z), fabsf(c.w))), fmaxf(fmaxf(fabsf(d.x), fabsf(d.y)), fmaxf(fabsf(d.z), fabsf(d.w)))));
        mx = fmaxf(wave_max(mx), 1e-30f);
        const float sc = 224.0f / mx;
        u32x4 o; int w;
        w = __builtin_amdgcn_cvt_pk_fp8_f32(a.x * sc, a.y * sc, 0, false); w = __builtin_amdgcn_cvt_pk_fp8_f32(a.z * sc, a.w * sc, w, true); o.x = (unsigned)w;
        w = __builtin_amdgcn_cvt_pk_fp8_f32(b.x * sc, b.y * sc, 0, false); w = __builtin_amdgcn_cvt_pk_fp8_f32(b.z * sc, b.w * sc, w, true); o.y = (unsigned)w;
        w = __builtin_amdgcn_cvt_pk_fp8_f32(c.x * sc, c.y * sc, 0, false); w = __builtin_amdgcn_cvt_pk_fp8_f32(c.z * sc, c.w * sc, w, true); o.z = (unsigned)w;
        w = __builtin_amdgcn_cvt_pk_fp8_f32(d.x * sc, d.y * sc, 0, false); w = __builtin_amdgcn_cvt_pk_fp8_f32(d.z * sc, d.w * sc, w, true); o.w = (unsigned)w;
        *(u32x4*)(ws + (which ? WS_VB : WS_UB) + (size_t)(lane >> 3) * (16384 * 128) + (size_t)row * 128 + (lane & 7) * 16) = o;
        if (lane == 0) ((float*)(ws + (which ? WS_VS : WS_US)))[row] = mx * (1.0f / 224.0f);
    }
}

__device__ __forceinline__ int swz(int ob) { return ob ^ (((ob >> 9) & 1) << 5); }
constexpr int G_STAGE = 49152;
__device__ __forceinline__ void gemm_mainloop(f32x4 (&acc)[4][4], const bf16* __restrict__ A, int lda, const bf16* __restrict__ Bt, int ldb, int K, int m0, int n0, unsigned char* lds) {
    const int tid = threadIdx.x, lane = tid & 63, wid = tid >> 6, wm = wid >> 1, wn = wid & 1, fr = lane & 15, fq = lane >> 4;
    const int lrow = tid >> 3, lc = tid & 7;
    const bf16* ag = A + (size_t)(m0 + lrow) * lda + lc * 8;
    const bf16* bg = Bt + (size_t)(n0 + lrow) * ldb + lc * 8;
    const int woff = ((lrow >> 4) * 2 + (lc >> 2)) * 1024 + swz((lrow & 15) * 64 + (lc & 3) * 16);
    const int roff = swz(fr * 64 + fq * 16);
    const int nk = K >> 6;
    u32x4 ra0[4], rb0[2], ra1[4], rb1[2];
#define GM_LOAD(ra, rb, kt) { _Pragma("unroll") for (int i = 0; i < 4; ++i) ra[i] = *(const u32x4*)(ag + (size_t)i * 64 * lda + (kt) * 64); \
                              _Pragma("unroll") for (int i = 0; i < 2; ++i) rb[i] = *(const u32x4*)(bg + (size_t)i * 64 * ldb + (kt) * 64); }
#define GM_STORE(ra, rb, buf) { _Pragma("unroll") for (int i = 0; i < 4; ++i) *(u32x4*)((buf) + woff + i * 8192) = ra[i]; \
                                _Pragma("unroll") for (int i = 0; i < 2; ++i) *(u32x4*)((buf) + 32768 + woff + i * 8192) = rb[i]; }
#define GM_COMPUTE(cur) { _Pragma("unroll") for (int s = 0; s < 2; ++s) { bf16x8 af[4], bfr[4]; \
        _Pragma("unroll") for (int i = 0; i < 4; ++i) af[i] = *(const bf16x8*)((cur) + ((wm * 4 + i) * 2 + s) * 1024 + roff); \
        _Pragma("unroll") for (int i = 0; i < 4; ++i) bfr[i] = *(const bf16x8*)((cur) + 32768 + ((wn * 4 + i) * 2 + s) * 1024 + roff); \
        _Pragma("unroll") for (int mi = 0; mi < 4; ++mi) _Pragma("unroll") for (int ni = 0; ni < 4; ++ni) acc[mi][ni] = __builtin_amdgcn_mfma_f32_16x16x32_bf16(bfr[ni], af[mi], acc[mi][ni], 0, 0, 0); } }
    unsigned char* buf0 = lds; unsigned char* buf1 = lds + G_STAGE;
    GM_LOAD(ra0, rb0, 0)
    GM_LOAD(ra1, rb1, 1)
    GM_STORE(ra0, rb0, buf0)
    __syncthreads();
    for (int kt = 0; kt < nk; kt += 2) {
        { const int kp = (kt + 2 < nk) ? kt + 2 : kt; GM_LOAD(ra0, rb0, kp) }
        GM_COMPUTE(buf0)
        GM_STORE(ra1, rb1, buf1)
        __syncthreads();
        { const int kp = (kt + 3 < nk) ? kt + 3 : kt + 1; GM_LOAD(ra1, rb1, kp) }
        GM_COMPUTE(buf1)
        if (kt + 2 < nk) GM_STORE(ra0, rb0, buf0)
        __syncthreads();
    }
}
__device__ __forceinline__ void acc_zero(f32x4 (&acc)[4][4]) {
#pragma unroll
    for (int i = 0; i < 4; ++i)
#pragma unroll
        for (int j = 0; j < 4; ++j) acc[i][j] = (f32x4){0.f, 0.f, 0.f, 0.f};
}
namespace pg8 {
#define PG8_LAS __attribute__((address_space(3)))
typedef unsigned short bf16_t;
typedef short bf16x8 __attribute__((ext_vector_type(8)));
typedef float f32x4 __attribute__((ext_vector_type(4)));
typedef unsigned u32x4 __attribute__((ext_vector_type(4)));
constexpr int BM = 256, BK = 64, HALF = 128, HTB = HALF * BK * 2  , STAGE_BYTES = 8 * HTB, NXCD = 8, WGM = 8;

__host__ __device__ __forceinline__ int lds_byte(int r, int c) { const int st = (r >> 4) * 2 + (c >> 5), rr = r & 15, cc = c & 31, ob = rr * 64 + cc * 2; return st * 1024 + (ob ^ (((ob >> 9) & 1) << 5)); }
__host__ __device__ __forceinline__ void stage_rc(int b, int& R, int& C) { const int st = b / 1024, sb = b % 1024, swz = sb ^ (((sb >> 9) & 1) << 5); R = (st >> 1) * 16 + swz / 64; C = (st & 1) * 32 + (swz % 64) / 2; }
__host__ __device__ __forceinline__ int perm32(int rho) { const int n = rho >> 4, i = rho & 15; return 8 * (i >> 2) + 4 * n + (i & 3); }

struct Unit { int pm, pn; };
struct Gemm { const bf16_t* A; const bf16_t* Bt; int M, N, K; };

struct StaticOrder {
    int nM, nN, nwg, G, c;
    __host__ __device__ void init(int M, int N, int G_, int c_) { nM = M / BM; nN = N / BM; nwg = nM * nN; G = G_; c = c_; }
    __host__ __device__ bool next(int i, Unit& u) const {
        const long L = (long)i * G + c; if (L >= nwg) return false;
        int wgid = (int)L; { const int q = nwg / NXCD, r = nwg % NXCD, xcd = wgid % NXCD, off = wgid / NXCD; wgid = (xcd < r ? xcd * (q + 1) : r * (q + 1) + (xcd - r) * q) + off; }
        const int nig = WGM * nN, gid = wgid / nig, fm = gid * WGM, gsz = (nM - fm) < WGM ? (nM - fm) : WGM;
        u.pm = fm + ((wgid % nig) % gsz); u.pn = (wgid % nig) / gsz; return true;
    }
    __device__ __forceinline__ void a_ready(const Unit&) const {}
    __device__ __forceinline__ void done(const Unit&) const {}
};

__device__ __forceinline__ unsigned pk2b(float lo, float hi) { typedef __bf16 b2 __attribute__((ext_vector_type(2))); b2 v = { (__bf16)lo, (__bf16)hi }; return __builtin_bit_cast(unsigned, v); }
typedef unsigned u32x2 __attribute__((ext_vector_type(2)));
struct EpiStoreBf16 {
    static constexpr bool PERM = false, AFTER_DRAIN = false;
    bf16_t* C; int ldc; int ncols;
    __device__ __forceinline__ void operator()(const f32x4 (&acc)[2][2][4][2], const Unit& u, int wr, int wc, int fr, int fq) const {
#pragma unroll
        for (int ai = 0; ai < 2; ++ai)
#pragma unroll
            for (int m = 0; m < 4; ++m) { bf16_t* rowp = C + (size_t)(u.pm * BM + ai * HALF + wr * 64 + m * 16 + fr) * ldc;
#pragma unroll
                for (int bj = 0; bj < 2; ++bj)
#pragma unroll
                    for (int n = 0; n < 2; ++n) { const int col = u.pn * BM + bj * HALF + wc * 32 + n * 16 + fq * 4;
                        if (col < ncols) { u32x2 w; w.x = pk2b(acc[ai][bj][m][n][0], acc[ai][bj][m][n][1]); w.y = pk2b(acc[ai][bj][m][n][2], acc[ai][bj][m][n][3]); *(u32x2*)(rowp + col) = w; } } }
    }
};
struct EpiStorePQF {
    static constexpr bool PERM = false, AFTER_DRAIN = false;
    bf16_t* C; int pad0, pad1;
    __device__ __forceinline__ void operator()(const f32x4 (&acc)[2][2][4][2], const Unit& u, int wr, int wc, int fr, int fq) const {
#pragma unroll
        for (int ai = 0; ai < 2; ++ai)
#pragma unroll
            for (int m = 0; m < 4; ++m) { const int row = u.pm * BM + ai * HALF + wr * 64 + m * 16 + fr;
#pragma unroll
                for (int bj = 0; bj < 2; ++bj)
#pragma unroll
                    for (int n = 0; n < 2; ++n) { const int col = u.pn * BM + bj * HALF + wc * 32 + n * 16 + fq * 4, d = col & 127;
                        const size_t off = ((((size_t)(row >> 5) * 16 + (col >> 7)) * 8 + (d >> 4)) * 64 + (row & 31) + 32 * ((d >> 3) & 1)) * 8 + (d & 7);
                        u32x2 w; w.x = pk2b(acc[ai][bj][m][n][0], acc[ai][bj][m][n][1]); w.y = pk2b(acc[ai][bj][m][n][2], acc[ai][bj][m][n][3]); *(u32x2*)(C + off) = w; } }
    }
};
struct EpiResidF32 {
    static constexpr bool PERM = false, AFTER_DRAIN = false;
    const float* X; float* O; int ld; int pad;
    __device__ __forceinline__ void operator()(const f32x4 (&acc)[2][2][4][2], const Unit& u, int wr, int wc, int fr, int fq) const {
#pragma unroll
        for (int ai = 0; ai < 2; ++ai)
#pragma unroll
            for (int m = 0; m < 4; ++m) { const size_t ro = (size_t)(u.pm * BM + ai * HALF + wr * 64 + m * 16 + fr) * ld;
#pragma unroll
                for (int bj = 0; bj < 2; ++bj)
#pragma unroll
                    for (int n = 0; n < 2; ++n) { const size_t idx = ro + u.pn * BM + bj * HALF + wc * 32 + n * 16 + fq * 4; *(f32x4*)(O + idx) = *(const f32x4*)(X + idx) + acc[ai][bj][m][n]; } }
    }
};
struct EpiFinalGate {
    static constexpr bool PERM = false, AFTER_DRAIN = false;
    const bf16_t* PL; const float* SSQ; float* O; int ld; int ntok; float eps; int pad;
    __device__ __forceinline__ void operator()(const f32x4 (&acc)[2][2][4][2], const Unit& u, int wr, int wc, int fr, int fq) const {
#pragma unroll
        for (int ai = 0; ai < 2; ++ai)
#pragma unroll
            for (int m = 0; m < 4; ++m) { const int row = u.pm * BM + ai * HALF + wr * 64 + m * 16 + fr; const size_t ro = (size_t)row * ld;
                float tot = 0.f;
#pragma unroll
                for (int x = 0; x < 8; ++x) tot += SSQ[(size_t)x * ntok + row];
                const float rs = 1.0f / sqrtf(tot * (1.0f / 1024.0f) + eps);
#pragma unroll
                for (int bj = 0; bj < 2; ++bj)
#pragma unroll
                    for (int n = 0; n < 2; ++n) { const size_t idx = ro + u.pn * BM + bj * HALF + wc * 32 + n * 16 + fq * 4;
                        const u32x2 pw = *(const u32x2*)(PL + idx); const unsigned px = pw.x, py = pw.y;
                        f32x4 pv; pv.x = __uint_as_float(px << 16); pv.y = __uint_as_float(px & 0xffff0000u); pv.z = __uint_as_float(py << 16); pv.w = __uint_as_float(py & 0xffff0000u);
                        f32x4 g;
#pragma unroll
                        for (int e = 0; e < 4; ++e) g[e] = 1.0f / (1.0f + __expf(-rs * acc[ai][bj][m][n][e]));
                        *(f32x4*)(O + idx) = *(const f32x4*)(O + idx) + pv * g; } }
    }
};

template <class Epi, class Sched, bool ALIGN_EPI = false, bool SP2 = false>
__device__ __forceinline__ void gemm_phase(PG8_LAS unsigned char* lds, const Gemm g, const Sched& S, const Epi& E) {
    const int tid = threadIdx.x, wid = __builtin_amdgcn_readfirstlane(tid >> 6), lane = tid & 63, wr = wid >> 2, wc = wid & 3, fr = lane & 15, fq = lane >> 4;
    const int K = g.K, nt = K / BK;
    unsigned voffA[2], voffB[2];
#pragma unroll
    for (int i = 0; i < 2; ++i) { int R, C; stage_rc(tid * 16 + i * 8192, R, C); const int Rb = Epi::PERM ? ((R & ~31) + perm32(R & 31)) : R;
        voffA[i] = (unsigned)(R * K + C) * 2u; voffB[i] = (unsigned)(Rb * K + C) * 2u; }
    const size_t kstep = (size_t)(BK * 2);
    const size_t hstep = (size_t)HALF * K * 2;
    const size_t tstep = 2 * hstep;
    const unsigned ldsw = (unsigned)wid * 1024u;
    const int aoff = lds_byte(wr * 64 + fr, fq * 8), boff = lds_byte(wc * 32 + fr, fq * 8);
#define PG8_SA(b, h) (((b) * 2 + (h)) * HTB)
#define PG8_SB(b, h) ((4 + (b) * 2 + (h)) * HTB)
#define PG8_STAGE(bufoff, gbase, voff) do { _Pragma("unroll") for (int _i = 0; _i < 2; ++_i) \
        __builtin_amdgcn_global_load_lds((const unsigned*)((const char*)(gbase) + (voff)[_i]), (PG8_LAS unsigned*)(lds + (bufoff) + ldsw + _i * 8192), 16, 0, 0); } while (0)
#define PG8_LDA(dst, b, h) do { _Pragma("unroll") for (int m = 0; m < 4; ++m) _Pragma("unroll") for (int k = 0; k < 2; ++k) dst[m][k] = *(const PG8_LAS bf16x8*)(lds + PG8_SA(b, h) + aoff + m * 2048 + k * 1024); } while (0)
#define PG8_LDB(dst, b, h) do { _Pragma("unroll") for (int n = 0; n < 2; ++n) _Pragma("unroll") for (int k = 0; k < 2; ++k) dst[n][k] = *(const PG8_LAS bf16x8*)(lds + PG8_SB(b, h) + boff + n * 2048 + k * 1024); } while (0)
#define PG8_MMA(ai, bj, At, Bt) do { __builtin_amdgcn_s_setprio(1); _Pragma("unroll") for (int m = 0; m < 4; ++m) _Pragma("unroll") for (int n = 0; n < 2; ++n) _Pragma("unroll") for (int k = 0; k < 2; ++k) \
        acc[ai][bj][m][n] = __builtin_amdgcn_mfma_f32_16x16x32_bf16(Bt[n][k], At[m][k], acc[ai][bj][m][n], 0, 0, 0); __builtin_amdgcn_s_setprio(0); } while (0)
#define PG8_WAIT_V(n) asm volatile("s_waitcnt vmcnt(" #n ")" ::: "memory")
#define PG8_WAIT_L(n) asm volatile("s_waitcnt lgkmcnt(" #n ")" ::: "memory")
#define PG8_BAR __builtin_amdgcn_s_barrier()
#define PG8_SCHED __builtin_amdgcn_sched_barrier(0)
    Unit cur, nxt; int ui = 0;
    if (!S.next(0, cur)) return;
    f32x4 acc[2][2][4][2];
#pragma unroll
    for (int a = 0; a < 2; ++a)
#pragma unroll
        for (int b = 0; b < 2; ++b)
#pragma unroll
            for (int m = 0; m < 4; ++m)
#pragma unroll
                for (int n = 0; n < 2; ++n) acc[a][b][m][n] = (f32x4){0.f, 0.f, 0.f, 0.f};
    bf16x8 At[4][2], B0[2][2], B1[2][2];
    const char* cA = (const char*)g.A + (size_t)cur.pm * tstep; const char* cB = (const char*)g.Bt + (size_t)cur.pn * tstep;
    S.a_ready(cur);
    if constexpr (SP2) {
        PG8_STAGE(PG8_SB(0, 0), cB, voffB); PG8_STAGE(PG8_SB(0, 1), cB + hstep, voffB); PG8_STAGE(PG8_SA(0, 0), cA, voffA); PG8_STAGE(PG8_SA(0, 1), cA + hstep, voffA);
        if (wr == 1) PG8_BAR;
        PG8_WAIT_V(2); PG8_BAR;
        PG8_STAGE(PG8_SB(1, 0), cB + kstep, voffB); PG8_STAGE(PG8_SA(1, 0), cA + kstep, voffA); PG8_STAGE(PG8_SB(1, 1), cB + hstep + kstep, voffB);
        PG8_WAIT_V(6); PG8_BAR;
    } else {
        PG8_STAGE(PG8_SB(0, 0), cB, voffB); PG8_STAGE(PG8_SA(0, 0), cA, voffA); PG8_STAGE(PG8_SB(0, 1), cB + hstep, voffB); PG8_STAGE(PG8_SA(0, 1), cA + hstep, voffA);
        if (wr == 1) PG8_BAR;
        PG8_WAIT_V(4); PG8_BAR;
        PG8_STAGE(PG8_SB(1, 0), cB + kstep, voffB); PG8_STAGE(PG8_SA(1, 0), cA + kstep, voffA); PG8_STAGE(PG8_SB(1, 1), cB + hstep + kstep, voffB);
        PG8_WAIT_V(6); PG8_BAR;
    }
    for (;;) {
        const bool has_next = S.next(ui + 1, nxt);
        const char* nA = has_next ? (const char*)g.A + (size_t)nxt.pm * tstep : cA; const char* nB = has_next ? (const char*)g.Bt + (size_t)nxt.pn * tstep : cB;
        for (int t = 0; t < nt; t += 2) {
            const bool last = (t == nt - 2);
            const char* a1 = cA + (size_t)(t + 1) * kstep;
            const char* a2 = last ? nA : cA + (size_t)(t + 2) * kstep; const char* b2 = last ? nB : cB + (size_t)(t + 2) * kstep;
            const char* a3 = a2 + kstep; const char* b3 = b2 + kstep;
            if (last && has_next) S.a_ready(nxt);
            if constexpr (SP2) {
            PG8_LDB(B0, 0, 0); PG8_LDB(B1, 0, 1); PG8_SCHED; PG8_LDA(At, 0, 0); PG8_STAGE(PG8_SA(1, 1), a1 + hstep, voffA);
            PG8_WAIT_V(8); PG8_WAIT_L(0); PG8_BAR; PG8_MMA(0, 0, At, B0); PG8_MMA(0, 1, At, B1); PG8_BAR; PG8_SCHED;
            PG8_LDA(At, 0, 1); PG8_STAGE(PG8_SB(0, 0), b2, voffB); PG8_STAGE(PG8_SB(0, 1), b2 + hstep, voffB); PG8_STAGE(PG8_SA(0, 0), a2, voffA);
            PG8_WAIT_V(8); PG8_WAIT_L(0); PG8_BAR; PG8_MMA(1, 0, At, B0); PG8_MMA(1, 1, At, B1); PG8_BAR; PG8_SCHED;
            PG8_LDB(B0, 1, 0); PG8_LDB(B1, 1, 1); PG8_SCHED; PG8_LDA(At, 1, 0); PG8_STAGE(PG8_SA(0, 1), a2 + hstep, voffA);
            PG8_WAIT_V(8); PG8_WAIT_L(0); PG8_BAR; PG8_MMA(0, 0, At, B0); PG8_MMA(0, 1, At, B1); PG8_BAR; PG8_SCHED;
            PG8_LDA(At, 1, 1); PG8_STAGE(PG8_SB(1, 0), b3, voffB); PG8_STAGE(PG8_SB(1, 1), b3 + hstep, voffB); PG8_STAGE(PG8_SA(1, 0), a3, voffA);
            PG8_WAIT_V(8); PG8_WAIT_L(0); PG8_BAR; PG8_MMA(1, 0, At, B0); PG8_MMA(1, 1, At, B1); PG8_BAR; PG8_SCHED;
            } else {
            PG8_LDB(B0, 0, 0); PG8_SCHED; PG8_LDA(At, 0, 0); PG8_STAGE(PG8_SA(1, 1), a1 + hstep, voffA);
            PG8_WAIT_L(8); PG8_BAR; PG8_WAIT_L(0); PG8_MMA(0, 0, At, B0); PG8_BAR; PG8_SCHED;
            PG8_LDB(B1, 0, 1); PG8_STAGE(PG8_SB(0, 0), b2, voffB);
            PG8_BAR; PG8_WAIT_L(0); PG8_MMA(0, 1, At, B1); PG8_BAR;
            PG8_LDA(At, 0, 1); PG8_STAGE(PG8_SA(0, 0), a2, voffA);
            PG8_BAR; PG8_WAIT_L(0); PG8_MMA(1, 0, At, B0); PG8_BAR; PG8_SCHED;
            PG8_STAGE(PG8_SB(0, 1), b2 + hstep, voffB);
            PG8_WAIT_V(6); PG8_BAR; PG8_MMA(1, 1, At, B1); PG8_BAR;
            PG8_LDB(B0, 1, 0); PG8_SCHED; PG8_LDA(At, 1, 0); PG8_STAGE(PG8_SA(0, 1), a2 + hstep, voffA);
            PG8_WAIT_L(8); PG8_BAR; PG8_WAIT_L(0); PG8_MMA(0, 0, At, B0); PG8_BAR; PG8_SCHED;
            PG8_LDB(B1, 1, 1); PG8_STAGE(PG8_SB(1, 0), b3, voffB);
            PG8_BAR; PG8_WAIT_L(0); PG8_MMA(0, 1, At, B1); PG8_BAR;
            PG8_LDA(At, 1, 1); PG8_STAGE(PG8_SA(1, 0), a3, voffA);
            PG8_BAR; PG8_WAIT_L(0); PG8_MMA(1, 0, At, B0); PG8_BAR; PG8_SCHED;
            PG8_STAGE(PG8_SB(1, 1), b3 + hstep, voffB);
            PG8_WAIT_V(6); PG8_BAR; PG8_MMA(1, 1, At, B1); PG8_BAR;
            }
        }
        if constexpr (ALIGN_EPI) { if (wr == 0) PG8_BAR; }
        if constexpr (!Epi::AFTER_DRAIN) { E(acc, cur, wr, wc, fr, fq); S.done(cur); }
        if (!has_next) break;
#pragma unroll
        for (int a = 0; a < 2; ++a)
#pragma unroll
            for (int b = 0; b < 2; ++b)
#pragma unroll
                for (int m = 0; m < 4; ++m)
#pragma unroll
                    for (int n = 0; n < 2; ++n) acc[a][b][m][n] = (f32x4){0.f, 0.f, 0.f, 0.f};
        cur = nxt; cA = nA; cB = nB; ++ui;
        if constexpr (ALIGN_EPI) { if (wr == 1) PG8_BAR; }
    }
    PG8_WAIT_V(0);
    if constexpr (!ALIGN_EPI) { if (wr == 0) PG8_BAR; }
    PG8_BAR;
    if constexpr (Epi::AFTER_DRAIN) { E.fused(acc, cur, wr, wc, fr, fq, lds, wid, lane); S.done(cur); }
#undef PG8_SA
#undef PG8_SB
#undef PG8_STAGE
#undef PG8_LDA
#undef PG8_LDB
#undef PG8_MMA
#undef PG8_WAIT_V
#undef PG8_WAIT_L
#undef PG8_BAR
#undef PG8_SCHED
}
}

__device__ __forceinline__ void phase1(const Params& p, unsigned char* lds) {
    pg8::Gemm g{(const bf16*)(p.ws + WS_ACT), (const bf16*)(p.ws + WS_WINT), NTOK, 3584, D}; pg8::StaticOrder S; S.init(NTOK, 3584, (int)gridDim.x, (int)blockIdx.x);
    pg8::EpiStoreBf16 E{(bf16*)(p.ws + WS_PROJ), PS, DIN};
    pg8::gemm_phase<pg8::EpiStoreBf16, pg8::StaticOrder, true, true>((PG8_LAS unsigned char*)lds, g, S, E);
}


__device__ __forceinline__ void phase5(const Params& p, unsigned char* lds) {
    pg8::Gemm g{(const bf16*)(p.ws + WS_ACT), (const bf16*)(p.ws + WS_WOUTT), NTOK, D, D}; pg8::StaticOrder S; S.init(NTOK, D, (int)gridDim.x, (int)blockIdx.x);
    pg8::EpiResidF32 E{p.in[0], p.out, D, 0};
    pg8::gemm_phase<pg8::EpiResidF32, pg8::StaticOrder, true, true>((PG8_LAS unsigned char*)lds, g, S, E);
}
__device__ __forceinline__ void phase6(const Params& p, unsigned char* lds) {
    const int gw = (blockIdx.x * NTHR + threadIdx.x) >> 6, ngw = (gridDim.x * NTHR) >> 6, lane = threadIdx.x & 63;
    for (int m = gw; m < NTOK; m += ngw) rms_row_bf16(p.out + (size_t)m * D, p.in[13], (bf16*)(p.ws + WS_ACT) + (size_t)m * D, lane);
}
__device__ __forceinline__ void phase7(const Params& p, unsigned char* lds) {
    pg8::Gemm g{(const bf16*)(p.ws + WS_ACT), (const bf16*)(p.ws + WS_WQT), NTOK, 2048, D}; pg8::StaticOrder S; S.init(NTOK, 2048, (int)gridDim.x, (int)blockIdx.x);
    pg8::EpiStorePQF E{(bf16*)(p.ws + WS_PROJ), 0, 0};
    pg8::gemm_phase<pg8::EpiStorePQF, pg8::StaticOrder, true, true>((PG8_LAS unsigned char*)lds, g, S, E);
}
__device__ __forceinline__ void phase10(const Params& p, unsigned char* lds) {
    {
        pg8::Gemm g{(const bf16*)(p.ws + WS_PB), (const bf16*)(p.ws + WS_WPT), NTOK, D, 256}; pg8::StaticOrder S; S.init(NTOK, D, (int)gridDim.x, (int)blockIdx.x);
        pg8::EpiStoreBf16 E{(bf16*)(p.ws + WS_ACT), D, D};
        pg8::gemm_phase<pg8::EpiStoreBf16, pg8::StaticOrder, true, true>((PG8_LAS unsigned char*)lds, g, S, E);
    }
    {
        pg8::Gemm g{(const bf16*)(p.ws + WS_PROJ + 64 * MiB), (const bf16*)(p.ws + WS_WGT), NTOK, D, D}; pg8::StaticOrder S; S.init(NTOK, D, (int)gridDim.x, (int)blockIdx.x);
        pg8::EpiFinalGate E{(const bf16*)(p.ws + WS_ACT), (const float*)(p.ws + WS_SSQ), p.out, D, NTOK, EPS, 0};
        pg8::gemm_phase<pg8::EpiFinalGate, pg8::StaticOrder, true, true>((PG8_LAS unsigned char*)lds, g, S, E);
    }
}

typedef __bf16 bf16x2v __attribute__((ext_vector_type(2)));
template <int CTRL> __device__ __forceinline__ float dpp_f(float v) { return __int_as_float(__builtin_amdgcn_update_dpp(0, __float_as_int(v), CTRL, 0xF, 0xF, false)); }
__device__ __forceinline__ float grp16_max(float v) { v = fmaxf(v, dpp_f<0xB1>(v)); v = fmaxf(v, dpp_f<0x4E>(v)); v = fmaxf(v, dpp_f<0x141>(v)); v = fmaxf(v, dpp_f<0x140>(v)); return v; }
__device__ __forceinline__ float grp16_sum(float v) { v += dpp_f<0xB1>(v); v += dpp_f<0x4E>(v); v += dpp_f<0x141>(v); v += dpp_f<0x140>(v); return v; }
#define CE_DESC(a, b) { const float _hi = fmaxf(a, b), _lo = fminf(a, b); a = _hi; b = _lo; }
__device__ __forceinline__ float grp16_top16(float (&v)[8], int lig) {
    CE_DESC(v[0], v[1]) CE_DESC(v[2], v[3]) CE_DESC(v[4], v[5]) CE_DESC(v[6], v[7])
    CE_DESC(v[0], v[2]) CE_DESC(v[1], v[3]) CE_DESC(v[4], v[6]) CE_DESC(v[5], v[7])
    CE_DESC(v[1], v[2]) CE_DESC(v[5], v[6])
    CE_DESC(v[0], v[4]) CE_DESC(v[1], v[5]) CE_DESC(v[2], v[6]) CE_DESC(v[3], v[7])
    CE_DESC(v[2], v[4]) CE_DESC(v[3], v[5])
    CE_DESC(v[1], v[2]) CE_DESC(v[3], v[4]) CE_DESC(v[5], v[6])
    float top = 0.f;
#pragma unroll
    for (int r = 0; r < 16; ++r) {
        const float m = grp16_max(v[0]);
        if (lig == r) top = m;
        const bool own = (v[0] == m);
#pragma unroll
        for (int j = 0; j < 7; ++j) v[j] = own ? v[j + 1] : v[j];
        v[7] = own ? -3.0e38f : v[7];
    }
    return top;
}
__device__ __forceinline__ void phase8(const Params& p, unsigned char* lds) {
    const bf16* PQ = (const bf16*)(p.ws + WS_PROJ); const bf16* KB = (const bf16*)(p.ws + WS_KEYB);
    int* ids = (int*)(p.ws + WS_IDS); float* wts = (float*)(p.ws + WS_WTS);
    float* S = (float*)lds;
    const int tid = threadIdx.x, lane = tid & 63, wid = tid >> 6, lig = tid & 15, gbase = lane & 48;
    for (int item = blockIdx.x; item < 2048; item += gridDim.x) {
        const int tok0 = (item >> 3) * 64, h = item & 7;
        {
            const int c = wid >> 2, key0 = (wid & 3) * 32, r = lane & 31, hh = lane >> 5;
            f32x16 acc0, acc1;
#pragma unroll
            for (int i = 0; i < 16; ++i) { acc0[i] = 0.f; acc1[i] = 0.f; }
            const bf16* bq = KB + (((size_t)(h * 2 + c) * 4 + (key0 >> 5)) * 8) * 512 + lane * 8;
            const bf16* aq0 = PQ + ((((size_t)(tok0 >> 5)) * 16 + h * 2 + c) * 8) * 512 + lane * 8;
            const bf16* aq1 = aq0 + (size_t)16 * 8 * 512;
#pragma unroll
            for (int s = 0; s < 8; ++s) {
                const bf16x8 b = *(const bf16x8*)(bq + s * 512), a0 = *(const bf16x8*)(aq0 + s * 512), a1 = *(const bf16x8*)(aq1 + s * 512);
                acc0 = __builtin_amdgcn_mfma_f32_32x32x16_bf16(a0, b, acc0, 0, 0, 0);
                acc1 = __builtin_amdgcn_mfma_f32_32x32x16_bf16(a1, b, acc1, 0, 0, 0);
            }
#pragma unroll
            for (int i = 0; i < 16; ++i) { const int tl = (i & 3) + 8 * (i >> 2) + 4 * hh; S[(c * 64 + tl) * 132 + key0 + r] = acc0[i]; S[(c * 64 + 32 + tl) * 132 + key0 + r] = acc1[i]; }
        }
        __syncthreads();
        {
            const int tl0 = tid >> 4;
            float ts[2][2];
#pragma unroll
            for (int rd = 0; rd < 2; ++rd)
#pragma unroll
                for (int c = 0; c < 2; ++c) {
                    float v[8];
                    const float* sp = S + (c * 64 + tl0 + 32 * rd) * 132 + lig * 8;
                    const f32x4 lo = *(const f32x4*)sp, hi = *(const f32x4*)(sp + 4);
                    v[0] = lo.x; v[1] = lo.y; v[2] = lo.z; v[3] = lo.w; v[4] = hi.x; v[5] = hi.y; v[6] = hi.z; v[7] = hi.w;
#pragma unroll
                    for (int j = 0; j < 8; ++j) v[j] = __uint_as_float((__float_as_uint(v[j]) & ~127u) | (unsigned)(lig * 8 + j));
                    ts[rd][c] = grp16_top16(v, lig);
                }
            int bp[2] = {0, 0}; float my_s[2] = {0.f, 0.f}; int my_eid[2] = {0, 0};
#pragma unroll 4
            for (int r = 0; r < 16; ++r) {
#pragma unroll
                for (int rd = 0; rd < 2; ++rd) {
                    const float other = __shfl(ts[rd][1], gbase + (bp[rd] < 15 ? bp[rd] : 15));
                    const float sum = ts[rd][0] + other;
                    const float head = (bp[rd] >= 16) ? -3.0e38f : __uint_as_float((__float_as_uint(sum) & ~15u) | (unsigned)lig);
                    const int cur_eid = (int)(((__float_as_uint(ts[rd][0]) & 127u) << 7) | (__float_as_uint(other) & 127u));
                    const float m = grp16_max(head);
                    const int owner = (int)(__float_as_uint(m) & 15u);
                    const int ew = __shfl(cur_eid, gbase + owner);
                    if (lig == r) { my_s[rd] = m; my_eid[rd] = ew; }
                    if (lig == owner) ++bp[rd];
                }
            }
#pragma unroll
            for (int rd = 0; rd < 2; ++rd) {
                const int tl = tl0 + 32 * rd;
                const float mx = grp16_max(my_s[rd]);
                const float e = __expf(my_s[rd] - mx);
                const float sm = grp16_sum(e);
                const size_t o = (size_t)(tok0 + tl) * 128 + h * 16 + lig;
                ((unsigned short*)ids)[(size_t)(tok0 + tl) * 128 + (h >> 2) * 64 + (lig & 7) * 8 + (h & 3) * 2 + (lig >> 3)] = (unsigned short)my_eid[rd]; wts[o] = e / sm;
            }
        }
        __syncthreads();
    }
}

__device__ __forceinline__ void hgrn_pre_item(const Params& p, unsigned char* lds, int ci) {
    const int tid = threadIdx.x, lane = tid & 63, wid = tid >> 6, k = tid & 127, tq = tid >> 7;
    const int n = ci & 127, h = (ci >> 7) & 3, b = ci >> 9, tok0 = b * T + n * 64;
    bf16* proj = (bf16*)(p.ws + WS_PROJ);
    float* OB = p.out; bf16* KIT = (bf16*)((unsigned char*)p.out + OUT_KIT) + (size_t)ci * 8192; bf16* VTg = (bf16*)((unsigned char*)p.out + OUT_VT) + (size_t)ci * 8192;
    float* DEC = (float*)(p.ws + WS_DEC) + (size_t)ci * 128;
    bf16* QT = (bf16*)lds; bf16* KT = (bf16*)(lds + 17408); bf16* VTl = (bf16*)(lds + 34816); bf16* AM = (bf16*)(lds + 53248);
    float* part = (float*)(lds + 62464); float* gref = (float*)(lds + 64512);
    float lb; { const float l0 = p.in[4][h * 128 + k], l1 = p.in[4][512 + h * 128 + k]; const float m = fmaxf(l0, l1); const float e0 = __expf(l0 - m), e1 = __expf(l1 - m); lb = e0 / (e0 + e1); }
    float G[16], key[16], qv[16], vv[16];
    {
        float c = 0.f;
#pragma unroll
        for (int i = 0; i < 16; ++i) {
            const size_t row = (size_t)(tok0 + tq * 16 + i) * PS;
            const float fg = lb + (1.0f - lb) * sigmoidf_(bf2f(proj[row + C_HF + h * 128 + k]));
            key[i] = 1.0f - fg; c += __logf(fg); G[i] = c;
            qv[i] = siluf_(bf2f(proj[row + C_HQ + h * 128 + k])) * 0.08838834764831845f;
            vv[i] = bf2f(proj[row + C_HI + h * 128 + k]);
        }
        part[tq * 128 + k] = c;
    }
    __syncthreads();
    {
        float off = 0.f;
#pragma unroll
        for (int j = 0; j < 3; ++j) off += (j < tq) ? part[j * 128 + k] : 0.f;
#pragma unroll
        for (int i = 0; i < 16; ++i) G[i] += off;
        if (tq == 1) gref[k] = G[15];
        if (tq == 3) gref[128 + k] = G[15];
    }
    __syncthreads();
    {
        const float gr = gref[k], gl = gref[128 + k];
        const int kpos = (k & ~31) | (((k >> 2) & 3) << 3) | (((k >> 4) & 1) << 2) | (k & 3);
        unsigned kp[8], vp[8];
#pragma unroll
        for (int i = 0; i < 16; i += 2) {
            kp[i >> 1] = pk2(key[i] * __expf(gl - G[i]), key[i + 1] * __expf(gl - G[i + 1]));
            vp[i >> 1] = pk2(vv[i], vv[i + 1]);
        }
#pragma unroll
        for (int i = 0; i < 16; ++i) {
            const int t = tq * 16 + i;
            QT[t * 136 + k] = f2bf(qv[i] * __expf(G[i] - gr));
            KT[t * 136 + k] = f2bf(key[i] * __expf(gr - G[i]));
            proj[(size_t)(tok0 + t) * PS + C_HQ + h * 128 + kpos] = f2bf(qv[i] * __expf(G[i]));
        }
        u32x4 a0, a1, b0, b1; a0.x = kp[0]; a0.y = kp[1]; a0.z = kp[2]; a0.w = kp[3]; a1.x = kp[4]; a1.y = kp[5]; a1.z = kp[6]; a1.w = kp[7];
        b0.x = vp[0]; b0.y = vp[1]; b0.z = vp[2]; b0.w = vp[3]; b1.x = vp[4]; b1.y = vp[5]; b1.z = vp[6]; b1.w = vp[7];
        *(u32x4*)(KIT + k * 64 + tq * 16) = a0; *(u32x4*)(KIT + k * 64 + tq * 16 + 8) = a1;
        *(u32x4*)(VTg + k * 64 + tq * 16) = b0; *(u32x4*)(VTg + k * 64 + tq * 16 + 8) = b1;
        *(u32x4*)(VTl + k * 72 + tq * 16) = b0; *(u32x4*)(VTl + k * 72 + tq * 16 + 8) = b1;
        if (tq == 3) DEC[k] = __expf(gl);
    }
    __syncthreads();
    const int fr = lane & 15, fq = lane >> 4;
    {
        const int tt = wid >> 1;
#pragma unroll
        for (int e = 0; e < 2; ++e) {
            const int st = 2 * (wid & 1) + e;
            f32x4 acc = (f32x4){0.f, 0.f, 0.f, 0.f};
            if (st <= tt) {
#pragma unroll
                for (int s = 0; s < 4; ++s) {
                    const bf16x8 a = *(const bf16x8*)(QT + (tt * 16 + fr) * 136 + s * 32 + fq * 8), bb = *(const bf16x8*)(KT + (st * 16 + fr) * 136 + s * 32 + fq * 8);
                    acc = __builtin_amdgcn_mfma_f32_16x16x32_bf16(a, bb, acc, 0, 0, 0);
                }
            }
#pragma unroll
            for (int r = 0; r < 4; ++r) { const int t = tt * 16 + fq * 4 + r, sp = st * 16 + fr; AM[t * 72 + sp] = f2bf(sp <= t ? acc[r] : 0.f); }
        }
    }
    __syncthreads();
    {
        const int tt = wid >> 1;
        const bf16x8 a0 = *(const bf16x8*)(AM + (tt * 16 + fr) * 72 + fq * 8), a1 = *(const bf16x8*)(AM + (tt * 16 + fr) * 72 + 32 + fq * 8);
#pragma unroll
        for (int e = 0; e < 4; ++e) {
            const int vt = (wid & 1) * 4 + e;
            const bf16x8 b0 = *(const bf16x8*)(VTl + (vt * 16 + fr) * 72 + fq * 8), b1 = *(const bf16x8*)(VTl + (vt * 16 + fr) * 72 + 32 + fq * 8);
            f32x4 acc = (f32x4){0.f, 0.f, 0.f, 0.f};
            acc = __builtin_amdgcn_mfma_f32_16x16x32_bf16(a0, b0, acc, 0, 0, 0);
            acc = __builtin_amdgcn_mfma_f32_16x16x32_bf16(a1, b1, acc, 0, 0, 0);
#pragma unroll
            for (int r = 0; r < 4; ++r) OB[(size_t)(tok0 + tt * 16 + fq * 4 + r) * 512 + h * 128 + vt * 16 + fr] = acc[r];
        }
    }
    __syncthreads();
}
template <bool DUMMY>
__device__ __forceinline__ void hgrn_scan_item(const Params& p, int wi) {
    const int lane = threadIdx.x & 63, fr = lane & 15, fq = lane >> 4;
    const int vs = wi & 7, bh = wi >> 3, h = bh & 3, b = bh >> 2;
    const bf16* proj = (const bf16*)(p.ws + WS_PROJ);
    float* OB = p.out; const bf16* KIT = (const bf16*)((unsigned char*)p.out + OUT_KIT); const bf16* VTg = (const bf16*)((unsigned char*)p.out + OUT_VT);
    const float* DEC = (const float*)(p.ws + WS_DEC);
    f32x4 S[8];
#pragma unroll
    for (int i = 0; i < 8; ++i) S[i] = (f32x4){0.f, 0.f, 0.f, 0.f};
#pragma unroll 1
    for (int n = 0; n < 128; ++n) {
        const int ci = bh * 128 + n, tok0 = b * T + n * 64;
        bf16x8 qf[4][4];
#pragma unroll
        for (int tt = 0; tt < 4; ++tt)
#pragma unroll
            for (int s = 0; s < 4; ++s) qf[tt][s] = *(const bf16x8*)(proj + (size_t)(tok0 + tt * 16 + fr) * PS + C_HQ + h * 128 + s * 32 + fq * 8);
        float oin[4][4];
#pragma unroll
        for (int tt = 0; tt < 4; ++tt)
#pragma unroll
            for (int r = 0; r < 4; ++r) oin[tt][r] = OB[(size_t)(tok0 + tt * 16 + fq * 4 + r) * 512 + h * 128 + vs * 16 + fr];
        bf16x8 Sb[4];
#pragma unroll
        for (int s = 0; s < 4; ++s) {
            u32x4 w; w.x = pk2(S[2 * s][0], S[2 * s][1]); w.y = pk2(S[2 * s][2], S[2 * s][3]); w.z = pk2(S[2 * s + 1][0], S[2 * s + 1][1]); w.w = pk2(S[2 * s + 1][2], S[2 * s + 1][3]);
            Sb[s] = __builtin_bit_cast(bf16x8, w);
        }
#pragma unroll
        for (int tt = 0; tt < 4; ++tt) {
            f32x4 acc = (f32x4){0.f, 0.f, 0.f, 0.f};
#pragma unroll
            for (int s = 0; s < 4; ++s) acc = __builtin_amdgcn_mfma_f32_16x16x32_bf16(qf[tt][s], Sb[s], acc, 0, 0, 0);
#pragma unroll
            for (int r = 0; r < 4; ++r) { const size_t oi = (size_t)(tok0 + tt * 16 + fq * 4 + r) * 512 + h * 128 + vs * 16 + fr; if (DUMMY) ((float*)(p.ws + WS_SPARE))[oi & 0x3fffff] = oin[tt][r] + acc[r]; else OB[oi] = oin[tt][r] + acc[r]; }
        }
        const bf16x8 v0 = *(const bf16x8*)(VTg + (size_t)ci * 8192 + (vs * 16 + fr) * 64 + fq * 8), v1 = *(const bf16x8*)(VTg + (size_t)ci * 8192 + (vs * 16 + fr) * 64 + 32 + fq * 8);
#pragma unroll
        for (int kb = 0; kb < 8; ++kb) {
            const bf16x8 k0 = *(const bf16x8*)(KIT + (size_t)ci * 8192 + (kb * 16 + fr) * 64 + fq * 8), k1 = *(const bf16x8*)(KIT + (size_t)ci * 8192 + (kb * 16 + fr) * 64 + 32 + fq * 8);
            const f32x4 dv = *(const f32x4*)(DEC + (size_t)ci * 128 + kb * 16 + fq * 4);
            f32x4 sacc = S[kb] * dv;
            sacc = __builtin_amdgcn_mfma_f32_16x16x32_bf16(k0, v0, sacc, 0, 0, 0);
            sacc = __builtin_amdgcn_mfma_f32_16x16x32_bf16(k1, v1, sacc, 0, 0, 0);
            S[kb] = sacc;
        }
    }
}

__device__ __forceinline__ void hgrn_scan_block(const Params& p, unsigned char* lds, int sb) {
    const int tid = threadIdx.x, lane = tid & 63, wid = __builtin_amdgcn_readfirstlane(tid >> 6), fr = lane & 15, fq = lane >> 4;
    const int bh = sb >> 2, vs = (sb & 3) * 2 + (wid & 1); const bool worker = wid < 2;
    const int h = bh & 3, b = bh >> 2;
    const bf16* proj = (const bf16*)(p.ws + WS_PROJ);
    float* OB = p.out; const bf16* KIT = (const bf16*)((unsigned char*)p.out + OUT_KIT); const bf16* VTg = (const bf16*)((unsigned char*)p.out + OUT_VT);
    const float* DEC = (const float*)(p.ws + WS_DEC);
    constexpr int BUF = 54784, O_KIT = 17408, O_VT = 17408 + 18432, O_DEC = 17408 + 2 * 18432;
    u32x4 rqA[2], rkA[2], rvA[2], rdA, rqB[2], rkB[2], rvB[2], rdB;
    float oin[4][4];
#define SC_ISSUE(rq, rk, rv, rd, n_) { const int ci_ = bh * 128 + (n_), tk_ = b * T + (n_) * 64; \
        _Pragma("unroll") for (int i = 0; i < 2; ++i) { const int id = tid + i * NTHR; \
            rq[i] = *(const u32x4*)(proj + (size_t)(tk_ + (id >> 4)) * PS + C_HQ + h * 128 + (id & 15) * 8); \
            rk[i] = *(const u32x4*)(KIT + (size_t)ci_ * 8192 + id * 8); rv[i] = *(const u32x4*)(VTg + (size_t)ci_ * 8192 + id * 8); } \
        if (tid < 32) rd = *(const u32x4*)(DEC + (size_t)ci_ * 128 + tid * 4); }
#define SC_STASH(rq, rk, rv, rd, buf) { _Pragma("unroll") for (int i = 0; i < 2; ++i) { const int id = tid + i * NTHR; \
            *(u32x4*)((buf) + (id >> 4) * 272 + (id & 15) * 16) = rq[i]; *(u32x4*)((buf) + O_KIT + (id >> 3) * 144 + (id & 7) * 16) = rk[i]; \
            *(u32x4*)((buf) + O_VT + (id >> 3) * 144 + (id & 7) * 16) = rv[i]; } \
        if (tid < 32) *(u32x4*)((buf) + O_DEC + tid * 16) = rd; }
    auto load_oin = [&](int n) {
        const int tok0 = b * T + n * 64;
#pragma unroll
        for (int tt = 0; tt < 4; ++tt)
#pragma unroll
            for (int r = 0; r < 4; ++r) oin[tt][r] = OB[(size_t)(tok0 + tt * 16 + fq * 4 + r) * 512 + h * 128 + vs * 16 + fr];
    };
    f32x4 S[8];
#pragma unroll
    for (int i = 0; i < 8; ++i) S[i] = (f32x4){0.f, 0.f, 0.f, 0.f};
    SC_ISSUE(rqA, rkA, rvA, rdA, 0)
    SC_ISSUE(rqB, rkB, rvB, rdB, 1)
    SC_STASH(rqA, rkA, rvA, rdA, lds)
    __syncthreads();
    auto compute = [&](int n, unsigned char* cur) {
        const int tok0 = b * T + n * 64;
        const int nn = (n + 1 < 128) ? n + 1 : n;
        bf16x8 Sb[4];
#pragma unroll
        for (int s = 0; s < 4; ++s) {
            u32x4 w; w.x = pk2(S[2 * s][0], S[2 * s][1]); w.y = pk2(S[2 * s][2], S[2 * s][3]); w.z = pk2(S[2 * s + 1][0], S[2 * s + 1][1]); w.w = pk2(S[2 * s + 1][2], S[2 * s + 1][3]);
            Sb[s] = __builtin_bit_cast(bf16x8, w);
        }
        f32x4 oacc[4];
#pragma unroll
        for (int hf = 0; hf < 2; ++hf) {
            bf16x8 qf[2][4];
#pragma unroll
            for (int t2 = 0; t2 < 2; ++t2)
#pragma unroll
                for (int s = 0; s < 4; ++s) qf[t2][s] = *(const bf16x8*)(cur + ((hf * 2 + t2) * 16 + fr) * 272 + (s * 32 + fq * 8) * 2);
            __builtin_amdgcn_sched_barrier(0);
#pragma unroll
            for (int t2 = 0; t2 < 2; ++t2) oacc[hf * 2 + t2] = (f32x4){0.f, 0.f, 0.f, 0.f};
#pragma unroll
            for (int s = 0; s < 4; ++s)
#pragma unroll
                for (int t2 = 0; t2 < 2; ++t2) oacc[hf * 2 + t2] = __builtin_amdgcn_mfma_f32_16x16x32_bf16(qf[t2][s], Sb[s], oacc[hf * 2 + t2], 0, 0, 0);
        }
        { bf16* MX = (bf16*)(p.ws + WS_ACT);
#pragma unroll
          for (int tt = 0; tt < 4; ++tt)
#pragma unroll
            for (int r = 0; r < 4; ++r) MX[(size_t)(tok0 + tt * 16 + fq * 4 + r) * D + h * 128 + vs * 16 + fr] = f2bf(oacc[tt][r]); }
        const bf16x8 v0 = *(const bf16x8*)(cur + O_VT + (vs * 16 + fr) * 144 + fq * 16), v1 = *(const bf16x8*)(cur + O_VT + (vs * 16 + fr) * 144 + 64 + fq * 16);
#pragma unroll
        for (int hf = 0; hf < 2; ++hf) {
            bf16x8 kf[4][2]; f32x4 dvv[4];
#pragma unroll
            for (int k4 = 0; k4 < 4; ++k4) { const int kb = hf * 4 + k4;
                kf[k4][0] = *(const bf16x8*)(cur + O_KIT + (kb * 16 + fr) * 144 + fq * 16); kf[k4][1] = *(const bf16x8*)(cur + O_KIT + (kb * 16 + fr) * 144 + 64 + fq * 16);
                dvv[k4] = *(const f32x4*)(cur + O_DEC + (kb * 16 + fq * 4) * 4); }
            __builtin_amdgcn_sched_barrier(0);
#pragma unroll
            for (int k4 = 0; k4 < 4; ++k4) S[hf * 4 + k4] = S[hf * 4 + k4] * dvv[k4];
#pragma unroll
            for (int e = 0; e < 2; ++e)
#pragma unroll
                for (int k4 = 0; k4 < 4; ++k4) S[hf * 4 + k4] = __builtin_amdgcn_mfma_f32_16x16x32_bf16(kf[k4][e], e == 0 ? v0 : v1, S[hf * 4 + k4], 0, 0, 0);
        }
    };
#pragma unroll 1
    for (int n = 0; n < 128; n += 2) {
        { const int n2 = (n + 2 < 128) ? n + 2 : n; SC_ISSUE(rqA, rkA, rvA, rdA, n2) }
        if (worker) compute(n, lds);
        SC_STASH(rqB, rkB, rvB, rdB, lds + BUF)
        asm volatile("s_waitcnt lgkmcnt(0)" ::: "memory"); __builtin_amdgcn_s_barrier(); asm volatile("" ::: "memory");
        { const int n3 = (n + 3 < 128) ? n + 3 : n + 1; SC_ISSUE(rqB, rkB, rvB, rdB, n3) }
        if (worker) compute(n + 1, lds + BUF);
        SC_STASH(rqA, rkA, rvA, rdA, lds)
        asm volatile("s_waitcnt lgkmcnt(0)" ::: "memory"); __builtin_amdgcn_s_barrier(); asm volatile("" ::: "memory");
    }
#undef SC_ISSUE
#undef SC_STASH
}
__device__ __forceinline__ void phase4(const Params& p, unsigned char* lds) {
    const bf16* proj = (const bf16*)(p.ws + WS_PROJ); const float* OB = p.out; bf16* mixed = (bf16*)(p.ws + WS_ACT); const float* gain = p.in[5];
    const int lane = threadIdx.x & 63, gw = (blockIdx.x * NTHR + threadIdx.x) >> 6, ngw = (gridDim.x * NTHR) >> 6;
    for (int tok = gw; tok < NTOK; tok += ngw) {
        f32x4 o0 = *(const f32x4*)(OB + (size_t)tok * 512 + lane * 8), o1 = *(const f32x4*)(OB + (size_t)tok * 512 + lane * 8 + 4);
        { const u32x4 oi = *(const u32x4*)(mixed + (size_t)tok * D + lane * 8); const unsigned a = oi.x, b = oi.y, c = oi.z, d = oi.w;
          o0.x += __uint_as_float(a << 16); o0.y += __uint_as_float(a & 0xffff0000u); o0.z += __uint_as_float(b << 16); o0.w += __uint_as_float(b & 0xffff0000u);
          o1.x += __uint_as_float(c << 16); o1.y += __uint_as_float(c & 0xffff0000u); o1.z += __uint_as_float(d << 16); o1.w += __uint_as_float(d & 0xffff0000u); }
        const u32x4 gp = *(const u32x4*)(proj + (size_t)tok * PS + C_HG + lane * 8);
        const f32x4 g0 = *(const f32x4*)(gain + lane * 8), g1 = *(const f32x4*)(gain + lane * 8 + 4);
        float ss = o0.x * o0.x + o0.y * o0.y + o0.z * o0.z + o0.w * o0.w + o1.x * o1.x + o1.y * o1.y + o1.z * o1.z + o1.w * o1.w;
        ss = grp16_sum(ss);
        const float r = rsqrtf(ss * (1.0f / 128.0f) + EPS);
        const unsigned gx = gp.x, gy = gp.y, gz = gp.z, gw_ = gp.w;
        u32x4 w;
        w.x = pk2(o0.x * r * g0.x * siluf_(__uint_as_float(gx << 16)), o0.y * r * g0.y * siluf_(__uint_as_float(gx & 0xffff0000u)));
        w.y = pk2(o0.z * r * g0.z * siluf_(__uint_as_float(gy << 16)), o0.w * r * g0.w * siluf_(__uint_as_float(gy & 0xffff0000u)));
        w.z = pk2(o1.x * r * g1.x * siluf_(__uint_as_float(gz << 16)), o1.y * r * g1.y * siluf_(__uint_as_float(gz & 0xffff0000u)));
        w.w = pk2(o1.z * r * g1.z * siluf_(__uint_as_float(gw_ << 16)), o1.w * r * g1.w * siluf_(__uint_as_float(gw_ & 0xffff0000u)));
        *(u32x4*)(mixed + (size_t)tok * D + lane * 8) = w;
    }
}

#define WAVE_LDS_SYNC() asm volatile("s_waitcnt lgkmcnt(0)" ::: "memory")
__device__ __forceinline__ void nsa_prep_item(const Params& p, unsigned char* lds, int tile) {
    const int tid = threadIdx.x, lig = tid & 15;
    const int tok0 = tile * 64;
    bf16* proj = (bf16*)(p.ws + WS_PROJ);
    for (int rho = tid >> 4; rho < 768; rho += 32) {
        const int tl = rho / 12, which = rho - tl * 12;
        int col; const float* gain; float sc = 1.0f;
        if (which < 8) { col = C_NQ + which * 64; gain = p.in[6]; sc = 0.125f * 1.4426950408889634f; }
        else if (which < 10) { col = C_KS + (which - 8) * 64; gain = p.in[7] + 64; }
        else { col = C_KW + (which - 10) * 64; gain = p.in[7] + 128; }
        bf16* rp = proj + (size_t)(tok0 + tl) * PS + col + lig * 4;
        const u32x2 raw = *(const u32x2*)rp;
        const unsigned r0 = raw.x, r1 = raw.y;
        const float a = __uint_as_float(r0 << 16), b = __uint_as_float(r0 & 0xffff0000u), c = __uint_as_float(r1 << 16), d = __uint_as_float(r1 & 0xffff0000u);
        const float ss = grp16_sum(a * a + b * b + c * c + d * d);
        const float r = rsqrtf(ss * (1.0f / 64.0f) + EPS) * sc;
        const f32x4 gg = *(const f32x4*)(gain + lig * 4);
        u32x2 o; o.x = pk2(a * r * gg.x, b * r * gg.y); o.y = pk2(c * r * gg.z, d * r * gg.w);
        if (which < 8) *(u32x2*)rp = o;
        else {
            const int g = (which - 8) & 1, tok = tok0 + tl, b = tok / T, t = tok % T;
            unsigned char* kb = p.ws + (which < 10 ? WS_KFS : WS_KFW) + ((size_t)(b * 2 + g) * 256 + (t >> 5)) * 4096;
            *(u32x2*)(kb + (lig >> 2) * 1024 + ((t & 31) + 32 * ((lig >> 1) & 1)) * 16 + (lig & 1) * 8) = o;
        }
    }
    {
        const int c = tid & 127, tq = tid >> 7, g = c >> 6, d = c & 63, b = tok0 / T, t0 = tok0 % T;
#pragma unroll
        for (int which = 0; which < 2; ++which) {
            const int col = (which == 0 ? C_VS : C_VW) + c;
            unsigned short e[16];
#pragma unroll
            for (int i = 0; i < 16; ++i) e[i] = proj[(size_t)(tok0 + tq * 16 + i) * PS + col];
            unsigned char* vb = p.ws + (which == 0 ? WS_VTS : WS_VTW) + ((size_t)(b * 2 + g) * 256 + ((t0 + tq * 16) >> 5)) * 4096 + ((d >> 5) * 2 + (tq & 1)) * 1024 + (d & 31) * 16;
            u32x4 h0, h1;
            h0.x = e[0] | ((unsigned)e[1] << 16); h0.y = e[2] | ((unsigned)e[3] << 16); h0.z = e[8] | ((unsigned)e[9] << 16); h0.w = e[10] | ((unsigned)e[11] << 16);
            h1.x = e[4] | ((unsigned)e[5] << 16); h1.y = e[6] | ((unsigned)e[7] << 16); h1.z = e[12] | ((unsigned)e[13] << 16); h1.w = e[14] | ((unsigned)e[15] << 16);
            *(u32x4*)vb = h0; *(u32x4*)(vb + 512) = h1;
        }
    }
}
__device__ __forceinline__ void nsa_cmp_item(const Params& p, unsigned char* lds, int item) {
    const int tid = threadIdx.x, lane = tid & 63, wid = tid >> 6, fr = lane & 15, fq = lane >> 4;
    const int nt32 = item & 15, g = (item >> 4) & 1, b = (item >> 5) & 1, which = item >> 6, n0 = nt32 * 32;
    const bf16* proj = (const bf16*)(p.ws + WS_PROJ);
    const float* pe = p.in[8] + which * 2048;
    const bf16* W1T = (const bf16*)(p.ws + WS_W1T) + (size_t)which * 64 * 2048;
    const float* w2 = p.in[10] + which * 4096;
    bf16* A = (bf16*)lds; float* H = (float*)(lds + 33280);
    const int col0 = (which == 0 ? C_KC : C_VC) + g * 64;
    const int nt = wid & 1, ct = wid >> 1;
    f32x4 acc = (f32x4){0.f, 0.f, 0.f, 0.f};
#pragma unroll 1
    for (int kc = 0; kc < 4; ++kc) {
#pragma unroll
        for (int i = 0; i < 4; ++i) {
            const int idx = tid + i * NTHR, dch = idx & 7, jj = (idx >> 3) & 7, n = idx >> 6, j = kc * 8 + jj;
            u32x4 o = (u32x4){0u, 0u, 0u, 0u};
            if (n0 + n < NCMP) {
                const u32x4 raw = *(const u32x4*)(proj + (size_t)(b * T + 16 * (n0 + n) + j) * PS + col0 + dch * 8);
                const f32x4 p0 = *(const f32x4*)(pe + j * 64 + dch * 8), p1 = *(const f32x4*)(pe + j * 64 + dch * 8 + 4);
                const unsigned r0 = raw.x, r1 = raw.y, r2 = raw.z, r3 = raw.w;
                o.x = pk2(__uint_as_float(r0 << 16) + p0.x, __uint_as_float(r0 & 0xffff0000u) + p0.y);
                o.y = pk2(__uint_as_float(r1 << 16) + p0.z, __uint_as_float(r1 & 0xffff0000u) + p0.w);
                o.z = pk2(__uint_as_float(r2 << 16) + p1.x, __uint_as_float(r2 & 0xffff0000u) + p1.y);
                o.w = pk2(__uint_as_float(r3 << 16) + p1.z, __uint_as_float(r3 & 0xffff0000u) + p1.w);
            }
            *(u32x4*)(A + n * 520 + jj * 64 + dch * 8) = o;
        }
        __syncthreads();
#pragma unroll 4
        for (int s = 0; s < 16; ++s) {
            const bf16x8 a = *(const bf16x8*)(A + (nt * 16 + fr) * 520 + s * 32 + fq * 8);
            const bf16x8 bb = *(const bf16x8*)(W1T + (size_t)(ct * 16 + fr) * 2048 + kc * 512 + s * 32 + fq * 8);
            acc = __builtin_amdgcn_mfma_f32_16x16x32_bf16(a, bb, acc, 0, 0, 0);
        }
        __syncthreads();
    }
#pragma unroll
    for (int r = 0; r < 4; ++r) H[(nt * 16 + fq * 4 + r) * 64 + ct * 16 + fr] = gelu_tanh(acc[r]);
    __syncthreads();
    {
        const int n = tid >> 4, c = (tid & 15) * 4;
        f32x4 o = (f32x4){0.f, 0.f, 0.f, 0.f};
#pragma unroll 8
        for (int i = 0; i < 64; ++i) { const float hv = H[n * 64 + i]; const f32x4 w = *(const f32x4*)(w2 + i * 64 + c); o += hv * w; }
        if (which == 0) {
            const float ss = grp16_sum(o.x * o.x + o.y * o.y + o.z * o.z + o.w * o.w);
            const float r = rsqrtf(ss * (1.0f / 64.0f) + EPS);
            const f32x4 gg = *(const f32x4*)(p.in[7] + c);
            o = o * r * gg;
        }
        if (n0 + n >= NCMP) o = (f32x4){0.f, 0.f, 0.f, 0.f};
        const int nn = n0 + n;
        if (which == 0) { u32x2 w; w.x = pk2(o.x, o.y); w.y = pk2(o.z, o.w);
            *(u32x2*)(p.ws + WS_KC + ((size_t)(b * 2 + g) * 16 + (nn >> 5)) * 4096 + (c >> 4) * 1024 + ((nn & 31) + 32 * ((c >> 3) & 1)) * 16 + (c & 7) * 2) = w; }
        else {
            const int kl = nn & 31, sst = kl >> 4, r = kl & 15, j = ((r >> 3) << 2) | (r & 3), hh = (r >> 2) & 1;
            bf16* vt = (bf16*)(p.ws + WS_VCT + ((size_t)(b * 2 + g) * 16 + (nn >> 5)) * 4096 + sst * 1024 + hh * 512 + j * 2);
            const float ov[4] = {o.x, o.y, o.z, o.w};
#pragma unroll
            for (int e = 0; e < 4; ++e) { const int dd = c + e; vt[((dd >> 5) * 2048 + (dd & 31) * 16) / 2] = f2bf(ov[e]); }
        }
    }
    __syncthreads();
}

constexpr float LOG2E = 1.4426950408889634f;
__device__ __forceinline__ int rho16(int reg, int hh) { return (reg & 3) + 8 * (reg >> 2) + 4 * hh; }
__device__ __forceinline__ bf16x8 pack8(const float* pv) {
    u32x4 w; w.x = pk2(pv[0], pv[1]); w.y = pk2(pv[2], pv[3]); w.z = pk2(pv[4], pv[5]); w.w = pk2(pv[6], pv[7]);
    return __builtin_bit_cast(bf16x8, w);
}
struct KF { bf16x8 f[4]; };
struct VF { bf16x8 f[4]; };
__device__ __forceinline__ void load_k(KF& k, const unsigned char* tp) {
#pragma unroll
    for (int s = 0; s < 4; ++s) k.f[s] = *(const bf16x8*)(tp + s * 1024);
}
__device__ __forceinline__ void load_v(VF& v, const unsigned char* tp) {
#pragma unroll
    for (int q = 0; q < 4; ++q) v.f[q] = *(const bf16x8*)(tp + q * 1024);
}
__device__ __forceinline__ f32x16 score_tile(const KF& k, const bf16x8 (&qf)[4], float slope, float base) {
    f32x16 st;
#pragma unroll
    for (int i = 0; i < 16; ++i) st[i] = fmaf(slope, (float)((i & 3) + 8 * (i >> 2)), base);
#pragma unroll
    for (int s = 0; s < 4; ++s) st = __builtin_amdgcn_mfma_f32_32x32x16_bf16(k.f[s], qf[s], st, 0, 0, 0);
    return st;
}
__device__ __forceinline__ void pv_tile(f32x16& o0, f32x16& o1, const VF& v, const float* pv) {
    const bf16x8 p0 = pack8(pv), p1 = pack8(pv + 8);
    o0 = __builtin_amdgcn_mfma_f32_32x32x16_bf16(v.f[0], p0, o0, 0, 0, 0); o0 = __builtin_amdgcn_mfma_f32_32x32x16_bf16(v.f[1], p1, o0, 0, 0, 0);
    o1 = __builtin_amdgcn_mfma_f32_32x32x16_bf16(v.f[2], p0, o1, 0, 0, 0); o1 = __builtin_amdgcn_mfma_f32_32x32x16_bf16(v.f[3], p1, o1, 0, 0, 0);
}
template <bool FAST>
__device__ __forceinline__ void attn_tile(const KF& kc, const VF& vf, const bf16x8 (&qf)[4], float slope, float base, int distbase, bool colsel, int wlimit,
                                          float& l, f32x16& o0, f32x16& o1) {
    const f32x16 st = score_tile(kc, qf, slope, base);
    float sv[16]; float ps = 0.f;
#pragma unroll
    for (int i = 0; i < 16; ++i) {
        float e = __builtin_amdgcn_exp2f(st[i]);
        if (!FAST) { const int dist = distbase - ((i & 3) + 8 * (i >> 2)); e = (colsel && dist >= 0 && dist < wlimit) ? e : 0.f; }
        sv[i] = e; ps += e;
    }
    l += ps;
    pv_tile(o0, o1, vf, sv);
}
__device__ __forceinline__ void nsa_attn_item(const Params& p, unsigned char* wlds, int item) {
    const int lane = threadIdx.x & 63, c = lane & 31, hh = lane >> 5, jt = c >> 2, r4 = c & 3;
    const int oct = item & 1023, g = (item >> 10) & 1, b = item >> 11;
    const int t0 = oct * 8, tc = t0 + jt, h = g * 4 + r4;
    const float slope = exp2f(-(float)(h + 1)) * LOG2E;
    const bf16* proj = (const bf16*)(p.ws + WS_PROJ);
    float* impA = (float*)wlds; float* impB = impA + 1024; unsigned* msk = (unsigned*)(impB + 1024);
    unsigned char* blist = (unsigned char*)(msk + 32);
    float* ocl = (float*)(wlds + 8448) + lane;
#pragma unroll
    for (int i = 0; i < 16; ++i) { impA[lane + 64 * i] = 0.f; impB[lane + 64 * i] = 0.f; }
    if (lane < 32) msk[lane] = 0u;
    bf16x8 qf[4];
    { const bf16* qp = proj + (size_t)(b * T + tc) * PS + C_NQ + h * 64 + hh * 8;
#pragma unroll
      for (int s = 0; s < 4; ++s) qf[s] = *(const bf16x8*)(qp + s * 16); }
    const bf16* gatep = proj + (size_t)(b * T + tc) * PS + C_GT + h * 3;
#define NSA_GATE(i) sigmoidf_(bf2f(gatep[i]))
    float bnd[3];
    { const float gq = wave_max(fabsf(p.in[6][lane]));
#pragma unroll
      for (int i = 0; i < 3; ++i) bnd[i] = __uint_as_float((unsigned)__builtin_amdgcn_readfirstlane((int)__float_as_uint(8.0f * LOG2E * 1.02f * gq * wave_max(fabsf(p.in[7][i * 64 + lane]))))); }
    WAVE_LDS_SYNC();
    {
        const unsigned char* KC = p.ws + WS_KC + (size_t)(b * 2 + g) * 65536 + lane * 16;
        const unsigned char* VCT = p.ws + WS_VCT + (size_t)(b * 2 + g) * 65536 + lane * 16;
        const int nmax = (t0 + 7 >= 31) ? ((t0 + 7 - 31) >> 4) : -1;
        const int nlast = (nmax >= 0) ? (nmax & ~31) : -32;
        float l = 0.f;
        f32x16 o0, o1;
#pragma unroll
        for (int i = 0; i < 16; ++i) { o0[i] = 0.f; o1[i] = 0.f; }
        KF kn;
        if (nlast >= 0) load_k(kn, KC + (size_t)nlast * 128);
#pragma unroll 1
        for (int n0 = nlast; n0 >= 0; n0 -= 32) {
            const KF kc = kn;
            load_k(kn, KC + (size_t)(n0 >= 32 ? n0 - 32 : n0) * 128);
            __builtin_amdgcn_sched_barrier(0);
            const int distbase = tc - 16 * (n0 + 4 * hh) - 31;
            const f32x16 st = score_tile(kc, qf, 16.0f * slope, -slope * (float)distbase - bnd[0]);
            float ps = 0.f;
#pragma unroll
            for (int i = 0; i < 16; ++i) { const int dist = distbase - 16 * ((i & 3) + 8 * (i >> 2)); ps += (dist >= 0) ? __builtin_amdgcn_exp2f(st[i]) : 0.f; }
            l += ps;
        }
        l += __shfl_xor(l, 32);
        const float inv = (l > 0.f) ? 1.0f / l : 0.f;
        if (nlast >= 0) load_k(kn, KC + (size_t)nlast * 128);
#pragma unroll 1
        for (int n0 = nlast; n0 >= 0; n0 -= 32) {
            const KF kc = kn; VF vf;
            load_v(vf, VCT + (size_t)n0 * 128);
            load_k(kn, KC + (size_t)(n0 >= 32 ? n0 - 32 : n0) * 128);
            __builtin_amdgcn_sched_barrier(0);
            const int distbase = tc - 16 * (n0 + 4 * hh) - 31;
            const f32x16 st = score_tile(kc, qf, 16.0f * slope, -slope * (float)distbase - bnd[0]);
            float pv[16];
#pragma unroll
            for (int i = 0; i < 16; ++i) { const int dist = distbase - 16 * ((i & 3) + 8 * (i >> 2)); pv[i] = (dist >= 0) ? __builtin_amdgcn_exp2f(st[i]) * inv : 0.f; }
            pv_tile(o0, o1, vf, pv);
#pragma unroll
            for (int i = 0; i < 16; ++i) { float v = pv[i]; v += dpp_f<0xB1>(v); v += dpp_f<0x4E>(v); pv[i] = v; }
            if (r4 == 0) {
#pragma unroll
                for (int rg = 0; rg < 4; ++rg) {
                    const int jb = (n0 >> 2) + 2 * rg + hh;
                    impA[jt * 128 + jb] = pv[4 * rg] + 2.f * pv[4 * rg + 1] + 2.f * pv[4 * rg + 2] + 2.f * pv[4 * rg + 3];
                    if (jb >= 1) impB[jt * 128 + jb - 1] = pv[4 * rg];
                }
            }
        }
        { const float g0 = NSA_GATE(0);
#pragma unroll
        for (int i = 0; i < 16; ++i) { ocl[i * 64] = g0 * o0[i]; ocl[(16 + i) * 64] = g0 * o1[i]; } }
    }
    WAVE_LDS_SYNC();
    {
        const int lig = lane & 15, grp = lane >> 4;
#pragma unroll 1
        for (int half = 0; half < 2; ++half) {
            const int j2 = half * 4 + grp, cur = (t0 + j2) >> 6;
            float v[8];
#pragma unroll
            for (int e = 0; e < 8; ++e) {
                const int j = lig * 8 + e; const float val = impA[j2 * 128 + j] + impB[j2 * 128 + j];
                v[e] = (j >= 1 && j <= cur - 2) ? __uint_as_float((__float_as_uint(val) & ~127u) | (unsigned)(127 - j)) : -1.0f;
            }
            const float top = grp16_top16(v, lig);
            const int need = 16 - ((cur == 0) ? 1 : (cur == 1) ? 2 : 3);
            if (lig < need && top >= 0.f) { const int idx = 127 - (int)(__float_as_uint(top) & 127u); atomicOr(&msk[j2 * 4 + (idx >> 5)], 1u << (idx & 31)); }
            if (lig == 0) { atomicOr(&msk[j2 * 4], 1u); atomicOr(&msk[j2 * 4 + (cur >> 5)], 1u << (cur & 31)); if (cur >= 1) atomicOr(&msk[j2 * 4 + ((cur - 1) >> 5)], 1u << ((cur - 1) & 31)); }
        }
    }
    WAVE_LDS_SYNC();
    {
        int nblk = 0;
#pragma unroll
        for (int w = 3; w >= 0; --w) {
            unsigned u = 0u;
#pragma unroll
            for (int j = 0; j < 8; ++j) u |= msk[j * 4 + w];
            u = (unsigned)__builtin_amdgcn_readfirstlane((int)u);
            while (u) { const int bit = 31 - __builtin_clz(u); u &= ~(1u << bit); if (lane == 0) blist[nblk] = (unsigned char)(w * 32 + bit); ++nblk; }
        }
        WAVE_LDS_SYNC();
        const unsigned char* KS = p.ws + WS_KFS + (size_t)(b * 2 + g) * (256 * 4096) + lane * 16;
        const unsigned char* VTS = p.ws + WS_VTS + (size_t)(b * 2 + g) * (256 * 4096) + lane * 16;
        float l = 0.f;
        f32x16 o0, o1;
#pragma unroll
        for (int i = 0; i < 16; ++i) { o0[i] = 0.f; o1[i] = 0.f; }
        const int ntile = 2 * nblk;
        KF kn; VF vn;
        { const int jb0 = blist[0]; load_k(kn, KS + (size_t)(jb0 * 64 + 32) * 128); load_v(vn, VTS + (size_t)(jb0 * 64 + 32) * 128); }
#pragma unroll 1
        for (int ti = 0; ti < ntile; ++ti) {
            const int jb = __builtin_amdgcn_readfirstlane((int)blist[ti >> 1]);
            const int key0 = jb * 64 + 32 - 32 * (ti & 1);
            const KF kc = kn; const VF vf = vn;
            { const int tn = (ti + 1 < ntile) ? ti + 1 : ti; const int jn = __builtin_amdgcn_readfirstlane((int)blist[tn >> 1]); const size_t off = (size_t)(jn * 64 + 32 - 32 * (tn & 1)) * 128;
              load_k(kn, KS + off); load_v(vn, VTS + off); }
            __builtin_amdgcn_sched_barrier(0);
            const bool colsel = (msk[jt * 4 + (jb >> 5)] >> (jb & 31)) & 1u;
            const int distbase = tc - key0 - 4 * hh;
            if (key0 + 31 <= t0) attn_tile<true>(kc, vf, qf, slope, colsel ? -slope * (float)distbase - bnd[1] : -1e30f, distbase, true, 1 << 30, l, o0, o1);
            else attn_tile<false>(kc, vf, qf, slope, -slope * (float)distbase - bnd[1], distbase, colsel, 1 << 30, l, o0, o1);
        }
        l += __shfl_xor(l, 32);
        const float sc = (l > 0.f) ? NSA_GATE(1) / l : 0.f;
#pragma unroll
        for (int i = 0; i < 16; ++i) { ocl[i * 64] += sc * o0[i]; ocl[(16 + i) * 64] += sc * o1[i]; }
    }
    {
        const unsigned char* KW = p.ws + WS_KFW + (size_t)(b * 2 + g) * (256 * 4096) + lane * 16;
        const unsigned char* VTW = p.ws + WS_VTW + (size_t)(b * 2 + g) * (256 * 4096) + lane * 16;
        float l = 0.f;
        f32x16 o0, o1;
#pragma unroll
        for (int i = 0; i < 16; ++i) { o0[i] = 0.f; o1[i] = 0.f; }
        const int kstart = (t0 - 511 > 0 ? t0 - 511 : 0) & ~31, kfirst = t0 & ~31;
        KF kn;
        load_k(kn, KW + (size_t)kfirst * 128);
#pragma unroll 1
        for (int key0 = kfirst; key0 >= kstart; key0 -= 32) {
            const KF kc = kn; VF vf;
            load_v(vf, VTW + (size_t)key0 * 128);
            { const int kn0 = (key0 - 32 >= kstart) ? key0 - 32 : key0; load_k(kn, KW + (size_t)kn0 * 128); }
            __builtin_amdgcn_sched_barrier(0);
            const int distbase = tc - key0 - 4 * hh;
            if (key0 + 31 <= t0 && key0 >= t0 - 504) attn_tile<true>(kc, vf, qf, slope, -slope * (float)distbase - bnd[2], distbase, true, 512, l, o0, o1);
            else attn_tile<false>(kc, vf, qf, slope, -slope * (float)distbase - bnd[2], distbase, true, 512, l, o0, o1);
        }
        l += __shfl_xor(l, 32);
        const float sc = (l > 0.f) ? NSA_GATE(2) / l : 0.f;
#pragma unroll
        for (int i = 0; i < 16; ++i) { o0[i] = ocl[i * 64] + sc * o0[i]; o1[i] = ocl[(16 + i) * 64] + sc * o1[i]; }
        float ss = 0.f;
#pragma unroll
        for (int i = 0; i < 16; ++i) ss += o0[i] * o0[i] + o1[i] * o1[i];
        ss += __shfl_xor(ss, 32);
        const float r = rsqrtf(ss * (1.0f / 64.0f) + EPS);
        const float* og = p.in[11] + h * 64;
        bf16* op = (bf16*)(p.ws + WS_ACT) + (size_t)(b * T + tc) * D + 512 + h * 64;
#pragma unroll
        for (int dt = 0; dt < 2; ++dt)
#pragma unroll
            for (int rg = 0; rg < 4; ++rg) {
                const int d0 = dt * 32 + 8 * rg + 4 * hh;
                const f32x4 gg = *(const f32x4*)(og + d0);
                u32x2 w;
                if (dt == 0) { w.x = pk2(o0[4 * rg] * r * gg.x, o0[4 * rg + 1] * r * gg.y); w.y = pk2(o0[4 * rg + 2] * r * gg.z, o0[4 * rg + 3] * r * gg.w); }
                else { w.x = pk2(o1[4 * rg] * r * gg.x, o1[4 * rg + 1] * r * gg.y); w.y = pk2(o1[4 * rg + 2] * r * gg.z, o1[4 * rg + 3] * r * gg.w); }
                *(u32x2*)(op + d0) = w;
            }
    }
    WAVE_LDS_SYNC();
}
__device__ __forceinline__ void phase2(const Params& p, unsigned char* lds) {
    unsigned* ctr = (unsigned*)(p.ws + WS_CTR) + 2048;
    volatile int* slot = (volatile int*)(lds + LDS_BYTES - 32);
    for (;;) {
        if (threadIdx.x == 0) *slot = (int)atomicAdd(ctr, 1u);
        __syncthreads();
        const int it = *slot;
        __syncthreads();
        if (it >= 128 + 1024 + 256) break;
        if (it < 128) nsa_cmp_item(p, lds, it);
        else if (it < 1152) hgrn_pre_item(p, lds, it - 128);
        else { nsa_prep_item(p, lds, it - 1152); __syncthreads(); }
    }
}
template <bool SCAN>
__device__ __forceinline__ void phase3(const Params& p, unsigned char* lds) {
    const int wid = __builtin_amdgcn_readfirstlane((int)(threadIdx.x >> 6));
    if (SCAN && blockIdx.x < 32) hgrn_scan_block(p, lds, blockIdx.x);
    unsigned* ctr = (unsigned*)(p.ws + WS_CTR) + (SCAN ? 0 : 128);
    const int myx = (int)(xb_xcc_id() & 7u);
    for (;;) {
        int q = -1, it = 0;
        const int kmax = (wid == 0) ? 8 : 1;
        for (int k = 0; k < kmax; ++k) {
            const int x = (myx + k) & 7;
            int v = 0;
            if ((threadIdx.x & 63) == 0) v = (int)atomicAdd(ctr + x * 16, 1u);
            v = __builtin_amdgcn_readfirstlane(v);
            if (v < 512) { q = x; it = v; break; }
        }
        if (q < 0) break;
        const int item = ((q >> 1) << 10) | ((q & 1) * 512 + 511 - it);
        nsa_attn_item(p, lds + wid * 16640, item);
    }
}

__device__ __forceinline__ float dot2u(unsigned a, unsigned b, float acc) { return __builtin_amdgcn_fdot2_f32_bf16(__builtin_bit_cast(bf16x2v, a), __builtin_bit_cast(bf16x2v, b), acc, false); }
__device__ __forceinline__ float dot8(u32x4 a, u32x4 b, float acc) {
    const unsigned a0 = a.x, a1 = a.y, a2 = a.z, a3 = a.w, b0 = b.x, b1 = b.y, b2 = b.z, b3 = b.w;
    acc = dot2u(a0, b0, acc); acc = dot2u(a1, b1, acc); acc = dot2u(a2, b2, acc); acc = dot2u(a3, b3, acc);
    return acc;
}
__device__ __forceinline__ void axpy8(float (&o)[8], float c, u32x4 v) {
    o[0] += c * __uint_as_float(v.x << 16); o[1] += c * __uint_as_float(v.x & 0xffff0000u);
    o[2] += c * __uint_as_float(v.y << 16); o[3] += c * __uint_as_float(v.y & 0xffff0000u);
    o[4] += c * __uint_as_float(v.z << 16); o[5] += c * __uint_as_float(v.z & 0xffff0000u);
    o[6] += c * __uint_as_float(v.w << 16); o[7] += c * __uint_as_float(v.w & 0xffff0000u);
}
typedef float f32x2 __attribute__((ext_vector_type(2)));
__device__ __forceinline__ float dot16_fp8(u32x4 r, const float* xf) {
    const unsigned r0 = r.x, r1 = r.y, r2 = r.z, r3 = r.w; f32x2 acc = (f32x2){0.f, 0.f};
#define D16_STEP(rr, hi, k) acc = __builtin_elementwise_fma(__builtin_amdgcn_cvt_pk_f32_fp8((int)(rr), hi), (f32x2){xf[k], xf[(k) + 1]}, acc);
    D16_STEP(r0, false, 0) D16_STEP(r0, true, 2) D16_STEP(r1, false, 4) D16_STEP(r1, true, 6)
    D16_STEP(r2, false, 8) D16_STEP(r2, true, 10) D16_STEP(r3, false, 12) D16_STEP(r3, true, 14)
#undef D16_STEP
    return acc.x + acc.y;
}
__device__ __forceinline__ void axpy16_fp8(float* o, float c, u32x4 r) {
    const unsigned r0 = r.x, r1 = r.y, r2 = r.z, r3 = r.w; const f32x2 cc = (f32x2){c, c};
#define A16_STEP(rr, hi, k) { f32x2 a = (f32x2){o[k], o[(k) + 1]}; a = __builtin_elementwise_fma(__builtin_amdgcn_cvt_pk_f32_fp8((int)(rr), hi), cc, a); o[k] = a.x; o[(k) + 1] = a.y; }
    A16_STEP(r0, false, 0) A16_STEP(r0, true, 2) A16_STEP(r1, false, 4) A16_STEP(r1, true, 6)
    A16_STEP(r2, false, 8) A16_STEP(r2, true, 10) A16_STEP(r3, false, 12) A16_STEP(r3, true, 14)
#undef A16_STEP
}
template <bool DUMMY>
__device__ __forceinline__ void phase9(const Params& p, unsigned char* lds) {
    const bf16* HN = (const bf16*)(p.ws + WS_ACT); const unsigned char* UB = p.ws + WS_UB; const unsigned char* VB = p.ws + WS_VB;
    const float* US = (const float*)(p.ws + WS_US); const float* VS = (const float*)(p.ws + WS_VS);
    const int* ids = (const int*)(p.ws + WS_IDS); const float* wts = (const float*)(p.ws + WS_WTS);
    float* O = p.out; bf16* HG = (bf16*)(p.ws + WS_PROJ + 64 * MiB); const float* gn = p.in[19];
    const int lane = threadIdx.x & 63, gw = (blockIdx.x * NTHR + threadIdx.x) >> 6, ngw = (gridDim.x * NTHR) >> 6;
    for (int tok = gw; tok < NTOK; tok += ngw) {
        float xf[16], oa[16];
        {
            const u32x4 x0 = *(const u32x4*)(HN + (size_t)tok * D + lane * 16), x1 = *(const u32x4*)(HN + (size_t)tok * D + lane * 16 + 8);
            const unsigned a0 = x0.x, a1 = x0.y, a2 = x0.z, a3 = x0.w, b0 = x1.x, b1 = x1.y, b2 = x1.z, b3 = x1.w;
            xf[0] = __uint_as_float(a0 << 16); xf[1] = __uint_as_float(a0 & 0xffff0000u); xf[2] = __uint_as_float(a1 << 16); xf[3] = __uint_as_float(a1 & 0xffff0000u);
            xf[4] = __uint_as_float(a2 << 16); xf[5] = __uint_as_float(a2 & 0xffff0000u); xf[6] = __uint_as_float(a3 << 16); xf[7] = __uint_as_float(a3 & 0xffff0000u);
            xf[8] = __uint_as_float(b0 << 16); xf[9] = __uint_as_float(b0 & 0xffff0000u); xf[10] = __uint_as_float(b1 << 16); xf[11] = __uint_as_float(b1 & 0xffff0000u);
            xf[12] = __uint_as_float(b2 << 16); xf[13] = __uint_as_float(b2 & 0xffff0000u); xf[14] = __uint_as_float(b3 << 16); xf[15] = __uint_as_float(b3 & 0xffff0000u);
        }
#pragma unroll
        for (int j = 0; j < 16; ++j) oa[j] = 0.f;
#pragma unroll 1
        for (int half = 0; half < 2; ++half) {
            const int myid = ids[(size_t)tok * 128 + half * 64 + lane];
            const float myw = wts[(size_t)tok * 128 + half * 64 + lane] * VS[myid];
            const float myus = US[myid];
#pragma unroll 1
            for (int eb = 0; eb < 64; eb += 16) {
                int id[16]; float d[16]; u32x4 ur[16];
#pragma unroll
                for (int j = 0; j < 16; ++j) id[j] = __shfl(myid, eb + j);
#pragma unroll
                for (int j = 0; j < 16; ++j) ur[j] = *(const u32x4*)(UB + (size_t)id[j] * D + lane * 16);
#pragma unroll
                for (int j = 0; j < 16; ++j) d[j] = dot16_fp8(ur[j], xf);
#pragma unroll
                for (int j = 0; j < 16; ++j) ur[j] = *(const u32x4*)(VB + (size_t)id[j] * D + lane * 16);
#pragma unroll
                for (int j = 0; j < 16; ++j) d[j] = wave_sum(d[j]);
#pragma unroll
                for (int j = 0; j < 16; ++j) { const float c = __shfl(myw, eb + j) * gelu_tanh(d[j] * __shfl(myus, eb + j)); axpy16_fp8(oa, c, ur[j]); }
            }
        }
        float* orow = O + (size_t)tok * D + lane * 16; float* wrow = DUMMY ? (float*)(p.ws + WS_PROJ) + (size_t)tok * D + lane * 16 : orow;
        float ss = 0.f; f32x4 hv[4];
#pragma unroll
        for (int q = 0; q < 4; ++q) {
            f32x4 h = *(const f32x4*)(orow + 4 * q);
            h.x += oa[4 * q]; h.y += oa[4 * q + 1]; h.z += oa[4 * q + 2]; h.w += oa[4 * q + 3];
            *(f32x4*)(wrow + 4 * q) = h; hv[q] = h;
            ss += h.x * h.x + h.y * h.y + h.z * h.z + h.w * h.w;
        }
        ss = wave_sum(ss);
        const float r = rsqrtf(ss * (1.0f / D) + EPS);
        u32x4 q0, q1;
        { const f32x4 g0 = *(const f32x4*)(gn + lane * 16), g1 = *(const f32x4*)(gn + lane * 16 + 4), g2 = *(const f32x4*)(gn + lane * 16 + 8), g3 = *(const f32x4*)(gn + lane * 16 + 12);
          q0.x = pk2(hv[0].x * r * g0.x, hv[0].y * r * g0.y); q0.y = pk2(hv[0].z * r * g0.z, hv[0].w * r * g0.w); q0.z = pk2(hv[1].x * r * g1.x, hv[1].y * r * g1.y); q0.w = pk2(hv[1].z * r * g1.z, hv[1].w * r * g1.w);
          q1.x = pk2(hv[2].x * r * g2.x, hv[2].y * r * g2.y); q1.y = pk2(hv[2].z * r * g2.z, hv[2].w * r * g2.w); q1.z = pk2(hv[3].x * r * g3.x, hv[3].y * r * g3.y); q1.w = pk2(hv[3].z * r * g3.z, hv[3].w * r * g3.w); }
        *(u32x4*)(HG + (size_t)tok * D + lane * 16) = q0; *(u32x4*)(HG + (size_t)tok * D + lane * 16 + 8) = q1;
    }
}


__device__ __forceinline__ unsigned xb_xcc_id();
template <int CTRL> __device__ __forceinline__ float dpp_row_ror(float v) { return __int_as_float(__builtin_amdgcn_update_dpp(0, __float_as_int(v), CTRL, 0xF, 0xF, false)); }
__device__ __forceinline__ float grp8_sum(float v) { v += dpp_f<0xB1>(v); v += dpp_f<0x4E>(v); v += dpp_f<0x141>(v); return v; }
__device__ __forceinline__ int peer_next_item(unsigned* ctr, int myx, int& slice) {
    const int kmax = (__builtin_amdgcn_readfirstlane((int)(threadIdx.x >> 6)) == 0) ? 8 : 1;
    for (int k = 0; k < kmax; ++k) {
        const int x = (myx + k) & 7;
        int it = 0;
        if ((threadIdx.x & 63) == 0) it = (int)atomicAdd(ctr + x * 16, 1u);
        it = __builtin_amdgcn_readfirstlane(it);
        if (it < 1024) { slice = x; return it; }
    }
    return -1;
}
__device__ __forceinline__ void unpack16(const u32x4 x0, const u32x4 x1, float* xf) {
    const unsigned a0 = x0.x, a1 = x0.y, a2 = x0.z, a3 = x0.w, b0 = x1.x, b1 = x1.y, b2 = x1.z, b3 = x1.w;
    xf[0] = __uint_as_float(a0 << 16); xf[1] = __uint_as_float(a0 & 0xffff0000u); xf[2] = __uint_as_float(a1 << 16); xf[3] = __uint_as_float(a1 & 0xffff0000u);
    xf[4] = __uint_as_float(a2 << 16); xf[5] = __uint_as_float(a2 & 0xffff0000u); xf[6] = __uint_as_float(a3 << 16); xf[7] = __uint_as_float(a3 & 0xffff0000u);
    xf[8] = __uint_as_float(b0 << 16); xf[9] = __uint_as_float(b0 & 0xffff0000u); xf[10] = __uint_as_float(b1 << 16); xf[11] = __uint_as_float(b1 & 0xffff0000u);
    xf[12] = __uint_as_float(b2 << 16); xf[13] = __uint_as_float(b2 & 0xffff0000u); xf[14] = __uint_as_float(b3 << 16); xf[15] = __uint_as_float(b3 & 0xffff0000u);
}
__device__ __forceinline__ void unpack_ids(const u32x4 r, int* id) {
    const unsigned a = r.x, b = r.y, c = r.z, d = r.w;
    id[0] = a & 0xffff; id[1] = a >> 16; id[2] = b & 0xffff; id[3] = b >> 16; id[4] = c & 0xffff; id[5] = c >> 16; id[6] = d & 0xffff; id[7] = d >> 16;
}
__device__ __forceinline__ void phase9a(const Params& p, unsigned char* lds) {
    const bf16* HN = (const bf16*)(p.ws + WS_ACT); const unsigned char* UB = p.ws + WS_UB;
    const unsigned short* ids = (const unsigned short*)(p.ws + WS_IDS); float* PD = (float*)(p.ws + WS_PROJ);
    unsigned* ctr = (unsigned*)(p.ws + WS_CTR) + 256;
    const int lane = threadIdx.x & 63, gq = lane >> 3, cl = lane & 7, myx = (int)(xb_xcc_id() & 7u);
    for (;;) {
        int x; const int it = peer_next_item(ctr, myx, x);
        if (it < 0) break;
        const unsigned char* ub = UB + (size_t)x * (16384 * 128);
        const unsigned cofs = (unsigned)cl * 16u;
        const bf16* hn = HN + x * 128 + cl * 16;
        const int tokb = it * 16;
        const unsigned short* ip = ids + (size_t)tokb * 128 + gq * 8;
        int idn[8]; u32x4 bufA[8], bufB[8], xa0, xa1, xb0, xb1, idr;
        idr = *(const u32x4*)ip; unpack_ids(idr, idn);
#pragma unroll
        for (int i = 0; i < 8; ++i) bufA[i] = *(const u32x4*)(ub + (((unsigned)idn[i] << 7) | cofs));
        xa0 = *(const u32x4*)(hn + (size_t)tokb * D); xa1 = *(const u32x4*)(hn + (size_t)tokb * D + 8);
        idr = *(const u32x4*)(ip + 64); unpack_ids(idr, idn);
#pragma unroll
        for (int i = 0; i < 8; ++i) bufB[i] = *(const u32x4*)(ub + (((unsigned)idn[i] << 7) | cofs));
        xb0 = xa0; xb1 = xa1;
        idr = *(const u32x4*)(ip + 128);
#define P9A_STEP(buf, x0, x1, u) { const int u2_ = ((u) + 2 < 32) ? (u) + 2 : (u), u3_ = ((u) + 3 < 32) ? (u) + 3 : (u); \
            unpack_ids(idr, idn); idr = *(const u32x4*)(ip + u3_ * 64); \
            float xf[16]; unpack16(x0, x1, xf); \
            x0 = *(const u32x4*)(hn + (size_t)(tokb + (u2_ >> 1)) * D); x1 = *(const u32x4*)(hn + (size_t)(tokb + (u2_ >> 1)) * D + 8); \
            float dv[8]; \
            __builtin_amdgcn_sched_barrier(0); \
            _Pragma("unroll") for (int i = 0; i < 8; ++i) { dv[i] = dot16_fp8(buf[i], xf); buf[i] = *(const u32x4*)(ub + (((unsigned)idn[i] << 7) | cofs)); __builtin_amdgcn_sched_barrier(0); } \
              \
            float e4[4], e2[2]; \
            _Pragma("unroll") for (int k = 0; k < 4; ++k) { const float mine = (cl & 1) ? dv[2 * k + 1] : dv[2 * k], send = (cl & 1) ? dv[2 * k] : dv[2 * k + 1]; e4[k] = mine + dpp_f<0xB1>(send); } \
            _Pragma("unroll") for (int k = 0; k < 2; ++k) { const float mine = (cl & 2) ? e4[2 * k + 1] : e4[2 * k], send = (cl & 2) ? e4[2 * k] : e4[2 * k + 1]; e2[k] = mine + dpp_f<0x4E>(send); } \
            const float keep = ((cl & 4) ? e2[1] : e2[0]) + __shfl_xor((cl & 4) ? e2[0] : e2[1], 4); \
            PD[((size_t)x * NTOK + tokb + ((u) >> 1)) * 128 + (((u) & 1) * 8 + cl) * 8 + gq] = keep; }
#pragma unroll 1
        for (int u = 0; u < 32; u += 2) {
            P9A_STEP(bufA, xa0, xa1, u)
            P9A_STEP(bufB, xb0, xb1, u + 1)
        }
#undef P9A_STEP
    }
}
__device__ __forceinline__ void phase9c(const Params& p, unsigned char* lds) {
    const unsigned short* ids = (const unsigned short*)(p.ws + WS_IDS); const float* wts = (const float*)(p.ws + WS_WTS); const float* PD = (const float*)(p.ws + WS_PROJ);
    const float* US = (const float*)(p.ws + WS_US); const float* VS = (const float*)(p.ws + WS_VS); float* coefT = (float*)(p.ws + WS_COEFT);
    const size_t gtid = (size_t)blockIdx.x * NTHR + threadIdx.x, gth = (size_t)gridDim.x * NTHR;
    for (size_t idx = gtid; idx < (size_t)NTOK * 128; idx += gth) {
        const size_t tok = idx >> 7; const int r = (int)(idx & 127), e = (r & 64) + (r & 7) * 8 + ((r >> 3) & 7);
        float sdot = 0.f;
#pragma unroll
        for (int x = 0; x < 8; ++x) sdot += PD[(size_t)x * NTOK * 128 + tok * 128 + e];
        const int id = ids[idx];
        coefT[idx] = wts[tok * 128 + e] * VS[id] * gelu_tanh(sdot * US[id]);
    }
}
__device__ __forceinline__ void phase9b(const Params& p, unsigned char* lds) {
    const unsigned char* VB = p.ws + WS_VB; const unsigned short* ids = (const unsigned short*)(p.ws + WS_IDS); const float* coef = (const float*)(p.ws + WS_COEFT);
    float* O = p.out; bf16* HG = (bf16*)(p.ws + WS_PROJ + 64 * MiB); const float* gn = p.in[19]; float* SSQ = (float*)(p.ws + WS_SSQ);
    unsigned* ctr = (unsigned*)(p.ws + WS_CTR) + 512;
    const int lane = threadIdx.x & 63, gq = lane >> 3, cl = lane & 7, myx = (int)(xb_xcc_id() & 7u);
    for (;;) {
        int x; const int it = peer_next_item(ctr, myx, x);
        if (it < 0) break;
        const unsigned char* vb = VB + (size_t)x * (16384 * 128);
        const unsigned cofs = (unsigned)cl * 16u;
        const int tokb = it * 16;
        const unsigned short* ip = ids + (size_t)tokb * 128 + gq * 8;
        const float* cp = coef + (size_t)tokb * 128 + gq * 8;
        int idn[8]; u32x4 buf[8], idr; f32x4 cf0, cf1, cn0, cn1; float acc[16];
#pragma unroll
        for (int j = 0; j < 16; ++j) acc[j] = 0.f;
        idr = *(const u32x4*)ip; unpack_ids(idr, idn);
        cf0 = *(const f32x4*)cp; cf1 = *(const f32x4*)(cp + 4);
#pragma unroll
        for (int i = 0; i < 8; ++i) buf[i] = *(const u32x4*)(vb + (((unsigned)idn[i] << 7) | cofs));
        idr = *(const u32x4*)(ip + 64); cn0 = *(const f32x4*)(cp + 64); cn1 = *(const f32x4*)(cp + 68);
#pragma unroll 1
        for (int u = 0; u < 32; ++u) {
            const int u2 = (u + 2 < 32) ? u + 2 : u;
            unpack_ids(idr, idn);
            const f32x4 c0 = cf0, c1 = cf1; cf0 = cn0; cf1 = cn1;
            idr = *(const u32x4*)(ip + u2 * 64); cn0 = *(const f32x4*)(cp + u2 * 64); cn1 = *(const f32x4*)(cp + u2 * 64 + 4);
            const float cfv[8] = {c0.x, c0.y, c0.z, c0.w, c1.x, c1.y, c1.z, c1.w};
            __builtin_amdgcn_sched_barrier(0);
#pragma unroll
            for (int i = 0; i < 8; ++i) { axpy16_fp8(acc, cfv[i], buf[i]); buf[i] = *(const u32x4*)(vb + (((unsigned)idn[i] << 7) | cofs)); __builtin_amdgcn_sched_barrier(0); }
            if (u & 1) {
                const int tok = tokb + (u >> 1);
#pragma unroll
                for (int j = 0; j < 16; ++j) { float v = acc[j]; v += __shfl_xor(v, 8); v += __shfl_xor(v, 16); v += __shfl_xor(v, 32); acc[j] = v; }
                float ss = 0.f;
                if (gq == 0) {
                    float* orow = O + (size_t)tok * D + x * 128 + cl * 16; const float* gr = gn + x * 128 + cl * 16; u32x4 q0, q1; unsigned qq[8];
#pragma unroll
                    for (int q = 0; q < 4; ++q) {
                        f32x4 hv = *(const f32x4*)(orow + 4 * q); const f32x4 gg = *(const f32x4*)(gr + 4 * q);
                        hv.x += acc[4 * q]; hv.y += acc[4 * q + 1]; hv.z += acc[4 * q + 2]; hv.w += acc[4 * q + 3];
                        *(f32x4*)(orow + 4 * q) = hv;
                        ss += hv.x * hv.x + hv.y * hv.y + hv.z * hv.z + hv.w * hv.w;
                        qq[2 * q] = pk2(hv.x * gg.x, hv.y * gg.y); qq[2 * q + 1] = pk2(hv.z * gg.z, hv.w * gg.w);
                    }
                    q0.x = qq[0]; q0.y = qq[1]; q0.z = qq[2]; q0.w = qq[3]; q1.x = qq[4]; q1.y = qq[5]; q1.z = qq[6]; q1.w = qq[7];
                    *(u32x4*)(HG + (size_t)tok * D + x * 128 + cl * 16) = q0; *(u32x4*)(HG + (size_t)tok * D + x * 128 + cl * 16 + 8) = q1;
                }
                ss = grp8_sum(ss);
                if (lane == 0) SSQ[(size_t)x * NTOK + tok] = ss;
#pragma unroll
                for (int j = 0; j < 16; ++j) acc[j] = 0.f;
            }
        }
    }
}

#define XB_TMO      128
#define XB_XCNT(j)  (256  + 64 * (j))
#define XB_XSUB(j)  (1280 + 64 * (j))
#define XB_XGEN(j)  (2304 + 64 * (j))
#define XB_TOP      3328
#define XB_TOPGEN   3392
#define XCD_BAR_WORDS 3456
#define XB_SPIN_CAP (1u << 18)
#define LAS __attribute__((address_space(3)))
__device__ __forceinline__ unsigned xb_ld(unsigned* p)              { return __hip_atomic_load(p, __ATOMIC_RELAXED, __HIP_MEMORY_SCOPE_AGENT); }
__device__ __forceinline__ unsigned xb_add(unsigned* p, unsigned v) { return __hip_atomic_fetch_add(p, v, __ATOMIC_RELAXED, __HIP_MEMORY_SCOPE_AGENT); }
__device__ __forceinline__ unsigned xb_xcc_id() { return (unsigned)__builtin_amdgcn_s_getreg((3 << 11) | 20) & 0xFu; }
#define XB_SPIN(cond, bar) do { unsigned _sp = 0; while (cond) { __builtin_amdgcn_s_sleep(1); \
    if ((++_sp & 255u) == 0u) { if (xb_ld(&(bar)[XB_TMO])) break; if (_sp > XB_SPIN_CAP) { atomicAdd(&(bar)[XB_TMO], 1u); break; } } } } while (0)
struct XcdBarrier { unsigned* bar; unsigned x; volatile LAS unsigned* st; };
__device__ __forceinline__ XcdBarrier xcd_barrier_post(unsigned* bar, volatile LAS unsigned* st) {
    XcdBarrier b; b.bar = bar; b.x = xb_xcc_id(); b.st = st;
    if (threadIdx.x == 0) (void)xb_add(&bar[XB_XCNT(b.x)], 1u);
    return b;
}
__device__ __forceinline__ void xcd_barrier_complete(unsigned* bar, unsigned x, unsigned& nloc, unsigned& nx) {
    const unsigned G = gridDim.x * gridDim.y * gridDim.z;
    unsigned sum, cnt, mine, sp = 0u;
    for (;;) {
        sum = 0u; cnt = 0u; mine = 0u;
#pragma unroll
        for (unsigned j = 0; j < 16; ++j) { const unsigned c = xb_ld(&bar[XB_XCNT(j)]); sum += c; cnt += (c > 0u) ? 1u : 0u; mine = (j == x) ? c : mine; }
        if (sum == G) break;
        __builtin_amdgcn_s_sleep(1);
        if ((++sp & 255u) == 0u) { if (xb_ld(&bar[XB_TMO])) break; if (sp > XB_SPIN_CAP) { atomicAdd(&bar[XB_TMO], 1u); break; } }
    }
    nloc = mine > 0u ? mine : 1u; nx = cnt > 0u ? cnt : 1u;
}
__device__ __forceinline__ void xcd_barrier(const XcdBarrier& b) {
    asm volatile("s_waitcnt vmcnt(0)" ::: "memory");
    __syncthreads();
    if (threadIdx.x == 0) {
        unsigned* bar = b.bar;
        __builtin_amdgcn_s_waitcnt(0);
        unsigned nloc = b.st[0], nx = b.st[1];
        if (nloc == 0u) { xcd_barrier_complete(bar, b.x, nloc, nx); b.st[0] = nloc; b.st[1] = nx; }
        const unsigned old = xb_add(&bar[XB_XSUB(b.x)], 1u);
        const unsigned gen = old / nloc;
        if (old + 1u == (gen + 1u) * nloc) {
            __builtin_amdgcn_fence(__ATOMIC_RELEASE, "agent");
            asm volatile("s_waitcnt vmcnt(0)" ::: "memory");
            const unsigned og = xb_add(&bar[XB_TOP], 1u);
            const unsigned tg = og / nx;
            if (og + 1u == (tg + 1u) * nx) xb_add(&bar[XB_TOPGEN], 1u);
            else XB_SPIN(xb_ld(&bar[XB_TOPGEN]) == tg, bar);
            __builtin_amdgcn_fence(__ATOMIC_ACQUIRE, "agent");
            xb_add(&bar[XB_XGEN(b.x)], 1u);
            asm volatile("s_waitcnt vmcnt(0)" ::: "memory");
        } else {
            XB_SPIN(xb_ld(&bar[XB_XGEN(b.x)]) == gen, bar);
            __builtin_amdgcn_fence(__ATOMIC_ACQUIRE, "agent");
            asm volatile("s_waitcnt vmcnt(0)" ::: "memory");
        }
    }
    __syncthreads();
}

constexpr int REPK = -1;
__global__ void __launch_bounds__(NTHR, 2) mega(Params p, int ph_lo, int ph_hi) {
    extern __shared__ __attribute__((aligned(16))) unsigned char lds[];
    volatile LAS unsigned* st = (volatile LAS unsigned*)(LAS unsigned char*)(lds + LDS_BYTES - 16);
    if (threadIdx.x < 4) st[threadIdx.x] = 0u;
    __syncthreads();
    const XcdBarrier bar = xcd_barrier_post((unsigned*)p.ws, st);
#define RUN_PHASE(k, call) if (ph_lo <= (k) && (k) < ph_hi) { if ((k) > ph_lo) xcd_barrier(bar); call; if (REPK == (k)) { xcd_barrier(bar); call; } }
    RUN_PHASE(0, phase0(p, lds))
    RUN_PHASE(1, phase1(p, lds))
    RUN_PHASE(2, phase2(p, lds))
    if (REPK == 30) { xcd_barrier(bar); if ((threadIdx.x >> 6) == 0 && blockIdx.x < 64) hgrn_scan_item<true>(p, blockIdx.x); }
    if (ph_lo <= 3 && 3 < ph_hi) { if (3 > ph_lo) xcd_barrier(bar); phase3<true>(p, lds); if (REPK == 3) { xcd_barrier(bar); phase3<false>(p, lds); } }
    RUN_PHASE(4, phase4(p, lds))
    RUN_PHASE(5, phase5(p, lds))
    RUN_PHASE(6, phase6(p, lds))
    RUN_PHASE(7, phase7(p, lds))
    RUN_PHASE(8, phase8(p, lds))
    if (ph_lo <= 9 && 9 < ph_hi) { if (9 > ph_lo) xcd_barrier(bar); phase9a(p, lds); }
    if (ph_lo <= 9 && 9 < ph_hi) { xcd_barrier(bar); phase9c(p, lds); }
    if (ph_lo <= 9 && 9 < ph_hi) { xcd_barrier(bar); phase9b(p, lds); }
    RUN_PHASE(10, phase10(p, lds))
}

static void launch_mega(const Params& p, int lo, int hi, hipStream_t stream) {
    static int grid = 0;
    if (grid == 0) {
        int dev = 0, cus = 0, per_cu = 0;
        hipGetDevice(&dev); hipDeviceGetAttribute(&cus, hipDeviceAttributeMultiprocessorCount, dev);
        hipFuncSetAttribute((const void*)mega, hipFuncAttributeMaxDynamicSharedMemorySize, LDS_BYTES);
        hipOccupancyMaxActiveBlocksPerMultiprocessor(&per_cu, (const void*)mega, NTHR, LDS_BYTES);
        if (per_cu < 1) { fprintf(stderr, "mega: occupancy query says %d blocks/CU\n", per_cu); per_cu = 1; }
        grid = cus;
    }
    hipMemsetAsync(p.ws, 0, 65536, stream);
    Params pp = p; int l = lo, h = hi;
    void* args[] = {&pp, &l, &h};
    hipError_t e = hipLaunchCooperativeKernel((const void*)mega, dim3(grid), dim3(NTHR), args, LDS_BYTES, stream);
    if (e != hipSuccess) fprintf(stderr, "cooperative launch failed: %s (grid %d)\n", hipGetErrorString(e), grid);
}

extern "C" void kernel_launch(void* const* d_in, const int* in_sizes, int n_in, void* d_out, int out_size, void* d_ws, size_t ws_size, hipStream_t stream) {
    float* out = (float*)d_out; unsigned char* ws = (unsigned char*)d_ws;
    Params prm{}; for (int i = 0; i < 21; ++i) prm.in[i] = (const float*)d_in[i]; prm.out = out; prm.ws = ws;
    launch_mega(prm, 0, 11, stream);
}
```
